# Optimizing an MI355X kernel written in HIP

```python
import math, functools
import jax, jax.numpy as jnp
from jax import lax
import numpy as np

D_MODEL = 1024
BATCH = 4
SEQ = 4096
DEPTH = 4
DEC_BATCH = 8
DEC_SEQ = 64
PAST_LEN = 1024

CHUNK = 64
Q_BLOCK = 128
HEAD_DIM = 64
D_RWKV = D_MODEL // 2
N_RWKV_HEADS = D_RWKV // HEAD_DIM
LORA_DECAY = 64
LORA_ICLR = 64
N_DIFF_HEADS = D_MODEL // (4 * HEAD_DIM)
D_DIFF = N_DIFF_HEADS * 2 * HEAD_DIM
PLE_DIM = 256
NORM_EPS = 1e-6
GN_EPS = 64e-5
SUBLN_EPS = 1e-5
NEG_INF = -1e30
SHIFT_COLS = 3 * D_RWKV + LORA_DECAY + LORA_ICLR
RWKV_SIZES = (D_RWKV, D_RWKV, D_RWKV, LORA_DECAY, LORA_ICLR)
IN_SIZES = (SHIFT_COLS, D_RWKV, D_DIFF, D_DIFF, D_DIFF, D_DIFF, D_MODEL, D_MODEL)
IN_COLS = SHIFT_COLS + D_RWKV + 4 * D_DIFF + 2 * D_MODEL

kernel_name = 'hybrid_rwkv7_diffattn_stream_step'


def _split_points(sizes):
    return [int(s) for s in np.cumsum(sizes)[:-1]]


def rms_norm(x, g, eps=NORM_EPS):
    xf = x.astype(jnp.float32)
    y = xf * lax.rsqrt(jnp.mean(xf * xf, axis=-1, keepdims=True) + eps)
    return (y * g.astype(jnp.float32)).astype(x.dtype)


def head_group_norm(o, g, b):
    mu = jnp.mean(o, axis=-1, keepdims=True)
    var = jnp.mean(jnp.square(o - mu), axis=-1, keepdims=True)
    hn = o.shape[-2:]
    y = (o - mu) * lax.rsqrt(var + GN_EPS)
    y = y * g.astype(jnp.float32).reshape(hn) + b.astype(jnp.float32).reshape(hn)
    return y.reshape(o.shape[:-2] + (hn[0] * hn[1],))


def alibi_slopes():
    return jnp.asarray([2.0 ** (-8.0 * (h + 1) / N_DIFF_HEADS) for h in range(N_DIFF_HEADS)], dtype=jnp.float32)


def diff_attend(q, k, v, q_pos, k_pos, lam):
    s = jnp.einsum('bqhmd,bkhmd->bhmqk', q, k).astype(jnp.float32) * (HEAD_DIM ** -0.5)
    dist = jnp.abs(q_pos[:, None] - k_pos[None, :]).astype(jnp.float32)
    bias = -alibi_slopes()[:, None, None] * dist
    allowed = (k_pos[None, :] // CHUNK) <= (q_pos[:, None] // CHUNK)
    s = jnp.where(allowed, s + bias[:, None], NEG_INF)
    p = jax.nn.softmax(s, axis=-1)
    attn = p[:, :, 0] - lam * p[:, :, 1]
    return jnp.einsum('bhqk,bkhe->bqhe', attn.astype(v.dtype), v)


def prompt_attention(q, k, v, lam):
    b, t = q.shape[:2]
    nb = t // Q_BLOCK
    pos = jnp.arange(t, dtype=jnp.int32)
    qb = jnp.moveaxis(q.reshape((b, nb, Q_BLOCK) + q.shape[2:]), 1, 0)
    pb = pos.reshape(nb, Q_BLOCK)
    ob = lax.map(lambda blk: diff_attend(blk[0], k, v, blk[1], pos, lam), (qb, pb))
    return jnp.moveaxis(ob, 0, 1).reshape((b, t) + ob.shape[3:])


def sample_attention(q, k, v, lam, k_cache, v_cache):
    past, t = k_cache.shape[1], q.shape[1]
    k_all = jnp.concatenate([k_cache.astype(k.dtype), k], axis=1)
    v_all = jnp.concatenate([v_cache.astype(v.dtype), v], axis=1)
    k_pos = jnp.arange(past + t, dtype=jnp.int32)
    return diff_attend(q, k_all, v_all, k_pos[past:], k_pos, lam)


def wkv_scan(r, w, k, v, kk, a, s0):
    def step(S, inp):
        r_t, w_t, k_t, v_t, kk_t, a_t = inp
        S = (S * w_t[:, :, None, :]
             - jnp.einsum('bhvk,bhk->bhv', S, kk_t)[..., None] * (kk_t * a_t)[:, :, None, :]
             + v_t[..., :, None] * k_t[:, :, None, :])
        return S, jnp.einsum('bhvk,bhk->bhv', S, r_t)
    xs = tuple(jnp.moveaxis(u, 1, 0) for u in (r, w, k, v, kk, a))
    s_final, o = lax.scan(step, s0, xs)
    return jnp.moveaxis(o, 0, 1), s_final


def trunk_layer(x, p_emb, lp, layer_idx, shift_prev, wkv_prev, attend):
    b, t, _ = x.shape
    f32 = jnp.float32
    h = rms_norm(x, lp['norm_g'])
    z = h @ lp['w_in']
    z_shift, gate_r, q, k, v, gate_a, mg_r, mg_a = jnp.split(z, _split_points(IN_SIZES), axis=-1)

    z_prev = jnp.concatenate([shift_prev[:, None, :].astype(z.dtype), z_shift[:, :-1]], axis=1)
    zs = z_shift + (z_prev - z_shift) * lp['shift_mu']
    r_, k_, v_, wd, ad = jnp.split(zs, _split_points(RWKV_SIZES), axis=-1)
    w_log = -jax.nn.softplus(-(lp['decay_w0'] + jnp.tanh(wd) @ lp['decay_w2']).astype(f32)) - 0.5
    decay = jnp.exp(-jnp.exp(w_log))
    a = jax.nn.sigmoid((lp['iclr_a0'] + ad @ lp['iclr_a2']).astype(f32))

    def heads(u):
        return u.astype(f32).reshape(b, t, N_RWKV_HEADS, HEAD_DIM)

    kk = heads(k_ * lp['k_k'])
    kk = kk / jnp.maximum(jnp.sqrt(jnp.sum(kk * kk, axis=-1, keepdims=True)), 1e-12)
    kf = k_.astype(f32) * (1.0 + (a - 1.0) * lp['k_a'].astype(f32))
    rh, kh, vh, ah = heads(r_), heads(kf), heads(v_), heads(a)
    o_r, wkv_new = wkv_scan(rh, heads(decay), kh, vh, kk, ah, wkv_prev.astype(f32))
    bonus = jnp.sum(rh * kh * lp['r_k'].astype(f32), axis=-1, keepdims=True) * vh
    o_r = head_group_norm(o_r, lp['lnx_g'], lp['lnx_b']) + bonus.reshape(b, t, D_RWKV)
    o_r = o_r.astype(x.dtype) * jax.nn.silu(gate_r)

    qh = rms_norm(q.reshape(b, t, N_DIFF_HEADS, 2, HEAD_DIM), lp['q_norm_g'])
    kh_a = rms_norm(k.reshape(b, t, N_DIFF_HEADS, 2, HEAD_DIM), lp['k_norm_g'])
    vh_a = v.reshape(b, t, N_DIFF_HEADS, 2 * HEAD_DIM)
    lam_init = 0.8 - 0.6 * math.exp(-0.3 * layer_idx)
    lam = (jnp.exp(jnp.sum(lp['lambda_q1'].astype(f32) * lp['lambda_k1'].astype(f32)))
           - jnp.exp(jnp.sum(lp['lambda_q2'].astype(f32) * lp['lambda_k2'].astype(f32))) + lam_init)
    o_a = attend(qh, kh_a, vh_a, lam)
    o_a = rms_norm(o_a, lp['subln_g'], SUBLN_EPS) * (1.0 - lam_init)
    o_a = o_a.reshape(b, t, D_DIFF) * jax.nn.silu(gate_a)

    u = jax.nn.sigmoid(mg_r) * (o_r @ lp['w_br_r']) + jax.nn.sigmoid(mg_a) * (o_a @ lp['w_br_a'])
    x = x + u @ lp['w_out']
    e = p_emb @ lp['ple_w']
    x = x + e * jax.nn.sigmoid(rms_norm(x, lp['ple_norm_g']) @ lp['ple_gate_w'])
    return x, kh_a, vh_a, wkv_new.astype(x.dtype), z_shift[:, -1]


def setup_inputs(seed: int = 0) -> dict:
    key = jax.random.key(seed)
    ks = iter(jax.random.split(key, 48))
    f32 = jnp.float32

    def nrm(shape, scale):
        return jax.random.normal(next(ks), shape, f32) * scale

    L = DEPTH
    return {
        'x_prompt': nrm((BATCH, SEQ, D_MODEL), 1.0),
        'x_sample': nrm((DEC_BATCH, DEC_SEQ, D_MODEL), 1.0),
        'p_prompt': nrm((DEPTH, BATCH, SEQ, PLE_DIM), 1.0),
        'p_sample': nrm((DEPTH, DEC_BATCH, DEC_SEQ, PLE_DIM), 1.0),
        'cache_k': nrm((L, DEC_BATCH, PAST_LEN, N_DIFF_HEADS, 2, HEAD_DIM), 1.0),
        'cache_v': nrm((L, DEC_BATCH, PAST_LEN, N_DIFF_HEADS, 2 * HEAD_DIM), 1.0),
        'state_wkv': nrm((L, DEC_BATCH, N_RWKV_HEADS, HEAD_DIM, HEAD_DIM), 0.5),
        'state_shift': nrm((L, DEC_BATCH, SHIFT_COLS), 1.0),
        'norm_g': 1.0 + nrm((L, D_MODEL), 0.02),
        'w_in': nrm((L, D_MODEL, IN_COLS), D_MODEL ** -0.5),
        'shift_mu': jax.random.uniform(next(ks), (L, SHIFT_COLS), f32),
        'decay_w0': jax.random.uniform(next(ks), (L, D_RWKV), f32, -3.0, 0.0),
        'decay_w2': nrm((L, LORA_DECAY, D_RWKV), 0.5 * LORA_DECAY ** -0.5),
        'iclr_a0': nrm((L, D_RWKV), 0.5),
        'iclr_a2': nrm((L, LORA_ICLR, D_RWKV), 0.5 * LORA_ICLR ** -0.5),
        'k_k': 0.85 + nrm((L, D_RWKV), 0.05),
        'k_a': 1.0 + nrm((L, D_RWKV), 0.05),
        'r_k': nrm((L, N_RWKV_HEADS, HEAD_DIM), 0.1),
        'lnx_g': 1.0 + nrm((L, D_RWKV), 0.02),
        'lnx_b': nrm((L, D_RWKV), 0.02),
        'q_norm_g': 1.0 + nrm((L, HEAD_DIM), 0.02),
        'k_norm_g': 1.0 + nrm((L, HEAD_DIM), 0.02),
        'lambda_q1': nrm((L, HEAD_DIM), 0.1),
        'lambda_k1': nrm((L, HEAD_DIM), 0.1),
        'lambda_q2': nrm((L, HEAD_DIM), 0.1),
        'lambda_k2': nrm((L, HEAD_DIM), 0.1),
        'subln_g': 1.0 + nrm((L, 2 * HEAD_DIM), 0.02),
        'w_br_r': nrm((L, D_RWKV, D_MODEL), D_RWKV ** -0.5),
        'w_br_a': nrm((L, D_DIFF, D_MODEL), D_DIFF ** -0.5),
        'w_out': nrm((L, D_MODEL, D_MODEL), D_MODEL ** -0.5),
        'ple_w': nrm((L, PLE_DIM, D_MODEL), 0.5 * PLE_DIM ** -0.5),
        'ple_gate_w': nrm((L, D_MODEL, D_MODEL), D_MODEL ** -0.5),
        'ple_norm_g': 1.0 + nrm((L, D_MODEL), 0.02),
    }


def reference(x_prompt, x_sample, p_prompt, p_sample, cache_k, cache_v, state_wkv, state_shift,
              norm_g, w_in, shift_mu, decay_w0, decay_w2, iclr_a0, iclr_a2, k_k, k_a, r_k,
              lnx_g, lnx_b, q_norm_g, k_norm_g, lambda_q1, lambda_k1, lambda_q2, lambda_k2,
              subln_g, w_br_r, w_br_a, w_out, ple_w, ple_gate_w, ple_norm_g):
    y_p, y_s = x_prompt, x_sample
    kp_l, vp_l, wp_l, sp_l, ks_l, vs_l, ws_l, ss_l = [], [], [], [], [], [], [], []
    b_p = x_prompt.shape[0]
    for i in range(DEPTH):
        lp = dict(norm_g=norm_g[i], w_in=w_in[i], shift_mu=shift_mu[i], decay_w0=decay_w0[i],
                  decay_w2=decay_w2[i], iclr_a0=iclr_a0[i], iclr_a2=iclr_a2[i], k_k=k_k[i],
                  k_a=k_a[i], r_k=r_k[i], lnx_g=lnx_g[i], lnx_b=lnx_b[i], q_norm_g=q_norm_g[i],
                  k_norm_g=k_norm_g[i], lambda_q1=lambda_q1[i], lambda_k1=lambda_k1[i],
                  lambda_q2=lambda_q2[i], lambda_k2=lambda_k2[i], subln_g=subln_g[i],
                  w_br_r=w_br_r[i], w_br_a=w_br_a[i], w_out=w_out[i], ple_w=ple_w[i],
                  ple_gate_w=ple_gate_w[i], ple_norm_g=ple_norm_g[i])
        zero_shift = jnp.zeros((b_p, SHIFT_COLS), x_prompt.dtype)
        zero_wkv = jnp.zeros((b_p, N_RWKV_HEADS, HEAD_DIM, HEAD_DIM), jnp.float32)
        y_p, kp, vp, wp, sp = trunk_layer(y_p, p_prompt[i], lp, i, zero_shift, zero_wkv, prompt_attention)
        att_s = functools.partial(sample_attention, k_cache=cache_k[i], v_cache=cache_v[i])
        y_s, ks_, vs_, ws_, ss_ = trunk_layer(y_s, p_sample[i], lp, i, state_shift[i], state_wkv[i], att_s)
        kp_l.append(kp); vp_l.append(vp); wp_l.append(wp); sp_l.append(sp)
        ks_l.append(ks_); vs_l.append(vs_); ws_l.append(ws_); ss_l.append(ss_)
    return (y_p, y_s, jnp.stack(kp_l), jnp.stack(vp_l), jnp.stack(wp_l), jnp.stack(sp_l),
            jnp.stack(ks_l), jnp.stack(vs_l), jnp.stack(ws_l), jnp.stack(ss_l))
```

```cpp
#include <hip/hip_runtime.h>
#include <hip/hip_cooperative_groups.h>
#include <stdint.h>
#include <stdio.h>
namespace cg = cooperative_groups;

#ifndef MEGA
#define MEGA 1
#endif

typedef unsigned short bf16_t;
typedef short bf16x8 __attribute__((ext_vector_type(8)));
typedef short s16x4 __attribute__((ext_vector_type(4)));
typedef float f32x4 __attribute__((ext_vector_type(4)));
typedef float f32x2 __attribute__((ext_vector_type(2)));
typedef float f32x16 __attribute__((ext_vector_type(16)));
typedef unsigned u32x4 __attribute__((ext_vector_type(4)));
typedef unsigned u32x2 __attribute__((ext_vector_type(2)));
typedef __bf16 bfv2 __attribute__((ext_vector_type(2)));

#define DI __device__ __forceinline__
DI int tid_() { int t = threadIdx.x; asm volatile("" : "+v"(t)); return t; }

constexpr int DM = 1024, MP = 16384, MS = 512, MT = 16896, NZ = 6272, NL = 4;
constexpr int C_GR = 1664, C_Q = 2176, C_K = 2688, C_V = 3200, C_GA = 3712, C_MR = 4224, C_MA = 5248;
constexpr int SHC = 1664;
constexpr size_t O_YP = 0, O_YS = 16777216, O_KP = 17301504, O_VP = 50855936, O_WP = 84410368, O_SP = 84934656,
                 O_KS = 84961280, O_VS = 86009856, O_WS = 87058432, O_SS = 88107008;

struct Params {
  const float *xp, *xs, *pp, *ps, *ck, *cv, *swkv, *sshift;
  const float *norm_g, *w_in, *shift_mu, *decay_w0, *decay_w2, *iclr_a0, *iclr_a2, *k_k, *k_a, *r_k, *lnx_g, *lnx_b,
      *qng, *kng, *lq1, *lk1, *lq2, *lk2, *subln_g, *w_br_r, *w_br_a, *w_out, *ple_w, *ple_gate_w, *ple_norm_g;
  float* out;
  bf16_t *wt_in, *wt_brr, *wt_bra, *wt_out, *wt_ple, *wt_gate, *w2t, *a2t;
  bf16_t *hn, *z, *vtp, *vts, *kc, *vct, *o_r, *o_a;
};

DI unsigned pk2(float a, float b) { f32x2 v = {a, b}; bfv2 r = __builtin_convertvector(v, bfv2); return __builtin_bit_cast(unsigned, r); }
DI float bf_lo(unsigned u) { return __uint_as_float(u << 16); }
DI float bf_hi(unsigned u) { return __uint_as_float(u & 0xffff0000u); }
DI float bf1(bf16_t u) { return __uint_as_float(((unsigned)u) << 16); }
DI float sigmoidf_(float x) { return 1.0f / (1.0f + __expf(-x)); }
DI float siluf_(float x) { return x / (1.0f + __expf(-x)); }

DI void tr_tile(const float* __restrict__ src, int ld_src, bf16_t* __restrict__ dst, int ld_dst, float* sm) {
  const int tid = tid_();
  const int r = tid >> 4, c4 = (tid & 15) * 4;
#pragma unroll
  for (int i = 0; i < 4; ++i) {
    const int row = r + 16 * i;
    f32x4 v = *(const f32x4*)(src + (size_t)row * ld_src + c4);
    sm[row * 65 + c4 + 0] = v[0]; sm[row * 65 + c4 + 1] = v[1]; sm[row * 65 + c4 + 2] = v[2]; sm[row * 65 + c4 + 3] = v[3];
  }
  __syncthreads();
  const int n = tid >> 2, ks = (tid & 3) * 16;
  u32x4 o0, o1;
  o0[0] = pk2(sm[(ks + 0) * 65 + n], sm[(ks + 1) * 65 + n]);   o0[1] = pk2(sm[(ks + 2) * 65 + n], sm[(ks + 3) * 65 + n]);
  o0[2] = pk2(sm[(ks + 4) * 65 + n], sm[(ks + 5) * 65 + n]);   o0[3] = pk2(sm[(ks + 6) * 65 + n], sm[(ks + 7) * 65 + n]);
  o1[0] = pk2(sm[(ks + 8) * 65 + n], sm[(ks + 9) * 65 + n]);   o1[1] = pk2(sm[(ks + 10) * 65 + n], sm[(ks + 11) * 65 + n]);
  o1[2] = pk2(sm[(ks + 12) * 65 + n], sm[(ks + 13) * 65 + n]); o1[3] = pk2(sm[(ks + 14) * 65 + n], sm[(ks + 15) * 65 + n]);
  *(u32x4*)(dst + (size_t)n * ld_dst + ks) = o0;
  *(u32x4*)(dst + (size_t)n * ld_dst + ks + 8) = o1;
  __syncthreads();
}

DI void phase_wconv(const Params& p, char* lds) {
  float* sm = (float*)lds;
  const int per_layer = 1568 + 128 + 128 + 256 + 64 + 256 + 8 + 8;
  for (int it = blockIdx.x; it < per_layer * NL; it += gridDim.x) {
    const int l = it / per_layer; int t = it % per_layer;
    const float* src; bf16_t* dst; int K, N;
    if (t < 1568) { src = p.w_in + (size_t)l * 1024 * NZ; dst = p.wt_in + (size_t)l * NZ * 1024; K = 1024; N = NZ; }
    else if ((t -= 1568) < 128) { src = p.w_br_r + (size_t)l * 512 * 1024; dst = p.wt_brr + (size_t)l * 1024 * 512; K = 512; N = 1024; }
    else if ((t -= 128) < 128) { src = p.w_br_a + (size_t)l * 512 * 1024; dst = p.wt_bra + (size_t)l * 1024 * 512; K = 512; N = 1024; }
    else if ((t -= 128) < 256) { src = p.w_out + (size_t)l * 1024 * 1024; dst = p.wt_out + (size_t)l * 1024 * 1024; K = 1024; N = 1024; }
    else if ((t -= 256) < 64) { src = p.ple_w + (size_t)l * 256 * 1024; dst = p.wt_ple + (size_t)l * 1024 * 256; K = 256; N = 1024; }
    else if ((t -= 64) < 256) { src = p.ple_gate_w + (size_t)l * 1024 * 1024; dst = p.wt_gate + (size_t)l * 1024 * 1024; K = 1024; N = 1024; }
    else if ((t -= 256) < 8) { src = p.decay_w2 + (size_t)l * 64 * 512; dst = p.w2t + (size_t)l * 512 * 64; K = 64; N = 512; }
    else { t -= 8; src = p.iclr_a2 + (size_t)l * 64 * 512; dst = p.a2t + (size_t)l * 512 * 64; K = 64; N = 512; }
    const int ntn = N / 64; const int tk = t / ntn, tn = t % ntn;
    tr_tile(src + (size_t)(tk * 64) * N + tn * 64, N, dst + (size_t)(tn * 64) * K + tk * 64, K, sm);
  }
}

DI const float* x_row(const Params& p, int l, int r) {
  if (l == 0) return r < MP ? p.xp + (size_t)r * DM : p.xs + (size_t)(r - MP) * DM;
  return p.out + (size_t)r * DM;
}
DI void phase_norm(const Params& p, int l, bool first, char* lds) {
  const int tid = tid_(), wave = tid >> 6, lane = tid & 63;
  const float* g = (first ? p.norm_g : p.ple_norm_g) + l * DM;
  const int n_norm = MT / 4;
  const int n_items = n_norm + (first ? 2048 : 0);
  for (int it = blockIdx.x; it < n_items; it += gridDim.x) {
    if (it < n_norm) {
      const int r = it * 4 + wave;
      const float* x = first ? x_row(p, l, r) : p.out + (size_t)r * DM;
      f32x4 v[4]; float ss = 0.f;
#pragma unroll
      for (int i = 0; i < 4; ++i) { v[i] = *(const f32x4*)(x + lane * 4 + 256 * i); ss += v[i][0] * v[i][0] + v[i][1] * v[i][1] + v[i][2] * v[i][2] + v[i][3] * v[i][3]; }
#pragma unroll
      for (int o = 32; o >= 1; o >>= 1) ss += __shfl_xor(ss, o);
      const float rstd = rsqrtf(ss * (1.0f / 1024.0f) + 1e-6f);
#pragma unroll
      for (int i = 0; i < 4; ++i) {
        const f32x4 gv = *(const f32x4*)(g + lane * 4 + 256 * i);
        u32x2 o; o[0] = pk2(v[i][0] * rstd * gv[0], v[i][1] * rstd * gv[1]); o[1] = pk2(v[i][2] * rstd * gv[2], v[i][3] * rstd * gv[3]);
        *(u32x2*)(p.hn + (size_t)r * DM + lane * 4 + 256 * i) = o;
      }
    } else if (it < n_norm + 1024) {
      const int c = it - n_norm;
      const float* src = p.ck + (size_t)l * 8 * 1024 * 512 + (size_t)c * 4096 + tid * 16;
      bf16_t* dst = p.kc + (size_t)c * 4096 + tid * 16;
      f32x4 a0 = *(const f32x4*)(src), a1 = *(const f32x4*)(src + 4), a2 = *(const f32x4*)(src + 8), a3 = *(const f32x4*)(src + 12);
      u32x4 o0, o1;
      o0[0] = pk2(a0[0], a0[1]); o0[1] = pk2(a0[2], a0[3]); o0[2] = pk2(a1[0], a1[1]); o0[3] = pk2(a1[2], a1[3]);
      o1[0] = pk2(a2[0], a2[1]); o1[1] = pk2(a2[2], a2[3]); o1[2] = pk2(a3[0], a3[1]); o1[3] = pk2(a3[2], a3[3]);
      *(u32x4*)dst = o0; *(u32x4*)(dst + 8) = o1;
    } else {
      const int c = it - n_norm - 1024;
      const int bh = c >> 5, tt = c & 31; const int b = bh >> 2, h = bh & 3; const int tk = tt >> 1, tn = tt & 1;
      const float* src = p.cv + (size_t)l * 8 * 1024 * 512 + ((size_t)(b * 1024 + tk * 64)) * 512 + h * 128 + tn * 64;
      bf16_t* dst = p.vct + ((size_t)(bh * 128 + tn * 64)) * 1024 + tk * 64;
      tr_tile(src, 512, dst, 1024, (float*)lds);
    }
  }
}

constexpr int GLD = 72;
template <bool A_F32>
DI void gemm_core(f32x4 (&acc)[4][4], const void* Ap, int lda, const bf16_t* Bp, int ldb, int K, char* lds) {
  bf16_t* As = (bf16_t*)lds;
  bf16_t* Bs = (bf16_t*)(lds + 2 * 128 * GLD * 2);
  const int tid = tid_(), wave = tid >> 6, lane = tid & 63;
  const int wm = wave >> 1, wn = wave & 1, l15 = lane & 15, quad = lane >> 4;
  const int nk = K / 64;
  u32x4 ra[4], rb[4];
  auto gload = [&](int kt) {
#pragma unroll
    for (int i = 0; i < 4; ++i) {
      const int c = tid + 256 * i; const int row = c >> 3, c8 = (c & 7) * 8;
      if (!A_F32) ra[i] = *(const u32x4*)((const bf16_t*)Ap + (size_t)row * lda + kt * 64 + c8);
      rb[i] = *(const u32x4*)(Bp + (size_t)row * ldb + kt * 64 + c8);
    }
  };
  auto sstore = [&](int buf, int kt) {
#pragma unroll
    for (int i = 0; i < 4; ++i) {
      const int c = tid + 256 * i; const int row = c >> 3, c8 = (c & 7) * 8;
      if (A_F32) {
        const float* a = (const float*)Ap + (size_t)row * lda + kt * 64 + c8;
        const f32x4 v0 = *(const f32x4*)a, v1 = *(const f32x4*)(a + 4);
        u32x4 t; t[0] = pk2(v0[0], v0[1]); t[1] = pk2(v0[2], v0[3]); t[2] = pk2(v1[0], v1[1]); t[3] = pk2(v1[2], v1[3]);
        *(u32x4*)(As + (buf * 128 + row) * GLD + c8) = t;
      } else {
        *(u32x4*)(As + (buf * 128 + row) * GLD + c8) = ra[i];
      }
      *(u32x4*)(Bs + (buf * 128 + row) * GLD + c8) = rb[i];
    }
  };
  gload(0); sstore(0, 0); __syncthreads();
  for (int kt = 0; kt < nk; ++kt) {
    const int buf = kt & 1;
    if (kt + 1 < nk) gload(kt + 1);
#pragma unroll
    for (int ks = 0; ks < 2; ++ks) {
      bf16x8 af[4], bfr[4];
#pragma unroll
      for (int i = 0; i < 4; ++i) {
        af[i] = *(const bf16x8*)(As + (buf * 128 + wm * 64 + i * 16 + l15) * GLD + ks * 32 + quad * 8);
        bfr[i] = *(const bf16x8*)(Bs + (buf * 128 + wn * 64 + i * 16 + l15) * GLD + ks * 32 + quad * 8);
      }
#pragma unroll
      for (int mi = 0; mi < 4; ++mi)
#pragma unroll
        for (int ni = 0; ni < 4; ++ni) acc[mi][ni] = __builtin_amdgcn_mfma_f32_16x16x32_bf16(bfr[ni], af[mi], acc[mi][ni], 0, 0, 0);
    }
    if (kt + 1 < nk) sstore(buf ^ 1, kt + 1);
    __syncthreads();
  }
}
DI void zero_acc(f32x4 (&acc)[4][4]) {
#pragma unroll
  for (int i = 0; i < 4; ++i)
#pragma unroll
    for (int j = 0; j < 4; ++j) acc[i][j] = (f32x4){0.f, 0.f, 0.f, 0.f};
}

DI void phase_gemm_in(const Params& p, int l, char* lds) {
  const int tid = tid_(), wave = tid >> 6, lane = tid & 63;
  const int wm = wave >> 1, wn = wave & 1, l15 = lane & 15, quad = lane >> 4;
  const bf16_t* Wt = p.wt_in + (size_t)l * NZ * 1024;
  const int NTN = 49, NTM = 132;
  for (int tile = blockIdx.x; tile < NTN * NTM; tile += gridDim.x) {
    const int mt = tile / NTN, nt = tile % NTN;
    f32x4 acc[4][4]; zero_acc(acc);
    gemm_core<false>(acc, p.hn + (size_t)mt * 128 * DM, DM, Wt + (size_t)nt * 128 * DM, DM, DM, lds);
    const int colb = nt * 128 + wn * 64 + quad * 4;
    int kind;
    if (nt < 13) kind = 0; else if (nt < 17) kind = 1; else if (nt < 21) kind = 2; else if (nt < 25) kind = 3; else if (nt < 29) kind = 4; else if (nt < 33) kind = 1; else kind = 5;
#pragma unroll
    for (int mi = 0; mi < 4; ++mi) {
      const int R = mt * 128 + wm * 64 + mi * 16 + l15;
      const bool isp = R < MP; const int rs = R - MP;
      bf16_t* zrow = p.z + (size_t)R * NZ;
      if (kind == 0) {
        const bool last = isp ? ((R & 4095) == 4095) : ((rs & 63) == 63);
        float* so = isp ? p.out + O_SP + (size_t)(l * 4 + (R >> 12)) * SHC : p.out + O_SS + (size_t)(l * 8 + (rs >> 6)) * SHC;
#pragma unroll
        for (int ni = 0; ni < 4; ++ni) {
          const int c = colb + ni * 16; const f32x4 v = acc[mi][ni];
          u32x2 o; o[0] = pk2(v[0], v[1]); o[1] = pk2(v[2], v[3]); *(u32x2*)(zrow + c) = o;
          if (last) *(f32x4*)(so + c) = v;
        }
      } else if (kind == 1 || kind == 5) {
#pragma unroll
        for (int ni = 0; ni < 4; ++ni) {
          const int c = colb + ni * 16; f32x4 v = acc[mi][ni];
#pragma unroll
          for (int e = 0; e < 4; ++e) v[e] = (kind == 1) ? siluf_(v[e]) : sigmoidf_(v[e]);
          u32x2 o; o[0] = pk2(v[0], v[1]); o[1] = pk2(v[2], v[3]); *(u32x2*)(zrow + c) = o;
        }
      } else if (kind == 2 || kind == 3) {
        float ss = 0.f;
#pragma unroll
        for (int ni = 0; ni < 4; ++ni) { const f32x4 v = acc[mi][ni]; ss += v[0] * v[0] + v[1] * v[1] + v[2] * v[2] + v[3] * v[3]; }
        ss += __shfl_xor(ss, 16); ss += __shfl_xor(ss, 32);
        const float rstd = rsqrtf(ss * (1.0f / 64.0f) + 1e-6f);
        const float* g = (kind == 2 ? p.qng : p.kng) + l * 64;
        float* ko = isp ? p.out + O_KP + ((size_t)l * MP + R) * 512 : p.out + O_KS + ((size_t)l * MS + rs) * 512;
#pragma unroll
        for (int ni = 0; ni < 4; ++ni) {
          const int c = colb + ni * 16; const int d = ni * 16 + quad * 4;
          const f32x4 gv = *(const f32x4*)(g + d); f32x4 v = acc[mi][ni];
#pragma unroll
          for (int e = 0; e < 4; ++e) v[e] = v[e] * rstd * gv[e];
          u32x2 o; o[0] = pk2(v[0], v[1]); o[1] = pk2(v[2], v[3]); *(u32x2*)(zrow + c) = o;
          if (kind == 3) *(f32x4*)(ko + (c - C_K)) = v;
        }
      } else {
        float* vo = isp ? p.out + O_VP + ((size_t)l * MP + R) * 512 : p.out + O_VS + ((size_t)l * MS + rs) * 512;
#pragma unroll
        for (int ni = 0; ni < 4; ++ni) {
          const int cv = colb + ni * 16 - C_V; const f32x4 v = acc[mi][ni];
          *(f32x4*)(vo + cv) = v;
          const int h = cv >> 7, vd = cv & 127;
          if (isp) {
            bf16_t* vt = p.vtp + ((size_t)(((R >> 12) * 4 + h) * 128 + vd)) * 4096 + (R & 4095);
#pragma unroll
            for (int e = 0; e < 4; ++e) vt[(size_t)e * 4096] = (bf16_t)(pk2(v[e], 0.f) & 0xffff);
          } else {
            bf16_t* vt = p.vts + ((size_t)(((rs >> 6) * 4 + h) * 128 + vd)) * 64 + (rs & 63);
#pragma unroll
            for (int e = 0; e < 4; ++e) vt[(size_t)e * 64] = (bf16_t)(pk2(v[e], 0.f) & 0xffff);
          }
        }
      }
    }
  }
}

constexpr int SB = 32;
DI void scan_item(const Params& p, int l, int item, char* lds) {
  const int tid = tid_(), wave = tid >> 6, lane = tid & 63, l15 = lane & 15, quad = lane >> 4;
  const bool isp = item < 32;
  const int bh = isp ? item : item - 32; const int b = bh >> 3, h = bh & 7;
  const int T = isp ? 4096 : 64; const int row0 = isp ? b * 4096 : MP + b * 64;
  float* s_r = (float*)lds;
  float* s_kf = s_r + SB * 64;
  float* s_v = s_kf + SB * 64;
  float* s_w = s_v + SB * 64;
  float* s_kk = s_w + SB * 64;
  float* s_bb = s_kk + SB * 64;
  float* s_o = s_bb + SB * 64;
  float* s_bonus = s_o + SB * 64;
  bf16_t* s_wd = (bf16_t*)(s_bonus + SB);
  bf16_t* s_ad = s_wd + SB * 72;
  const int sv = tid >> 2, kq = tid & 3;
  float S[16];
  if (isp) {
#pragma unroll
    for (int j = 0; j < 16; ++j) S[j] = 0.f;
  } else {
    const float* sp = p.swkv + (((size_t)(l * 8 + b) * 8 + h) * 64 + sv) * 64 + kq * 16;
#pragma unroll
    for (int j = 0; j < 16; j += 4) { f32x4 v = *(const f32x4*)(sp + j); S[j] = v[0]; S[j + 1] = v[1]; S[j + 2] = v[2]; S[j + 3] = v[3]; }
  }
  const int mat = wave >> 1, tt = wave & 1;
  const bf16_t* wl = (mat == 0 ? p.w2t : p.a2t) + (size_t)l * 512 * 64 + (size_t)(h * 64) * 64;
  const float* mu = p.shift_mu + l * SHC;
  const float* w0 = p.decay_w0 + l * 512 + h * 64;
  const float* a0 = p.iclr_a0 + l * 512 + h * 64;
  const float* kkp = p.k_k + l * 512 + h * 64;
  const float* kap = p.k_a + l * 512 + h * 64;
  const float* rkp = p.r_k + l * 512 + h * 64;
  const float* lg = p.lnx_g + l * 512 + h * 64;
  const float* lb = p.lnx_b + l * 512 + h * 64;
  const int ptok = tid >> 3, pcs = (tid & 7) * 8;

  for (int t0 = 0; t0 < T; t0 += SB) {
    {
      const int t = t0 + ptok; const size_t row = (size_t)(row0 + t);
#pragma unroll
      for (int g = 0; g < 5; ++g) {
        const int zc = (g < 3 ? g * 512 + h * 64 : 1536 + (g - 3) * 64) + pcs;
        const u32x4 cu = *(const u32x4*)(p.z + row * NZ + zc);
        float cur[8], prv[8];
#pragma unroll
        for (int e = 0; e < 4; ++e) { cur[2 * e] = bf_lo(cu[e]); cur[2 * e + 1] = bf_hi(cu[e]); }
        if (t > 0) {
          const u32x4 pu = *(const u32x4*)(p.z + (row - 1) * NZ + zc);
#pragma unroll
          for (int e = 0; e < 4; ++e) { prv[2 * e] = bf_lo(pu[e]); prv[2 * e + 1] = bf_hi(pu[e]); }
        } else if (isp) {
#pragma unroll
          for (int e = 0; e < 8; ++e) prv[e] = 0.f;
        } else {
          const float* sp = p.sshift + (size_t)(l * 8 + b) * SHC + zc;
#pragma unroll
          for (int e = 0; e < 8; ++e) prv[e] = sp[e];
        }
        float zs[8];
#pragma unroll
        for (int e = 0; e < 8; ++e) zs[e] = cur[e] + (prv[e] - cur[e]) * mu[zc + e];
        if (g < 3) {
          float* d = (g == 0 ? s_r : g == 1 ? s_kf : s_v) + ptok * 64 + pcs;
          *(f32x4*)d = (f32x4){zs[0], zs[1], zs[2], zs[3]}; *(f32x4*)(d + 4) = (f32x4){zs[4], zs[5], zs[6], zs[7]};
        } else {
          if (g == 3) {
#pragma unroll
            for (int e = 0; e < 8; ++e) { const float ex = __expf(2.f * zs[e]); zs[e] = 1.f - 2.f / (ex + 1.f); }
          }
          u32x4 o; o[0] = pk2(zs[0], zs[1]); o[1] = pk2(zs[2], zs[3]); o[2] = pk2(zs[4], zs[5]); o[3] = pk2(zs[6], zs[7]);
          *(u32x4*)((g == 3 ? s_wd : s_ad) + ptok * 72 + pcs) = o;
        }
      }
    }
    __syncthreads();
    {
      const bf16_t* At = (mat == 0 ? s_wd : s_ad);
      bf16x8 af[2];
#pragma unroll
      for (int ks = 0; ks < 2; ++ks) af[ks] = *(const bf16x8*)(At + (tt * 16 + l15) * 72 + ks * 32 + quad * 8);
#pragma unroll
      for (int ct = 0; ct < 4; ++ct) {
        f32x4 d = (f32x4){0.f, 0.f, 0.f, 0.f};
#pragma unroll
        for (int ks = 0; ks < 2; ++ks) {
          const bf16x8 wfr = *(const bf16x8*)(wl + (size_t)(ct * 16 + l15) * 64 + ks * 32 + quad * 8);
          d = __builtin_amdgcn_mfma_f32_16x16x32_bf16(wfr, af[ks], d, 0, 0, 0);
        }
        const int ch = ct * 16 + quad * 4; const int tok = tt * 16 + l15;
        f32x4 o;
        if (mat == 0) {
#pragma unroll
          for (int e = 0; e < 4; ++e) {
            const float val = w0[ch + e] + d[e];
            const float y = -val;
            const float sp = fmaxf(y, 0.f) + log1pf(__expf(-fabsf(y)));
            const float wlog = -sp - 0.5f;
            o[e] = __expf(-__expf(wlog));
          }
          *(f32x4*)(s_w + tok * 64 + ch) = o;
        } else {
#pragma unroll
          for (int e = 0; e < 4; ++e) o[e] = sigmoidf_(a0[ch + e] + d[e]);
          *(f32x4*)(s_bb + tok * 64 + ch) = o;
        }
      }
    }
    __syncthreads();
    {
      float k_[8], a_[8], r_[8];
      *(f32x4*)&k_[0] = *(const f32x4*)(s_kf + ptok * 64 + pcs); *(f32x4*)&k_[4] = *(const f32x4*)(s_kf + ptok * 64 + pcs + 4);
      *(f32x4*)&a_[0] = *(const f32x4*)(s_bb + ptok * 64 + pcs); *(f32x4*)&a_[4] = *(const f32x4*)(s_bb + ptok * 64 + pcs + 4);
      *(f32x4*)&r_[0] = *(const f32x4*)(s_r + ptok * 64 + pcs); *(f32x4*)&r_[4] = *(const f32x4*)(s_r + ptok * 64 + pcs + 4);
      float kk[8], ss = 0.f, bon = 0.f, kf[8];
#pragma unroll
      for (int e = 0; e < 8; ++e) {
        kk[e] = k_[e] * kkp[pcs + e]; ss += kk[e] * kk[e];
        kf[e] = k_[e] * (1.f + (a_[e] - 1.f) * kap[pcs + e]);
        bon += r_[e] * kf[e] * rkp[pcs + e];
      }
      ss += __shfl_xor(ss, 1); ss += __shfl_xor(ss, 2); ss += __shfl_xor(ss, 4);
      bon += __shfl_xor(bon, 1); bon += __shfl_xor(bon, 2); bon += __shfl_xor(bon, 4);
      const float inv = 1.0f / fmaxf(sqrtf(ss), 1e-12f);
      float bbv[8];
#pragma unroll
      for (int e = 0; e < 8; ++e) { kk[e] *= inv; bbv[e] = kk[e] * a_[e]; }
      *(f32x4*)(s_kf + ptok * 64 + pcs) = (f32x4){kf[0], kf[1], kf[2], kf[3]}; *(f32x4*)(s_kf + ptok * 64 + pcs + 4) = (f32x4){kf[4], kf[5], kf[6], kf[7]};
      *(f32x4*)(s_kk + ptok * 64 + pcs) = (f32x4){kk[0], kk[1], kk[2], kk[3]}; *(f32x4*)(s_kk + ptok * 64 + pcs + 4) = (f32x4){kk[4], kk[5], kk[6], kk[7]};
      *(f32x4*)(s_bb + ptok * 64 + pcs) = (f32x4){bbv[0], bbv[1], bbv[2], bbv[3]}; *(f32x4*)(s_bb + ptok * 64 + pcs + 4) = (f32x4){bbv[4], bbv[5], bbv[6], bbv[7]};
      if ((tid & 7) == 0) s_bonus[ptok] = bon;
    }
    __syncthreads();
    for (int t = 0; t < SB; ++t) {
      const int o = t * 64 + kq * 16;
      float w_[16], kk_[16], bb_[16], kf_[16], r_[16];
#pragma unroll
      for (int j = 0; j < 16; j += 4) {
        *(f32x4*)&w_[j] = *(const f32x4*)(s_w + o + j); *(f32x4*)&kk_[j] = *(const f32x4*)(s_kk + o + j);
        *(f32x4*)&bb_[j] = *(const f32x4*)(s_bb + o + j); *(f32x4*)&kf_[j] = *(const f32x4*)(s_kf + o + j);
        *(f32x4*)&r_[j] = *(const f32x4*)(s_r + o + j);
      }
      const float vv = s_v[t * 64 + sv];
      float sa = 0.f;
#pragma unroll
      for (int j = 0; j < 16; ++j) sa += S[j] * kk_[j];
      sa += __shfl_xor(sa, 1); sa += __shfl_xor(sa, 2);
      float oo = 0.f;
#pragma unroll
      for (int j = 0; j < 16; ++j) { S[j] = S[j] * w_[j] + (vv * kf_[j] - sa * bb_[j]); oo += S[j] * r_[j]; }
      oo += __shfl_xor(oo, 1); oo += __shfl_xor(oo, 2);
      if (kq == 0) s_o[t * 64 + sv] = oo;
    }
    __syncthreads();
    {
      float o_[8];
      *(f32x4*)&o_[0] = *(const f32x4*)(s_o + ptok * 64 + pcs); *(f32x4*)&o_[4] = *(const f32x4*)(s_o + ptok * 64 + pcs + 4);
      float sm = 0.f;
#pragma unroll
      for (int e = 0; e < 8; ++e) sm += o_[e];
      sm += __shfl_xor(sm, 1); sm += __shfl_xor(sm, 2); sm += __shfl_xor(sm, 4);
      const float mean = sm * (1.0f / 64.0f);
      float vr = 0.f;
#pragma unroll
      for (int e = 0; e < 8; ++e) { const float d = o_[e] - mean; vr += d * d; }
      vr += __shfl_xor(vr, 1); vr += __shfl_xor(vr, 2); vr += __shfl_xor(vr, 4);
      const float rstd = rsqrtf(vr * (1.0f / 64.0f) + 64e-5f);
      const float bon = s_bonus[ptok];
      const size_t row = (size_t)(row0 + t0 + ptok);
      const u32x4 gu = *(const u32x4*)(p.z + row * NZ + C_GR + h * 64 + pcs);
      float gt[8];
#pragma unroll
      for (int e = 0; e < 4; ++e) { gt[2 * e] = bf_lo(gu[e]); gt[2 * e + 1] = bf_hi(gu[e]); }
      float y[8];
#pragma unroll
      for (int e = 0; e < 8; ++e) {
        const float yn = (o_[e] - mean) * rstd * lg[pcs + e] + lb[pcs + e] + bon * s_v[ptok * 64 + pcs + e];
        y[e] = yn * gt[e];
      }
      u32x4 ov; ov[0] = pk2(y[0], y[1]); ov[1] = pk2(y[2], y[3]); ov[2] = pk2(y[4], y[5]); ov[3] = pk2(y[6], y[7]);
      *(u32x4*)(p.o_r + row * 512 + h * 64 + pcs) = ov;
    }
    __syncthreads();
  }
  float* so = (isp ? p.out + O_WP + (((size_t)(l * 4 + b) * 8 + h) * 64 + sv) * 64 : p.out + O_WS + (((size_t)(l * 8 + b) * 8 + h) * 64 + sv) * 64) + kq * 16;
#pragma unroll
  for (int j = 0; j < 16; j += 4) *(f32x4*)(so + j) = (f32x4){S[j], S[j + 1], S[j + 2], S[j + 3]};
}

constexpr int ALD = 72;
DI void attn_item(const Params& p, int l, int item, char* lds) {
  const int tid = tid_(), wave = tid >> 6, lane = tid & 63;
  const int m = wave & 1, qh = wave >> 1, q = lane & 31, hh = lane >> 5;
  bf16_t* Ks = (bf16_t*)lds;
  bf16_t* Vs = Ks + 2 * 64 * ALD;
  float* xb = (float*)lds;
  bool samp; int b, h, nch, qrow0, qpos0;
  if (item < 32) { samp = true; b = item >> 2; h = item & 3; nch = 17; qrow0 = MP + b * 64; qpos0 = 1024; }
  else { samp = false; const int a = item - 32; const int qc = 63 - (a >> 4); const int bh = a & 15; b = bh >> 2; h = bh & 3; nch = qc + 1; qrow0 = b * 4096 + qc * 64; qpos0 = qc * 64; }
  bf16x8 qf[4];
  {
    const bf16_t* qp = p.z + (size_t)(qrow0 + qh * 32 + q) * NZ + C_Q + h * 128 + m * 64;
#pragma unroll
    for (int ks = 0; ks < 4; ++ks) qf[ks] = *(const bf16x8*)(qp + ks * 16 + hh * 8);
  }
  const float slope = exp2f(-2.0f * (float)(h + 1));
  const float LOG2E = 1.4426950408889634f;
  const float c1 = 0.125f * LOG2E, sl2 = slope * LOG2E;
  const float qposf = (float)(qpos0 + qh * 32 + q);
  f32x16 O[4];
#pragma unroll
  for (int i = 0; i < 4; ++i)
#pragma unroll
    for (int e = 0; e < 16; ++e) O[i][e] = 0.f;
  float mrun = -1e30f, lrun = 0.f;
  u32x4 rk[4], rv[4];
  auto gload = [&](int j) {
    const bf16_t* kb; size_t kld; const bf16_t* vb; size_t vld;
    if (!samp) { kb = p.z + (size_t)(b * 4096 + j * 64) * NZ + C_K + h * 128; kld = NZ; vb = p.vtp + (size_t)((b * 4 + h) * 128) * 4096 + j * 64; vld = 4096; }
    else if (j < 16) { kb = p.kc + (size_t)(b * 1024 + j * 64) * 512 + h * 128; kld = 512; vb = p.vct + (size_t)((b * 4 + h) * 128) * 1024 + j * 64; vld = 1024; }
    else { kb = p.z + (size_t)(MP + b * 64) * NZ + C_K + h * 128; kld = NZ; vb = p.vts + (size_t)((b * 4 + h) * 128) * 64; vld = 64; }
#pragma unroll
    for (int i = 0; i < 4; ++i) {
      const int c = tid + 256 * i;
      const int mm = c >> 9, key = (c >> 3) & 63, d8 = (c & 7) * 8;
      rk[i] = *(const u32x4*)(kb + (size_t)key * kld + mm * 64 + d8);
      const int vd = c >> 3, k8 = (c & 7) * 8;
      rv[i] = *(const u32x4*)(vb + (size_t)vd * vld + k8);
    }
  };
  auto sstore = [&]() {
#pragma unroll
    for (int i = 0; i < 4; ++i) {
      const int c = tid + 256 * i;
      const int mm = c >> 9, key = (c >> 3) & 63, d8 = (c & 7) * 8;
      *(u32x4*)(Ks + (mm * 64 + key) * ALD + d8) = rk[i];
      const int vd = c >> 3, k8 = (c & 7) * 8;
      *(u32x4*)(Vs + vd * ALD + k8) = rv[i];
    }
  };
  gload(0); sstore(); __syncthreads();
  for (int j = 0; j < nch; ++j) {
    if (j + 1 < nch) gload(j + 1);
    f32x16 s[2];
#pragma unroll
    for (int kt = 0; kt < 2; ++kt) {
#pragma unroll
      for (int e = 0; e < 16; ++e) s[kt][e] = 0.f;
#pragma unroll
      for (int ks = 0; ks < 4; ++ks) {
        const bf16x8 kf = *(const bf16x8*)(Ks + (m * 64 + kt * 32 + q) * ALD + ks * 16 + hh * 8);
        s[kt] = __builtin_amdgcn_mfma_f32_32x32x16_bf16(kf, qf[ks], s[kt], 0, 0, 0);
      }
    }
    float mx = -1e30f;
#pragma unroll
    for (int kt = 0; kt < 2; ++kt)
#pragma unroll
      for (int e = 0; e < 16; ++e) {
        const float kpos = (float)(j * 64 + kt * 32 + (e & 3) + 8 * (e >> 2) + 4 * hh);
        const float v = s[kt][e] * c1 - sl2 * fabsf(qposf - kpos);
        s[kt][e] = v; mx = fmaxf(mx, v);
      }
    mx = fmaxf(mx, __shfl_xor(mx, 32));
    const float mnew = fmaxf(mrun, mx);
    const float alpha = exp2f(mrun - mnew);
    mrun = mnew;
    float ps = 0.f;
#pragma unroll
    for (int kt = 0; kt < 2; ++kt)
#pragma unroll
      for (int e = 0; e < 16; ++e) { const float pe = exp2f(s[kt][e] - mnew); s[kt][e] = pe; ps += pe; }
    lrun = lrun * alpha + ps;
#pragma unroll
    for (int i = 0; i < 4; ++i)
#pragma unroll
      for (int e = 0; e < 16; ++e) O[i][e] *= alpha;
#pragma unroll
    for (int kt = 0; kt < 2; ++kt)
#pragma unroll
      for (int sx = 0; sx < 2; ++sx) {
        u32x4 pb;
        pb[0] = pk2(s[kt][8 * sx + 0], s[kt][8 * sx + 1]); pb[1] = pk2(s[kt][8 * sx + 2], s[kt][8 * sx + 3]);
        pb[2] = pk2(s[kt][8 * sx + 4], s[kt][8 * sx + 5]); pb[3] = pk2(s[kt][8 * sx + 6], s[kt][8 * sx + 7]);
        const bf16x8 pf = __builtin_bit_cast(bf16x8, pb);
#pragma unroll
        for (int vt = 0; vt < 4; ++vt) {
          const bf16_t* vp = Vs + (vt * 32 + q) * ALD + kt * 32 + 16 * sx + 4 * hh;
          const s16x4 lo = *(const s16x4*)vp, hi = *(const s16x4*)(vp + 8);
          const bf16x8 vf = __builtin_shufflevector(lo, hi, 0, 1, 2, 3, 4, 5, 6, 7);
          O[vt] = __builtin_amdgcn_mfma_f32_32x32x16_bf16(vf, pf, O[vt], 0, 0, 0);
        }
      }
    __syncthreads();
    if (j + 1 < nch) sstore();
    __syncthreads();
  }
  const float ltot = lrun + __shfl_xor(lrun, 32);
  const float inv = 1.0f / ltot;
#pragma unroll
  for (int i = 0; i < 4; ++i)
#pragma unroll
    for (int e = 0; e < 16; ++e) O[i][e] *= inv;
  if (m == 1) {
#pragma unroll
    for (int vt = 0; vt < 4; ++vt)
#pragma unroll
      for (int e = 0; e < 16; ++e) { const int vd = vt * 32 + (e & 3) + 8 * (e >> 2) + 4 * hh; xb[(qh * 128 + vd) * 32 + q] = O[vt][e]; }
  }
  __syncthreads();
  if (m == 0) {
    float d1 = 0.f, d2 = 0.f;
    for (int i = 0; i < 64; ++i) { d1 += p.lq1[l * 64 + i] * p.lk1[l * 64 + i]; d2 += p.lq2[l * 64 + i] * p.lk2[l * 64 + i]; }
    const float lam_init = 0.8f - 0.6f * __expf(-0.3f * (float)l);
    const float lam = __expf(d1) - __expf(d2) + lam_init;
    float ss = 0.f;
#pragma unroll
    for (int vt = 0; vt < 4; ++vt)
#pragma unroll
      for (int e = 0; e < 16; ++e) {
        const int vd = vt * 32 + (e & 3) + 8 * (e >> 2) + 4 * hh;
        const float o2 = xb[(qh * 128 + vd) * 32 + q];
        const float o = O[vt][e] - lam * o2; O[vt][e] = o; ss += o * o;
      }
    ss += __shfl_xor(ss, 32);
    const float rstd = rsqrtf(ss * (1.0f / 128.0f) + 1e-5f) * (1.0f - lam_init);
    const size_t row = (size_t)(qrow0 + qh * 32 + q);
    const float* sg = p.subln_g + l * 128;
#pragma unroll
    for (int vt = 0; vt < 4; ++vt)
#pragma unroll
      for (int e4 = 0; e4 < 4; ++e4) {
        const int vd = vt * 32 + 8 * e4 + 4 * hh;
        const u32x2 gu = *(const u32x2*)(p.z + row * NZ + C_GA + h * 128 + vd);
        const f32x4 gv = *(const f32x4*)(sg + vd);
        const float y0 = O[vt][4 * e4 + 0] * rstd * gv[0] * bf_lo(gu[0]);
        const float y1 = O[vt][4 * e4 + 1] * rstd * gv[1] * bf_hi(gu[0]);
        const float y2 = O[vt][4 * e4 + 2] * rstd * gv[2] * bf_lo(gu[1]);
        const float y3 = O[vt][4 * e4 + 3] * rstd * gv[3] * bf_hi(gu[1]);
        u32x2 ov; ov[0] = pk2(y0, y1); ov[1] = pk2(y2, y3);
        *(u32x2*)(p.o_a + row * 512 + h * 128 + vd) = ov;
      }
  }
  __syncthreads();
}

DI void phase_mix(const Params& p, int l, char* lds) {
  const int n_scan = 96, n_attn = 32 + 1024;
  for (int it = blockIdx.x; it < n_scan + n_attn; it += gridDim.x) {
    if (it < n_scan) scan_item(p, l, it, lds); else attn_item(p, l, it - n_scan, lds);
  }
}

DI void phase_merge(const Params& p, int l, char* lds) {
  const int tid = tid_(), wave = tid >> 6, lane = tid & 63;
  const int wm = wave >> 1, wn = wave & 1, l15 = lane & 15, quad = lane >> 4;
  for (int tile = blockIdx.x; tile < 132 * 8; tile += gridDim.x) {
    const int mt = tile >> 3, nt = tile & 7;
    f32x4 a1[4][4]; zero_acc(a1);
    gemm_core<false>(a1, p.o_r + (size_t)mt * 128 * 512, 512, p.wt_brr + (size_t)l * 1024 * 512 + (size_t)nt * 128 * 512, 512, 512, lds);
    u32x2 pk[4][4];
#pragma unroll
    for (int mi = 0; mi < 4; ++mi) {
      const int R = mt * 128 + wm * 64 + mi * 16 + l15;
#pragma unroll
      for (int ni = 0; ni < 4; ++ni) {
        const int c = nt * 128 + wn * 64 + ni * 16 + quad * 4;
        const u32x2 g1 = *(const u32x2*)(p.z + (size_t)R * NZ + C_MR + c);
        const f32x4 v1 = a1[mi][ni];
        pk[mi][ni][0] = pk2(bf_lo(g1[0]) * v1[0], bf_hi(g1[0]) * v1[1]);
        pk[mi][ni][1] = pk2(bf_lo(g1[1]) * v1[2], bf_hi(g1[1]) * v1[3]);
      }
    }
    zero_acc(a1);
    gemm_core<false>(a1, p.o_a + (size_t)mt * 128 * 512, 512, p.wt_bra + (size_t)l * 1024 * 512 + (size_t)nt * 128 * 512, 512, 512, lds);
#pragma unroll
    for (int mi = 0; mi < 4; ++mi) {
      const int R = mt * 128 + wm * 64 + mi * 16 + l15;
#pragma unroll
      for (int ni = 0; ni < 4; ++ni) {
        const int c = nt * 128 + wn * 64 + ni * 16 + quad * 4;
        const u32x2 g2 = *(const u32x2*)(p.z + (size_t)R * NZ + C_MA + c);
        const f32x4 v2 = a1[mi][ni]; const u32x2 u1 = pk[mi][ni];
        u32x2 o;
        o[0] = pk2(bf_lo(u1[0]) + bf_lo(g2[0]) * v2[0], bf_hi(u1[0]) + bf_hi(g2[0]) * v2[1]);
        o[1] = pk2(bf_lo(u1[1]) + bf_lo(g2[1]) * v2[2], bf_hi(u1[1]) + bf_hi(g2[1]) * v2[3]);
        *(u32x2*)(p.hn + (size_t)R * DM + c) = o;
      }
    }
  }
}
DI void phase_out(const Params& p, int l, char* lds) {
  const int tid = tid_(), wave = tid >> 6, lane = tid & 63;
  const int wm = wave >> 1, wn = wave & 1, l15 = lane & 15, quad = lane >> 4;
  for (int tile = blockIdx.x; tile < 132 * 8; tile += gridDim.x) {
    const int mt = tile >> 3, nt = tile & 7;
    f32x4 acc[4][4]; zero_acc(acc);
    gemm_core<false>(acc, p.hn + (size_t)mt * 128 * DM, DM, p.wt_out + (size_t)l * 1024 * 1024 + (size_t)nt * 128 * DM, DM, DM, lds);
#pragma unroll
    for (int mi = 0; mi < 4; ++mi) {
      const int R = mt * 128 + wm * 64 + mi * 16 + l15;
      const float* xr = x_row(p, l, R);
#pragma unroll
      for (int ni = 0; ni < 4; ++ni) {
        const int c = nt * 128 + wn * 64 + ni * 16 + quad * 4;
        const f32x4 xv = *(const f32x4*)(xr + c);
        *(f32x4*)(p.out + (size_t)R * DM + c) = xv + acc[mi][ni];
      }
    }
  }
}
DI void phase_ple(const Params& p, int l, char* lds) {
  const int tid = tid_(), wave = tid >> 6, lane = tid & 63;
  const int wm = wave >> 1, wn = wave & 1, l15 = lane & 15, quad = lane >> 4;
  for (int tile = blockIdx.x; tile < 132 * 8; tile += gridDim.x) {
    const int mt = tile >> 3, nt = tile & 7;
    f32x4 a1[4][4]; zero_acc(a1);
    gemm_core<false>(a1, p.hn + (size_t)mt * 128 * DM, DM, p.wt_gate + (size_t)l * 1024 * 1024 + (size_t)nt * 128 * DM, DM, DM, lds);
    u32x2 pk[4][4];
#pragma unroll
    for (int mi = 0; mi < 4; ++mi)
#pragma unroll
      for (int ni = 0; ni < 4; ++ni) { const f32x4 v = a1[mi][ni]; pk[mi][ni][0] = pk2(sigmoidf_(v[0]), sigmoidf_(v[1])); pk[mi][ni][1] = pk2(sigmoidf_(v[2]), sigmoidf_(v[3])); }
    zero_acc(a1);
    const int r0 = mt * 128;
    const float* pa = r0 < MP ? p.pp + ((size_t)l * MP + r0) * 256 : p.ps + ((size_t)l * MS + (r0 - MP)) * 256;
    gemm_core<true>(a1, pa, 256, p.wt_ple + (size_t)l * 1024 * 256 + (size_t)nt * 128 * 256, 256, 256, lds);
#pragma unroll
    for (int mi = 0; mi < 4; ++mi) {
      const int R = mt * 128 + wm * 64 + mi * 16 + l15;
#pragma unroll
      for (int ni = 0; ni < 4; ++ni) {
        const int c = nt * 128 + wn * 64 + ni * 16 + quad * 4;
        float* xo = p.out + (size_t)R * DM + c;
        const f32x4 xv = *(const f32x4*)xo; const f32x4 e = a1[mi][ni]; const u32x2 g = pk[mi][ni];
        f32x4 o;
        o[0] = xv[0] + e[0] * bf_lo(g[0]); o[1] = xv[1] + e[1] * bf_hi(g[0]);
        o[2] = xv[2] + e[2] * bf_lo(g[1]); o[3] = xv[3] + e[3] * bf_hi(g[1]);
        *(f32x4*)xo = o;
      }
    }
  }
}

constexpr int LDS_BYTES = 73728;
DI void run_phase(const Params& p, int ph, int l, char* lds) {
  switch (ph) {
    case 0: phase_wconv(p, lds); break;
    case 1: phase_norm(p, l, true, lds); break;
    case 2: phase_gemm_in(p, l, lds); break;
    case 3: phase_mix(p, l, lds); break;
    case 4: phase_merge(p, l, lds); break;
    case 5: phase_out(p, l, lds); break;
    case 6: phase_norm(p, l, false, lds); break;
    case 7: phase_ple(p, l, lds); break;
  }
}

#if MEGA
__global__ void __launch_bounds__(256, 2) k_mega(Params p) {
  __shared__ __attribute__((aligned(16))) char lds[LDS_BYTES];
  cg::grid_group grid = cg::this_grid();
  phase_wconv(p, lds);
  grid.sync();
#pragma unroll 1
  for (int l = 0; l < NL; ++l) {
    phase_norm(p, l, true, lds); grid.sync();
    phase_gemm_in(p, l, lds); grid.sync();
    phase_mix(p, l, lds); grid.sync();
    phase_merge(p, l, lds); grid.sync();
    phase_out(p, l, lds); grid.sync();
    phase_norm(p, l, false, lds); grid.sync();
    phase_ple(p, l, lds); if (l + 1 < NL) grid.sync();
  }
}
#else
template <int PH>
__global__ void __launch_bounds__(256, 2) k_phase(Params p, int l) {
  __shared__ __attribute__((aligned(16))) char lds[LDS_BYTES];
  run_phase(p, PH, l, lds);
}
#endif

extern "C" void kernel_launch(void* const* d_in, const int* in_sizes, int n_in, void* d_out, int out_size, void* d_ws, size_t ws_size,
                              hipStream_t stream) {
  Params p{};
  const float** pf = (const float**)&p;
  for (int i = 0; i < 33; ++i) pf[i] = (const float*)d_in[i];
  p.out = (float*)d_out;
  char* w = (char*)d_ws; size_t off = 0;
  auto take = [&](size_t bytes) { char* r = w + off; off += (bytes + 255) & ~(size_t)255; return (bf16_t*)r; };
  p.wt_in = take((size_t)NL * NZ * 1024 * 2);
  p.wt_brr = take((size_t)NL * 1024 * 512 * 2);
  p.wt_bra = take((size_t)NL * 1024 * 512 * 2);
  p.wt_out = take((size_t)NL * 1024 * 1024 * 2);
  p.wt_ple = take((size_t)NL * 1024 * 256 * 2);
  p.wt_gate = take((size_t)NL * 1024 * 1024 * 2);
  p.w2t = take((size_t)NL * 512 * 64 * 2);
  p.a2t = take((size_t)NL * 512 * 64 * 2);
  p.hn = take((size_t)MT * DM * 2);
  p.z = take((size_t)MT * NZ * 2);
  p.vtp = take((size_t)16 * 128 * 4096 * 2);
  p.vts = take((size_t)32 * 128 * 64 * 2);
  p.kc = take((size_t)8 * 1024 * 512 * 2);
  p.vct = take((size_t)32 * 128 * 1024 * 2);
  p.o_r = take((size_t)MT * 512 * 2);
  p.o_a = take((size_t)MT * 512 * 2);
  if (off > ws_size) { fprintf(stderr, "workspace too small: need %zu have %zu\n", off, ws_size); return; }
#if MEGA
  static int grid_blocks = 0;
  if (!grid_blocks) {
    int dev = 0, cus = 0, per_cu = 0;
    hipGetDevice(&dev);
    hipDeviceGetAttribute(&cus, hipDeviceAttributeMultiprocessorCount, dev);
    hipOccupancyMaxActiveBlocksPerMultiprocessor(&per_cu, k_mega, 256, 0);
    if (per_cu > 2) per_cu = 2;
    grid_blocks = cus * per_cu;
  }
  void* args[] = {&p};
  hipError_t e = hipLaunchCooperativeKernel((void*)k_mega, dim3(grid_blocks), dim3(256), args, 0, stream);
  if (e != hipSuccess) fprintf(stderr, "cooperative launch failed: %s (grid %d)\n", hipGetErrorString(e), grid_blocks);
#else
  const int G = 512;
  k_phase<0><<<G, 256, 0, stream>>>(p, 0);
  for (int l = 0; l < NL; ++l) {
    k_phase<1><<<G, 256, 0, stream>>>(p, l);
    k_phase<2><<<G, 256, 0, stream>>>(p, l);
    k_phase<3><<<G, 256, 0, stream>>>(p, l);
    k_phase<4><<<G, 256, 0, stream>>>(p, l);
    k_phase<5><<<G, 256, 0, stream>>>(p, l);
    k_phase<6><<<G, 256, 0, stream>>>(p, l);
    k_phase<7><<<G, 256, 0, stream>>>(p, l);
  }
#endif
}
```

```cpp
#include <hip/hip_runtime.h>
#include <hip/hip_cooperative_groups.h>
#include <stdint.h>
#include <stdio.h>
namespace cg = cooperative_groups;

#ifndef MEGA
#define MEGA 1
#endif

typedef unsigned short bf16_t;
typedef short bf16x8 __attribute__((ext_vector_type(8)));
typedef short s16x4 __attribute__((ext_vector_type(4)));
typedef float f32x4 __attribute__((ext_vector_type(4)));
typedef float f32x2 __attribute__((ext_vector_type(2)));
typedef float f32x16 __attribute__((ext_vector_type(16)));
typedef unsigned u32x4 __attribute__((ext_vector_type(4)));
typedef unsigned u32x2 __attribute__((ext_vector_type(2)));
typedef __bf16 bfv2 __attribute__((ext_vector_type(2)));

#define DI __device__ __forceinline__
DI int tid_() { int t = threadIdx.x; asm volatile("" : "+v"(t)); return t; }

constexpr int DM = 1024, MP = 16384, MS = 512, MT = 16896, NZ = 6272, NL = 4;
constexpr int C_GR = 1664, C_Q = 2176, C_K = 2688, C_V = 3200, C_GA = 3712, C_MR = 4224, C_MA = 5248;
constexpr int SHC = 1664;
constexpr size_t O_YP = 0, O_YS = 16777216, O_KP = 17301504, O_VP = 50855936, O_WP = 84410368, O_SP = 84934656,
                 O_KS = 84961280, O_VS = 86009856, O_WS = 87058432, O_SS = 88107008;

struct Params {
  const float *xp, *xs, *pp, *ps, *ck, *cv, *swkv, *sshift;
  const float *norm_g, *w_in, *shift_mu, *decay_w0, *decay_w2, *iclr_a0, *iclr_a2, *k_k, *k_a, *r_k, *lnx_g, *lnx_b,
      *qng, *kng, *lq1, *lk1, *lq2, *lk2, *subln_g, *w_br_r, *w_br_a, *w_out, *ple_w, *ple_gate_w, *ple_norm_g;
  float* out;
  bf16_t *wt_in, *wt_brr, *wt_bra, *wt_out, *wt_ple, *wt_gate, *w2t, *a2t;
  bf16_t *hn, *z, *vtp, *vts, *kc, *vct, *o_r, *o_a;
  bf16_t *cPT, *cG, *cRT, *cOI, *cBA;
};

DI unsigned pk2(float a, float b) { f32x2 v = {a, b}; bfv2 r = __builtin_convertvector(v, bfv2); return __builtin_bit_cast(unsigned, r); }
DI float bf_lo(unsigned u) { return __uint_as_float(u << 16); }
DI float bf_hi(unsigned u) { return __uint_as_float(u & 0xffff0000u); }
DI float bf1(bf16_t u) { return __uint_as_float(((unsigned)u) << 16); }
DI float sigmoidf_(float x) { return 1.0f / (1.0f + __expf(-x)); }
DI float siluf_(float x) { return x / (1.0f + __expf(-x)); }

DI void tr_tile(const float* __restrict__ src, int ld_src, bf16_t* __restrict__ dst, int ld_dst, float* sm) {
  const int tid = tid_();
  const int r = tid >> 4, c4 = (tid & 15) * 4;
#pragma unroll
  for (int i = 0; i < 4; ++i) {
    const int row = r + 16 * i;
    f32x4 v = *(const f32x4*)(src + (size_t)row * ld_src + c4);
    sm[row * 65 + c4 + 0] = v[0]; sm[row * 65 + c4 + 1] = v[1]; sm[row * 65 + c4 + 2] = v[2]; sm[row * 65 + c4 + 3] = v[3];
  }
  __syncthreads();
  const int n = tid >> 2, ks = (tid & 3) * 16;
  u32x4 o0, o1;
  o0[0] = pk2(sm[(ks + 0) * 65 + n], sm[(ks + 1) * 65 + n]);   o0[1] = pk2(sm[(ks + 2) * 65 + n], sm[(ks + 3) * 65 + n]);
  o0[2] = pk2(sm[(ks + 4) * 65 + n], sm[(ks + 5) * 65 + n]);   o0[3] = pk2(sm[(ks + 6) * 65 + n], sm[(ks + 7) * 65 + n]);
  o1[0] = pk2(sm[(ks + 8) * 65 + n], sm[(ks + 9) * 65 + n]);   o1[1] = pk2(sm[(ks + 10) * 65 + n], sm[(ks + 11) * 65 + n]);
  o1[2] = pk2(sm[(ks + 12) * 65 + n], sm[(ks + 13) * 65 + n]); o1[3] = pk2(sm[(ks + 14) * 65 + n], sm[(ks + 15) * 65 + n]);
  *(u32x4*)(dst + (size_t)n * ld_dst + ks) = o0;
  *(u32x4*)(dst + (size_t)n * ld_dst + ks + 8) = o1;
  __syncthreads();
}

constexpr int WCONV_TILES = 1568 + 128 + 128 + 256 + 64 + 256 + 8 + 8;
DI void wconv_tile(const Params& p, int l, int t, float* sm) {
  const float* src; bf16_t* dst; int K, N;
  if (t < 1568) { src = p.w_in + (size_t)l * 1024 * NZ; dst = p.wt_in; K = 1024; N = NZ; }
  else if ((t -= 1568) < 128) { src = p.w_br_r + (size_t)l * 512 * 1024; dst = p.wt_brr; K = 512; N = 1024; }
  else if ((t -= 128) < 128) { src = p.w_br_a + (size_t)l * 512 * 1024; dst = p.wt_bra; K = 512; N = 1024; }
  else if ((t -= 128) < 256) { src = p.w_out + (size_t)l * 1024 * 1024; dst = p.wt_out; K = 1024; N = 1024; }
  else if ((t -= 256) < 64) { src = p.ple_w + (size_t)l * 256 * 1024; dst = p.wt_ple; K = 256; N = 1024; }
  else if ((t -= 64) < 256) { src = p.ple_gate_w + (size_t)l * 1024 * 1024; dst = p.wt_gate; K = 1024; N = 1024; }
  else if ((t -= 256) < 8) { src = p.decay_w2 + (size_t)l * 64 * 512; dst = p.w2t; K = 64; N = 512; }
  else { t -= 8; src = p.iclr_a2 + (size_t)l * 64 * 512; dst = p.a2t; K = 64; N = 512; }
  const int ntn = N / 64; const int tk = t / ntn, tn = t % ntn;
  tr_tile(src + (size_t)(tk * 64) * N + tn * 64, N, dst + (size_t)(tn * 64) * K + tk * 64, K, sm);
}

DI const float* x_row(const Params& p, int l, int r) {
  if (l == 0) return r < MP ? p.xp + (size_t)r * DM : p.xs + (size_t)(r - MP) * DM;
  return p.out + (size_t)r * DM;
}
DI void phase_norm(const Params& p, int l, bool first, char* lds) {
  const int tid = tid_(), wave = tid >> 6, lane = tid & 63;
  const float* g = (first ? p.norm_g : p.ple_norm_g) + l * DM;
  const int n_norm = MT / 4;
  const int n_items = n_norm + (first ? 2048 + WCONV_TILES : 0);
  for (int it = blockIdx.x; it < n_items; it += gridDim.x) {
    if (it < n_norm) {
      const int r = it * 4 + wave;
      const float* x = first ? x_row(p, l, r) : p.out + (size_t)r * DM;
      f32x4 v[4]; float ss = 0.f;
#pragma unroll
      for (int i = 0; i < 4; ++i) { v[i] = *(const f32x4*)(x + lane * 4 + 256 * i); ss += v[i][0] * v[i][0] + v[i][1] * v[i][1] + v[i][2] * v[i][2] + v[i][3] * v[i][3]; }
#pragma unroll
      for (int o = 32; o >= 1; o >>= 1) ss += __shfl_xor(ss, o);
      const float rstd = rsqrtf(ss * (1.0f / 1024.0f) + 1e-6f);
#pragma unroll
      for (int i = 0; i < 4; ++i) {
        const f32x4 gv = *(const f32x4*)(g + lane * 4 + 256 * i);
        u32x2 o; o[0] = pk2(v[i][0] * rstd * gv[0], v[i][1] * rstd * gv[1]); o[1] = pk2(v[i][2] * rstd * gv[2], v[i][3] * rstd * gv[3]);
        *(u32x2*)(p.hn + (size_t)r * DM + lane * 4 + 256 * i) = o;
      }
    } else if (it < n_norm + 1024) {
      const int c = it - n_norm;
      const float* src = p.ck + (size_t)l * 8 * 1024 * 512 + (size_t)c * 4096 + tid * 16;
      bf16_t* dst = p.kc + (size_t)c * 4096 + tid * 16;
      f32x4 a0 = *(const f32x4*)(src), a1 = *(const f32x4*)(src + 4), a2 = *(const f32x4*)(src + 8), a3 = *(const f32x4*)(src + 12);
      u32x4 o0, o1;
      o0[0] = pk2(a0[0], a0[1]); o0[1] = pk2(a0[2], a0[3]); o0[2] = pk2(a1[0], a1[1]); o0[3] = pk2(a1[2], a1[3]);
      o1[0] = pk2(a2[0], a2[1]); o1[1] = pk2(a2[2], a2[3]); o1[2] = pk2(a3[0], a3[1]); o1[3] = pk2(a3[2], a3[3]);
      *(u32x4*)dst = o0; *(u32x4*)(dst + 8) = o1;
    } else if (it >= n_norm + 2048) {
      wconv_tile(p, l, it - n_norm - 2048, (float*)lds);
    } else {
      const int c = it - n_norm - 1024;
      const int bh = c >> 5, tt = c & 31; const int b = bh >> 2, h = bh & 3; const int tk = tt >> 1, tn = tt & 1;
      const float* src = p.cv + (size_t)l * 8 * 1024 * 512 + ((size_t)(b * 1024 + tk * 64)) * 512 + h * 128 + tn * 64;
      bf16_t* dst = p.vct + ((size_t)(bh * 128 + tn * 64)) * 1024 + tk * 64;
      tr_tile(src, 512, dst, 1024, (float*)lds);
    }
  }
}

constexpr int GLD = 72;
template <bool A_F32>
DI void gemm_core(f32x4 (&acc)[4][4], const void* Ap, int lda, const bf16_t* Bp, int ldb, int K, char* lds) {
  bf16_t* As = (bf16_t*)lds;
  bf16_t* Bs = (bf16_t*)(lds + 2 * 128 * GLD * 2);
  const int tid = tid_(), wave = tid >> 6, lane = tid & 63;
  const int wm = wave >> 1, wn = wave & 1, l15 = lane & 15, quad = lane >> 4;
  const int nk = K / 64;
  u32x4 ra[4], rb[4];
  auto gload = [&](int kt) {
#pragma unroll
    for (int i = 0; i < 4; ++i) {
      const int c = tid + 256 * i; const int row = c >> 3, c8 = (c & 7) * 8;
      if (!A_F32) ra[i] = *(const u32x4*)((const bf16_t*)Ap + (size_t)row * lda + kt * 64 + c8);
      rb[i] = *(const u32x4*)(Bp + (size_t)row * ldb + kt * 64 + c8);
    }
  };
  auto sstore = [&](int buf, int kt) {
#pragma unroll
    for (int i = 0; i < 4; ++i) {
      const int c = tid + 256 * i; const int row = c >> 3, c8 = (c & 7) * 8;
      if (A_F32) {
        const float* a = (const float*)Ap + (size_t)row * lda + kt * 64 + c8;
        const f32x4 v0 = *(const f32x4*)a, v1 = *(const f32x4*)(a + 4);
        u32x4 t; t[0] = pk2(v0[0], v0[1]); t[1] = pk2(v0[2], v0[3]); t[2] = pk2(v1[0], v1[1]); t[3] = pk2(v1[2], v1[3]);
        *(u32x4*)(As + (buf * 128 + row) * GLD + c8) = t;
      } else {
        *(u32x4*)(As + (buf * 128 + row) * GLD + c8) = ra[i];
      }
      *(u32x4*)(Bs + (buf * 128 + row) * GLD + c8) = rb[i];
    }
  };
  gload(0); sstore(0, 0); __syncthreads();
  for (int kt = 0; kt < nk; ++kt) {
    const int buf = kt & 1;
    if (kt + 1 < nk) gload(kt + 1);
#pragma unroll
    for (int ks = 0; ks < 2; ++ks) {
      bf16x8 af[4], bfr[4];
#pragma unroll
      for (int i = 0; i < 4; ++i) {
        af[i] = *(const bf16x8*)(As + (buf * 128 + wm * 64 + i * 16 + l15) * GLD + ks * 32 + quad * 8);
        bfr[i] = *(const bf16x8*)(Bs + (buf * 128 + wn * 64 + i * 16 + l15) * GLD + ks * 32 + quad * 8);
      }
#pragma unroll
      for (int mi = 0; mi < 4; ++mi)
#pragma unroll
        for (int ni = 0; ni < 4; ++ni) acc[mi][ni] = __builtin_amdgcn_mfma_f32_16x16x32_bf16(bfr[ni], af[mi], acc[mi][ni], 0, 0, 0);
    }
    if (kt + 1 < nk) sstore(buf ^ 1, kt + 1);
    __syncthreads();
  }
}
DI void zero_acc(f32x4 (&acc)[4][4]) {
#pragma unroll
  for (int i = 0; i < 4; ++i)
#pragma unroll
    for (int j = 0; j < 4; ++j) acc[i][j] = (f32x4){0.f, 0.f, 0.f, 0.f};
}

DI void phase_gemm_in(const Params& p, int l, char* lds) {
  const int tid = tid_(), wave = tid >> 6, lane = tid & 63;
  const int wm = wave >> 1, wn = wave & 1, l15 = lane & 15, quad = lane >> 4;
  const bf16_t* Wt = p.wt_in;
  const int NTN = 49, NTM = 132;
  for (int tile = blockIdx.x; tile < NTN * NTM; tile += gridDim.x) {
    const int mt = tile / NTN, nt = tile % NTN;
    f32x4 acc[4][4]; zero_acc(acc);
    gemm_core<false>(acc, p.hn + (size_t)mt * 128 * DM, DM, Wt + (size_t)nt * 128 * DM, DM, DM, lds);
    const int colb = nt * 128 + wn * 64 + quad * 4;
    int kind;
    if (nt < 13) kind = 0; else if (nt < 17) kind = 1; else if (nt < 21) kind = 2; else if (nt < 25) kind = 3; else if (nt < 29) kind = 4; else if (nt < 33) kind = 1; else kind = 5;
#pragma unroll
    for (int mi = 0; mi < 4; ++mi) {
      const int R = mt * 128 + wm * 64 + mi * 16 + l15;
      const bool isp = R < MP; const int rs = R - MP;
      bf16_t* zrow = p.z + (size_t)R * NZ;
      if (kind == 0) {
        const bool last = isp ? ((R & 4095) == 4095) : ((rs & 63) == 63);
        float* so = isp ? p.out + O_SP + (size_t)(l * 4 + (R >> 12)) * SHC : p.out + O_SS + (size_t)(l * 8 + (rs >> 6)) * SHC;
#pragma unroll
        for (int ni = 0; ni < 4; ++ni) {
          const int c = colb + ni * 16; const f32x4 v = acc[mi][ni];
          u32x2 o; o[0] = pk2(v[0], v[1]); o[1] = pk2(v[2], v[3]); *(u32x2*)(zrow + c) = o;
          if (last) *(f32x4*)(so + c) = v;
        }
      } else if (kind == 1 || kind == 5) {
#pragma unroll
        for (int ni = 0; ni < 4; ++ni) {
          const int c = colb + ni * 16; f32x4 v = acc[mi][ni];
#pragma unroll
          for (int e = 0; e < 4; ++e) v[e] = (kind == 1) ? siluf_(v[e]) : sigmoidf_(v[e]);
          u32x2 o; o[0] = pk2(v[0], v[1]); o[1] = pk2(v[2], v[3]); *(u32x2*)(zrow + c) = o;
        }
      } else if (kind == 2 || kind == 3) {
        float ss = 0.f;
#pragma unroll
        for (int ni = 0; ni < 4; ++ni) { const f32x4 v = acc[mi][ni]; ss += v[0] * v[0] + v[1] * v[1] + v[2] * v[2] + v[3] * v[3]; }
        ss += __shfl_xor(ss, 16); ss += __shfl_xor(ss, 32);
        const float rstd = rsqrtf(ss * (1.0f / 64.0f) + 1e-6f);
        const float* g = (kind == 2 ? p.qng : p.kng) + l * 64;
        float* ko = isp ? p.out + O_KP + ((size_t)l * MP + R) * 512 : p.out + O_KS + ((size_t)l * MS + rs) * 512;
#pragma unroll
        for (int ni = 0; ni < 4; ++ni) {
          const int c = colb + ni * 16; const int d = ni * 16 + quad * 4;
          const f32x4 gv = *(const f32x4*)(g + d); f32x4 v = acc[mi][ni];
#pragma unroll
          for (int e = 0; e < 4; ++e) v[e] = v[e] * rstd * gv[e];
          u32x2 o; o[0] = pk2(v[0], v[1]); o[1] = pk2(v[2], v[3]); *(u32x2*)(zrow + c) = o;
          if (kind == 3) *(f32x4*)(ko + (c - C_K)) = v;
        }
      } else {
        float* vo = isp ? p.out + O_VP + ((size_t)l * MP + R) * 512 : p.out + O_VS + ((size_t)l * MS + rs) * 512;
#pragma unroll
        for (int ni = 0; ni < 4; ++ni) {
          const int cv = colb + ni * 16 - C_V; const f32x4 v = acc[mi][ni];
          *(f32x4*)(vo + cv) = v;
          const int h = cv >> 7, vd = cv & 127;
          if (isp) {
            bf16_t* vt = p.vtp + ((size_t)(((R >> 12) * 4 + h) * 128 + vd)) * 4096 + (R & 4095);
#pragma unroll
            for (int e = 0; e < 4; ++e) vt[(size_t)e * 4096] = (bf16_t)(pk2(v[e], 0.f) & 0xffff);
          } else {
            bf16_t* vt = p.vts + ((size_t)(((rs >> 6) * 4 + h) * 128 + vd)) * 64 + (rs & 63);
#pragma unroll
            for (int e = 0; e < 4; ++e) vt[(size_t)e * 64] = (bf16_t)(pk2(v[e], 0.f) & 0xffff);
          }
        }
      }
    }
  }
}

constexpr int NCH_P = 4096, NCH = 4224;
constexpr int XLD = 40;
DI f32x4 mm16(const bf16_t* Xrow, int ldx, const bf16_t* Yrow, int ldy, int ksteps, f32x4 acc, int l15, int quad) {
  for (int ks = 0; ks < ksteps; ++ks) {
    const bf16x8 a = *(const bf16x8*)(Xrow + l15 * ldx + ks * 32 + quad * 8);
    const bf16x8 b = *(const bf16x8*)(Yrow + l15 * ldy + ks * 32 + quad * 8);
    acc = __builtin_amdgcn_mfma_f32_16x16x32_bf16(a, b, acc, 0, 0, 0);
  }
  return acc;
}
DI void chunk_item(const Params& p, int l, int item, char* lds) {
  const int tid = tid_(), wave = tid >> 6, lane = tid & 63, l15 = lane & 15, quad = lane >> 4;
  const bool isp = item < NCH_P;
  int bh, c;
  if (isp) { bh = item >> 7; c = item & 127; } else { const int j = item - NCH_P; bh = j >> 1; c = j & 1; }
  const int b = bh >> 3, h = bh & 7;
  const int t0 = c * 32; const int row0 = (isp ? b * 4096 : MP + b * 64) + t0;
  float* s_r = (float*)lds;
  float* s_kf = s_r + 2048;
  float* s_v = s_kf + 2048;
  float* s_w = s_v + 2048;
  float* s_kk = s_w + 2048;
  float* s_bb = s_kk + 2048;
  bf16_t* s_wd = (bf16_t*)(lds + 49152);
  bf16_t* s_ad = (bf16_t*)(lds + 53760);
  float* s_bonus = (float*)(lds + 58368);
  float* s_wl = (float*)(lds + 58496);
  float* s_rhs = (float*)lds;
  bf16_t* s_A = (bf16_t*)lds;
  bf16_t* s_Bm = (bf16_t*)(lds + 4608);
  bf16_t* s_Kp = (bf16_t*)(lds + 9216);
  bf16_t* s_R = (bf16_t*)(lds + 16384);
  bf16_t* s_BmT = (bf16_t*)(lds + 20992);
  bf16_t* s_KpT = (bf16_t*)(lds + 26112);
  bf16_t* s_VmT = (bf16_t*)(lds + 31232);
  bf16_t* s_Lak = (bf16_t*)(lds + 36352);
  bf16_t* s_Mrk = (bf16_t*)(lds + 38912);
  bf16_t* s_Mrb = (bf16_t*)(lds + 41472);
  float* s_lab = (float*)(lds + 44032);
  bf16_t* s_XT = (bf16_t*)(lds + 48256);

  const int mat = wave >> 1, tt = wave & 1;
  const bf16_t* wl = (mat == 0 ? p.w2t : p.a2t) + (size_t)(h * 64) * 64;
  const float* mu = p.shift_mu + l * SHC;
  const float* w0 = p.decay_w0 + l * 512 + h * 64;
  const float* a0 = p.iclr_a0 + l * 512 + h * 64;
  const float* kkp = p.k_k + l * 512 + h * 64;
  const float* kap = p.k_a + l * 512 + h * 64;
  const float* rkp = p.r_k + l * 512 + h * 64;
  const float* lb = p.lnx_b + l * 512 + h * 64;
  const int ptok = tid >> 3, pcs = (tid & 7) * 8;
  {
    const int t = t0 + ptok; const size_t row = (size_t)(row0 + ptok);
#pragma unroll
    for (int g = 0; g < 5; ++g) {
      const int zc = (g < 3 ? g * 512 + h * 64 : 1536 + (g - 3) * 64) + pcs;
      const u32x4 cu = *(const u32x4*)(p.z + row * NZ + zc);
      float cur[8], prv[8];
#pragma unroll
      for (int e = 0; e < 4; ++e) { cur[2 * e] = bf_lo(cu[e]); cur[2 * e + 1] = bf_hi(cu[e]); }
      if (t > 0) {
        const u32x4 pu = *(const u32x4*)(p.z + (row - 1) * NZ + zc);
#pragma unroll
        for (int e = 0; e < 4; ++e) { prv[2 * e] = bf_lo(pu[e]); prv[2 * e + 1] = bf_hi(pu[e]); }
      } else if (isp) {
#pragma unroll
        for (int e = 0; e < 8; ++e) prv[e] = 0.f;
      } else {
        const float* sp = p.sshift + (size_t)(l * 8 + b) * SHC + zc;
#pragma unroll
        for (int e = 0; e < 8; ++e) prv[e] = sp[e];
      }
      float zs[8];
#pragma unroll
      for (int e = 0; e < 8; ++e) zs[e] = cur[e] + (prv[e] - cur[e]) * mu[zc + e];
      if (g < 3) {
        float* d = (g == 0 ? s_r : g == 1 ? s_kf : s_v) + ptok * 64 + pcs;
        *(f32x4*)d = (f32x4){zs[0], zs[1], zs[2], zs[3]}; *(f32x4*)(d + 4) = (f32x4){zs[4], zs[5], zs[6], zs[7]};
      } else {
        if (g == 3) {
#pragma unroll
          for (int e = 0; e < 8; ++e) { const float ex = __expf(2.f * zs[e]); zs[e] = 1.f - 2.f / (ex + 1.f); }
        }
        u32x4 o; o[0] = pk2(zs[0], zs[1]); o[1] = pk2(zs[2], zs[3]); o[2] = pk2(zs[4], zs[5]); o[3] = pk2(zs[6], zs[7]);
        *(u32x4*)((g == 3 ? s_wd : s_ad) + ptok * 72 + pcs) = o;
      }
    }
  }
  __syncthreads();
  {
    const bf16_t* At = (mat == 0 ? s_wd : s_ad);
    bf16x8 af[2];
#pragma unroll
    for (int ks = 0; ks < 2; ++ks) af[ks] = *(const bf16x8*)(At + (tt * 16 + l15) * 72 + ks * 32 + quad * 8);
#pragma unroll
    for (int ct = 0; ct < 4; ++ct) {
      f32x4 d = (f32x4){0.f, 0.f, 0.f, 0.f};
#pragma unroll
      for (int ks = 0; ks < 2; ++ks) {
        const bf16x8 wfr = *(const bf16x8*)(wl + (size_t)(ct * 16 + l15) * 64 + ks * 32 + quad * 8);
        d = __builtin_amdgcn_mfma_f32_16x16x32_bf16(wfr, af[ks], d, 0, 0, 0);
      }
      const int ch = ct * 16 + quad * 4; const int tok = tt * 16 + l15;
      f32x4 o;
      if (mat == 0) {
#pragma unroll
        for (int e = 0; e < 4; ++e) {
          const float y = -(w0[ch + e] + d[e]);
          const float sp = fmaxf(y, 0.f) + log1pf(__expf(-fabsf(y)));
          o[e] = -__expf(-sp - 0.5f);
        }
        *(f32x4*)(s_w + tok * 64 + ch) = o;
      } else {
#pragma unroll
        for (int e = 0; e < 4; ++e) o[e] = sigmoidf_(a0[ch + e] + d[e]);
        *(f32x4*)(s_bb + tok * 64 + ch) = o;
      }
    }
  }
  __syncthreads();
  float r_[8], kf[8], kk[8], bbv[8], v_[8], bon;
  {
    float k_[8], a_[8];
    *(f32x4*)&k_[0] = *(const f32x4*)(s_kf + ptok * 64 + pcs); *(f32x4*)&k_[4] = *(const f32x4*)(s_kf + ptok * 64 + pcs + 4);
    *(f32x4*)&a_[0] = *(const f32x4*)(s_bb + ptok * 64 + pcs); *(f32x4*)&a_[4] = *(const f32x4*)(s_bb + ptok * 64 + pcs + 4);
    *(f32x4*)&r_[0] = *(const f32x4*)(s_r + ptok * 64 + pcs); *(f32x4*)&r_[4] = *(const f32x4*)(s_r + ptok * 64 + pcs + 4);
    *(f32x4*)&v_[0] = *(const f32x4*)(s_v + ptok * 64 + pcs); *(f32x4*)&v_[4] = *(const f32x4*)(s_v + ptok * 64 + pcs + 4);
    float ss = 0.f; bon = 0.f;
#pragma unroll
    for (int e = 0; e < 8; ++e) {
      kk[e] = k_[e] * kkp[pcs + e]; ss += kk[e] * kk[e];
      kf[e] = k_[e] * (1.f + (a_[e] - 1.f) * kap[pcs + e]);
      bon += r_[e] * kf[e] * rkp[pcs + e];
    }
    ss += __shfl_xor(ss, 1); ss += __shfl_xor(ss, 2); ss += __shfl_xor(ss, 4);
    bon += __shfl_xor(bon, 1); bon += __shfl_xor(bon, 2); bon += __shfl_xor(bon, 4);
    const float inv = 1.0f / fmaxf(sqrtf(ss), 1e-12f);
#pragma unroll
    for (int e = 0; e < 8; ++e) { kk[e] *= inv; bbv[e] = kk[e] * a_[e]; }
  }
  if (tid < 64) {
    float run = 0.f;
#pragma unroll 8
    for (int t = 0; t < 32; ++t) { run += s_w[t * 64 + tid]; s_w[t * 64 + tid] = run; }
  }
  __syncthreads();
  {
    float cw[8], cwp[8];
    *(f32x4*)&cw[0] = *(const f32x4*)(s_w + ptok * 64 + pcs); *(f32x4*)&cw[4] = *(const f32x4*)(s_w + ptok * 64 + pcs + 4);
    if (ptok > 0) { *(f32x4*)&cwp[0] = *(const f32x4*)(s_w + (ptok - 1) * 64 + pcs); *(f32x4*)&cwp[4] = *(const f32x4*)(s_w + (ptok - 1) * 64 + pcs + 4); }
    else {
#pragma unroll
      for (int e = 0; e < 8; ++e) cwp[e] = 0.f;
    }
    __syncthreads();
    float av[8], bm[8], kp[8], rr[8];
#pragma unroll
    for (int e = 0; e < 8; ++e) {
      const float ec = __expf(cw[e]), en = __expf(-cw[e]), ep = __expf(cwp[e]);
      av[e] = kk[e] * ep; bm[e] = bbv[e] * en; kp[e] = kf[e] * en; rr[e] = r_[e] * ec;
      if (ptok == 31) s_wl[pcs + e] = ec;
    }
    u32x4 o;
    o[0] = pk2(av[0], av[1]); o[1] = pk2(av[2], av[3]); o[2] = pk2(av[4], av[5]); o[3] = pk2(av[6], av[7]); *(u32x4*)(s_A + ptok * 72 + pcs) = o;
    o[0] = pk2(bm[0], bm[1]); o[1] = pk2(bm[2], bm[3]); o[2] = pk2(bm[4], bm[5]); o[3] = pk2(bm[6], bm[7]); *(u32x4*)(s_Bm + ptok * 72 + pcs) = o;
#pragma unroll
    for (int e = 0; e < 4; ++e) { s_BmT[(pcs + 2 * e) * XLD + ptok] = (bf16_t)(o[e] & 0xffff); s_BmT[(pcs + 2 * e + 1) * XLD + ptok] = (bf16_t)(o[e] >> 16); }
    o[0] = pk2(kp[0], kp[1]); o[1] = pk2(kp[2], kp[3]); o[2] = pk2(kp[4], kp[5]); o[3] = pk2(kp[6], kp[7]); *(u32x4*)(s_Kp + ptok * 72 + pcs) = o;
#pragma unroll
    for (int e = 0; e < 4; ++e) { s_KpT[(pcs + 2 * e) * XLD + ptok] = (bf16_t)(o[e] & 0xffff); s_KpT[(pcs + 2 * e + 1) * XLD + ptok] = (bf16_t)(o[e] >> 16); }
    o[0] = pk2(rr[0], rr[1]); o[1] = pk2(rr[2], rr[3]); o[2] = pk2(rr[4], rr[5]); o[3] = pk2(rr[6], rr[7]); *(u32x4*)(s_R + ptok * 72 + pcs) = o;
    o[0] = pk2(v_[0], v_[1]); o[1] = pk2(v_[2], v_[3]); o[2] = pk2(v_[4], v_[5]); o[3] = pk2(v_[6], v_[7]);
#pragma unroll
    for (int e = 0; e < 4; ++e) { s_VmT[(pcs + 2 * e) * XLD + ptok] = (bf16_t)(o[e] & 0xffff); s_VmT[(pcs + 2 * e + 1) * XLD + ptok] = (bf16_t)(o[e] >> 16); }
    u32x4 ob;
    ob[0] = pk2(lb[pcs + 0] + bon * v_[0], lb[pcs + 1] + bon * v_[1]); ob[1] = pk2(lb[pcs + 2] + bon * v_[2], lb[pcs + 3] + bon * v_[3]);
    ob[2] = pk2(lb[pcs + 4] + bon * v_[4], lb[pcs + 5] + bon * v_[5]); ob[3] = pk2(lb[pcs + 6] + bon * v_[6], lb[pcs + 7] + bon * v_[7]);
    *(u32x4*)(p.cBA + ((size_t)item * 32 + ptok) * 64 + pcs) = ob;
  }
  __syncthreads();
  {
    const bf16_t* X = (wave < 2) ? s_A : s_R;
    const bf16_t* Y = (wave == 0 || wave == 3) ? s_Bm : s_Kp;
    const bool strict = wave < 2;
#pragma unroll
    for (int ti = 0; ti < 2; ++ti)
#pragma unroll
      for (int ii = 0; ii < 2; ++ii) {
        f32x4 d = (f32x4){0.f, 0.f, 0.f, 0.f};
        if (ii <= ti) d = mm16(X + ti * 16 * 72, 72, Y + ii * 16 * 72, 72, 2, d, l15, quad);
        const int i = ii * 16 + l15;
#pragma unroll
        for (int e = 0; e < 4; ++e) {
          const int t = ti * 16 + quad * 4 + e;
          const bool keep = strict ? (i < t) : (i <= t);
          const float val = keep ? d[e] : 0.f;
          if (wave == 0) s_lab[t * 33 + i] = val;
          else { bf16_t* dst = (wave == 1 ? s_Lak : wave == 2 ? s_Mrk : s_Mrb); dst[t * XLD + i] = (bf16_t)(pk2(val, 0.f) & 0xffff); }
        }
      }
  }
  const u32x4 acap = *(const u32x4*)(s_A + ptok * 72 + pcs);
  __syncthreads();
  {
    float* d = s_rhs + ptok * 128 + pcs;
    *(f32x4*)d = (f32x4){bf_lo(acap[0]), bf_hi(acap[0]), bf_lo(acap[1]), bf_hi(acap[1])};
    *(f32x4*)(d + 4) = (f32x4){bf_lo(acap[2]), bf_hi(acap[2]), bf_lo(acap[3]), bf_hi(acap[3])};
  }
  {
    const int ti = wave & 1;
#pragma unroll
    for (int vv = 0; vv < 2; ++vv) {
      const int vi = (wave >> 1) * 2 + vv;
      f32x4 d = (f32x4){0.f, 0.f, 0.f, 0.f};
      d = mm16(s_Lak + ti * 16 * XLD, XLD, s_VmT + vi * 16 * XLD, XLD, 1, d, l15, quad);
#pragma unroll
      for (int e = 0; e < 4; ++e) s_rhs[(ti * 16 + quad * 4 + e) * 128 + 64 + vi * 16 + l15] = d[e];
    }
  }
  __syncthreads();
  if (tid < 128) {
    float x[32];
#pragma unroll
    for (int t = 0; t < 32; ++t) {
      float a = s_rhs[t * 128 + tid];
#pragma unroll
      for (int i = 0; i < t; ++i) a -= s_lab[t * 33 + i] * x[i];
      x[t] = a;
    }
#pragma unroll
    for (int q4 = 0; q4 < 4; ++q4) {
      u32x4 o; o[0] = pk2(x[8 * q4], x[8 * q4 + 1]); o[1] = pk2(x[8 * q4 + 2], x[8 * q4 + 3]); o[2] = pk2(x[8 * q4 + 4], x[8 * q4 + 5]); o[3] = pk2(x[8 * q4 + 6], x[8 * q4 + 7]);
      *(u32x4*)(s_XT + tid * XLD + q4 * 8) = o;
    }
  }
  __syncthreads();
  {
    const f32x4 z4 = (f32x4){0.f, 0.f, 0.f, 0.f};
    bf16_t* gPT = p.cPT + (size_t)item * 4096;
    const float wl_c = s_wl[wave * 16 + l15];
#pragma unroll
    for (int k1t = 0; k1t < 4; ++k1t) {
      f32x4 d = mm16(s_XT + k1t * 16 * XLD, XLD, s_BmT + wave * 16 * XLD, XLD, 1, z4, l15, quad);
      const int k2 = wave * 16 + l15, k1 = k1t * 16 + quad * 4;
      float o[4];
#pragma unroll
      for (int e = 0; e < 4; ++e) o[e] = ((k1 + e == k2 ? 1.f : 0.f) - d[e]) * wl_c;
      u32x2 ov; ov[0] = pk2(o[0], o[1]); ov[1] = pk2(o[2], o[3]);
      *(u32x2*)(gPT + k2 * 64 + k1) = ov;
    }
    bf16_t* gG = p.cG + (size_t)item * 4096;
#pragma unroll
    for (int k2t = 0; k2t < 4; ++k2t) {
      const f32x4 d1 = mm16(s_KpT + k2t * 16 * XLD, XLD, s_VmT + wave * 16 * XLD, XLD, 1, z4, l15, quad);
      const f32x4 d2 = mm16(s_BmT + k2t * 16 * XLD, XLD, s_XT + (64 + wave * 16) * XLD, XLD, 1, z4, l15, quad);
      const int k2 = k2t * 16 + quad * 4, v = wave * 16 + l15;
      const f32x4 wv = *(const f32x4*)(s_wl + k2);
      u32x2 ov; ov[0] = pk2((d1[0] - d2[0]) * wv[0], (d1[1] - d2[1]) * wv[1]); ov[1] = pk2((d1[2] - d2[2]) * wv[2], (d1[3] - d2[3]) * wv[3]);
      *(u32x2*)(gG + v * 64 + k2) = ov;
    }
    bf16_t* gRT = p.cRT + (size_t)item * 2048;
    bf16_t* gOI = p.cOI + (size_t)item * 2048;
#pragma unroll
    for (int ti = 0; ti < 2; ++ti) {
      const f32x4 d = mm16(s_XT + wave * 16 * XLD, XLD, s_Mrb + ti * 16 * XLD, XLD, 1, z4, l15, quad);
      const int t = ti * 16 + l15, k = wave * 16 + quad * 4;
      const u32x2 rv = *(const u32x2*)(s_R + t * 72 + k);
      u32x2 ov; ov[0] = pk2(bf_lo(rv[0]) - d[0], bf_hi(rv[0]) - d[1]); ov[1] = pk2(bf_lo(rv[1]) - d[2], bf_hi(rv[1]) - d[3]);
      *(u32x2*)(gRT + t * 64 + k) = ov;
      const f32x4 e1 = mm16(s_VmT + wave * 16 * XLD, XLD, s_Mrk + ti * 16 * XLD, XLD, 1, z4, l15, quad);
      const f32x4 e2 = mm16(s_XT + (64 + wave * 16) * XLD, XLD, s_Mrb + ti * 16 * XLD, XLD, 1, z4, l15, quad);
      u32x2 oo; oo[0] = pk2(e1[0] - e2[0], e1[1] - e2[1]); oo[1] = pk2(e1[2] - e2[2], e1[3] - e2[3]);
      *(u32x2*)(gOI + t * 64 + k) = oo;
    }
  }
  __syncthreads();
}

DI void rec_item(const Params& p, int l, int item, char* lds) {
  const int tid = tid_(), wave = tid >> 6, lane = tid & 63, l15 = lane & 15, quad = lane >> 4;
  const bool isp = item < 32;
  const int bh = isp ? item : item - 32; const int b = bh >> 3, h = bh & 7;
  const int nch = isp ? 128 : 2; const int cid0 = isp ? bh * 128 : NCH_P + bh * 2;
  const int row0 = isp ? b * 4096 : MP + b * 64;
  bf16_t* Sb = (bf16_t*)lds;
  const int v = wave * 16 + l15;
  f32x4 acc[4];
  if (isp) {
#pragma unroll
    for (int nk = 0; nk < 4; ++nk) acc[nk] = (f32x4){0.f, 0.f, 0.f, 0.f};
  } else {
    const float* sp = p.swkv + (((size_t)(l * 8 + b) * 8 + h) * 64 + v) * 64;
#pragma unroll
    for (int nk = 0; nk < 4; ++nk) acc[nk] = *(const f32x4*)(sp + nk * 16 + quad * 4);
  }
#pragma unroll
  for (int nk = 0; nk < 4; ++nk) { u32x2 o; o[0] = pk2(acc[nk][0], acc[nk][1]); o[1] = pk2(acc[nk][2], acc[nk][3]); *(u32x2*)(Sb + v * 72 + nk * 16 + quad * 4) = o; }
  __syncthreads();
  const float* lg = p.lnx_g + l * 512 + h * 64;
  for (int c = 0; c < nch; ++c) {
    const int buf = c & 1; const size_t cid = (size_t)(cid0 + c);
    const bf16_t* gPT = p.cPT + cid * 4096; const bf16_t* gG = p.cG + cid * 4096;
    bf16x8 pt[4][2]; u32x2 gv[4];
#pragma unroll
    for (int nk = 0; nk < 4; ++nk) {
#pragma unroll
      for (int ks = 0; ks < 2; ++ks) pt[nk][ks] = *(const bf16x8*)(gPT + (nk * 16 + l15) * 64 + ks * 32 + quad * 8);
      gv[nk] = *(const u32x2*)(gG + v * 64 + nk * 16 + quad * 4);
    }
    bf16x8 rt[2]; u32x2 oi[4], ba[4], gt[4];
    const int tok = (wave & 1) * 16 + l15; const size_t row = (size_t)(row0 + c * 32 + tok);
    if (wave < 2) {
#pragma unroll
      for (int ks = 0; ks < 2; ++ks) rt[ks] = *(const bf16x8*)(p.cRT + cid * 2048 + tok * 64 + ks * 32 + quad * 8);
#pragma unroll
      for (int vt = 0; vt < 4; ++vt) {
        oi[vt] = *(const u32x2*)(p.cOI + cid * 2048 + tok * 64 + vt * 16 + quad * 4);
        ba[vt] = *(const u32x2*)(p.cBA + cid * 2048 + tok * 64 + vt * 16 + quad * 4);
        gt[vt] = *(const u32x2*)(p.z + row * NZ + C_GR + h * 64 + vt * 16 + quad * 4);
      }
    }
    bf16x8 sf[2];
#pragma unroll
    for (int ks = 0; ks < 2; ++ks) sf[ks] = *(const bf16x8*)(Sb + (buf * 64 + v) * 72 + ks * 32 + quad * 8);
#pragma unroll
    for (int nk = 0; nk < 4; ++nk) {
      f32x4 a = (f32x4){bf_lo(gv[nk][0]), bf_hi(gv[nk][0]), bf_lo(gv[nk][1]), bf_hi(gv[nk][1])};
#pragma unroll
      for (int ks = 0; ks < 2; ++ks) a = __builtin_amdgcn_mfma_f32_16x16x32_bf16(pt[nk][ks], sf[ks], a, 0, 0, 0);
      acc[nk] = a;
    }
    f32x4 ao[4];
    if (wave < 2) {
#pragma unroll
      for (int vt = 0; vt < 4; ++vt) {
        f32x4 a = (f32x4){bf_lo(oi[vt][0]), bf_hi(oi[vt][0]), bf_lo(oi[vt][1]), bf_hi(oi[vt][1])};
#pragma unroll
        for (int ks = 0; ks < 2; ++ks) {
          const bf16x8 sa = *(const bf16x8*)(Sb + (buf * 64 + vt * 16 + l15) * 72 + ks * 32 + quad * 8);
          a = __builtin_amdgcn_mfma_f32_16x16x32_bf16(sa, rt[ks], a, 0, 0, 0);
        }
        ao[vt] = a;
      }
    }
#pragma unroll
    for (int nk = 0; nk < 4; ++nk) { u32x2 o; o[0] = pk2(acc[nk][0], acc[nk][1]); o[1] = pk2(acc[nk][2], acc[nk][3]); *(u32x2*)(Sb + ((buf ^ 1) * 64 + v) * 72 + nk * 16 + quad * 4) = o; }
    __syncthreads();
    if (wave < 2) {
      float sm = 0.f;
#pragma unroll
      for (int vt = 0; vt < 4; ++vt) sm += (ao[vt][0] + ao[vt][1]) + (ao[vt][2] + ao[vt][3]);
      sm += __shfl_xor(sm, 16); sm += __shfl_xor(sm, 32);
      const float mean = sm * (1.0f / 64.0f);
      float vr = 0.f;
#pragma unroll
      for (int vt = 0; vt < 4; ++vt)
#pragma unroll
        for (int e = 0; e < 4; ++e) { const float d = ao[vt][e] - mean; vr += d * d; }
      vr += __shfl_xor(vr, 16); vr += __shfl_xor(vr, 32);
      const float rstd = rsqrtf(vr * (1.0f / 64.0f) + 64e-5f);
#pragma unroll
      for (int vt = 0; vt < 4; ++vt) {
        const int vv = vt * 16 + quad * 4;
        const f32x4 g4 = *(const f32x4*)(lg + vv);
        const float y0 = ((ao[vt][0] - mean) * rstd * g4[0] + bf_lo(ba[vt][0])) * bf_lo(gt[vt][0]);
        const float y1 = ((ao[vt][1] - mean) * rstd * g4[1] + bf_hi(ba[vt][0])) * bf_hi(gt[vt][0]);
        const float y2 = ((ao[vt][2] - mean) * rstd * g4[2] + bf_lo(ba[vt][1])) * bf_lo(gt[vt][1]);
        const float y3 = ((ao[vt][3] - mean) * rstd * g4[3] + bf_hi(ba[vt][1])) * bf_hi(gt[vt][1]);
        u32x2 ov; ov[0] = pk2(y0, y1); ov[1] = pk2(y2, y3);
        *(u32x2*)(p.o_r + row * 512 + h * 64 + vv) = ov;
      }
    }
  }
  float* so = (isp ? p.out + O_WP + (((size_t)(l * 4 + b) * 8 + h) * 64 + v) * 64 : p.out + O_WS + (((size_t)(l * 8 + b) * 8 + h) * 64 + v) * 64);
#pragma unroll
  for (int nk = 0; nk < 4; ++nk) *(f32x4*)(so + nk * 16 + quad * 4) = acc[nk];
  __syncthreads();
}
DI void phase_chunk(const Params& p, int l, char* lds) {
  for (int it = blockIdx.x; it < NCH; it += gridDim.x) chunk_item(p, l, it, lds);
}

constexpr int ALD = 72;
DI void attn_item(const Params& p, int l, int item, char* lds) {
  const int tid = tid_(), wave = tid >> 6, lane = tid & 63;
  const int m = wave & 1, qh = wave >> 1, q = lane & 31, hh = lane >> 5;
  bf16_t* Ks = (bf16_t*)lds;
  bf16_t* Vs = Ks + 2 * 64 * ALD;
  float* xb = (float*)lds;
  bool samp; int b, h, nch, qrow0, qpos0;
  if (item < 32) { samp = true; b = item >> 2; h = item & 3; nch = 17; qrow0 = MP + b * 64; qpos0 = 1024; }
  else { samp = false; const int a = item - 32; const int qc = 63 - (a >> 4); const int bh = a & 15; b = bh >> 2; h = bh & 3; nch = qc + 1; qrow0 = b * 4096 + qc * 64; qpos0 = qc * 64; }
  bf16x8 qf[4];
  {
    const bf16_t* qp = p.z + (size_t)(qrow0 + qh * 32 + q) * NZ + C_Q + h * 128 + m * 64;
#pragma unroll
    for (int ks = 0; ks < 4; ++ks) qf[ks] = *(const bf16x8*)(qp + ks * 16 + hh * 8);
  }
  const float slope = exp2f(-2.0f * (float)(h + 1));
  const float LOG2E = 1.4426950408889634f;
  const float c1 = 0.125f * LOG2E, sl2 = slope * LOG2E;
  const float qposf = (float)(qpos0 + qh * 32 + q);
  f32x16 O[4];
#pragma unroll
  for (int i = 0; i < 4; ++i)
#pragma unroll
    for (int e = 0; e < 16; ++e) O[i][e] = 0.f;
  float mrun = -1e30f, lrun = 0.f;
  u32x4 rk[4], rv[4];
  auto gload = [&](int j) {
    const bf16_t* kb; size_t kld; const bf16_t* vb; size_t vld;
    if (!samp) { kb = p.z + (size_t)(b * 4096 + j * 64) * NZ + C_K + h * 128; kld = NZ; vb = p.vtp + (size_t)((b * 4 + h) * 128) * 4096 + j * 64; vld = 4096; }
    else if (j < 16) { kb = p.kc + (size_t)(b * 1024 + j * 64) * 512 + h * 128; kld = 512; vb = p.vct + (size_t)((b * 4 + h) * 128) * 1024 + j * 64; vld = 1024; }
    else { kb = p.z + (size_t)(MP + b * 64) * NZ + C_K + h * 128; kld = NZ; vb = p.vts + (size_t)((b * 4 + h) * 128) * 64; vld = 64; }
#pragma unroll
    for (int i = 0; i < 4; ++i) {
      const int c = tid + 256 * i;
      const int mm = c >> 9, key = (c >> 3) & 63, d8 = (c & 7) * 8;
      rk[i] = *(const u32x4*)(kb + (size_t)key * kld + mm * 64 + d8);
      const int vd = c >> 3, k8 = (c & 7) * 8;
      rv[i] = *(const u32x4*)(vb + (size_t)vd * vld + k8);
    }
  };
  auto sstore = [&]() {
#pragma unroll
    for (int i = 0; i < 4; ++i) {
      const int c = tid + 256 * i;
      const int mm = c >> 9, key = (c >> 3) & 63, d8 = (c & 7) * 8;
      *(u32x4*)(Ks + (mm * 64 + key) * ALD + d8) = rk[i];
      const int vd = c >> 3, k8 = (c & 7) * 8;
      *(u32x4*)(Vs + vd * ALD + k8) = rv[i];
    }
  };
  gload(0); sstore(); __syncthreads();
  for (int j = 0; j < nch; ++j) {
    if (j + 1 < nch) gload(j + 1);
    f32x16 s[2];
#pragma unroll
    for (int kt = 0; kt < 2; ++kt) {
#pragma unroll
      for (int e = 0; e < 16; ++e) s[kt][e] = 0.f;
#pragma unroll
      for (int ks = 0; ks < 4; ++ks) {
        const bf16x8 kf = *(const bf16x8*)(Ks + (m * 64 + kt * 32 + q) * ALD + ks * 16 + hh * 8);
        s[kt] = __builtin_amdgcn_mfma_f32_32x32x16_bf16(kf, qf[ks], s[kt], 0, 0, 0);
      }
    }
    float mx = -1e30f;
#pragma unroll
    for (int kt = 0; kt < 2; ++kt)
#pragma unroll
      for (int e = 0; e < 16; ++e) {
        const float kpos = (float)(j * 64 + kt * 32 + (e & 3) + 8 * (e >> 2) + 4 * hh);
        const float v = s[kt][e] * c1 - sl2 * fabsf(qposf - kpos);
        s[kt][e] = v; mx = fmaxf(mx, v);
      }
    mx = fmaxf(mx, __shfl_xor(mx, 32));
    const float mnew = fmaxf(mrun, mx);
    const float alpha = exp2f(mrun - mnew);
    mrun = mnew;
    float ps = 0.f;
#pragma unroll
    for (int kt = 0; kt < 2; ++kt)
#pragma unroll
      for (int e = 0; e < 16; ++e) { const float pe = exp2f(s[kt][e] - mnew); s[kt][e] = pe; ps += pe; }
    lrun = lrun * alpha + ps;
#pragma unroll
    for (int i = 0; i < 4; ++i)
#pragma unroll
      for (int e = 0; e < 16; ++e) O[i][e] *= alpha;
#pragma unroll
    for (int kt = 0; kt < 2; ++kt)
#pragma unroll
      for (int sx = 0; sx < 2; ++sx) {
        u32x4 pb;
        pb[0] = pk2(s[kt][8 * sx + 0], s[kt][8 * sx + 1]); pb[1] = pk2(s[kt][8 * sx + 2], s[kt][8 * sx + 3]);
        pb[2] = pk2(s[kt][8 * sx + 4], s[kt][8 * sx + 5]); pb[3] = pk2(s[kt][8 * sx + 6], s[kt][8 * sx + 7]);
        const bf16x8 pf = __builtin_bit_cast(bf16x8, pb);
#pragma unroll
        for (int vt = 0; vt < 4; ++vt) {
          const bf16_t* vp = Vs + (vt * 32 + q) * ALD + kt * 32 + 16 * sx + 4 * hh;
          const s16x4 lo = *(const s16x4*)vp, hi = *(const s16x4*)(vp + 8);
          const bf16x8 vf = __builtin_shufflevector(lo, hi, 0, 1, 2, 3, 4, 5, 6, 7);
          O[vt] = __builtin_amdgcn_mfma_f32_32x32x16_bf16(vf, pf, O[vt], 0, 0, 0);
        }
      }
    __syncthreads();
    if (j + 1 < nch) sstore();
    __syncthreads();
  }
  const float ltot = lrun + __shfl_xor(lrun, 32);
  const float inv = 1.0f / ltot;
#pragma unroll
  for (int i = 0; i < 4; ++i)
#pragma unroll
    for (int e = 0; e < 16; ++e) O[i][e] *= inv;
  if (m == 1) {
#pragma unroll
    for (int vt = 0; vt < 4; ++vt)
#pragma unroll
      for (int e = 0; e < 16; ++e) { const int vd = vt * 32 + (e & 3) + 8 * (e >> 2) + 4 * hh; xb[(qh * 128 + vd) * 32 + q] = O[vt][e]; }
  }
  __syncthreads();
  if (m == 0) {
    float d1 = 0.f, d2 = 0.f;
    for (int i = 0; i < 64; ++i) { d1 += p.lq1[l * 64 + i] * p.lk1[l * 64 + i]; d2 += p.lq2[l * 64 + i] * p.lk2[l * 64 + i]; }
    const float lam_init = 0.8f - 0.6f * __expf(-0.3f * (float)l);
    const float lam = __expf(d1) - __expf(d2) + lam_init;
    float ss = 0.f;
#pragma unroll
    for (int vt = 0; vt < 4; ++vt)
#pragma unroll
      for (int e = 0; e < 16; ++e) {
        const int vd = vt * 32 + (e & 3) + 8 * (e >> 2) + 4 * hh;
        const float o2 = xb[(qh * 128 + vd) * 32 + q];
        const float o = O[vt][e] - lam * o2; O[vt][e] = o; ss += o * o;
      }
    ss += __shfl_xor(ss, 32);
    const float rstd = rsqrtf(ss * (1.0f / 128.0f) + 1e-5f) * (1.0f - lam_init);
    const size_t row = (size_t)(qrow0 + qh * 32 + q);
    const float* sg = p.subln_g + l * 128;
#pragma unroll
    for (int vt = 0; vt < 4; ++vt)
#pragma unroll
      for (int e4 = 0; e4 < 4; ++e4) {
        const int vd = vt * 32 + 8 * e4 + 4 * hh;
        const u32x2 gu = *(const u32x2*)(p.z + row * NZ + C_GA + h * 128 + vd);
        const f32x4 gv = *(const f32x4*)(sg + vd);
        const float y0 = O[vt][4 * e4 + 0] * rstd * gv[0] * bf_lo(gu[0]);
        const float y1 = O[vt][4 * e4 + 1] * rstd * gv[1] * bf_hi(gu[0]);
        const float y2 = O[vt][4 * e4 + 2] * rstd * gv[2] * bf_lo(gu[1]);
        const float y3 = O[vt][4 * e4 + 3] * rstd * gv[3] * bf_hi(gu[1]);
        u32x2 ov; ov[0] = pk2(y0, y1); ov[1] = pk2(y2, y3);
        *(u32x2*)(p.o_a + row * 512 + h * 128 + vd) = ov;
      }
  }
  __syncthreads();
}

DI void phase_mix(const Params& p, int l, char* lds) {
  const int n_scan = 96, n_attn = 32 + 1024;
  for (int it = blockIdx.x; it < n_scan + n_attn; it += gridDim.x) {
    if (it < n_scan) rec_item(p, l, it, lds); else attn_item(p, l, it - n_scan, lds);
  }
}

DI void phase_merge(const Params& p, int l, char* lds) {
  const int tid = tid_(), wave = tid >> 6, lane = tid & 63;
  const int wm = wave >> 1, wn = wave & 1, l15 = lane & 15, quad = lane >> 4;
  for (int tile = blockIdx.x; tile < 132 * 8; tile += gridDim.x) {
    const int mt = tile >> 3, nt = tile & 7;
    f32x4 a1[4][4]; zero_acc(a1);
    gemm_core<false>(a1, p.o_r + (size_t)mt * 128 * 512, 512, p.wt_brr + (size_t)nt * 128 * 512, 512, 512, lds);
    u32x2 pk[4][4];
#pragma unroll
    for (int mi = 0; mi < 4; ++mi) {
      const int R = mt * 128 + wm * 64 + mi * 16 + l15;
#pragma unroll
      for (int ni = 0; ni < 4; ++ni) {
        const int c = nt * 128 + wn * 64 + ni * 16 + quad * 4;
        const u32x2 g1 = *(const u32x2*)(p.z + (size_t)R * NZ + C_MR + c);
        const f32x4 v1 = a1[mi][ni];
        pk[mi][ni][0] = pk2(bf_lo(g1[0]) * v1[0], bf_hi(g1[0]) * v1[1]);
        pk[mi][ni][1] = pk2(bf_lo(g1[1]) * v1[2], bf_hi(g1[1]) * v1[3]);
      }
    }
    zero_acc(a1);
    gemm_core<false>(a1, p.o_a + (size_t)mt * 128 * 512, 512, p.wt_bra + (size_t)nt * 128 * 512, 512, 512, lds);
#pragma unroll
    for (int mi = 0; mi < 4; ++mi) {
      const int R = mt * 128 + wm * 64 + mi * 16 + l15;
#pragma unroll
      for (int ni = 0; ni < 4; ++ni) {
        const int c = nt * 128 + wn * 64 + ni * 16 + quad * 4;
        const u32x2 g2 = *(const u32x2*)(p.z + (size_t)R * NZ + C_MA + c);
        const f32x4 v2 = a1[mi][ni]; const u32x2 u1 = pk[mi][ni];
        u32x2 o;
        o[0] = pk2(bf_lo(u1[0]) + bf_lo(g2[0]) * v2[0], bf_hi(u1[0]) + bf_hi(g2[0]) * v2[1]);
        o[1] = pk2(bf_lo(u1[1]) + bf_lo(g2[1]) * v2[2], bf_hi(u1[1]) + bf_hi(g2[1]) * v2[3]);
        *(u32x2*)(p.hn + (size_t)R * DM + c) = o;
      }
    }
  }
}
DI void phase_out(const Params& p, int l, char* lds) {
  const int tid = tid_(), wave = tid >> 6, lane = tid & 63;
  const int wm = wave >> 1, wn = wave & 1, l15 = lane & 15, quad = lane >> 4;
  for (int tile = blockIdx.x; tile < 132 * 8; tile += gridDim.x) {
    const int mt = tile >> 3, nt = tile & 7;
    f32x4 acc[4][4]; zero_acc(acc);
    gemm_core<false>(acc, p.hn + (size_t)mt * 128 * DM, DM, p.wt_out + (size_t)nt * 128 * DM, DM, DM, lds);
#pragma unroll
    for (int mi = 0; mi < 4; ++mi) {
      const int R = mt * 128 + wm * 64 + mi * 16 + l15;
      const float* xr = x_row(p, l, R);
#pragma unroll
      for (int ni = 0; ni < 4; ++ni) {
        const int c = nt * 128 + wn * 64 + ni * 16 + quad * 4;
        const f32x4 xv = *(const f32x4*)(xr + c);
        *(f32x4*)(p.out + (size_t)R * DM + c) = xv + acc[mi][ni];
      }
    }
  }
}
DI void phase_ple(const Params& p, int l, char* lds) {
  const int tid = tid_(), wave = tid >> 6, lane = tid & 63;
  const int wm = wave >> 1, wn = wave & 1, l15 = lane & 15, quad = lane >> 4;
  for (int tile = blockIdx.x; tile < 132 * 8; tile += gridDim.x) {
    const int mt = tile >> 3, nt = tile & 7;
    f32x4 a1[4][4]; zero_acc(a1);
    gemm_core<false>(a1, p.hn + (size_t)mt * 128 * DM, DM, p.wt_gate + (size_t)nt * 128 * DM, DM, DM, lds);
    u32x2 pk[4][4];
#pragma unroll
    for (int mi = 0; mi < 4; ++mi)
#pragma unroll
      for (int ni = 0; ni < 4; ++ni) { const f32x4 v = a1[mi][ni]; pk[mi][ni][0] = pk2(sigmoidf_(v[0]), sigmoidf_(v[1])); pk[mi][ni][1] = pk2(sigmoidf_(v[2]), sigmoidf_(v[3])); }
    zero_acc(a1);
    const int r0 = mt * 128;
    const float* pa = r0 < MP ? p.pp + ((size_t)l * MP + r0) * 256 : p.ps + ((size_t)l * MS + (r0 - MP)) * 256;
    gemm_core<true>(a1, pa, 256, p.wt_ple + (size_t)nt * 128 * 256, 256, 256, lds);
#pragma unroll
    for (int mi = 0; mi < 4; ++mi) {
      const int R = mt * 128 + wm * 64 + mi * 16 + l15;
#pragma unroll
      for (int ni = 0; ni < 4; ++ni) {
        const int c = nt * 128 + wn * 64 + ni * 16 + quad * 4;
        float* xo = p.out + (size_t)R * DM + c;
        const f32x4 xv = *(const f32x4*)xo; const f32x4 e = a1[mi][ni]; const u32x2 g = pk[mi][ni];
        f32x4 o;
        o[0] = xv[0] + e[0] * bf_lo(g[0]); o[1] = xv[1] + e[1] * bf_hi(g[0]);
        o[2] = xv[2] + e[2] * bf_lo(g[1]); o[3] = xv[3] + e[3] * bf_hi(g[1]);
        *(f32x4*)xo = o;
      }
    }
  }
}

constexpr int LDS_BYTES = 73728;
DI void run_phase(const Params& p, int ph, int l, char* lds) {
  switch (ph) {
    case 1: phase_norm(p, l, true, lds); break;
    case 2: phase_gemm_in(p, l, lds); break;
    case 3: phase_mix(p, l, lds); break;
    case 4: phase_merge(p, l, lds); break;
    case 5: phase_out(p, l, lds); break;
    case 6: phase_norm(p, l, false, lds); break;
    case 7: phase_ple(p, l, lds); break;
    case 8: phase_chunk(p, l, lds); break;
  }
}

#if MEGA
__global__ void __launch_bounds__(256, 2) k_mega(Params p) {
  __shared__ __attribute__((aligned(16))) char lds[LDS_BYTES];
  cg::grid_group grid = cg::this_grid();
#pragma unroll 1
  for (int l = 0; l < NL; ++l) {
    phase_norm(p, l, true, lds); grid.sync();
    phase_gemm_in(p, l, lds); grid.sync();
    phase_chunk(p, l, lds); grid.sync();
    phase_mix(p, l, lds); grid.sync();
    phase_merge(p, l, lds); grid.sync();
    phase_out(p, l, lds); grid.sync();
    phase_norm(p, l, false, lds); grid.sync();
    phase_ple(p, l, lds); if (l + 1 < NL) grid.sync();
  }
}
#else
template <int PH>
__global__ void __launch_bounds__(256, 2) k_phase(Params p, int l) {
  __shared__ __attribute__((aligned(16))) char lds[LDS_BYTES];
  run_phase(p, PH, l, lds);
}
#endif

extern "C" void kernel_launch(void* const* d_in, const int* in_sizes, int n_in, void* d_out, int out_size, void* d_ws, size_t ws_size,
                              hipStream_t stream) {
  Params p{};
  const float** pf = (const float**)&p;
  for (int i = 0; i < 33; ++i) pf[i] = (const float*)d_in[i];
  p.out = (float*)d_out;
  char* w = (char*)d_ws; size_t off = 0;
  auto take = [&](size_t bytes) { char* r = w + off; off += (bytes + 255) & ~(size_t)255; return (bf16_t*)r; };
  p.wt_in = take((size_t)NZ * 1024 * 2);
  p.wt_brr = take((size_t)1024 * 512 * 2);
  p.wt_bra = take((size_t)1024 * 512 * 2);
  p.wt_out = take((size_t)1024 * 1024 * 2);
  p.wt_ple = take((size_t)1024 * 256 * 2);
  p.wt_gate = take((size_t)1024 * 1024 * 2);
  p.w2t = take((size_t)512 * 64 * 2);
  p.a2t = take((size_t)512 * 64 * 2);
  p.z = take((size_t)MT * NZ * 2);
  p.vtp = take((size_t)16 * 128 * 4096 * 2);
  p.vts = take((size_t)32 * 128 * 64 * 2);
  p.kc = take((size_t)8 * 1024 * 512 * 2);
  p.vct = take((size_t)32 * 128 * 1024 * 2);
  p.o_r = take((size_t)MT * 512 * 2);
  p.o_a = take((size_t)MT * 512 * 2);
  p.hn = take((size_t)MT * DM * 2);
  p.cPT = p.hn;
  p.cG = take((size_t)NCH * 4096 * 2);
  p.cRT = take((size_t)NCH * 2048 * 2);
  p.cOI = take((size_t)NCH * 2048 * 2);
  p.cBA = take((size_t)NCH * 2048 * 2);
  if (off > ws_size) { fprintf(stderr, "workspace too small: need %zu have %zu\n", off, ws_size); return; }
#if MEGA
  static int grid_blocks = 0;
  if (!grid_blocks) {
    int dev = 0, cus = 0, per_cu = 0;
    hipGetDevice(&dev);
    hipDeviceGetAttribute(&cus, hipDeviceAttributeMultiprocessorCount, dev);
    hipOccupancyMaxActiveBlocksPerMultiprocessor(&per_cu, k_mega, 256, 0);
    if (per_cu > 2) per_cu = 2;
    grid_blocks = cus * per_cu;
  }
  void* args[] = {&p};
  hipError_t e = hipLaunchCooperativeKernel((void*)k_mega, dim3(grid_blocks), dim3(256), args, 0, stream);
  if (e != hipSuccess) fprintf(stderr, "cooperative launch failed: %s (grid %d)\n", hipGetErrorString(e), grid_blocks);
#else
  const int G = 512;
  for (int l = 0; l < NL; ++l) {
    k_phase<1><<<G, 256, 0, stream>>>(p, l);
    k_phase<2><<<G, 256, 0, stream>>>(p, l);
    k_phase<8><<<G, 256, 0, stream>>>(p, l);
    k_phase<3><<<G, 256, 0, stream>>>(p, l);
    k_phase<4><<<G, 256, 0, stream>>>(p, l);
    k_phase<5><<<G, 256, 0, stream>>>(p, l);
    k_phase<6><<<G, 256, 0, stream>>>(p, l);
    k_phase<7><<<G, 256, 0, stream>>>(p, l);
  }
#endif
}
```

```cpp
#include <hip/hip_runtime.h>
#include <hip/hip_cooperative_groups.h>
#include <stdint.h>
#include <stdio.h>
namespace cg = cooperative_groups;

#ifndef MEGA
#define MEGA 1
#endif

typedef unsigned short bf16_t;
typedef short bf16x8 __attribute__((ext_vector_type(8)));
typedef short s16x4 __attribute__((ext_vector_type(4)));
typedef float f32x4 __attribute__((ext_vector_type(4)));
typedef float f32x2 __attribute__((ext_vector_type(2)));
typedef float f32x16 __attribute__((ext_vector_type(16)));
typedef unsigned u32x4 __attribute__((ext_vector_type(4)));
typedef unsigned u32x2 __attribute__((ext_vector_type(2)));
typedef __bf16 bfv2 __attribute__((ext_vector_type(2)));

#define DI __device__ __forceinline__
DI int tid_() { int t = threadIdx.x; asm volatile("" : "+v"(t)); return t; }

constexpr int DM = 1024, MP = 16384, MS = 512, MT = 16896, NZ = 6272, NL = 4;
constexpr int C_GR = 1664, C_Q = 2176, C_K = 2688, C_V = 3200, C_GA = 3712, C_MR = 4224, C_MA = 5248;
constexpr int SHC = 1664;
constexpr size_t O_YP = 0, O_YS = 16777216, O_KP = 17301504, O_VP = 50855936, O_WP = 84410368, O_SP = 84934656,
                 O_KS = 84961280, O_VS = 86009856, O_WS = 87058432, O_SS = 88107008;

struct Params {
  const float *xp, *xs, *pp, *ps, *ck, *cv, *swkv, *sshift;
  const float *norm_g, *w_in, *shift_mu, *decay_w0, *decay_w2, *iclr_a0, *iclr_a2, *k_k, *k_a, *r_k, *lnx_g, *lnx_b,
      *qng, *kng, *lq1, *lk1, *lq2, *lk2, *subln_g, *w_br_r, *w_br_a, *w_out, *ple_w, *ple_gate_w, *ple_norm_g;
  float* out;
  bf16_t *wt_in, *wt_brr, *wt_bra, *wt_out, *wt_ple, *wt_gate, *w2t, *a2t;
  bf16_t *hn, *z, *vtp, *vts, *kc, *vct, *o_r, *o_a;
  bf16_t *cPT, *cG, *cRT, *cOI, *cBA;
  unsigned* bar;
};

DI unsigned pk2(float a, float b) { f32x2 v = {a, b}; bfv2 r = __builtin_convertvector(v, bfv2); return __builtin_bit_cast(unsigned, r); }
DI float bf_lo(unsigned u) { return __uint_as_float(u << 16); }
DI float bf_hi(unsigned u) { return __uint_as_float(u & 0xffff0000u); }
DI float bf1(bf16_t u) { return __uint_as_float(((unsigned)u) << 16); }
DI float sigmoidf_(float x) { return 1.0f / (1.0f + __expf(-x)); }
DI float siluf_(float x) { return x / (1.0f + __expf(-x)); }

DI void tr_tile(const float* __restrict__ src, int ld_src, bf16_t* __restrict__ dst, int ld_dst, float* sm) {
  const int tid = tid_();
  const int r = tid >> 4, c4 = (tid & 15) * 4;
#pragma unroll
  for (int i = 0; i < 4; ++i) {
    const int row = r + 16 * i;
    f32x4 v = *(const f32x4*)(src + (size_t)row * ld_src + c4);
    sm[row * 65 + c4 + 0] = v[0]; sm[row * 65 + c4 + 1] = v[1]; sm[row * 65 + c4 + 2] = v[2]; sm[row * 65 + c4 + 3] = v[3];
  }
  __syncthreads();
  const int n = tid >> 2, ks = (tid & 3) * 16;
  u32x4 o0, o1;
  o0[0] = pk2(sm[(ks + 0) * 65 + n], sm[(ks + 1) * 65 + n]);   o0[1] = pk2(sm[(ks + 2) * 65 + n], sm[(ks + 3) * 65 + n]);
  o0[2] = pk2(sm[(ks + 4) * 65 + n], sm[(ks + 5) * 65 + n]);   o0[3] = pk2(sm[(ks + 6) * 65 + n], sm[(ks + 7) * 65 + n]);
  o1[0] = pk2(sm[(ks + 8) * 65 + n], sm[(ks + 9) * 65 + n]);   o1[1] = pk2(sm[(ks + 10) * 65 + n], sm[(ks + 11) * 65 + n]);
  o1[2] = pk2(sm[(ks + 12) * 65 + n], sm[(ks + 13) * 65 + n]); o1[3] = pk2(sm[(ks + 14) * 65 + n], sm[(ks + 15) * 65 + n]);
  *(u32x4*)(dst + (size_t)n * ld_dst + ks) = o0;
  *(u32x4*)(dst + (size_t)n * ld_dst + ks + 8) = o1;
  __syncthreads();
}

constexpr int WCONV_TILES = 1568 + 128 + 128 + 256 + 64 + 256 + 8 + 8;
DI void wconv_tile(const Params& p, int l, int t, float* sm) {
  const float* src; bf16_t* dst; int K, N;
  if (t < 1568) { src = p.w_in + (size_t)l * 1024 * NZ; dst = p.wt_in; K = 1024; N = NZ; }
  else if ((t -= 1568) < 128) { src = p.w_br_r + (size_t)l * 512 * 1024; dst = p.wt_brr; K = 512; N = 1024; }
  else if ((t -= 128) < 128) { src = p.w_br_a + (size_t)l * 512 * 1024; dst = p.wt_bra; K = 512; N = 1024; }
  else if ((t -= 128) < 256) { src = p.w_out + (size_t)l * 1024 * 1024; dst = p.wt_out; K = 1024; N = 1024; }
  else if ((t -= 256) < 64) { src = p.ple_w + (size_t)l * 256 * 1024; dst = p.wt_ple; K = 256; N = 1024; }
  else if ((t -= 64) < 256) { src = p.ple_gate_w + (size_t)l * 1024 * 1024; dst = p.wt_gate; K = 1024; N = 1024; }
  else if ((t -= 256) < 8) { src = p.decay_w2 + (size_t)l * 64 * 512; dst = p.w2t; K = 64; N = 512; }
  else { t -= 8; src = p.iclr_a2 + (size_t)l * 64 * 512; dst = p.a2t; K = 64; N = 512; }
  const int ntn = N / 64; const int tk = t / ntn, tn = t % ntn;
  tr_tile(src + (size_t)(tk * 64) * N + tn * 64, N, dst + (size_t)(tn * 64) * K + tk * 64, K, sm);
}

DI const float* x_row(const Params& p, int l, int r) {
  if (l == 0) return r < MP ? p.xp + (size_t)r * DM : p.xs + (size_t)(r - MP) * DM;
  return p.out + (size_t)r * DM;
}
DI void phase_norm(const Params& p, int l, bool first, char* lds) {
  const int tid = tid_(), wave = tid >> 6, lane = tid & 63;
  const float* g = (first ? p.norm_g : p.ple_norm_g) + l * DM;
  const int n_norm = MT / 4;
  const int n_items = n_norm + (first ? 2048 + WCONV_TILES : 0);
  for (int it = blockIdx.x; it < n_items; it += gridDim.x) {
    if (it < n_norm) {
      const int r = it * 4 + wave;
      const float* x = first ? x_row(p, l, r) : p.out + (size_t)r * DM;
      f32x4 v[4]; float ss = 0.f;
#pragma unroll
      for (int i = 0; i < 4; ++i) { v[i] = *(const f32x4*)(x + lane * 4 + 256 * i); ss += v[i][0] * v[i][0] + v[i][1] * v[i][1] + v[i][2] * v[i][2] + v[i][3] * v[i][3]; }
#pragma unroll
      for (int o = 32; o >= 1; o >>= 1) ss += __shfl_xor(ss, o);
      const float rstd = rsqrtf(ss * (1.0f / 1024.0f) + 1e-6f);
#pragma unroll
      for (int i = 0; i < 4; ++i) {
        const f32x4 gv = *(const f32x4*)(g + lane * 4 + 256 * i);
        u32x2 o; o[0] = pk2(v[i][0] * rstd * gv[0], v[i][1] * rstd * gv[1]); o[1] = pk2(v[i][2] * rstd * gv[2], v[i][3] * rstd * gv[3]);
        *(u32x2*)(p.hn + (size_t)r * DM + lane * 4 + 256 * i) = o;
      }
    } else if (it < n_norm + 1024) {
      const int c = it - n_norm;
      const float* src = p.ck + (size_t)l * 8 * 1024 * 512 + (size_t)c * 4096 + tid * 16;
      bf16_t* dst = p.kc + (size_t)c * 4096 + tid * 16;
      f32x4 a0 = *(const f32x4*)(src), a1 = *(const f32x4*)(src + 4), a2 = *(const f32x4*)(src + 8), a3 = *(const f32x4*)(src + 12);
      u32x4 o0, o1;
      o0[0] = pk2(a0[0], a0[1]); o0[1] = pk2(a0[2], a0[3]); o0[2] = pk2(a1[0], a1[1]); o0[3] = pk2(a1[2], a1[3]);
      o1[0] = pk2(a2[0], a2[1]); o1[1] = pk2(a2[2], a2[3]); o1[2] = pk2(a3[0], a3[1]); o1[3] = pk2(a3[2], a3[3]);
      *(u32x4*)dst = o0; *(u32x4*)(dst + 8) = o1;
    } else if (it >= n_norm + 2048) {
      wconv_tile(p, l, it - n_norm - 2048, (float*)lds);
    } else {
      const int c = it - n_norm - 1024;
      const int bh = c >> 5, tt = c & 31; const int b = bh >> 2, h = bh & 3; const int tk = tt >> 1, tn = tt & 1;
      const float* src = p.cv + (size_t)l * 8 * 1024 * 512 + ((size_t)(b * 1024 + tk * 64)) * 512 + h * 128 + tn * 64;
      bf16_t* dst = p.vct + ((size_t)(bh * 128 + tn * 64)) * 1024 + tk * 64;
      tr_tile(src, 512, dst, 1024, (float*)lds);
    }
  }
}

constexpr int GLD = 72;
template <bool A_F32>
DI void gemm_core(f32x4 (&acc)[4][4], const void* Ap, int lda, const bf16_t* Bp, int ldb, int K, char* lds) {
  bf16_t* As = (bf16_t*)lds;
  bf16_t* Bs = (bf16_t*)(lds + 2 * 128 * GLD * 2);
  const int tid = tid_(), wave = tid >> 6, lane = tid & 63;
  const int wm = wave >> 1, wn = wave & 1, l15 = lane & 15, quad = lane >> 4;
  const int nk = K / 64;
  u32x4 ra[4], rb[4];
  auto gload = [&](int kt) {
#pragma unroll
    for (int i = 0; i < 4; ++i) {
      const int c = tid + 256 * i; const int row = c >> 3, c8 = (c & 7) * 8;
      if (!A_F32) ra[i] = *(const u32x4*)((const bf16_t*)Ap + (size_t)row * lda + kt * 64 + c8);
      rb[i] = *(const u32x4*)(Bp + (size_t)row * ldb + kt * 64 + c8);
    }
  };
  auto sstore = [&](int buf, int kt) {
#pragma unroll
    for (int i = 0; i < 4; ++i) {
      const int c = tid + 256 * i; const int row = c >> 3, c8 = (c & 7) * 8;
      if (A_F32) {
        const float* a = (const float*)Ap + (size_t)row * lda + kt * 64 + c8;
        const f32x4 v0 = *(const f32x4*)a, v1 = *(const f32x4*)(a + 4);
        u32x4 t; t[0] = pk2(v0[0], v0[1]); t[1] = pk2(v0[2], v0[3]); t[2] = pk2(v1[0], v1[1]); t[3] = pk2(v1[2], v1[3]);
        *(u32x4*)(As + (buf * 128 + row) * GLD + c8) = t;
      } else {
        *(u32x4*)(As + (buf * 128 + row) * GLD + c8) = ra[i];
      }
      *(u32x4*)(Bs + (buf * 128 + row) * GLD + c8) = rb[i];
    }
  };
  gload(0); sstore(0, 0); __syncthreads();
  for (int kt = 0; kt < nk; ++kt) {
    const int buf = kt & 1;
    if (kt + 1 < nk) gload(kt + 1);
#pragma unroll
    for (int ks = 0; ks < 2; ++ks) {
      bf16x8 af[4], bfr[4];
#pragma unroll
      for (int i = 0; i < 4; ++i) {
        af[i] = *(const bf16x8*)(As + (buf * 128 + wm * 64 + i * 16 + l15) * GLD + ks * 32 + quad * 8);
        bfr[i] = *(const bf16x8*)(Bs + (buf * 128 + wn * 64 + i * 16 + l15) * GLD + ks * 32 + quad * 8);
      }
#pragma unroll
      for (int mi = 0; mi < 4; ++mi)
#pragma unroll
        for (int ni = 0; ni < 4; ++ni) acc[mi][ni] = __builtin_amdgcn_mfma_f32_16x16x32_bf16(bfr[ni], af[mi], acc[mi][ni], 0, 0, 0);
    }
    if (kt + 1 < nk) sstore(buf ^ 1, kt + 1);
    __syncthreads();
  }
}
DI void zero_acc(f32x4 (&acc)[4][4]) {
#pragma unroll
  for (int i = 0; i < 4; ++i)
#pragma unroll
    for (int j = 0; j < 4; ++j) acc[i][j] = (f32x4){0.f, 0.f, 0.f, 0.f};
}

DI void phase_gemm_in(const Params& p, int l, char* lds) {
  const int tid = tid_(), wave = tid >> 6, lane = tid & 63;
  const int wm = wave >> 1, wn = wave & 1, l15 = lane & 15, quad = lane >> 4;
  const bf16_t* Wt = p.wt_in;
  const int NTN = 49, NTM = 132;
  for (int tile = blockIdx.x; tile < NTN * NTM; tile += gridDim.x) {
    const int mt = tile / NTN, nt = tile % NTN;
    f32x4 acc[4][4]; zero_acc(acc);
    gemm_core<false>(acc, p.hn + (size_t)mt * 128 * DM, DM, Wt + (size_t)nt * 128 * DM, DM, DM, lds);
    const int colb = nt * 128 + wn * 64 + quad * 4;
    int kind;
    if (nt < 13) kind = 0; else if (nt < 17) kind = 1; else if (nt < 21) kind = 2; else if (nt < 25) kind = 3; else if (nt < 29) kind = 4; else if (nt < 33) kind = 1; else kind = 5;
#pragma unroll
    for (int mi = 0; mi < 4; ++mi) {
      const int R = mt * 128 + wm * 64 + mi * 16 + l15;
      const bool isp = R < MP; const int rs = R - MP;
      bf16_t* zrow = p.z + (size_t)R * NZ;
      if (kind == 0) {
        const bool last = isp ? ((R & 4095) == 4095) : ((rs & 63) == 63);
        float* so = isp ? p.out + O_SP + (size_t)(l * 4 + (R >> 12)) * SHC : p.out + O_SS + (size_t)(l * 8 + (rs >> 6)) * SHC;
#pragma unroll
        for (int ni = 0; ni < 4; ++ni) {
          const int c = colb + ni * 16; const f32x4 v = acc[mi][ni];
          u32x2 o; o[0] = pk2(v[0], v[1]); o[1] = pk2(v[2], v[3]); *(u32x2*)(zrow + c) = o;
          if (last) *(f32x4*)(so + c) = v;
        }
      } else if (kind == 1 || kind == 5) {
#pragma unroll
        for (int ni = 0; ni < 4; ++ni) {
          const int c = colb + ni * 16; f32x4 v = acc[mi][ni];
#pragma unroll
          for (int e = 0; e < 4; ++e) v[e] = (kind == 1) ? siluf_(v[e]) : sigmoidf_(v[e]);
          u32x2 o; o[0] = pk2(v[0], v[1]); o[1] = pk2(v[2], v[3]); *(u32x2*)(zrow + c) = o;
        }
      } else if (kind == 2 || kind == 3) {
        float ss = 0.f;
#pragma unroll
        for (int ni = 0; ni < 4; ++ni) { const f32x4 v = acc[mi][ni]; ss += v[0] * v[0] + v[1] * v[1] + v[2] * v[2] + v[3] * v[3]; }
        ss += __shfl_xor(ss, 16); ss += __shfl_xor(ss, 32);
        const float rstd = rsqrtf(ss * (1.0f / 64.0f) + 1e-6f);
        const float* g = (kind == 2 ? p.qng : p.kng) + l * 64;
        float* ko = isp ? p.out + O_KP + ((size_t)l * MP + R) * 512 : p.out + O_KS + ((size_t)l * MS + rs) * 512;
#pragma unroll
        for (int ni = 0; ni < 4; ++ni) {
          const int c = colb + ni * 16; const int d = ni * 16 + quad * 4;
          const f32x4 gv = *(const f32x4*)(g + d); f32x4 v = acc[mi][ni];
#pragma unroll
          for (int e = 0; e < 4; ++e) v[e] = v[e] * rstd * gv[e];
          u32x2 o; o[0] = pk2(v[0], v[1]); o[1] = pk2(v[2], v[3]); *(u32x2*)(zrow + c) = o;
          if (kind == 3) *(f32x4*)(ko + (c - C_K)) = v;
        }
      } else {
        float* vo = isp ? p.out + O_VP + ((size_t)l * MP + R) * 512 : p.out + O_VS + ((size_t)l * MS + rs) * 512;
#pragma unroll
        for (int ni = 0; ni < 4; ++ni) {
          const int cv = colb + ni * 16 - C_V; const f32x4 v = acc[mi][ni];
          *(f32x4*)(vo + cv) = v;
          const int h = cv >> 7, vd = cv & 127;
          if (isp) {
            bf16_t* vt = p.vtp + ((size_t)(((R >> 12) * 4 + h) * 128 + vd)) * 4096 + (R & 4095);
#pragma unroll
            for (int e = 0; e < 4; ++e) vt[(size_t)e * 4096] = (bf16_t)(pk2(v[e], 0.f) & 0xffff);
          } else {
            bf16_t* vt = p.vts + ((size_t)(((rs >> 6) * 4 + h) * 128 + vd)) * 64 + (rs & 63);
#pragma unroll
            for (int e = 0; e < 4; ++e) vt[(size_t)e * 64] = (bf16_t)(pk2(v[e], 0.f) & 0xffff);
          }
        }
      }
    }
  }
}

constexpr int NCH_P = 4096, NCH = 4224;
constexpr int XLD = 40;
DI f32x4 mm16(const bf16_t* Xrow, int ldx, const bf16_t* Yrow, int ldy, int ksteps, f32x4 acc, int l15, int quad) {
  for (int ks = 0; ks < ksteps; ++ks) {
    const bf16x8 a = *(const bf16x8*)(Xrow + l15 * ldx + ks * 32 + quad * 8);
    const bf16x8 b = *(const bf16x8*)(Yrow + l15 * ldy + ks * 32 + quad * 8);
    acc = __builtin_amdgcn_mfma_f32_16x16x32_bf16(a, b, acc, 0, 0, 0);
  }
  return acc;
}
DI void chunk_item(const Params& p, int l, int item, char* lds) {
  const int tid = tid_(), wave = tid >> 6, lane = tid & 63, l15 = lane & 15, quad = lane >> 4;
  const bool isp = item < NCH_P;
  int bh, c;
  if (isp) { bh = item >> 7; c = item & 127; } else { const int j = item - NCH_P; bh = j >> 1; c = j & 1; }
  const int b = bh >> 3, h = bh & 7;
  const int t0 = c * 32; const int row0 = (isp ? b * 4096 : MP + b * 64) + t0;
  float* s_r = (float*)lds;
  float* s_kf = s_r + 2048;
  float* s_v = s_kf + 2048;
  float* s_w = s_v + 2048;
  float* s_kk = s_w + 2048;
  float* s_bb = s_kk + 2048;
  bf16_t* s_wd = (bf16_t*)(lds + 49152);
  bf16_t* s_ad = (bf16_t*)(lds + 53760);
  float* s_bonus = (float*)(lds + 58368);
  float* s_wl = (float*)(lds + 58496);
  float* s_rhs = (float*)lds;
  bf16_t* s_A = (bf16_t*)lds;
  bf16_t* s_Bm = (bf16_t*)(lds + 4608);
  bf16_t* s_Kp = (bf16_t*)(lds + 9216);
  bf16_t* s_R = (bf16_t*)(lds + 16384);
  bf16_t* s_BmT = (bf16_t*)(lds + 20992);
  bf16_t* s_KpT = (bf16_t*)(lds + 26112);
  bf16_t* s_VmT = (bf16_t*)(lds + 31232);
  bf16_t* s_Lak = (bf16_t*)(lds + 36352);
  bf16_t* s_Mrk = (bf16_t*)(lds + 38912);
  bf16_t* s_Mrb = (bf16_t*)(lds + 41472);
  float* s_lab = (float*)(lds + 44032);
  bf16_t* s_XT = (bf16_t*)(lds + 48256);

  const int mat = wave >> 1, tt = wave & 1;
  const bf16_t* wl = (mat == 0 ? p.w2t : p.a2t) + (size_t)(h * 64) * 64;
  const float* mu = p.shift_mu + l * SHC;
  const float* w0 = p.decay_w0 + l * 512 + h * 64;
  const float* a0 = p.iclr_a0 + l * 512 + h * 64;
  const float* kkp = p.k_k + l * 512 + h * 64;
  const float* kap = p.k_a + l * 512 + h * 64;
  const float* rkp = p.r_k + l * 512 + h * 64;
  const float* lb = p.lnx_b + l * 512 + h * 64;
  const int ptok = tid >> 3, pcs = (tid & 7) * 8;
  {
    const int t = t0 + ptok; const size_t row = (size_t)(row0 + ptok);
#pragma unroll
    for (int g = 0; g < 5; ++g) {
      const int zc = (g < 3 ? g * 512 + h * 64 : 1536 + (g - 3) * 64) + pcs;
      const u32x4 cu = *(const u32x4*)(p.z + row * NZ + zc);
      float cur[8], prv[8];
#pragma unroll
      for (int e = 0; e < 4; ++e) { cur[2 * e] = bf_lo(cu[e]); cur[2 * e + 1] = bf_hi(cu[e]); }
      if (t > 0) {
        const u32x4 pu = *(const u32x4*)(p.z + (row - 1) * NZ + zc);
#pragma unroll
        for (int e = 0; e < 4; ++e) { prv[2 * e] = bf_lo(pu[e]); prv[2 * e + 1] = bf_hi(pu[e]); }
      } else if (isp) {
#pragma unroll
        for (int e = 0; e < 8; ++e) prv[e] = 0.f;
      } else {
        const float* sp = p.sshift + (size_t)(l * 8 + b) * SHC + zc;
#pragma unroll
        for (int e = 0; e < 8; ++e) prv[e] = sp[e];
      }
      float zs[8];
#pragma unroll
      for (int e = 0; e < 8; ++e) zs[e] = cur[e] + (prv[e] - cur[e]) * mu[zc + e];
      if (g < 3) {
        float* d = (g == 0 ? s_r : g == 1 ? s_kf : s_v) + ptok * 64 + pcs;
        *(f32x4*)d = (f32x4){zs[0], zs[1], zs[2], zs[3]}; *(f32x4*)(d + 4) = (f32x4){zs[4], zs[5], zs[6], zs[7]};
      } else {
        if (g == 3) {
#pragma unroll
          for (int e = 0; e < 8; ++e) { const float ex = __expf(2.f * zs[e]); zs[e] = 1.f - 2.f / (ex + 1.f); }
        }
        u32x4 o; o[0] = pk2(zs[0], zs[1]); o[1] = pk2(zs[2], zs[3]); o[2] = pk2(zs[4], zs[5]); o[3] = pk2(zs[6], zs[7]);
        *(u32x4*)((g == 3 ? s_wd : s_ad) + ptok * 72 + pcs) = o;
      }
    }
  }
  __syncthreads();
  {
    const bf16_t* At = (mat == 0 ? s_wd : s_ad);
    bf16x8 af[2];
#pragma unroll
    for (int ks = 0; ks < 2; ++ks) af[ks] = *(const bf16x8*)(At + (tt * 16 + l15) * 72 + ks * 32 + quad * 8);
#pragma unroll
    for (int ct = 0; ct < 4; ++ct) {
      f32x4 d = (f32x4){0.f, 0.f, 0.f, 0.f};
#pragma unroll
      for (int ks = 0; ks < 2; ++ks) {
        const bf16x8 wfr = *(const bf16x8*)(wl + (size_t)(ct * 16 + l15) * 64 + ks * 32 + quad * 8);
        d = __builtin_amdgcn_mfma_f32_16x16x32_bf16(wfr, af[ks], d, 0, 0, 0);
      }
      const int ch = ct * 16 + quad * 4; const int tok = tt * 16 + l15;
      f32x4 o;
      if (mat == 0) {
#pragma unroll
        for (int e = 0; e < 4; ++e) {
          const float y = -(w0[ch + e] + d[e]);
          const float sp = fmaxf(y, 0.f) + log1pf(__expf(-fabsf(y)));
          o[e] = -__expf(-sp - 0.5f);
        }
        *(f32x4*)(s_w + tok * 64 + ch) = o;
      } else {
#pragma unroll
        for (int e = 0; e < 4; ++e) o[e] = sigmoidf_(a0[ch + e] + d[e]);
        *(f32x4*)(s_bb + tok * 64 + ch) = o;
      }
    }
  }
  __syncthreads();
  float r_[8], kf[8], kk[8], bbv[8], v_[8], bon;
  {
    float k_[8], a_[8];
    *(f32x4*)&k_[0] = *(const f32x4*)(s_kf + ptok * 64 + pcs); *(f32x4*)&k_[4] = *(const f32x4*)(s_kf + ptok * 64 + pcs + 4);
    *(f32x4*)&a_[0] = *(const f32x4*)(s_bb + ptok * 64 + pcs); *(f32x4*)&a_[4] = *(const f32x4*)(s_bb + ptok * 64 + pcs + 4);
    *(f32x4*)&r_[0] = *(const f32x4*)(s_r + ptok * 64 + pcs); *(f32x4*)&r_[4] = *(const f32x4*)(s_r + ptok * 64 + pcs + 4);
    *(f32x4*)&v_[0] = *(const f32x4*)(s_v + ptok * 64 + pcs); *(f32x4*)&v_[4] = *(const f32x4*)(s_v + ptok * 64 + pcs + 4);
    float ss = 0.f; bon = 0.f;
#pragma unroll
    for (int e = 0; e < 8; ++e) {
      kk[e] = k_[e] * kkp[pcs + e]; ss += kk[e] * kk[e];
      kf[e] = k_[e] * (1.f + (a_[e] - 1.f) * kap[pcs + e]);
      bon += r_[e] * kf[e] * rkp[pcs + e];
    }
    ss += __shfl_xor(ss, 1); ss += __shfl_xor(ss, 2); ss += __shfl_xor(ss, 4);
    bon += __shfl_xor(bon, 1); bon += __shfl_xor(bon, 2); bon += __shfl_xor(bon, 4);
    const float inv = 1.0f / fmaxf(sqrtf(ss), 1e-12f);
#pragma unroll
    for (int e = 0; e < 8; ++e) { kk[e] *= inv; bbv[e] = kk[e] * a_[e]; }
  }
  if (tid < 64) {
    float run = 0.f;
#pragma unroll 8
    for (int t = 0; t < 32; ++t) { run += s_w[t * 64 + tid]; s_w[t * 64 + tid] = run; }
  }
  __syncthreads();
  {
    float cw[8], cwp[8];
    *(f32x4*)&cw[0] = *(const f32x4*)(s_w + ptok * 64 + pcs); *(f32x4*)&cw[4] = *(const f32x4*)(s_w + ptok * 64 + pcs + 4);
    if (ptok > 0) { *(f32x4*)&cwp[0] = *(const f32x4*)(s_w + (ptok - 1) * 64 + pcs); *(f32x4*)&cwp[4] = *(const f32x4*)(s_w + (ptok - 1) * 64 + pcs + 4); }
    else {
#pragma unroll
      for (int e = 0; e < 8; ++e) cwp[e] = 0.f;
    }
    __syncthreads();
    float av[8], bm[8], kp[8], rr[8];
#pragma unroll
    for (int e = 0; e < 8; ++e) {
      const float ec = __expf(cw[e]), en = __expf(-cw[e]), ep = __expf(cwp[e]);
      av[e] = kk[e] * ep; bm[e] = bbv[e] * en; kp[e] = kf[e] * en; rr[e] = r_[e] * ec;
      if (ptok == 31) s_wl[pcs + e] = ec;
    }
    u32x4 o;
    o[0] = pk2(av[0], av[1]); o[1] = pk2(av[2], av[3]); o[2] = pk2(av[4], av[5]); o[3] = pk2(av[6], av[7]); *(u32x4*)(s_A + ptok * 72 + pcs) = o;
    o[0] = pk2(bm[0], bm[1]); o[1] = pk2(bm[2], bm[3]); o[2] = pk2(bm[4], bm[5]); o[3] = pk2(bm[6], bm[7]); *(u32x4*)(s_Bm + ptok * 72 + pcs) = o;
#pragma unroll
    for (int e = 0; e < 4; ++e) { s_BmT[(pcs + 2 * e) * XLD + ptok] = (bf16_t)(o[e] & 0xffff); s_BmT[(pcs + 2 * e + 1) * XLD + ptok] = (bf16_t)(o[e] >> 16); }
    o[0] = pk2(kp[0], kp[1]); o[1] = pk2(kp[2], kp[3]); o[2] = pk2(kp[4], kp[5]); o[3] = pk2(kp[6], kp[7]); *(u32x4*)(s_Kp + ptok * 72 + pcs) = o;
#pragma unroll
    for (int e = 0; e < 4; ++e) { s_KpT[(pcs + 2 * e) * XLD + ptok] = (bf16_t)(o[e] & 0xffff); s_KpT[(pcs + 2 * e + 1) * XLD + ptok] = (bf16_t)(o[e] >> 16); }
    o[0] = pk2(rr[0], rr[1]); o[1] = pk2(rr[2], rr[3]); o[2] = pk2(rr[4], rr[5]); o[3] = pk2(rr[6], rr[7]); *(u32x4*)(s_R + ptok * 72 + pcs) = o;
    o[0] = pk2(v_[0], v_[1]); o[1] = pk2(v_[2], v_[3]); o[2] = pk2(v_[4], v_[5]); o[3] = pk2(v_[6], v_[7]);
#pragma unroll
    for (int e = 0; e < 4; ++e) { s_VmT[(pcs + 2 * e) * XLD + ptok] = (bf16_t)(o[e] & 0xffff); s_VmT[(pcs + 2 * e + 1) * XLD + ptok] = (bf16_t)(o[e] >> 16); }
    u32x4 ob;
    ob[0] = pk2(lb[pcs + 0] + bon * v_[0], lb[pcs + 1] + bon * v_[1]); ob[1] = pk2(lb[pcs + 2] + bon * v_[2], lb[pcs + 3] + bon * v_[3]);
    ob[2] = pk2(lb[pcs + 4] + bon * v_[4], lb[pcs + 5] + bon * v_[5]); ob[3] = pk2(lb[pcs + 6] + bon * v_[6], lb[pcs + 7] + bon * v_[7]);
    *(u32x4*)(p.cBA + ((size_t)item * 32 + ptok) * 64 + pcs) = ob;
  }
  __syncthreads();
  {
    const bf16_t* X = (wave < 2) ? s_A : s_R;
    const bf16_t* Y = (wave == 0 || wave == 3) ? s_Bm : s_Kp;
    const bool strict = wave < 2;
#pragma unroll
    for (int ti = 0; ti < 2; ++ti)
#pragma unroll
      for (int ii = 0; ii < 2; ++ii) {
        f32x4 d = (f32x4){0.f, 0.f, 0.f, 0.f};
        if (ii <= ti) d = mm16(X + ti * 16 * 72, 72, Y + ii * 16 * 72, 72, 2, d, l15, quad);
        const int i = ii * 16 + l15;
#pragma unroll
        for (int e = 0; e < 4; ++e) {
          const int t = ti * 16 + quad * 4 + e;
          const bool keep = strict ? (i < t) : (i <= t);
          const float val = keep ? d[e] : 0.f;
          if (wave == 0) s_lab[t * 33 + i] = val;
          else { bf16_t* dst = (wave == 1 ? s_Lak : wave == 2 ? s_Mrk : s_Mrb); dst[t * XLD + i] = (bf16_t)(pk2(val, 0.f) & 0xffff); }
        }
      }
  }
  const u32x4 acap = *(const u32x4*)(s_A + ptok * 72 + pcs);
  __syncthreads();
  {
    float* d = s_rhs + ptok * 128 + pcs;
    *(f32x4*)d = (f32x4){bf_lo(acap[0]), bf_hi(acap[0]), bf_lo(acap[1]), bf_hi(acap[1])};
    *(f32x4*)(d + 4) = (f32x4){bf_lo(acap[2]), bf_hi(acap[2]), bf_lo(acap[3]), bf_hi(acap[3])};
  }
  {
    const int ti = wave & 1;
#pragma unroll
    for (int vv = 0; vv < 2; ++vv) {
      const int vi = (wave >> 1) * 2 + vv;
      f32x4 d = (f32x4){0.f, 0.f, 0.f, 0.f};
      d = mm16(s_Lak + ti * 16 * XLD, XLD, s_VmT + vi * 16 * XLD, XLD, 1, d, l15, quad);
#pragma unroll
      for (int e = 0; e < 4; ++e) s_rhs[(ti * 16 + quad * 4 + e) * 128 + 64 + vi * 16 + l15] = d[e];
    }
  }
  __syncthreads();
  if (tid < 128) {
    float x[32];
#pragma unroll
    for (int t = 0; t < 32; ++t) {
      float a = s_rhs[t * 128 + tid];
#pragma unroll
      for (int i = 0; i < t; ++i) a -= s_lab[t * 33 + i] * x[i];
      x[t] = a;
    }
#pragma unroll
    for (int q4 = 0; q4 < 4; ++q4) {
      u32x4 o; o[0] = pk2(x[8 * q4], x[8 * q4 + 1]); o[1] = pk2(x[8 * q4 + 2], x[8 * q4 + 3]); o[2] = pk2(x[8 * q4 + 4], x[8 * q4 + 5]); o[3] = pk2(x[8 * q4 + 6], x[8 * q4 + 7]);
      *(u32x4*)(s_XT + tid * XLD + q4 * 8) = o;
    }
  }
  __syncthreads();
  {
    const f32x4 z4 = (f32x4){0.f, 0.f, 0.f, 0.f};
    bf16_t* gPT = p.cPT + (size_t)item * 4096;
    const float wl_c = s_wl[wave * 16 + l15];
#pragma unroll
    for (int k1t = 0; k1t < 4; ++k1t) {
      f32x4 d = mm16(s_XT + k1t * 16 * XLD, XLD, s_BmT + wave * 16 * XLD, XLD, 1, z4, l15, quad);
      const int k2 = wave * 16 + l15, k1 = k1t * 16 + quad * 4;
      float o[4];
#pragma unroll
      for (int e = 0; e < 4; ++e) o[e] = ((k1 + e == k2 ? 1.f : 0.f) - d[e]) * wl_c;
      u32x2 ov; ov[0] = pk2(o[0], o[1]); ov[1] = pk2(o[2], o[3]);
      *(u32x2*)(gPT + k2 * 64 + k1) = ov;
    }
    bf16_t* gG = p.cG + (size_t)item * 4096;
#pragma unroll
    for (int k2t = 0; k2t < 4; ++k2t) {
      const f32x4 d1 = mm16(s_KpT + k2t * 16 * XLD, XLD, s_VmT + wave * 16 * XLD, XLD, 1, z4, l15, quad);
      const f32x4 d2 = mm16(s_BmT + k2t * 16 * XLD, XLD, s_XT + (64 + wave * 16) * XLD, XLD, 1, z4, l15, quad);
      const int k2 = k2t * 16 + quad * 4, v = wave * 16 + l15;
      const f32x4 wv = *(const f32x4*)(s_wl + k2);
      u32x2 ov; ov[0] = pk2((d1[0] - d2[0]) * wv[0], (d1[1] - d2[1]) * wv[1]); ov[1] = pk2((d1[2] - d2[2]) * wv[2], (d1[3] - d2[3]) * wv[3]);
      *(u32x2*)(gG + v * 64 + k2) = ov;
    }
    bf16_t* gRT = p.cRT + (size_t)item * 2048;
    bf16_t* gOI = p.cOI + (size_t)item * 2048;
#pragma unroll
    for (int ti = 0; ti < 2; ++ti) {
      const f32x4 d = mm16(s_XT + wave * 16 * XLD, XLD, s_Mrb + ti * 16 * XLD, XLD, 1, z4, l15, quad);
      const int t = ti * 16 + l15, k = wave * 16 + quad * 4;
      const u32x2 rv = *(const u32x2*)(s_R + t * 72 + k);
      u32x2 ov; ov[0] = pk2(bf_lo(rv[0]) - d[0], bf_hi(rv[0]) - d[1]); ov[1] = pk2(bf_lo(rv[1]) - d[2], bf_hi(rv[1]) - d[3]);
      *(u32x2*)(gRT + t * 64 + k) = ov;
      const f32x4 e1 = mm16(s_VmT + wave * 16 * XLD, XLD, s_Mrk + ti * 16 * XLD, XLD, 1, z4, l15, quad);
      const f32x4 e2 = mm16(s_XT + (64 + wave * 16) * XLD, XLD, s_Mrb + ti * 16 * XLD, XLD, 1, z4, l15, quad);
      u32x2 oo; oo[0] = pk2(e1[0] - e2[0], e1[1] - e2[1]); oo[1] = pk2(e1[2] - e2[2], e1[3] - e2[3]);
      *(u32x2*)(gOI + t * 64 + k) = oo;
    }
  }
  __syncthreads();
}

DI void rec_item(const Params& p, int l, int item, char* lds) {
  const int tid = tid_(), wave = tid >> 6, lane = tid & 63, l15 = lane & 15, quad = lane >> 4;
  const bool isp = item < 32;
  const int bh = isp ? item : item - 32; const int b = bh >> 3, h = bh & 7;
  const int nch = isp ? 128 : 2; const int cid0 = isp ? bh * 128 : NCH_P + bh * 2;
  const int row0 = isp ? b * 4096 : MP + b * 64;
  bf16_t* Sb = (bf16_t*)lds;
  const int v = wave * 16 + l15;
  f32x4 acc[4];
  if (isp) {
#pragma unroll
    for (int nk = 0; nk < 4; ++nk) acc[nk] = (f32x4){0.f, 0.f, 0.f, 0.f};
  } else {
    const float* sp = p.swkv + (((size_t)(l * 8 + b) * 8 + h) * 64 + v) * 64;
#pragma unroll
    for (int nk = 0; nk < 4; ++nk) acc[nk] = *(const f32x4*)(sp + nk * 16 + quad * 4);
  }
#pragma unroll
  for (int nk = 0; nk < 4; ++nk) { u32x2 o; o[0] = pk2(acc[nk][0], acc[nk][1]); o[1] = pk2(acc[nk][2], acc[nk][3]); *(u32x2*)(Sb + v * 72 + nk * 16 + quad * 4) = o; }
  __syncthreads();
  const float* lg = p.lnx_g + l * 512 + h * 64;
  for (int c = 0; c < nch; ++c) {
    const int buf = c & 1; const size_t cid = (size_t)(cid0 + c);
    const bf16_t* gPT = p.cPT + cid * 4096; const bf16_t* gG = p.cG + cid * 4096;
    bf16x8 pt[4][2]; u32x2 gv[4];
#pragma unroll
    for (int nk = 0; nk < 4; ++nk) {
#pragma unroll
      for (int ks = 0; ks < 2; ++ks) pt[nk][ks] = *(const bf16x8*)(gPT + (nk * 16 + l15) * 64 + ks * 32 + quad * 8);
      gv[nk] = *(const u32x2*)(gG + v * 64 + nk * 16 + quad * 4);
    }
    bf16x8 rt[2]; u32x2 oi[4], ba[4], gt[4];
    const int tok = (wave & 1) * 16 + l15; const size_t row = (size_t)(row0 + c * 32 + tok);
    if (wave < 2) {
#pragma unroll
      for (int ks = 0; ks < 2; ++ks) rt[ks] = *(const bf16x8*)(p.cRT + cid * 2048 + tok * 64 + ks * 32 + quad * 8);
#pragma unroll
      for (int vt = 0; vt < 4; ++vt) {
        oi[vt] = *(const u32x2*)(p.cOI + cid * 2048 + tok * 64 + vt * 16 + quad * 4);
        ba[vt] = *(const u32x2*)(p.cBA + cid * 2048 + tok * 64 + vt * 16 + quad * 4);
        gt[vt] = *(const u32x2*)(p.z + row * NZ + C_GR + h * 64 + vt * 16 + quad * 4);
      }
    }
    bf16x8 sf[2];
#pragma unroll
    for (int ks = 0; ks < 2; ++ks) sf[ks] = *(const bf16x8*)(Sb + (buf * 64 + v) * 72 + ks * 32 + quad * 8);
#pragma unroll
    for (int nk = 0; nk < 4; ++nk) {
      f32x4 a = (f32x4){bf_lo(gv[nk][0]), bf_hi(gv[nk][0]), bf_lo(gv[nk][1]), bf_hi(gv[nk][1])};
#pragma unroll
      for (int ks = 0; ks < 2; ++ks) a = __builtin_amdgcn_mfma_f32_16x16x32_bf16(pt[nk][ks], sf[ks], a, 0, 0, 0);
      acc[nk] = a;
    }
    f32x4 ao[4];
    if (wave < 2) {
#pragma unroll
      for (int vt = 0; vt < 4; ++vt) {
        f32x4 a = (f32x4){bf_lo(oi[vt][0]), bf_hi(oi[vt][0]), bf_lo(oi[vt][1]), bf_hi(oi[vt][1])};
#pragma unroll
        for (int ks = 0; ks < 2; ++ks) {
          const bf16x8 sa = *(const bf16x8*)(Sb + (buf * 64 + vt * 16 + l15) * 72 + ks * 32 + quad * 8);
          a = __builtin_amdgcn_mfma_f32_16x16x32_bf16(sa, rt[ks], a, 0, 0, 0);
        }
        ao[vt] = a;
      }
    }
#pragma unroll
    for (int nk = 0; nk < 4; ++nk) { u32x2 o; o[0] = pk2(acc[nk][0], acc[nk][1]); o[1] = pk2(acc[nk][2], acc[nk][3]); *(u32x2*)(Sb + ((buf ^ 1) * 64 + v) * 72 + nk * 16 + quad * 4) = o; }
    __syncthreads();
    if (wave < 2) {
      float sm = 0.f;
#pragma unroll
      for (int vt = 0; vt < 4; ++vt) sm += (ao[vt][0] + ao[vt][1]) + (ao[vt][2] + ao[vt][3]);
      sm += __shfl_xor(sm, 16); sm += __shfl_xor(sm, 32);
      const float mean = sm * (1.0f / 64.0f);
      float vr = 0.f;
#pragma unroll
      for (int vt = 0; vt < 4; ++vt)
#pragma unroll
        for (int e = 0; e < 4; ++e) { const float d = ao[vt][e] - mean; vr += d * d; }
      vr += __shfl_xor(vr, 16); vr += __shfl_xor(vr, 32);
      const float rstd = rsqrtf(vr * (1.0f / 64.0f) + 64e-5f);
#pragma unroll
      for (int vt = 0; vt < 4; ++vt) {
        const int vv = vt * 16 + quad * 4;
        const f32x4 g4 = *(const f32x4*)(lg + vv);
        const float y0 = ((ao[vt][0] - mean) * rstd * g4[0] + bf_lo(ba[vt][0])) * bf_lo(gt[vt][0]);
        const float y1 = ((ao[vt][1] - mean) * rstd * g4[1] + bf_hi(ba[vt][0])) * bf_hi(gt[vt][0]);
        const float y2 = ((ao[vt][2] - mean) * rstd * g4[2] + bf_lo(ba[vt][1])) * bf_lo(gt[vt][1]);
        const float y3 = ((ao[vt][3] - mean) * rstd * g4[3] + bf_hi(ba[vt][1])) * bf_hi(gt[vt][1]);
        u32x2 ov; ov[0] = pk2(y0, y1); ov[1] = pk2(y2, y3);
        *(u32x2*)(p.o_r + row * 512 + h * 64 + vv) = ov;
      }
    }
  }
  float* so = (isp ? p.out + O_WP + (((size_t)(l * 4 + b) * 8 + h) * 64 + v) * 64 : p.out + O_WS + (((size_t)(l * 8 + b) * 8 + h) * 64 + v) * 64);
#pragma unroll
  for (int nk = 0; nk < 4; ++nk) *(f32x4*)(so + nk * 16 + quad * 4) = acc[nk];
  __syncthreads();
}
DI void phase_chunk(const Params& p, int l, char* lds) {
  for (int it = blockIdx.x; it < NCH; it += gridDim.x) chunk_item(p, l, it, lds);
}

constexpr int ALD = 72;
DI void attn_item(const Params& p, int l, int item, char* lds) {
  const int tid = tid_(), wave = tid >> 6, lane = tid & 63;
  const int m = wave & 1, qh = wave >> 1, q = lane & 31, hh = lane >> 5;
  bf16_t* Ks = (bf16_t*)lds;
  bf16_t* Vs = Ks + 2 * 64 * ALD;
  float* xb = (float*)lds;
  bool samp; int b, h, nch, qrow0, qpos0;
  if (item < 32) { samp = true; b = item >> 2; h = item & 3; nch = 17; qrow0 = MP + b * 64; qpos0 = 1024; }
  else { samp = false; const int a = item - 32; const int qc = 63 - (a >> 4); const int bh = a & 15; b = bh >> 2; h = bh & 3; nch = qc + 1; qrow0 = b * 4096 + qc * 64; qpos0 = qc * 64; }
  bf16x8 qf[4];
  {
    const bf16_t* qp = p.z + (size_t)(qrow0 + qh * 32 + q) * NZ + C_Q + h * 128 + m * 64;
#pragma unroll
    for (int ks = 0; ks < 4; ++ks) qf[ks] = *(const bf16x8*)(qp + ks * 16 + hh * 8);
  }
  const float slope = exp2f(-2.0f * (float)(h + 1));
  const float LOG2E = 1.4426950408889634f;
  const float c1 = 0.125f * LOG2E, sl2 = slope * LOG2E;
  const float qposf = (float)(qpos0 + qh * 32 + q);
  f32x16 O[4];
#pragma unroll
  for (int i = 0; i < 4; ++i)
#pragma unroll
    for (int e = 0; e < 16; ++e) O[i][e] = 0.f;
  float mrun = -1e30f, lrun = 0.f;
  u32x4 rk[4], rv[4];
  auto gload = [&](int j) {
    const bf16_t* kb; size_t kld; const bf16_t* vb; size_t vld;
    if (!samp) { kb = p.z + (size_t)(b * 4096 + j * 64) * NZ + C_K + h * 128; kld = NZ; vb = p.vtp + (size_t)((b * 4 + h) * 128) * 4096 + j * 64; vld = 4096; }
    else if (j < 16) { kb = p.kc + (size_t)(b * 1024 + j * 64) * 512 + h * 128; kld = 512; vb = p.vct + (size_t)((b * 4 + h) * 128) * 1024 + j * 64; vld = 1024; }
    else { kb = p.z + (size_t)(MP + b * 64) * NZ + C_K + h * 128; kld = NZ; vb = p.vts + (size_t)((b * 4 + h) * 128) * 64; vld = 64; }
#pragma unroll
    for (int i = 0; i < 4; ++i) {
      const int c = tid + 256 * i;
      const int mm = c >> 9, key = (c >> 3) & 63, d8 = (c & 7) * 8;
      rk[i] = *(const u32x4*)(kb + (size_t)key * kld + mm * 64 + d8);
      const int vd = c >> 3, k8 = (c & 7) * 8;
      rv[i] = *(const u32x4*)(vb + (size_t)vd * vld + k8);
    }
  };
  auto sstore = [&]() {
#pragma unroll
    for (int i = 0; i < 4; ++i) {
      const int c = tid + 256 * i;
      const int mm = c >> 9, key = (c >> 3) & 63, d8 = (c & 7) * 8;
      *(u32x4*)(Ks + (mm * 64 + key) * ALD + d8) = rk[i];
      const int vd = c >> 3, k8 = (c & 7) * 8;
      *(u32x4*)(Vs + vd * ALD + k8) = rv[i];
    }
  };
  gload(0); sstore(); __syncthreads();
  for (int j = 0; j < nch; ++j) {
    if (j + 1 < nch) gload(j + 1);
    f32x16 s[2];
#pragma unroll
    for (int kt = 0; kt < 2; ++kt) {
#pragma unroll
      for (int e = 0; e < 16; ++e) s[kt][e] = 0.f;
#pragma unroll
      for (int ks = 0; ks < 4; ++ks) {
        const bf16x8 kf = *(const bf16x8*)(Ks + (m * 64 + kt * 32 + q) * ALD + ks * 16 + hh * 8);
        s[kt] = __builtin_amdgcn_mfma_f32_32x32x16_bf16(kf, qf[ks], s[kt], 0, 0, 0);
      }
    }
    float mx = -1e30f;
#pragma unroll
    for (int kt = 0; kt < 2; ++kt)
#pragma unroll
      for (int e = 0; e < 16; ++e) {
        const float kpos = (float)(j * 64 + kt * 32 + (e & 3) + 8 * (e >> 2) + 4 * hh);
        const float v = s[kt][e] * c1 - sl2 * fabsf(qposf - kpos);
        s[kt][e] = v; mx = fmaxf(mx, v);
      }
    mx = fmaxf(mx, __shfl_xor(mx, 32));
    const float mnew = fmaxf(mrun, mx);
    const float alpha = exp2f(mrun - mnew);
    mrun = mnew;
    float ps = 0.f;
#pragma unroll
    for (int kt = 0; kt < 2; ++kt)
#pragma unroll
      for (int e = 0; e < 16; ++e) { const float pe = exp2f(s[kt][e] - mnew); s[kt][e] = pe; ps += pe; }
    lrun = lrun * alpha + ps;
#pragma unroll
    for (int i = 0; i < 4; ++i)
#pragma unroll
      for (int e = 0; e < 16; ++e) O[i][e] *= alpha;
#pragma unroll
    for (int kt = 0; kt < 2; ++kt)
#pragma unroll
      for (int sx = 0; sx < 2; ++sx) {
        u32x4 pb;
        pb[0] = pk2(s[kt][8 * sx + 0], s[kt][8 * sx + 1]); pb[1] = pk2(s[kt][8 * sx + 2], s[kt][8 * sx + 3]);
        pb[2] = pk2(s[kt][8 * sx + 4], s[kt][8 * sx + 5]); pb[3] = pk2(s[kt][8 * sx + 6], s[kt][8 * sx + 7]);
        const bf16x8 pf = __builtin_bit_cast(bf16x8, pb);
#pragma unroll
        for (int vt = 0; vt < 4; ++vt) {
          const bf16_t* vp = Vs + (vt * 32 + q) * ALD + kt * 32 + 16 * sx + 4 * hh;
          const s16x4 lo = *(const s16x4*)vp, hi = *(const s16x4*)(vp + 8);
          const bf16x8 vf = __builtin_shufflevector(lo, hi, 0, 1, 2, 3, 4, 5, 6, 7);
          O[vt] = __builtin_amdgcn_mfma_f32_32x32x16_bf16(vf, pf, O[vt], 0, 0, 0);
        }
      }
    __syncthreads();
    if (j + 1 < nch) sstore();
    __syncthreads();
  }
  const float ltot = lrun + __shfl_xor(lrun, 32);
  const float inv = 1.0f / ltot;
#pragma unroll
  for (int i = 0; i < 4; ++i)
#pragma unroll
    for (int e = 0; e < 16; ++e) O[i][e] *= inv;
  if (m == 1) {
#pragma unroll
    for (int vt = 0; vt < 4; ++vt)
#pragma unroll
      for (int e = 0; e < 16; ++e) { const int vd = vt * 32 + (e & 3) + 8 * (e >> 2) + 4 * hh; xb[(qh * 128 + vd) * 32 + q] = O[vt][e]; }
  }
  __syncthreads();
  if (m == 0) {
    float d1 = 0.f, d2 = 0.f;
    for (int i = 0; i < 64; ++i) { d1 += p.lq1[l * 64 + i] * p.lk1[l * 64 + i]; d2 += p.lq2[l * 64 + i] * p.lk2[l * 64 + i]; }
    const float lam_init = 0.8f - 0.6f * __expf(-0.3f * (float)l);
    const float lam = __expf(d1) - __expf(d2) + lam_init;
    float ss = 0.f;
#pragma unroll
    for (int vt = 0; vt < 4; ++vt)
#pragma unroll
      for (int e = 0; e < 16; ++e) {
        const int vd = vt * 32 + (e & 3) + 8 * (e >> 2) + 4 * hh;
        const float o2 = xb[(qh * 128 + vd) * 32 + q];
        const float o = O[vt][e] - lam * o2; O[vt][e] = o; ss += o * o;
      }
    ss += __shfl_xor(ss, 32);
    const float rstd = rsqrtf(ss * (1.0f / 128.0f) + 1e-5f) * (1.0f - lam_init);
    const size_t row = (size_t)(qrow0 + qh * 32 + q);
    const float* sg = p.subln_g + l * 128;
#pragma unroll
    for (int vt = 0; vt < 4; ++vt)
#pragma unroll
      for (int e4 = 0; e4 < 4; ++e4) {
        const int vd = vt * 32 + 8 * e4 + 4 * hh;
        const u32x2 gu = *(const u32x2*)(p.z + row * NZ + C_GA + h * 128 + vd);
        const f32x4 gv = *(const f32x4*)(sg + vd);
        const float y0 = O[vt][4 * e4 + 0] * rstd * gv[0] * bf_lo(gu[0]);
        const float y1 = O[vt][4 * e4 + 1] * rstd * gv[1] * bf_hi(gu[0]);
        const float y2 = O[vt][4 * e4 + 2] * rstd * gv[2] * bf_lo(gu[1]);
        const float y3 = O[vt][4 * e4 + 3] * rstd * gv[3] * bf_hi(gu[1]);
        u32x2 ov; ov[0] = pk2(y0, y1); ov[1] = pk2(y2, y3);
        *(u32x2*)(p.o_a + row * 512 + h * 128 + vd) = ov;
      }
  }
  __syncthreads();
}

DI void phase_mix(const Params& p, int l, char* lds) {
  const int n_scan = 96, n_attn = 32 + 1024;
  for (int it = blockIdx.x; it < n_scan + n_attn; it += gridDim.x) {
    if (it < n_scan) rec_item(p, l, it, lds); else attn_item(p, l, it - n_scan, lds);
  }
}

DI void phase_merge(const Params& p, int l, char* lds) {
  const int tid = tid_(), wave = tid >> 6, lane = tid & 63;
  const int wm = wave >> 1, wn = wave & 1, l15 = lane & 15, quad = lane >> 4;
  for (int tile = blockIdx.x; tile < 132 * 8; tile += gridDim.x) {
    const int mt = tile >> 3, nt = tile & 7;
    f32x4 a1[4][4]; zero_acc(a1);
    gemm_core<false>(a1, p.o_r + (size_t)mt * 128 * 512, 512, p.wt_brr + (size_t)nt * 128 * 512, 512, 512, lds);
    u32x2 pk[4][4];
#pragma unroll
    for (int mi = 0; mi < 4; ++mi) {
      const int R = mt * 128 + wm * 64 + mi * 16 + l15;
#pragma unroll
      for (int ni = 0; ni < 4; ++ni) {
        const int c = nt * 128 + wn * 64 + ni * 16 + quad * 4;
        const u32x2 g1 = *(const u32x2*)(p.z + (size_t)R * NZ + C_MR + c);
        const f32x4 v1 = a1[mi][ni];
        pk[mi][ni][0] = pk2(bf_lo(g1[0]) * v1[0], bf_hi(g1[0]) * v1[1]);
        pk[mi][ni][1] = pk2(bf_lo(g1[1]) * v1[2], bf_hi(g1[1]) * v1[3]);
      }
    }
    zero_acc(a1);
    gemm_core<false>(a1, p.o_a + (size_t)mt * 128 * 512, 512, p.wt_bra + (size_t)nt * 128 * 512, 512, 512, lds);
#pragma unroll
    for (int mi = 0; mi < 4; ++mi) {
      const int R = mt * 128 + wm * 64 + mi * 16 + l15;
#pragma unroll
      for (int ni = 0; ni < 4; ++ni) {
        const int c = nt * 128 + wn * 64 + ni * 16 + quad * 4;
        const u32x2 g2 = *(const u32x2*)(p.z + (size_t)R * NZ + C_MA + c);
        const f32x4 v2 = a1[mi][ni]; const u32x2 u1 = pk[mi][ni];
        u32x2 o;
        o[0] = pk2(bf_lo(u1[0]) + bf_lo(g2[0]) * v2[0], bf_hi(u1[0]) + bf_hi(g2[0]) * v2[1]);
        o[1] = pk2(bf_lo(u1[1]) + bf_lo(g2[1]) * v2[2], bf_hi(u1[1]) + bf_hi(g2[1]) * v2[3]);
        *(u32x2*)(p.hn + (size_t)R * DM + c) = o;
      }
    }
  }
}
DI void phase_out(const Params& p, int l, char* lds) {
  const int tid = tid_(), wave = tid >> 6, lane = tid & 63;
  const int wm = wave >> 1, wn = wave & 1, l15 = lane & 15, quad = lane >> 4;
  for (int tile = blockIdx.x; tile < 132 * 8; tile += gridDim.x) {
    const int mt = tile >> 3, nt = tile & 7;
    f32x4 acc[4][4]; zero_acc(acc);
    gemm_core<false>(acc, p.hn + (size_t)mt * 128 * DM, DM, p.wt_out + (size_t)nt * 128 * DM, DM, DM, lds);
#pragma unroll
    for (int mi = 0; mi < 4; ++mi) {
      const int R = mt * 128 + wm * 64 + mi * 16 + l15;
      const float* xr = x_row(p, l, R);
#pragma unroll
      for (int ni = 0; ni < 4; ++ni) {
        const int c = nt * 128 + wn * 64 + ni * 16 + quad * 4;
        const f32x4 xv = *(const f32x4*)(xr + c);
        *(f32x4*)(p.out + (size_t)R * DM + c) = xv + acc[mi][ni];
      }
    }
  }
}
DI void phase_ple(const Params& p, int l, char* lds) {
  const int tid = tid_(), wave = tid >> 6, lane = tid & 63;
  const int wm = wave >> 1, wn = wave & 1, l15 = lane & 15, quad = lane >> 4;
  for (int tile = blockIdx.x; tile < 132 * 8; tile += gridDim.x) {
    const int mt = tile >> 3, nt = tile & 7;
    f32x4 a1[4][4]; zero_acc(a1);
    gemm_core<false>(a1, p.hn + (size_t)mt * 128 * DM, DM, p.wt_gate + (size_t)nt * 128 * DM, DM, DM, lds);
    u32x2 pk[4][4];
#pragma unroll
    for (int mi = 0; mi < 4; ++mi)
#pragma unroll
      for (int ni = 0; ni < 4; ++ni) { const f32x4 v = a1[mi][ni]; pk[mi][ni][0] = pk2(sigmoidf_(v[0]), sigmoidf_(v[1])); pk[mi][ni][1] = pk2(sigmoidf_(v[2]), sigmoidf_(v[3])); }
    zero_acc(a1);
    const int r0 = mt * 128;
    const float* pa = r0 < MP ? p.pp + ((size_t)l * MP + r0) * 256 : p.ps + ((size_t)l * MS + (r0 - MP)) * 256;
    gemm_core<true>(a1, pa, 256, p.wt_ple + (size_t)nt * 128 * 256, 256, 256, lds);
#pragma unroll
    for (int mi = 0; mi < 4; ++mi) {
      const int R = mt * 128 + wm * 64 + mi * 16 + l15;
#pragma unroll
      for (int ni = 0; ni < 4; ++ni) {
        const int c = nt * 128 + wn * 64 + ni * 16 + quad * 4;
        float* xo = p.out + (size_t)R * DM + c;
        const f32x4 xv = *(const f32x4*)xo; const f32x4 e = a1[mi][ni]; const u32x2 g = pk[mi][ni];
        f32x4 o;
        o[0] = xv[0] + e[0] * bf_lo(g[0]); o[1] = xv[1] + e[1] * bf_hi(g[0]);
        o[2] = xv[2] + e[2] * bf_lo(g[1]); o[3] = xv[3] + e[3] * bf_hi(g[1]);
        *(f32x4*)xo = o;
      }
    }
  }
}


#define XB_TMO      128
#define XB_XCNT(j)  (256  + 64 * (j))
#define XB_XSUB(j)  (1280 + 64 * (j))
#define XB_XGEN(j)  (2304 + 64 * (j))
#define XB_TOP      3328
#define XB_TOPGEN   3392
#define XCD_BAR_WORDS 3456
#define XB_SPIN_CAP (1u << 18)
#define LAS __attribute__((address_space(3)))
DI unsigned xb_ld(unsigned* p)              { return __hip_atomic_load(p, __ATOMIC_RELAXED, __HIP_MEMORY_SCOPE_AGENT); }
DI unsigned xb_add(unsigned* p, unsigned v) { return __hip_atomic_fetch_add(p, v, __ATOMIC_RELAXED, __HIP_MEMORY_SCOPE_AGENT); }
DI unsigned xb_xcc_id() { return (unsigned)__builtin_amdgcn_s_getreg((3 << 11) | 20) & 0xFu; }
#define XB_SPIN(cond, bar) do { unsigned _sp = 0; while (cond) { __builtin_amdgcn_s_sleep(1); \
    if ((++_sp & 255u) == 0u) { if (xb_ld(&(bar)[XB_TMO])) break; if (_sp > XB_SPIN_CAP) { atomicAdd(&(bar)[XB_TMO], 1u); break; } } } } while (0)
struct XcdBarrier { unsigned* bar; unsigned x; volatile LAS unsigned* st; };
DI XcdBarrier xcd_barrier_post(unsigned* bar, volatile LAS unsigned* st) {
  XcdBarrier b; b.bar = bar; b.x = xb_xcc_id(); b.st = st;
  if (threadIdx.x == 0) (void)xb_add(&bar[XB_XCNT(b.x)], 1u);
  return b;
}
DI void xcd_barrier_complete(unsigned* bar, unsigned x, unsigned& nloc, unsigned& nx) {
  const unsigned G = gridDim.x * gridDim.y * gridDim.z;
  unsigned sum, cnt, mine, sp = 0u;
  for (;;) {
    sum = 0u; cnt = 0u; mine = 0u;
#pragma unroll
    for (unsigned j = 0; j < 16; ++j) { const unsigned c = xb_ld(&bar[XB_XCNT(j)]); sum += c; cnt += (c > 0u) ? 1u : 0u; mine = (j == x) ? c : mine; }
    if (sum == G) break;
    __builtin_amdgcn_s_sleep(1);
    if ((++sp & 255u) == 0u) { if (xb_ld(&bar[XB_TMO])) break; if (sp > XB_SPIN_CAP) { atomicAdd(&bar[XB_TMO], 1u); break; } }
  }
  nloc = mine > 0u ? mine : 1u; nx = cnt > 0u ? cnt : 1u;
}
DI void xcd_barrier(const XcdBarrier& b) {
  asm volatile("s_waitcnt vmcnt(0)" ::: "memory");
  __syncthreads();
  if (threadIdx.x == 0) {
    unsigned* bar = b.bar;
    __builtin_amdgcn_s_waitcnt(0);
    unsigned nloc = b.st[0], nx = b.st[1];
    if (nloc == 0u) { xcd_barrier_complete(bar, b.x, nloc, nx); b.st[0] = nloc; b.st[1] = nx; }
    const unsigned old = xb_add(&bar[XB_XSUB(b.x)], 1u);
    const unsigned gen = old / nloc;
    if (old + 1u == (gen + 1u) * nloc) {
      __builtin_amdgcn_fence(__ATOMIC_RELEASE, "agent");
      asm volatile("s_waitcnt vmcnt(0)" ::: "memory");
      const unsigned og = xb_add(&bar[XB_TOP], 1u);
      const unsigned tg = og / nx;
      if (og + 1u == (tg + 1u) * nx) xb_add(&bar[XB_TOPGEN], 1u);
      else XB_SPIN(xb_ld(&bar[XB_TOPGEN]) == tg, bar);
      __builtin_amdgcn_fence(__ATOMIC_ACQUIRE, "agent");
      xb_add(&bar[XB_XGEN(b.x)], 1u);
      asm volatile("s_waitcnt vmcnt(0)" ::: "memory");
    } else {
      XB_SPIN(xb_ld(&bar[XB_XGEN(b.x)]) == gen, bar);
      __builtin_amdgcn_fence(__ATOMIC_ACQUIRE, "agent");
      asm volatile("s_waitcnt vmcnt(0)" ::: "memory");
    }
  }
  __syncthreads();
}
constexpr int LDS_BYTES = 73728;
DI void run_phase(const Params& p, int ph, int l, char* lds) {
  switch (ph) {
    case 1: phase_norm(p, l, true, lds); break;
    case 2: phase_gemm_in(p, l, lds); break;
    case 3: phase_mix(p, l, lds); break;
    case 4: phase_merge(p, l, lds); break;
    case 5: phase_out(p, l, lds); break;
    case 6: phase_norm(p, l, false, lds); break;
    case 7: phase_ple(p, l, lds); break;
    case 8: phase_chunk(p, l, lds); break;
  }
}

#if MEGA
__global__ void __launch_bounds__(256, 2) k_mega(Params p) {
  __shared__ __attribute__((aligned(16))) char lds[LDS_BYTES];
  __shared__ uint4 xb_words;
  cg::grid_group grid = cg::this_grid();
  if (threadIdx.x == 0) xb_words = make_uint4(0u, 0u, 0u, 0u);
  __syncthreads();
  const XcdBarrier xb = xcd_barrier_post(p.bar, (volatile LAS unsigned*)&xb_words);
#pragma unroll 1
  for (int l = 0; l < NL; ++l) {
    phase_norm(p, l, true, lds);
    if (l == 0) grid.sync(); else xcd_barrier(xb);
    phase_gemm_in(p, l, lds); xcd_barrier(xb);
    phase_chunk(p, l, lds); xcd_barrier(xb);
    phase_mix(p, l, lds); xcd_barrier(xb);
    phase_merge(p, l, lds); xcd_barrier(xb);
    phase_out(p, l, lds); xcd_barrier(xb);
    phase_norm(p, l, false, lds); xcd_barrier(xb);
    phase_ple(p, l, lds); if (l + 1 < NL) xcd_barrier(xb);
  }
}
#else
template <int PH>
__global__ void __launch_bounds__(256, 2) k_phase(Params p, int l) {
  __shared__ __attribute__((aligned(16))) char lds[LDS_BYTES];
  run_phase(p, PH, l, lds);
}
#endif

extern "C" void kernel_launch(void* const* d_in, const int* in_sizes, int n_in, void* d_out, int out_size, void* d_ws, size_t ws_size,
                              hipStream_t stream) {
  Params p{};
  const float** pf = (const float**)&p;
  for (int i = 0; i < 33; ++i) pf[i] = (const float*)d_in[i];
  p.out = (float*)d_out;
  char* w = (char*)d_ws; size_t off = 0;
  auto take = [&](size_t bytes) { char* r = w + off; off += (bytes + 255) & ~(size_t)255; return (bf16_t*)r; };
  p.bar = (unsigned*)take((size_t)XCD_BAR_WORDS * 4);
  p.wt_in = take((size_t)NZ * 1024 * 2);
  p.wt_brr = take((size_t)1024 * 512 * 2);
  p.wt_bra = take((size_t)1024 * 512 * 2);
  p.wt_out = take((size_t)1024 * 1024 * 2);
  p.wt_ple = take((size_t)1024 * 256 * 2);
  p.wt_gate = take((size_t)1024 * 1024 * 2);
  p.w2t = take((size_t)512 * 64 * 2);
  p.a2t = take((size_t)512 * 64 * 2);
  p.z = take((size_t)MT * NZ * 2);
  p.vtp = take((size_t)16 * 128 * 4096 * 2);
  p.vts = take((size_t)32 * 128 * 64 * 2);
  p.kc = take((size_t)8 * 1024 * 512 * 2);
  p.vct = take((size_t)32 * 128 * 1024 * 2);
  p.o_r = take((size_t)MT * 512 * 2);
  p.o_a = take((size_t)MT * 512 * 2);
  p.hn = take((size_t)MT * DM * 2);
  p.cPT = p.hn;
  p.cG = take((size_t)NCH * 4096 * 2);
  p.cRT = take((size_t)NCH * 2048 * 2);
  p.cOI = take((size_t)NCH * 2048 * 2);
  p.cBA = take((size_t)NCH * 2048 * 2);
  if (off > ws_size) { fprintf(stderr, "workspace too small: need %zu have %zu\n", off, ws_size); return; }
#if MEGA
  hipMemsetAsync(p.bar, 0, (size_t)XCD_BAR_WORDS * 4, stream);
  static int grid_blocks = 0;
  if (!grid_blocks) {
    int dev = 0, cus = 0, per_cu = 0;
    hipGetDevice(&dev);
    hipDeviceGetAttribute(&cus, hipDeviceAttributeMultiprocessorCount, dev);
    hipOccupancyMaxActiveBlocksPerMultiprocessor(&per_cu, k_mega, 256, 0);
    if (per_cu > 2) per_cu = 2;
    grid_blocks = cus * per_cu;
  }
  void* args[] = {&p};
  hipError_t e = hipLaunchCooperativeKernel((void*)k_mega, dim3(grid_blocks), dim3(256), args, 0, stream);
  if (e != hipSuccess) fprintf(stderr, "cooperative launch failed: %s (grid %d)\n", hipGetErrorString(e), grid_blocks);
#else
  const int G = 512;
  for (int l = 0; l < NL; ++l) {
    k_phase<1><<<G, 256, 0, stream>>>(p, l);
    k_phase<2><<<G, 256, 0, stream>>>(p, l);
    k_phase<8><<<G, 256, 0, stream>>>(p, l);
    k_phase<3><<<G, 256, 0, stream>>>(p, l);
    k_phase<4><<<G, 256, 0, stream>>>(p, l);
    k_phase<5><<<G, 256, 0, stream>>>(p, l);
    k_phase<6><<<G, 256, 0, stream>>>(p, l);
    k_phase<7><<<G, 256, 0, stream>>>(p, l);
  }
#endif
}
```

```cpp
#include <hip/hip_runtime.h>
#include <hip/hip_cooperative_groups.h>
#include <stdint.h>
#include <stdio.h>
namespace cg = cooperative_groups;

#ifndef MEGA
#define MEGA 1
#endif

typedef unsigned short bf16_t;
typedef short bf16x8 __attribute__((ext_vector_type(8)));
typedef short s16x4 __attribute__((ext_vector_type(4)));
typedef float f32x4 __attribute__((ext_vector_type(4)));
typedef float f32x2 __attribute__((ext_vector_type(2)));
typedef float f32x16 __attribute__((ext_vector_type(16)));
typedef unsigned u32x4 __attribute__((ext_vector_type(4)));
typedef unsigned u32x2 __attribute__((ext_vector_type(2)));
typedef __bf16 bfv2 __attribute__((ext_vector_type(2)));

#define DI __device__ __forceinline__
DI int tid_() { int t = threadIdx.x; asm volatile("" : "+v"(t)); return t; }

constexpr int DM = 1024, MP = 16384, MS = 512, MT = 16896, NZ = 6272, NL = 4;
constexpr int C_GR = 1664, C_Q = 2176, C_K = 2688, C_V = 3200, C_GA = 3712, C_MR = 4224, C_MA = 5248;
constexpr int SHC = 1664;
constexpr size_t O_YP = 0, O_YS = 16777216, O_KP = 17301504, O_VP = 50855936, O_WP = 84410368, O_SP = 84934656,
                 O_KS = 84961280, O_VS = 86009856, O_WS = 87058432, O_SS = 88107008;

struct Params {
  const float *xp, *xs, *pp, *ps, *ck, *cv, *swkv, *sshift;
  const float *norm_g, *w_in, *shift_mu, *decay_w0, *decay_w2, *iclr_a0, *iclr_a2, *k_k, *k_a, *r_k, *lnx_g, *lnx_b,
      *qng, *kng, *lq1, *lk1, *lq2, *lk2, *subln_g, *w_br_r, *w_br_a, *w_out, *ple_w, *ple_gate_w, *ple_norm_g;
  float* out;
  bf16_t *wt_in, *wt_brr, *wt_bra, *wt_out, *wt_ple, *wt_gate, *w2t, *a2t;
  bf16_t *hn, *z, *vtp, *vts, *kc, *vct, *o_r, *o_a;
  bf16_t *cPT, *cG, *cRT, *cOI, *cBA;
  unsigned* bar;
};

DI unsigned pk2(float a, float b) { f32x2 v = {a, b}; bfv2 r = __builtin_convertvector(v, bfv2); return __builtin_bit_cast(unsigned, r); }
DI float bf_lo(unsigned u) { return __uint_as_float(u << 16); }
DI float bf_hi(unsigned u) { return __uint_as_float(u & 0xffff0000u); }
DI float bf1(bf16_t u) { return __uint_as_float(((unsigned)u) << 16); }
DI float sigmoidf_(float x) { return 1.0f / (1.0f + __expf(-x)); }
DI float siluf_(float x) { return x / (1.0f + __expf(-x)); }

DI void tr_tile(const float* __restrict__ src, int ld_src, bf16_t* __restrict__ dst, int ld_dst, float* sm) {
  const int tid = tid_();
  const int r = tid >> 4, c4 = (tid & 15) * 4;
#pragma unroll
  for (int i = 0; i < 4; ++i) {
    const int row = r + 16 * i;
    f32x4 v = *(const f32x4*)(src + (size_t)row * ld_src + c4);
    sm[row * 65 + c4 + 0] = v[0]; sm[row * 65 + c4 + 1] = v[1]; sm[row * 65 + c4 + 2] = v[2]; sm[row * 65 + c4 + 3] = v[3];
  }
  __syncthreads();
  const int n = tid >> 2, ks = (tid & 3) * 16;
  u32x4 o0, o1;
  o0[0] = pk2(sm[(ks + 0) * 65 + n], sm[(ks + 1) * 65 + n]);   o0[1] = pk2(sm[(ks + 2) * 65 + n], sm[(ks + 3) * 65 + n]);
  o0[2] = pk2(sm[(ks + 4) * 65 + n], sm[(ks + 5) * 65 + n]);   o0[3] = pk2(sm[(ks + 6) * 65 + n], sm[(ks + 7) * 65 + n]);
  o1[0] = pk2(sm[(ks + 8) * 65 + n], sm[(ks + 9) * 65 + n]);   o1[1] = pk2(sm[(ks + 10) * 65 + n], sm[(ks + 11) * 65 + n]);
  o1[2] = pk2(sm[(ks + 12) * 65 + n], sm[(ks + 13) * 65 + n]); o1[3] = pk2(sm[(ks + 14) * 65 + n], sm[(ks + 15) * 65 + n]);
  *(u32x4*)(dst + (size_t)n * ld_dst + ks) = o0;
  *(u32x4*)(dst + (size_t)n * ld_dst + ks + 8) = o1;
  __syncthreads();
}

constexpr int WCONV_TILES = 1568 + 128 + 128 + 256 + 64 + 256 + 8 + 8;
DI void wconv_tile(const Params& p, int l, int t, float* sm) {
  const float* src; bf16_t* dst; int K, N;
  if (t < 1568) { src = p.w_in + (size_t)l * 1024 * NZ; dst = p.wt_in; K = 1024; N = NZ; }
  else if ((t -= 1568) < 128) { src = p.w_br_r + (size_t)l * 512 * 1024; dst = p.wt_brr; K = 512; N = 1024; }
  else if ((t -= 128) < 128) { src = p.w_br_a + (size_t)l * 512 * 1024; dst = p.wt_bra; K = 512; N = 1024; }
  else if ((t -= 128) < 256) { src = p.w_out + (size_t)l * 1024 * 1024; dst = p.wt_out; K = 1024; N = 1024; }
  else if ((t -= 256) < 64) { src = p.ple_w + (size_t)l * 256 * 1024; dst = p.wt_ple; K = 256; N = 1024; }
  else if ((t -= 64) < 256) { src = p.ple_gate_w + (size_t)l * 1024 * 1024; dst = p.wt_gate; K = 1024; N = 1024; }
  else if ((t -= 256) < 8) { src = p.decay_w2 + (size_t)l * 64 * 512; dst = p.w2t; K = 64; N = 512; }
  else { t -= 8; src = p.iclr_a2 + (size_t)l * 64 * 512; dst = p.a2t; K = 64; N = 512; }
  const int ntn = N / 64; const int tk = t / ntn, tn = t % ntn;
  tr_tile(src + (size_t)(tk * 64) * N + tn * 64, N, dst + (size_t)(tn * 64) * K + tk * 64, K, sm);
}

DI const float* x_row(const Params& p, int l, int r) {
  if (l == 0) return r < MP ? p.xp + (size_t)r * DM : p.xs + (size_t)(r - MP) * DM;
  return p.out + (size_t)r * DM;
}
DI void phase_norm(const Params& p, int l, bool first, char* lds) {
  const int tid = tid_(), wave = tid >> 6, lane = tid & 63;
  const float* g = (first ? p.norm_g : p.ple_norm_g) + l * DM;
  const int n_norm = MT / 4;
  const int n_items = n_norm + (first ? 2048 + WCONV_TILES : 0);
  for (int it = blockIdx.x; it < n_items; it += gridDim.x) {
    if (it < n_norm) {
      const int r = it * 4 + wave;
      const float* x = first ? x_row(p, l, r) : p.out + (size_t)r * DM;
      f32x4 v[4]; float ss = 0.f;
#pragma unroll
      for (int i = 0; i < 4; ++i) { v[i] = *(const f32x4*)(x + lane * 4 + 256 * i); ss += v[i][0] * v[i][0] + v[i][1] * v[i][1] + v[i][2] * v[i][2] + v[i][3] * v[i][3]; }
#pragma unroll
      for (int o = 32; o >= 1; o >>= 1) ss += __shfl_xor(ss, o);
      const float rstd = rsqrtf(ss * (1.0f / 1024.0f) + 1e-6f);
#pragma unroll
      for (int i = 0; i < 4; ++i) {
        const f32x4 gv = *(const f32x4*)(g + lane * 4 + 256 * i);
        u32x2 o; o[0] = pk2(v[i][0] * rstd * gv[0], v[i][1] * rstd * gv[1]); o[1] = pk2(v[i][2] * rstd * gv[2], v[i][3] * rstd * gv[3]);
        *(u32x2*)(p.hn + (size_t)r * DM + lane * 4 + 256 * i) = o;
      }
    } else if (it < n_norm + 1024) {
      const int c = it - n_norm;
      const float* src = p.ck + (size_t)l * 8 * 1024 * 512 + (size_t)c * 4096 + tid * 16;
      bf16_t* dst = p.kc + (size_t)c * 4096 + tid * 16;
      f32x4 a0 = *(const f32x4*)(src), a1 = *(const f32x4*)(src + 4), a2 = *(const f32x4*)(src + 8), a3 = *(const f32x4*)(src + 12);
      u32x4 o0, o1;
      o0[0] = pk2(a0[0], a0[1]); o0[1] = pk2(a0[2], a0[3]); o0[2] = pk2(a1[0], a1[1]); o0[3] = pk2(a1[2], a1[3]);
      o1[0] = pk2(a2[0], a2[1]); o1[1] = pk2(a2[2], a2[3]); o1[2] = pk2(a3[0], a3[1]); o1[3] = pk2(a3[2], a3[3]);
      *(u32x4*)dst = o0; *(u32x4*)(dst + 8) = o1;
    } else if (it >= n_norm + 2048) {
      wconv_tile(p, l, it - n_norm - 2048, (float*)lds);
    } else {
      const int c = it - n_norm - 1024;
      const int bh = c >> 5, tt = c & 31; const int b = bh >> 2, h = bh & 3; const int tk = tt >> 1, tn = tt & 1;
      const float* src = p.cv + (size_t)l * 8 * 1024 * 512 + ((size_t)(b * 1024 + tk * 64)) * 512 + h * 128 + tn * 64;
      bf16_t* dst = p.vct + ((size_t)(bh * 128 + tn * 64)) * 1024 + tk * 64;
      tr_tile(src, 512, dst, 1024, (float*)lds);
    }
  }
}

constexpr int GLD = 72;
template <bool A_F32>
DI void gemm_core(f32x4 (&acc)[4][4], const void* Ap, int lda, const bf16_t* Bp, int ldb, int K, char* lds) {
  bf16_t* As = (bf16_t*)lds;
  bf16_t* Bs = (bf16_t*)(lds + 2 * 128 * GLD * 2);
  const int tid = tid_(), wave = tid >> 6, lane = tid & 63;
  const int wm = wave >> 1, wn = wave & 1, l15 = lane & 15, quad = lane >> 4;
  const int nk = K / 64;
  u32x4 ra[4], rb[4];
  auto gload = [&](int kt) {
#pragma unroll
    for (int i = 0; i < 4; ++i) {
      const int c = tid + 256 * i; const int row = c >> 3, c8 = (c & 7) * 8;
      if (!A_F32) ra[i] = *(const u32x4*)((const bf16_t*)Ap + (size_t)row * lda + kt * 64 + c8);
      rb[i] = *(const u32x4*)(Bp + (size_t)row * ldb + kt * 64 + c8);
    }
  };
  auto sstore = [&](int buf, int kt) {
#pragma unroll
    for (int i = 0; i < 4; ++i) {
      const int c = tid + 256 * i; const int row = c >> 3, c8 = (c & 7) * 8;
      if (A_F32) {
        const float* a = (const float*)Ap + (size_t)row * lda + kt * 64 + c8;
        const f32x4 v0 = *(const f32x4*)a, v1 = *(const f32x4*)(a + 4);
        u32x4 t; t[0] = pk2(v0[0], v0[1]); t[1] = pk2(v0[2], v0[3]); t[2] = pk2(v1[0], v1[1]); t[3] = pk2(v1[2], v1[3]);
        *(u32x4*)(As + (buf * 128 + row) * GLD + c8) = t;
      } else {
        *(u32x4*)(As + (buf * 128 + row) * GLD + c8) = ra[i];
      }
      *(u32x4*)(Bs + (buf * 128 + row) * GLD + c8) = rb[i];
    }
  };
  gload(0); sstore(0, 0); __syncthreads();
  for (int kt = 0; kt < nk; ++kt) {
    const int buf = kt & 1;
    if (kt + 1 < nk) gload(kt + 1);
#pragma unroll
    for (int ks = 0; ks < 2; ++ks) {
      bf16x8 af[4], bfr[4];
#pragma unroll
      for (int i = 0; i < 4; ++i) {
        af[i] = *(const bf16x8*)(As + (buf * 128 + wm * 64 + i * 16 + l15) * GLD + ks * 32 + quad * 8);
        bfr[i] = *(const bf16x8*)(Bs + (buf * 128 + wn * 64 + i * 16 + l15) * GLD + ks * 32 + quad * 8);
      }
#pragma unroll
      for (int mi = 0; mi < 4; ++mi)
#pragma unroll
        for (int ni = 0; ni < 4; ++ni) acc[mi][ni] = __builtin_amdgcn_mfma_f32_16x16x32_bf16(bfr[ni], af[mi], acc[mi][ni], 0, 0, 0);
    }
    if (kt + 1 < nk) sstore(buf ^ 1, kt + 1);
    __syncthreads();
  }
}
DI void zero_acc(f32x4 (&acc)[4][4]) {
#pragma unroll
  for (int i = 0; i < 4; ++i)
#pragma unroll
    for (int j = 0; j < 4; ++j) acc[i][j] = (f32x4){0.f, 0.f, 0.f, 0.f};
}

DI void phase_gemm_in(const Params& p, int l, char* lds) {
  const int tid = tid_(), wave = tid >> 6, lane = tid & 63;
  const int wm = wave >> 1, wn = wave & 1, l15 = lane & 15, quad = lane >> 4;
  const bf16_t* Wt = p.wt_in;
  const int NTN = 49, NTM = 132;
  for (int tile = blockIdx.x; tile < NTN * NTM; tile += gridDim.x) {
    const int mt = tile / NTN, nt = tile % NTN;
    f32x4 acc[4][4]; zero_acc(acc);
    gemm_core<false>(acc, p.hn + (size_t)mt * 128 * DM, DM, Wt + (size_t)nt * 128 * DM, DM, DM, lds);
    const int colb = nt * 128 + wn * 64 + quad * 4;
    int kind;
    if (nt < 13) kind = 0; else if (nt < 17) kind = 1; else if (nt < 21) kind = 2; else if (nt < 25) kind = 3; else if (nt < 29) kind = 4; else if (nt < 33) kind = 1; else kind = 5;
#pragma unroll
    for (int mi = 0; mi < 4; ++mi) {
      const int R = mt * 128 + wm * 64 + mi * 16 + l15;
      const bool isp = R < MP; const int rs = R - MP;
      bf16_t* zrow = p.z + (size_t)R * NZ;
      if (kind == 0) {
        const bool last = isp ? ((R & 4095) == 4095) : ((rs & 63) == 63);
        float* so = isp ? p.out + O_SP + (size_t)(l * 4 + (R >> 12)) * SHC : p.out + O_SS + (size_t)(l * 8 + (rs >> 6)) * SHC;
#pragma unroll
        for (int ni = 0; ni < 4; ++ni) {
          const int c = colb + ni * 16; const f32x4 v = acc[mi][ni];
          u32x2 o; o[0] = pk2(v[0], v[1]); o[1] = pk2(v[2], v[3]); *(u32x2*)(zrow + c) = o;
          if (last) *(f32x4*)(so + c) = v;
        }
      } else if (kind == 1 || kind == 5) {
#pragma unroll
        for (int ni = 0; ni < 4; ++ni) {
          const int c = colb + ni * 16; f32x4 v = acc[mi][ni];
#pragma unroll
          for (int e = 0; e < 4; ++e) v[e] = (kind == 1) ? siluf_(v[e]) : sigmoidf_(v[e]);
          u32x2 o; o[0] = pk2(v[0], v[1]); o[1] = pk2(v[2], v[3]); *(u32x2*)(zrow + c) = o;
        }
      } else if (kind == 2 || kind == 3) {
        float ss = 0.f;
#pragma unroll
        for (int ni = 0; ni < 4; ++ni) { const f32x4 v = acc[mi][ni]; ss += v[0] * v[0] + v[1] * v[1] + v[2] * v[2] + v[3] * v[3]; }
        ss += __shfl_xor(ss, 16); ss += __shfl_xor(ss, 32);
        const float rstd = rsqrtf(ss * (1.0f / 64.0f) + 1e-6f);
        const float* g = (kind == 2 ? p.qng : p.kng) + l * 64;
        float* ko = isp ? p.out + O_KP + ((size_t)l * MP + R) * 512 : p.out + O_KS + ((size_t)l * MS + rs) * 512;
#pragma unroll
        for (int ni = 0; ni < 4; ++ni) {
          const int c = colb + ni * 16; const int d = ni * 16 + quad * 4;
          const f32x4 gv = *(const f32x4*)(g + d); f32x4 v = acc[mi][ni];
#pragma unroll
          for (int e = 0; e < 4; ++e) v[e] = v[e] * rstd * gv[e];
          u32x2 o; o[0] = pk2(v[0], v[1]); o[1] = pk2(v[2], v[3]); *(u32x2*)(zrow + c) = o;
          if (kind == 3) *(f32x4*)(ko + (c - C_K)) = v;
        }
      } else {
        float* vo = isp ? p.out + O_VP + ((size_t)l * MP + R) * 512 : p.out + O_VS + ((size_t)l * MS + rs) * 512;
#pragma unroll
        for (int ni = 0; ni < 4; ++ni) {
          const int cv = colb + ni * 16 - C_V; const f32x4 v = acc[mi][ni];
          *(f32x4*)(vo + cv) = v;
          const int h = cv >> 7, vd = cv & 127;
          if (isp) {
            bf16_t* vt = p.vtp + ((size_t)(((R >> 12) * 4 + h) * 128 + vd)) * 4096 + (R & 4095);
#pragma unroll
            for (int e = 0; e < 4; ++e) vt[(size_t)e * 4096] = (bf16_t)(pk2(v[e], 0.f) & 0xffff);
          } else {
            bf16_t* vt = p.vts + ((size_t)(((rs >> 6) * 4 + h) * 128 + vd)) * 64 + (rs & 63);
#pragma unroll
            for (int e = 0; e < 4; ++e) vt[(size_t)e * 64] = (bf16_t)(pk2(v[e], 0.f) & 0xffff);
          }
        }
      }
    }
  }
}

constexpr int NCH_P = 4096, NCH = 4224;
constexpr int XLD = 40;
DI f32x4 mm16(const bf16_t* Xrow, int ldx, const bf16_t* Yrow, int ldy, int ksteps, f32x4 acc, int l15, int quad) {
  for (int ks = 0; ks < ksteps; ++ks) {
    const bf16x8 a = *(const bf16x8*)(Xrow + l15 * ldx + ks * 32 + quad * 8);
    const bf16x8 b = *(const bf16x8*)(Yrow + l15 * ldy + ks * 32 + quad * 8);
    acc = __builtin_amdgcn_mfma_f32_16x16x32_bf16(a, b, acc, 0, 0, 0);
  }
  return acc;
}
DI void chunk_item(const Params& p, int l, int item, char* lds) {
  const int tid = tid_(), wave = tid >> 6, lane = tid & 63, l15 = lane & 15, quad = lane >> 4;
  const bool isp = item < NCH_P;
  int bh, c;
  if (isp) { bh = item >> 7; c = item & 127; } else { const int j = item - NCH_P; bh = j >> 1; c = j & 1; }
  const int b = bh >> 3, h = bh & 7;
  const int t0 = c * 32; const int row0 = (isp ? b * 4096 : MP + b * 64) + t0;
  float* s_r = (float*)lds;
  float* s_kf = s_r + 2048;
  float* s_v = s_kf + 2048;
  float* s_w = s_v + 2048;
  float* s_kk = s_w + 2048;
  float* s_bb = s_kk + 2048;
  bf16_t* s_wd = (bf16_t*)(lds + 49152);
  bf16_t* s_ad = (bf16_t*)(lds + 53760);
  float* s_bonus = (float*)(lds + 58368);
  float* s_wl = (float*)(lds + 58496);
  float* s_rhs = (float*)lds;
  bf16_t* s_A = (bf16_t*)lds;
  bf16_t* s_Bm = (bf16_t*)(lds + 4608);
  bf16_t* s_Kp = (bf16_t*)(lds + 9216);
  bf16_t* s_R = (bf16_t*)(lds + 16384);
  bf16_t* s_BmT = (bf16_t*)(lds + 20992);
  bf16_t* s_KpT = (bf16_t*)(lds + 26112);
  bf16_t* s_VmT = (bf16_t*)(lds + 31232);
  bf16_t* s_Lak = (bf16_t*)(lds + 36352);
  bf16_t* s_Mrk = (bf16_t*)(lds + 38912);
  bf16_t* s_Mrb = (bf16_t*)(lds + 41472);
  float* s_lab = (float*)(lds + 44032);
  bf16_t* s_XT = (bf16_t*)(lds + 48256);

  const int mat = wave >> 1, tt = wave & 1;
  const bf16_t* wl = (mat == 0 ? p.w2t : p.a2t) + (size_t)(h * 64) * 64;
  const float* mu = p.shift_mu + l * SHC;
  const float* w0 = p.decay_w0 + l * 512 + h * 64;
  const float* a0 = p.iclr_a0 + l * 512 + h * 64;
  const float* kkp = p.k_k + l * 512 + h * 64;
  const float* kap = p.k_a + l * 512 + h * 64;
  const float* rkp = p.r_k + l * 512 + h * 64;
  const float* lb = p.lnx_b + l * 512 + h * 64;
  const int ptok = tid >> 3, pcs = (tid & 7) * 8;
  {
    const int t = t0 + ptok; const size_t row = (size_t)(row0 + ptok);
#pragma unroll
    for (int g = 0; g < 5; ++g) {
      const int zc = (g < 3 ? g * 512 + h * 64 : 1536 + (g - 3) * 64) + pcs;
      const u32x4 cu = *(const u32x4*)(p.z + row * NZ + zc);
      float cur[8], prv[8];
#pragma unroll
      for (int e = 0; e < 4; ++e) { cur[2 * e] = bf_lo(cu[e]); cur[2 * e + 1] = bf_hi(cu[e]); }
      if (t > 0) {
        const u32x4 pu = *(const u32x4*)(p.z + (row - 1) * NZ + zc);
#pragma unroll
        for (int e = 0; e < 4; ++e) { prv[2 * e] = bf_lo(pu[e]); prv[2 * e + 1] = bf_hi(pu[e]); }
      } else if (isp) {
#pragma unroll
        for (int e = 0; e < 8; ++e) prv[e] = 0.f;
      } else {
        const float* sp = p.sshift + (size_t)(l * 8 + b) * SHC + zc;
#pragma unroll
        for (int e = 0; e < 8; ++e) prv[e] = sp[e];
      }
      float zs[8];
#pragma unroll
      for (int e = 0; e < 8; ++e) zs[e] = cur[e] + (prv[e] - cur[e]) * mu[zc + e];
      if (g < 3) {
        float* d = (g == 0 ? s_r : g == 1 ? s_kf : s_v) + ptok * 64 + pcs;
        *(f32x4*)d = (f32x4){zs[0], zs[1], zs[2], zs[3]}; *(f32x4*)(d + 4) = (f32x4){zs[4], zs[5], zs[6], zs[7]};
      } else {
        if (g == 3) {
#pragma unroll
          for (int e = 0; e < 8; ++e) { const float ex = __expf(2.f * zs[e]); zs[e] = 1.f - 2.f / (ex + 1.f); }
        }
        u32x4 o; o[0] = pk2(zs[0], zs[1]); o[1] = pk2(zs[2], zs[3]); o[2] = pk2(zs[4], zs[5]); o[3] = pk2(zs[6], zs[7]);
        *(u32x4*)((g == 3 ? s_wd : s_ad) + ptok * 72 + pcs) = o;
      }
    }
  }
  __syncthreads();
  {
    const bf16_t* At = (mat == 0 ? s_wd : s_ad);
    bf16x8 af[2];
#pragma unroll
    for (int ks = 0; ks < 2; ++ks) af[ks] = *(const bf16x8*)(At + (tt * 16 + l15) * 72 + ks * 32 + quad * 8);
#pragma unroll
    for (int ct = 0; ct < 4; ++ct) {
      f32x4 d = (f32x4){0.f, 0.f, 0.f, 0.f};
#pragma unroll
      for (int ks = 0; ks < 2; ++ks) {
        const bf16x8 wfr = *(const bf16x8*)(wl + (size_t)(ct * 16 + l15) * 64 + ks * 32 + quad * 8);
        d = __builtin_amdgcn_mfma_f32_16x16x32_bf16(wfr, af[ks], d, 0, 0, 0);
      }
      const int ch = ct * 16 + quad * 4; const int tok = tt * 16 + l15;
      f32x4 o;
      if (mat == 0) {
#pragma unroll
        for (int e = 0; e < 4; ++e) {
          const float y = -(w0[ch + e] + d[e]);
          const float sp = fmaxf(y, 0.f) + log1pf(__expf(-fabsf(y)));
          o[e] = -__expf(-sp - 0.5f);
        }
        *(f32x4*)(s_w + tok * 64 + ch) = o;
      } else {
#pragma unroll
        for (int e = 0; e < 4; ++e) o[e] = sigmoidf_(a0[ch + e] + d[e]);
        *(f32x4*)(s_bb + tok * 64 + ch) = o;
      }
    }
  }
  __syncthreads();
  float r_[8], kf[8], kk[8], bbv[8], v_[8], bon;
  {
    float k_[8], a_[8];
    *(f32x4*)&k_[0] = *(const f32x4*)(s_kf + ptok * 64 + pcs); *(f32x4*)&k_[4] = *(const f32x4*)(s_kf + ptok * 64 + pcs + 4);
    *(f32x4*)&a_[0] = *(const f32x4*)(s_bb + ptok * 64 + pcs); *(f32x4*)&a_[4] = *(const f32x4*)(s_bb + ptok * 64 + pcs + 4);
    *(f32x4*)&r_[0] = *(const f32x4*)(s_r + ptok * 64 + pcs); *(f32x4*)&r_[4] = *(const f32x4*)(s_r + ptok * 64 + pcs + 4);
    *(f32x4*)&v_[0] = *(const f32x4*)(s_v + ptok * 64 + pcs); *(f32x4*)&v_[4] = *(const f32x4*)(s_v + ptok * 64 + pcs + 4);
    float ss = 0.f; bon = 0.f;
#pragma unroll
    for (int e = 0; e < 8; ++e) {
      kk[e] = k_[e] * kkp[pcs + e]; ss += kk[e] * kk[e];
      kf[e] = k_[e] * (1.f + (a_[e] - 1.f) * kap[pcs + e]);
      bon += r_[e] * kf[e] * rkp[pcs + e];
    }
    ss += __shfl_xor(ss, 1); ss += __shfl_xor(ss, 2); ss += __shfl_xor(ss, 4);
    bon += __shfl_xor(bon, 1); bon += __shfl_xor(bon, 2); bon += __shfl_xor(bon, 4);
    const float inv = 1.0f / fmaxf(sqrtf(ss), 1e-12f);
#pragma unroll
    for (int e = 0; e < 8; ++e) { kk[e] *= inv; bbv[e] = kk[e] * a_[e]; }
  }
  if (tid < 64) {
    float run = 0.f;
#pragma unroll 8
    for (int t = 0; t < 32; ++t) { run += s_w[t * 64 + tid]; s_w[t * 64 + tid] = run; }
  }
  __syncthreads();
  {
    float cw[8], cwp[8];
    *(f32x4*)&cw[0] = *(const f32x4*)(s_w + ptok * 64 + pcs); *(f32x4*)&cw[4] = *(const f32x4*)(s_w + ptok * 64 + pcs + 4);
    if (ptok > 0) { *(f32x4*)&cwp[0] = *(const f32x4*)(s_w + (ptok - 1) * 64 + pcs); *(f32x4*)&cwp[4] = *(const f32x4*)(s_w + (ptok - 1) * 64 + pcs + 4); }
    else {
#pragma unroll
      for (int e = 0; e < 8; ++e) cwp[e] = 0.f;
    }
    __syncthreads();
    float av[8], bm[8], kp[8], rr[8];
#pragma unroll
    for (int e = 0; e < 8; ++e) {
      const float ec = __expf(cw[e]), en = __expf(-cw[e]), ep = __expf(cwp[e]);
      av[e] = kk[e] * ep; bm[e] = bbv[e] * en; kp[e] = kf[e] * en; rr[e] = r_[e] * ec;
      if (ptok == 31) s_wl[pcs + e] = ec;
    }
    u32x4 o;
    o[0] = pk2(av[0], av[1]); o[1] = pk2(av[2], av[3]); o[2] = pk2(av[4], av[5]); o[3] = pk2(av[6], av[7]); *(u32x4*)(s_A + ptok * 72 + pcs) = o;
    o[0] = pk2(bm[0], bm[1]); o[1] = pk2(bm[2], bm[3]); o[2] = pk2(bm[4], bm[5]); o[3] = pk2(bm[6], bm[7]); *(u32x4*)(s_Bm + ptok * 72 + pcs) = o;
#pragma unroll
    for (int e = 0; e < 4; ++e) { s_BmT[(pcs + 2 * e) * XLD + ptok] = (bf16_t)(o[e] & 0xffff); s_BmT[(pcs + 2 * e + 1) * XLD + ptok] = (bf16_t)(o[e] >> 16); }
    o[0] = pk2(kp[0], kp[1]); o[1] = pk2(kp[2], kp[3]); o[2] = pk2(kp[4], kp[5]); o[3] = pk2(kp[6], kp[7]); *(u32x4*)(s_Kp + ptok * 72 + pcs) = o;
#pragma unroll
    for (int e = 0; e < 4; ++e) { s_KpT[(pcs + 2 * e) * XLD + ptok] = (bf16_t)(o[e] & 0xffff); s_KpT[(pcs + 2 * e + 1) * XLD + ptok] = (bf16_t)(o[e] >> 16); }
    o[0] = pk2(rr[0], rr[1]); o[1] = pk2(rr[2], rr[3]); o[2] = pk2(rr[4], rr[5]); o[3] = pk2(rr[6], rr[7]); *(u32x4*)(s_R + ptok * 72 + pcs) = o;
    o[0] = pk2(v_[0], v_[1]); o[1] = pk2(v_[2], v_[3]); o[2] = pk2(v_[4], v_[5]); o[3] = pk2(v_[6], v_[7]);
#pragma unroll
    for (int e = 0; e < 4; ++e) { s_VmT[(pcs + 2 * e) * XLD + ptok] = (bf16_t)(o[e] & 0xffff); s_VmT[(pcs + 2 * e + 1) * XLD + ptok] = (bf16_t)(o[e] >> 16); }
    u32x4 ob;
    ob[0] = pk2(lb[pcs + 0] + bon * v_[0], lb[pcs + 1] + bon * v_[1]); ob[1] = pk2(lb[pcs + 2] + bon * v_[2], lb[pcs + 3] + bon * v_[3]);
    ob[2] = pk2(lb[pcs + 4] + bon * v_[4], lb[pcs + 5] + bon * v_[5]); ob[3] = pk2(lb[pcs + 6] + bon * v_[6], lb[pcs + 7] + bon * v_[7]);
    *(u32x4*)(p.cBA + ((size_t)item * 32 + ptok) * 64 + pcs) = ob;
  }
  __syncthreads();
  {
    const bf16_t* X = (wave < 2) ? s_A : s_R;
    const bf16_t* Y = (wave == 0 || wave == 3) ? s_Bm : s_Kp;
    const bool strict = wave < 2;
#pragma unroll
    for (int ti = 0; ti < 2; ++ti)
#pragma unroll
      for (int ii = 0; ii < 2; ++ii) {
        f32x4 d = (f32x4){0.f, 0.f, 0.f, 0.f};
        if (ii <= ti) d = mm16(X + ti * 16 * 72, 72, Y + ii * 16 * 72, 72, 2, d, l15, quad);
        const int i = ii * 16 + l15;
#pragma unroll
        for (int e = 0; e < 4; ++e) {
          const int t = ti * 16 + quad * 4 + e;
          const bool keep = strict ? (i < t) : (i <= t);
          const float val = keep ? d[e] : 0.f;
          if (wave == 0) s_lab[t * 33 + i] = val;
          else { bf16_t* dst = (wave == 1 ? s_Lak : wave == 2 ? s_Mrk : s_Mrb); dst[t * XLD + i] = (bf16_t)(pk2(val, 0.f) & 0xffff); }
        }
      }
  }
  const u32x4 acap = *(const u32x4*)(s_A + ptok * 72 + pcs);
  __syncthreads();
  {
    float* d = s_rhs + ptok * 128 + pcs;
    *(f32x4*)d = (f32x4){bf_lo(acap[0]), bf_hi(acap[0]), bf_lo(acap[1]), bf_hi(acap[1])};
    *(f32x4*)(d + 4) = (f32x4){bf_lo(acap[2]), bf_hi(acap[2]), bf_lo(acap[3]), bf_hi(acap[3])};
  }
  {
    const int ti = wave & 1;
#pragma unroll
    for (int vv = 0; vv < 2; ++vv) {
      const int vi = (wave >> 1) * 2 + vv;
      f32x4 d = (f32x4){0.f, 0.f, 0.f, 0.f};
      d = mm16(s_Lak + ti * 16 * XLD, XLD, s_VmT + vi * 16 * XLD, XLD, 1, d, l15, quad);
#pragma unroll
      for (int e = 0; e < 4; ++e) s_rhs[(ti * 16 + quad * 4 + e) * 128 + 64 + vi * 16 + l15] = d[e];
    }
  }
  __syncthreads();
  if (tid < 128) {
    float x[32];
#pragma unroll
    for (int t = 0; t < 32; ++t) {
      float a = s_rhs[t * 128 + tid];
#pragma unroll
      for (int i = 0; i < t; ++i) a -= s_lab[t * 33 + i] * x[i];
      x[t] = a;
    }
#pragma unroll
    for (int q4 = 0; q4 < 4; ++q4) {
      u32x4 o; o[0] = pk2(x[8 * q4], x[8 * q4 + 1]); o[1] = pk2(x[8 * q4 + 2], x[8 * q4 + 3]); o[2] = pk2(x[8 * q4 + 4], x[8 * q4 + 5]); o[3] = pk2(x[8 * q4 + 6], x[8 * q4 + 7]);
      *(u32x4*)(s_XT + tid * XLD + q4 * 8) = o;
    }
  }
  __syncthreads();
  {
    const f32x4 z4 = (f32x4){0.f, 0.f, 0.f, 0.f};
    bf16_t* gPT = p.cPT + (size_t)item * 4096;
    const float wl_c = s_wl[wave * 16 + l15];
#pragma unroll
    for (int k1t = 0; k1t < 4; ++k1t) {
      f32x4 d = mm16(s_XT + k1t * 16 * XLD, XLD, s_BmT + wave * 16 * XLD, XLD, 1, z4, l15, quad);
      const int k2 = wave * 16 + l15, k1 = k1t * 16 + quad * 4;
      float o[4];
#pragma unroll
      for (int e = 0; e < 4; ++e) o[e] = ((k1 + e == k2 ? 1.f : 0.f) - d[e]) * wl_c;
      u32x2 ov; ov[0] = pk2(o[0], o[1]); ov[1] = pk2(o[2], o[3]);
      *(u32x2*)(gPT + k2 * 64 + k1) = ov;
    }
    bf16_t* gG = p.cG + (size_t)item * 4096;
#pragma unroll
    for (int k2t = 0; k2t < 4; ++k2t) {
      const f32x4 d1 = mm16(s_KpT + k2t * 16 * XLD, XLD, s_VmT + wave * 16 * XLD, XLD, 1, z4, l15, quad);
      const f32x4 d2 = mm16(s_BmT + k2t * 16 * XLD, XLD, s_XT + (64 + wave * 16) * XLD, XLD, 1, z4, l15, quad);
      const int k2 = k2t * 16 + quad * 4, v = wave * 16 + l15;
      const f32x4 wv = *(const f32x4*)(s_wl + k2);
      u32x2 ov; ov[0] = pk2((d1[0] - d2[0]) * wv[0], (d1[1] - d2[1]) * wv[1]); ov[1] = pk2((d1[2] - d2[2]) * wv[2], (d1[3] - d2[3]) * wv[3]);
      *(u32x2*)(gG + v * 64 + k2) = ov;
    }
    bf16_t* gRT = p.cRT + (size_t)item * 2048;
    bf16_t* gOI = p.cOI + (size_t)item * 2048;
#pragma unroll
    for (int ti = 0; ti < 2; ++ti) {
      const f32x4 d = mm16(s_XT + wave * 16 * XLD, XLD, s_Mrb + ti * 16 * XLD, XLD, 1, z4, l15, quad);
      const int t = ti * 16 + l15, k = wave * 16 + quad * 4;
      const u32x2 rv = *(const u32x2*)(s_R + t * 72 + k);
      u32x2 ov; ov[0] = pk2(bf_lo(rv[0]) - d[0], bf_hi(rv[0]) - d[1]); ov[1] = pk2(bf_lo(rv[1]) - d[2], bf_hi(rv[1]) - d[3]);
      *(u32x2*)(gRT + t * 64 + k) = ov;
      const f32x4 e1 = mm16(s_VmT + wave * 16 * XLD, XLD, s_Mrk + ti * 16 * XLD, XLD, 1, z4, l15, quad);
      const f32x4 e2 = mm16(s_XT + (64 + wave * 16) * XLD, XLD, s_Mrb + ti * 16 * XLD, XLD, 1, z4, l15, quad);
      u32x2 oo; oo[0] = pk2(e1[0] - e2[0], e1[1] - e2[1]); oo[1] = pk2(e1[2] - e2[2], e1[3] - e2[3]);
      *(u32x2*)(gOI + t * 64 + k) = oo;
    }
  }
  __syncthreads();
}

DI void rec_item(const Params& p, int l, int item, char* lds) {
  const int tid = tid_(), wave = tid >> 6, lane = tid & 63, l15 = lane & 15, quad = lane >> 4;
  const bool isp = item < 32;
  const int bh = isp ? item : item - 32; const int b = bh >> 3, h = bh & 7;
  const int nch = isp ? 128 : 2; const int cid0 = isp ? bh * 128 : NCH_P + bh * 2;
  const int row0 = isp ? b * 4096 : MP + b * 64;
  bf16_t* Sb = (bf16_t*)lds;
  const int v = wave * 16 + l15;
  f32x4 acc[4];
  if (isp) {
#pragma unroll
    for (int nk = 0; nk < 4; ++nk) acc[nk] = (f32x4){0.f, 0.f, 0.f, 0.f};
  } else {
    const float* sp = p.swkv + (((size_t)(l * 8 + b) * 8 + h) * 64 + v) * 64;
#pragma unroll
    for (int nk = 0; nk < 4; ++nk) acc[nk] = *(const f32x4*)(sp + nk * 16 + quad * 4);
  }
#pragma unroll
  for (int nk = 0; nk < 4; ++nk) { u32x2 o; o[0] = pk2(acc[nk][0], acc[nk][1]); o[1] = pk2(acc[nk][2], acc[nk][3]); *(u32x2*)(Sb + v * 72 + nk * 16 + quad * 4) = o; }
  __syncthreads();
  const float* lg = p.lnx_g + l * 512 + h * 64;
  f32x4 lgv[4];
#pragma unroll
  for (int vt = 0; vt < 4; ++vt) lgv[vt] = *(const f32x4*)(lg + vt * 16 + quad * 4);
  bf16x8 pt[4][2]; u32x2 gv[4]; bf16x8 rt[2]; u32x2 oi[4], ba[4], gt[4];
  const int tok = (wave & 1) * 16 + l15;
  auto ld_pg = [&](int c) {
    const size_t cid = (size_t)(cid0 + c);
    const bf16_t* gPT = p.cPT + cid * 4096; const bf16_t* gG = p.cG + cid * 4096;
#pragma unroll
    for (int nk = 0; nk < 4; ++nk) {
#pragma unroll
      for (int ks = 0; ks < 2; ++ks) pt[nk][ks] = *(const bf16x8*)(gPT + (nk * 16 + l15) * 64 + ks * 32 + quad * 8);
      gv[nk] = *(const u32x2*)(gG + v * 64 + nk * 16 + quad * 4);
    }
  };
  auto ld_ro = [&](int c) {
    const size_t cid = (size_t)(cid0 + c);
#pragma unroll
    for (int ks = 0; ks < 2; ++ks) rt[ks] = *(const bf16x8*)(p.cRT + cid * 2048 + tok * 64 + ks * 32 + quad * 8);
#pragma unroll
    for (int vt = 0; vt < 4; ++vt) oi[vt] = *(const u32x2*)(p.cOI + cid * 2048 + tok * 64 + vt * 16 + quad * 4);
  };
  auto ld_bg = [&](int c) {
    const size_t cid = (size_t)(cid0 + c); const size_t row = (size_t)(row0 + c * 32 + tok);
#pragma unroll
    for (int vt = 0; vt < 4; ++vt) {
      ba[vt] = *(const u32x2*)(p.cBA + cid * 2048 + tok * 64 + vt * 16 + quad * 4);
      gt[vt] = *(const u32x2*)(p.z + row * NZ + C_GR + h * 64 + vt * 16 + quad * 4);
    }
  };
  ld_pg(0);
  if (wave < 2) { ld_ro(0); ld_bg(0); }
#pragma unroll 1
  for (int c = 0; c < nch; ++c) {
    const int buf = c & 1; const bool more = (c + 1 < nch);
    const size_t row = (size_t)(row0 + c * 32 + tok);
    bf16x8 sf[2];
#pragma unroll
    for (int ks = 0; ks < 2; ++ks) sf[ks] = *(const bf16x8*)(Sb + (buf * 64 + v) * 72 + ks * 32 + quad * 8);
#pragma unroll
    for (int nk = 0; nk < 4; ++nk) {
      f32x4 a = (f32x4){bf_lo(gv[nk][0]), bf_hi(gv[nk][0]), bf_lo(gv[nk][1]), bf_hi(gv[nk][1])};
#pragma unroll
      for (int ks = 0; ks < 2; ++ks) a = __builtin_amdgcn_mfma_f32_16x16x32_bf16(pt[nk][ks], sf[ks], a, 0, 0, 0);
      acc[nk] = a;
    }
    if (more) ld_pg(c + 1);
    f32x4 ao[4];
    if (wave < 2) {
#pragma unroll
      for (int vt = 0; vt < 4; ++vt) {
        f32x4 a = (f32x4){bf_lo(oi[vt][0]), bf_hi(oi[vt][0]), bf_lo(oi[vt][1]), bf_hi(oi[vt][1])};
#pragma unroll
        for (int ks = 0; ks < 2; ++ks) {
          const bf16x8 sa = *(const bf16x8*)(Sb + (buf * 64 + vt * 16 + l15) * 72 + ks * 32 + quad * 8);
          a = __builtin_amdgcn_mfma_f32_16x16x32_bf16(sa, rt[ks], a, 0, 0, 0);
        }
        ao[vt] = a;
      }
      if (more) ld_ro(c + 1);
    }
#pragma unroll
    for (int nk = 0; nk < 4; ++nk) { u32x2 ov; ov[0] = pk2(acc[nk][0], acc[nk][1]); ov[1] = pk2(acc[nk][2], acc[nk][3]); *(u32x2*)(Sb + ((buf ^ 1) * 64 + v) * 72 + nk * 16 + quad * 4) = ov; }
    __syncthreads();
    if (wave < 2) {
      float sm = 0.f;
#pragma unroll
      for (int vt = 0; vt < 4; ++vt) sm += (ao[vt][0] + ao[vt][1]) + (ao[vt][2] + ao[vt][3]);
      sm += __shfl_xor(sm, 16); sm += __shfl_xor(sm, 32);
      const float mean = sm * (1.0f / 64.0f);
      float vr = 0.f;
#pragma unroll
      for (int vt = 0; vt < 4; ++vt)
#pragma unroll
        for (int e = 0; e < 4; ++e) { const float d = ao[vt][e] - mean; vr += d * d; }
      vr += __shfl_xor(vr, 16); vr += __shfl_xor(vr, 32);
      const float rstd = rsqrtf(vr * (1.0f / 64.0f) + 64e-5f);
#pragma unroll
      for (int vt = 0; vt < 4; ++vt) {
        const int vv = vt * 16 + quad * 4;
        const f32x4 g4 = lgv[vt];
        const float y0 = ((ao[vt][0] - mean) * rstd * g4[0] + bf_lo(ba[vt][0])) * bf_lo(gt[vt][0]);
        const float y1 = ((ao[vt][1] - mean) * rstd * g4[1] + bf_hi(ba[vt][0])) * bf_hi(gt[vt][0]);
        const float y2 = ((ao[vt][2] - mean) * rstd * g4[2] + bf_lo(ba[vt][1])) * bf_lo(gt[vt][1]);
        const float y3 = ((ao[vt][3] - mean) * rstd * g4[3] + bf_hi(ba[vt][1])) * bf_hi(gt[vt][1]);
        u32x2 ov; ov[0] = pk2(y0, y1); ov[1] = pk2(y2, y3);
        *(u32x2*)(p.o_r + row * 512 + h * 64 + vv) = ov;
      }
      if (more) ld_bg(c + 1);
    }
  }
  float* so = (isp ? p.out + O_WP + (((size_t)(l * 4 + b) * 8 + h) * 64 + v) * 64 : p.out + O_WS + (((size_t)(l * 8 + b) * 8 + h) * 64 + v) * 64);
#pragma unroll
  for (int nk = 0; nk < 4; ++nk) *(f32x4*)(so + nk * 16 + quad * 4) = acc[nk];
  __syncthreads();
}
DI void phase_chunk(const Params& p, int l, char* lds) {
  for (int it = blockIdx.x; it < NCH; it += gridDim.x) chunk_item(p, l, it, lds);
}

constexpr int ALD = 72;
DI void attn_item(const Params& p, int l, int item, char* lds) {
  const int tid = tid_(), wave = tid >> 6, lane = tid & 63;
  const int m = wave & 1, qh = wave >> 1, q = lane & 31, hh = lane >> 5;
  bf16_t* Ks = (bf16_t*)lds;
  bf16_t* Vs = Ks + 2 * 64 * ALD;
  float* xb = (float*)lds;
  bool samp; int b, h, nch, qrow0, qpos0;
  if (item < 32) { samp = true; b = item >> 2; h = item & 3; nch = 17; qrow0 = MP + b * 64; qpos0 = 1024; }
  else { samp = false; const int a = item - 32; const int qc = 63 - (a >> 4); const int bh = a & 15; b = bh >> 2; h = bh & 3; nch = qc + 1; qrow0 = b * 4096 + qc * 64; qpos0 = qc * 64; }
  bf16x8 qf[4];
  {
    const bf16_t* qp = p.z + (size_t)(qrow0 + qh * 32 + q) * NZ + C_Q + h * 128 + m * 64;
#pragma unroll
    for (int ks = 0; ks < 4; ++ks) qf[ks] = *(const bf16x8*)(qp + ks * 16 + hh * 8);
  }
  const float slope = exp2f(-2.0f * (float)(h + 1));
  const float LOG2E = 1.4426950408889634f;
  const float c1 = 0.125f * LOG2E, sl2 = slope * LOG2E;
  const float qposf = (float)(qpos0 + qh * 32 + q);
  f32x16 O[4];
#pragma unroll
  for (int i = 0; i < 4; ++i)
#pragma unroll
    for (int e = 0; e < 16; ++e) O[i][e] = 0.f;
  float mrun = -1e30f, lrun = 0.f;
  u32x4 rk[4], rv[4];
  auto gload = [&](int j) {
    const bf16_t* kb; size_t kld; const bf16_t* vb; size_t vld;
    if (!samp) { kb = p.z + (size_t)(b * 4096 + j * 64) * NZ + C_K + h * 128; kld = NZ; vb = p.vtp + (size_t)((b * 4 + h) * 128) * 4096 + j * 64; vld = 4096; }
    else if (j < 16) { kb = p.kc + (size_t)(b * 1024 + j * 64) * 512 + h * 128; kld = 512; vb = p.vct + (size_t)((b * 4 + h) * 128) * 1024 + j * 64; vld = 1024; }
    else { kb = p.z + (size_t)(MP + b * 64) * NZ + C_K + h * 128; kld = NZ; vb = p.vts + (size_t)((b * 4 + h) * 128) * 64; vld = 64; }
#pragma unroll
    for (int i = 0; i < 4; ++i) {
      const int c = tid + 256 * i;
      const int mm = c >> 9, key = (c >> 3) & 63, d8 = (c & 7) * 8;
      rk[i] = *(const u32x4*)(kb + (size_t)key * kld + mm * 64 + d8);
      const int vd = c >> 3, k8 = (c & 7) * 8;
      rv[i] = *(const u32x4*)(vb + (size_t)vd * vld + k8);
    }
  };
  auto sstore = [&]() {
#pragma unroll
    for (int i = 0; i < 4; ++i) {
      const int c = tid + 256 * i;
      const int mm = c >> 9, key = (c >> 3) & 63, d8 = (c & 7) * 8;
      *(u32x4*)(Ks + (mm * 64 + key) * ALD + d8) = rk[i];
      const int vd = c >> 3, k8 = (c & 7) * 8;
      *(u32x4*)(Vs + vd * ALD + k8) = rv[i];
    }
  };
  gload(0); sstore(); __syncthreads();
  for (int j = 0; j < nch; ++j) {
    if (j + 1 < nch) gload(j + 1);
    f32x16 s[2];
#pragma unroll
    for (int kt = 0; kt < 2; ++kt) {
#pragma unroll
      for (int e = 0; e < 16; ++e) s[kt][e] = 0.f;
#pragma unroll
      for (int ks = 0; ks < 4; ++ks) {
        const bf16x8 kf = *(const bf16x8*)(Ks + (m * 64 + kt * 32 + q) * ALD + ks * 16 + hh * 8);
        s[kt] = __builtin_amdgcn_mfma_f32_32x32x16_bf16(kf, qf[ks], s[kt], 0, 0, 0);
      }
    }
    float mx = -1e30f;
#pragma unroll
    for (int kt = 0; kt < 2; ++kt)
#pragma unroll
      for (int e = 0; e < 16; ++e) {
        const float kpos = (float)(j * 64 + kt * 32 + (e & 3) + 8 * (e >> 2) + 4 * hh);
        const float v = s[kt][e] * c1 - sl2 * fabsf(qposf - kpos);
        s[kt][e] = v; mx = fmaxf(mx, v);
      }
    mx = fmaxf(mx, __shfl_xor(mx, 32));
    const float mnew = fmaxf(mrun, mx);
    const float alpha = exp2f(mrun - mnew);
    mrun = mnew;
    float ps = 0.f;
#pragma unroll
    for (int kt = 0; kt < 2; ++kt)
#pragma unroll
      for (int e = 0; e < 16; ++e) { const float pe = exp2f(s[kt][e] - mnew); s[kt][e] = pe; ps += pe; }
    lrun = lrun * alpha + ps;
#pragma unroll
    for (int i = 0; i < 4; ++i)
#pragma unroll
      for (int e = 0; e < 16; ++e) O[i][e] *= alpha;
#pragma unroll
    for (int kt = 0; kt < 2; ++kt)
#pragma unroll
      for (int sx = 0; sx < 2; ++sx) {
        u32x4 pb;
        pb[0] = pk2(s[kt][8 * sx + 0], s[kt][8 * sx + 1]); pb[1] = pk2(s[kt][8 * sx + 2], s[kt][8 * sx + 3]);
        pb[2] = pk2(s[kt][8 * sx + 4], s[kt][8 * sx + 5]); pb[3] = pk2(s[kt][8 * sx + 6], s[kt][8 * sx + 7]);
        const bf16x8 pf = __builtin_bit_cast(bf16x8, pb);
#pragma unroll
        for (int vt = 0; vt < 4; ++vt) {
          const bf16_t* vp = Vs + (vt * 32 + q) * ALD + kt * 32 + 16 * sx + 4 * hh;
          const s16x4 lo = *(const s16x4*)vp, hi = *(const s16x4*)(vp + 8);
          const bf16x8 vf = __builtin_shufflevector(lo, hi, 0, 1, 2, 3, 4, 5, 6, 7);
          O[vt] = __builtin_amdgcn_mfma_f32_32x32x16_bf16(vf, pf, O[vt], 0, 0, 0);
        }
      }
    __syncthreads();
    if (j + 1 < nch) sstore();
    __syncthreads();
  }
  const float ltot = lrun + __shfl_xor(lrun, 32);
  const float inv = 1.0f / ltot;
#pragma unroll
  for (int i = 0; i < 4; ++i)
#pragma unroll
    for (int e = 0; e < 16; ++e) O[i][e] *= inv;
  if (m == 1) {
#pragma unroll
    for (int vt = 0; vt < 4; ++vt)
#pragma unroll
      for (int e = 0; e < 16; ++e) { const int vd = vt * 32 + (e & 3) + 8 * (e >> 2) + 4 * hh; xb[(qh * 128 + vd) * 32 + q] = O[vt][e]; }
  }
  __syncthreads();
  if (m == 0) {
    float d1 = 0.f, d2 = 0.f;
    for (int i = 0; i < 64; ++i) { d1 += p.lq1[l * 64 + i] * p.lk1[l * 64 + i]; d2 += p.lq2[l * 64 + i] * p.lk2[l * 64 + i]; }
    const float lam_init = 0.8f - 0.6f * __expf(-0.3f * (float)l);
    const float lam = __expf(d1) - __expf(d2) + lam_init;
    float ss = 0.f;
#pragma unroll
    for (int vt = 0; vt < 4; ++vt)
#pragma unroll
      for (int e = 0; e < 16; ++e) {
        const int vd = vt * 32 + (e & 3) + 8 * (e >> 2) + 4 * hh;
        const float o2 = xb[(qh * 128 + vd) * 32 + q];
        const float o = O[vt][e] - lam * o2; O[vt][e] = o; ss += o * o;
      }
    ss += __shfl_xor(ss, 32);
    const float rstd = rsqrtf(ss * (1.0f / 128.0f) + 1e-5f) * (1.0f - lam_init);
    const size_t row = (size_t)(qrow0 + qh * 32 + q);
    const float* sg = p.subln_g + l * 128;
#pragma unroll
    for (int vt = 0; vt < 4; ++vt)
#pragma unroll
      for (int e4 = 0; e4 < 4; ++e4) {
        const int vd = vt * 32 + 8 * e4 + 4 * hh;
        const u32x2 gu = *(const u32x2*)(p.z + row * NZ + C_GA + h * 128 + vd);
        const f32x4 gv = *(const f32x4*)(sg + vd);
        const float y0 = O[vt][4 * e4 + 0] * rstd * gv[0] * bf_lo(gu[0]);
        const float y1 = O[vt][4 * e4 + 1] * rstd * gv[1] * bf_hi(gu[0]);
        const float y2 = O[vt][4 * e4 + 2] * rstd * gv[2] * bf_lo(gu[1]);
        const float y3 = O[vt][4 * e4 + 3] * rstd * gv[3] * bf_hi(gu[1]);
        u32x2 ov; ov[0] = pk2(y0, y1); ov[1] = pk2(y2, y3);
        *(u32x2*)(p.o_a + row * 512 + h * 128 + vd) = ov;
      }
  }
  __syncthreads();
}

DI void phase_mix(const Params& p, int l, char* lds) {
  const int n_scan = 96, n_attn = 32 + 1024;
  for (int it = blockIdx.x; it < n_scan + n_attn; it += gridDim.x) {
    if (it < n_scan) rec_item(p, l, it, lds); else attn_item(p, l, it - n_scan, lds);
  }
}

DI void phase_merge(const Params& p, int l, char* lds) {
  const int tid = tid_(), wave = tid >> 6, lane = tid & 63;
  const int wm = wave >> 1, wn = wave & 1, l15 = lane & 15, quad = lane >> 4;
  for (int tile = blockIdx.x; tile < 132 * 8; tile += gridDim.x) {
    const int mt = tile >> 3, nt = tile & 7;
    f32x4 a1[4][4]; zero_acc(a1);
    gemm_core<false>(a1, p.o_r + (size_t)mt * 128 * 512, 512, p.wt_brr + (size_t)nt * 128 * 512, 512, 512, lds);
    u32x2 pk[4][4];
#pragma unroll
    for (int mi = 0; mi < 4; ++mi) {
      const int R = mt * 128 + wm * 64 + mi * 16 + l15;
#pragma unroll
      for (int ni = 0; ni < 4; ++ni) {
        const int c = nt * 128 + wn * 64 + ni * 16 + quad * 4;
        const u32x2 g1 = *(const u32x2*)(p.z + (size_t)R * NZ + C_MR + c);
        const f32x4 v1 = a1[mi][ni];
        pk[mi][ni][0] = pk2(bf_lo(g1[0]) * v1[0], bf_hi(g1[0]) * v1[1]);
        pk[mi][ni][1] = pk2(bf_lo(g1[1]) * v1[2], bf_hi(g1[1]) * v1[3]);
      }
    }
    zero_acc(a1);
    gemm_core<false>(a1, p.o_a + (size_t)mt * 128 * 512, 512, p.wt_bra + (size_t)nt * 128 * 512, 512, 512, lds);
#pragma unroll
    for (int mi = 0; mi < 4; ++mi) {
      const int R = mt * 128 + wm * 64 + mi * 16 + l15;
#pragma unroll
      for (int ni = 0; ni < 4; ++ni) {
        const int c = nt * 128 + wn * 64 + ni * 16 + quad * 4;
        const u32x2 g2 = *(const u32x2*)(p.z + (size_t)R * NZ + C_MA + c);
        const f32x4 v2 = a1[mi][ni]; const u32x2 u1 = pk[mi][ni];
        u32x2 o;
        o[0] = pk2(bf_lo(u1[0]) + bf_lo(g2[0]) * v2[0], bf_hi(u1[0]) + bf_hi(g2[0]) * v2[1]);
        o[1] = pk2(bf_lo(u1[1]) + bf_lo(g2[1]) * v2[2], bf_hi(u1[1]) + bf_hi(g2[1]) * v2[3]);
        *(u32x2*)(p.hn + (size_t)R * DM + c) = o;
      }
    }
  }
}
DI void phase_out(const Params& p, int l, char* lds) {
  const int tid = tid_(), wave = tid >> 6, lane = tid & 63;
  const int wm = wave >> 1, wn = wave & 1, l15 = lane & 15, quad = lane >> 4;
  for (int tile = blockIdx.x; tile < 132 * 8; tile += gridDim.x) {
    const int mt = tile >> 3, nt = tile & 7;
    f32x4 acc[4][4]; zero_acc(acc);
    gemm_core<false>(acc, p.hn + (size_t)mt * 128 * DM, DM, p.wt_out + (size_t)nt * 128 * DM, DM, DM, lds);
#pragma unroll
    for (int mi = 0; mi < 4; ++mi) {
      const int R = mt * 128 + wm * 64 + mi * 16 + l15;
      const float* xr = x_row(p, l, R);
#pragma unroll
      for (int ni = 0; ni < 4; ++ni) {
        const int c = nt * 128 + wn * 64 + ni * 16 + quad * 4;
        const f32x4 xv = *(const f32x4*)(xr + c);
        *(f32x4*)(p.out + (size_t)R * DM + c) = xv + acc[mi][ni];
      }
    }
  }
}
DI void phase_ple(const Params& p, int l, char* lds) {
  const int tid = tid_(), wave = tid >> 6, lane = tid & 63;
  const int wm = wave >> 1, wn = wave & 1, l15 = lane & 15, quad = lane >> 4;
  for (int tile = blockIdx.x; tile < 132 * 8; tile += gridDim.x) {
    const int mt = tile >> 3, nt = tile & 7;
    f32x4 a1[4][4]; zero_acc(a1);
    gemm_core<false>(a1, p.hn + (size_t)mt * 128 * DM, DM, p.wt_gate + (size_t)nt * 128 * DM, DM, DM, lds);
    u32x2 pk[4][4];
#pragma unroll
    for (int mi = 0; mi < 4; ++mi)
#pragma unroll
      for (int ni = 0; ni < 4; ++ni) { const f32x4 v = a1[mi][ni]; pk[mi][ni][0] = pk2(sigmoidf_(v[0]), sigmoidf_(v[1])); pk[mi][ni][1] = pk2(sigmoidf_(v[2]), sigmoidf_(v[3])); }
    zero_acc(a1);
    const int r0 = mt * 128;
    const float* pa = r0 < MP ? p.pp + ((size_t)l * MP + r0) * 256 : p.ps + ((size_t)l * MS + (r0 - MP)) * 256;
    gemm_core<true>(a1, pa, 256, p.wt_ple + (size_t)nt * 128 * 256, 256, 256, lds);
#pragma unroll
    for (int mi = 0; mi < 4; ++mi) {
      const int R = mt * 128 + wm * 64 + mi * 16 + l15;
#pragma unroll
      for (int ni = 0; ni < 4; ++ni) {
        const int c = nt * 128 + wn * 64 + ni * 16 + quad * 4;
        float* xo = p.out + (size_t)R * DM + c;
        const f32x4 xv = *(const f32x4*)xo; const f32x4 e = a1[mi][ni]; const u32x2 g = pk[mi][ni];
        f32x4 o;
        o[0] = xv[0] + e[0] * bf_lo(g[0]); o[1] = xv[1] + e[1] * bf_hi(g[0]);
        o[2] = xv[2] + e[2] * bf_lo(g[1]); o[3] = xv[3] + e[3] * bf_hi(g[1]);
        *(f32x4*)xo = o;
      }
    }
  }
}


#define XB_TMO      128
#define XB_XCNT(j)  (256  + 64 * (j))
#define XB_XSUB(j)  (1280 + 64 * (j))
#define XB_XGEN(j)  (2304 + 64 * (j))
#define XB_TOP      3328
#define XB_TOPGEN   3392
#define XCD_BAR_WORDS 3456
#define XB_SPIN_CAP (1u << 18)
#define LAS __attribute__((address_space(3)))
DI unsigned xb_ld(unsigned* p)              { return __hip_atomic_load(p, __ATOMIC_RELAXED, __HIP_MEMORY_SCOPE_AGENT); }
DI unsigned xb_add(unsigned* p, unsigned v) { return __hip_atomic_fetch_add(p, v, __ATOMIC_RELAXED, __HIP_MEMORY_SCOPE_AGENT); }
DI unsigned xb_xcc_id() { return (unsigned)__builtin_amdgcn_s_getreg((3 << 11) | 20) & 0xFu; }
#define XB_SPIN(cond, bar) do { unsigned _sp = 0; while (cond) { __builtin_amdgcn_s_sleep(1); \
    if ((++_sp & 255u) == 0u) { if (xb_ld(&(bar)[XB_TMO])) break; if (_sp > XB_SPIN_CAP) { atomicAdd(&(bar)[XB_TMO], 1u); break; } } } } while (0)
struct XcdBarrier { unsigned* bar; unsigned x; volatile LAS unsigned* st; };
DI XcdBarrier xcd_barrier_post(unsigned* bar, volatile LAS unsigned* st) {
  XcdBarrier b; b.bar = bar; b.x = xb_xcc_id(); b.st = st;
  if (threadIdx.x == 0) (void)xb_add(&bar[XB_XCNT(b.x)], 1u);
  return b;
}
DI void xcd_barrier_complete(unsigned* bar, unsigned x, unsigned& nloc, unsigned& nx) {
  const unsigned G = gridDim.x * gridDim.y * gridDim.z;
  unsigned sum, cnt, mine, sp = 0u;
  for (;;) {
    sum = 0u; cnt = 0u; mine = 0u;
#pragma unroll
    for (unsigned j = 0; j < 16; ++j) { const unsigned c = xb_ld(&bar[XB_XCNT(j)]); sum += c; cnt += (c > 0u) ? 1u : 0u; mine = (j == x) ? c : mine; }
    if (sum == G) break;
    __builtin_amdgcn_s_sleep(1);
    if ((++sp & 255u) == 0u) { if (xb_ld(&bar[XB_TMO])) break; if (sp > XB_SPIN_CAP) { atomicAdd(&bar[XB_TMO], 1u); break; } }
  }
  nloc = mine > 0u ? mine : 1u; nx = cnt > 0u ? cnt : 1u;
}
DI void xcd_barrier(const XcdBarrier& b) {
  asm volatile("s_waitcnt vmcnt(0)" ::: "memory");
  __syncthreads();
  if (threadIdx.x == 0) {
    unsigned* bar = b.bar;
    __builtin_amdgcn_s_waitcnt(0);
    unsigned nloc = b.st[0], nx = b.st[1];
    if (nloc == 0u) { xcd_barrier_complete(bar, b.x, nloc, nx); b.st[0] = nloc; b.st[1] = nx; }
    const unsigned old = xb_add(&bar[XB_XSUB(b.x)], 1u);
    const unsigned gen = old / nloc;
    if (old + 1u == (gen + 1u) * nloc) {
      __builtin_amdgcn_fence(__ATOMIC_RELEASE, "agent");
      asm volatile("s_waitcnt vmcnt(0)" ::: "memory");
      const unsigned og = xb_add(&bar[XB_TOP], 1u);
      const unsigned tg = og / nx;
      if (og + 1u == (tg + 1u) * nx) xb_add(&bar[XB_TOPGEN], 1u);
      else XB_SPIN(xb_ld(&bar[XB_TOPGEN]) == tg, bar);
      __builtin_amdgcn_fence(__ATOMIC_ACQUIRE, "agent");
      xb_add(&bar[XB_XGEN(b.x)], 1u);
      asm volatile("s_waitcnt vmcnt(0)" ::: "memory");
    } else {
      XB_SPIN(xb_ld(&bar[XB_XGEN(b.x)]) == gen, bar);
      __builtin_amdgcn_fence(__ATOMIC_ACQUIRE, "agent");
      asm volatile("s_waitcnt vmcnt(0)" ::: "memory");
    }
  }
  __syncthreads();
}
constexpr int LDS_BYTES = 73728;
DI void run_phase(const Params& p, int ph, int l, char* lds) {
  switch (ph) {
    case 1: phase_norm(p, l, true, lds); break;
    case 2: phase_gemm_in(p, l, lds); break;
    case 3: phase_mix(p, l, lds); break;
    case 4: phase_merge(p, l, lds); break;
    case 5: phase_out(p, l, lds); break;
    case 6: phase_norm(p, l, false, lds); break;
    case 7: phase_ple(p, l, lds); break;
    case 8: phase_chunk(p, l, lds); break;
  }
}

#if MEGA
__global__ void __launch_bounds__(256, 2) k_mega(Params p) {
  __shared__ __attribute__((aligned(16))) char lds[LDS_BYTES];
  __shared__ uint4 xb_words;
  cg::grid_group grid = cg::this_grid();
  if (threadIdx.x == 0) xb_words = make_uint4(0u, 0u, 0u, 0u);
  __syncthreads();
  const XcdBarrier xb = xcd_barrier_post(p.bar, (volatile LAS unsigned*)&xb_words);
#pragma unroll 1
  for (int l = 0; l < NL; ++l) {
    phase_norm(p, l, true, lds);
    if (l == 0) grid.sync(); else xcd_barrier(xb);
    phase_gemm_in(p, l, lds); xcd_barrier(xb);
    phase_chunk(p, l, lds); xcd_barrier(xb);
    phase_mix(p, l, lds); xcd_barrier(xb);
    phase_merge(p, l, lds); xcd_barrier(xb);
    phase_out(p, l, lds); xcd_barrier(xb);
    phase_norm(p, l, false, lds); xcd_barrier(xb);
    phase_ple(p, l, lds); if (l + 1 < NL) xcd_barrier(xb);
  }
}
#else
template <int PH>
__global__ void __launch_bounds__(256, 2) k_phase(Params p, int l) {
  __shared__ __attribute__((aligned(16))) char lds[LDS_BYTES];
  run_phase(p, PH, l, lds);
}
#endif

extern "C" void kernel_launch(void* const* d_in, const int* in_sizes, int n_in, void* d_out, int out_size, void* d_ws, size_t ws_size,
                              hipStream_t stream) {
  Params p{};
  const float** pf = (const float**)&p;
  for (int i = 0; i < 33; ++i) pf[i] = (const float*)d_in[i];
  p.out = (float*)d_out;
  char* w = (char*)d_ws; size_t off = 0;
  auto take = [&](size_t bytes) { char* r = w + off; off += (bytes + 255) & ~(size_t)255; return (bf16_t*)r; };
  p.bar = (unsigned*)take((size_t)XCD_BAR_WORDS * 4);
  p.wt_in = take((size_t)NZ * 1024 * 2);
  p.wt_brr = take((size_t)1024 * 512 * 2);
  p.wt_bra = take((size_t)1024 * 512 * 2);
  p.wt_out = take((size_t)1024 * 1024 * 2);
  p.wt_ple = take((size_t)1024 * 256 * 2);
  p.wt_gate = take((size_t)1024 * 1024 * 2);
  p.w2t = take((size_t)512 * 64 * 2);
  p.a2t = take((size_t)512 * 64 * 2);
  p.z = take((size_t)MT * NZ * 2);
  p.vtp = take((size_t)16 * 128 * 4096 * 2);
  p.vts = take((size_t)32 * 128 * 64 * 2);
  p.kc = take((size_t)8 * 1024 * 512 * 2);
  p.vct = take((size_t)32 * 128 * 1024 * 2);
  p.o_r = take((size_t)MT * 512 * 2);
  p.o_a = take((size_t)MT * 512 * 2);
  p.hn = take((size_t)MT * DM * 2);
  p.cPT = p.hn;
  p.cG = take((size_t)NCH * 4096 * 2);
  p.cRT = take((size_t)NCH * 2048 * 2);
  p.cOI = take((size_t)NCH * 2048 * 2);
  p.cBA = take((size_t)NCH * 2048 * 2);
  if (off > ws_size) { fprintf(stderr, "workspace too small: need %zu have %zu\n", off, ws_size); return; }
#if MEGA
  hipMemsetAsync(p.bar, 0, (size_t)XCD_BAR_WORDS * 4, stream);
  static int grid_blocks = 0;
  if (!grid_blocks) {
    int dev = 0, cus = 0, per_cu = 0;
    hipGetDevice(&dev);
    hipDeviceGetAttribute(&cus, hipDeviceAttributeMultiprocessorCount, dev);
    hipOccupancyMaxActiveBlocksPerMultiprocessor(&per_cu, k_mega, 256, 0);
    if (per_cu > 2) per_cu = 2;
    grid_blocks = cus * per_cu;
  }
  void* args[] = {&p};
  hipError_t e = hipLaunchCooperativeKernel((void*)k_mega, dim3(grid_blocks), dim3(256), args, 0, stream);
  if (e != hipSuccess) fprintf(stderr, "cooperative launch failed: %s (grid %d)\n", hipGetErrorString(e), grid_blocks);
#else
  const int G = 512;
  for (int l = 0; l < NL; ++l) {
    k_phase<1><<<G, 256, 0, stream>>>(p, l);
    k_phase<2><<<G, 256, 0, stream>>>(p, l);
    k_phase<8><<<G, 256, 0, stream>>>(p, l);
    k_phase<3><<<G, 256, 0, stream>>>(p, l);
    k_phase<4><<<G, 256, 0, stream>>>(p, l);
    k_phase<5><<<G, 256, 0, stream>>>(p, l);
    k_phase<6><<<G, 256, 0, stream>>>(p, l);
    k_phase<7><<<G, 256, 0, stream>>>(p, l);
  }
#endif
}
```

```cpp
#include <hip/hip_runtime.h>
#include <hip/hip_cooperative_groups.h>
#include <stdint.h>
#include <stdio.h>
namespace cg = cooperative_groups;

#ifndef MEGA
#define MEGA 1
#endif

typedef unsigned short bf16_t;
typedef short bf16x8 __attribute__((ext_vector_type(8)));
typedef short s16x4 __attribute__((ext_vector_type(4)));
typedef float f32x4 __attribute__((ext_vector_type(4)));
typedef float f32x2 __attribute__((ext_vector_type(2)));
typedef float f32x16 __attribute__((ext_vector_type(16)));
typedef unsigned u32x4 __attribute__((ext_vector_type(4)));
typedef unsigned u32x2 __attribute__((ext_vector_type(2)));
typedef __bf16 bfv2 __attribute__((ext_vector_type(2)));

#define DI __device__ __forceinline__
#define XCD_BAR_WORDS 3456
DI int tid_() { int t = threadIdx.x; asm volatile("" : "+v"(t)); return t; }

constexpr int DM = 1024, MP = 16384, MS = 512, MT = 16896, NZ = 6272, NL = 4;
constexpr int C_GR = 1664, C_Q = 2176, C_K = 2688, C_V = 3200, C_GA = 3712, C_MR = 4224, C_MA = 5248;
constexpr int SHC = 1664;
constexpr size_t O_YP = 0, O_YS = 16777216, O_KP = 17301504, O_VP = 50855936, O_WP = 84410368, O_SP = 84934656,
                 O_KS = 84961280, O_VS = 86009856, O_WS = 87058432, O_SS = 88107008;

struct Params {
  const float *xp, *xs, *pp, *ps, *ck, *cv, *swkv, *sshift;
  const float *norm_g, *w_in, *shift_mu, *decay_w0, *decay_w2, *iclr_a0, *iclr_a2, *k_k, *k_a, *r_k, *lnx_g, *lnx_b,
      *qng, *kng, *lq1, *lk1, *lq2, *lk2, *subln_g, *w_br_r, *w_br_a, *w_out, *ple_w, *ple_gate_w, *ple_norm_g;
  float* out;
  bf16_t *wt_in, *wt_brr, *wt_bra, *wt_out, *wt_ple, *wt_gate, *w2t, *a2t;
  bf16_t *hn, *z, *vtp, *vts, *kc, *vct, *o_r, *o_a;
  bf16_t *cPT, *cG, *cRT, *cOI, *cBA;
  unsigned* bar;
};

DI unsigned pk2(float a, float b) { f32x2 v = {a, b}; bfv2 r = __builtin_convertvector(v, bfv2); return __builtin_bit_cast(unsigned, r); }
DI float bf_lo(unsigned u) { return __uint_as_float(u << 16); }
DI float bf_hi(unsigned u) { return __uint_as_float(u & 0xffff0000u); }
DI float bf1(bf16_t u) { return __uint_as_float(((unsigned)u) << 16); }
DI float sigmoidf_(float x) { return 1.0f / (1.0f + __expf(-x)); }
DI float siluf_(float x) { return x / (1.0f + __expf(-x)); }

DI void tr_tile(const float* __restrict__ src, int ld_src, bf16_t* __restrict__ dst, int ld_dst, float* sm) {
  const int tid = tid_();
  const int r = tid >> 4, c4 = (tid & 15) * 4;
#pragma unroll
  for (int i = 0; i < 4; ++i) {
    const int row = r + 16 * i;
    f32x4 v = *(const f32x4*)(src + (size_t)row * ld_src + c4);
    sm[row * 65 + c4 + 0] = v[0]; sm[row * 65 + c4 + 1] = v[1]; sm[row * 65 + c4 + 2] = v[2]; sm[row * 65 + c4 + 3] = v[3];
  }
  __syncthreads();
  const int n = tid >> 2, ks = (tid & 3) * 16;
  u32x4 o0, o1;
  o0[0] = pk2(sm[(ks + 0) * 65 + n], sm[(ks + 1) * 65 + n]);   o0[1] = pk2(sm[(ks + 2) * 65 + n], sm[(ks + 3) * 65 + n]);
  o0[2] = pk2(sm[(ks + 4) * 65 + n], sm[(ks + 5) * 65 + n]);   o0[3] = pk2(sm[(ks + 6) * 65 + n], sm[(ks + 7) * 65 + n]);
  o1[0] = pk2(sm[(ks + 8) * 65 + n], sm[(ks + 9) * 65 + n]);   o1[1] = pk2(sm[(ks + 10) * 65 + n], sm[(ks + 11) * 65 + n]);
  o1[2] = pk2(sm[(ks + 12) * 65 + n], sm[(ks + 13) * 65 + n]); o1[3] = pk2(sm[(ks + 14) * 65 + n], sm[(ks + 15) * 65 + n]);
  *(u32x4*)(dst + (size_t)n * ld_dst + ks) = o0;
  *(u32x4*)(dst + (size_t)n * ld_dst + ks + 8) = o1;
  __syncthreads();
}

constexpr int WCONV_TILES = 1568 + 128 + 128 + 256 + 64 + 256 + 8 + 8;
DI void wconv_tile(const Params& p, int l, int t, float* sm) {
  const float* src; bf16_t* dst; int K, N;
  if (t < 1568) { src = p.w_in + (size_t)l * 1024 * NZ; dst = p.wt_in; K = 1024; N = NZ; }
  else if ((t -= 1568) < 128) { src = p.w_br_r + (size_t)l * 512 * 1024; dst = p.wt_brr; K = 512; N = 1024; }
  else if ((t -= 128) < 128) { src = p.w_br_a + (size_t)l * 512 * 1024; dst = p.wt_bra; K = 512; N = 1024; }
  else if ((t -= 128) < 256) { src = p.w_out + (size_t)l * 1024 * 1024; dst = p.wt_out; K = 1024; N = 1024; }
  else if ((t -= 256) < 64) { src = p.ple_w + (size_t)l * 256 * 1024; dst = p.wt_ple; K = 256; N = 1024; }
  else if ((t -= 64) < 256) { src = p.ple_gate_w + (size_t)l * 1024 * 1024; dst = p.wt_gate; K = 1024; N = 1024; }
  else if ((t -= 256) < 8) { src = p.decay_w2 + (size_t)l * 64 * 512; dst = p.w2t; K = 64; N = 512; }
  else { t -= 8; src = p.iclr_a2 + (size_t)l * 64 * 512; dst = p.a2t; K = 64; N = 512; }
  const int ntn = N / 64; const int tk = t / ntn, tn = t % ntn;
  tr_tile(src + (size_t)(tk * 64) * N + tn * 64, N, dst + (size_t)(tn * 64) * K + tk * 64, K, sm);
}

DI const float* x_row(const Params& p, int l, int r) {
  if (l == 0) return r < MP ? p.xp + (size_t)r * DM : p.xs + (size_t)(r - MP) * DM;
  return p.out + (size_t)r * DM;
}
DI void phase_norm(const Params& p, int l, bool first, char* lds) {
  const int tid = tid_(), wave = tid >> 6, lane = tid & 63;
  const float* g = (first ? p.norm_g : p.ple_norm_g) + l * DM;
  const int n_norm = MT / 4;
  const int n_items = n_norm + (first ? 2048 + WCONV_TILES : 0);
  for (int it = blockIdx.x; it < n_items; it += gridDim.x) {
    if (it < n_norm) {
      const int r = it * 4 + wave;
      const float* x = first ? x_row(p, l, r) : p.out + (size_t)r * DM;
      f32x4 v[4]; float ss = 0.f;
#pragma unroll
      for (int i = 0; i < 4; ++i) { v[i] = *(const f32x4*)(x + lane * 4 + 256 * i); ss += v[i][0] * v[i][0] + v[i][1] * v[i][1] + v[i][2] * v[i][2] + v[i][3] * v[i][3]; }
#pragma unroll
      for (int o = 32; o >= 1; o >>= 1) ss += __shfl_xor(ss, o);
      const float rstd = rsqrtf(ss * (1.0f / 1024.0f) + 1e-6f);
#pragma unroll
      for (int i = 0; i < 4; ++i) {
        const f32x4 gv = *(const f32x4*)(g + lane * 4 + 256 * i);
        u32x2 o; o[0] = pk2(v[i][0] * rstd * gv[0], v[i][1] * rstd * gv[1]); o[1] = pk2(v[i][2] * rstd * gv[2], v[i][3] * rstd * gv[3]);
        *(u32x2*)(p.hn + (size_t)r * DM + lane * 4 + 256 * i) = o;
      }
    } else if (it < n_norm + 1024) {
      const int c = it - n_norm;
      const float* src = p.ck + (size_t)l * 8 * 1024 * 512 + (size_t)c * 4096 + tid * 16;
      bf16_t* dst = p.kc + (size_t)c * 4096 + tid * 16;
      f32x4 a0 = *(const f32x4*)(src), a1 = *(const f32x4*)(src + 4), a2 = *(const f32x4*)(src + 8), a3 = *(const f32x4*)(src + 12);
      u32x4 o0, o1;
      o0[0] = pk2(a0[0], a0[1]); o0[1] = pk2(a0[2], a0[3]); o0[2] = pk2(a1[0], a1[1]); o0[3] = pk2(a1[2], a1[3]);
      o1[0] = pk2(a2[0], a2[1]); o1[1] = pk2(a2[2], a2[3]); o1[2] = pk2(a3[0], a3[1]); o1[3] = pk2(a3[2], a3[3]);
      *(u32x4*)dst = o0; *(u32x4*)(dst + 8) = o1;
    } else if (it >= n_norm + 2048) {
      wconv_tile(p, l, it - n_norm - 2048, (float*)lds);
    } else {
      const int c = it - n_norm - 1024;
      const int bh = c >> 5, tt = c & 31; const int b = bh >> 2, h = bh & 3; const int tk = tt >> 1, tn = tt & 1;
      const float* src = p.cv + (size_t)l * 8 * 1024 * 512 + ((size_t)(b * 1024 + tk * 64)) * 512 + h * 128 + tn * 64;
      bf16_t* dst = p.vct + ((size_t)(bh * 128 + tn * 64)) * 1024 + tk * 64;
      tr_tile(src, 512, dst, 1024, (float*)lds);
    }
  }
}

constexpr int GLD = 72;
template <bool A_F32>
DI void gemm_core(f32x4 (&acc)[4][4], const void* Ap, int lda, const bf16_t* Bp, int ldb, int K, char* lds) {
  bf16_t* As = (bf16_t*)lds;
  bf16_t* Bs = (bf16_t*)(lds + 2 * 128 * GLD * 2);
  const int tid = tid_(), wave = tid >> 6, lane = tid & 63;
  const int wm = wave >> 1, wn = wave & 1, l15 = lane & 15, quad = lane >> 4;
  const int nk = K / 64;
  u32x4 ra[4], rb[4];
  auto gload = [&](int kt) {
#pragma unroll
    for (int i = 0; i < 4; ++i) {
      const int c = tid + 256 * i; const int row = c >> 3, c8 = (c & 7) * 8;
      if (!A_F32) ra[i] = *(const u32x4*)((const bf16_t*)Ap + (size_t)row * lda + kt * 64 + c8);
      rb[i] = *(const u32x4*)(Bp + (size_t)row * ldb + kt * 64 + c8);
    }
  };
  auto sstore = [&](int buf, int kt) {
#pragma unroll
    for (int i = 0; i < 4; ++i) {
      const int c = tid + 256 * i; const int row = c >> 3, c8 = (c & 7) * 8;
      if (A_F32) {
        const float* a = (const float*)Ap + (size_t)row * lda + kt * 64 + c8;
        const f32x4 v0 = *(const f32x4*)a, v1 = *(const f32x4*)(a + 4);
        u32x4 t; t[0] = pk2(v0[0], v0[1]); t[1] = pk2(v0[2], v0[3]); t[2] = pk2(v1[0], v1[1]); t[3] = pk2(v1[2], v1[3]);
        *(u32x4*)(As + (buf * 128 + row) * GLD + c8) = t;
      } else {
        *(u32x4*)(As + (buf * 128 + row) * GLD + c8) = ra[i];
      }
      *(u32x4*)(Bs + (buf * 128 + row) * GLD + c8) = rb[i];
    }
  };
  gload(0); sstore(0, 0); __syncthreads();
  for (int kt = 0; kt < nk; ++kt) {
    const int buf = kt & 1;
    if (kt + 1 < nk) gload(kt + 1);
#pragma unroll
    for (int ks = 0; ks < 2; ++ks) {
      bf16x8 af[4], bfr[4];
#pragma unroll
      for (int i = 0; i < 4; ++i) {
        af[i] = *(const bf16x8*)(As + (buf * 128 + wm * 64 + i * 16 + l15) * GLD + ks * 32 + quad * 8);
        bfr[i] = *(const bf16x8*)(Bs + (buf * 128 + wn * 64 + i * 16 + l15) * GLD + ks * 32 + quad * 8);
      }
#pragma unroll
      for (int mi = 0; mi < 4; ++mi)
#pragma unroll
        for (int ni = 0; ni < 4; ++ni) acc[mi][ni] = __builtin_amdgcn_mfma_f32_16x16x32_bf16(bfr[ni], af[mi], acc[mi][ni], 0, 0, 0);
    }
    if (kt + 1 < nk) sstore(buf ^ 1, kt + 1);
    __syncthreads();
  }
}
DI void zero_acc(f32x4 (&acc)[4][4]) {
#pragma unroll
  for (int i = 0; i < 4; ++i)
#pragma unroll
    for (int j = 0; j < 4; ++j) acc[i][j] = (f32x4){0.f, 0.f, 0.f, 0.f};
}

DI void phase_gemm_in(const Params& p, int l, char* lds) {
  const int tid = tid_(), wave = tid >> 6, lane = tid & 63;
  const int wm = wave >> 1, wn = wave & 1, l15 = lane & 15, quad = lane >> 4;
  const bf16_t* Wt = p.wt_in;
  const int NTN = 49, NTM = 132;
  for (int tile = blockIdx.x; tile < NTN * NTM; tile += gridDim.x) {
    const int mt = tile / NTN, nt = tile % NTN;
    f32x4 acc[4][4]; zero_acc(acc);
    gemm_core<false>(acc, p.hn + (size_t)mt * 128 * DM, DM, Wt + (size_t)nt * 128 * DM, DM, DM, lds);
    const int colb = nt * 128 + wn * 64 + quad * 4;
    int kind;
    if (nt < 13) kind = 0; else if (nt < 17) kind = 1; else if (nt < 21) kind = 2; else if (nt < 25) kind = 3; else if (nt < 29) kind = 4; else if (nt < 33) kind = 1; else kind = 5;
#pragma unroll
    for (int mi = 0; mi < 4; ++mi) {
      const int R = mt * 128 + wm * 64 + mi * 16 + l15;
      const bool isp = R < MP; const int rs = R - MP;
      bf16_t* zrow = p.z + (size_t)R * NZ;
      if (kind == 0) {
        const bool last = isp ? ((R & 4095) == 4095) : ((rs & 63) == 63);
        float* so = isp ? p.out + O_SP + (size_t)(l * 4 + (R >> 12)) * SHC : p.out + O_SS + (size_t)(l * 8 + (rs >> 6)) * SHC;
#pragma unroll
        for (int ni = 0; ni < 4; ++ni) {
          const int c = colb + ni * 16; const f32x4 v = acc[mi][ni];
          u32x2 o; o[0] = pk2(v[0], v[1]); o[1] = pk2(v[2], v[3]); *(u32x2*)(zrow + c) = o;
          if (last) *(f32x4*)(so + c) = v;
        }
      } else if (kind == 1 || kind == 5) {
#pragma unroll
        for (int ni = 0; ni < 4; ++ni) {
          const int c = colb + ni * 16; f32x4 v = acc[mi][ni];
#pragma unroll
          for (int e = 0; e < 4; ++e) v[e] = (kind == 1) ? siluf_(v[e]) : sigmoidf_(v[e]);
          u32x2 o; o[0] = pk2(v[0], v[1]); o[1] = pk2(v[2], v[3]); *(u32x2*)(zrow + c) = o;
        }
      } else if (kind == 2 || kind == 3) {
        float ss = 0.f;
#pragma unroll
        for (int ni = 0; ni < 4; ++ni) { const f32x4 v = acc[mi][ni]; ss += v[0] * v[0] + v[1] * v[1] + v[2] * v[2] + v[3] * v[3]; }
        ss += __shfl_xor(ss, 16); ss += __shfl_xor(ss, 32);
        const float rstd = rsqrtf(ss * (1.0f / 64.0f) + 1e-6f);
        const float* g = (kind == 2 ? p.qng : p.kng) + l * 64;
        float* ko = isp ? p.out + O_KP + ((size_t)l * MP + R) * 512 : p.out + O_KS + ((size_t)l * MS + rs) * 512;
#pragma unroll
        for (int ni = 0; ni < 4; ++ni) {
          const int c = colb + ni * 16; const int d = ni * 16 + quad * 4;
          const f32x4 gv = *(const f32x4*)(g + d); f32x4 v = acc[mi][ni];
#pragma unroll
          for (int e = 0; e < 4; ++e) v[e] = v[e] * rstd * gv[e];
          u32x2 o; o[0] = pk2(v[0], v[1]); o[1] = pk2(v[2], v[3]); *(u32x2*)(zrow + c) = o;
          if (kind == 3) *(f32x4*)(ko + (c - C_K)) = v;
        }
      } else {
        float* vo = isp ? p.out + O_VP + ((size_t)l * MP + R) * 512 : p.out + O_VS + ((size_t)l * MS + rs) * 512;
#pragma unroll
        for (int ni = 0; ni < 4; ++ni) {
          const int cv = colb + ni * 16 - C_V; const f32x4 v = acc[mi][ni];
          *(f32x4*)(vo + cv) = v;
          const int h = cv >> 7, vd = cv & 127;
          if (isp) {
            bf16_t* vt = p.vtp + ((size_t)(((R >> 12) * 4 + h) * 128 + vd)) * 4096 + (R & 4095);
#pragma unroll
            for (int e = 0; e < 4; ++e) vt[(size_t)e * 4096] = (bf16_t)(pk2(v[e], 0.f) & 0xffff);
          } else {
            bf16_t* vt = p.vts + ((size_t)(((rs >> 6) * 4 + h) * 128 + vd)) * 64 + (rs & 63);
#pragma unroll
            for (int e = 0; e < 4; ++e) vt[(size_t)e * 64] = (bf16_t)(pk2(v[e], 0.f) & 0xffff);
          }
        }
      }
    }
  }
}

constexpr int NCH_P = 4096, NCH = 4224;
constexpr int XLD = 40;
DI f32x4 mm16(const bf16_t* Xrow, int ldx, const bf16_t* Yrow, int ldy, int ksteps, f32x4 acc, int l15, int quad) {
  for (int ks = 0; ks < ksteps; ++ks) {
    const bf16x8 a = *(const bf16x8*)(Xrow + l15 * ldx + ks * 32 + quad * 8);
    const bf16x8 b = *(const bf16x8*)(Yrow + l15 * ldy + ks * 32 + quad * 8);
    acc = __builtin_amdgcn_mfma_f32_16x16x32_bf16(a, b, acc, 0, 0, 0);
  }
  return acc;
}
DI void chunk_item(const Params& p, int l, int item, char* lds) {
  const int tid = tid_(), wave = tid >> 6, lane = tid & 63, l15 = lane & 15, quad = lane >> 4;
  const bool isp = item < NCH_P;
  int bh, c;
  if (isp) { bh = item >> 7; c = item & 127; } else { const int j = item - NCH_P; bh = j >> 1; c = j & 1; }
  const int b = bh >> 3, h = bh & 7;
  const int t0 = c * 32; const int row0 = (isp ? b * 4096 : MP + b * 64) + t0;
  float* s_r = (float*)lds;
  float* s_kf = s_r + 2048;
  float* s_v = s_kf + 2048;
  float* s_w = s_v + 2048;
  float* s_kk = s_w + 2048;
  float* s_bb = s_kk + 2048;
  bf16_t* s_wd = (bf16_t*)(lds + 49152);
  bf16_t* s_ad = (bf16_t*)(lds + 53760);
  float* s_bonus = (float*)(lds + 58368);
  float* s_wl = (float*)(lds + 58496);
  float* s_rhs = (float*)lds;
  bf16_t* s_A = (bf16_t*)lds;
  bf16_t* s_Bm = (bf16_t*)(lds + 4608);
  bf16_t* s_Kp = (bf16_t*)(lds + 9216);
  bf16_t* s_R = (bf16_t*)(lds + 16384);
  bf16_t* s_BmT = (bf16_t*)(lds + 20992);
  bf16_t* s_KpT = (bf16_t*)(lds + 26112);
  bf16_t* s_VmT = (bf16_t*)(lds + 31232);
  bf16_t* s_Lak = (bf16_t*)(lds + 36352);
  bf16_t* s_Mrk = (bf16_t*)(lds + 38912);
  bf16_t* s_Mrb = (bf16_t*)(lds + 41472);
  float* s_lab = (float*)(lds + 44032);
  bf16_t* s_XT = (bf16_t*)(lds + 48256);

  const int mat = wave >> 1, tt = wave & 1;
  const bf16_t* wl = (mat == 0 ? p.w2t : p.a2t) + (size_t)(h * 64) * 64;
  const float* mu = p.shift_mu + l * SHC;
  const float* w0 = p.decay_w0 + l * 512 + h * 64;
  const float* a0 = p.iclr_a0 + l * 512 + h * 64;
  const float* kkp = p.k_k + l * 512 + h * 64;
  const float* kap = p.k_a + l * 512 + h * 64;
  const float* rkp = p.r_k + l * 512 + h * 64;
  const float* lb = p.lnx_b + l * 512 + h * 64;
  const int ptok = tid >> 3, pcs = (tid & 7) * 8;
  {
    const int t = t0 + ptok; const size_t row = (size_t)(row0 + ptok);
#pragma unroll
    for (int g = 0; g < 5; ++g) {
      const int zc = (g < 3 ? g * 512 + h * 64 : 1536 + (g - 3) * 64) + pcs;
      const u32x4 cu = *(const u32x4*)(p.z + row * NZ + zc);
      float cur[8], prv[8];
#pragma unroll
      for (int e = 0; e < 4; ++e) { cur[2 * e] = bf_lo(cu[e]); cur[2 * e + 1] = bf_hi(cu[e]); }
      if (t > 0) {
        const u32x4 pu = *(const u32x4*)(p.z + (row - 1) * NZ + zc);
#pragma unroll
        for (int e = 0; e < 4; ++e) { prv[2 * e] = bf_lo(pu[e]); prv[2 * e + 1] = bf_hi(pu[e]); }
      } else if (isp) {
#pragma unroll
        for (int e = 0; e < 8; ++e) prv[e] = 0.f;
      } else {
        const float* sp = p.sshift + (size_t)(l * 8 + b) * SHC + zc;
#pragma unroll
        for (int e = 0; e < 8; ++e) prv[e] = sp[e];
      }
      float zs[8];
#pragma unroll
      for (int e = 0; e < 8; ++e) zs[e] = cur[e] + (prv[e] - cur[e]) * mu[zc + e];
      if (g < 3) {
        float* d = (g == 0 ? s_r : g == 1 ? s_kf : s_v) + ptok * 64 + pcs;
        *(f32x4*)d = (f32x4){zs[0], zs[1], zs[2], zs[3]}; *(f32x4*)(d + 4) = (f32x4){zs[4], zs[5], zs[6], zs[7]};
      } else {
        if (g == 3) {
#pragma unroll
          for (int e = 0; e < 8; ++e) { const float ex = __expf(2.f * zs[e]); zs[e] = 1.f - 2.f / (ex + 1.f); }
        }
        u32x4 o; o[0] = pk2(zs[0], zs[1]); o[1] = pk2(zs[2], zs[3]); o[2] = pk2(zs[4], zs[5]); o[3] = pk2(zs[6], zs[7]);
        *(u32x4*)((g == 3 ? s_wd : s_ad) + ptok * 72 + pcs) = o;
      }
    }
  }
  __syncthreads();
  {
    const bf16_t* At = (mat == 0 ? s_wd : s_ad);
    bf16x8 af[2];
#pragma unroll
    for (int ks = 0; ks < 2; ++ks) af[ks] = *(const bf16x8*)(At + (tt * 16 + l15) * 72 + ks * 32 + quad * 8);
#pragma unroll
    for (int ct = 0; ct < 4; ++ct) {
      f32x4 d = (f32x4){0.f, 0.f, 0.f, 0.f};
#pragma unroll
      for (int ks = 0; ks < 2; ++ks) {
        const bf16x8 wfr = *(const bf16x8*)(wl + (size_t)(ct * 16 + l15) * 64 + ks * 32 + quad * 8);
        d = __builtin_amdgcn_mfma_f32_16x16x32_bf16(wfr, af[ks], d, 0, 0, 0);
      }
      const int ch = ct * 16 + quad * 4; const int tok = tt * 16 + l15;
      f32x4 o;
      if (mat == 0) {
#pragma unroll
        for (int e = 0; e < 4; ++e) {
          const float y = -(w0[ch + e] + d[e]);
          const float sp = fmaxf(y, 0.f) + log1pf(__expf(-fabsf(y)));
          o[e] = -__expf(-sp - 0.5f);
        }
        *(f32x4*)(s_w + tok * 64 + ch) = o;
      } else {
#pragma unroll
        for (int e = 0; e < 4; ++e) o[e] = sigmoidf_(a0[ch + e] + d[e]);
        *(f32x4*)(s_bb + tok * 64 + ch) = o;
      }
    }
  }
  __syncthreads();
  float r_[8], kf[8], kk[8], bbv[8], v_[8], bon;
  {
    float k_[8], a_[8];
    *(f32x4*)&k_[0] = *(const f32x4*)(s_kf + ptok * 64 + pcs); *(f32x4*)&k_[4] = *(const f32x4*)(s_kf + ptok * 64 + pcs + 4);
    *(f32x4*)&a_[0] = *(const f32x4*)(s_bb + ptok * 64 + pcs); *(f32x4*)&a_[4] = *(const f32x4*)(s_bb + ptok * 64 + pcs + 4);
    *(f32x4*)&r_[0] = *(const f32x4*)(s_r + ptok * 64 + pcs); *(f32x4*)&r_[4] = *(const f32x4*)(s_r + ptok * 64 + pcs + 4);
    *(f32x4*)&v_[0] = *(const f32x4*)(s_v + ptok * 64 + pcs); *(f32x4*)&v_[4] = *(const f32x4*)(s_v + ptok * 64 + pcs + 4);
    float ss = 0.f; bon = 0.f;
#pragma unroll
    for (int e = 0; e < 8; ++e) {
      kk[e] = k_[e] * kkp[pcs + e]; ss += kk[e] * kk[e];
      kf[e] = k_[e] * (1.f + (a_[e] - 1.f) * kap[pcs + e]);
      bon += r_[e] * kf[e] * rkp[pcs + e];
    }
    ss += __shfl_xor(ss, 1); ss += __shfl_xor(ss, 2); ss += __shfl_xor(ss, 4);
    bon += __shfl_xor(bon, 1); bon += __shfl_xor(bon, 2); bon += __shfl_xor(bon, 4);
    const float inv = 1.0f / fmaxf(sqrtf(ss), 1e-12f);
#pragma unroll
    for (int e = 0; e < 8; ++e) { kk[e] *= inv; bbv[e] = kk[e] * a_[e]; }
  }
  if (tid < 64) {
    float run = 0.f;
#pragma unroll 8
    for (int t = 0; t < 32; ++t) { run += s_w[t * 64 + tid]; s_w[t * 64 + tid] = run; }
  }
  __syncthreads();
  {
    float cw[8], cwp[8];
    *(f32x4*)&cw[0] = *(const f32x4*)(s_w + ptok * 64 + pcs); *(f32x4*)&cw[4] = *(const f32x4*)(s_w + ptok * 64 + pcs + 4);
    if (ptok > 0) { *(f32x4*)&cwp[0] = *(const f32x4*)(s_w + (ptok - 1) * 64 + pcs); *(f32x4*)&cwp[4] = *(const f32x4*)(s_w + (ptok - 1) * 64 + pcs + 4); }
    else {
#pragma unroll
      for (int e = 0; e < 8; ++e) cwp[e] = 0.f;
    }
    __syncthreads();
    float av[8], bm[8], kp[8], rr[8];
#pragma unroll
    for (int e = 0; e < 8; ++e) {
      const float ec = __expf(cw[e]), en = __expf(-cw[e]), ep = __expf(cwp[e]);
      av[e] = kk[e] * ep; bm[e] = bbv[e] * en; kp[e] = kf[e] * en; rr[e] = r_[e] * ec;
      if (ptok == 31) s_wl[pcs + e] = ec;
    }
    u32x4 o;
    o[0] = pk2(av[0], av[1]); o[1] = pk2(av[2], av[3]); o[2] = pk2(av[4], av[5]); o[3] = pk2(av[6], av[7]); *(u32x4*)(s_A + ptok * 72 + pcs) = o;
    o[0] = pk2(bm[0], bm[1]); o[1] = pk2(bm[2], bm[3]); o[2] = pk2(bm[4], bm[5]); o[3] = pk2(bm[6], bm[7]); *(u32x4*)(s_Bm + ptok * 72 + pcs) = o;
#pragma unroll
    for (int e = 0; e < 4; ++e) { s_BmT[(pcs + 2 * e) * XLD + ptok] = (bf16_t)(o[e] & 0xffff); s_BmT[(pcs + 2 * e + 1) * XLD + ptok] = (bf16_t)(o[e] >> 16); }
    o[0] = pk2(kp[0], kp[1]); o[1] = pk2(kp[2], kp[3]); o[2] = pk2(kp[4], kp[5]); o[3] = pk2(kp[6], kp[7]); *(u32x4*)(s_Kp + ptok * 72 + pcs) = o;
#pragma unroll
    for (int e = 0; e < 4; ++e) { s_KpT[(pcs + 2 * e) * XLD + ptok] = (bf16_t)(o[e] & 0xffff); s_KpT[(pcs + 2 * e + 1) * XLD + ptok] = (bf16_t)(o[e] >> 16); }
    o[0] = pk2(rr[0], rr[1]); o[1] = pk2(rr[2], rr[3]); o[2] = pk2(rr[4], rr[5]); o[3] = pk2(rr[6], rr[7]); *(u32x4*)(s_R + ptok * 72 + pcs) = o;
    o[0] = pk2(v_[0], v_[1]); o[1] = pk2(v_[2], v_[3]); o[2] = pk2(v_[4], v_[5]); o[3] = pk2(v_[6], v_[7]);
#pragma unroll
    for (int e = 0; e < 4; ++e) { s_VmT[(pcs + 2 * e) * XLD + ptok] = (bf16_t)(o[e] & 0xffff); s_VmT[(pcs + 2 * e + 1) * XLD + ptok] = (bf16_t)(o[e] >> 16); }
    u32x4 ob;
    ob[0] = pk2(lb[pcs + 0] + bon * v_[0], lb[pcs + 1] + bon * v_[1]); ob[1] = pk2(lb[pcs + 2] + bon * v_[2], lb[pcs + 3] + bon * v_[3]);
    ob[2] = pk2(lb[pcs + 4] + bon * v_[4], lb[pcs + 5] + bon * v_[5]); ob[3] = pk2(lb[pcs + 6] + bon * v_[6], lb[pcs + 7] + bon * v_[7]);
    *(u32x4*)(p.cBA + ((size_t)item * 32 + ptok) * 64 + pcs) = ob;
  }
  __syncthreads();
  {
    const bf16_t* X = (wave < 2) ? s_A : s_R;
    const bf16_t* Y = (wave == 0 || wave == 3) ? s_Bm : s_Kp;
    const bool strict = wave < 2;
#pragma unroll
    for (int ti = 0; ti < 2; ++ti)
#pragma unroll
      for (int ii = 0; ii < 2; ++ii) {
        f32x4 d = (f32x4){0.f, 0.f, 0.f, 0.f};
        if (ii <= ti) d = mm16(X + ti * 16 * 72, 72, Y + ii * 16 * 72, 72, 2, d, l15, quad);
        const int i = ii * 16 + l15;
#pragma unroll
        for (int e = 0; e < 4; ++e) {
          const int t = ti * 16 + quad * 4 + e;
          const bool keep = strict ? (i < t) : (i <= t);
          const float val = keep ? d[e] : 0.f;
          if (wave == 0) s_lab[t * 33 + i] = val;
          else { bf16_t* dst = (wave == 1 ? s_Lak : wave == 2 ? s_Mrk : s_Mrb); dst[t * XLD + i] = (bf16_t)(pk2(val, 0.f) & 0xffff); }
        }
      }
  }
  const u32x4 acap = *(const u32x4*)(s_A + ptok * 72 + pcs);
  __syncthreads();
  {
    float* d = s_rhs + ptok * 128 + pcs;
    *(f32x4*)d = (f32x4){bf_lo(acap[0]), bf_hi(acap[0]), bf_lo(acap[1]), bf_hi(acap[1])};
    *(f32x4*)(d + 4) = (f32x4){bf_lo(acap[2]), bf_hi(acap[2]), bf_lo(acap[3]), bf_hi(acap[3])};
  }
  {
    const int ti = wave & 1;
#pragma unroll
    for (int vv = 0; vv < 2; ++vv) {
      const int vi = (wave >> 1) * 2 + vv;
      f32x4 d = (f32x4){0.f, 0.f, 0.f, 0.f};
      d = mm16(s_Lak + ti * 16 * XLD, XLD, s_VmT + vi * 16 * XLD, XLD, 1, d, l15, quad);
#pragma unroll
      for (int e = 0; e < 4; ++e) s_rhs[(ti * 16 + quad * 4 + e) * 128 + 64 + vi * 16 + l15] = d[e];
    }
  }
  __syncthreads();
  if (tid < 128) {
    float x[32];
#pragma unroll
    for (int t = 0; t < 32; ++t) {
      float a = s_rhs[t * 128 + tid];
#pragma unroll
      for (int i = 0; i < t; ++i) a -= s_lab[t * 33 + i] * x[i];
      x[t] = a;
    }
#pragma unroll
    for (int q4 = 0; q4 < 4; ++q4) {
      u32x4 o; o[0] = pk2(x[8 * q4], x[8 * q4 + 1]); o[1] = pk2(x[8 * q4 + 2], x[8 * q4 + 3]); o[2] = pk2(x[8 * q4 + 4], x[8 * q4 + 5]); o[3] = pk2(x[8 * q4 + 6], x[8 * q4 + 7]);
      *(u32x4*)(s_XT + tid * XLD + q4 * 8) = o;
    }
  }
  __syncthreads();
  {
    const f32x4 z4 = (f32x4){0.f, 0.f, 0.f, 0.f};
    bf16_t* gPT = p.cPT + (size_t)item * 4096;
    const float wl_c = s_wl[wave * 16 + l15];
#pragma unroll
    for (int k1t = 0; k1t < 4; ++k1t) {
      f32x4 d = mm16(s_XT + k1t * 16 * XLD, XLD, s_BmT + wave * 16 * XLD, XLD, 1, z4, l15, quad);
      const int k2 = wave * 16 + l15, k1 = k1t * 16 + quad * 4;
      float o[4];
#pragma unroll
      for (int e = 0; e < 4; ++e) o[e] = ((k1 + e == k2 ? 1.f : 0.f) - d[e]) * wl_c;
      u32x2 ov; ov[0] = pk2(o[0], o[1]); ov[1] = pk2(o[2], o[3]);
      *(u32x2*)(gPT + k2 * 64 + k1) = ov;
    }
    bf16_t* gG = p.cG + (size_t)item * 4096;
#pragma unroll
    for (int k2t = 0; k2t < 4; ++k2t) {
      const f32x4 d1 = mm16(s_KpT + k2t * 16 * XLD, XLD, s_VmT + wave * 16 * XLD, XLD, 1, z4, l15, quad);
      const f32x4 d2 = mm16(s_BmT + k2t * 16 * XLD, XLD, s_XT + (64 + wave * 16) * XLD, XLD, 1, z4, l15, quad);
      const int k2 = k2t * 16 + quad * 4, v = wave * 16 + l15;
      const f32x4 wv = *(const f32x4*)(s_wl + k2);
      u32x2 ov; ov[0] = pk2((d1[0] - d2[0]) * wv[0], (d1[1] - d2[1]) * wv[1]); ov[1] = pk2((d1[2] - d2[2]) * wv[2], (d1[3] - d2[3]) * wv[3]);
      *(u32x2*)(gG + v * 64 + k2) = ov;
    }
    bf16_t* gRT = p.cRT + (size_t)item * 2048;
    bf16_t* gOI = p.cOI + (size_t)item * 2048;
#pragma unroll
    for (int ti = 0; ti < 2; ++ti) {
      const f32x4 d = mm16(s_XT + wave * 16 * XLD, XLD, s_Mrb + ti * 16 * XLD, XLD, 1, z4, l15, quad);
      const int t = ti * 16 + l15, k = wave * 16 + quad * 4;
      const u32x2 rv = *(const u32x2*)(s_R + t * 72 + k);
      u32x2 ov; ov[0] = pk2(bf_lo(rv[0]) - d[0], bf_hi(rv[0]) - d[1]); ov[1] = pk2(bf_lo(rv[1]) - d[2], bf_hi(rv[1]) - d[3]);
      *(u32x2*)(gRT + t * 64 + k) = ov;
      const f32x4 e1 = mm16(s_VmT + wave * 16 * XLD, XLD, s_Mrk + ti * 16 * XLD, XLD, 1, z4, l15, quad);
      const f32x4 e2 = mm16(s_XT + (64 + wave * 16) * XLD, XLD, s_Mrb + ti * 16 * XLD, XLD, 1, z4, l15, quad);
      u32x2 oo; oo[0] = pk2(e1[0] - e2[0], e1[1] - e2[1]); oo[1] = pk2(e1[2] - e2[2], e1[3] - e2[3]);
      *(u32x2*)(gOI + t * 64 + k) = oo;
    }
  }
  __syncthreads();
}

DI void rec_item(const Params& p, int l, int item, char* lds) {
  const int tid = tid_(), wave = tid >> 6, lane = tid & 63, l15 = lane & 15, quad = lane >> 4;
  const bool isp = item < 32;
  const int bh = isp ? item : item - 32; const int b = bh >> 3, h = bh & 7;
  const int nch = isp ? 128 : 2; const int cid0 = isp ? bh * 128 : NCH_P + bh * 2;
  const int row0 = isp ? b * 4096 : MP + b * 64;
  bf16_t* Sb = (bf16_t*)lds;
  const int v = wave * 16 + l15;
  f32x4 acc[4];
  if (isp) {
#pragma unroll
    for (int nk = 0; nk < 4; ++nk) acc[nk] = (f32x4){0.f, 0.f, 0.f, 0.f};
  } else {
    const float* sp = p.swkv + (((size_t)(l * 8 + b) * 8 + h) * 64 + v) * 64;
#pragma unroll
    for (int nk = 0; nk < 4; ++nk) acc[nk] = *(const f32x4*)(sp + nk * 16 + quad * 4);
  }
#pragma unroll
  for (int nk = 0; nk < 4; ++nk) { u32x2 o; o[0] = pk2(acc[nk][0], acc[nk][1]); o[1] = pk2(acc[nk][2], acc[nk][3]); *(u32x2*)(Sb + v * 72 + nk * 16 + quad * 4) = o; }
  __syncthreads();
  const float* lg = p.lnx_g + l * 512 + h * 64;
  f32x4 lgv[4];
#pragma unroll
  for (int vt = 0; vt < 4; ++vt) lgv[vt] = *(const f32x4*)(lg + vt * 16 + quad * 4);
  bf16x8 pt[4][2]; u32x2 gv[4]; bf16x8 rt[2]; u32x2 oi[4], ba[4], gt[4];
  const int tok = (wave & 1) * 16 + l15;
  auto ld_pg = [&](int c) {
    const size_t cid = (size_t)(cid0 + c);
    const bf16_t* gPT = p.cPT + cid * 4096; const bf16_t* gG = p.cG + cid * 4096;
#pragma unroll
    for (int nk = 0; nk < 4; ++nk) {
#pragma unroll
      for (int ks = 0; ks < 2; ++ks) pt[nk][ks] = *(const bf16x8*)(gPT + (nk * 16 + l15) * 64 + ks * 32 + quad * 8);
      gv[nk] = *(const u32x2*)(gG + v * 64 + nk * 16 + quad * 4);
    }
  };
  auto ld_ro = [&](int c) {
    const size_t cid = (size_t)(cid0 + c);
#pragma unroll
    for (int ks = 0; ks < 2; ++ks) rt[ks] = *(const bf16x8*)(p.cRT + cid * 2048 + tok * 64 + ks * 32 + quad * 8);
#pragma unroll
    for (int vt = 0; vt < 4; ++vt) oi[vt] = *(const u32x2*)(p.cOI + cid * 2048 + tok * 64 + vt * 16 + quad * 4);
  };
  auto ld_bg = [&](int c) {
    const size_t cid = (size_t)(cid0 + c); const size_t row = (size_t)(row0 + c * 32 + tok);
#pragma unroll
    for (int vt = 0; vt < 4; ++vt) {
      ba[vt] = *(const u32x2*)(p.cBA + cid * 2048 + tok * 64 + vt * 16 + quad * 4);
      gt[vt] = *(const u32x2*)(p.z + row * NZ + C_GR + h * 64 + vt * 16 + quad * 4);
    }
  };
  ld_pg(0); ld_ro(0); ld_bg(0);
#pragma unroll 1
  for (int c = 0; c < nch; ++c) {
    const int buf = c & 1; const int cn = (c + 1 < nch) ? c + 1 : c;
    const size_t row = (size_t)(row0 + c * 32 + tok);
    bf16x8 sf[2];
#pragma unroll
    for (int ks = 0; ks < 2; ++ks) sf[ks] = *(const bf16x8*)(Sb + (buf * 64 + v) * 72 + ks * 32 + quad * 8);
#pragma unroll
    for (int nk = 0; nk < 4; ++nk) {
      f32x4 a = (f32x4){bf_lo(gv[nk][0]), bf_hi(gv[nk][0]), bf_lo(gv[nk][1]), bf_hi(gv[nk][1])};
#pragma unroll
      for (int ks = 0; ks < 2; ++ks) a = __builtin_amdgcn_mfma_f32_16x16x32_bf16(pt[nk][ks], sf[ks], a, 0, 0, 0);
      acc[nk] = a;
    }
    ld_pg(cn);
    f32x4 ao[4];
    if (wave < 2) {
#pragma unroll
      for (int vt = 0; vt < 4; ++vt) {
        f32x4 a = (f32x4){bf_lo(oi[vt][0]), bf_hi(oi[vt][0]), bf_lo(oi[vt][1]), bf_hi(oi[vt][1])};
#pragma unroll
        for (int ks = 0; ks < 2; ++ks) {
          const bf16x8 sa = *(const bf16x8*)(Sb + (buf * 64 + vt * 16 + l15) * 72 + ks * 32 + quad * 8);
          a = __builtin_amdgcn_mfma_f32_16x16x32_bf16(sa, rt[ks], a, 0, 0, 0);
        }
        ao[vt] = a;
      }
    }
    ld_ro(cn);
#pragma unroll
    for (int nk = 0; nk < 4; ++nk) { u32x2 ov; ov[0] = pk2(acc[nk][0], acc[nk][1]); ov[1] = pk2(acc[nk][2], acc[nk][3]); *(u32x2*)(Sb + ((buf ^ 1) * 64 + v) * 72 + nk * 16 + quad * 4) = ov; }
    asm volatile("s_waitcnt lgkmcnt(0)" ::: "memory"); __builtin_amdgcn_s_barrier(); asm volatile("" ::: "memory");
    if (wave < 2) {
      float sm = 0.f;
#pragma unroll
      for (int vt = 0; vt < 4; ++vt) sm += (ao[vt][0] + ao[vt][1]) + (ao[vt][2] + ao[vt][3]);
      sm += __shfl_xor(sm, 16); sm += __shfl_xor(sm, 32);
      const float mean = sm * (1.0f / 64.0f);
      float vr = 0.f;
#pragma unroll
      for (int vt = 0; vt < 4; ++vt)
#pragma unroll
        for (int e = 0; e < 4; ++e) { const float d = ao[vt][e] - mean; vr += d * d; }
      vr += __shfl_xor(vr, 16); vr += __shfl_xor(vr, 32);
      const float rstd = rsqrtf(vr * (1.0f / 64.0f) + 64e-5f);
#pragma unroll
      for (int vt = 0; vt < 4; ++vt) {
        const int vv = vt * 16 + quad * 4;
        const f32x4 g4 = lgv[vt];
        const float y0 = ((ao[vt][0] - mean) * rstd * g4[0] + bf_lo(ba[vt][0])) * bf_lo(gt[vt][0]);
        const float y1 = ((ao[vt][1] - mean) * rstd * g4[1] + bf_hi(ba[vt][0])) * bf_hi(gt[vt][0]);
        const float y2 = ((ao[vt][2] - mean) * rstd * g4[2] + bf_lo(ba[vt][1])) * bf_lo(gt[vt][1]);
        const float y3 = ((ao[vt][3] - mean) * rstd * g4[3] + bf_hi(ba[vt][1])) * bf_hi(gt[vt][1]);
        u32x2 ov; ov[0] = pk2(y0, y1); ov[1] = pk2(y2, y3);
        *(u32x2*)(p.o_r + row * 512 + h * 64 + vv) = ov;
      }
    }
    ld_bg(cn);
  }
  float* so = (isp ? p.out + O_WP + (((size_t)(l * 4 + b) * 8 + h) * 64 + v) * 64 : p.out + O_WS + (((size_t)(l * 8 + b) * 8 + h) * 64 + v) * 64);
#pragma unroll
  for (int nk = 0; nk < 4; ++nk) *(f32x4*)(so + nk * 16 + quad * 4) = acc[nk];
  __syncthreads();
}
DI void phase_chunk(const Params& p, int l, char* lds) {
  for (int it = blockIdx.x; it < NCH; it += gridDim.x) chunk_item(p, l, it, lds);
}

constexpr int ALD = 72;
DI void attn_item(const Params& p, int l, int item, char* lds) {
  const int tid = tid_(), wave = tid >> 6, lane = tid & 63;
  const int m = wave & 1, qh = wave >> 1, q = lane & 31, hh = lane >> 5;
  bf16_t* Ks = (bf16_t*)lds;
  bf16_t* Vs = Ks + 2 * 64 * ALD;
  float* xb = (float*)lds;
  bool samp; int b, h, nch, qrow0, qpos0;
  if (item < 32) { samp = true; b = item >> 2; h = item & 3; nch = 17; qrow0 = MP + b * 64; qpos0 = 1024; }
  else { samp = false; const int a = item - 32; const int qc = 63 - (a >> 4); const int bh = a & 15; b = bh >> 2; h = bh & 3; nch = qc + 1; qrow0 = b * 4096 + qc * 64; qpos0 = qc * 64; }
  bf16x8 qf[4];
  {
    const bf16_t* qp = p.z + (size_t)(qrow0 + qh * 32 + q) * NZ + C_Q + h * 128 + m * 64;
#pragma unroll
    for (int ks = 0; ks < 4; ++ks) qf[ks] = *(const bf16x8*)(qp + ks * 16 + hh * 8);
  }
  const float slope = exp2f(-2.0f * (float)(h + 1));
  const float LOG2E = 1.4426950408889634f;
  const float c1 = 0.125f * LOG2E, sl2 = slope * LOG2E;
  const float qposf = (float)(qpos0 + qh * 32 + q);
  f32x16 O[4];
#pragma unroll
  for (int i = 0; i < 4; ++i)
#pragma unroll
    for (int e = 0; e < 16; ++e) O[i][e] = 0.f;
  float mrun = -1e30f, lrun = 0.f;
  u32x4 rk[4], rv[4];
  auto gload = [&](int j) {
    const bf16_t* kb; size_t kld; const bf16_t* vb; size_t vld;
    if (!samp) { kb = p.z + (size_t)(b * 4096 + j * 64) * NZ + C_K + h * 128; kld = NZ; vb = p.vtp + (size_t)((b * 4 + h) * 128) * 4096 + j * 64; vld = 4096; }
    else if (j < 16) { kb = p.kc + (size_t)(b * 1024 + j * 64) * 512 + h * 128; kld = 512; vb = p.vct + (size_t)((b * 4 + h) * 128) * 1024 + j * 64; vld = 1024; }
    else { kb = p.z + (size_t)(MP + b * 64) * NZ + C_K + h * 128; kld = NZ; vb = p.vts + (size_t)((b * 4 + h) * 128) * 64; vld = 64; }
#pragma unroll
    for (int i = 0; i < 4; ++i) {
      const int c = tid + 256 * i;
      const int mm = c >> 9, key = (c >> 3) & 63, d8 = (c & 7) * 8;
      rk[i] = *(const u32x4*)(kb + (size_t)key * kld + mm * 64 + d8);
      const int vd = c >> 3, k8 = (c & 7) * 8;
      rv[i] = *(const u32x4*)(vb + (size_t)vd * vld + k8);
    }
  };
  auto sstore = [&]() {
#pragma unroll
    for (int i = 0; i < 4; ++i) {
      const int c = tid + 256 * i;
      const int mm = c >> 9, key = (c >> 3) & 63, d8 = (c & 7) * 8;
      *(u32x4*)(Ks + (mm * 64 + key) * ALD + d8) = rk[i];
      const int vd = c >> 3, k8 = (c & 7) * 8;
      *(u32x4*)(Vs + vd * ALD + k8) = rv[i];
    }
  };
  gload(0); sstore(); __syncthreads();
  for (int j = 0; j < nch; ++j) {
    if (j + 1 < nch) gload(j + 1);
    f32x16 s[2];
#pragma unroll
    for (int kt = 0; kt < 2; ++kt) {
#pragma unroll
      for (int e = 0; e < 16; ++e) s[kt][e] = 0.f;
#pragma unroll
      for (int ks = 0; ks < 4; ++ks) {
        const bf16x8 kf = *(const bf16x8*)(Ks + (m * 64 + kt * 32 + q) * ALD + ks * 16 + hh * 8);
        s[kt] = __builtin_amdgcn_mfma_f32_32x32x16_bf16(kf, qf[ks], s[kt], 0, 0, 0);
      }
    }
    float mx = -1e30f;
    const float dbase = qposf - (float)(j * 64 + 4 * hh);
#pragma unroll
    for (int kt = 0; kt < 2; ++kt)
#pragma unroll
      for (int e = 0; e < 16; ++e) {
        const float dd = dbase - (float)(kt * 32 + (e & 3) + 8 * (e >> 2));
        const float v = s[kt][e] * c1 - sl2 * fabsf(dd);
        s[kt][e] = v; mx = fmaxf(mx, v);
      }
    mx = fmaxf(mx, __shfl_xor(mx, 32));
    const float mnew = fmaxf(mrun, mx);
    const float alpha = __builtin_amdgcn_exp2f(mrun - mnew);
    const bool resc = mnew > mrun;
    mrun = mnew;
    float ps = 0.f;
#pragma unroll
    for (int kt = 0; kt < 2; ++kt)
#pragma unroll
      for (int e = 0; e < 16; ++e) { const float pe = __builtin_amdgcn_exp2f(s[kt][e] - mnew); s[kt][e] = pe; ps += pe; }
    lrun = lrun * alpha + ps;
    if (__any(resc)) {
#pragma unroll
      for (int i = 0; i < 4; ++i)
#pragma unroll
        for (int e = 0; e < 16; ++e) O[i][e] *= alpha;
    }
#pragma unroll
    for (int kt = 0; kt < 2; ++kt)
#pragma unroll
      for (int sx = 0; sx < 2; ++sx) {
        u32x4 pb;
        pb[0] = pk2(s[kt][8 * sx + 0], s[kt][8 * sx + 1]); pb[1] = pk2(s[kt][8 * sx + 2], s[kt][8 * sx + 3]);
        pb[2] = pk2(s[kt][8 * sx + 4], s[kt][8 * sx + 5]); pb[3] = pk2(s[kt][8 * sx + 6], s[kt][8 * sx + 7]);
        const bf16x8 pf = __builtin_bit_cast(bf16x8, pb);
#pragma unroll
        for (int vt = 0; vt < 4; ++vt) {
          const bf16_t* vp = Vs + (vt * 32 + q) * ALD + kt * 32 + 16 * sx + 4 * hh;
          const s16x4 lo = *(const s16x4*)vp, hi = *(const s16x4*)(vp + 8);
          const bf16x8 vf = __builtin_shufflevector(lo, hi, 0, 1, 2, 3, 4, 5, 6, 7);
          O[vt] = __builtin_amdgcn_mfma_f32_32x32x16_bf16(vf, pf, O[vt], 0, 0, 0);
        }
      }
    __syncthreads();
    if (j + 1 < nch) sstore();
    __syncthreads();
  }
  const float ltot = lrun + __shfl_xor(lrun, 32);
  const float inv = 1.0f / ltot;
#pragma unroll
  for (int i = 0; i < 4; ++i)
#pragma unroll
    for (int e = 0; e < 16; ++e) O[i][e] *= inv;
  if (m == 1) {
#pragma unroll
    for (int vt = 0; vt < 4; ++vt)
#pragma unroll
      for (int e = 0; e < 16; ++e) { const int vd = vt * 32 + (e & 3) + 8 * (e >> 2) + 4 * hh; xb[(qh * 128 + vd) * 32 + q] = O[vt][e]; }
  }
  __syncthreads();
  if (m == 0) {
    float d1 = 0.f, d2 = 0.f;
    for (int i = 0; i < 64; ++i) { d1 += p.lq1[l * 64 + i] * p.lk1[l * 64 + i]; d2 += p.lq2[l * 64 + i] * p.lk2[l * 64 + i]; }
    const float lam_init = 0.8f - 0.6f * __expf(-0.3f * (float)l);
    const float lam = __expf(d1) - __expf(d2) + lam_init;
    float ss = 0.f;
#pragma unroll
    for (int vt = 0; vt < 4; ++vt)
#pragma unroll
      for (int e = 0; e < 16; ++e) {
        const int vd = vt * 32 + (e & 3) + 8 * (e >> 2) + 4 * hh;
        const float o2 = xb[(qh * 128 + vd) * 32 + q];
        const float o = O[vt][e] - lam * o2; O[vt][e] = o; ss += o * o;
      }
    ss += __shfl_xor(ss, 32);
    const float rstd = rsqrtf(ss * (1.0f / 128.0f) + 1e-5f) * (1.0f - lam_init);
    const size_t row = (size_t)(qrow0 + qh * 32 + q);
    const float* sg = p.subln_g + l * 128;
#pragma unroll
    for (int vt = 0; vt < 4; ++vt)
#pragma unroll
      for (int e4 = 0; e4 < 4; ++e4) {
        const int vd = vt * 32 + 8 * e4 + 4 * hh;
        const u32x2 gu = *(const u32x2*)(p.z + row * NZ + C_GA + h * 128 + vd);
        const f32x4 gv = *(const f32x4*)(sg + vd);
        const float y0 = O[vt][4 * e4 + 0] * rstd * gv[0] * bf_lo(gu[0]);
        const float y1 = O[vt][4 * e4 + 1] * rstd * gv[1] * bf_hi(gu[0]);
        const float y2 = O[vt][4 * e4 + 2] * rstd * gv[2] * bf_lo(gu[1]);
        const float y3 = O[vt][4 * e4 + 3] * rstd * gv[3] * bf_hi(gu[1]);
        u32x2 ov; ov[0] = pk2(y0, y1); ov[1] = pk2(y2, y3);
        *(u32x2*)(p.o_a + row * 512 + h * 128 + vd) = ov;
      }
  }
  __syncthreads();
}

DI void phase_mix(const Params& p, int l, char* lds) {
  __shared__ int s_next;
  if (blockIdx.x < 96) rec_item(p, l, blockIdx.x, lds);
  unsigned* ctr = p.bar + XCD_BAR_WORDS + 64 * l;
  for (;;) {
    __syncthreads();
    if (threadIdx.x == 0) s_next = (int)atomicAdd(ctr, 1u);
    __syncthreads();
    const int it = s_next;
    if (it >= 1056) break;
    attn_item(p, l, it, lds);
  }
}

DI void phase_merge(const Params& p, int l, char* lds) {
  const int tid = tid_(), wave = tid >> 6, lane = tid & 63;
  const int wm = wave >> 1, wn = wave & 1, l15 = lane & 15, quad = lane >> 4;
  for (int tile = blockIdx.x; tile < 132 * 8; tile += gridDim.x) {
    const int mt = tile >> 3, nt = tile & 7;
    f32x4 a1[4][4]; zero_acc(a1);
    gemm_core<false>(a1, p.o_r + (size_t)mt * 128 * 512, 512, p.wt_brr + (size_t)nt * 128 * 512, 512, 512, lds);
    u32x2 pk[4][4];
#pragma unroll
    for (int mi = 0; mi < 4; ++mi) {
      const int R = mt * 128 + wm * 64 + mi * 16 + l15;
#pragma unroll
      for (int ni = 0; ni < 4; ++ni) {
        const int c = nt * 128 + wn * 64 + ni * 16 + quad * 4;
        const u32x2 g1 = *(const u32x2*)(p.z + (size_t)R * NZ + C_MR + c);
        const f32x4 v1 = a1[mi][ni];
        pk[mi][ni][0] = pk2(bf_lo(g1[0]) * v1[0], bf_hi(g1[0]) * v1[1]);
        pk[mi][ni][1] = pk2(bf_lo(g1[1]) * v1[2], bf_hi(g1[1]) * v1[3]);
      }
    }
    zero_acc(a1);
    gemm_core<false>(a1, p.o_a + (size_t)mt * 128 * 512, 512, p.wt_bra + (size_t)nt * 128 * 512, 512, 512, lds);
#pragma unroll
    for (int mi = 0; mi < 4; ++mi) {
      const int R = mt * 128 + wm * 64 + mi * 16 + l15;
#pragma unroll
      for (int ni = 0; ni < 4; ++ni) {
        const int c = nt * 128 + wn * 64 + ni * 16 + quad * 4;
        const u32x2 g2 = *(const u32x2*)(p.z + (size_t)R * NZ + C_MA + c);
        const f32x4 v2 = a1[mi][ni]; const u32x2 u1 = pk[mi][ni];
        u32x2 o;
        o[0] = pk2(bf_lo(u1[0]) + bf_lo(g2[0]) * v2[0], bf_hi(u1[0]) + bf_hi(g2[0]) * v2[1]);
        o[1] = pk2(bf_lo(u1[1]) + bf_lo(g2[1]) * v2[2], bf_hi(u1[1]) + bf_hi(g2[1]) * v2[3]);
        *(u32x2*)(p.hn + (size_t)R * DM + c) = o;
      }
    }
  }
}
DI void phase_out(const Params& p, int l, char* lds) {
  const int tid = tid_(), wave = tid >> 6, lane = tid & 63;
  const int wm = wave >> 1, wn = wave & 1, l15 = lane & 15, quad = lane >> 4;
  for (int tile = blockIdx.x; tile < 132 * 8; tile += gridDim.x) {
    const int mt = tile >> 3, nt = tile & 7;
    f32x4 acc[4][4]; zero_acc(acc);
    gemm_core<false>(acc, p.hn + (size_t)mt * 128 * DM, DM, p.wt_out + (size_t)nt * 128 * DM, DM, DM, lds);
#pragma unroll
    for (int mi = 0; mi < 4; ++mi) {
      const int R = mt * 128 + wm * 64 + mi * 16 + l15;
      const float* xr = x_row(p, l, R);
#pragma unroll
      for (int ni = 0; ni < 4; ++ni) {
        const int c = nt * 128 + wn * 64 + ni * 16 + quad * 4;
        const f32x4 xv = *(const f32x4*)(xr + c);
        *(f32x4*)(p.out + (size_t)R * DM + c) = xv + acc[mi][ni];
      }
    }
  }
}
DI void phase_ple(const Params& p, int l, char* lds) {
  const int tid = tid_(), wave = tid >> 6, lane = tid & 63;
  const int wm = wave >> 1, wn = wave & 1, l15 = lane & 15, quad = lane >> 4;
  for (int tile = blockIdx.x; tile < 132 * 8; tile += gridDim.x) {
    const int mt = tile >> 3, nt = tile & 7;
    f32x4 a1[4][4]; zero_acc(a1);
    gemm_core<false>(a1, p.hn + (size_t)mt * 128 * DM, DM, p.wt_gate + (size_t)nt * 128 * DM, DM, DM, lds);
    u32x2 pk[4][4];
#pragma unroll
    for (int mi = 0; mi < 4; ++mi)
#pragma unroll
      for (int ni = 0; ni < 4; ++ni) { const f32x4 v = a1[mi][ni]; pk[mi][ni][0] = pk2(sigmoidf_(v[0]), sigmoidf_(v[1])); pk[mi][ni][1] = pk2(sigmoidf_(v[2]), sigmoidf_(v[3])); }
    zero_acc(a1);
    const int r0 = mt * 128;
    const float* pa = r0 < MP ? p.pp + ((size_t)l * MP + r0) * 256 : p.ps + ((size_t)l * MS + (r0 - MP)) * 256;
    gemm_core<true>(a1, pa, 256, p.wt_ple + (size_t)nt * 128 * 256, 256, 256, lds);
#pragma unroll
    for (int mi = 0; mi < 4; ++mi) {
      const int R = mt * 128 + wm * 64 + mi * 16 + l15;
#pragma unroll
      for (int ni = 0; ni < 4; ++ni) {
        const int c = nt * 128 + wn * 64 + ni * 16 + quad * 4;
        float* xo = p.out + (size_t)R * DM + c;
        const f32x4 xv = *(const f32x4*)xo; const f32x4 e = a1[mi][ni]; const u32x2 g = pk[mi][ni];
        f32x4 o;
        o[0] = xv[0] + e[0] * bf_lo(g[0]); o[1] = xv[1] + e[1] * bf_hi(g[0]);
        o[2] = xv[2] + e[2] * bf_lo(g[1]); o[3] = xv[3] + e[3] * bf_hi(g[1]);
        *(f32x4*)xo = o;
      }
    }
  }
}


#define XB_TMO      128
#define XB_XCNT(j)  (256  + 64 * (j))
#define XB_XSUB(j)  (1280 + 64 * (j))
#define XB_XGEN(j)  (2304 + 64 * (j))
#define XB_TOP      3328
#define XB_TOPGEN   3392
#define XB_SPIN_CAP (1u << 18)
#define LAS __attribute__((address_space(3)))
DI unsigned xb_ld(unsigned* p)              { return __hip_atomic_load(p, __ATOMIC_RELAXED, __HIP_MEMORY_SCOPE_AGENT); }
DI unsigned xb_add(unsigned* p, unsigned v) { return __hip_atomic_fetch_add(p, v, __ATOMIC_RELAXED, __HIP_MEMORY_SCOPE_AGENT); }
DI unsigned xb_xcc_id() { return (unsigned)__builtin_amdgcn_s_getreg((3 << 11) | 20) & 0xFu; }
#define XB_SPIN(cond, bar) do { unsigned _sp = 0; while (cond) { __builtin_amdgcn_s_sleep(1); \
    if ((++_sp & 255u) == 0u) { if (xb_ld(&(bar)[XB_TMO])) break; if (_sp > XB_SPIN_CAP) { atomicAdd(&(bar)[XB_TMO], 1u); break; } } } } while (0)
struct XcdBarrier { unsigned* bar; unsigned x; volatile LAS unsigned* st; };
DI XcdBarrier xcd_barrier_post(unsigned* bar, volatile LAS unsigned* st) {
  XcdBarrier b; b.bar = bar; b.x = xb_xcc_id(); b.st = st;
  if (threadIdx.x == 0) (void)xb_add(&bar[XB_XCNT(b.x)], 1u);
  return b;
}
DI void xcd_barrier_complete(unsigned* bar, unsigned x, unsigned& nloc, unsigned& nx) {
  const unsigned G = gridDim.x * gridDim.y * gridDim.z;
  unsigned sum, cnt, mine, sp = 0u;
  for (;;) {
    sum = 0u; cnt = 0u; mine = 0u;
#pragma unroll
    for (unsigned j = 0; j < 16; ++j) { const unsigned c = xb_ld(&bar[XB_XCNT(j)]); sum += c; cnt += (c > 0u) ? 1u : 0u; mine = (j == x) ? c : mine; }
    if (sum == G) break;
    __builtin_amdgcn_s_sleep(1);
    if ((++sp & 255u) == 0u) { if (xb_ld(&bar[XB_TMO])) break; if (sp > XB_SPIN_CAP) { atomicAdd(&bar[XB_TMO], 1u); break; } }
  }
  nloc = mine > 0u ? mine : 1u; nx = cnt > 0u ? cnt : 1u;
}
DI void xcd_barrier(const XcdBarrier& b) {
  asm volatile("s_waitcnt vmcnt(0)" ::: "memory");
  __syncthreads();
  if (threadIdx.x == 0) {
    unsigned* bar = b.bar;
    __builtin_amdgcn_s_waitcnt(0);
    unsigned nloc = b.st[0], nx = b.st[1];
    if (nloc == 0u) { xcd_barrier_complete(bar, b.x, nloc, nx); b.st[0] = nloc; b.st[1] = nx; }
    const unsigned old = xb_add(&bar[XB_XSUB(b.x)], 1u);
    const unsigned gen = old / nloc;
    if (old + 1u == (gen + 1u) * nloc) {
      __builtin_amdgcn_fence(__ATOMIC_RELEASE, "agent");
      asm volatile("s_waitcnt vmcnt(0)" ::: "memory");
      const unsigned og = xb_add(&bar[XB_TOP], 1u);
      const unsigned tg = og / nx;
      if (og + 1u == (tg + 1u) * nx) xb_add(&bar[XB_TOPGEN], 1u);
      else XB_SPIN(xb_ld(&bar[XB_TOPGEN]) == tg, bar);
      __builtin_amdgcn_fence(__ATOMIC_ACQUIRE, "agent");
      xb_add(&bar[XB_XGEN(b.x)], 1u);
      asm volatile("s_waitcnt vmcnt(0)" ::: "memory");
    } else {
      XB_SPIN(xb_ld(&bar[XB_XGEN(b.x)]) == gen, bar);
      __builtin_amdgcn_fence(__ATOMIC_ACQUIRE, "agent");
      asm volatile("s_waitcnt vmcnt(0)" ::: "memory");
    }
  }
  __syncthreads();
}
constexpr int LDS_BYTES = 73728;
DI void run_phase(const Params& p, int ph, int l, char* lds) {
  switch (ph) {
    case 1: phase_norm(p, l, true, lds); break;
    case 2: phase_gemm_in(p, l, lds); break;
    case 3: phase_mix(p, l, lds); break;
    case 4: phase_merge(p, l, lds); break;
    case 5: phase_out(p, l, lds); break;
    case 6: phase_norm(p, l, false, lds); break;
    case 7: phase_ple(p, l, lds); break;
    case 8: phase_chunk(p, l, lds); break;
  }
}

#if MEGA
__global__ void __launch_bounds__(256, 2) k_mega(Params p) {
  __shared__ __attribute__((aligned(16))) char lds[LDS_BYTES];
  __shared__ uint4 xb_words;
  cg::grid_group grid = cg::this_grid();
  if (threadIdx.x == 0) xb_words = make_uint4(0u, 0u, 0u, 0u);
  __syncthreads();
  const XcdBarrier xb = xcd_barrier_post(p.bar, (volatile LAS unsigned*)&xb_words);
#pragma unroll 1
  for (int l = 0; l < NL; ++l) {
    phase_norm(p, l, true, lds);
    if (l == 0) grid.sync(); else xcd_barrier(xb);
    phase_gemm_in(p, l, lds); xcd_barrier(xb);
    phase_chunk(p, l, lds); xcd_barrier(xb);
    phase_mix(p, l, lds); xcd_barrier(xb);
    phase_merge(p, l, lds); xcd_barrier(xb);
    phase_out(p, l, lds); xcd_barrier(xb);
    phase_norm(p, l, false, lds); xcd_barrier(xb);
    phase_ple(p, l, lds); if (l + 1 < NL) xcd_barrier(xb);
  }
}
#else
template <int PH>
__global__ void __launch_bounds__(256, 2) k_phase(Params p, int l) {
  __shared__ __attribute__((aligned(16))) char lds[LDS_BYTES];
  run_phase(p, PH, l, lds);
}
#endif

extern "C" void kernel_launch(void* const* d_in, const int* in_sizes, int n_in, void* d_out, int out_size, void* d_ws, size_t ws_size,
                              hipStream_t stream) {
  Params p{};
  const float** pf = (const float**)&p;
  for (int i = 0; i < 33; ++i) pf[i] = (const float*)d_in[i];
  p.out = (float*)d_out;
  char* w = (char*)d_ws; size_t off = 0;
  auto take = [&](size_t bytes) { char* r = w + off; off += (bytes + 255) & ~(size_t)255; return (bf16_t*)r; };
  p.bar = (unsigned*)take((size_t)(XCD_BAR_WORDS + 64 * NL) * 4);
  p.wt_in = take((size_t)NZ * 1024 * 2);
  p.wt_brr = take((size_t)1024 * 512 * 2);
  p.wt_bra = take((size_t)1024 * 512 * 2);
  p.wt_out = take((size_t)1024 * 1024 * 2);
  p.wt_ple = take((size_t)1024 * 256 * 2);
  p.wt_gate = take((size_t)1024 * 1024 * 2);
  p.w2t = take((size_t)512 * 64 * 2);
  p.a2t = take((size_t)512 * 64 * 2);
  p.z = take((size_t)MT * NZ * 2);
  p.vtp = take((size_t)16 * 128 * 4096 * 2);
  p.vts = take((size_t)32 * 128 * 64 * 2);
  p.kc = take((size_t)8 * 1024 * 512 * 2);
  p.vct = take((size_t)32 * 128 * 1024 * 2);
  p.o_r = take((size_t)MT * 512 * 2);
  p.o_a = take((size_t)MT * 512 * 2);
  p.hn = take((size_t)MT * DM * 2);
  p.cPT = p.hn;
  p.cG = take((size_t)NCH * 4096 * 2);
  p.cRT = take((size_t)NCH * 2048 * 2);
  p.cOI = take((size_t)NCH * 2048 * 2);
  p.cBA = take((size_t)NCH * 2048 * 2);
  if (off > ws_size) { fprintf(stderr, "workspace too small: need %zu have %zu\n", off, ws_size); return; }
#if MEGA
  hipMemsetAsync(p.bar, 0, (size_t)(XCD_BAR_WORDS + 64 * NL) * 4, stream);
  static int grid_blocks = 0;
  if (!grid_blocks) {
    int dev = 0, cus = 0, per_cu = 0;
    hipGetDevice(&dev);
    hipDeviceGetAttribute(&cus, hipDeviceAttributeMultiprocessorCount, dev);
    hipOccupancyMaxActiveBlocksPerMultiprocessor(&per_cu, k_mega, 256, 0);
    if (per_cu > 2) per_cu = 2;
    grid_blocks = cus * per_cu;
  }
  void* args[] = {&p};
  hipError_t e = hipLaunchCooperativeKernel((void*)k_mega, dim3(grid_blocks), dim3(256), args, 0, stream);
  if (e != hipSuccess) fprintf(stderr, "cooperative launch failed: %s (grid %d)\n", hipGetErrorString(e), grid_blocks);
#else
  const int G = 512;
  for (int l = 0; l < NL; ++l) {
    k_phase<1><<<G, 256, 0, stream>>>(p, l);
    k_phase<2><<<G, 256, 0, stream>>>(p, l);
    k_phase<8><<<G, 256, 0, stream>>>(p, l);
    k_phase<3><<<G, 256, 0, stream>>>(p, l);
    k_phase<4><<<G, 256, 0, stream>>>(p, l);
    k_phase<5><<<G, 256, 0, stream>>>(p, l);
    k_phase<6><<<G, 256, 0, stream>>>(p, l);
    k_phase<7><<<G, 256, 0, stream>>>(p, l);
  }
#endif
}
```

```cpp
#include <hip/hip_runtime.h>
#include <hip/hip_cooperative_groups.h>
#include <stdint.h>
#include <stdio.h>
namespace cg = cooperative_groups;

#ifndef MEGA
#define MEGA 1
#endif

typedef unsigned short bf16_t;
typedef short bf16x8 __attribute__((ext_vector_type(8)));
typedef short s16x4 __attribute__((ext_vector_type(4)));
typedef float f32x4 __attribute__((ext_vector_type(4)));
typedef float f32x2 __attribute__((ext_vector_type(2)));
typedef float f32x16 __attribute__((ext_vector_type(16)));
typedef unsigned u32x4 __attribute__((ext_vector_type(4)));
typedef unsigned u32x2 __attribute__((ext_vector_type(2)));
typedef __bf16 bfv2 __attribute__((ext_vector_type(2)));

#define DI __device__ __forceinline__
#define XCD_BAR_WORDS 3456
DI int tid_() { int t = threadIdx.x; asm volatile("" : "+v"(t)); return t; }

constexpr int DM = 1024, MP = 16384, MS = 512, MT = 16896, NZ = 6272, NL = 4;
constexpr int C_GR = 1664, C_Q = 2176, C_K = 2688, C_V = 3200, C_GA = 3712, C_MR = 4224, C_MA = 5248;
constexpr int SHC = 1664;
constexpr size_t O_YP = 0, O_YS = 16777216, O_KP = 17301504, O_VP = 50855936, O_WP = 84410368, O_SP = 84934656,
                 O_KS = 84961280, O_VS = 86009856, O_WS = 87058432, O_SS = 88107008;

struct Params {
  const float *xp, *xs, *pp, *ps, *ck, *cv, *swkv, *sshift;
  const float *norm_g, *w_in, *shift_mu, *decay_w0, *decay_w2, *iclr_a0, *iclr_a2, *k_k, *k_a, *r_k, *lnx_g, *lnx_b,
      *qng, *kng, *lq1, *lk1, *lq2, *lk2, *subln_g, *w_br_r, *w_br_a, *w_out, *ple_w, *ple_gate_w, *ple_norm_g;
  float* out;
  bf16_t *wt_in, *wt_brr, *wt_bra, *wt_out, *wt_ple, *wt_gate, *w2t, *a2t;
  bf16_t *hn, *z, *vtp, *vts, *kc, *vct, *o_r, *o_a;
  bf16_t *cPT, *cG, *cRT, *cOI, *cBA;
  unsigned* bar;
};

DI unsigned pk2(float a, float b) { f32x2 v = {a, b}; bfv2 r = __builtin_convertvector(v, bfv2); return __builtin_bit_cast(unsigned, r); }
DI float bf_lo(unsigned u) { return __uint_as_float(u << 16); }
DI float bf_hi(unsigned u) { return __uint_as_float(u & 0xffff0000u); }
DI float bf1(bf16_t u) { return __uint_as_float(((unsigned)u) << 16); }
DI float sigmoidf_(float x) { return 1.0f / (1.0f + __expf(-x)); }
DI float siluf_(float x) { return x / (1.0f + __expf(-x)); }

DI void tr_tile(const float* __restrict__ src, int ld_src, bf16_t* __restrict__ dst, int ld_dst, float* sm) {
  const int tid = tid_();
  const int r = tid >> 4, c4 = (tid & 15) * 4;
#pragma unroll
  for (int i = 0; i < 4; ++i) {
    const int row = r + 16 * i;
    f32x4 v = *(const f32x4*)(src + (size_t)row * ld_src + c4);
    sm[row * 65 + c4 + 0] = v[0]; sm[row * 65 + c4 + 1] = v[1]; sm[row * 65 + c4 + 2] = v[2]; sm[row * 65 + c4 + 3] = v[3];
  }
  __syncthreads();
  const int n = tid >> 2, ks = (tid & 3) * 16;
  u32x4 o0, o1;
  o0[0] = pk2(sm[(ks + 0) * 65 + n], sm[(ks + 1) * 65 + n]);   o0[1] = pk2(sm[(ks + 2) * 65 + n], sm[(ks + 3) * 65 + n]);
  o0[2] = pk2(sm[(ks + 4) * 65 + n], sm[(ks + 5) * 65 + n]);   o0[3] = pk2(sm[(ks + 6) * 65 + n], sm[(ks + 7) * 65 + n]);
  o1[0] = pk2(sm[(ks + 8) * 65 + n], sm[(ks + 9) * 65 + n]);   o1[1] = pk2(sm[(ks + 10) * 65 + n], sm[(ks + 11) * 65 + n]);
  o1[2] = pk2(sm[(ks + 12) * 65 + n], sm[(ks + 13) * 65 + n]); o1[3] = pk2(sm[(ks + 14) * 65 + n], sm[(ks + 15) * 65 + n]);
  *(u32x4*)(dst + (size_t)n * ld_dst + ks) = o0;
  *(u32x4*)(dst + (size_t)n * ld_dst + ks + 8) = o1;
  __syncthreads();
}

constexpr int WCONV_TILES = 1568 + 128 + 128 + 256 + 64 + 256 + 8 + 8;
DI void wconv_tile(const Params& p, int l, int t, float* sm) {
  const float* src; bf16_t* dst; int K, N;
  if (t < 1568) { src = p.w_in + (size_t)l * 1024 * NZ; dst = p.wt_in; K = 1024; N = NZ; }
  else if ((t -= 1568) < 128) { src = p.w_br_r + (size_t)l * 512 * 1024; dst = p.wt_brr; K = 512; N = 1024; }
  else if ((t -= 128) < 128) { src = p.w_br_a + (size_t)l * 512 * 1024; dst = p.wt_bra; K = 512; N = 1024; }
  else if ((t -= 128) < 256) { src = p.w_out + (size_t)l * 1024 * 1024; dst = p.wt_out; K = 1024; N = 1024; }
  else if ((t -= 256) < 64) { src = p.ple_w + (size_t)l * 256 * 1024; dst = p.wt_ple; K = 256; N = 1024; }
  else if ((t -= 64) < 256) { src = p.ple_gate_w + (size_t)l * 1024 * 1024; dst = p.wt_gate; K = 1024; N = 1024; }
  else if ((t -= 256) < 8) { src = p.decay_w2 + (size_t)l * 64 * 512; dst = p.w2t; K = 64; N = 512; }
  else { t -= 8; src = p.iclr_a2 + (size_t)l * 64 * 512; dst = p.a2t; K = 64; N = 512; }
  const int ntn = N / 64; const int tk = t / ntn, tn = t % ntn;
  tr_tile(src + (size_t)(tk * 64) * N + tn * 64, N, dst + (size_t)(tn * 64) * K + tk * 64, K, sm);
}

DI const float* x_row(const Params& p, int l, int r) {
  if (l == 0) return r < MP ? p.xp + (size_t)r * DM : p.xs + (size_t)(r - MP) * DM;
  return p.out + (size_t)r * DM;
}
DI void phase_norm(const Params& p, int l, bool first, char* lds) {
  const int tid = tid_(), wave = tid >> 6, lane = tid & 63;
  const float* g = (first ? p.norm_g : p.ple_norm_g) + l * DM;
  const int n_norm = MT / 4;
  const int n_items = n_norm + (first ? 2048 + WCONV_TILES : 0);
  for (int it = blockIdx.x; it < n_items; it += gridDim.x) {
    if (it < n_norm) {
      const int r = it * 4 + wave;
      const float* x = first ? x_row(p, l, r) : p.out + (size_t)r * DM;
      f32x4 v[4]; float ss = 0.f;
#pragma unroll
      for (int i = 0; i < 4; ++i) { v[i] = *(const f32x4*)(x + lane * 4 + 256 * i); ss += v[i][0] * v[i][0] + v[i][1] * v[i][1] + v[i][2] * v[i][2] + v[i][3] * v[i][3]; }
#pragma unroll
      for (int o = 32; o >= 1; o >>= 1) ss += __shfl_xor(ss, o);
      const float rstd = rsqrtf(ss * (1.0f / 1024.0f) + 1e-6f);
#pragma unroll
      for (int i = 0; i < 4; ++i) {
        const f32x4 gv = *(const f32x4*)(g + lane * 4 + 256 * i);
        u32x2 o; o[0] = pk2(v[i][0] * rstd * gv[0], v[i][1] * rstd * gv[1]); o[1] = pk2(v[i][2] * rstd * gv[2], v[i][3] * rstd * gv[3]);
        *(u32x2*)(p.hn + (size_t)r * DM + lane * 4 + 256 * i) = o;
      }
    } else if (it < n_norm + 1024) {
      const int c = it - n_norm;
      const float* src = p.ck + (size_t)l * 8 * 1024 * 512 + (size_t)c * 4096 + tid * 16;
      bf16_t* dst = p.kc + (size_t)c * 4096 + tid * 16;
      f32x4 a0 = *(const f32x4*)(src), a1 = *(const f32x4*)(src + 4), a2 = *(const f32x4*)(src + 8), a3 = *(const f32x4*)(src + 12);
      u32x4 o0, o1;
      o0[0] = pk2(a0[0], a0[1]); o0[1] = pk2(a0[2], a0[3]); o0[2] = pk2(a1[0], a1[1]); o0[3] = pk2(a1[2], a1[3]);
      o1[0] = pk2(a2[0], a2[1]); o1[1] = pk2(a2[2], a2[3]); o1[2] = pk2(a3[0], a3[1]); o1[3] = pk2(a3[2], a3[3]);
      *(u32x4*)dst = o0; *(u32x4*)(dst + 8) = o1;
    } else if (it >= n_norm + 2048) {
      wconv_tile(p, l, it - n_norm - 2048, (float*)lds);
    } else {
      const int c = it - n_norm - 1024;
      const int bh = c >> 5, tt = c & 31; const int b = bh >> 2, h = bh & 3; const int tk = tt >> 1, tn = tt & 1;
      const float* src = p.cv + (size_t)l * 8 * 1024 * 512 + ((size_t)(b * 1024 + tk * 64)) * 512 + h * 128 + tn * 64;
      bf16_t* dst = p.vct + ((size_t)(bh * 128 + tn * 64)) * 1024 + tk * 64;
      tr_tile(src, 512, dst, 1024, (float*)lds);
    }
  }
}

constexpr int GLD = 72;
template <bool A_F32>
DI void gemm_core(f32x4 (&acc)[4][4], const void* Ap, int lda, const bf16_t* Bp, int ldb, int K, char* lds) {
  bf16_t* As = (bf16_t*)lds;
  bf16_t* Bs = (bf16_t*)(lds + 2 * 128 * GLD * 2);
  const int tid = tid_(), wave = tid >> 6, lane = tid & 63;
  const int wm = wave >> 1, wn = wave & 1, l15 = lane & 15, quad = lane >> 4;
  const int nk = K / 64;
  u32x4 ra[4], rb[4];
  auto gload = [&](int kt) {
#pragma unroll
    for (int i = 0; i < 4; ++i) {
      const int c = tid + 256 * i; const int row = c >> 3, c8 = (c & 7) * 8;
      if (!A_F32) ra[i] = *(const u32x4*)((const bf16_t*)Ap + (size_t)row * lda + kt * 64 + c8);
      rb[i] = *(const u32x4*)(Bp + (size_t)row * ldb + kt * 64 + c8);
    }
  };
  auto sstore = [&](int buf, int kt) {
#pragma unroll
    for (int i = 0; i < 4; ++i) {
      const int c = tid + 256 * i; const int row = c >> 3, c8 = (c & 7) * 8;
      if (A_F32) {
        const float* a = (const float*)Ap + (size_t)row * lda + kt * 64 + c8;
        const f32x4 v0 = *(const f32x4*)a, v1 = *(const f32x4*)(a + 4);
        u32x4 t; t[0] = pk2(v0[0], v0[1]); t[1] = pk2(v0[2], v0[3]); t[2] = pk2(v1[0], v1[1]); t[3] = pk2(v1[2], v1[3]);
        *(u32x4*)(As + (buf * 128 + row) * GLD + c8) = t;
      } else {
        *(u32x4*)(As + (buf * 128 + row) * GLD + c8) = ra[i];
      }
      *(u32x4*)(Bs + (buf * 128 + row) * GLD + c8) = rb[i];
    }
  };
  gload(0); sstore(0, 0); __syncthreads();
  for (int kt = 0; kt < nk; ++kt) {
    const int buf = kt & 1;
    if (kt + 1 < nk) gload(kt + 1);
#pragma unroll
    for (int ks = 0; ks < 2; ++ks) {
      bf16x8 af[4], bfr[4];
#pragma unroll
      for (int i = 0; i < 4; ++i) {
        af[i] = *(const bf16x8*)(As + (buf * 128 + wm * 64 + i * 16 + l15) * GLD + ks * 32 + quad * 8);
        bfr[i] = *(const bf16x8*)(Bs + (buf * 128 + wn * 64 + i * 16 + l15) * GLD + ks * 32 + quad * 8);
      }
#pragma unroll
      for (int mi = 0; mi < 4; ++mi)
#pragma unroll
        for (int ni = 0; ni < 4; ++ni) acc[mi][ni] = __builtin_amdgcn_mfma_f32_16x16x32_bf16(bfr[ni], af[mi], acc[mi][ni], 0, 0, 0);
    }
    if (kt + 1 < nk) sstore(buf ^ 1, kt + 1);
    __syncthreads();
  }
}
DI void zero_acc(f32x4 (&acc)[4][4]) {
#pragma unroll
  for (int i = 0; i < 4; ++i)
#pragma unroll
    for (int j = 0; j < 4; ++j) acc[i][j] = (f32x4){0.f, 0.f, 0.f, 0.f};
}

DI void phase_gemm_in(const Params& p, int l, char* lds) {
  const int tid = tid_(), wave = tid >> 6, lane = tid & 63;
  const int wm = wave >> 1, wn = wave & 1, l15 = lane & 15, quad = lane >> 4;
  const bf16_t* Wt = p.wt_in;
  const int NTN = 49, NTM = 132;
  for (int tile = blockIdx.x; tile < NTN * NTM; tile += gridDim.x) {
    const int mt = tile / NTN, nt = tile % NTN;
    f32x4 acc[4][4]; zero_acc(acc);
    gemm_core<false>(acc, p.hn + (size_t)mt * 128 * DM, DM, Wt + (size_t)nt * 128 * DM, DM, DM, lds);
    const int colb = nt * 128 + wn * 64 + quad * 4;
    int kind;
    if (nt < 13) kind = 0; else if (nt < 17) kind = 1; else if (nt < 21) kind = 2; else if (nt < 25) kind = 3; else if (nt < 29) kind = 4; else if (nt < 33) kind = 1; else kind = 5;
#pragma unroll
    for (int mi = 0; mi < 4; ++mi) {
      const int R = mt * 128 + wm * 64 + mi * 16 + l15;
      const bool isp = R < MP; const int rs = R - MP;
      bf16_t* zrow = p.z + (size_t)R * NZ;
      if (kind == 0) {
        const bool last = isp ? ((R & 4095) == 4095) : ((rs & 63) == 63);
        float* so = isp ? p.out + O_SP + (size_t)(l * 4 + (R >> 12)) * SHC : p.out + O_SS + (size_t)(l * 8 + (rs >> 6)) * SHC;
#pragma unroll
        for (int ni = 0; ni < 4; ++ni) {
          const int c = colb + ni * 16; const f32x4 v = acc[mi][ni];
          u32x2 o; o[0] = pk2(v[0], v[1]); o[1] = pk2(v[2], v[3]); *(u32x2*)(zrow + c) = o;
          if (last) *(f32x4*)(so + c) = v;
        }
      } else if (kind == 1 || kind == 5) {
#pragma unroll
        for (int ni = 0; ni < 4; ++ni) {
          const int c = colb + ni * 16; f32x4 v = acc[mi][ni];
#pragma unroll
          for (int e = 0; e < 4; ++e) v[e] = (kind == 1) ? siluf_(v[e]) : sigmoidf_(v[e]);
          u32x2 o; o[0] = pk2(v[0], v[1]); o[1] = pk2(v[2], v[3]); *(u32x2*)(zrow + c) = o;
        }
      } else if (kind == 2 || kind == 3) {
        float ss = 0.f;
#pragma unroll
        for (int ni = 0; ni < 4; ++ni) { const f32x4 v = acc[mi][ni]; ss += v[0] * v[0] + v[1] * v[1] + v[2] * v[2] + v[3] * v[3]; }
        ss += __shfl_xor(ss, 16); ss += __shfl_xor(ss, 32);
        const float rstd = rsqrtf(ss * (1.0f / 64.0f) + 1e-6f);
        const float* g = (kind == 2 ? p.qng : p.kng) + l * 64;
        float* ko = isp ? p.out + O_KP + ((size_t)l * MP + R) * 512 : p.out + O_KS + ((size_t)l * MS + rs) * 512;
#pragma unroll
        for (int ni = 0; ni < 4; ++ni) {
          const int c = colb + ni * 16; const int d = ni * 16 + quad * 4;
          const f32x4 gv = *(const f32x4*)(g + d); f32x4 v = acc[mi][ni];
#pragma unroll
          for (int e = 0; e < 4; ++e) v[e] = v[e] * rstd * gv[e];
          u32x2 o; o[0] = pk2(v[0], v[1]); o[1] = pk2(v[2], v[3]); *(u32x2*)(zrow + c) = o;
          if (kind == 3) *(f32x4*)(ko + (c - C_K)) = v;
        }
      } else {
        float* vo = isp ? p.out + O_VP + ((size_t)l * MP + R) * 512 : p.out + O_VS + ((size_t)l * MS + rs) * 512;
#pragma unroll
        for (int ni = 0; ni < 4; ++ni) {
          const int cv = colb + ni * 16 - C_V; const f32x4 v = acc[mi][ni];
          *(f32x4*)(vo + cv) = v;
          const int h = cv >> 7, vd = cv & 127;
          if (isp) {
            bf16_t* vt = p.vtp + ((size_t)(((R >> 12) * 4 + h) * 128 + vd)) * 4096 + (R & 4095);
#pragma unroll
            for (int e = 0; e < 4; ++e) vt[(size_t)e * 4096] = (bf16_t)(pk2(v[e], 0.f) & 0xffff);
          } else {
            bf16_t* vt = p.vts + ((size_t)(((rs >> 6) * 4 + h) * 128 + vd)) * 64 + (rs & 63);
#pragma unroll
            for (int e = 0; e < 4; ++e) vt[(size_t)e * 64] = (bf16_t)(pk2(v[e], 0.f) & 0xffff);
          }
        }
      }
    }
  }
}

constexpr int NCH_P = 4096, NCH = 4224;
constexpr int XLD = 40;
DI f32x4 mm16(const bf16_t* Xrow, int ldx, const bf16_t* Yrow, int ldy, int ksteps, f32x4 acc, int l15, int quad) {
  for (int ks = 0; ks < ksteps; ++ks) {
    const bf16x8 a = *(const bf16x8*)(Xrow + l15 * ldx + ks * 32 + quad * 8);
    const bf16x8 b = *(const bf16x8*)(Yrow + l15 * ldy + ks * 32 + quad * 8);
    acc = __builtin_amdgcn_mfma_f32_16x16x32_bf16(a, b, acc, 0, 0, 0);
  }
  return acc;
}
DI void chunk_item(const Params& p, int l, int item, char* lds) {
  const int tid = tid_(), wave = tid >> 6, lane = tid & 63, l15 = lane & 15, quad = lane >> 4;
  const bool isp = item < NCH_P;
  int bh, c;
  if (isp) { bh = item >> 7; c = item & 127; } else { const int j = item - NCH_P; bh = j >> 1; c = j & 1; }
  const int b = bh >> 3, h = bh & 7;
  const int t0 = c * 32; const int row0 = (isp ? b * 4096 : MP + b * 64) + t0;
  float* s_r = (float*)lds;
  float* s_kf = s_r + 2048;
  float* s_v = s_kf + 2048;
  float* s_w = s_v + 2048;
  float* s_kk = s_w + 2048;
  float* s_bb = s_kk + 2048;
  bf16_t* s_wd = (bf16_t*)(lds + 49152);
  bf16_t* s_ad = (bf16_t*)(lds + 53760);
  float* s_bonus = (float*)(lds + 58368);
  float* s_wl = (float*)(lds + 58496);
  float* s_rhs = (float*)lds;
  bf16_t* s_A = (bf16_t*)lds;
  bf16_t* s_Bm = (bf16_t*)(lds + 4608);
  bf16_t* s_Kp = (bf16_t*)(lds + 9216);
  bf16_t* s_R = (bf16_t*)(lds + 16384);
  bf16_t* s_BmT = (bf16_t*)(lds + 20992);
  bf16_t* s_KpT = (bf16_t*)(lds + 26112);
  bf16_t* s_VmT = (bf16_t*)(lds + 31232);
  bf16_t* s_Lak = (bf16_t*)(lds + 36352);
  bf16_t* s_Mrk = (bf16_t*)(lds + 38912);
  bf16_t* s_Mrb = (bf16_t*)(lds + 41472);
  float* s_lab = (float*)(lds + 44032);
  bf16_t* s_XT = (bf16_t*)(lds + 48256);

  const int mat = wave >> 1, tt = wave & 1;
  const bf16_t* wl = (mat == 0 ? p.w2t : p.a2t) + (size_t)(h * 64) * 64;
  const float* mu = p.shift_mu + l * SHC;
  const float* w0 = p.decay_w0 + l * 512 + h * 64;
  const float* a0 = p.iclr_a0 + l * 512 + h * 64;
  const float* kkp = p.k_k + l * 512 + h * 64;
  const float* kap = p.k_a + l * 512 + h * 64;
  const float* rkp = p.r_k + l * 512 + h * 64;
  const float* lb = p.lnx_b + l * 512 + h * 64;
  const int ptok = tid >> 3, pcs = (tid & 7) * 8;
  {
    const int t = t0 + ptok; const size_t row = (size_t)(row0 + ptok);
#pragma unroll
    for (int g = 0; g < 5; ++g) {
      const int zc = (g < 3 ? g * 512 + h * 64 : 1536 + (g - 3) * 64) + pcs;
      const u32x4 cu = *(const u32x4*)(p.z + row * NZ + zc);
      float cur[8], prv[8];
#pragma unroll
      for (int e = 0; e < 4; ++e) { cur[2 * e] = bf_lo(cu[e]); cur[2 * e + 1] = bf_hi(cu[e]); }
      if (t > 0) {
        const u32x4 pu = *(const u32x4*)(p.z + (row - 1) * NZ + zc);
#pragma unroll
        for (int e = 0; e < 4; ++e) { prv[2 * e] = bf_lo(pu[e]); prv[2 * e + 1] = bf_hi(pu[e]); }
      } else if (isp) {
#pragma unroll
        for (int e = 0; e < 8; ++e) prv[e] = 0.f;
      } else {
        const float* sp = p.sshift + (size_t)(l * 8 + b) * SHC + zc;
#pragma unroll
        for (int e = 0; e < 8; ++e) prv[e] = sp[e];
      }
      float zs[8];
#pragma unroll
      for (int e = 0; e < 8; ++e) zs[e] = cur[e] + (prv[e] - cur[e]) * mu[zc + e];
      if (g < 3) {
        float* d = (g == 0 ? s_r : g == 1 ? s_kf : s_v) + ptok * 64 + pcs;
        *(f32x4*)d = (f32x4){zs[0], zs[1], zs[2], zs[3]}; *(f32x4*)(d + 4) = (f32x4){zs[4], zs[5], zs[6], zs[7]};
      } else {
        if (g == 3) {
#pragma unroll
          for (int e = 0; e < 8; ++e) { const float ex = __expf(2.f * zs[e]); zs[e] = 1.f - 2.f / (ex + 1.f); }
        }
        u32x4 o; o[0] = pk2(zs[0], zs[1]); o[1] = pk2(zs[2], zs[3]); o[2] = pk2(zs[4], zs[5]); o[3] = pk2(zs[6], zs[7]);
        *(u32x4*)((g == 3 ? s_wd : s_ad) + ptok * 72 + pcs) = o;
      }
    }
  }
  __syncthreads();
  {
    const bf16_t* At = (mat == 0 ? s_wd : s_ad);
    bf16x8 af[2];
#pragma unroll
    for (int ks = 0; ks < 2; ++ks) af[ks] = *(const bf16x8*)(At + (tt * 16 + l15) * 72 + ks * 32 + quad * 8);
#pragma unroll
    for (int ct = 0; ct < 4; ++ct) {
      f32x4 d = (f32x4){0.f, 0.f, 0.f, 0.f};
#pragma unroll
      for (int ks = 0; ks < 2; ++ks) {
        const bf16x8 wfr = *(const bf16x8*)(wl + (size_t)(ct * 16 + l15) * 64 + ks * 32 + quad * 8);
        d = __builtin_amdgcn_mfma_f32_16x16x32_bf16(wfr, af[ks], d, 0, 0, 0);
      }
      const int ch = ct * 16 + quad * 4; const int tok = tt * 16 + l15;
      f32x4 o;
      if (mat == 0) {
#pragma unroll
        for (int e = 0; e < 4; ++e) {
          const float y = -(w0[ch + e] + d[e]);
          const float sp = fmaxf(y, 0.f) + log1pf(__expf(-fabsf(y)));
          o[e] = -__expf(-sp - 0.5f);
        }
        *(f32x4*)(s_w + tok * 64 + ch) = o;
      } else {
#pragma unroll
        for (int e = 0; e < 4; ++e) o[e] = sigmoidf_(a0[ch + e] + d[e]);
        *(f32x4*)(s_bb + tok * 64 + ch) = o;
      }
    }
  }
  __syncthreads();
  float r_[8], kf[8], kk[8], bbv[8], v_[8], bon;
  {
    float k_[8], a_[8];
    *(f32x4*)&k_[0] = *(const f32x4*)(s_kf + ptok * 64 + pcs); *(f32x4*)&k_[4] = *(const f32x4*)(s_kf + ptok * 64 + pcs + 4);
    *(f32x4*)&a_[0] = *(const f32x4*)(s_bb + ptok * 64 + pcs); *(f32x4*)&a_[4] = *(const f32x4*)(s_bb + ptok * 64 + pcs + 4);
    *(f32x4*)&r_[0] = *(const f32x4*)(s_r + ptok * 64 + pcs); *(f32x4*)&r_[4] = *(const f32x4*)(s_r + ptok * 64 + pcs + 4);
    *(f32x4*)&v_[0] = *(const f32x4*)(s_v + ptok * 64 + pcs); *(f32x4*)&v_[4] = *(const f32x4*)(s_v + ptok * 64 + pcs + 4);
    float ss = 0.f; bon = 0.f;
#pragma unroll
    for (int e = 0; e < 8; ++e) {
      kk[e] = k_[e] * kkp[pcs + e]; ss += kk[e] * kk[e];
      kf[e] = k_[e] * (1.f + (a_[e] - 1.f) * kap[pcs + e]);
      bon += r_[e] * kf[e] * rkp[pcs + e];
    }
    ss += __shfl_xor(ss, 1); ss += __shfl_xor(ss, 2); ss += __shfl_xor(ss, 4);
    bon += __shfl_xor(bon, 1); bon += __shfl_xor(bon, 2); bon += __shfl_xor(bon, 4);
    const float inv = 1.0f / fmaxf(sqrtf(ss), 1e-12f);
#pragma unroll
    for (int e = 0; e < 8; ++e) { kk[e] *= inv; bbv[e] = kk[e] * a_[e]; }
  }
  if (tid < 64) {
    float run = 0.f;
#pragma unroll 8
    for (int t = 0; t < 32; ++t) { run += s_w[t * 64 + tid]; s_w[t * 64 + tid] = run; }
  }
  __syncthreads();
  {
    float cw[8], cwp[8];
    *(f32x4*)&cw[0] = *(const f32x4*)(s_w + ptok * 64 + pcs); *(f32x4*)&cw[4] = *(const f32x4*)(s_w + ptok * 64 + pcs + 4);
    if (ptok > 0) { *(f32x4*)&cwp[0] = *(const f32x4*)(s_w + (ptok - 1) * 64 + pcs); *(f32x4*)&cwp[4] = *(const f32x4*)(s_w + (ptok - 1) * 64 + pcs + 4); }
    else {
#pragma unroll
      for (int e = 0; e < 8; ++e) cwp[e] = 0.f;
    }
    __syncthreads();
    float av[8], bm[8], kp[8], rr[8];
#pragma unroll
    for (int e = 0; e < 8; ++e) {
      const float ec = __expf(cw[e]), en = __expf(-cw[e]), ep = __expf(cwp[e]);
      av[e] = kk[e] * ep; bm[e] = bbv[e] * en; kp[e] = kf[e] * en; rr[e] = r_[e] * ec;
      if (ptok == 31) s_wl[pcs + e] = ec;
    }
    u32x4 o;
    o[0] = pk2(av[0], av[1]); o[1] = pk2(av[2], av[3]); o[2] = pk2(av[4], av[5]); o[3] = pk2(av[6], av[7]); *(u32x4*)(s_A + ptok * 72 + pcs) = o;
    o[0] = pk2(bm[0], bm[1]); o[1] = pk2(bm[2], bm[3]); o[2] = pk2(bm[4], bm[5]); o[3] = pk2(bm[6], bm[7]); *(u32x4*)(s_Bm + ptok * 72 + pcs) = o;
#pragma unroll
    for (int e = 0; e < 4; ++e) { s_BmT[(pcs + 2 * e) * XLD + ptok] = (bf16_t)(o[e] & 0xffff); s_BmT[(pcs + 2 * e + 1) * XLD + ptok] = (bf16_t)(o[e] >> 16); }
    o[0] = pk2(kp[0], kp[1]); o[1] = pk2(kp[2], kp[3]); o[2] = pk2(kp[4], kp[5]); o[3] = pk2(kp[6], kp[7]); *(u32x4*)(s_Kp + ptok * 72 + pcs) = o;
#pragma unroll
    for (int e = 0; e < 4; ++e) { s_KpT[(pcs + 2 * e) * XLD + ptok] = (bf16_t)(o[e] & 0xffff); s_KpT[(pcs + 2 * e + 1) * XLD + ptok] = (bf16_t)(o[e] >> 16); }
    o[0] = pk2(rr[0], rr[1]); o[1] = pk2(rr[2], rr[3]); o[2] = pk2(rr[4], rr[5]); o[3] = pk2(rr[6], rr[7]); *(u32x4*)(s_R + ptok * 72 + pcs) = o;
    o[0] = pk2(v_[0], v_[1]); o[1] = pk2(v_[2], v_[3]); o[2] = pk2(v_[4], v_[5]); o[3] = pk2(v_[6], v_[7]);
#pragma unroll
    for (int e = 0; e < 4; ++e) { s_VmT[(pcs + 2 * e) * XLD + ptok] = (bf16_t)(o[e] & 0xffff); s_VmT[(pcs + 2 * e + 1) * XLD + ptok] = (bf16_t)(o[e] >> 16); }
    u32x4 ob;
    ob[0] = pk2(lb[pcs + 0] + bon * v_[0], lb[pcs + 1] + bon * v_[1]); ob[1] = pk2(lb[pcs + 2] + bon * v_[2], lb[pcs + 3] + bon * v_[3]);
    ob[2] = pk2(lb[pcs + 4] + bon * v_[4], lb[pcs + 5] + bon * v_[5]); ob[3] = pk2(lb[pcs + 6] + bon * v_[6], lb[pcs + 7] + bon * v_[7]);
    *(u32x4*)(p.cBA + ((size_t)item * 32 + ptok) * 64 + pcs) = ob;
  }
  __syncthreads();
  {
    const bf16_t* X = (wave < 2) ? s_A : s_R;
    const bf16_t* Y = (wave == 0 || wave == 3) ? s_Bm : s_Kp;
    const bool strict = wave < 2;
#pragma unroll
    for (int ti = 0; ti < 2; ++ti)
#pragma unroll
      for (int ii = 0; ii < 2; ++ii) {
        f32x4 d = (f32x4){0.f, 0.f, 0.f, 0.f};
        if (ii <= ti) d = mm16(X + ti * 16 * 72, 72, Y + ii * 16 * 72, 72, 2, d, l15, quad);
        const int i = ii * 16 + l15;
#pragma unroll
        for (int e = 0; e < 4; ++e) {
          const int t = ti * 16 + quad * 4 + e;
          const bool keep = strict ? (i < t) : (i <= t);
          const float val = keep ? d[e] : 0.f;
          if (wave == 0) s_lab[t * 33 + i] = val;
          else { bf16_t* dst = (wave == 1 ? s_Lak : wave == 2 ? s_Mrk : s_Mrb); dst[t * XLD + i] = (bf16_t)(pk2(val, 0.f) & 0xffff); }
        }
      }
  }
  const u32x4 acap = *(const u32x4*)(s_A + ptok * 72 + pcs);
  __syncthreads();
  {
    float* d = s_rhs + ptok * 128 + pcs;
    *(f32x4*)d = (f32x4){bf_lo(acap[0]), bf_hi(acap[0]), bf_lo(acap[1]), bf_hi(acap[1])};
    *(f32x4*)(d + 4) = (f32x4){bf_lo(acap[2]), bf_hi(acap[2]), bf_lo(acap[3]), bf_hi(acap[3])};
  }
  {
    const int ti = wave & 1;
#pragma unroll
    for (int vv = 0; vv < 2; ++vv) {
      const int vi = (wave >> 1) * 2 + vv;
      f32x4 d = (f32x4){0.f, 0.f, 0.f, 0.f};
      d = mm16(s_Lak + ti * 16 * XLD, XLD, s_VmT + vi * 16 * XLD, XLD, 1, d, l15, quad);
#pragma unroll
      for (int e = 0; e < 4; ++e) s_rhs[(ti * 16 + quad * 4 + e) * 128 + 64 + vi * 16 + l15] = d[e];
    }
  }
  __syncthreads();
  if (tid < 128) {
    float x[32];
#pragma unroll
    for (int t = 0; t < 32; ++t) {
      float a = s_rhs[t * 128 + tid];
#pragma unroll
      for (int i = 0; i < t; ++i) a -= s_lab[t * 33 + i] * x[i];
      x[t] = a;
    }
#pragma unroll
    for (int q4 = 0; q4 < 4; ++q4) {
      u32x4 o; o[0] = pk2(x[8 * q4], x[8 * q4 + 1]); o[1] = pk2(x[8 * q4 + 2], x[8 * q4 + 3]); o[2] = pk2(x[8 * q4 + 4], x[8 * q4 + 5]); o[3] = pk2(x[8 * q4 + 6], x[8 * q4 + 7]);
      *(u32x4*)(s_XT + tid * XLD + q4 * 8) = o;
    }
  }
  __syncthreads();
  {
    const f32x4 z4 = (f32x4){0.f, 0.f, 0.f, 0.f};
    bf16_t* gPT = p.cPT + (size_t)item * 4096;
    const float wl_c = s_wl[wave * 16 + l15];
#pragma unroll
    for (int k1t = 0; k1t < 4; ++k1t) {
      f32x4 d = mm16(s_XT + k1t * 16 * XLD, XLD, s_BmT + wave * 16 * XLD, XLD, 1, z4, l15, quad);
      const int k2 = wave * 16 + l15, k1 = k1t * 16 + quad * 4;
      float o[4];
#pragma unroll
      for (int e = 0; e < 4; ++e) o[e] = ((k1 + e == k2 ? 1.f : 0.f) - d[e]) * wl_c;
      u32x2 ov; ov[0] = pk2(o[0], o[1]); ov[1] = pk2(o[2], o[3]);
      *(u32x2*)(gPT + k2 * 64 + k1) = ov;
    }
    bf16_t* gG = p.cG + (size_t)item * 4096;
#pragma unroll
    for (int k2t = 0; k2t < 4; ++k2t) {
      const f32x4 d1 = mm16(s_KpT + k2t * 16 * XLD, XLD, s_VmT + wave * 16 * XLD, XLD, 1, z4, l15, quad);
      const f32x4 d2 = mm16(s_BmT + k2t * 16 * XLD, XLD, s_XT + (64 + wave * 16) * XLD, XLD, 1, z4, l15, quad);
      const int k2 = k2t * 16 + quad * 4, v = wave * 16 + l15;
      const f32x4 wv = *(const f32x4*)(s_wl + k2);
      u32x2 ov; ov[0] = pk2((d1[0] - d2[0]) * wv[0], (d1[1] - d2[1]) * wv[1]); ov[1] = pk2((d1[2] - d2[2]) * wv[2], (d1[3] - d2[3]) * wv[3]);
      *(u32x2*)(gG + v * 64 + k2) = ov;
    }
    bf16_t* gRT = p.cRT + (size_t)item * 2048;
    bf16_t* gOI = p.cOI + (size_t)item * 2048;
#pragma unroll
    for (int ti = 0; ti < 2; ++ti) {
      const f32x4 d = mm16(s_XT + wave * 16 * XLD, XLD, s_Mrb + ti * 16 * XLD, XLD, 1, z4, l15, quad);
      const int t = ti * 16 + l15, k = wave * 16 + quad * 4;
      const u32x2 rv = *(const u32x2*)(s_R + t * 72 + k);
      u32x2 ov; ov[0] = pk2(bf_lo(rv[0]) - d[0], bf_hi(rv[0]) - d[1]); ov[1] = pk2(bf_lo(rv[1]) - d[2], bf_hi(rv[1]) - d[3]);
      *(u32x2*)(gRT + t * 64 + k) = ov;
      const f32x4 e1 = mm16(s_VmT + wave * 16 * XLD, XLD, s_Mrk + ti * 16 * XLD, XLD, 1, z4, l15, quad);
      const f32x4 e2 = mm16(s_XT + (64 + wave * 16) * XLD, XLD, s_Mrb + ti * 16 * XLD, XLD, 1, z4, l15, quad);
      u32x2 oo; oo[0] = pk2(e1[0] - e2[0], e1[1] - e2[1]); oo[1] = pk2(e1[2] - e2[2], e1[3] - e2[3]);
      *(u32x2*)(gOI + t * 64 + k) = oo;
    }
  }
  __syncthreads();
}

DI void rec_item(const Params& p, int l, int item, char* lds) {
  const int tid = tid_(), wave = tid >> 6, lane = tid & 63, l15 = lane & 15, quad = lane >> 4;
  const bool isp = item < 32;
  const int bh = isp ? item : item - 32; const int b = bh >> 3, h = bh & 7;
  const int nch = isp ? 128 : 2; const int cid0 = isp ? bh * 128 : NCH_P + bh * 2;
  const int row0 = isp ? b * 4096 : MP + b * 64;
  bf16_t* Sb = (bf16_t*)lds;
  {
    const int v = wave * 16 + l15;
    f32x4 a0[4];
    if (isp) {
#pragma unroll
      for (int nk = 0; nk < 4; ++nk) a0[nk] = (f32x4){0.f, 0.f, 0.f, 0.f};
    } else {
      const float* sp = p.swkv + (((size_t)(l * 8 + b) * 8 + h) * 64 + v) * 64;
#pragma unroll
      for (int nk = 0; nk < 4; ++nk) a0[nk] = *(const f32x4*)(sp + nk * 16 + quad * 4);
    }
#pragma unroll
    for (int nk = 0; nk < 4; ++nk) { u32x2 o; o[0] = pk2(a0[nk][0], a0[nk][1]); o[1] = pk2(a0[nk][2], a0[nk][3]); *(u32x2*)(Sb + v * 72 + nk * 16 + quad * 4) = o; }
  }
  __syncthreads();
  const int nmain = nch - 2;
  if (wave < 2) {
    struct PS { bf16x8 pt[4][2]; u32x2 gv[2][4]; };
    auto ldp = [&](PS& s, int c) {
      const int cc = c < nch ? c : nch - 1;
      const size_t cid = (size_t)(cid0 + cc);
      const bf16_t* gPT = p.cPT + cid * 4096; const bf16_t* gG = p.cG + cid * 4096;
#pragma unroll
      for (int nk = 0; nk < 4; ++nk) {
#pragma unroll
        for (int ks = 0; ks < 2; ++ks) s.pt[nk][ks] = *(const bf16x8*)(gPT + (nk * 16 + l15) * 64 + ks * 32 + quad * 8);
#pragma unroll
        for (int v2 = 0; v2 < 2; ++v2) s.gv[v2][nk] = *(const u32x2*)(gG + ((wave * 2 + v2) * 16 + l15) * 64 + nk * 16 + quad * 4);
      }
    };
    f32x4 acc[2][4];
    auto step = [&](PS& s, int c) {
      const int buf = c & 1;
#pragma unroll
      for (int v2 = 0; v2 < 2; ++v2) {
        const int v = (wave * 2 + v2) * 16 + l15;
        bf16x8 sf[2];
#pragma unroll
        for (int ks = 0; ks < 2; ++ks) sf[ks] = *(const bf16x8*)(Sb + (buf * 64 + v) * 72 + ks * 32 + quad * 8);
#pragma unroll
        for (int nk = 0; nk < 4; ++nk) {
          f32x4 a = (f32x4){bf_lo(s.gv[v2][nk][0]), bf_hi(s.gv[v2][nk][0]), bf_lo(s.gv[v2][nk][1]), bf_hi(s.gv[v2][nk][1])};
#pragma unroll
          for (int ks = 0; ks < 2; ++ks) a = __builtin_amdgcn_mfma_f32_16x16x32_bf16(s.pt[nk][ks], sf[ks], a, 0, 0, 0);
          acc[v2][nk] = a;
        }
      }
      ldp(s, c + 3);
#pragma unroll
      for (int v2 = 0; v2 < 2; ++v2) {
        const int v = (wave * 2 + v2) * 16 + l15;
#pragma unroll
        for (int nk = 0; nk < 4; ++nk) { u32x2 ov; ov[0] = pk2(acc[v2][nk][0], acc[v2][nk][1]); ov[1] = pk2(acc[v2][nk][2], acc[v2][nk][3]); *(u32x2*)(Sb + ((buf ^ 1) * 64 + v) * 72 + nk * 16 + quad * 4) = ov; }
      }
      asm volatile("s_waitcnt lgkmcnt(0)" ::: "memory"); __builtin_amdgcn_s_barrier(); asm volatile("" ::: "memory");
    };
    PS s0, s1, s2;
    ldp(s0, 0); ldp(s1, 1); ldp(s2, 2);
#pragma unroll 1
    for (int c = 0; c < nmain; c += 3) { step(s0, c); step(s1, c + 1); step(s2, c + 2); }
    step(s0, nmain); step(s1, nmain + 1);
#pragma unroll
    for (int v2 = 0; v2 < 2; ++v2) {
      const int v = (wave * 2 + v2) * 16 + l15;
      float* so = (isp ? p.out + O_WP + (((size_t)(l * 4 + b) * 8 + h) * 64 + v) * 64 : p.out + O_WS + (((size_t)(l * 8 + b) * 8 + h) * 64 + v) * 64);
#pragma unroll
      for (int nk = 0; nk < 4; ++nk) *(f32x4*)(so + nk * 16 + quad * 4) = acc[v2][nk];
    }
  } else {
    struct CS { bf16x8 rt[2]; u32x2 oi[4], ba[4], gt[4]; };
    const int tok = (wave - 2) * 16 + l15;
    auto ldc = [&](CS& s, int c) {
      const int cc = c < nch ? c : nch - 1;
      const size_t cid = (size_t)(cid0 + cc); const size_t row = (size_t)(row0 + cc * 32 + tok);
#pragma unroll
      for (int ks = 0; ks < 2; ++ks) s.rt[ks] = *(const bf16x8*)(p.cRT + cid * 2048 + tok * 64 + ks * 32 + quad * 8);
#pragma unroll
      for (int vt = 0; vt < 4; ++vt) {
        s.oi[vt] = *(const u32x2*)(p.cOI + cid * 2048 + tok * 64 + vt * 16 + quad * 4);
        s.ba[vt] = *(const u32x2*)(p.cBA + cid * 2048 + tok * 64 + vt * 16 + quad * 4);
        s.gt[vt] = *(const u32x2*)(p.z + row * NZ + C_GR + h * 64 + vt * 16 + quad * 4);
      }
    };
    const float* lg = p.lnx_g + l * 512 + h * 64;
    f32x4 lgv[4];
#pragma unroll
    for (int vt = 0; vt < 4; ++vt) lgv[vt] = *(const f32x4*)(lg + vt * 16 + quad * 4);
    auto step = [&](CS& s, int c) {
      const int buf = c & 1; const size_t row = (size_t)(row0 + c * 32 + tok);
      f32x4 ao[4];
#pragma unroll
      for (int vt = 0; vt < 4; ++vt) {
        f32x4 a = (f32x4){bf_lo(s.oi[vt][0]), bf_hi(s.oi[vt][0]), bf_lo(s.oi[vt][1]), bf_hi(s.oi[vt][1])};
#pragma unroll
        for (int ks = 0; ks < 2; ++ks) {
          const bf16x8 sa = *(const bf16x8*)(Sb + (buf * 64 + vt * 16 + l15) * 72 + ks * 32 + quad * 8);
          a = __builtin_amdgcn_mfma_f32_16x16x32_bf16(sa, s.rt[ks], a, 0, 0, 0);
        }
        ao[vt] = a;
      }
      float sm = 0.f;
#pragma unroll
      for (int vt = 0; vt < 4; ++vt) sm += (ao[vt][0] + ao[vt][1]) + (ao[vt][2] + ao[vt][3]);
      sm += __shfl_xor(sm, 16); sm += __shfl_xor(sm, 32);
      const float mean = sm * (1.0f / 64.0f);
      float vr = 0.f;
#pragma unroll
      for (int vt = 0; vt < 4; ++vt)
#pragma unroll
        for (int e = 0; e < 4; ++e) { const float d = ao[vt][e] - mean; vr += d * d; }
      vr += __shfl_xor(vr, 16); vr += __shfl_xor(vr, 32);
      const float rstd = rsqrtf(vr * (1.0f / 64.0f) + 64e-5f);
#pragma unroll
      for (int vt = 0; vt < 4; ++vt) {
        const int vv = vt * 16 + quad * 4;
        const f32x4 g4 = lgv[vt];
        const float y0 = ((ao[vt][0] - mean) * rstd * g4[0] + bf_lo(s.ba[vt][0])) * bf_lo(s.gt[vt][0]);
        const float y1 = ((ao[vt][1] - mean) * rstd * g4[1] + bf_hi(s.ba[vt][0])) * bf_hi(s.gt[vt][0]);
        const float y2 = ((ao[vt][2] - mean) * rstd * g4[2] + bf_lo(s.ba[vt][1])) * bf_lo(s.gt[vt][1]);
        const float y3 = ((ao[vt][3] - mean) * rstd * g4[3] + bf_hi(s.ba[vt][1])) * bf_hi(s.gt[vt][1]);
        u32x2 ov; ov[0] = pk2(y0, y1); ov[1] = pk2(y2, y3);
        *(u32x2*)(p.o_r + row * 512 + h * 64 + vv) = ov;
      }
      ldc(s, c + 3);
      asm volatile("s_waitcnt lgkmcnt(0)" ::: "memory"); __builtin_amdgcn_s_barrier(); asm volatile("" ::: "memory");
    };
    CS s0, s1, s2;
    ldc(s0, 0); ldc(s1, 1); ldc(s2, 2);
#pragma unroll 1
    for (int c = 0; c < nmain; c += 3) { step(s0, c); step(s1, c + 1); step(s2, c + 2); }
    step(s0, nmain); step(s1, nmain + 1);
  }
  __syncthreads();
}
DI void phase_chunk(const Params& p, int l, char* lds) {
  for (int it = blockIdx.x; it < NCH; it += gridDim.x) chunk_item(p, l, it, lds);
}

constexpr int ALD = 72;
DI void attn_item(const Params& p, int l, int item, char* lds) {
  const int tid = tid_(), wave = tid >> 6, lane = tid & 63;
  const int m = wave & 1, qh = wave >> 1, q = lane & 31, hh = lane >> 5;
  bf16_t* Ks = (bf16_t*)lds;
  bf16_t* Vs = Ks + 2 * 64 * ALD;
  float* xb = (float*)lds;
  bool samp; int b, h, nch, qrow0, qpos0;
  if (item < 32) { samp = true; b = item >> 2; h = item & 3; nch = 17; qrow0 = MP + b * 64; qpos0 = 1024; }
  else { samp = false; const int a = item - 32; const int qc = 63 - (a >> 4); const int bh = a & 15; b = bh >> 2; h = bh & 3; nch = qc + 1; qrow0 = b * 4096 + qc * 64; qpos0 = qc * 64; }
  bf16x8 qf[4];
  {
    const bf16_t* qp = p.z + (size_t)(qrow0 + qh * 32 + q) * NZ + C_Q + h * 128 + m * 64;
#pragma unroll
    for (int ks = 0; ks < 4; ++ks) qf[ks] = *(const bf16x8*)(qp + ks * 16 + hh * 8);
  }
  const float slope = exp2f(-2.0f * (float)(h + 1));
  const float LOG2E = 1.4426950408889634f;
  const float c1 = 0.125f * LOG2E, sl2 = slope * LOG2E;
  const float qposf = (float)(qpos0 + qh * 32 + q);
  f32x16 O[4];
#pragma unroll
  for (int i = 0; i < 4; ++i)
#pragma unroll
    for (int e = 0; e < 16; ++e) O[i][e] = 0.f;
  float mrun = -1e30f, lrun = 0.f;
  u32x4 rk[4], rv[4];
  auto gload = [&](int j) {
    const bf16_t* kb; size_t kld; const bf16_t* vb; size_t vld;
    if (!samp) { kb = p.z + (size_t)(b * 4096 + j * 64) * NZ + C_K + h * 128; kld = NZ; vb = p.vtp + (size_t)((b * 4 + h) * 128) * 4096 + j * 64; vld = 4096; }
    else if (j < 16) { kb = p.kc + (size_t)(b * 1024 + j * 64) * 512 + h * 128; kld = 512; vb = p.vct + (size_t)((b * 4 + h) * 128) * 1024 + j * 64; vld = 1024; }
    else { kb = p.z + (size_t)(MP + b * 64) * NZ + C_K + h * 128; kld = NZ; vb = p.vts + (size_t)((b * 4 + h) * 128) * 64; vld = 64; }
#pragma unroll
    for (int i = 0; i < 4; ++i) {
      const int c = tid + 256 * i;
      const int mm = c >> 9, key = (c >> 3) & 63, d8 = (c & 7) * 8;
      rk[i] = *(const u32x4*)(kb + (size_t)key * kld + mm * 64 + d8);
      const int vd = c >> 3, k8 = (c & 7) * 8;
      rv[i] = *(const u32x4*)(vb + (size_t)vd * vld + k8);
    }
  };
  auto sstore = [&]() {
#pragma unroll
    for (int i = 0; i < 4; ++i) {
      const int c = tid + 256 * i;
      const int mm = c >> 9, key = (c >> 3) & 63, d8 = (c & 7) * 8;
      *(u32x4*)(Ks + (mm * 64 + key) * ALD + d8) = rk[i];
      const int vd = c >> 3, k8 = (c & 7) * 8;
      *(u32x4*)(Vs + vd * ALD + k8) = rv[i];
    }
  };
  gload(0); sstore(); __syncthreads();
  for (int j = 0; j < nch; ++j) {
    if (j + 1 < nch) gload(j + 1);
    f32x16 s[2];
#pragma unroll
    for (int kt = 0; kt < 2; ++kt) {
#pragma unroll
      for (int e = 0; e < 16; ++e) s[kt][e] = 0.f;
#pragma unroll
      for (int ks = 0; ks < 4; ++ks) {
        const bf16x8 kf = *(const bf16x8*)(Ks + (m * 64 + kt * 32 + q) * ALD + ks * 16 + hh * 8);
        s[kt] = __builtin_amdgcn_mfma_f32_32x32x16_bf16(kf, qf[ks], s[kt], 0, 0, 0);
      }
    }
    float mx = -1e30f;
    const float dbase = qposf - (float)(j * 64 + 4 * hh);
#pragma unroll
    for (int kt = 0; kt < 2; ++kt)
#pragma unroll
      for (int e = 0; e < 16; ++e) {
        const float dd = dbase - (float)(kt * 32 + (e & 3) + 8 * (e >> 2));
        const float v = s[kt][e] * c1 - sl2 * fabsf(dd);
        s[kt][e] = v; mx = fmaxf(mx, v);
      }
    mx = fmaxf(mx, __shfl_xor(mx, 32));
    const float mnew = fmaxf(mrun, mx);
    const float alpha = __builtin_amdgcn_exp2f(mrun - mnew);
    const bool resc = mnew > mrun;
    mrun = mnew;
    float ps = 0.f;
#pragma unroll
    for (int kt = 0; kt < 2; ++kt)
#pragma unroll
      for (int e = 0; e < 16; ++e) { const float pe = __builtin_amdgcn_exp2f(s[kt][e] - mnew); s[kt][e] = pe; ps += pe; }
    lrun = lrun * alpha + ps;
    if (__any(resc)) {
#pragma unroll
      for (int i = 0; i < 4; ++i)
#pragma unroll
        for (int e = 0; e < 16; ++e) O[i][e] *= alpha;
    }
#pragma unroll
    for (int kt = 0; kt < 2; ++kt)
#pragma unroll
      for (int sx = 0; sx < 2; ++sx) {
        u32x4 pb;
        pb[0] = pk2(s[kt][8 * sx + 0], s[kt][8 * sx + 1]); pb[1] = pk2(s[kt][8 * sx + 2], s[kt][8 * sx + 3]);
        pb[2] = pk2(s[kt][8 * sx + 4], s[kt][8 * sx + 5]); pb[3] = pk2(s[kt][8 * sx + 6], s[kt][8 * sx + 7]);
        const bf16x8 pf = __builtin_bit_cast(bf16x8, pb);
#pragma unroll
        for (int vt = 0; vt < 4; ++vt) {
          const bf16_t* vp = Vs + (vt * 32 + q) * ALD + kt * 32 + 16 * sx + 4 * hh;
          const s16x4 lo = *(const s16x4*)vp, hi = *(const s16x4*)(vp + 8);
          const bf16x8 vf = __builtin_shufflevector(lo, hi, 0, 1, 2, 3, 4, 5, 6, 7);
          O[vt] = __builtin_amdgcn_mfma_f32_32x32x16_bf16(vf, pf, O[vt], 0, 0, 0);
        }
      }
    __syncthreads();
    if (j + 1 < nch) sstore();
    __syncthreads();
  }
  const float ltot = lrun + __shfl_xor(lrun, 32);
  const float inv = 1.0f / ltot;
#pragma unroll
  for (int i = 0; i < 4; ++i)
#pragma unroll
    for (int e = 0; e < 16; ++e) O[i][e] *= inv;
  if (m == 1) {
#pragma unroll
    for (int vt = 0; vt < 4; ++vt)
#pragma unroll
      for (int e = 0; e < 16; ++e) { const int vd = vt * 32 + (e & 3) + 8 * (e >> 2) + 4 * hh; xb[(qh * 128 + vd) * 32 + q] = O[vt][e]; }
  }
  __syncthreads();
  if (m == 0) {
    float d1 = 0.f, d2 = 0.f;
    for (int i = 0; i < 64; ++i) { d1 += p.lq1[l * 64 + i] * p.lk1[l * 64 + i]; d2 += p.lq2[l * 64 + i] * p.lk2[l * 64 + i]; }
    const float lam_init = 0.8f - 0.6f * __expf(-0.3f * (float)l);
    const float lam = __expf(d1) - __expf(d2) + lam_init;
    float ss = 0.f;
#pragma unroll
    for (int vt = 0; vt < 4; ++vt)
#pragma unroll
      for (int e = 0; e < 16; ++e) {
        const int vd = vt * 32 + (e & 3) + 8 * (e >> 2) + 4 * hh;
        const float o2 = xb[(qh * 128 + vd) * 32 + q];
        const float o = O[vt][e] - lam * o2; O[vt][e] = o; ss += o * o;
      }
    ss += __shfl_xor(ss, 32);
    const float rstd = rsqrtf(ss * (1.0f / 128.0f) + 1e-5f) * (1.0f - lam_init);
    const size_t row = (size_t)(qrow0 + qh * 32 + q);
    const float* sg = p.subln_g + l * 128;
#pragma unroll
    for (int vt = 0; vt < 4; ++vt)
#pragma unroll
      for (int e4 = 0; e4 < 4; ++e4) {
        const int vd = vt * 32 + 8 * e4 + 4 * hh;
        const u32x2 gu = *(const u32x2*)(p.z + row * NZ + C_GA + h * 128 + vd);
        const f32x4 gv = *(const f32x4*)(sg + vd);
        const float y0 = O[vt][4 * e4 + 0] * rstd * gv[0] * bf_lo(gu[0]);
        const float y1 = O[vt][4 * e4 + 1] * rstd * gv[1] * bf_hi(gu[0]);
        const float y2 = O[vt][4 * e4 + 2] * rstd * gv[2] * bf_lo(gu[1]);
        const float y3 = O[vt][4 * e4 + 3] * rstd * gv[3] * bf_hi(gu[1]);
        u32x2 ov; ov[0] = pk2(y0, y1); ov[1] = pk2(y2, y3);
        *(u32x2*)(p.o_a + row * 512 + h * 128 + vd) = ov;
      }
  }
  __syncthreads();
}

DI void phase_mix(const Params& p, int l, char* lds) {
  __shared__ int s_next;
  if (blockIdx.x < 96) rec_item(p, l, blockIdx.x, lds);
  unsigned* ctr = p.bar + XCD_BAR_WORDS + 64 * l;
  for (;;) {
    __syncthreads();
    if (threadIdx.x == 0) s_next = (int)atomicAdd(ctr, 1u);
    __syncthreads();
    const int it = s_next;
    if (it >= 1056) break;
    attn_item(p, l, it, lds);
  }
}

DI void phase_merge(const Params& p, int l, char* lds) {
  const int tid = tid_(), wave = tid >> 6, lane = tid & 63;
  const int wm = wave >> 1, wn = wave & 1, l15 = lane & 15, quad = lane >> 4;
  for (int tile = blockIdx.x; tile < 132 * 8; tile += gridDim.x) {
    const int mt = tile >> 3, nt = tile & 7;
    f32x4 a1[4][4]; zero_acc(a1);
    gemm_core<false>(a1, p.o_r + (size_t)mt * 128 * 512, 512, p.wt_brr + (size_t)nt * 128 * 512, 512, 512, lds);
    u32x2 pk[4][4];
#pragma unroll
    for (int mi = 0; mi < 4; ++mi) {
      const int R = mt * 128 + wm * 64 + mi * 16 + l15;
#pragma unroll
      for (int ni = 0; ni < 4; ++ni) {
        const int c = nt * 128 + wn * 64 + ni * 16 + quad * 4;
        const u32x2 g1 = *(const u32x2*)(p.z + (size_t)R * NZ + C_MR + c);
        const f32x4 v1 = a1[mi][ni];
        pk[mi][ni][0] = pk2(bf_lo(g1[0]) * v1[0], bf_hi(g1[0]) * v1[1]);
        pk[mi][ni][1] = pk2(bf_lo(g1[1]) * v1[2], bf_hi(g1[1]) * v1[3]);
      }
    }
    zero_acc(a1);
    gemm_core<false>(a1, p.o_a + (size_t)mt * 128 * 512, 512, p.wt_bra + (size_t)nt * 128 * 512, 512, 512, lds);
#pragma unroll
    for (int mi = 0; mi < 4; ++mi) {
      const int R = mt * 128 + wm * 64 + mi * 16 + l15;
#pragma unroll
      for (int ni = 0; ni < 4; ++ni) {
        const int c = nt * 128 + wn * 64 + ni * 16 + quad * 4;
        const u32x2 g2 = *(const u32x2*)(p.z + (size_t)R * NZ + C_MA + c);
        const f32x4 v2 = a1[mi][ni]; const u32x2 u1 = pk[mi][ni];
        u32x2 o;
        o[0] = pk2(bf_lo(u1[0]) + bf_lo(g2[0]) * v2[0], bf_hi(u1[0]) + bf_hi(g2[0]) * v2[1]);
        o[1] = pk2(bf_lo(u1[1]) + bf_lo(g2[1]) * v2[2], bf_hi(u1[1]) + bf_hi(g2[1]) * v2[3]);
        *(u32x2*)(p.hn + (size_t)R * DM + c) = o;
      }
    }
  }
}
DI void phase_out(const Params& p, int l, char* lds) {
  const int tid = tid_(), wave = tid >> 6, lane = tid & 63;
  const int wm = wave >> 1, wn = wave & 1, l15 = lane & 15, quad = lane >> 4;
  for (int tile = blockIdx.x; tile < 132 * 8; tile += gridDim.x) {
    const int mt = tile >> 3, nt = tile & 7;
    f32x4 acc[4][4]; zero_acc(acc);
    gemm_core<false>(acc, p.hn + (size_t)mt * 128 * DM, DM, p.wt_out + (size_t)nt * 128 * DM, DM, DM, lds);
#pragma unroll
    for (int mi = 0; mi < 4; ++mi) {
      const int R = mt * 128 + wm * 64 + mi * 16 + l15;
      const float* xr = x_row(p, l, R);
#pragma unroll
      for (int ni = 0; ni < 4; ++ni) {
        const int c = nt * 128 + wn * 64 + ni * 16 + quad * 4;
        const f32x4 xv = *(const f32x4*)(xr + c);
        *(f32x4*)(p.out + (size_t)R * DM + c) = xv + acc[mi][ni];
      }
    }
  }
}
DI void phase_ple(const Params& p, int l, char* lds) {
  const int tid = tid_(), wave = tid >> 6, lane = tid & 63;
  const int wm = wave >> 1, wn = wave & 1, l15 = lane & 15, quad = lane >> 4;
  for (int tile = blockIdx.x; tile < 132 * 8; tile += gridDim.x) {
    const int mt = tile >> 3, nt = tile & 7;
    f32x4 a1[4][4]; zero_acc(a1);
    gemm_core<false>(a1, p.hn + (size_t)mt * 128 * DM, DM, p.wt_gate + (size_t)nt * 128 * DM, DM, DM, lds);
    u32x2 pk[4][4];
#pragma unroll
    for (int mi = 0; mi < 4; ++mi)
#pragma unroll
      for (int ni = 0; ni < 4; ++ni) { const f32x4 v = a1[mi][ni]; pk[mi][ni][0] = pk2(sigmoidf_(v[0]), sigmoidf_(v[1])); pk[mi][ni][1] = pk2(sigmoidf_(v[2]), sigmoidf_(v[3])); }
    zero_acc(a1);
    const int r0 = mt * 128;
    const float* pa = r0 < MP ? p.pp + ((size_t)l * MP + r0) * 256 : p.ps + ((size_t)l * MS + (r0 - MP)) * 256;
    gemm_core<true>(a1, pa, 256, p.wt_ple + (size_t)nt * 128 * 256, 256, 256, lds);
#pragma unroll
    for (int mi = 0; mi < 4; ++mi) {
      const int R = mt * 128 + wm * 64 + mi * 16 + l15;
#pragma unroll
      for (int ni = 0; ni < 4; ++ni) {
        const int c = nt * 128 + wn * 64 + ni * 16 + quad * 4;
        float* xo = p.out + (size_t)R * DM + c;
        const f32x4 xv = *(const f32x4*)xo; const f32x4 e = a1[mi][ni]; const u32x2 g = pk[mi][ni];
        f32x4 o;
        o[0] = xv[0] + e[0] * bf_lo(g[0]); o[1] = xv[1] + e[1] * bf_hi(g[0]);
        o[2] = xv[2] + e[2] * bf_lo(g[1]); o[3] = xv[3] + e[3] * bf_hi(g[1]);
        *(f32x4*)xo = o;
      }
    }
  }
}


#define XB_TMO      128
#define XB_XCNT(j)  (256  + 64 * (j))
#define XB_XSUB(j)  (1280 + 64 * (j))
#define XB_XGEN(j)  (2304 + 64 * (j))
#define XB_TOP      3328
#define XB_TOPGEN   3392
#define XB_SPIN_CAP (1u << 18)
#define LAS __attribute__((address_space(3)))
DI unsigned xb_ld(unsigned* p)              { return __hip_atomic_load(p, __ATOMIC_RELAXED, __HIP_MEMORY_SCOPE_AGENT); }
DI unsigned xb_add(unsigned* p, unsigned v) { return __hip_atomic_fetch_add(p, v, __ATOMIC_RELAXED, __HIP_MEMORY_SCOPE_AGENT); }
DI unsigned xb_xcc_id() { return (unsigned)__builtin_amdgcn_s_getreg((3 << 11) | 20) & 0xFu; }
#define XB_SPIN(cond, bar) do { unsigned _sp = 0; while (cond) { __builtin_amdgcn_s_sleep(1); \
    if ((++_sp & 255u) == 0u) { if (xb_ld(&(bar)[XB_TMO])) break; if (_sp > XB_SPIN_CAP) { atomicAdd(&(bar)[XB_TMO], 1u); break; } } } } while (0)
struct XcdBarrier { unsigned* bar; unsigned x; volatile LAS unsigned* st; };
DI XcdBarrier xcd_barrier_post(unsigned* bar, volatile LAS unsigned* st) {
  XcdBarrier b; b.bar = bar; b.x = xb_xcc_id(); b.st = st;
  if (threadIdx.x == 0) (void)xb_add(&bar[XB_XCNT(b.x)], 1u);
  return b;
}
DI void xcd_barrier_complete(unsigned* bar, unsigned x, unsigned& nloc, unsigned& nx) {
  const unsigned G = gridDim.x * gridDim.y * gridDim.z;
  unsigned sum, cnt, mine, sp = 0u;
  for (;;) {
    sum = 0u; cnt = 0u; mine = 0u;
#pragma unroll
    for (unsigned j = 0; j < 16; ++j) { const unsigned c = xb_ld(&bar[XB_XCNT(j)]); sum += c; cnt += (c > 0u) ? 1u : 0u; mine = (j == x) ? c : mine; }
    if (sum == G) break;
    __builtin_amdgcn_s_sleep(1);
    if ((++sp & 255u) == 0u) { if (xb_ld(&bar[XB_TMO])) break; if (sp > XB_SPIN_CAP) { atomicAdd(&bar[XB_TMO], 1u); break; } }
  }
  nloc = mine > 0u ? mine : 1u; nx = cnt > 0u ? cnt : 1u;
}
DI void xcd_barrier(const XcdBarrier& b) {
  asm volatile("s_waitcnt vmcnt(0)" ::: "memory");
  __syncthreads();
  if (threadIdx.x == 0) {
    unsigned* bar = b.bar;
    __builtin_amdgcn_s_waitcnt(0);
    unsigned nloc = b.st[0], nx = b.st[1];
    if (nloc == 0u) { xcd_barrier_complete(bar, b.x, nloc, nx); b.st[0] = nloc; b.st[1] = nx; }
    const unsigned old = xb_add(&bar[XB_XSUB(b.x)], 1u);
    const unsigned gen = old / nloc;
    if (old + 1u == (gen + 1u) * nloc) {
      __builtin_amdgcn_fence(__ATOMIC_RELEASE, "agent");
      asm volatile("s_waitcnt vmcnt(0)" ::: "memory");
      const unsigned og = xb_add(&bar[XB_TOP], 1u);
      const unsigned tg = og / nx;
      if (og + 1u == (tg + 1u) * nx) xb_add(&bar[XB_TOPGEN], 1u);
      else XB_SPIN(xb_ld(&bar[XB_TOPGEN]) == tg, bar);
      __builtin_amdgcn_fence(__ATOMIC_ACQUIRE, "agent");
      xb_add(&bar[XB_XGEN(b.x)], 1u);
      asm volatile("s_waitcnt vmcnt(0)" ::: "memory");
    } else {
      XB_SPIN(xb_ld(&bar[XB_XGEN(b.x)]) == gen, bar);
      __builtin_amdgcn_fence(__ATOMIC_ACQUIRE, "agent");
      asm volatile("s_waitcnt vmcnt(0)" ::: "memory");
    }
  }
  __syncthreads();
}
constexpr int LDS_BYTES = 73728;
DI void run_phase(const Params& p, int ph, int l, char* lds) {
  switch (ph) {
    case 1: phase_norm(p, l, true, lds); break;
    case 2: phase_gemm_in(p, l, lds); break;
    case 3: phase_mix(p, l, lds); break;
    case 4: phase_merge(p, l, lds); break;
    case 5: phase_out(p, l, lds); break;
    case 6: phase_norm(p, l, false, lds); break;
    case 7: phase_ple(p, l, lds); break;
    case 8: phase_chunk(p, l, lds); break;
  }
}

#if MEGA
__global__ void __launch_bounds__(256, 2) k_mega(Params p) {
  __shared__ __attribute__((aligned(16))) char lds[LDS_BYTES];
  __shared__ uint4 xb_words;
  cg::grid_group grid = cg::this_grid();
  if (threadIdx.x == 0) xb_words = make_uint4(0u, 0u, 0u, 0u);
  __syncthreads();
  const XcdBarrier xb = xcd_barrier_post(p.bar, (volatile LAS unsigned*)&xb_words);
#pragma unroll 1
  for (int l = 0; l < NL; ++l) {
    phase_norm(p, l, true, lds);
    if (l == 0) grid.sync(); else xcd_barrier(xb);
    phase_gemm_in(p, l, lds); xcd_barrier(xb);
    phase_chunk(p, l, lds); xcd_barrier(xb);
    phase_mix(p, l, lds); xcd_barrier(xb);
    phase_merge(p, l, lds); xcd_barrier(xb);
    phase_out(p, l, lds); xcd_barrier(xb);
    phase_norm(p, l, false, lds); xcd_barrier(xb);
    phase_ple(p, l, lds); if (l + 1 < NL) xcd_barrier(xb);
  }
}
#else
template <int PH>
__global__ void __launch_bounds__(256, 2) k_phase(Params p, int l) {
  __shared__ __attribute__((aligned(16))) char lds[LDS_BYTES];
  run_phase(p, PH, l, lds);
}
#endif

extern "C" void kernel_launch(void* const* d_in, const int* in_sizes, int n_in, void* d_out, int out_size, void* d_ws, size_t ws_size,
                              hipStream_t stream) {
  Params p{};
  const float** pf = (const float**)&p;
  for (int i = 0; i < 33; ++i) pf[i] = (const float*)d_in[i];
  p.out = (float*)d_out;
  char* w = (char*)d_ws; size_t off = 0;
  auto take = [&](size_t bytes) { char* r = w + off; off += (bytes + 255) & ~(size_t)255; return (bf16_t*)r; };
  p.bar = (unsigned*)take((size_t)(XCD_BAR_WORDS + 64 * NL) * 4);
  p.wt_in = take((size_t)NZ * 1024 * 2);
  p.wt_brr = take((size_t)1024 * 512 * 2);
  p.wt_bra = take((size_t)1024 * 512 * 2);
  p.wt_out = take((size_t)1024 * 1024 * 2);
  p.wt_ple = take((size_t)1024 * 256 * 2);
  p.wt_gate = take((size_t)1024 * 1024 * 2);
  p.w2t = take((size_t)512 * 64 * 2);
  p.a2t = take((size_t)512 * 64 * 2);
  p.z = take((size_t)MT * NZ * 2);
  p.vtp = take((size_t)16 * 128 * 4096 * 2);
  p.vts = take((size_t)32 * 128 * 64 * 2);
  p.kc = take((size_t)8 * 1024 * 512 * 2);
  p.vct = take((size_t)32 * 128 * 1024 * 2);
  p.o_r = take((size_t)MT * 512 * 2);
  p.o_a = take((size_t)MT * 512 * 2);
  p.hn = take((size_t)MT * DM * 2);
  p.cPT = p.hn;
  p.cG = take((size_t)NCH * 4096 * 2);
  p.cRT = take((size_t)NCH * 2048 * 2);
  p.cOI = take((size_t)NCH * 2048 * 2);
  p.cBA = take((size_t)NCH * 2048 * 2);
  if (off > ws_size) { fprintf(stderr, "workspace too small: need %zu have %zu\n", off, ws_size); return; }
#if MEGA
  hipMemsetAsync(p.bar, 0, (size_t)(XCD_BAR_WORDS + 64 * NL) * 4, stream);
  static int grid_blocks = 0;
  if (!grid_blocks) {
    int dev = 0, cus = 0, per_cu = 0;
    hipGetDevice(&dev);
    hipDeviceGetAttribute(&cus, hipDeviceAttributeMultiprocessorCount, dev);
    hipOccupancyMaxActiveBlocksPerMultiprocessor(&per_cu, k_mega, 256, 0);
    if (per_cu > 2) per_cu = 2;
    grid_blocks = cus * per_cu;
  }
  void* args[] = {&p};
  hipError_t e = hipLaunchCooperativeKernel((void*)k_mega, dim3(grid_blocks), dim3(256), args, 0, stream);
  if (e != hipSuccess) fprintf(stderr, "cooperative launch failed: %s (grid %d)\n", hipGetErrorString(e), grid_blocks);
#else
  const int G = 512;
  for (int l = 0; l < NL; ++l) {
    k_phase<1><<<G, 256, 0, stream>>>(p, l);
    k_phase<2><<<G, 256, 0, stream>>>(p, l);
    k_phase<8><<<G, 256, 0, stream>>>(p, l);
    k_phase<3><<<G, 256, 0, stream>>>(p, l);
    k_phase<4><<<G, 256, 0, stream>>>(p, l);
    k_phase<5><<<G, 256, 0, stream>>>(p, l);
    k_phase<6><<<G, 256, 0, stream>>>(p, l);
    k_phase<7><<<G, 256, 0, stream>>>(p, l);
  }
#endif
}
```

```cpp
#include <hip/hip_runtime.h>
#include <hip/hip_cooperative_groups.h>
#include <stdint.h>
#include <stdio.h>
namespace cg = cooperative_groups;

#ifndef MEGA
#define MEGA 1
#endif

typedef unsigned short bf16_t;
typedef short bf16x8 __attribute__((ext_vector_type(8)));
typedef short s16x4 __attribute__((ext_vector_type(4)));
typedef float f32x4 __attribute__((ext_vector_type(4)));
typedef float f32x2 __attribute__((ext_vector_type(2)));
typedef float f32x16 __attribute__((ext_vector_type(16)));
typedef unsigned u32x4 __attribute__((ext_vector_type(4)));
typedef unsigned u32x2 __attribute__((ext_vector_type(2)));
typedef __bf16 bfv2 __attribute__((ext_vector_type(2)));

#define DI __device__ __forceinline__
#define XCD_BAR_WORDS 3456
DI int tid_() { int t = threadIdx.x; asm volatile("" : "+v"(t)); return t; }

constexpr int DM = 1024, MP = 16384, MS = 512, MT = 16896, NZ = 6272, NL = 4;
constexpr int C_GR = 1664, C_Q = 2176, C_K = 2688, C_V = 3200, C_GA = 3712, C_MR = 4224, C_MA = 5248;
constexpr int SHC = 1664;
constexpr size_t O_YP = 0, O_YS = 16777216, O_KP = 17301504, O_VP = 50855936, O_WP = 84410368, O_SP = 84934656,
                 O_KS = 84961280, O_VS = 86009856, O_WS = 87058432, O_SS = 88107008;

struct Params {
  const float *xp, *xs, *pp, *ps, *ck, *cv, *swkv, *sshift;
  const float *norm_g, *w_in, *shift_mu, *decay_w0, *decay_w2, *iclr_a0, *iclr_a2, *k_k, *k_a, *r_k, *lnx_g, *lnx_b,
      *qng, *kng, *lq1, *lk1, *lq2, *lk2, *subln_g, *w_br_r, *w_br_a, *w_out, *ple_w, *ple_gate_w, *ple_norm_g;
  float* out;
  bf16_t *wt_in, *wt_brr, *wt_bra, *wt_out, *wt_ple, *wt_gate, *w2t, *a2t;
  bf16_t *hn, *z, *vtp, *vts, *kc, *vct, *o_r, *o_a;
  bf16_t *cPT, *cG, *cRT, *cOI, *cBA;
  unsigned* bar;
};

DI unsigned pk2(float a, float b) { f32x2 v = {a, b}; bfv2 r = __builtin_convertvector(v, bfv2); return __builtin_bit_cast(unsigned, r); }
DI float bf_lo(unsigned u) { return __uint_as_float(u << 16); }
DI float bf_hi(unsigned u) { return __uint_as_float(u & 0xffff0000u); }
DI float bf1(bf16_t u) { return __uint_as_float(((unsigned)u) << 16); }
DI float sigmoidf_(float x) { return 1.0f / (1.0f + __expf(-x)); }
DI float siluf_(float x) { return x / (1.0f + __expf(-x)); }

DI void tr_tile(const float* __restrict__ src, int ld_src, bf16_t* __restrict__ dst, int ld_dst, float* sm) {
  const int tid = tid_();
  const int r = tid >> 4, c4 = (tid & 15) * 4;
#pragma unroll
  for (int i = 0; i < 4; ++i) {
    const int row = r + 16 * i;
    f32x4 v = *(const f32x4*)(src + (size_t)row * ld_src + c4);
    sm[row * 65 + c4 + 0] = v[0]; sm[row * 65 + c4 + 1] = v[1]; sm[row * 65 + c4 + 2] = v[2]; sm[row * 65 + c4 + 3] = v[3];
  }
  __syncthreads();
  const int n = tid >> 2, ks = (tid & 3) * 16;
  u32x4 o0, o1;
  o0[0] = pk2(sm[(ks + 0) * 65 + n], sm[(ks + 1) * 65 + n]);   o0[1] = pk2(sm[(ks + 2) * 65 + n], sm[(ks + 3) * 65 + n]);
  o0[2] = pk2(sm[(ks + 4) * 65 + n], sm[(ks + 5) * 65 + n]);   o0[3] = pk2(sm[(ks + 6) * 65 + n], sm[(ks + 7) * 65 + n]);
  o1[0] = pk2(sm[(ks + 8) * 65 + n], sm[(ks + 9) * 65 + n]);   o1[1] = pk2(sm[(ks + 10) * 65 + n], sm[(ks + 11) * 65 + n]);
  o1[2] = pk2(sm[(ks + 12) * 65 + n], sm[(ks + 13) * 65 + n]); o1[3] = pk2(sm[(ks + 14) * 65 + n], sm[(ks + 15) * 65 + n]);
  *(u32x4*)(dst + (size_t)n * ld_dst + ks) = o0;
  *(u32x4*)(dst + (size_t)n * ld_dst + ks + 8) = o1;
  __syncthreads();
}

constexpr int WCONV_TILES = 1568 + 128 + 128 + 256 + 64 + 256 + 8 + 8;
DI void wconv_tile(const Params& p, int l, int t, float* sm) {
  const float* src; bf16_t* dst; int K, N;
  if (t < 1568) { src = p.w_in + (size_t)l * 1024 * NZ; dst = p.wt_in; K = 1024; N = NZ; }
  else if ((t -= 1568) < 128) { src = p.w_br_r + (size_t)l * 512 * 1024; dst = p.wt_brr; K = 512; N = 1024; }
  else if ((t -= 128) < 128) { src = p.w_br_a + (size_t)l * 512 * 1024; dst = p.wt_bra; K = 512; N = 1024; }
  else if ((t -= 128) < 256) { src = p.w_out + (size_t)l * 1024 * 1024; dst = p.wt_out; K = 1024; N = 1024; }
  else if ((t -= 256) < 64) { src = p.ple_w + (size_t)l * 256 * 1024; dst = p.wt_ple; K = 256; N = 1024; }
  else if ((t -= 64) < 256) { src = p.ple_gate_w + (size_t)l * 1024 * 1024; dst = p.wt_gate; K = 1024; N = 1024; }
  else if ((t -= 256) < 8) { src = p.decay_w2 + (size_t)l * 64 * 512; dst = p.w2t; K = 64; N = 512; }
  else { t -= 8; src = p.iclr_a2 + (size_t)l * 64 * 512; dst = p.a2t; K = 64; N = 512; }
  const int ntn = N / 64; const int tk = t / ntn, tn = t % ntn;
  tr_tile(src + (size_t)(tk * 64) * N + tn * 64, N, dst + (size_t)(tn * 64) * K + tk * 64, K, sm);
}

DI const float* x_row(const Params& p, int l, int r) {
  if (l == 0) return r < MP ? p.xp + (size_t)r * DM : p.xs + (size_t)(r - MP) * DM;
  return p.out + (size_t)r * DM;
}
DI void phase_norm(const Params& p, int l, bool first, char* lds) {
  const int tid = tid_(), wave = tid >> 6, lane = tid & 63;
  const float* g = (first ? p.norm_g : p.ple_norm_g) + l * DM;
  const int n_norm = MT / 4;
  const int n_items = n_norm + (first ? 2048 + WCONV_TILES : 0);
  for (int it = blockIdx.x; it < n_items; it += gridDim.x) {
    if (it < n_norm) {
      const int r = it * 4 + wave;
      const float* x = first ? x_row(p, l, r) : p.out + (size_t)r * DM;
      f32x4 v[4]; float ss = 0.f;
#pragma unroll
      for (int i = 0; i < 4; ++i) { v[i] = *(const f32x4*)(x + lane * 4 + 256 * i); ss += v[i][0] * v[i][0] + v[i][1] * v[i][1] + v[i][2] * v[i][2] + v[i][3] * v[i][3]; }
#pragma unroll
      for (int o = 32; o >= 1; o >>= 1) ss += __shfl_xor(ss, o);
      const float rstd = rsqrtf(ss * (1.0f / 1024.0f) + 1e-6f);
#pragma unroll
      for (int i = 0; i < 4; ++i) {
        const f32x4 gv = *(const f32x4*)(g + lane * 4 + 256 * i);
        u32x2 o; o[0] = pk2(v[i][0] * rstd * gv[0], v[i][1] * rstd * gv[1]); o[1] = pk2(v[i][2] * rstd * gv[2], v[i][3] * rstd * gv[3]);
        *(u32x2*)(p.hn + (size_t)r * DM + lane * 4 + 256 * i) = o;
      }
    } else if (it < n_norm + 1024) {
      const int c = it - n_norm;
      const float* src = p.ck + (size_t)l * 8 * 1024 * 512 + (size_t)c * 4096 + tid * 16;
      bf16_t* dst = p.kc + (size_t)c * 4096 + tid * 16;
      f32x4 a0 = *(const f32x4*)(src), a1 = *(const f32x4*)(src + 4), a2 = *(const f32x4*)(src + 8), a3 = *(const f32x4*)(src + 12);
      u32x4 o0, o1;
      o0[0] = pk2(a0[0], a0[1]); o0[1] = pk2(a0[2], a0[3]); o0[2] = pk2(a1[0], a1[1]); o0[3] = pk2(a1[2], a1[3]);
      o1[0] = pk2(a2[0], a2[1]); o1[1] = pk2(a2[2], a2[3]); o1[2] = pk2(a3[0], a3[1]); o1[3] = pk2(a3[2], a3[3]);
      *(u32x4*)dst = o0; *(u32x4*)(dst + 8) = o1;
    } else if (it >= n_norm + 2048) {
      wconv_tile(p, l, it - n_norm - 2048, (float*)lds);
    } else {
      const int c = it - n_norm - 1024;
      const int bh = c >> 5, tt = c & 31; const int b = bh >> 2, h = bh & 3; const int tk = tt >> 1, tn = tt & 1;
      const float* src = p.cv + (size_t)l * 8 * 1024 * 512 + ((size_t)(b * 1024 + tk * 64)) * 512 + h * 128 + tn * 64;
      bf16_t* dst = p.vct + ((size_t)(bh * 128 + tn * 64)) * 1024 + tk * 64;
      tr_tile(src, 512, dst, 1024, (float*)lds);
    }
  }
}

constexpr int GLD = 72;
template <bool A_F32>
DI void gemm_core(f32x4 (&acc)[4][4], const void* Ap, int lda, const bf16_t* Bp, int ldb, int K, char* lds) {
  bf16_t* As = (bf16_t*)lds;
  bf16_t* Bs = (bf16_t*)(lds + 2 * 128 * GLD * 2);
  const int tid = tid_(), wave = tid >> 6, lane = tid & 63;
  const int wm = wave >> 1, wn = wave & 1, l15 = lane & 15, quad = lane >> 4;
  const int nk = K / 64;
  u32x4 ra[4], rb[4];
  auto gload = [&](int kt) {
#pragma unroll
    for (int i = 0; i < 4; ++i) {
      const int c = tid + 256 * i; const int row = c >> 3, c8 = (c & 7) * 8;
      if (!A_F32) ra[i] = *(const u32x4*)((const bf16_t*)Ap + (size_t)row * lda + kt * 64 + c8);
      rb[i] = *(const u32x4*)(Bp + (size_t)row * ldb + kt * 64 + c8);
    }
  };
  auto sstore = [&](int buf, int kt) {
#pragma unroll
    for (int i = 0; i < 4; ++i) {
      const int c = tid + 256 * i; const int row = c >> 3, c8 = (c & 7) * 8;
      if (A_F32) {
        const float* a = (const float*)Ap + (size_t)row * lda + kt * 64 + c8;
        const f32x4 v0 = *(const f32x4*)a, v1 = *(const f32x4*)(a + 4);
        u32x4 t; t[0] = pk2(v0[0], v0[1]); t[1] = pk2(v0[2], v0[3]); t[2] = pk2(v1[0], v1[1]); t[3] = pk2(v1[2], v1[3]);
        *(u32x4*)(As + (buf * 128 + row) * GLD + c8) = t;
      } else {
        *(u32x4*)(As + (buf * 128 + row) * GLD + c8) = ra[i];
      }
      *(u32x4*)(Bs + (buf * 128 + row) * GLD + c8) = rb[i];
    }
  };
  gload(0); sstore(0, 0); __syncthreads();
  for (int kt = 0; kt < nk; ++kt) {
    const int buf = kt & 1;
    if (kt + 1 < nk) gload(kt + 1);
#pragma unroll
    for (int ks = 0; ks < 2; ++ks) {
      bf16x8 af[4], bfr[4];
#pragma unroll
      for (int i = 0; i < 4; ++i) {
        af[i] = *(const bf16x8*)(As + (buf * 128 + wm * 64 + i * 16 + l15) * GLD + ks * 32 + quad * 8);
        bfr[i] = *(const bf16x8*)(Bs + (buf * 128 + wn * 64 + i * 16 + l15) * GLD + ks * 32 + quad * 8);
      }
#pragma unroll
      for (int mi = 0; mi < 4; ++mi)
#pragma unroll
        for (int ni = 0; ni < 4; ++ni) acc[mi][ni] = __builtin_amdgcn_mfma_f32_16x16x32_bf16(bfr[ni], af[mi], acc[mi][ni], 0, 0, 0);
    }
    if (kt + 1 < nk) sstore(buf ^ 1, kt + 1);
    __syncthreads();
  }
}
#define LASP __attribute__((address_space(3)))
DI void gemm_dma(f32x4 (&acc)[4][4], const bf16_t* Ap, int lda, const bf16_t* Bp, int ldb, int K, char* lds) {
  const int tid = tid_(), wave = __builtin_amdgcn_readfirstlane(tid >> 6), lane = tid & 63;
  const int wm = wave >> 1, wn = wave & 1, l15 = lane & 15, quad = lane >> 4;
  const int nk = K / 32;
  const int lrow = lane >> 2, lpc = lane & 3;
  const bf16_t* ga[2]; const bf16_t* gb[2];
#pragma unroll
  for (int i = 0; i < 2; ++i) {
    const int row = (wave * 2 + i) * 16 + lrow; const int q = lpc ^ ((row >> 2) & 3);
    ga[i] = Ap + (size_t)row * lda + q * 8; gb[i] = Bp + (size_t)row * ldb + q * 8;
  }
  auto issue = [&](int kt) {
    char* sb = lds + (kt & 3) * 16384 + wave * 2048;
#pragma unroll
    for (int i = 0; i < 2; ++i) {
      __builtin_amdgcn_global_load_lds((const unsigned*)(ga[i] + kt * 32), (LASP unsigned*)(sb + i * 1024), 16, 0, 0);
      __builtin_amdgcn_global_load_lds((const unsigned*)(gb[i] + kt * 32), (LASP unsigned*)(sb + 8192 + i * 1024), 16, 0, 0);
    }
  };
  const int aoff = (wm * 64 + l15) * 64 + ((quad ^ ((l15 >> 2) & 3)) * 16);
  const int boff = 8192 + (wn * 64 + l15) * 64 + ((quad ^ ((l15 >> 2) & 3)) * 16);
  const unsigned lbase = (unsigned)(size_t)(LASP char*)lds;
  asm volatile("s_waitcnt vmcnt(0)" ::: "memory");
  __builtin_amdgcn_s_barrier();
  asm volatile("" ::: "memory");
  issue(0); issue(1); issue(2);
  for (int kt = 0; kt < nk; ++kt) {
    const int rem = nk - 1 - kt;
    if (rem >= 2) asm volatile("s_waitcnt vmcnt(8)" ::: "memory");
    else if (rem == 1) asm volatile("s_waitcnt vmcnt(4)" ::: "memory");
    else asm volatile("s_waitcnt vmcnt(0)" ::: "memory");
    __builtin_amdgcn_s_barrier();
    asm volatile("" ::: "memory");
    if (kt + 3 < nk) issue(kt + 3);
    const unsigned sa = lbase + (unsigned)((kt & 3) * 16384);
    bf16x8 af[4], bfr[4];
    asm volatile("ds_read_b128 %0, %8\n\tds_read_b128 %1, %8 offset:1024\n\tds_read_b128 %2, %8 offset:2048\n\tds_read_b128 %3, %8 offset:3072\n\t"
                 "ds_read_b128 %4, %9\n\tds_read_b128 %5, %9 offset:1024\n\tds_read_b128 %6, %9 offset:2048\n\tds_read_b128 %7, %9 offset:3072\n\t"
                 "s_waitcnt lgkmcnt(0)"
                 : "=&v"(af[0]), "=&v"(af[1]), "=&v"(af[2]), "=&v"(af[3]), "=&v"(bfr[0]), "=&v"(bfr[1]), "=&v"(bfr[2]), "=&v"(bfr[3])
                 : "v"(sa + (unsigned)aoff), "v"(sa + (unsigned)boff) : "memory");
#pragma unroll
    for (int mi = 0; mi < 4; ++mi)
#pragma unroll
      for (int ni = 0; ni < 4; ++ni) acc[mi][ni] = __builtin_amdgcn_mfma_f32_16x16x32_bf16(bfr[ni], af[mi], acc[mi][ni], 0, 0, 0);
  }
  asm volatile("" ::: "memory");
  __builtin_amdgcn_s_barrier();
  asm volatile("" ::: "memory");
}
DI void zero_acc(f32x4 (&acc)[4][4]) {
#pragma unroll
  for (int i = 0; i < 4; ++i)
#pragma unroll
    for (int j = 0; j < 4; ++j) acc[i][j] = (f32x4){0.f, 0.f, 0.f, 0.f};
}

DI int xcd_tile(int r, int T) {
  const int x = blockIdx.x & 7, j = blockIdx.x >> 3, nb = gridDim.x >> 3;
  if (j >= nb) return -1;
  const int start = (int)(((long)x * T) / 8), end = (int)(((long)(x + 1) * T) / 8);
  const int g = start + r * nb + j;
  return g < end ? g : -1;
}
DI void tile_decode(int g, int nM, int nN, int& mt, int& nt) {
  const int per = 8 * nN; const int grp = g / per, idx = g - grp * per; const int gm0 = grp * 8;
  const int gsz = (nM - gm0) < 8 ? (nM - gm0) : 8;
  nt = idx / gsz; mt = gm0 + (idx - nt * gsz);
}
DI void phase_gemm_in(const Params& p, int l, char* lds) {
  const int tid = tid_(), wave = tid >> 6, lane = tid & 63;
  const int wm = wave >> 1, wn = wave & 1, l15 = lane & 15, quad = lane >> 4;
  const bf16_t* Wt = p.wt_in;
  const int NTN = 49, NTM = 132;
  for (int r = 0;; ++r) {
    const int g = xcd_tile(r, NTN * NTM); if (g < 0) break;
    int mt, nt; tile_decode(g, NTM, NTN, mt, nt);
    f32x4 acc[4][4]; zero_acc(acc);
    gemm_dma(acc, p.hn + (size_t)mt * 128 * DM, DM, Wt + (size_t)nt * 128 * DM, DM, DM, lds);
    const int colb = nt * 128 + wn * 64 + quad * 4;
    int kind;
    if (nt < 13) kind = 0; else if (nt < 17) kind = 1; else if (nt < 21) kind = 2; else if (nt < 25) kind = 3; else if (nt < 29) kind = 4; else if (nt < 33) kind = 1; else kind = 5;
#pragma unroll
    for (int mi = 0; mi < 4; ++mi) {
      const int R = mt * 128 + wm * 64 + mi * 16 + l15;
      const bool isp = R < MP; const int rs = R - MP;
      bf16_t* zrow = p.z + (size_t)R * NZ;
      if (kind == 0) {
        const bool last = isp ? ((R & 4095) == 4095) : ((rs & 63) == 63);
        float* so = isp ? p.out + O_SP + (size_t)(l * 4 + (R >> 12)) * SHC : p.out + O_SS + (size_t)(l * 8 + (rs >> 6)) * SHC;
#pragma unroll
        for (int ni = 0; ni < 4; ++ni) {
          const int c = colb + ni * 16; const f32x4 v = acc[mi][ni];
          u32x2 o; o[0] = pk2(v[0], v[1]); o[1] = pk2(v[2], v[3]); *(u32x2*)(zrow + c) = o;
          if (last) *(f32x4*)(so + c) = v;
        }
      } else if (kind == 1 || kind == 5) {
#pragma unroll
        for (int ni = 0; ni < 4; ++ni) {
          const int c = colb + ni * 16; f32x4 v = acc[mi][ni];
#pragma unroll
          for (int e = 0; e < 4; ++e) v[e] = (kind == 1) ? siluf_(v[e]) : sigmoidf_(v[e]);
          u32x2 o; o[0] = pk2(v[0], v[1]); o[1] = pk2(v[2], v[3]); *(u32x2*)(zrow + c) = o;
        }
      } else if (kind == 2 || kind == 3) {
        float ss = 0.f;
#pragma unroll
        for (int ni = 0; ni < 4; ++ni) { const f32x4 v = acc[mi][ni]; ss += v[0] * v[0] + v[1] * v[1] + v[2] * v[2] + v[3] * v[3]; }
        ss += __shfl_xor(ss, 16); ss += __shfl_xor(ss, 32);
        const float rstd = rsqrtf(ss * (1.0f / 64.0f) + 1e-6f);
        const float* g = (kind == 2 ? p.qng : p.kng) + l * 64;
        float* ko = isp ? p.out + O_KP + ((size_t)l * MP + R) * 512 : p.out + O_KS + ((size_t)l * MS + rs) * 512;
#pragma unroll
        for (int ni = 0; ni < 4; ++ni) {
          const int c = colb + ni * 16; const int d = ni * 16 + quad * 4;
          const f32x4 gv = *(const f32x4*)(g + d); f32x4 v = acc[mi][ni];
#pragma unroll
          for (int e = 0; e < 4; ++e) v[e] = v[e] * rstd * gv[e];
          u32x2 o; o[0] = pk2(v[0], v[1]); o[1] = pk2(v[2], v[3]); *(u32x2*)(zrow + c) = o;
          if (kind == 3) *(f32x4*)(ko + (c - C_K)) = v;
        }
      } else {
        float* vo = isp ? p.out + O_VP + ((size_t)l * MP + R) * 512 : p.out + O_VS + ((size_t)l * MS + rs) * 512;
#pragma unroll
        for (int ni = 0; ni < 4; ++ni) {
          const int cv = colb + ni * 16 - C_V; const f32x4 v = acc[mi][ni];
          *(f32x4*)(vo + cv) = v;
          const int h = cv >> 7, vd = cv & 127;
          if (isp) {
            bf16_t* vt = p.vtp + ((size_t)(((R >> 12) * 4 + h) * 128 + vd)) * 4096 + (R & 4095);
#pragma unroll
            for (int e = 0; e < 4; ++e) vt[(size_t)e * 4096] = (bf16_t)(pk2(v[e], 0.f) & 0xffff);
          } else {
            bf16_t* vt = p.vts + ((size_t)(((rs >> 6) * 4 + h) * 128 + vd)) * 64 + (rs & 63);
#pragma unroll
            for (int e = 0; e < 4; ++e) vt[(size_t)e * 64] = (bf16_t)(pk2(v[e], 0.f) & 0xffff);
          }
        }
      }
    }
  }
}

constexpr int NCH_P = 4096, NCH = 4224;
constexpr int XLD = 40;
DI f32x4 mm16(const bf16_t* Xrow, int ldx, const bf16_t* Yrow, int ldy, int ksteps, f32x4 acc, int l15, int quad) {
  for (int ks = 0; ks < ksteps; ++ks) {
    const bf16x8 a = *(const bf16x8*)(Xrow + l15 * ldx + ks * 32 + quad * 8);
    const bf16x8 b = *(const bf16x8*)(Yrow + l15 * ldy + ks * 32 + quad * 8);
    acc = __builtin_amdgcn_mfma_f32_16x16x32_bf16(a, b, acc, 0, 0, 0);
  }
  return acc;
}
DI void chunk_item(const Params& p, int l, int item, char* lds) {
  const int tid = tid_(), wave = tid >> 6, lane = tid & 63, l15 = lane & 15, quad = lane >> 4;
  const bool isp = item < NCH_P;
  int bh, c;
  if (isp) { bh = item >> 7; c = item & 127; } else { const int j = item - NCH_P; bh = j >> 1; c = j & 1; }
  const int b = bh >> 3, h = bh & 7;
  const int t0 = c * 32; const int row0 = (isp ? b * 4096 : MP + b * 64) + t0;
  float* s_r = (float*)lds;
  float* s_kf = s_r + 2048;
  float* s_v = s_kf + 2048;
  float* s_w = s_v + 2048;
  float* s_kk = s_w + 2048;
  float* s_bb = s_kk + 2048;
  bf16_t* s_wd = (bf16_t*)(lds + 49152);
  bf16_t* s_ad = (bf16_t*)(lds + 53760);
  float* s_bonus = (float*)(lds + 58368);
  float* s_wl = (float*)(lds + 58496);
  float* s_rhs = (float*)lds;
  bf16_t* s_A = (bf16_t*)lds;
  bf16_t* s_Bm = (bf16_t*)(lds + 4608);
  bf16_t* s_Kp = (bf16_t*)(lds + 9216);
  bf16_t* s_R = (bf16_t*)(lds + 16384);
  bf16_t* s_BmT = (bf16_t*)(lds + 20992);
  bf16_t* s_KpT = (bf16_t*)(lds + 26112);
  bf16_t* s_VmT = (bf16_t*)(lds + 31232);
  bf16_t* s_Lak = (bf16_t*)(lds + 36352);
  bf16_t* s_Mrk = (bf16_t*)(lds + 38912);
  bf16_t* s_Mrb = (bf16_t*)(lds + 41472);
  float* s_lab = (float*)(lds + 44032);
  bf16_t* s_XT = (bf16_t*)(lds + 48256);

  const int mat = wave >> 1, tt = wave & 1;
  const bf16_t* wl = (mat == 0 ? p.w2t : p.a2t) + (size_t)(h * 64) * 64;
  const float* mu = p.shift_mu + l * SHC;
  const float* w0 = p.decay_w0 + l * 512 + h * 64;
  const float* a0 = p.iclr_a0 + l * 512 + h * 64;
  const float* kkp = p.k_k + l * 512 + h * 64;
  const float* kap = p.k_a + l * 512 + h * 64;
  const float* rkp = p.r_k + l * 512 + h * 64;
  const float* lb = p.lnx_b + l * 512 + h * 64;
  const int ptok = tid >> 3, pcs = (tid & 7) * 8;
  {
    const int t = t0 + ptok; const size_t row = (size_t)(row0 + ptok);
#pragma unroll
    for (int g = 0; g < 5; ++g) {
      const int zc = (g < 3 ? g * 512 + h * 64 : 1536 + (g - 3) * 64) + pcs;
      const u32x4 cu = *(const u32x4*)(p.z + row * NZ + zc);
      float cur[8], prv[8];
#pragma unroll
      for (int e = 0; e < 4; ++e) { cur[2 * e] = bf_lo(cu[e]); cur[2 * e + 1] = bf_hi(cu[e]); }
      if (t > 0) {
        const u32x4 pu = *(const u32x4*)(p.z + (row - 1) * NZ + zc);
#pragma unroll
        for (int e = 0; e < 4; ++e) { prv[2 * e] = bf_lo(pu[e]); prv[2 * e + 1] = bf_hi(pu[e]); }
      } else if (isp) {
#pragma unroll
        for (int e = 0; e < 8; ++e) prv[e] = 0.f;
      } else {
        const float* sp = p.sshift + (size_t)(l * 8 + b) * SHC + zc;
#pragma unroll
        for (int e = 0; e < 8; ++e) prv[e] = sp[e];
      }
      float zs[8];
#pragma unroll
      for (int e = 0; e < 8; ++e) zs[e] = cur[e] + (prv[e] - cur[e]) * mu[zc + e];
      if (g < 3) {
        float* d = (g == 0 ? s_r : g == 1 ? s_kf : s_v) + ptok * 64 + pcs;
        *(f32x4*)d = (f32x4){zs[0], zs[1], zs[2], zs[3]}; *(f32x4*)(d + 4) = (f32x4){zs[4], zs[5], zs[6], zs[7]};
      } else {
        if (g == 3) {
#pragma unroll
          for (int e = 0; e < 8; ++e) { const float ex = __expf(2.f * zs[e]); zs[e] = 1.f - 2.f / (ex + 1.f); }
        }
        u32x4 o; o[0] = pk2(zs[0], zs[1]); o[1] = pk2(zs[2], zs[3]); o[2] = pk2(zs[4], zs[5]); o[3] = pk2(zs[6], zs[7]);
        *(u32x4*)((g == 3 ? s_wd : s_ad) + ptok * 72 + pcs) = o;
      }
    }
  }
  __syncthreads();
  {
    const bf16_t* At = (mat == 0 ? s_wd : s_ad);
    bf16x8 af[2];
#pragma unroll
    for (int ks = 0; ks < 2; ++ks) af[ks] = *(const bf16x8*)(At + (tt * 16 + l15) * 72 + ks * 32 + quad * 8);
#pragma unroll
    for (int ct = 0; ct < 4; ++ct) {
      f32x4 d = (f32x4){0.f, 0.f, 0.f, 0.f};
#pragma unroll
      for (int ks = 0; ks < 2; ++ks) {
        const bf16x8 wfr = *(const bf16x8*)(wl + (size_t)(ct * 16 + l15) * 64 + ks * 32 + quad * 8);
        d = __builtin_amdgcn_mfma_f32_16x16x32_bf16(wfr, af[ks], d, 0, 0, 0);
      }
      const int ch = ct * 16 + quad * 4; const int tok = tt * 16 + l15;
      f32x4 o;
      if (mat == 0) {
#pragma unroll
        for (int e = 0; e < 4; ++e) {
          const float y = -(w0[ch + e] + d[e]);
          const float sp = fmaxf(y, 0.f) + log1pf(__expf(-fabsf(y)));
          o[e] = -__expf(-sp - 0.5f);
        }
        *(f32x4*)(s_w + tok * 64 + ch) = o;
      } else {
#pragma unroll
        for (int e = 0; e < 4; ++e) o[e] = sigmoidf_(a0[ch + e] + d[e]);
        *(f32x4*)(s_bb + tok * 64 + ch) = o;
      }
    }
  }
  __syncthreads();
  float r_[8], kf[8], kk[8], bbv[8], v_[8], bon;
  {
    float k_[8], a_[8];
    *(f32x4*)&k_[0] = *(const f32x4*)(s_kf + ptok * 64 + pcs); *(f32x4*)&k_[4] = *(const f32x4*)(s_kf + ptok * 64 + pcs + 4);
    *(f32x4*)&a_[0] = *(const f32x4*)(s_bb + ptok * 64 + pcs); *(f32x4*)&a_[4] = *(const f32x4*)(s_bb + ptok * 64 + pcs + 4);
    *(f32x4*)&r_[0] = *(const f32x4*)(s_r + ptok * 64 + pcs); *(f32x4*)&r_[4] = *(const f32x4*)(s_r + ptok * 64 + pcs + 4);
    *(f32x4*)&v_[0] = *(const f32x4*)(s_v + ptok * 64 + pcs); *(f32x4*)&v_[4] = *(const f32x4*)(s_v + ptok * 64 + pcs + 4);
    float ss = 0.f; bon = 0.f;
#pragma unroll
    for (int e = 0; e < 8; ++e) {
      kk[e] = k_[e] * kkp[pcs + e]; ss += kk[e] * kk[e];
      kf[e] = k_[e] * (1.f + (a_[e] - 1.f) * kap[pcs + e]);
      bon += r_[e] * kf[e] * rkp[pcs + e];
    }
    ss += __shfl_xor(ss, 1); ss += __shfl_xor(ss, 2); ss += __shfl_xor(ss, 4);
    bon += __shfl_xor(bon, 1); bon += __shfl_xor(bon, 2); bon += __shfl_xor(bon, 4);
    const float inv = 1.0f / fmaxf(sqrtf(ss), 1e-12f);
#pragma unroll
    for (int e = 0; e < 8; ++e) { kk[e] *= inv; bbv[e] = kk[e] * a_[e]; }
  }
  if (tid < 64) {
    float run = 0.f;
#pragma unroll 8
    for (int t = 0; t < 32; ++t) { run += s_w[t * 64 + tid]; s_w[t * 64 + tid] = run; }
  }
  __syncthreads();
  {
    float cw[8], cwp[8];
    *(f32x4*)&cw[0] = *(const f32x4*)(s_w + ptok * 64 + pcs); *(f32x4*)&cw[4] = *(const f32x4*)(s_w + ptok * 64 + pcs + 4);
    if (ptok > 0) { *(f32x4*)&cwp[0] = *(const f32x4*)(s_w + (ptok - 1) * 64 + pcs); *(f32x4*)&cwp[4] = *(const f32x4*)(s_w + (ptok - 1) * 64 + pcs + 4); }
    else {
#pragma unroll
      for (int e = 0; e < 8; ++e) cwp[e] = 0.f;
    }
    __syncthreads();
    float av[8], bm[8], kp[8], rr[8];
#pragma unroll
    for (int e = 0; e < 8; ++e) {
      const float ec = __expf(cw[e]), en = __expf(-cw[e]), ep = __expf(cwp[e]);
      av[e] = kk[e] * ep; bm[e] = bbv[e] * en; kp[e] = kf[e] * en; rr[e] = r_[e] * ec;
      if (ptok == 31) s_wl[pcs + e] = ec;
    }
    u32x4 o;
    o[0] = pk2(av[0], av[1]); o[1] = pk2(av[2], av[3]); o[2] = pk2(av[4], av[5]); o[3] = pk2(av[6], av[7]); *(u32x4*)(s_A + ptok * 72 + pcs) = o;
    o[0] = pk2(bm[0], bm[1]); o[1] = pk2(bm[2], bm[3]); o[2] = pk2(bm[4], bm[5]); o[3] = pk2(bm[6], bm[7]); *(u32x4*)(s_Bm + ptok * 72 + pcs) = o;
#pragma unroll
    for (int e = 0; e < 4; ++e) { s_BmT[(pcs + 2 * e) * XLD + ptok] = (bf16_t)(o[e] & 0xffff); s_BmT[(pcs + 2 * e + 1) * XLD + ptok] = (bf16_t)(o[e] >> 16); }
    o[0] = pk2(kp[0], kp[1]); o[1] = pk2(kp[2], kp[3]); o[2] = pk2(kp[4], kp[5]); o[3] = pk2(kp[6], kp[7]); *(u32x4*)(s_Kp + ptok * 72 + pcs) = o;
#pragma unroll
    for (int e = 0; e < 4; ++e) { s_KpT[(pcs + 2 * e) * XLD + ptok] = (bf16_t)(o[e] & 0xffff); s_KpT[(pcs + 2 * e + 1) * XLD + ptok] = (bf16_t)(o[e] >> 16); }
    o[0] = pk2(rr[0], rr[1]); o[1] = pk2(rr[2], rr[3]); o[2] = pk2(rr[4], rr[5]); o[3] = pk2(rr[6], rr[7]); *(u32x4*)(s_R + ptok * 72 + pcs) = o;
    o[0] = pk2(v_[0], v_[1]); o[1] = pk2(v_[2], v_[3]); o[2] = pk2(v_[4], v_[5]); o[3] = pk2(v_[6], v_[7]);
#pragma unroll
    for (int e = 0; e < 4; ++e) { s_VmT[(pcs + 2 * e) * XLD + ptok] = (bf16_t)(o[e] & 0xffff); s_VmT[(pcs + 2 * e + 1) * XLD + ptok] = (bf16_t)(o[e] >> 16); }
    u32x4 ob;
    ob[0] = pk2(lb[pcs + 0] + bon * v_[0], lb[pcs + 1] + bon * v_[1]); ob[1] = pk2(lb[pcs + 2] + bon * v_[2], lb[pcs + 3] + bon * v_[3]);
    ob[2] = pk2(lb[pcs + 4] + bon * v_[4], lb[pcs + 5] + bon * v_[5]); ob[3] = pk2(lb[pcs + 6] + bon * v_[6], lb[pcs + 7] + bon * v_[7]);
    *(u32x4*)(p.cBA + ((size_t)item * 32 + ptok) * 64 + pcs) = ob;
  }
  __syncthreads();
  {
    const bf16_t* X = (wave < 2) ? s_A : s_R;
    const bf16_t* Y = (wave == 0 || wave == 3) ? s_Bm : s_Kp;
    const bool strict = wave < 2;
#pragma unroll
    for (int ti = 0; ti < 2; ++ti)
#pragma unroll
      for (int ii = 0; ii < 2; ++ii) {
        f32x4 d = (f32x4){0.f, 0.f, 0.f, 0.f};
        if (ii <= ti) d = mm16(X + ti * 16 * 72, 72, Y + ii * 16 * 72, 72, 2, d, l15, quad);
        const int i = ii * 16 + l15;
#pragma unroll
        for (int e = 0; e < 4; ++e) {
          const int t = ti * 16 + quad * 4 + e;
          const bool keep = strict ? (i < t) : (i <= t);
          const float val = keep ? d[e] : 0.f;
          if (wave == 0) s_lab[t * 33 + i] = val;
          else { bf16_t* dst = (wave == 1 ? s_Lak : wave == 2 ? s_Mrk : s_Mrb); dst[t * XLD + i] = (bf16_t)(pk2(val, 0.f) & 0xffff); }
        }
      }
  }
  const u32x4 acap = *(const u32x4*)(s_A + ptok * 72 + pcs);
  __syncthreads();
  {
    float* d = s_rhs + ptok * 128 + pcs;
    *(f32x4*)d = (f32x4){bf_lo(acap[0]), bf_hi(acap[0]), bf_lo(acap[1]), bf_hi(acap[1])};
    *(f32x4*)(d + 4) = (f32x4){bf_lo(acap[2]), bf_hi(acap[2]), bf_lo(acap[3]), bf_hi(acap[3])};
  }
  {
    const int ti = wave & 1;
#pragma unroll
    for (int vv = 0; vv < 2; ++vv) {
      const int vi = (wave >> 1) * 2 + vv;
      f32x4 d = (f32x4){0.f, 0.f, 0.f, 0.f};
      d = mm16(s_Lak + ti * 16 * XLD, XLD, s_VmT + vi * 16 * XLD, XLD, 1, d, l15, quad);
#pragma unroll
      for (int e = 0; e < 4; ++e) s_rhs[(ti * 16 + quad * 4 + e) * 128 + 64 + vi * 16 + l15] = d[e];
    }
  }
  __syncthreads();
  if (tid < 128) {
    float x[32];
#pragma unroll
    for (int t = 0; t < 32; ++t) {
      float a = s_rhs[t * 128 + tid];
#pragma unroll
      for (int i = 0; i < t; ++i) a -= s_lab[t * 33 + i] * x[i];
      x[t] = a;
    }
#pragma unroll
    for (int q4 = 0; q4 < 4; ++q4) {
      u32x4 o; o[0] = pk2(x[8 * q4], x[8 * q4 + 1]); o[1] = pk2(x[8 * q4 + 2], x[8 * q4 + 3]); o[2] = pk2(x[8 * q4 + 4], x[8 * q4 + 5]); o[3] = pk2(x[8 * q4 + 6], x[8 * q4 + 7]);
      *(u32x4*)(s_XT + tid * XLD + q4 * 8) = o;
    }
  }
  __syncthreads();
  {
    const f32x4 z4 = (f32x4){0.f, 0.f, 0.f, 0.f};
    bf16_t* gPT = p.cPT + (size_t)item * 4096;
    const float wl_c = s_wl[wave * 16 + l15];
#pragma unroll
    for (int k1t = 0; k1t < 4; ++k1t) {
      f32x4 d = mm16(s_XT + k1t * 16 * XLD, XLD, s_BmT + wave * 16 * XLD, XLD, 1, z4, l15, quad);
      const int k2 = wave * 16 + l15, k1 = k1t * 16 + quad * 4;
      float o[4];
#pragma unroll
      for (int e = 0; e < 4; ++e) o[e] = ((k1 + e == k2 ? 1.f : 0.f) - d[e]) * wl_c;
      u32x2 ov; ov[0] = pk2(o[0], o[1]); ov[1] = pk2(o[2], o[3]);
      *(u32x2*)(gPT + k2 * 64 + k1) = ov;
    }
    bf16_t* gG = p.cG + (size_t)item * 4096;
#pragma unroll
    for (int k2t = 0; k2t < 4; ++k2t) {
      const f32x4 d1 = mm16(s_KpT + k2t * 16 * XLD, XLD, s_VmT + wave * 16 * XLD, XLD, 1, z4, l15, quad);
      const f32x4 d2 = mm16(s_BmT + k2t * 16 * XLD, XLD, s_XT + (64 + wave * 16) * XLD, XLD, 1, z4, l15, quad);
      const int k2 = k2t * 16 + quad * 4, v = wave * 16 + l15;
      const f32x4 wv = *(const f32x4*)(s_wl + k2);
      u32x2 ov; ov[0] = pk2((d1[0] - d2[0]) * wv[0], (d1[1] - d2[1]) * wv[1]); ov[1] = pk2((d1[2] - d2[2]) * wv[2], (d1[3] - d2[3]) * wv[3]);
      *(u32x2*)(gG + v * 64 + k2) = ov;
    }
    bf16_t* gRT = p.cRT + (size_t)item * 2048;
    bf16_t* gOI = p.cOI + (size_t)item * 2048;
#pragma unroll
    for (int ti = 0; ti < 2; ++ti) {
      const f32x4 d = mm16(s_XT + wave * 16 * XLD, XLD, s_Mrb + ti * 16 * XLD, XLD, 1, z4, l15, quad);
      const int t = ti * 16 + l15, k = wave * 16 + quad * 4;
      const u32x2 rv = *(const u32x2*)(s_R + t * 72 + k);
      u32x2 ov; ov[0] = pk2(bf_lo(rv[0]) - d[0], bf_hi(rv[0]) - d[1]); ov[1] = pk2(bf_lo(rv[1]) - d[2], bf_hi(rv[1]) - d[3]);
      *(u32x2*)(gRT + t * 64 + k) = ov;
      const f32x4 e1 = mm16(s_VmT + wave * 16 * XLD, XLD, s_Mrk + ti * 16 * XLD, XLD, 1, z4, l15, quad);
      const f32x4 e2 = mm16(s_XT + (64 + wave * 16) * XLD, XLD, s_Mrb + ti * 16 * XLD, XLD, 1, z4, l15, quad);
      u32x2 oo; oo[0] = pk2(e1[0] - e2[0], e1[1] - e2[1]); oo[1] = pk2(e1[2] - e2[2], e1[3] - e2[3]);
      *(u32x2*)(gOI + t * 64 + k) = oo;
    }
  }
  __syncthreads();
}

DI void rec_item(const Params& p, int l, int item, char* lds) {
  const int tid = tid_(), wave = tid >> 6, lane = tid & 63, l15 = lane & 15, quad = lane >> 4;
  const bool isp = item < 32;
  const int bh = isp ? item : item - 32; const int b = bh >> 3, h = bh & 7;
  const int nch = isp ? 128 : 2; const int cid0 = isp ? bh * 128 : NCH_P + bh * 2;
  const int row0 = isp ? b * 4096 : MP + b * 64;
  bf16_t* Sb = (bf16_t*)lds;
  {
    const int v = wave * 16 + l15;
    f32x4 a0[4];
    if (isp) {
#pragma unroll
      for (int nk = 0; nk < 4; ++nk) a0[nk] = (f32x4){0.f, 0.f, 0.f, 0.f};
    } else {
      const float* sp = p.swkv + (((size_t)(l * 8 + b) * 8 + h) * 64 + v) * 64;
#pragma unroll
      for (int nk = 0; nk < 4; ++nk) a0[nk] = *(const f32x4*)(sp + nk * 16 + quad * 4);
    }
#pragma unroll
    for (int nk = 0; nk < 4; ++nk) { u32x2 o; o[0] = pk2(a0[nk][0], a0[nk][1]); o[1] = pk2(a0[nk][2], a0[nk][3]); *(u32x2*)(Sb + v * 72 + nk * 16 + quad * 4) = o; }
  }
  __syncthreads();
  const int nmain = nch - 2;
  if (wave < 2) {
    struct PS { bf16x8 pt[4][2]; u32x2 gv[2][4]; };
    auto ldp = [&](PS& s, int c) {
      const int cc = c < nch ? c : nch - 1;
      const size_t cid = (size_t)(cid0 + cc);
      const bf16_t* gPT = p.cPT + cid * 4096; const bf16_t* gG = p.cG + cid * 4096;
#pragma unroll
      for (int nk = 0; nk < 4; ++nk) {
#pragma unroll
        for (int ks = 0; ks < 2; ++ks) s.pt[nk][ks] = *(const bf16x8*)(gPT + (nk * 16 + l15) * 64 + ks * 32 + quad * 8);
#pragma unroll
        for (int v2 = 0; v2 < 2; ++v2) s.gv[v2][nk] = *(const u32x2*)(gG + ((wave * 2 + v2) * 16 + l15) * 64 + nk * 16 + quad * 4);
      }
    };
    f32x4 acc[2][4];
    auto step = [&](PS& s, int c) {
      const int buf = c & 1;
#pragma unroll
      for (int v2 = 0; v2 < 2; ++v2) {
        const int v = (wave * 2 + v2) * 16 + l15;
        bf16x8 sf[2];
#pragma unroll
        for (int ks = 0; ks < 2; ++ks) sf[ks] = *(const bf16x8*)(Sb + (buf * 64 + v) * 72 + ks * 32 + quad * 8);
#pragma unroll
        for (int nk = 0; nk < 4; ++nk) {
          f32x4 a = (f32x4){bf_lo(s.gv[v2][nk][0]), bf_hi(s.gv[v2][nk][0]), bf_lo(s.gv[v2][nk][1]), bf_hi(s.gv[v2][nk][1])};
#pragma unroll
          for (int ks = 0; ks < 2; ++ks) a = __builtin_amdgcn_mfma_f32_16x16x32_bf16(s.pt[nk][ks], sf[ks], a, 0, 0, 0);
          acc[v2][nk] = a;
        }
      }
      ldp(s, c + 3);
#pragma unroll
      for (int v2 = 0; v2 < 2; ++v2) {
        const int v = (wave * 2 + v2) * 16 + l15;
#pragma unroll
        for (int nk = 0; nk < 4; ++nk) { u32x2 ov; ov[0] = pk2(acc[v2][nk][0], acc[v2][nk][1]); ov[1] = pk2(acc[v2][nk][2], acc[v2][nk][3]); *(u32x2*)(Sb + ((buf ^ 1) * 64 + v) * 72 + nk * 16 + quad * 4) = ov; }
      }
      asm volatile("s_waitcnt lgkmcnt(0)" ::: "memory"); __builtin_amdgcn_s_barrier(); asm volatile("" ::: "memory");
    };
    PS s0, s1, s2;
    ldp(s0, 0); ldp(s1, 1); ldp(s2, 2);
#pragma unroll 1
    for (int c = 0; c < nmain; c += 3) { step(s0, c); step(s1, c + 1); step(s2, c + 2); }
    step(s0, nmain); step(s1, nmain + 1);
#pragma unroll
    for (int v2 = 0; v2 < 2; ++v2) {
      const int v = (wave * 2 + v2) * 16 + l15;
      float* so = (isp ? p.out + O_WP + (((size_t)(l * 4 + b) * 8 + h) * 64 + v) * 64 : p.out + O_WS + (((size_t)(l * 8 + b) * 8 + h) * 64 + v) * 64);
#pragma unroll
      for (int nk = 0; nk < 4; ++nk) *(f32x4*)(so + nk * 16 + quad * 4) = acc[v2][nk];
    }
  } else {
    struct CS { bf16x8 rt[2]; u32x2 oi[4], ba[4], gt[4]; };
    const int tok = (wave - 2) * 16 + l15;
    auto ldc = [&](CS& s, int c) {
      const int cc = c < nch ? c : nch - 1;
      const size_t cid = (size_t)(cid0 + cc); const size_t row = (size_t)(row0 + cc * 32 + tok);
#pragma unroll
      for (int ks = 0; ks < 2; ++ks) s.rt[ks] = *(const bf16x8*)(p.cRT + cid * 2048 + tok * 64 + ks * 32 + quad * 8);
#pragma unroll
      for (int vt = 0; vt < 4; ++vt) {
        s.oi[vt] = *(const u32x2*)(p.cOI + cid * 2048 + tok * 64 + vt * 16 + quad * 4);
        s.ba[vt] = *(const u32x2*)(p.cBA + cid * 2048 + tok * 64 + vt * 16 + quad * 4);
        s.gt[vt] = *(const u32x2*)(p.z + row * NZ + C_GR + h * 64 + vt * 16 + quad * 4);
      }
    };
    const float* lg = p.lnx_g + l * 512 + h * 64;
    f32x4 lgv[4];
#pragma unroll
    for (int vt = 0; vt < 4; ++vt) lgv[vt] = *(const f32x4*)(lg + vt * 16 + quad * 4);
    auto step = [&](CS& s, int c) {
      const int buf = c & 1; const size_t row = (size_t)(row0 + c * 32 + tok);
      f32x4 ao[4];
#pragma unroll
      for (int vt = 0; vt < 4; ++vt) {
        f32x4 a = (f32x4){bf_lo(s.oi[vt][0]), bf_hi(s.oi[vt][0]), bf_lo(s.oi[vt][1]), bf_hi(s.oi[vt][1])};
#pragma unroll
        for (int ks = 0; ks < 2; ++ks) {
          const bf16x8 sa = *(const bf16x8*)(Sb + (buf * 64 + vt * 16 + l15) * 72 + ks * 32 + quad * 8);
          a = __builtin_amdgcn_mfma_f32_16x16x32_bf16(sa, s.rt[ks], a, 0, 0, 0);
        }
        ao[vt] = a;
      }
      float sm = 0.f;
#pragma unroll
      for (int vt = 0; vt < 4; ++vt) sm += (ao[vt][0] + ao[vt][1]) + (ao[vt][2] + ao[vt][3]);
      sm += __shfl_xor(sm, 16); sm += __shfl_xor(sm, 32);
      const float mean = sm * (1.0f / 64.0f);
      float vr = 0.f;
#pragma unroll
      for (int vt = 0; vt < 4; ++vt)
#pragma unroll
        for (int e = 0; e < 4; ++e) { const float d = ao[vt][e] - mean; vr += d * d; }
      vr += __shfl_xor(vr, 16); vr += __shfl_xor(vr, 32);
      const float rstd = rsqrtf(vr * (1.0f / 64.0f) + 64e-5f);
#pragma unroll
      for (int vt = 0; vt < 4; ++vt) {
        const int vv = vt * 16 + quad * 4;
        const f32x4 g4 = lgv[vt];
        const float y0 = ((ao[vt][0] - mean) * rstd * g4[0] + bf_lo(s.ba[vt][0])) * bf_lo(s.gt[vt][0]);
        const float y1 = ((ao[vt][1] - mean) * rstd * g4[1] + bf_hi(s.ba[vt][0])) * bf_hi(s.gt[vt][0]);
        const float y2 = ((ao[vt][2] - mean) * rstd * g4[2] + bf_lo(s.ba[vt][1])) * bf_lo(s.gt[vt][1]);
        const float y3 = ((ao[vt][3] - mean) * rstd * g4[3] + bf_hi(s.ba[vt][1])) * bf_hi(s.gt[vt][1]);
        u32x2 ov; ov[0] = pk2(y0, y1); ov[1] = pk2(y2, y3);
        *(u32x2*)(p.o_r + row * 512 + h * 64 + vv) = ov;
      }
      ldc(s, c + 3);
      asm volatile("s_waitcnt lgkmcnt(0)" ::: "memory"); __builtin_amdgcn_s_barrier(); asm volatile("" ::: "memory");
    };
    CS s0, s1, s2;
    ldc(s0, 0); ldc(s1, 1); ldc(s2, 2);
#pragma unroll 1
    for (int c = 0; c < nmain; c += 3) { step(s0, c); step(s1, c + 1); step(s2, c + 2); }
    step(s0, nmain); step(s1, nmain + 1);
  }
  __syncthreads();
}
DI void phase_chunk(const Params& p, int l, char* lds) {
  for (int it = blockIdx.x; it < NCH; it += gridDim.x) chunk_item(p, l, it, lds);
}

constexpr int ALD = 72;
DI void attn_item(const Params& p, int l, int item, char* lds) {
  const int tid = tid_(), wave = tid >> 6, lane = tid & 63;
  const int m = wave & 1, qh = wave >> 1, q = lane & 31, hh = lane >> 5;
  bf16_t* Ks = (bf16_t*)lds;
  bf16_t* Vs = Ks + 2 * 64 * ALD;
  float* xb = (float*)lds;
  bool samp; int b, h, nch, qrow0, qpos0;
  if (item < 32) { samp = true; b = item >> 2; h = item & 3; nch = 17; qrow0 = MP + b * 64; qpos0 = 1024; }
  else { samp = false; const int a = item - 32; const int qc = 63 - (a >> 4); const int bh = a & 15; b = bh >> 2; h = bh & 3; nch = qc + 1; qrow0 = b * 4096 + qc * 64; qpos0 = qc * 64; }
  bf16x8 qf[4];
  {
    const bf16_t* qp = p.z + (size_t)(qrow0 + qh * 32 + q) * NZ + C_Q + h * 128 + m * 64;
#pragma unroll
    for (int ks = 0; ks < 4; ++ks) qf[ks] = *(const bf16x8*)(qp + ks * 16 + hh * 8);
  }
  const float slope = exp2f(-2.0f * (float)(h + 1));
  const float LOG2E = 1.4426950408889634f;
  const float c1 = 0.125f * LOG2E, sl2 = slope * LOG2E;
  const float qposf = (float)(qpos0 + qh * 32 + q);
  f32x16 O[4];
#pragma unroll
  for (int i = 0; i < 4; ++i)
#pragma unroll
    for (int e = 0; e < 16; ++e) O[i][e] = 0.f;
  float mrun = -1e30f, lrun = 0.f;
  u32x4 rk[4], rv[4];
  auto gload = [&](int j) {
    const bf16_t* kb; size_t kld; const bf16_t* vb; size_t vld;
    if (!samp) { kb = p.z + (size_t)(b * 4096 + j * 64) * NZ + C_K + h * 128; kld = NZ; vb = p.vtp + (size_t)((b * 4 + h) * 128) * 4096 + j * 64; vld = 4096; }
    else if (j < 16) { kb = p.kc + (size_t)(b * 1024 + j * 64) * 512 + h * 128; kld = 512; vb = p.vct + (size_t)((b * 4 + h) * 128) * 1024 + j * 64; vld = 1024; }
    else { kb = p.z + (size_t)(MP + b * 64) * NZ + C_K + h * 128; kld = NZ; vb = p.vts + (size_t)((b * 4 + h) * 128) * 64; vld = 64; }
#pragma unroll
    for (int i = 0; i < 4; ++i) {
      const int c = tid + 256 * i;
      const int mm = c >> 9, key = (c >> 3) & 63, d8 = (c & 7) * 8;
      rk[i] = *(const u32x4*)(kb + (size_t)key * kld + mm * 64 + d8);
      const int vd = c >> 3, k8 = (c & 7) * 8;
      rv[i] = *(const u32x4*)(vb + (size_t)vd * vld + k8);
    }
  };
  auto sstore = [&]() {
#pragma unroll
    for (int i = 0; i < 4; ++i) {
      const int c = tid + 256 * i;
      const int mm = c >> 9, key = (c >> 3) & 63, d8 = (c & 7) * 8;
      *(u32x4*)(Ks + (mm * 64 + key) * ALD + d8) = rk[i];
      const int vd = c >> 3, k8 = (c & 7) * 8;
      *(u32x4*)(Vs + vd * ALD + k8) = rv[i];
    }
  };
  gload(0); sstore(); __syncthreads();
  for (int j = 0; j < nch; ++j) {
    if (j + 1 < nch) gload(j + 1);
    f32x16 s[2];
#pragma unroll
    for (int kt = 0; kt < 2; ++kt) {
#pragma unroll
      for (int e = 0; e < 16; ++e) s[kt][e] = 0.f;
#pragma unroll
      for (int ks = 0; ks < 4; ++ks) {
        const bf16x8 kf = *(const bf16x8*)(Ks + (m * 64 + kt * 32 + q) * ALD + ks * 16 + hh * 8);
        s[kt] = __builtin_amdgcn_mfma_f32_32x32x16_bf16(kf, qf[ks], s[kt], 0, 0, 0);
      }
    }
    float mx = -1e30f;
    const float dbase = qposf - (float)(j * 64 + 4 * hh);
#pragma unroll
    for (int kt = 0; kt < 2; ++kt)
#pragma unroll
      for (int e = 0; e < 16; ++e) {
        const float dd = dbase - (float)(kt * 32 + (e & 3) + 8 * (e >> 2));
        const float v = s[kt][e] * c1 - sl2 * fabsf(dd);
        s[kt][e] = v; mx = fmaxf(mx, v);
      }
    mx = fmaxf(mx, __shfl_xor(mx, 32));
    const float mnew = fmaxf(mrun, mx);
    const float alpha = __builtin_amdgcn_exp2f(mrun - mnew);
    const bool resc = mnew > mrun;
    mrun = mnew;
    float ps = 0.f;
#pragma unroll
    for (int kt = 0; kt < 2; ++kt)
#pragma unroll
      for (int e = 0; e < 16; ++e) { const float pe = __builtin_amdgcn_exp2f(s[kt][e] - mnew); s[kt][e] = pe; ps += pe; }
    lrun = lrun * alpha + ps;
    if (__any(resc)) {
#pragma unroll
      for (int i = 0; i < 4; ++i)
#pragma unroll
        for (int e = 0; e < 16; ++e) O[i][e] *= alpha;
    }
#pragma unroll
    for (int kt = 0; kt < 2; ++kt)
#pragma unroll
      for (int sx = 0; sx < 2; ++sx) {
        u32x4 pb;
        pb[0] = pk2(s[kt][8 * sx + 0], s[kt][8 * sx + 1]); pb[1] = pk2(s[kt][8 * sx + 2], s[kt][8 * sx + 3]);
        pb[2] = pk2(s[kt][8 * sx + 4], s[kt][8 * sx + 5]); pb[3] = pk2(s[kt][8 * sx + 6], s[kt][8 * sx + 7]);
        const bf16x8 pf = __builtin_bit_cast(bf16x8, pb);
#pragma unroll
        for (int vt = 0; vt < 4; ++vt) {
          const bf16_t* vp = Vs + (vt * 32 + q) * ALD + kt * 32 + 16 * sx + 4 * hh;
          const s16x4 lo = *(const s16x4*)vp, hi = *(const s16x4*)(vp + 8);
          const bf16x8 vf = __builtin_shufflevector(lo, hi, 0, 1, 2, 3, 4, 5, 6, 7);
          O[vt] = __builtin_amdgcn_mfma_f32_32x32x16_bf16(vf, pf, O[vt], 0, 0, 0);
        }
      }
    __syncthreads();
    if (j + 1 < nch) sstore();
    __syncthreads();
  }
  const float ltot = lrun + __shfl_xor(lrun, 32);
  const float inv = 1.0f / ltot;
#pragma unroll
  for (int i = 0; i < 4; ++i)
#pragma unroll
    for (int e = 0; e < 16; ++e) O[i][e] *= inv;
  if (m == 1) {
#pragma unroll
    for (int vt = 0; vt < 4; ++vt)
#pragma unroll
      for (int e = 0; e < 16; ++e) { const int vd = vt * 32 + (e & 3) + 8 * (e >> 2) + 4 * hh; xb[(qh * 128 + vd) * 32 + q] = O[vt][e]; }
  }
  __syncthreads();
  if (m == 0) {
    float d1 = 0.f, d2 = 0.f;
    for (int i = 0; i < 64; ++i) { d1 += p.lq1[l * 64 + i] * p.lk1[l * 64 + i]; d2 += p.lq2[l * 64 + i] * p.lk2[l * 64 + i]; }
    const float lam_init = 0.8f - 0.6f * __expf(-0.3f * (float)l);
    const float lam = __expf(d1) - __expf(d2) + lam_init;
    float ss = 0.f;
#pragma unroll
    for (int vt = 0; vt < 4; ++vt)
#pragma unroll
      for (int e = 0; e < 16; ++e) {
        const int vd = vt * 32 + (e & 3) + 8 * (e >> 2) + 4 * hh;
        const float o2 = xb[(qh * 128 + vd) * 32 + q];
        const float o = O[vt][e] - lam * o2; O[vt][e] = o; ss += o * o;
      }
    ss += __shfl_xor(ss, 32);
    const float rstd = rsqrtf(ss * (1.0f / 128.0f) + 1e-5f) * (1.0f - lam_init);
    const size_t row = (size_t)(qrow0 + qh * 32 + q);
    const float* sg = p.subln_g + l * 128;
#pragma unroll
    for (int vt = 0; vt < 4; ++vt)
#pragma unroll
      for (int e4 = 0; e4 < 4; ++e4) {
        const int vd = vt * 32 + 8 * e4 + 4 * hh;
        const u32x2 gu = *(const u32x2*)(p.z + row * NZ + C_GA + h * 128 + vd);
        const f32x4 gv = *(const f32x4*)(sg + vd);
        const float y0 = O[vt][4 * e4 + 0] * rstd * gv[0] * bf_lo(gu[0]);
        const float y1 = O[vt][4 * e4 + 1] * rstd * gv[1] * bf_hi(gu[0]);
        const float y2 = O[vt][4 * e4 + 2] * rstd * gv[2] * bf_lo(gu[1]);
        const float y3 = O[vt][4 * e4 + 3] * rstd * gv[3] * bf_hi(gu[1]);
        u32x2 ov; ov[0] = pk2(y0, y1); ov[1] = pk2(y2, y3);
        *(u32x2*)(p.o_a + row * 512 + h * 128 + vd) = ov;
      }
  }
  __syncthreads();
}

DI void phase_mix(const Params& p, int l, char* lds) {
  __shared__ int s_next;
  if (blockIdx.x < 96) rec_item(p, l, blockIdx.x, lds);
  unsigned* ctr = p.bar + XCD_BAR_WORDS + 64 * l;
  for (;;) {
    __syncthreads();
    if (threadIdx.x == 0) s_next = (int)atomicAdd(ctr, 1u);
    __syncthreads();
    const int it = s_next;
    if (it >= 1056) break;
    attn_item(p, l, it, lds);
  }
}

DI void phase_merge(const Params& p, int l, char* lds) {
  const int tid = tid_(), wave = tid >> 6, lane = tid & 63;
  const int wm = wave >> 1, wn = wave & 1, l15 = lane & 15, quad = lane >> 4;
  for (int r = 0;; ++r) {
    const int g = xcd_tile(r, 132 * 8); if (g < 0) break;
    int mt, nt; tile_decode(g, 132, 8, mt, nt);
    f32x4 a1[4][4]; zero_acc(a1);
    gemm_dma(a1, p.o_r + (size_t)mt * 128 * 512, 512, p.wt_brr + (size_t)nt * 128 * 512, 512, 512, lds);
    u32x2 pk[4][4];
#pragma unroll
    for (int mi = 0; mi < 4; ++mi) {
      const int R = mt * 128 + wm * 64 + mi * 16 + l15;
#pragma unroll
      for (int ni = 0; ni < 4; ++ni) {
        const int c = nt * 128 + wn * 64 + ni * 16 + quad * 4;
        const u32x2 g1 = *(const u32x2*)(p.z + (size_t)R * NZ + C_MR + c);
        const f32x4 v1 = a1[mi][ni];
        pk[mi][ni][0] = pk2(bf_lo(g1[0]) * v1[0], bf_hi(g1[0]) * v1[1]);
        pk[mi][ni][1] = pk2(bf_lo(g1[1]) * v1[2], bf_hi(g1[1]) * v1[3]);
      }
    }
    zero_acc(a1);
    gemm_dma(a1, p.o_a + (size_t)mt * 128 * 512, 512, p.wt_bra + (size_t)nt * 128 * 512, 512, 512, lds);
#pragma unroll
    for (int mi = 0; mi < 4; ++mi) {
      const int R = mt * 128 + wm * 64 + mi * 16 + l15;
#pragma unroll
      for (int ni = 0; ni < 4; ++ni) {
        const int c = nt * 128 + wn * 64 + ni * 16 + quad * 4;
        const u32x2 g2 = *(const u32x2*)(p.z + (size_t)R * NZ + C_MA + c);
        const f32x4 v2 = a1[mi][ni]; const u32x2 u1 = pk[mi][ni];
        u32x2 o;
        o[0] = pk2(bf_lo(u1[0]) + bf_lo(g2[0]) * v2[0], bf_hi(u1[0]) + bf_hi(g2[0]) * v2[1]);
        o[1] = pk2(bf_lo(u1[1]) + bf_lo(g2[1]) * v2[2], bf_hi(u1[1]) + bf_hi(g2[1]) * v2[3]);
        *(u32x2*)(p.hn + (size_t)R * DM + c) = o;
      }
    }
  }
}
DI void phase_out(const Params& p, int l, char* lds) {
  const int tid = tid_(), wave = tid >> 6, lane = tid & 63;
  const int wm = wave >> 1, wn = wave & 1, l15 = lane & 15, quad = lane >> 4;
  for (int r = 0;; ++r) {
    const int g = xcd_tile(r, 132 * 8); if (g < 0) break;
    int mt, nt; tile_decode(g, 132, 8, mt, nt);
    f32x4 acc[4][4]; zero_acc(acc);
    gemm_dma(acc, p.hn + (size_t)mt * 128 * DM, DM, p.wt_out + (size_t)nt * 128 * DM, DM, DM, lds);
#pragma unroll
    for (int mi = 0; mi < 4; ++mi) {
      const int R = mt * 128 + wm * 64 + mi * 16 + l15;
      const float* xr = x_row(p, l, R);
#pragma unroll
      for (int ni = 0; ni < 4; ++ni) {
        const int c = nt * 128 + wn * 64 + ni * 16 + quad * 4;
        const f32x4 xv = *(const f32x4*)(xr + c);
        *(f32x4*)(p.out + (size_t)R * DM + c) = xv + acc[mi][ni];
      }
    }
  }
}
DI void phase_ple(const Params& p, int l, char* lds) {
  const int tid = tid_(), wave = tid >> 6, lane = tid & 63;
  const int wm = wave >> 1, wn = wave & 1, l15 = lane & 15, quad = lane >> 4;
  for (int r = 0;; ++r) {
    const int g = xcd_tile(r, 132 * 8); if (g < 0) break;
    int mt, nt; tile_decode(g, 132, 8, mt, nt);
    f32x4 a1[4][4]; zero_acc(a1);
    gemm_dma(a1, p.hn + (size_t)mt * 128 * DM, DM, p.wt_gate + (size_t)nt * 128 * DM, DM, DM, lds);
    u32x2 pk[4][4];
#pragma unroll
    for (int mi = 0; mi < 4; ++mi)
#pragma unroll
      for (int ni = 0; ni < 4; ++ni) { const f32x4 v = a1[mi][ni]; pk[mi][ni][0] = pk2(sigmoidf_(v[0]), sigmoidf_(v[1])); pk[mi][ni][1] = pk2(sigmoidf_(v[2]), sigmoidf_(v[3])); }
    zero_acc(a1);
    const int r0 = mt * 128;
    const float* pa = r0 < MP ? p.pp + ((size_t)l * MP + r0) * 256 : p.ps + ((size_t)l * MS + (r0 - MP)) * 256;
    gemm_core<true>(a1, pa, 256, p.wt_ple + (size_t)nt * 128 * 256, 256, 256, lds);
#pragma unroll
    for (int mi = 0; mi < 4; ++mi) {
      const int R = mt * 128 + wm * 64 + mi * 16 + l15;
#pragma unroll
      for (int ni = 0; ni < 4; ++ni) {
        const int c = nt * 128 + wn * 64 + ni * 16 + quad * 4;
        float* xo = p.out + (size_t)R * DM + c;
        const f32x4 xv = *(const f32x4*)xo; const f32x4 e = a1[mi][ni]; const u32x2 g = pk[mi][ni];
        f32x4 o;
        o[0] = xv[0] + e[0] * bf_lo(g[0]); o[1] = xv[1] + e[1] * bf_hi(g[0]);
        o[2] = xv[2] + e[2] * bf_lo(g[1]); o[3] = xv[3] + e[3] * bf_hi(g[1]);
        *(f32x4*)xo = o;
      }
    }
  }
}


#define XB_TMO      128
#define XB_XCNT(j)  (256  + 64 * (j))
#define XB_XSUB(j)  (1280 + 64 * (j))
#define XB_XGEN(j)  (2304 + 64 * (j))
#define XB_TOP      3328
#define XB_TOPGEN   3392
#define XB_SPIN_CAP (1u << 18)
#define LAS __attribute__((address_space(3)))
DI unsigned xb_ld(unsigned* p)              { return __hip_atomic_load(p, __ATOMIC_RELAXED, __HIP_MEMORY_SCOPE_AGENT); }
DI unsigned xb_add(unsigned* p, unsigned v) { return __hip_atomic_fetch_add(p, v, __ATOMIC_RELAXED, __HIP_MEMORY_SCOPE_AGENT); }
DI unsigned xb_xcc_id() { return (unsigned)__builtin_amdgcn_s_getreg((3 << 11) | 20) & 0xFu; }
#define XB_SPIN(cond, bar) do { unsigned _sp = 0; while (cond) { __builtin_amdgcn_s_sleep(1); \
    if ((++_sp & 255u) == 0u) { if (xb_ld(&(bar)[XB_TMO])) break; if (_sp > XB_SPIN_CAP) { atomicAdd(&(bar)[XB_TMO], 1u); break; } } } } while (0)
struct XcdBarrier { unsigned* bar; unsigned x; volatile LAS unsigned* st; };
DI XcdBarrier xcd_barrier_post(unsigned* bar, volatile LAS unsigned* st) {
  XcdBarrier b; b.bar = bar; b.x = xb_xcc_id(); b.st = st;
  if (threadIdx.x == 0) (void)xb_add(&bar[XB_XCNT(b.x)], 1u);
  return b;
}
DI void xcd_barrier_complete(unsigned* bar, unsigned x, unsigned& nloc, unsigned& nx) {
  const unsigned G = gridDim.x * gridDim.y * gridDim.z;
  unsigned sum, cnt, mine, sp = 0u;
  for (;;) {
    sum = 0u; cnt = 0u; mine = 0u;
#pragma unroll
    for (unsigned j = 0; j < 16; ++j) { const unsigned c = xb_ld(&bar[XB_XCNT(j)]); sum += c; cnt += (c > 0u) ? 1u : 0u; mine = (j == x) ? c : mine; }
    if (sum == G) break;
    __builtin_amdgcn_s_sleep(1);
    if ((++sp & 255u) == 0u) { if (xb_ld(&bar[XB_TMO])) break; if (sp > XB_SPIN_CAP) { atomicAdd(&bar[XB_TMO], 1u); break; } }
  }
  nloc = mine > 0u ? mine : 1u; nx = cnt > 0u ? cnt : 1u;
}
DI void xcd_barrier(const XcdBarrier& b) {
  asm volatile("s_waitcnt vmcnt(0)" ::: "memory");
  __syncthreads();
  if (threadIdx.x == 0) {
    unsigned* bar = b.bar;
    __builtin_amdgcn_s_waitcnt(0);
    unsigned nloc = b.st[0], nx = b.st[1];
    if (nloc == 0u) { xcd_barrier_complete(bar, b.x, nloc, nx); b.st[0] = nloc; b.st[1] = nx; }
    const unsigned old = xb_add(&bar[XB_XSUB(b.x)], 1u);
    const unsigned gen = old / nloc;
    if (old + 1u == (gen + 1u) * nloc) {
      __builtin_amdgcn_fence(__ATOMIC_RELEASE, "agent");
      asm volatile("s_waitcnt vmcnt(0)" ::: "memory");
      const unsigned og = xb_add(&bar[XB_TOP], 1u);
      const unsigned tg = og / nx;
      if (og + 1u == (tg + 1u) * nx) xb_add(&bar[XB_TOPGEN], 1u);
      else XB_SPIN(xb_ld(&bar[XB_TOPGEN]) == tg, bar);
      __builtin_amdgcn_fence(__ATOMIC_ACQUIRE, "agent");
      xb_add(&bar[XB_XGEN(b.x)], 1u);
      asm volatile("s_waitcnt vmcnt(0)" ::: "memory");
    } else {
      XB_SPIN(xb_ld(&bar[XB_XGEN(b.x)]) == gen, bar);
      __builtin_amdgcn_fence(__ATOMIC_ACQUIRE, "agent");
      asm volatile("s_waitcnt vmcnt(0)" ::: "memory");
    }
  }
  __syncthreads();
}
constexpr int LDS_BYTES = 73728;
DI void run_phase(const Params& p, int ph, int l, char* lds) {
  switch (ph) {
    case 1: phase_norm(p, l, true, lds); break;
    case 2: phase_gemm_in(p, l, lds); break;
    case 3: phase_mix(p, l, lds); break;
    case 4: phase_merge(p, l, lds); break;
    case 5: phase_out(p, l, lds); break;
    case 6: phase_norm(p, l, false, lds); break;
    case 7: phase_ple(p, l, lds); break;
    case 8: phase_chunk(p, l, lds); break;
  }
}

#if MEGA
__global__ void __launch_bounds__(256, 2) k_mega(Params p) {
  __shared__ __attribute__((aligned(16))) char lds[LDS_BYTES];
  __shared__ uint4 xb_words;
  cg::grid_group grid = cg::this_grid();
  if (threadIdx.x == 0) xb_words = make_uint4(0u, 0u, 0u, 0u);
  __syncthreads();
  const XcdBarrier xb = xcd_barrier_post(p.bar, (volatile LAS unsigned*)&xb_words);
#pragma unroll 1
  for (int l = 0; l < NL; ++l) {
    phase_norm(p, l, true, lds);
    if (l == 0) grid.sync(); else xcd_barrier(xb);
    phase_gemm_in(p, l, lds); xcd_barrier(xb);
    phase_chunk(p, l, lds); xcd_barrier(xb);
    phase_mix(p, l, lds); xcd_barrier(xb);
    phase_merge(p, l, lds); xcd_barrier(xb);
    phase_out(p, l, lds); xcd_barrier(xb);
    phase_norm(p, l, false, lds); xcd_barrier(xb);
    phase_ple(p, l, lds); if (l + 1 < NL) xcd_barrier(xb);
  }
}
#else
template <int PH>
__global__ void __launch_bounds__(256, 2) k_phase(Params p, int l) {
  __shared__ __attribute__((aligned(16))) char lds[LDS_BYTES];
  run_phase(p, PH, l, lds);
}
#endif

extern "C" void kernel_launch(void* const* d_in, const int* in_sizes, int n_in, void* d_out, int out_size, void* d_ws, size_t ws_size,
                              hipStream_t stream) {
  Params p{};
  const float** pf = (const float**)&p;
  for (int i = 0; i < 33; ++i) pf[i] = (const float*)d_in[i];
  p.out = (float*)d_out;
  char* w = (char*)d_ws; size_t off = 0;
  auto take = [&](size_t bytes) { char* r = w + off; off += (bytes + 255) & ~(size_t)255; return (bf16_t*)r; };
  p.bar = (unsigned*)take((size_t)(XCD_BAR_WORDS + 64 * NL) * 4);
  p.wt_in = take((size_t)NZ * 1024 * 2);
  p.wt_brr = take((size_t)1024 * 512 * 2);
  p.wt_bra = take((size_t)1024 * 512 * 2);
  p.wt_out = take((size_t)1024 * 1024 * 2);
  p.wt_ple = take((size_t)1024 * 256 * 2);
  p.wt_gate = take((size_t)1024 * 1024 * 2);
  p.w2t = take((size_t)512 * 64 * 2);
  p.a2t = take((size_t)512 * 64 * 2);
  p.z = take((size_t)MT * NZ * 2);
  p.vtp = take((size_t)16 * 128 * 4096 * 2);
  p.vts = take((size_t)32 * 128 * 64 * 2);
  p.kc = take((size_t)8 * 1024 * 512 * 2);
  p.vct = take((size_t)32 * 128 * 1024 * 2);
  p.o_r = take((size_t)MT * 512 * 2);
  p.o_a = take((size_t)MT * 512 * 2);
  p.hn = take((size_t)MT * DM * 2);
  p.cPT = p.hn;
  p.cG = take((size_t)NCH * 4096 * 2);
  p.cRT = take((size_t)NCH * 2048 * 2);
  p.cOI = take((size_t)NCH * 2048 * 2);
  p.cBA = take((size_t)NCH * 2048 * 2);
  if (off > ws_size) { fprintf(stderr, "workspace too small: need %zu have %zu\n", off, ws_size); return; }
#if MEGA
  hipMemsetAsync(p.bar, 0, (size_t)(XCD_BAR_WORDS + 64 * NL) * 4, stream);
  static int grid_blocks = 0;
  if (!grid_blocks) {
    int dev = 0, cus = 0, per_cu = 0;
    hipGetDevice(&dev);
    hipDeviceGetAttribute(&cus, hipDeviceAttributeMultiprocessorCount, dev);
    hipOccupancyMaxActiveBlocksPerMultiprocessor(&per_cu, k_mega, 256, 0);
    if (per_cu > 2) per_cu = 2;
    grid_blocks = cus * per_cu;
  }
  void* args[] = {&p};
  hipError_t e = hipLaunchCooperativeKernel((void*)k_mega, dim3(grid_blocks), dim3(256), args, 0, stream);
  if (e != hipSuccess) fprintf(stderr, "cooperative launch failed: %s (grid %d)\n", hipGetErrorString(e), grid_blocks);
#else
  const int G = 512;
  for (int l = 0; l < NL; ++l) {
    k_phase<1><<<G, 256, 0, stream>>>(p, l);
    k_phase<2><<<G, 256, 0, stream>>>(p, l);
    k_phase<8><<<G, 256, 0, stream>>>(p, l);
    k_phase<3><<<G, 256, 0, stream>>>(p, l);
    k_phase<4><<<G, 256, 0, stream>>>(p, l);
    k_phase<5><<<G, 256, 0, stream>>>(p, l);
    k_phase<6><<<G, 256, 0, stream>>>(p, l);
    k_phase<7><<<G, 256, 0, stream>>>(p, l);
  }
#endif
}
```

```cpp
#include <hip/hip_runtime.h>
#include <hip/hip_cooperative_groups.h>
#include <stdint.h>
#include <stdio.h>
namespace cg = cooperative_groups;

#ifndef MEGA
#define MEGA 1
#endif

typedef unsigned short bf16_t;
typedef short bf16x8 __attribute__((ext_vector_type(8)));
typedef short s16x4 __attribute__((ext_vector_type(4)));
typedef float f32x4 __attribute__((ext_vector_type(4)));
typedef float f32x2 __attribute__((ext_vector_type(2)));
typedef float f32x16 __attribute__((ext_vector_type(16)));
typedef unsigned u32x4 __attribute__((ext_vector_type(4)));
typedef unsigned u32x2 __attribute__((ext_vector_type(2)));
typedef __bf16 bfv2 __attribute__((ext_vector_type(2)));

#define DI __device__ __forceinline__
#define XCD_BAR_WORDS 3456
DI int tid_() { int t = threadIdx.x; asm volatile("" : "+v"(t)); return t; }

constexpr int DM = 1024, MP = 16384, MS = 512, MT = 16896, NZ = 6272, NL = 4;
constexpr int C_GR = 1664, C_Q = 2176, C_K = 2688, C_V = 3200, C_GA = 3712, C_MR = 4224, C_MA = 5248;
constexpr int SHC = 1664;
constexpr size_t O_YP = 0, O_YS = 16777216, O_KP = 17301504, O_VP = 50855936, O_WP = 84410368, O_SP = 84934656,
                 O_KS = 84961280, O_VS = 86009856, O_WS = 87058432, O_SS = 88107008;

struct Params {
  const float *xp, *xs, *pp, *ps, *ck, *cv, *swkv, *sshift;
  const float *norm_g, *w_in, *shift_mu, *decay_w0, *decay_w2, *iclr_a0, *iclr_a2, *k_k, *k_a, *r_k, *lnx_g, *lnx_b,
      *qng, *kng, *lq1, *lk1, *lq2, *lk2, *subln_g, *w_br_r, *w_br_a, *w_out, *ple_w, *ple_gate_w, *ple_norm_g;
  float* out;
  bf16_t *wt_in, *wt_brr, *wt_bra, *wt_out, *wt_ple, *wt_gate, *w2t, *a2t;
  bf16_t *hn, *z, *vtp, *vts, *kc, *vct, *o_r, *o_a;
  bf16_t *cPT, *cG, *cRT, *cOI, *cBA;
  unsigned* bar;
};

DI unsigned pk2(float a, float b) { f32x2 v = {a, b}; bfv2 r = __builtin_convertvector(v, bfv2); return __builtin_bit_cast(unsigned, r); }
DI float bf_lo(unsigned u) { return __uint_as_float(u << 16); }
DI float bf_hi(unsigned u) { return __uint_as_float(u & 0xffff0000u); }
DI float bf1(bf16_t u) { return __uint_as_float(((unsigned)u) << 16); }
DI float sigmoidf_(float x) { return __builtin_amdgcn_rcpf(1.0f + __expf(-x)); }
DI float siluf_(float x) { return x * __builtin_amdgcn_rcpf(1.0f + __expf(-x)); }

DI void tr_tile(const float* __restrict__ src, int ld_src, bf16_t* __restrict__ dst, int ld_dst, float* sm) {
  const int tid = tid_();
  const int r = tid >> 4, c4 = (tid & 15) * 4;
#pragma unroll
  for (int i = 0; i < 4; ++i) {
    const int row = r + 16 * i;
    f32x4 v = *(const f32x4*)(src + (size_t)row * ld_src + c4);
    sm[row * 65 + c4 + 0] = v[0]; sm[row * 65 + c4 + 1] = v[1]; sm[row * 65 + c4 + 2] = v[2]; sm[row * 65 + c4 + 3] = v[3];
  }
  __syncthreads();
  const int n = tid >> 2, ks = (tid & 3) * 16;
  u32x4 o0, o1;
  o0[0] = pk2(sm[(ks + 0) * 65 + n], sm[(ks + 1) * 65 + n]);   o0[1] = pk2(sm[(ks + 2) * 65 + n], sm[(ks + 3) * 65 + n]);
  o0[2] = pk2(sm[(ks + 4) * 65 + n], sm[(ks + 5) * 65 + n]);   o0[3] = pk2(sm[(ks + 6) * 65 + n], sm[(ks + 7) * 65 + n]);
  o1[0] = pk2(sm[(ks + 8) * 65 + n], sm[(ks + 9) * 65 + n]);   o1[1] = pk2(sm[(ks + 10) * 65 + n], sm[(ks + 11) * 65 + n]);
  o1[2] = pk2(sm[(ks + 12) * 65 + n], sm[(ks + 13) * 65 + n]); o1[3] = pk2(sm[(ks + 14) * 65 + n], sm[(ks + 15) * 65 + n]);
  *(u32x4*)(dst + (size_t)n * ld_dst + ks) = o0;
  *(u32x4*)(dst + (size_t)n * ld_dst + ks + 8) = o1;
  __syncthreads();
}

constexpr int WCONV_TILES = 1568 + 128 + 128 + 256 + 64 + 256 + 8 + 8;
DI void wconv_tile(const Params& p, int l, int t, float* sm) {
  const float* src; bf16_t* dst; int K, N;
  if (t < 1568) { src = p.w_in + (size_t)l * 1024 * NZ; dst = p.wt_in; K = 1024; N = NZ; }
  else if ((t -= 1568) < 128) { src = p.w_br_r + (size_t)l * 512 * 1024; dst = p.wt_brr; K = 512; N = 1024; }
  else if ((t -= 128) < 128) { src = p.w_br_a + (size_t)l * 512 * 1024; dst = p.wt_bra; K = 512; N = 1024; }
  else if ((t -= 128) < 256) { src = p.w_out + (size_t)l * 1024 * 1024; dst = p.wt_out; K = 1024; N = 1024; }
  else if ((t -= 256) < 64) { src = p.ple_w + (size_t)l * 256 * 1024; dst = p.wt_ple; K = 256; N = 1024; }
  else if ((t -= 64) < 256) { src = p.ple_gate_w + (size_t)l * 1024 * 1024; dst = p.wt_gate; K = 1024; N = 1024; }
  else if ((t -= 256) < 8) { src = p.decay_w2 + (size_t)l * 64 * 512; dst = p.w2t; K = 64; N = 512; }
  else { t -= 8; src = p.iclr_a2 + (size_t)l * 64 * 512; dst = p.a2t; K = 64; N = 512; }
  const int ntn = N / 64; const int tk = t / ntn, tn = t % ntn;
  tr_tile(src + (size_t)(tk * 64) * N + tn * 64, N, dst + (size_t)(tn * 64) * K + tk * 64, K, sm);
}

DI const float* x_row(const Params& p, int l, int r) {
  if (l == 0) return r < MP ? p.xp + (size_t)r * DM : p.xs + (size_t)(r - MP) * DM;
  return p.out + (size_t)r * DM;
}
DI void phase_norm(const Params& p, int l, bool first, char* lds) {
  const int tid = tid_(), wave = __builtin_amdgcn_readfirstlane(tid >> 6), lane = tid & 63;
  const float* g = (first ? p.norm_g : p.ple_norm_g) + l * DM;
  const int n_norm = MT / 4;
  const int n_items = n_norm + (first ? 2048 + WCONV_TILES : 0);
  for (int it = blockIdx.x; it < n_items; it += gridDim.x) {
    if (it < n_norm) {
      const int r = it * 4 + wave;
      const float* x = first ? x_row(p, l, r) : p.out + (size_t)r * DM;
      f32x4 v[4]; float ss = 0.f;
#pragma unroll
      for (int i = 0; i < 4; ++i) { v[i] = *(const f32x4*)(x + lane * 4 + 256 * i); ss += v[i][0] * v[i][0] + v[i][1] * v[i][1] + v[i][2] * v[i][2] + v[i][3] * v[i][3]; }
#pragma unroll
      for (int o = 32; o >= 1; o >>= 1) ss += __shfl_xor(ss, o);
      const float rstd = rsqrtf(ss * (1.0f / 1024.0f) + 1e-6f);
#pragma unroll
      for (int i = 0; i < 4; ++i) {
        const f32x4 gv = *(const f32x4*)(g + lane * 4 + 256 * i);
        u32x2 o; o[0] = pk2(v[i][0] * rstd * gv[0], v[i][1] * rstd * gv[1]); o[1] = pk2(v[i][2] * rstd * gv[2], v[i][3] * rstd * gv[3]);
        *(u32x2*)(p.hn + (size_t)r * DM + lane * 4 + 256 * i) = o;
      }
    } else if (it < n_norm + 1024) {
      const int c = it - n_norm;
      const float* src = p.ck + (size_t)l * 8 * 1024 * 512 + (size_t)c * 4096 + tid * 16;
      bf16_t* dst = p.kc + (size_t)c * 4096 + tid * 16;
      f32x4 a0 = *(const f32x4*)(src), a1 = *(const f32x4*)(src + 4), a2 = *(const f32x4*)(src + 8), a3 = *(const f32x4*)(src + 12);
      u32x4 o0, o1;
      o0[0] = pk2(a0[0], a0[1]); o0[1] = pk2(a0[2], a0[3]); o0[2] = pk2(a1[0], a1[1]); o0[3] = pk2(a1[2], a1[3]);
      o1[0] = pk2(a2[0], a2[1]); o1[1] = pk2(a2[2], a2[3]); o1[2] = pk2(a3[0], a3[1]); o1[3] = pk2(a3[2], a3[3]);
      *(u32x4*)dst = o0; *(u32x4*)(dst + 8) = o1;
    } else if (it >= n_norm + 2048) {
      wconv_tile(p, l, it - n_norm - 2048, (float*)lds);
    } else {
      const int c = it - n_norm - 1024;
      const int bh = c >> 5, tt = c & 31; const int b = bh >> 2, h = bh & 3; const int tk = tt >> 1, tn = tt & 1;
      const float* src = p.cv + (size_t)l * 8 * 1024 * 512 + ((size_t)(b * 1024 + tk * 64)) * 512 + h * 128 + tn * 64;
      bf16_t* dst = p.vct + ((size_t)(bh * 128 + tn * 64)) * 1024 + tk * 64;
      tr_tile(src, 512, dst, 1024, (float*)lds);
    }
  }
}

constexpr int GLD = 72;
template <bool A_F32>
DI void gemm_core(f32x4 (&acc)[4][4], const void* Ap, int lda, const bf16_t* Bp, int ldb, int K, char* lds) {
  bf16_t* As = (bf16_t*)lds;
  bf16_t* Bs = (bf16_t*)(lds + 2 * 128 * GLD * 2);
  const int tid = tid_(), wave = __builtin_amdgcn_readfirstlane(tid >> 6), lane = tid & 63;
  const int wm = wave >> 1, wn = wave & 1, l15 = lane & 15, quad = lane >> 4;
  const int nk = K / 64;
  u32x4 ra[4], rb[4];
  auto gload = [&](int kt) {
#pragma unroll
    for (int i = 0; i < 4; ++i) {
      const int c = tid + 256 * i; const int row = c >> 3, c8 = (c & 7) * 8;
      if (!A_F32) ra[i] = *(const u32x4*)((const bf16_t*)Ap + (size_t)row * lda + kt * 64 + c8);
      rb[i] = *(const u32x4*)(Bp + (size_t)row * ldb + kt * 64 + c8);
    }
  };
  auto sstore = [&](int buf, int kt) {
#pragma unroll
    for (int i = 0; i < 4; ++i) {
      const int c = tid + 256 * i; const int row = c >> 3, c8 = (c & 7) * 8;
      if (A_F32) {
        const float* a = (const float*)Ap + (size_t)row * lda + kt * 64 + c8;
        const f32x4 v0 = *(const f32x4*)a, v1 = *(const f32x4*)(a + 4);
        u32x4 t; t[0] = pk2(v0[0], v0[1]); t[1] = pk2(v0[2], v0[3]); t[2] = pk2(v1[0], v1[1]); t[3] = pk2(v1[2], v1[3]);
        *(u32x4*)(As + (buf * 128 + row) * GLD + c8) = t;
      } else {
        *(u32x4*)(As + (buf * 128 + row) * GLD + c8) = ra[i];
      }
      *(u32x4*)(Bs + (buf * 128 + row) * GLD + c8) = rb[i];
    }
  };
  gload(0); sstore(0, 0); __syncthreads();
  for (int kt = 0; kt < nk; ++kt) {
    const int buf = kt & 1;
    if (kt + 1 < nk) gload(kt + 1);
#pragma unroll
    for (int ks = 0; ks < 2; ++ks) {
      bf16x8 af[4], bfr[4];
#pragma unroll
      for (int i = 0; i < 4; ++i) {
        af[i] = *(const bf16x8*)(As + (buf * 128 + wm * 64 + i * 16 + l15) * GLD + ks * 32 + quad * 8);
        bfr[i] = *(const bf16x8*)(Bs + (buf * 128 + wn * 64 + i * 16 + l15) * GLD + ks * 32 + quad * 8);
      }
#pragma unroll
      for (int mi = 0; mi < 4; ++mi)
#pragma unroll
        for (int ni = 0; ni < 4; ++ni) acc[mi][ni] = __builtin_amdgcn_mfma_f32_16x16x32_bf16(bfr[ni], af[mi], acc[mi][ni], 0, 0, 0);
    }
    if (kt + 1 < nk) sstore(buf ^ 1, kt + 1);
    __syncthreads();
  }
}
#define LASP __attribute__((address_space(3)))
DI void gemm_dma(f32x4 (&acc)[4][4], const bf16_t* Ap, int lda, const bf16_t* Bp, int ldb, int K, char* lds) {
  const int tid = tid_(), wave = __builtin_amdgcn_readfirstlane(tid >> 6), lane = tid & 63;
  const int wm = wave >> 1, wn = wave & 1, l15 = lane & 15, quad = lane >> 4;
  const int nk = K / 32;
  const int lrow = lane >> 2, lpc = lane & 3;
  const bf16_t* ga[2]; const bf16_t* gb[2];
#pragma unroll
  for (int i = 0; i < 2; ++i) {
    const int row = (wave * 2 + i) * 16 + lrow; const int q = lpc ^ ((row >> 2) & 3);
    ga[i] = Ap + (size_t)row * lda + q * 8; gb[i] = Bp + (size_t)row * ldb + q * 8;
  }
  auto issue = [&](int kt) {
    char* sb = lds + (kt & 3) * 16384 + wave * 2048;
#pragma unroll
    for (int i = 0; i < 2; ++i) {
      __builtin_amdgcn_global_load_lds((const unsigned*)(ga[i] + kt * 32), (LASP unsigned*)(sb + i * 1024), 16, 0, 0);
      __builtin_amdgcn_global_load_lds((const unsigned*)(gb[i] + kt * 32), (LASP unsigned*)(sb + 8192 + i * 1024), 16, 0, 0);
    }
  };
  const int aoff = (wm * 64 + l15) * 64 + ((quad ^ ((l15 >> 2) & 3)) * 16);
  const int boff = 8192 + (wn * 64 + l15) * 64 + ((quad ^ ((l15 >> 2) & 3)) * 16);
  const unsigned lbase = (unsigned)(size_t)(LASP char*)lds;
  asm volatile("s_waitcnt vmcnt(0)" ::: "memory");
  __builtin_amdgcn_s_barrier();
  asm volatile("" ::: "memory");
  issue(0); issue(1); issue(2);
  for (int kt = 0; kt < nk; ++kt) {
    const int rem = nk - 1 - kt;
    if (rem >= 2) asm volatile("s_waitcnt vmcnt(8)" ::: "memory");
    else if (rem == 1) asm volatile("s_waitcnt vmcnt(4)" ::: "memory");
    else asm volatile("s_waitcnt vmcnt(0)" ::: "memory");
    __builtin_amdgcn_s_barrier();
    asm volatile("" ::: "memory");
    if (kt + 3 < nk) issue(kt + 3);
    const unsigned sa = lbase + (unsigned)((kt & 3) * 16384);
    bf16x8 af[4], bfr[4];
    asm volatile("ds_read_b128 %0, %8\n\tds_read_b128 %1, %8 offset:1024\n\tds_read_b128 %2, %8 offset:2048\n\tds_read_b128 %3, %8 offset:3072\n\t"
                 "ds_read_b128 %4, %9\n\tds_read_b128 %5, %9 offset:1024\n\tds_read_b128 %6, %9 offset:2048\n\tds_read_b128 %7, %9 offset:3072\n\t"
                 "s_waitcnt lgkmcnt(0)"
                 : "=&v"(af[0]), "=&v"(af[1]), "=&v"(af[2]), "=&v"(af[3]), "=&v"(bfr[0]), "=&v"(bfr[1]), "=&v"(bfr[2]), "=&v"(bfr[3])
                 : "v"(sa + (unsigned)aoff), "v"(sa + (unsigned)boff) : "memory");
#pragma unroll
    for (int mi = 0; mi < 4; ++mi)
#pragma unroll
      for (int ni = 0; ni < 4; ++ni) acc[mi][ni] = __builtin_amdgcn_mfma_f32_16x16x32_bf16(bfr[ni], af[mi], acc[mi][ni], 0, 0, 0);
  }
  asm volatile("" ::: "memory");
  __builtin_amdgcn_s_barrier();
  asm volatile("" ::: "memory");
}
DI void zero_acc(f32x4 (&acc)[4][4]) {
#pragma unroll
  for (int i = 0; i < 4; ++i)
#pragma unroll
    for (int j = 0; j < 4; ++j) acc[i][j] = (f32x4){0.f, 0.f, 0.f, 0.f};
}

DI int xcd_tile(int r, int T) {
  const int x = blockIdx.x & 7, j = blockIdx.x >> 3, nb = gridDim.x >> 3;
  if (j >= nb) return -1;
  const int start = (int)(((long)x * T) / 8), end = (int)(((long)(x + 1) * T) / 8);
  const int g = start + r * nb + j;
  return g < end ? g : -1;
}
DI void tile_decode(int g, int nM, int nN, int& mt, int& nt) {
  const int per = 8 * nN; const int grp = g / per, idx = g - grp * per; const int gm0 = grp * 8;
  const int gsz = (nM - gm0) < 8 ? (nM - gm0) : 8;
  nt = idx / gsz; mt = gm0 + (idx - nt * gsz);
}
DI void phase_gemm_in(const Params& p, int l, char* lds) {
  const int tid = tid_(), wave = __builtin_amdgcn_readfirstlane(tid >> 6), lane = tid & 63;
  const int wm = wave >> 1, wn = wave & 1, l15 = lane & 15, quad = lane >> 4;
  const bf16_t* Wt = p.wt_in;
  const int NTN = 49, NTM = 132;
  for (int r = 0;; ++r) {
    const int g = xcd_tile(r, NTN * NTM); if (g < 0) break;
    int mt, nt; tile_decode(g, NTM, NTN, mt, nt);
    f32x4 acc[4][4]; zero_acc(acc);
    gemm_dma(acc, p.hn + (size_t)mt * 128 * DM, DM, Wt + (size_t)nt * 128 * DM, DM, DM, lds);
    const int colb = nt * 128 + wn * 64 + quad * 4;
    int kind;
    if (nt < 13) kind = 0; else if (nt < 17) kind = 1; else if (nt < 21) kind = 2; else if (nt < 25) kind = 3; else if (nt < 29) kind = 4; else if (nt < 33) kind = 1; else kind = 5;
#pragma unroll
    for (int mi = 0; mi < 4; ++mi) {
      const int R = mt * 128 + wm * 64 + mi * 16 + l15;
      const bool isp = R < MP; const int rs = R - MP;
      bf16_t* zrow = p.z + (size_t)R * NZ;
      if (kind == 0) {
        const bool last = isp ? ((R & 4095) == 4095) : ((rs & 63) == 63);
        float* so = isp ? p.out + O_SP + (size_t)(l * 4 + (R >> 12)) * SHC : p.out + O_SS + (size_t)(l * 8 + (rs >> 6)) * SHC;
#pragma unroll
        for (int ni = 0; ni < 4; ++ni) {
          const int c = colb + ni * 16; const f32x4 v = acc[mi][ni];
          u32x2 o; o[0] = pk2(v[0], v[1]); o[1] = pk2(v[2], v[3]); *(u32x2*)(zrow + c) = o;
          if (last) *(f32x4*)(so + c) = v;
        }
      } else if (kind == 1 || kind == 5) {
#pragma unroll
        for (int ni = 0; ni < 4; ++ni) {
          const int c = colb + ni * 16; f32x4 v = acc[mi][ni];
#pragma unroll
          for (int e = 0; e < 4; ++e) v[e] = (kind == 1) ? siluf_(v[e]) : sigmoidf_(v[e]);
          u32x2 o; o[0] = pk2(v[0], v[1]); o[1] = pk2(v[2], v[3]); *(u32x2*)(zrow + c) = o;
        }
      } else if (kind == 2 || kind == 3) {
        float ss = 0.f;
#pragma unroll
        for (int ni = 0; ni < 4; ++ni) { const f32x4 v = acc[mi][ni]; ss += v[0] * v[0] + v[1] * v[1] + v[2] * v[2] + v[3] * v[3]; }
        ss += __shfl_xor(ss, 16); ss += __shfl_xor(ss, 32);
        const float rstd = rsqrtf(ss * (1.0f / 64.0f) + 1e-6f);
        const float* g = (kind == 2 ? p.qng : p.kng) + l * 64;
        float* ko = isp ? p.out + O_KP + ((size_t)l * MP + R) * 512 : p.out + O_KS + ((size_t)l * MS + rs) * 512;
#pragma unroll
        for (int ni = 0; ni < 4; ++ni) {
          const int c = colb + ni * 16; const int d = ni * 16 + quad * 4;
          const f32x4 gv = *(const f32x4*)(g + d); f32x4 v = acc[mi][ni];
#pragma unroll
          for (int e = 0; e < 4; ++e) v[e] = v[e] * rstd * gv[e];
          u32x2 o; o[0] = pk2(v[0], v[1]); o[1] = pk2(v[2], v[3]); *(u32x2*)(zrow + c) = o;
          if (kind == 3) *(f32x4*)(ko + (c - C_K)) = v;
        }
      } else {
        float* vo = isp ? p.out + O_VP + ((size_t)l * MP + R) * 512 : p.out + O_VS + ((size_t)l * MS + rs) * 512;
#pragma unroll
        for (int ni = 0; ni < 4; ++ni) {
          const int cv = colb + ni * 16 - C_V; const f32x4 v = acc[mi][ni];
          *(f32x4*)(vo + cv) = v;
          const int h = cv >> 7, vd = cv & 127;
          if (isp) {
            bf16_t* vt = p.vtp + ((size_t)(((R >> 12) * 4 + h) * 128 + vd)) * 4096 + (R & 4095);
#pragma unroll
            for (int e = 0; e < 4; ++e) vt[(size_t)e * 4096] = (bf16_t)(pk2(v[e], 0.f) & 0xffff);
          } else {
            bf16_t* vt = p.vts + ((size_t)(((rs >> 6) * 4 + h) * 128 + vd)) * 64 + (rs & 63);
#pragma unroll
            for (int e = 0; e < 4; ++e) vt[(size_t)e * 64] = (bf16_t)(pk2(v[e], 0.f) & 0xffff);
          }
        }
      }
    }
  }
}

constexpr int NCH_P = 4096, NCH = 4224;
constexpr int XLD = 40;
DI f32x4 mm16(const bf16_t* Xrow, int ldx, const bf16_t* Yrow, int ldy, int ksteps, f32x4 acc, int l15, int quad) {
  for (int ks = 0; ks < ksteps; ++ks) {
    const bf16x8 a = *(const bf16x8*)(Xrow + l15 * ldx + ks * 32 + quad * 8);
    const bf16x8 b = *(const bf16x8*)(Yrow + l15 * ldy + ks * 32 + quad * 8);
    acc = __builtin_amdgcn_mfma_f32_16x16x32_bf16(a, b, acc, 0, 0, 0);
  }
  return acc;
}
DI void chunk_item(const Params& p, int l, int item, char* lds) {
  const int tid = tid_(), wave = __builtin_amdgcn_readfirstlane(tid >> 6), lane = tid & 63, l15 = lane & 15, quad = lane >> 4;
  const bool isp = item < NCH_P;
  int bh, c;
  if (isp) { bh = item >> 7; c = item & 127; } else { const int j = item - NCH_P; bh = j >> 1; c = j & 1; }
  const int b = bh >> 3, h = bh & 7;
  const int t0 = c * 32; const int row0 = (isp ? b * 4096 : MP + b * 64) + t0;
  float* s_r = (float*)lds;
  float* s_kf = s_r + 2048;
  float* s_v = s_kf + 2048;
  float* s_w = s_v + 2048;
  float* s_kk = s_w + 2048;
  float* s_bb = s_kk + 2048;
  bf16_t* s_wd = (bf16_t*)(lds + 49152);
  bf16_t* s_ad = (bf16_t*)(lds + 53760);
  float* s_bonus = (float*)(lds + 58368);
  float* s_wl = (float*)(lds + 58880);
  float* s_rhs = (float*)lds;
  bf16_t* s_A = (bf16_t*)lds;
  bf16_t* s_Bm = (bf16_t*)(lds + 4608);
  bf16_t* s_Kp = (bf16_t*)(lds + 9216);
  bf16_t* s_R = (bf16_t*)(lds + 16384);
  bf16_t* s_BmT = (bf16_t*)(lds + 20992);
  bf16_t* s_KpT = (bf16_t*)(lds + 26112);
  bf16_t* s_VmT = (bf16_t*)(lds + 31232);
  bf16_t* s_Lak = (bf16_t*)(lds + 36352);
  bf16_t* s_Mrk = (bf16_t*)(lds + 38912);
  bf16_t* s_Mrb = (bf16_t*)(lds + 41472);
  float* s_labT = (float*)(lds + 44032);
  bf16_t* s_XT = (bf16_t*)(lds + 48640);

  const int mat = wave >> 1, tt = wave & 1;
  const bf16_t* wl = (mat == 0 ? p.w2t : p.a2t) + (size_t)(h * 64) * 64;
  const float* mu = p.shift_mu + l * SHC;
  const float* w0 = p.decay_w0 + l * 512 + h * 64;
  const float* a0 = p.iclr_a0 + l * 512 + h * 64;
  const float* kkp = p.k_k + l * 512 + h * 64;
  const float* kap = p.k_a + l * 512 + h * 64;
  const float* rkp = p.r_k + l * 512 + h * 64;
  const float* lb = p.lnx_b + l * 512 + h * 64;
  const int ptok = tid >> 3, pcs = (tid & 7) * 8;
  {
    const int t = t0 + ptok; const size_t row = (size_t)(row0 + ptok);
#pragma unroll
    for (int g = 0; g < 5; ++g) {
      const int zc = (g < 3 ? g * 512 + h * 64 : 1536 + (g - 3) * 64) + pcs;
      const u32x4 cu = *(const u32x4*)(p.z + row * NZ + zc);
      float cur[8], prv[8];
#pragma unroll
      for (int e = 0; e < 4; ++e) { cur[2 * e] = bf_lo(cu[e]); cur[2 * e + 1] = bf_hi(cu[e]); }
      if (t > 0) {
        const u32x4 pu = *(const u32x4*)(p.z + (row - 1) * NZ + zc);
#pragma unroll
        for (int e = 0; e < 4; ++e) { prv[2 * e] = bf_lo(pu[e]); prv[2 * e + 1] = bf_hi(pu[e]); }
      } else if (isp) {
#pragma unroll
        for (int e = 0; e < 8; ++e) prv[e] = 0.f;
      } else {
        const float* sp = p.sshift + (size_t)(l * 8 + b) * SHC + zc;
#pragma unroll
        for (int e = 0; e < 8; ++e) prv[e] = sp[e];
      }
      float zs[8];
#pragma unroll
      for (int e = 0; e < 8; ++e) zs[e] = cur[e] + (prv[e] - cur[e]) * mu[zc + e];
      if (g < 3) {
        float* d = (g == 0 ? s_r : g == 1 ? s_kf : s_v) + ptok * 64 + pcs;
        *(f32x4*)d = (f32x4){zs[0], zs[1], zs[2], zs[3]}; *(f32x4*)(d + 4) = (f32x4){zs[4], zs[5], zs[6], zs[7]};
      } else {
        if (g == 3) {
#pragma unroll
          for (int e = 0; e < 8; ++e) { const float ex = __expf(2.f * zs[e]); zs[e] = 1.f - 2.f * __builtin_amdgcn_rcpf(ex + 1.f); }
        }
        u32x4 o; o[0] = pk2(zs[0], zs[1]); o[1] = pk2(zs[2], zs[3]); o[2] = pk2(zs[4], zs[5]); o[3] = pk2(zs[6], zs[7]);
        *(u32x4*)((g == 3 ? s_wd : s_ad) + ptok * 72 + pcs) = o;
      }
    }
  }
  __syncthreads();
  {
    const bf16_t* At = (mat == 0 ? s_wd : s_ad);
    bf16x8 af[2];
#pragma unroll
    for (int ks = 0; ks < 2; ++ks) af[ks] = *(const bf16x8*)(At + (tt * 16 + l15) * 72 + ks * 32 + quad * 8);
#pragma unroll
    for (int ct = 0; ct < 4; ++ct) {
      f32x4 d = (f32x4){0.f, 0.f, 0.f, 0.f};
#pragma unroll
      for (int ks = 0; ks < 2; ++ks) {
        const bf16x8 wfr = *(const bf16x8*)(wl + (size_t)(ct * 16 + l15) * 64 + ks * 32 + quad * 8);
        d = __builtin_amdgcn_mfma_f32_16x16x32_bf16(wfr, af[ks], d, 0, 0, 0);
      }
      const int ch = ct * 16 + quad * 4; const int tok = tt * 16 + l15;
      f32x4 o;
      if (mat == 0) {
#pragma unroll
        for (int e = 0; e < 4; ++e) {
          const float y = -(w0[ch + e] + d[e]);
          const float sp = fmaxf(y, 0.f) + __logf(1.0f + __expf(-fabsf(y)));
          o[e] = -__expf(-sp - 0.5f);
        }
        *(f32x4*)(s_w + tok * 64 + ch) = o;
      } else {
#pragma unroll
        for (int e = 0; e < 4; ++e) o[e] = sigmoidf_(a0[ch + e] + d[e]);
        *(f32x4*)(s_bb + tok * 64 + ch) = o;
      }
    }
  }
  __syncthreads();
  float r_[8], kf[8], kk[8], bbv[8], v_[8], bon;
  {
    float k_[8], a_[8];
    *(f32x4*)&k_[0] = *(const f32x4*)(s_kf + ptok * 64 + pcs); *(f32x4*)&k_[4] = *(const f32x4*)(s_kf + ptok * 64 + pcs + 4);
    *(f32x4*)&a_[0] = *(const f32x4*)(s_bb + ptok * 64 + pcs); *(f32x4*)&a_[4] = *(const f32x4*)(s_bb + ptok * 64 + pcs + 4);
    *(f32x4*)&r_[0] = *(const f32x4*)(s_r + ptok * 64 + pcs); *(f32x4*)&r_[4] = *(const f32x4*)(s_r + ptok * 64 + pcs + 4);
    *(f32x4*)&v_[0] = *(const f32x4*)(s_v + ptok * 64 + pcs); *(f32x4*)&v_[4] = *(const f32x4*)(s_v + ptok * 64 + pcs + 4);
    float ss = 0.f; bon = 0.f;
#pragma unroll
    for (int e = 0; e < 8; ++e) {
      kk[e] = k_[e] * kkp[pcs + e]; ss += kk[e] * kk[e];
      kf[e] = k_[e] * (1.f + (a_[e] - 1.f) * kap[pcs + e]);
      bon += r_[e] * kf[e] * rkp[pcs + e];
    }
    ss += __shfl_xor(ss, 1); ss += __shfl_xor(ss, 2); ss += __shfl_xor(ss, 4);
    bon += __shfl_xor(bon, 1); bon += __shfl_xor(bon, 2); bon += __shfl_xor(bon, 4);
    const float inv = 1.0f / fmaxf(sqrtf(ss), 1e-12f);
#pragma unroll
    for (int e = 0; e < 8; ++e) { kk[e] *= inv; bbv[e] = kk[e] * a_[e]; }
  }
  if (tid < 64) {
    float run = 0.f;
#pragma unroll 8
    for (int t = 0; t < 32; ++t) { run += s_w[t * 64 + tid]; s_w[t * 64 + tid] = run; }
  }
  __syncthreads();
  {
    float cw[8], cwp[8];
    *(f32x4*)&cw[0] = *(const f32x4*)(s_w + ptok * 64 + pcs); *(f32x4*)&cw[4] = *(const f32x4*)(s_w + ptok * 64 + pcs + 4);
    if (ptok > 0) { *(f32x4*)&cwp[0] = *(const f32x4*)(s_w + (ptok - 1) * 64 + pcs); *(f32x4*)&cwp[4] = *(const f32x4*)(s_w + (ptok - 1) * 64 + pcs + 4); }
    else {
#pragma unroll
      for (int e = 0; e < 8; ++e) cwp[e] = 0.f;
    }
    __syncthreads();
    float av[8], bm[8], kp[8], rr[8];
#pragma unroll
    for (int e = 0; e < 8; ++e) {
      const float ec = __expf(cw[e]), en = __expf(-cw[e]), ep = __expf(cwp[e]);
      av[e] = kk[e] * ep; bm[e] = bbv[e] * en; kp[e] = kf[e] * en; rr[e] = r_[e] * ec;
      if (ptok == 31) s_wl[pcs + e] = ec;
    }
    u32x4 o;
    o[0] = pk2(av[0], av[1]); o[1] = pk2(av[2], av[3]); o[2] = pk2(av[4], av[5]); o[3] = pk2(av[6], av[7]); *(u32x4*)(s_A + ptok * 72 + pcs) = o;
    o[0] = pk2(bm[0], bm[1]); o[1] = pk2(bm[2], bm[3]); o[2] = pk2(bm[4], bm[5]); o[3] = pk2(bm[6], bm[7]); *(u32x4*)(s_Bm + ptok * 72 + pcs) = o;
#pragma unroll
    for (int e = 0; e < 4; ++e) { s_BmT[(pcs + 2 * e) * XLD + ptok] = (bf16_t)(o[e] & 0xffff); s_BmT[(pcs + 2 * e + 1) * XLD + ptok] = (bf16_t)(o[e] >> 16); }
    o[0] = pk2(kp[0], kp[1]); o[1] = pk2(kp[2], kp[3]); o[2] = pk2(kp[4], kp[5]); o[3] = pk2(kp[6], kp[7]); *(u32x4*)(s_Kp + ptok * 72 + pcs) = o;
#pragma unroll
    for (int e = 0; e < 4; ++e) { s_KpT[(pcs + 2 * e) * XLD + ptok] = (bf16_t)(o[e] & 0xffff); s_KpT[(pcs + 2 * e + 1) * XLD + ptok] = (bf16_t)(o[e] >> 16); }
    o[0] = pk2(rr[0], rr[1]); o[1] = pk2(rr[2], rr[3]); o[2] = pk2(rr[4], rr[5]); o[3] = pk2(rr[6], rr[7]); *(u32x4*)(s_R + ptok * 72 + pcs) = o;
    o[0] = pk2(v_[0], v_[1]); o[1] = pk2(v_[2], v_[3]); o[2] = pk2(v_[4], v_[5]); o[3] = pk2(v_[6], v_[7]);
#pragma unroll
    for (int e = 0; e < 4; ++e) { s_VmT[(pcs + 2 * e) * XLD + ptok] = (bf16_t)(o[e] & 0xffff); s_VmT[(pcs + 2 * e + 1) * XLD + ptok] = (bf16_t)(o[e] >> 16); }
    u32x4 ob;
    ob[0] = pk2(lb[pcs + 0] + bon * v_[0], lb[pcs + 1] + bon * v_[1]); ob[1] = pk2(lb[pcs + 2] + bon * v_[2], lb[pcs + 3] + bon * v_[3]);
    ob[2] = pk2(lb[pcs + 4] + bon * v_[4], lb[pcs + 5] + bon * v_[5]); ob[3] = pk2(lb[pcs + 6] + bon * v_[6], lb[pcs + 7] + bon * v_[7]);
    *(u32x4*)(p.cBA + ((size_t)item * 32 + ptok) * 64 + pcs) = ob;
  }
  __syncthreads();
  {
    const bf16_t* X = (wave < 2) ? s_A : s_R;
    const bf16_t* Y = (wave == 0 || wave == 3) ? s_Bm : s_Kp;
    const bool strict = wave < 2;
#pragma unroll
    for (int ti = 0; ti < 2; ++ti)
#pragma unroll
      for (int ii = 0; ii < 2; ++ii) {
        f32x4 d = (f32x4){0.f, 0.f, 0.f, 0.f};
        if (ii <= ti) d = mm16(X + ti * 16 * 72, 72, Y + ii * 16 * 72, 72, 2, d, l15, quad);
        const int i = ii * 16 + l15;
#pragma unroll
        for (int e = 0; e < 4; ++e) {
          const int t = ti * 16 + quad * 4 + e;
          const bool keep = strict ? (i < t) : (i <= t);
          const float val = keep ? d[e] : 0.f;
          if (wave == 0) s_labT[i * 36 + t] = val;
          else { bf16_t* dst = (wave == 1 ? s_Lak : wave == 2 ? s_Mrk : s_Mrb); dst[t * XLD + i] = (bf16_t)(pk2(val, 0.f) & 0xffff); }
        }
      }
  }
  const u32x4 acap = *(const u32x4*)(s_A + ptok * 72 + pcs);
  __syncthreads();
  {
    float* d = s_rhs + ptok * 128 + pcs;
    *(f32x4*)d = (f32x4){bf_lo(acap[0]), bf_hi(acap[0]), bf_lo(acap[1]), bf_hi(acap[1])};
    *(f32x4*)(d + 4) = (f32x4){bf_lo(acap[2]), bf_hi(acap[2]), bf_lo(acap[3]), bf_hi(acap[3])};
  }
  {
    const int ti = wave & 1;
#pragma unroll
    for (int vv = 0; vv < 2; ++vv) {
      const int vi = (wave >> 1) * 2 + vv;
      f32x4 d = (f32x4){0.f, 0.f, 0.f, 0.f};
      d = mm16(s_Lak + ti * 16 * XLD, XLD, s_VmT + vi * 16 * XLD, XLD, 1, d, l15, quad);
#pragma unroll
      for (int e = 0; e < 4; ++e) s_rhs[(ti * 16 + quad * 4 + e) * 128 + 64 + vi * 16 + l15] = d[e];
    }
  }
  __syncthreads();
  if (tid < 128) {
    float x[32];
#pragma unroll
    for (int t = 0; t < 32; ++t) x[t] = s_rhs[t * 128 + tid];
#pragma unroll
    for (int i = 0; i < 31; ++i) {
      const float xi = x[i];
#pragma unroll
      for (int t4 = ((i + 1) >> 2); t4 < 8; ++t4) {
        const f32x4 lv = *(const f32x4*)(s_labT + i * 36 + t4 * 4);
#pragma unroll
        for (int e = 0; e < 4; ++e) { const int t = t4 * 4 + e; if (t > i) x[t] -= lv[e] * xi; }
      }
    }
#pragma unroll
    for (int q4 = 0; q4 < 4; ++q4) {
      u32x4 o; o[0] = pk2(x[8 * q4], x[8 * q4 + 1]); o[1] = pk2(x[8 * q4 + 2], x[8 * q4 + 3]); o[2] = pk2(x[8 * q4 + 4], x[8 * q4 + 5]); o[3] = pk2(x[8 * q4 + 6], x[8 * q4 + 7]);
      *(u32x4*)(s_XT + tid * XLD + q4 * 8) = o;
    }
  }
  __syncthreads();
  {
    const f32x4 z4 = (f32x4){0.f, 0.f, 0.f, 0.f};
    bf16_t* gPT = p.cPT + (size_t)item * 4096;
    const float wl_c = s_wl[wave * 16 + l15];
#pragma unroll
    for (int k1t = 0; k1t < 4; ++k1t) {
      f32x4 d = mm16(s_XT + k1t * 16 * XLD, XLD, s_BmT + wave * 16 * XLD, XLD, 1, z4, l15, quad);
      const int k2 = wave * 16 + l15, k1 = k1t * 16 + quad * 4;
      float o[4];
#pragma unroll
      for (int e = 0; e < 4; ++e) o[e] = ((k1 + e == k2 ? 1.f : 0.f) - d[e]) * wl_c;
      u32x2 ov; ov[0] = pk2(o[0], o[1]); ov[1] = pk2(o[2], o[3]);
      *(u32x2*)(gPT + k2 * 64 + k1) = ov;
    }
    bf16_t* gG = p.cG + (size_t)item * 4096;
#pragma unroll
    for (int k2t = 0; k2t < 4; ++k2t) {
      const f32x4 d1 = mm16(s_KpT + k2t * 16 * XLD, XLD, s_VmT + wave * 16 * XLD, XLD, 1, z4, l15, quad);
      const f32x4 d2 = mm16(s_BmT + k2t * 16 * XLD, XLD, s_XT + (64 + wave * 16) * XLD, XLD, 1, z4, l15, quad);
      const int k2 = k2t * 16 + quad * 4, v = wave * 16 + l15;
      const f32x4 wv = *(const f32x4*)(s_wl + k2);
      u32x2 ov; ov[0] = pk2((d1[0] - d2[0]) * wv[0], (d1[1] - d2[1]) * wv[1]); ov[1] = pk2((d1[2] - d2[2]) * wv[2], (d1[3] - d2[3]) * wv[3]);
      *(u32x2*)(gG + v * 64 + k2) = ov;
    }
    bf16_t* gRT = p.cRT + (size_t)item * 2048;
    bf16_t* gOI = p.cOI + (size_t)item * 2048;
#pragma unroll
    for (int ti = 0; ti < 2; ++ti) {
      const f32x4 d = mm16(s_XT + wave * 16 * XLD, XLD, s_Mrb + ti * 16 * XLD, XLD, 1, z4, l15, quad);
      const int t = ti * 16 + l15, k = wave * 16 + quad * 4;
      const u32x2 rv = *(const u32x2*)(s_R + t * 72 + k);
      u32x2 ov; ov[0] = pk2(bf_lo(rv[0]) - d[0], bf_hi(rv[0]) - d[1]); ov[1] = pk2(bf_lo(rv[1]) - d[2], bf_hi(rv[1]) - d[3]);
      *(u32x2*)(gRT + t * 64 + k) = ov;
      const f32x4 e1 = mm16(s_VmT + wave * 16 * XLD, XLD, s_Mrk + ti * 16 * XLD, XLD, 1, z4, l15, quad);
      const f32x4 e2 = mm16(s_XT + (64 + wave * 16) * XLD, XLD, s_Mrb + ti * 16 * XLD, XLD, 1, z4, l15, quad);
      u32x2 oo; oo[0] = pk2(e1[0] - e2[0], e1[1] - e2[1]); oo[1] = pk2(e1[2] - e2[2], e1[3] - e2[3]);
      *(u32x2*)(gOI + t * 64 + k) = oo;
    }
  }
  __syncthreads();
}

DI void rec_item(const Params& p, int l, int item, char* lds) {
  const int tid = tid_(), wave = __builtin_amdgcn_readfirstlane(tid >> 6), lane = tid & 63, l15 = lane & 15, quad = lane >> 4;
  const bool isp = item < 32;
  const int bh = isp ? item : item - 32; const int b = bh >> 3, h = bh & 7;
  const int nch = isp ? 128 : 2; const int cid0 = isp ? bh * 128 : NCH_P + bh * 2;
  const int row0 = isp ? b * 4096 : MP + b * 64;
  bf16_t* Sb = (bf16_t*)lds;
  {
    const int v = wave * 16 + l15;
    f32x4 a0[4];
    if (isp) {
#pragma unroll
      for (int nk = 0; nk < 4; ++nk) a0[nk] = (f32x4){0.f, 0.f, 0.f, 0.f};
    } else {
      const float* sp = p.swkv + (((size_t)(l * 8 + b) * 8 + h) * 64 + v) * 64;
#pragma unroll
      for (int nk = 0; nk < 4; ++nk) a0[nk] = *(const f32x4*)(sp + nk * 16 + quad * 4);
    }
#pragma unroll
    for (int nk = 0; nk < 4; ++nk) { u32x2 o; o[0] = pk2(a0[nk][0], a0[nk][1]); o[1] = pk2(a0[nk][2], a0[nk][3]); *(u32x2*)(Sb + v * 72 + nk * 16 + quad * 4) = o; }
  }
  __syncthreads();
  const int nmain = nch - 2;
  if (wave < 2) {
    struct PS { bf16x8 pt[4][2]; u32x2 gv[2][4]; };
    auto ldp = [&](PS& s, int c) {
      const int cc = c < nch ? c : nch - 1;
      const size_t cid = (size_t)(cid0 + cc);
      const bf16_t* gPT = p.cPT + cid * 4096; const bf16_t* gG = p.cG + cid * 4096;
#pragma unroll
      for (int nk = 0; nk < 4; ++nk) {
#pragma unroll
        for (int ks = 0; ks < 2; ++ks) s.pt[nk][ks] = *(const bf16x8*)(gPT + (nk * 16 + l15) * 64 + ks * 32 + quad * 8);
#pragma unroll
        for (int v2 = 0; v2 < 2; ++v2) s.gv[v2][nk] = *(const u32x2*)(gG + ((wave * 2 + v2) * 16 + l15) * 64 + nk * 16 + quad * 4);
      }
    };
    f32x4 acc[2][4];
    auto step = [&](PS& s, int c) {
      const int buf = c & 1;
#pragma unroll
      for (int v2 = 0; v2 < 2; ++v2) {
        const int v = (wave * 2 + v2) * 16 + l15;
        bf16x8 sf[2];
#pragma unroll
        for (int ks = 0; ks < 2; ++ks) sf[ks] = *(const bf16x8*)(Sb + (buf * 64 + v) * 72 + ks * 32 + quad * 8);
#pragma unroll
        for (int nk = 0; nk < 4; ++nk) {
          f32x4 a = (f32x4){bf_lo(s.gv[v2][nk][0]), bf_hi(s.gv[v2][nk][0]), bf_lo(s.gv[v2][nk][1]), bf_hi(s.gv[v2][nk][1])};
#pragma unroll
          for (int ks = 0; ks < 2; ++ks) a = __builtin_amdgcn_mfma_f32_16x16x32_bf16(s.pt[nk][ks], sf[ks], a, 0, 0, 0);
          acc[v2][nk] = a;
        }
      }
      ldp(s, c + 3);
#pragma unroll
      for (int v2 = 0; v2 < 2; ++v2) {
        const int v = (wave * 2 + v2) * 16 + l15;
#pragma unroll
        for (int nk = 0; nk < 4; ++nk) { u32x2 ov; ov[0] = pk2(acc[v2][nk][0], acc[v2][nk][1]); ov[1] = pk2(acc[v2][nk][2], acc[v2][nk][3]); *(u32x2*)(Sb + ((buf ^ 1) * 64 + v) * 72 + nk * 16 + quad * 4) = ov; }
      }
      asm volatile("s_waitcnt lgkmcnt(0)" ::: "memory"); __builtin_amdgcn_s_barrier(); asm volatile("" ::: "memory");
    };
    PS s0, s1, s2;
    ldp(s0, 0); ldp(s1, 1); ldp(s2, 2);
#pragma unroll 1
    for (int c = 0; c < nmain; c += 3) { step(s0, c); step(s1, c + 1); step(s2, c + 2); }
    step(s0, nmain); step(s1, nmain + 1);
#pragma unroll
    for (int v2 = 0; v2 < 2; ++v2) {
      const int v = (wave * 2 + v2) * 16 + l15;
      float* so = (isp ? p.out + O_WP + (((size_t)(l * 4 + b) * 8 + h) * 64 + v) * 64 : p.out + O_WS + (((size_t)(l * 8 + b) * 8 + h) * 64 + v) * 64);
#pragma unroll
      for (int nk = 0; nk < 4; ++nk) *(f32x4*)(so + nk * 16 + quad * 4) = acc[v2][nk];
    }
  } else {
    struct CS { bf16x8 rt[2]; u32x2 oi[4], ba[4], gt[4]; };
    const int tok = (wave - 2) * 16 + l15;
    auto ldc = [&](CS& s, int c) {
      const int cc = c < nch ? c : nch - 1;
      const size_t cid = (size_t)(cid0 + cc); const size_t row = (size_t)(row0 + cc * 32 + tok);
#pragma unroll
      for (int ks = 0; ks < 2; ++ks) s.rt[ks] = *(const bf16x8*)(p.cRT + cid * 2048 + tok * 64 + ks * 32 + quad * 8);
#pragma unroll
      for (int vt = 0; vt < 4; ++vt) {
        s.oi[vt] = *(const u32x2*)(p.cOI + cid * 2048 + tok * 64 + vt * 16 + quad * 4);
        s.ba[vt] = *(const u32x2*)(p.cBA + cid * 2048 + tok * 64 + vt * 16 + quad * 4);
        s.gt[vt] = *(const u32x2*)(p.z + row * NZ + C_GR + h * 64 + vt * 16 + quad * 4);
      }
    };
    const float* lg = p.lnx_g + l * 512 + h * 64;
    f32x4 lgv[4];
#pragma unroll
    for (int vt = 0; vt < 4; ++vt) lgv[vt] = *(const f32x4*)(lg + vt * 16 + quad * 4);
    auto step = [&](CS& s, int c) {
      const int buf = c & 1; const size_t row = (size_t)(row0 + c * 32 + tok);
      f32x4 ao[4];
#pragma unroll
      for (int vt = 0; vt < 4; ++vt) {
        f32x4 a = (f32x4){bf_lo(s.oi[vt][0]), bf_hi(s.oi[vt][0]), bf_lo(s.oi[vt][1]), bf_hi(s.oi[vt][1])};
#pragma unroll
        for (int ks = 0; ks < 2; ++ks) {
          const bf16x8 sa = *(const bf16x8*)(Sb + (buf * 64 + vt * 16 + l15) * 72 + ks * 32 + quad * 8);
          a = __builtin_amdgcn_mfma_f32_16x16x32_bf16(sa, s.rt[ks], a, 0, 0, 0);
        }
        ao[vt] = a;
      }
      float sm = 0.f;
#pragma unroll
      for (int vt = 0; vt < 4; ++vt) sm += (ao[vt][0] + ao[vt][1]) + (ao[vt][2] + ao[vt][3]);
      sm += __shfl_xor(sm, 16); sm += __shfl_xor(sm, 32);
      const float mean = sm * (1.0f / 64.0f);
      float vr = 0.f;
#pragma unroll
      for (int vt = 0; vt < 4; ++vt)
#pragma unroll
        for (int e = 0; e < 4; ++e) { const float d = ao[vt][e] - mean; vr += d * d; }
      vr += __shfl_xor(vr, 16); vr += __shfl_xor(vr, 32);
      const float rstd = rsqrtf(vr * (1.0f / 64.0f) + 64e-5f);
#pragma unroll
      for (int vt = 0; vt < 4; ++vt) {
        const int vv = vt * 16 + quad * 4;
        const f32x4 g4 = lgv[vt];
        const float y0 = ((ao[vt][0] - mean) * rstd * g4[0] + bf_lo(s.ba[vt][0])) * bf_lo(s.gt[vt][0]);
        const float y1 = ((ao[vt][1] - mean) * rstd * g4[1] + bf_hi(s.ba[vt][0])) * bf_hi(s.gt[vt][0]);
        const float y2 = ((ao[vt][2] - mean) * rstd * g4[2] + bf_lo(s.ba[vt][1])) * bf_lo(s.gt[vt][1]);
        const float y3 = ((ao[vt][3] - mean) * rstd * g4[3] + bf_hi(s.ba[vt][1])) * bf_hi(s.gt[vt][1]);
        u32x2 ov; ov[0] = pk2(y0, y1); ov[1] = pk2(y2, y3);
        *(u32x2*)(p.o_r + row * 512 + h * 64 + vv) = ov;
      }
      ldc(s, c + 3);
      asm volatile("s_waitcnt lgkmcnt(0)" ::: "memory"); __builtin_amdgcn_s_barrier(); asm volatile("" ::: "memory");
    };
    CS s0, s1, s2;
    ldc(s0, 0); ldc(s1, 1); ldc(s2, 2);
#pragma unroll 1
    for (int c = 0; c < nmain; c += 3) { step(s0, c); step(s1, c + 1); step(s2, c + 2); }
    step(s0, nmain); step(s1, nmain + 1);
  }
  __syncthreads();
}
DI void phase_chunk(const Params& p, int l, char* lds) {
  for (int it = blockIdx.x; it < NCH; it += gridDim.x) chunk_item(p, l, it, lds);
}

constexpr int ALD = 72;
DI void attn_item(const Params& p, int l, int item, char* lds) {
  const int tid = tid_(), wave = __builtin_amdgcn_readfirstlane(tid >> 6), lane = tid & 63;
  const int m = wave & 1, qh = wave >> 1, q = lane & 31, hh = lane >> 5;
  bf16_t* Ks = (bf16_t*)lds;
  bf16_t* Vs = Ks + 2 * 64 * ALD;
  float* xb = (float*)lds;
  bool samp; int b, h, nch, qrow0, qpos0;
  if (item < 32) { samp = true; b = item >> 2; h = item & 3; nch = 17; qrow0 = MP + b * 64; qpos0 = 1024; }
  else { samp = false; const int a = item - 32; const int qc = 63 - (a >> 4); const int bh = a & 15; b = bh >> 2; h = bh & 3; nch = qc + 1; qrow0 = b * 4096 + qc * 64; qpos0 = qc * 64; }
  bf16x8 qf[4];
  {
    const bf16_t* qp = p.z + (size_t)(qrow0 + qh * 32 + q) * NZ + C_Q + h * 128 + m * 64;
#pragma unroll
    for (int ks = 0; ks < 4; ++ks) qf[ks] = *(const bf16x8*)(qp + ks * 16 + hh * 8);
  }
  const float slope = exp2f(-2.0f * (float)(h + 1));
  const float LOG2E = 1.4426950408889634f;
  const float c1 = 0.125f * LOG2E, sl2 = slope * LOG2E;
  const float qposf = (float)(qpos0 + qh * 32 + q);
  f32x16 O[4];
#pragma unroll
  for (int i = 0; i < 4; ++i)
#pragma unroll
    for (int e = 0; e < 16; ++e) O[i][e] = 0.f;
  float mrun = -1e30f, lrun = 0.f;
  u32x4 rk[4], rv[4];
  auto gload = [&](int j) {
    const bf16_t* kb; size_t kld; const bf16_t* vb; size_t vld;
    if (!samp) { kb = p.z + (size_t)(b * 4096 + j * 64) * NZ + C_K + h * 128; kld = NZ; vb = p.vtp + (size_t)((b * 4 + h) * 128) * 4096 + j * 64; vld = 4096; }
    else if (j < 16) { kb = p.kc + (size_t)(b * 1024 + j * 64) * 512 + h * 128; kld = 512; vb = p.vct + (size_t)((b * 4 + h) * 128) * 1024 + j * 64; vld = 1024; }
    else { kb = p.z + (size_t)(MP + b * 64) * NZ + C_K + h * 128; kld = NZ; vb = p.vts + (size_t)((b * 4 + h) * 128) * 64; vld = 64; }
#pragma unroll
    for (int i = 0; i < 4; ++i) {
      const int c = tid + 256 * i;
      const int mm = c >> 9, key = (c >> 3) & 63, d8 = (c & 7) * 8;
      rk[i] = *(const u32x4*)(kb + (size_t)key * kld + mm * 64 + d8);
      const int vd = c >> 3, k8 = (c & 7) * 8;
      rv[i] = *(const u32x4*)(vb + (size_t)vd * vld + k8);
    }
  };
  auto sstore = [&]() {
#pragma unroll
    for (int i = 0; i < 4; ++i) {
      const int c = tid + 256 * i;
      const int mm = c >> 9, key = (c >> 3) & 63, d8 = (c & 7) * 8;
      *(u32x4*)(Ks + (mm * 64 + key) * ALD + d8) = rk[i];
      const int vd = c >> 3, k8 = (c & 7) * 8;
      *(u32x4*)(Vs + vd * ALD + k8) = rv[i];
    }
  };
  gload(0); sstore(); __syncthreads();
  for (int j = 0; j < nch; ++j) {
    if (j + 1 < nch) gload(j + 1);
    f32x16 s[2];
#pragma unroll
    for (int kt = 0; kt < 2; ++kt) {
#pragma unroll
      for (int e = 0; e < 16; ++e) s[kt][e] = 0.f;
#pragma unroll
      for (int ks = 0; ks < 4; ++ks) {
        const bf16x8 kf = *(const bf16x8*)(Ks + (m * 64 + kt * 32 + q) * ALD + ks * 16 + hh * 8);
        s[kt] = __builtin_amdgcn_mfma_f32_32x32x16_bf16(kf, qf[ks], s[kt], 0, 0, 0);
      }
    }
    float mx = -1e30f;
    const float dbase = qposf - (float)(j * 64 + 4 * hh);
#pragma unroll
    for (int kt = 0; kt < 2; ++kt)
#pragma unroll
      for (int e = 0; e < 16; ++e) {
        const float dd = dbase - (float)(kt * 32 + (e & 3) + 8 * (e >> 2));
        const float v = s[kt][e] * c1 - sl2 * fabsf(dd);
        s[kt][e] = v; mx = fmaxf(mx, v);
      }
    mx = fmaxf(mx, __shfl_xor(mx, 32));
    const float mnew = fmaxf(mrun, mx);
    const float alpha = __builtin_amdgcn_exp2f(mrun - mnew);
    const bool resc = mnew > mrun;
    mrun = mnew;
    float ps = 0.f;
#pragma unroll
    for (int kt = 0; kt < 2; ++kt)
#pragma unroll
      for (int e = 0; e < 16; ++e) { const float pe = __builtin_amdgcn_exp2f(s[kt][e] - mnew); s[kt][e] = pe; ps += pe; }
    lrun = lrun * alpha + ps;
    if (__any(resc)) {
#pragma unroll
      for (int i = 0; i < 4; ++i)
#pragma unroll
        for (int e = 0; e < 16; ++e) O[i][e] *= alpha;
    }
#pragma unroll
    for (int kt = 0; kt < 2; ++kt)
#pragma unroll
      for (int sx = 0; sx < 2; ++sx) {
        u32x4 pb;
        pb[0] = pk2(s[kt][8 * sx + 0], s[kt][8 * sx + 1]); pb[1] = pk2(s[kt][8 * sx + 2], s[kt][8 * sx + 3]);
        pb[2] = pk2(s[kt][8 * sx + 4], s[kt][8 * sx + 5]); pb[3] = pk2(s[kt][8 * sx + 6], s[kt][8 * sx + 7]);
        const bf16x8 pf = __builtin_bit_cast(bf16x8, pb);
#pragma unroll
        for (int vt = 0; vt < 4; ++vt) {
          const bf16_t* vp = Vs + (vt * 32 + q) * ALD + kt * 32 + 16 * sx + 4 * hh;
          const s16x4 lo = *(const s16x4*)vp, hi = *(const s16x4*)(vp + 8);
          const bf16x8 vf = __builtin_shufflevector(lo, hi, 0, 1, 2, 3, 4, 5, 6, 7);
          O[vt] = __builtin_amdgcn_mfma_f32_32x32x16_bf16(vf, pf, O[vt], 0, 0, 0);
        }
      }
    __syncthreads();
    if (j + 1 < nch) sstore();
    __syncthreads();
  }
  const float ltot = lrun + __shfl_xor(lrun, 32);
  const float inv = 1.0f / ltot;
#pragma unroll
  for (int i = 0; i < 4; ++i)
#pragma unroll
    for (int e = 0; e < 16; ++e) O[i][e] *= inv;
  if (m == 1) {
#pragma unroll
    for (int vt = 0; vt < 4; ++vt)
#pragma unroll
      for (int e = 0; e < 16; ++e) { const int vd = vt * 32 + (e & 3) + 8 * (e >> 2) + 4 * hh; xb[(qh * 128 + vd) * 32 + q] = O[vt][e]; }
  }
  __syncthreads();
  if (m == 0) {
    float d1 = 0.f, d2 = 0.f;
    for (int i = 0; i < 64; ++i) { d1 += p.lq1[l * 64 + i] * p.lk1[l * 64 + i]; d2 += p.lq2[l * 64 + i] * p.lk2[l * 64 + i]; }
    const float lam_init = 0.8f - 0.6f * __expf(-0.3f * (float)l);
    const float lam = __expf(d1) - __expf(d2) + lam_init;
    float ss = 0.f;
#pragma unroll
    for (int vt = 0; vt < 4; ++vt)
#pragma unroll
      for (int e = 0; e < 16; ++e) {
        const int vd = vt * 32 + (e & 3) + 8 * (e >> 2) + 4 * hh;
        const float o2 = xb[(qh * 128 + vd) * 32 + q];
        const float o = O[vt][e] - lam * o2; O[vt][e] = o; ss += o * o;
      }
    ss += __shfl_xor(ss, 32);
    const float rstd = rsqrtf(ss * (1.0f / 128.0f) + 1e-5f) * (1.0f - lam_init);
    const size_t row = (size_t)(qrow0 + qh * 32 + q);
    const float* sg = p.subln_g + l * 128;
#pragma unroll
    for (int vt = 0; vt < 4; ++vt)
#pragma unroll
      for (int e4 = 0; e4 < 4; ++e4) {
        const int vd = vt * 32 + 8 * e4 + 4 * hh;
        const u32x2 gu = *(const u32x2*)(p.z + row * NZ + C_GA + h * 128 + vd);
        const f32x4 gv = *(const f32x4*)(sg + vd);
        const float y0 = O[vt][4 * e4 + 0] * rstd * gv[0] * bf_lo(gu[0]);
        const float y1 = O[vt][4 * e4 + 1] * rstd * gv[1] * bf_hi(gu[0]);
        const float y2 = O[vt][4 * e4 + 2] * rstd * gv[2] * bf_lo(gu[1]);
        const float y3 = O[vt][4 * e4 + 3] * rstd * gv[3] * bf_hi(gu[1]);
        u32x2 ov; ov[0] = pk2(y0, y1); ov[1] = pk2(y2, y3);
        *(u32x2*)(p.o_a + row * 512 + h * 128 + vd) = ov;
      }
  }
  __syncthreads();
}

DI void phase_mix(const Params& p, int l, char* lds) {
  __shared__ int s_next;
  if (blockIdx.x < 96) rec_item(p, l, blockIdx.x, lds);
  unsigned* ctr = p.bar + XCD_BAR_WORDS + 64 * l;
  for (;;) {
    __syncthreads();
    if (threadIdx.x == 0) s_next = (int)atomicAdd(ctr, 1u);
    __syncthreads();
    const int it = s_next;
    if (it >= 1056) break;
    attn_item(p, l, it, lds);
  }
}

DI void phase_merge(const Params& p, int l, char* lds) {
  const int tid = tid_(), wave = __builtin_amdgcn_readfirstlane(tid >> 6), lane = tid & 63;
  const int wm = wave >> 1, wn = wave & 1, l15 = lane & 15, quad = lane >> 4;
  for (int r = 0;; ++r) {
    const int g = xcd_tile(r, 132 * 8); if (g < 0) break;
    int mt, nt; tile_decode(g, 132, 8, mt, nt);
    f32x4 a1[4][4]; zero_acc(a1);
    gemm_dma(a1, p.o_r + (size_t)mt * 128 * 512, 512, p.wt_brr + (size_t)nt * 128 * 512, 512, 512, lds);
    u32x2 pk[4][4];
#pragma unroll
    for (int mi = 0; mi < 4; ++mi) {
      const int R = mt * 128 + wm * 64 + mi * 16 + l15;
#pragma unroll
      for (int ni = 0; ni < 4; ++ni) {
        const int c = nt * 128 + wn * 64 + ni * 16 + quad * 4;
        const u32x2 g1 = *(const u32x2*)(p.z + (size_t)R * NZ + C_MR + c);
        const f32x4 v1 = a1[mi][ni];
        pk[mi][ni][0] = pk2(bf_lo(g1[0]) * v1[0], bf_hi(g1[0]) * v1[1]);
        pk[mi][ni][1] = pk2(bf_lo(g1[1]) * v1[2], bf_hi(g1[1]) * v1[3]);
      }
    }
    zero_acc(a1);
    gemm_dma(a1, p.o_a + (size_t)mt * 128 * 512, 512, p.wt_bra + (size_t)nt * 128 * 512, 512, 512, lds);
#pragma unroll
    for (int mi = 0; mi < 4; ++mi) {
      const int R = mt * 128 + wm * 64 + mi * 16 + l15;
#pragma unroll
      for (int ni = 0; ni < 4; ++ni) {
        const int c = nt * 128 + wn * 64 + ni * 16 + quad * 4;
        const u32x2 g2 = *(const u32x2*)(p.z + (size_t)R * NZ + C_MA + c);
        const f32x4 v2 = a1[mi][ni]; const u32x2 u1 = pk[mi][ni];
        u32x2 o;
        o[0] = pk2(bf_lo(u1[0]) + bf_lo(g2[0]) * v2[0], bf_hi(u1[0]) + bf_hi(g2[0]) * v2[1]);
        o[1] = pk2(bf_lo(u1[1]) + bf_lo(g2[1]) * v2[2], bf_hi(u1[1]) + bf_hi(g2[1]) * v2[3]);
        *(u32x2*)(p.hn + (size_t)R * DM + c) = o;
      }
    }
  }
}
DI void phase_out(const Params& p, int l, char* lds) {
  const int tid = tid_(), wave = __builtin_amdgcn_readfirstlane(tid >> 6), lane = tid & 63;
  const int wm = wave >> 1, wn = wave & 1, l15 = lane & 15, quad = lane >> 4;
  for (int r = 0;; ++r) {
    const int g = xcd_tile(r, 132 * 8); if (g < 0) break;
    int mt, nt; tile_decode(g, 132, 8, mt, nt);
    f32x4 acc[4][4]; zero_acc(acc);
    gemm_dma(acc, p.hn + (size_t)mt * 128 * DM, DM, p.wt_out + (size_t)nt * 128 * DM, DM, DM, lds);
#pragma unroll
    for (int mi = 0; mi < 4; ++mi) {
      const int R = mt * 128 + wm * 64 + mi * 16 + l15;
      const float* xr = x_row(p, l, R);
#pragma unroll
      for (int ni = 0; ni < 4; ++ni) {
        const int c = nt * 128 + wn * 64 + ni * 16 + quad * 4;
        const f32x4 xv = *(const f32x4*)(xr + c);
        *(f32x4*)(p.out + (size_t)R * DM + c) = xv + acc[mi][ni];
      }
    }
  }
}
DI void phase_ple(const Params& p, int l, char* lds) {
  const int tid = tid_(), wave = __builtin_amdgcn_readfirstlane(tid >> 6), lane = tid & 63;
  const int wm = wave >> 1, wn = wave & 1, l15 = lane & 15, quad = lane >> 4;
  for (int r = 0;; ++r) {
    const int g = xcd_tile(r, 132 * 8); if (g < 0) break;
    int mt, nt; tile_decode(g, 132, 8, mt, nt);
    f32x4 a1[4][4]; zero_acc(a1);
    gemm_dma(a1, p.hn + (size_t)mt * 128 * DM, DM, p.wt_gate + (size_t)nt * 128 * DM, DM, DM, lds);
    u32x2 pk[4][4];
#pragma unroll
    for (int mi = 0; mi < 4; ++mi)
#pragma unroll
      for (int ni = 0; ni < 4; ++ni) { const f32x4 v = a1[mi][ni]; pk[mi][ni][0] = pk2(sigmoidf_(v[0]), sigmoidf_(v[1])); pk[mi][ni][1] = pk2(sigmoidf_(v[2]), sigmoidf_(v[3])); }
    zero_acc(a1);
    const int r0 = mt * 128;
    const float* pa = r0 < MP ? p.pp + ((size_t)l * MP + r0) * 256 : p.ps + ((size_t)l * MS + (r0 - MP)) * 256;
    gemm_core<true>(a1, pa, 256, p.wt_ple + (size_t)nt * 128 * 256, 256, 256, lds);
#pragma unroll
    for (int mi = 0; mi < 4; ++mi) {
      const int R = mt * 128 + wm * 64 + mi * 16 + l15;
#pragma unroll
      for (int ni = 0; ni < 4; ++ni) {
        const int c = nt * 128 + wn * 64 + ni * 16 + quad * 4;
        float* xo = p.out + (size_t)R * DM + c;
        const f32x4 xv = *(const f32x4*)xo; const f32x4 e = a1[mi][ni]; const u32x2 g = pk[mi][ni];
        f32x4 o;
        o[0] = xv[0] + e[0] * bf_lo(g[0]); o[1] = xv[1] + e[1] * bf_hi(g[0]);
        o[2] = xv[2] + e[2] * bf_lo(g[1]); o[3] = xv[3] + e[3] * bf_hi(g[1]);
        *(f32x4*)xo = o;
      }
    }
  }
}


#define XB_TMO      128
#define XB_XCNT(j)  (256  + 64 * (j))
#define XB_XSUB(j)  (1280 + 64 * (j))
#define XB_XGEN(j)  (2304 + 64 * (j))
#define XB_TOP      3328
#define XB_TOPGEN   3392
#define XB_SPIN_CAP (1u << 18)
#define LAS __attribute__((address_space(3)))
DI unsigned xb_ld(unsigned* p)              { return __hip_atomic_load(p, __ATOMIC_RELAXED, __HIP_MEMORY_SCOPE_AGENT); }
DI unsigned xb_add(unsigned* p, unsigned v) { return __hip_atomic_fetch_add(p, v, __ATOMIC_RELAXED, __HIP_MEMORY_SCOPE_AGENT); }
DI unsigned xb_xcc_id() { return (unsigned)__builtin_amdgcn_s_getreg((3 << 11) | 20) & 0xFu; }
#define XB_SPIN(cond, bar) do { unsigned _sp = 0; while (cond) { __builtin_amdgcn_s_sleep(1); \
    if ((++_sp & 255u) == 0u) { if (xb_ld(&(bar)[XB_TMO])) break; if (_sp > XB_SPIN_CAP) { atomicAdd(&(bar)[XB_TMO], 1u); break; } } } } while (0)
struct XcdBarrier { unsigned* bar; unsigned x; volatile LAS unsigned* st; };
DI XcdBarrier xcd_barrier_post(unsigned* bar, volatile LAS unsigned* st) {
  XcdBarrier b; b.bar = bar; b.x = xb_xcc_id(); b.st = st;
  if (threadIdx.x == 0) (void)xb_add(&bar[XB_XCNT(b.x)], 1u);
  return b;
}
DI void xcd_barrier_complete(unsigned* bar, unsigned x, unsigned& nloc, unsigned& nx) {
  const unsigned G = gridDim.x * gridDim.y * gridDim.z;
  unsigned sum, cnt, mine, sp = 0u;
  for (;;) {
    sum = 0u; cnt = 0u; mine = 0u;
#pragma unroll
    for (unsigned j = 0; j < 16; ++j) { const unsigned c = xb_ld(&bar[XB_XCNT(j)]); sum += c; cnt += (c > 0u) ? 1u : 0u; mine = (j == x) ? c : mine; }
    if (sum == G) break;
    __builtin_amdgcn_s_sleep(1);
    if ((++sp & 255u) == 0u) { if (xb_ld(&bar[XB_TMO])) break; if (sp > XB_SPIN_CAP) { atomicAdd(&bar[XB_TMO], 1u); break; } }
  }
  nloc = mine > 0u ? mine : 1u; nx = cnt > 0u ? cnt : 1u;
}
DI void xcd_barrier(const XcdBarrier& b) {
  asm volatile("s_waitcnt vmcnt(0)" ::: "memory");
  __syncthreads();
  if (threadIdx.x == 0) {
    unsigned* bar = b.bar;
    __builtin_amdgcn_s_waitcnt(0);
    unsigned nloc = b.st[0], nx = b.st[1];
    if (nloc == 0u) { xcd_barrier_complete(bar, b.x, nloc, nx); b.st[0] = nloc; b.st[1] = nx; }
    const unsigned old = xb_add(&bar[XB_XSUB(b.x)], 1u);
    const unsigned gen = old / nloc;
    if (old + 1u == (gen + 1u) * nloc) {
      __builtin_amdgcn_fence(__ATOMIC_RELEASE, "agent");
      asm volatile("s_waitcnt vmcnt(0)" ::: "memory");
      const unsigned og = xb_add(&bar[XB_TOP], 1u);
      const unsigned tg = og / nx;
      if (og + 1u == (tg + 1u) * nx) xb_add(&bar[XB_TOPGEN], 1u);
      else XB_SPIN(xb_ld(&bar[XB_TOPGEN]) == tg, bar);
      __builtin_amdgcn_fence(__ATOMIC_ACQUIRE, "agent");
      xb_add(&bar[XB_XGEN(b.x)], 1u);
      asm volatile("s_waitcnt vmcnt(0)" ::: "memory");
    } else {
      XB_SPIN(xb_ld(&bar[XB_XGEN(b.x)]) == gen, bar);
      __builtin_amdgcn_fence(__ATOMIC_ACQUIRE, "agent");
      asm volatile("s_waitcnt vmcnt(0)" ::: "memory");
    }
  }
  __syncthreads();
}
constexpr int LDS_BYTES = 73728;
DI void run_phase(const Params& p, int ph, int l, char* lds) {
  switch (ph) {
    case 1: phase_norm(p, l, true, lds); break;
    case 2: phase_gemm_in(p, l, lds); break;
    case 3: phase_mix(p, l, lds); break;
    case 4: phase_merge(p, l, lds); break;
    case 5: phase_out(p, l, lds); break;
    case 6: phase_norm(p, l, false, lds); break;
    case 7: phase_ple(p, l, lds); break;
    case 8: phase_chunk(p, l, lds); break;
  }
}

#if MEGA
__global__ void __launch_bounds__(256, 2) k_mega(Params p) {
  __shared__ __attribute__((aligned(16))) char lds[LDS_BYTES];
  __shared__ uint4 xb_words;
  cg::grid_group grid = cg::this_grid();
  if (threadIdx.x == 0) xb_words = make_uint4(0u, 0u, 0u, 0u);
  __syncthreads();
  const XcdBarrier xb = xcd_barrier_post(p.bar, (volatile LAS unsigned*)&xb_words);
#pragma unroll 1
  for (int l = 0; l < NL; ++l) {
    phase_norm(p, l, true, lds);
    if (l == 0) grid.sync(); else xcd_barrier(xb);
    phase_gemm_in(p, l, lds); xcd_barrier(xb);
    phase_chunk(p, l, lds); xcd_barrier(xb);
    phase_mix(p, l, lds); xcd_barrier(xb);
    phase_merge(p, l, lds); xcd_barrier(xb);
    phase_out(p, l, lds); xcd_barrier(xb);
    phase_norm(p, l, false, lds); xcd_barrier(xb);
    phase_ple(p, l, lds); if (l + 1 < NL) xcd_barrier(xb);
  }
}
#else
template <int PH>
__global__ void __launch_bounds__(256, 2) k_phase(Params p, int l) {
  __shared__ __attribute__((aligned(16))) char lds[LDS_BYTES];
  run_phase(p, PH, l, lds);
}
#endif

extern "C" void kernel_launch(void* const* d_in, const int* in_sizes, int n_in, void* d_out, int out_size, void* d_ws, size_t ws_size,
                              hipStream_t stream) {
  Params p{};
  const float** pf = (const float**)&p;
  for (int i = 0; i < 33; ++i) pf[i] = (const float*)d_in[i];
  p.out = (float*)d_out;
  char* w = (char*)d_ws; size_t off = 0;
  auto take = [&](size_t bytes) { char* r = w + off; off += (bytes + 255) & ~(size_t)255; return (bf16_t*)r; };
  p.bar = (unsigned*)take((size_t)(XCD_BAR_WORDS + 64 * NL) * 4);
  p.wt_in = take((size_t)NZ * 1024 * 2);
  p.wt_brr = take((size_t)1024 * 512 * 2);
  p.wt_bra = take((size_t)1024 * 512 * 2);
  p.wt_out = take((size_t)1024 * 1024 * 2);
  p.wt_ple = take((size_t)1024 * 256 * 2);
  p.wt_gate = take((size_t)1024 * 1024 * 2);
  p.w2t = take((size_t)512 * 64 * 2);
  p.a2t = take((size_t)512 * 64 * 2);
  p.z = take((size_t)MT * NZ * 2);
  p.vtp = take((size_t)16 * 128 * 4096 * 2);
  p.vts = take((size_t)32 * 128 * 64 * 2);
  p.kc = take((size_t)8 * 1024 * 512 * 2);
  p.vct = take((size_t)32 * 128 * 1024 * 2);
  p.o_r = take((size_t)MT * 512 * 2);
  p.o_a = take((size_t)MT * 512 * 2);
  p.hn = take((size_t)MT * DM * 2);
  p.cPT = p.hn;
  p.cG = take((size_t)NCH * 4096 * 2);
  p.cRT = take((size_t)NCH * 2048 * 2);
  p.cOI = take((size_t)NCH * 2048 * 2);
  p.cBA = take((size_t)NCH * 2048 * 2);
  if (off > ws_size) { fprintf(stderr, "workspace too small: need %zu have %zu\n", off, ws_size); return; }
#if MEGA
  hipMemsetAsync(p.bar, 0, (size_t)(XCD_BAR_WORDS + 64 * NL) * 4, stream);
  static int grid_blocks = 0;
  if (!grid_blocks) {
    int dev = 0, cus = 0, per_cu = 0;
    hipGetDevice(&dev);
    hipDeviceGetAttribute(&cus, hipDeviceAttributeMultiprocessorCount, dev);
    hipOccupancyMaxActiveBlocksPerMultiprocessor(&per_cu, k_mega, 256, 0);
    if (per_cu > 2) per_cu = 2;
    grid_blocks = cus * per_cu;
  }
  void* args[] = {&p};
  hipError_t e = hipLaunchCooperativeKernel((void*)k_mega, dim3(grid_blocks), dim3(256), args, 0, stream);
  if (e != hipSuccess) fprintf(stderr, "cooperative launch failed: %s (grid %d)\n", hipGetErrorString(e), grid_blocks);
#else
  const int G = 512;
  for (int l = 0; l < NL; ++l) {
    k_phase<1><<<G, 256, 0, stream>>>(p, l);
    k_phase<2><<<G, 256, 0, stream>>>(p, l);
    k_phase<8><<<G, 256, 0, stream>>>(p, l);
    k_phase<3><<<G, 256, 0, stream>>>(p, l);
    k_phase<4><<<G, 256, 0, stream>>>(p, l);
    k_phase<5><<<G, 256, 0, stream>>>(p, l);
    k_phase<6><<<G, 256, 0, stream>>>(p, l);
    k_phase<7><<<G, 256, 0, stream>>>(p, l);
  }
#endif
}
```

```cpp
#include <hip/hip_runtime.h>
#include <hip/hip_cooperative_groups.h>
#include <stdint.h>
#include <stdio.h>
namespace cg = cooperative_groups;

#ifndef MEGA
#define MEGA 1
#endif

typedef unsigned short bf16_t;
typedef short bf16x8 __attribute__((ext_vector_type(8)));
typedef short s16x4 __attribute__((ext_vector_type(4)));
typedef float f32x4 __attribute__((ext_vector_type(4)));
typedef float f32x2 __attribute__((ext_vector_type(2)));
typedef float f32x16 __attribute__((ext_vector_type(16)));
typedef unsigned u32x4 __attribute__((ext_vector_type(4)));
typedef unsigned u32x2 __attribute__((ext_vector_type(2)));
typedef __bf16 bfv2 __attribute__((ext_vector_type(2)));

#define DI __device__ __forceinline__
#define XCD_BAR_WORDS 3456
DI int tid_() { int t = threadIdx.x; asm volatile("" : "+v"(t)); return t; }

constexpr int DM = 1024, MP = 16384, MS = 512, MT = 16896, NZ = 6272, NL = 4;
constexpr int C_GR = 1664, C_Q = 2176, C_K = 2688, C_V = 3200, C_GA = 3712, C_MR = 4224, C_MA = 5248;
constexpr int SHC = 1664;
constexpr size_t O_YP = 0, O_YS = 16777216, O_KP = 17301504, O_VP = 50855936, O_WP = 84410368, O_SP = 84934656,
                 O_KS = 84961280, O_VS = 86009856, O_WS = 87058432, O_SS = 88107008;

struct Params {
  const float *xp, *xs, *pp, *ps, *ck, *cv, *swkv, *sshift;
  const float *norm_g, *w_in, *shift_mu, *decay_w0, *decay_w2, *iclr_a0, *iclr_a2, *k_k, *k_a, *r_k, *lnx_g, *lnx_b,
      *qng, *kng, *lq1, *lk1, *lq2, *lk2, *subln_g, *w_br_r, *w_br_a, *w_out, *ple_w, *ple_gate_w, *ple_norm_g;
  float* out;
  bf16_t *wt_in, *wt_brr, *wt_bra, *wt_out, *wt_ple, *wt_gate, *w2t, *a2t;
  bf16_t *hn, *z, *vtp, *vts, *kc, *vct, *o_r, *o_a;
  bf16_t *cPT, *cG, *cRT, *cOI, *cBA;
  unsigned* bar;
};

DI unsigned pk2(float a, float b) { f32x2 v = {a, b}; bfv2 r = __builtin_convertvector(v, bfv2); return __builtin_bit_cast(unsigned, r); }
DI float bf_lo(unsigned u) { return __uint_as_float(u << 16); }
DI float bf_hi(unsigned u) { return __uint_as_float(u & 0xffff0000u); }
DI float bf1(bf16_t u) { return __uint_as_float(((unsigned)u) << 16); }
DI float sigmoidf_(float x) { return __builtin_amdgcn_rcpf(1.0f + __expf(-x)); }
DI float siluf_(float x) { return x * __builtin_amdgcn_rcpf(1.0f + __expf(-x)); }

DI void tr_tile(const float* __restrict__ src, int ld_src, bf16_t* __restrict__ dst, int ld_dst, float* sm) {
  const int tid = tid_();
  const int r = tid >> 4, c4 = (tid & 15) * 4;
#pragma unroll
  for (int i = 0; i < 4; ++i) {
    const int row = r + 16 * i;
    f32x4 v = *(const f32x4*)(src + (size_t)row * ld_src + c4);
    sm[row * 65 + c4 + 0] = v[0]; sm[row * 65 + c4 + 1] = v[1]; sm[row * 65 + c4 + 2] = v[2]; sm[row * 65 + c4 + 3] = v[3];
  }
  __syncthreads();
  const int n = tid >> 2, ks = (tid & 3) * 16;
  u32x4 o0, o1;
  o0[0] = pk2(sm[(ks + 0) * 65 + n], sm[(ks + 1) * 65 + n]);   o0[1] = pk2(sm[(ks + 2) * 65 + n], sm[(ks + 3) * 65 + n]);
  o0[2] = pk2(sm[(ks + 4) * 65 + n], sm[(ks + 5) * 65 + n]);   o0[3] = pk2(sm[(ks + 6) * 65 + n], sm[(ks + 7) * 65 + n]);
  o1[0] = pk2(sm[(ks + 8) * 65 + n], sm[(ks + 9) * 65 + n]);   o1[1] = pk2(sm[(ks + 10) * 65 + n], sm[(ks + 11) * 65 + n]);
  o1[2] = pk2(sm[(ks + 12) * 65 + n], sm[(ks + 13) * 65 + n]); o1[3] = pk2(sm[(ks + 14) * 65 + n], sm[(ks + 15) * 65 + n]);
  *(u32x4*)(dst + (size_t)n * ld_dst + ks) = o0;
  *(u32x4*)(dst + (size_t)n * ld_dst + ks + 8) = o1;
  __syncthreads();
}

constexpr int WCONV_TILES = 1568 + 128 + 128 + 256 + 64 + 256 + 8 + 8;
DI void wconv_tile(const Params& p, int l, int t, float* sm) {
  const float* src; bf16_t* dst; int K, N;
  if (t < 1568) { src = p.w_in + (size_t)l * 1024 * NZ; dst = p.wt_in; K = 1024; N = NZ; }
  else if ((t -= 1568) < 128) { src = p.w_br_r + (size_t)l * 512 * 1024; dst = p.wt_brr; K = 512; N = 1024; }
  else if ((t -= 128) < 128) { src = p.w_br_a + (size_t)l * 512 * 1024; dst = p.wt_bra; K = 512; N = 1024; }
  else if ((t -= 128) < 256) { src = p.w_out + (size_t)l * 1024 * 1024; dst = p.wt_out; K = 1024; N = 1024; }
  else if ((t -= 256) < 64) { src = p.ple_w + (size_t)l * 256 * 1024; dst = p.wt_ple; K = 256; N = 1024; }
  else if ((t -= 64) < 256) { src = p.ple_gate_w + (size_t)l * 1024 * 1024; dst = p.wt_gate; K = 1024; N = 1024; }
  else if ((t -= 256) < 8) { src = p.decay_w2 + (size_t)l * 64 * 512; dst = p.w2t; K = 64; N = 512; }
  else { t -= 8; src = p.iclr_a2 + (size_t)l * 64 * 512; dst = p.a2t; K = 64; N = 512; }
  const int ntn = N / 64; const int tk = t / ntn, tn = t % ntn;
  tr_tile(src + (size_t)(tk * 64) * N + tn * 64, N, dst + (size_t)(tn * 64) * K + tk * 64, K, sm);
}

DI const float* x_row(const Params& p, int l, int r) {
  if (l == 0) return r < MP ? p.xp + (size_t)r * DM : p.xs + (size_t)(r - MP) * DM;
  return p.out + (size_t)r * DM;
}
DI void phase_norm(const Params& p, int l, bool first, char* lds) {
  const int tid = tid_(), wave = __builtin_amdgcn_readfirstlane(tid >> 6), lane = tid & 63;
  const float* g = (first ? p.norm_g : p.ple_norm_g) + l * DM;
  const int n_norm = MT / 4;
  const int n_items = n_norm + (first ? 2048 + WCONV_TILES : 0);
  for (int it = blockIdx.x; it < n_items; it += gridDim.x) {
    if (it < n_norm) {
      const int r = it * 4 + wave;
      const float* x = first ? x_row(p, l, r) : p.out + (size_t)r * DM;
      f32x4 v[4]; float ss = 0.f;
#pragma unroll
      for (int i = 0; i < 4; ++i) { v[i] = *(const f32x4*)(x + lane * 4 + 256 * i); ss += v[i][0] * v[i][0] + v[i][1] * v[i][1] + v[i][2] * v[i][2] + v[i][3] * v[i][3]; }
#pragma unroll
      for (int o = 32; o >= 1; o >>= 1) ss += __shfl_xor(ss, o);
      const float rstd = rsqrtf(ss * (1.0f / 1024.0f) + 1e-6f);
#pragma unroll
      for (int i = 0; i < 4; ++i) {
        const f32x4 gv = *(const f32x4*)(g + lane * 4 + 256 * i);
        u32x2 o; o[0] = pk2(v[i][0] * rstd * gv[0], v[i][1] * rstd * gv[1]); o[1] = pk2(v[i][2] * rstd * gv[2], v[i][3] * rstd * gv[3]);
        *(u32x2*)(p.hn + (size_t)r * DM + lane * 4 + 256 * i) = o;
      }
    } else if (it < n_norm + 1024) {
      const int c = it - n_norm;
      const float* src = p.ck + (size_t)l * 8 * 1024 * 512 + (size_t)c * 4096 + tid * 16;
      bf16_t* dst = p.kc + (size_t)c * 4096 + tid * 16;
      f32x4 a0 = *(const f32x4*)(src), a1 = *(const f32x4*)(src + 4), a2 = *(const f32x4*)(src + 8), a3 = *(const f32x4*)(src + 12);
      u32x4 o0, o1;
      o0[0] = pk2(a0[0], a0[1]); o0[1] = pk2(a0[2], a0[3]); o0[2] = pk2(a1[0], a1[1]); o0[3] = pk2(a1[2], a1[3]);
      o1[0] = pk2(a2[0], a2[1]); o1[1] = pk2(a2[2], a2[3]); o1[2] = pk2(a3[0], a3[1]); o1[3] = pk2(a3[2], a3[3]);
      *(u32x4*)dst = o0; *(u32x4*)(dst + 8) = o1;
    } else if (it >= n_norm + 2048) {
      wconv_tile(p, l, it - n_norm - 2048, (float*)lds);
    } else {
      const int c = it - n_norm - 1024;
      const int bh = c >> 5, tt = c & 31; const int b = bh >> 2, h = bh & 3; const int tk = tt >> 1, tn = tt & 1;
      const float* src = p.cv + (size_t)l * 8 * 1024 * 512 + ((size_t)(b * 1024 + tk * 64)) * 512 + h * 128 + tn * 64;
      bf16_t* dst = p.vct + ((size_t)(bh * 128 + tn * 64)) * 1024 + tk * 64;
      tr_tile(src, 512, dst, 1024, (float*)lds);
    }
  }
}

constexpr int GLD = 72;
template <bool A_F32>
DI void gemm_core(f32x4 (&acc)[4][4], const void* Ap, int lda, const bf16_t* Bp, int ldb, int K, char* lds) {
  bf16_t* As = (bf16_t*)lds;
  bf16_t* Bs = (bf16_t*)(lds + 2 * 128 * GLD * 2);
  const int tid = tid_(), wave = __builtin_amdgcn_readfirstlane(tid >> 6), lane = tid & 63;
  const int wm = wave >> 1, wn = wave & 1, l15 = lane & 15, quad = lane >> 4;
  const int nk = K / 64;
  u32x4 ra[4], rb[4];
  auto gload = [&](int kt) {
#pragma unroll
    for (int i = 0; i < 4; ++i) {
      const int c = tid + 256 * i; const int row = c >> 3, c8 = (c & 7) * 8;
      if (!A_F32) ra[i] = *(const u32x4*)((const bf16_t*)Ap + (size_t)row * lda + kt * 64 + c8);
      rb[i] = *(const u32x4*)(Bp + (size_t)row * ldb + kt * 64 + c8);
    }
  };
  auto sstore = [&](int buf, int kt) {
#pragma unroll
    for (int i = 0; i < 4; ++i) {
      const int c = tid + 256 * i; const int row = c >> 3, c8 = (c & 7) * 8;
      if (A_F32) {
        const float* a = (const float*)Ap + (size_t)row * lda + kt * 64 + c8;
        const f32x4 v0 = *(const f32x4*)a, v1 = *(const f32x4*)(a + 4);
        u32x4 t; t[0] = pk2(v0[0], v0[1]); t[1] = pk2(v0[2], v0[3]); t[2] = pk2(v1[0], v1[1]); t[3] = pk2(v1[2], v1[3]);
        *(u32x4*)(As + (buf * 128 + row) * GLD + c8) = t;
      } else {
        *(u32x4*)(As + (buf * 128 + row) * GLD + c8) = ra[i];
      }
      *(u32x4*)(Bs + (buf * 128 + row) * GLD + c8) = rb[i];
    }
  };
  gload(0); sstore(0, 0); __syncthreads();
  for (int kt = 0; kt < nk; ++kt) {
    const int buf = kt & 1;
    if (kt + 1 < nk) gload(kt + 1);
#pragma unroll
    for (int ks = 0; ks < 2; ++ks) {
      bf16x8 af[4], bfr[4];
#pragma unroll
      for (int i = 0; i < 4; ++i) {
        af[i] = *(const bf16x8*)(As + (buf * 128 + wm * 64 + i * 16 + l15) * GLD + ks * 32 + quad * 8);
        bfr[i] = *(const bf16x8*)(Bs + (buf * 128 + wn * 64 + i * 16 + l15) * GLD + ks * 32 + quad * 8);
      }
#pragma unroll
      for (int mi = 0; mi < 4; ++mi)
#pragma unroll
        for (int ni = 0; ni < 4; ++ni) acc[mi][ni] = __builtin_amdgcn_mfma_f32_16x16x32_bf16(bfr[ni], af[mi], acc[mi][ni], 0, 0, 0);
    }
    if (kt + 1 < nk) sstore(buf ^ 1, kt + 1);
    __syncthreads();
  }
}
#define LASP __attribute__((address_space(3)))
DI void gemm_dma(f32x4 (&acc)[4][4], const bf16_t* Ap, int lda, const bf16_t* Bp, int ldb, int K, char* lds) {
  const int tid = tid_(), wave = __builtin_amdgcn_readfirstlane(tid >> 6), lane = tid & 63;
  const int wm = wave >> 1, wn = wave & 1, l15 = lane & 15, quad = lane >> 4;
  const int nk = K / 64;
  const int lrow = lane >> 3, lpc = lane & 7;
  const bf16_t* ga[4]; const bf16_t* gb[4];
#pragma unroll
  for (int i = 0; i < 4; ++i) {
    const int row = (wave * 4 + i) * 8 + lrow; const int q = lpc ^ (row & 7);
    ga[i] = Ap + (size_t)row * lda + q * 8; gb[i] = Bp + (size_t)row * ldb + q * 8;
  }
  auto issue = [&](int kt) {
    char* sb = lds + (kt & 1) * 32768 + wave * 4096;
#pragma unroll
    for (int i = 0; i < 4; ++i) {
      __builtin_amdgcn_global_load_lds((const unsigned*)(ga[i] + kt * 64), (LASP unsigned*)(sb + i * 1024), 16, 0, 0);
      __builtin_amdgcn_global_load_lds((const unsigned*)(gb[i] + kt * 64), (LASP unsigned*)(sb + 16384 + i * 1024), 16, 0, 0);
    }
  };
  const int sw = l15 & 7;
  const unsigned lbase = (unsigned)(size_t)(LASP char*)lds;
  const unsigned a0 = (unsigned)((wm * 64 + l15) * 128 + ((quad ^ sw) * 16)), a1 = (unsigned)((wm * 64 + l15) * 128 + (((4 + quad) ^ sw) * 16));
  const unsigned b0 = 16384u + (unsigned)((wn * 64 + l15) * 128 + ((quad ^ sw) * 16)), b1 = 16384u + (unsigned)((wn * 64 + l15) * 128 + (((4 + quad) ^ sw) * 16));
  asm volatile("s_waitcnt vmcnt(0)" ::: "memory");
  __builtin_amdgcn_s_barrier();
  asm volatile("" ::: "memory");
  issue(0);
  for (int kt = 0; kt < nk; ++kt) {
    asm volatile("s_waitcnt vmcnt(0)" ::: "memory");
    __builtin_amdgcn_s_barrier();
    asm volatile("" ::: "memory");
    if (kt + 1 < nk) issue(kt + 1);
    const unsigned sa = lbase + (unsigned)((kt & 1) * 32768);
    bf16x8 af[4], bfr[4], ag[4], bg[4];
    asm volatile("ds_read_b128 %0, %8\n\tds_read_b128 %1, %8 offset:2048\n\tds_read_b128 %2, %8 offset:4096\n\tds_read_b128 %3, %8 offset:6144\n\t"
                 "ds_read_b128 %4, %9\n\tds_read_b128 %5, %9 offset:2048\n\tds_read_b128 %6, %9 offset:4096\n\tds_read_b128 %7, %9 offset:6144"
                 : "=&v"(af[0]), "=&v"(af[1]), "=&v"(af[2]), "=&v"(af[3]), "=&v"(bfr[0]), "=&v"(bfr[1]), "=&v"(bfr[2]), "=&v"(bfr[3])
                 : "v"(sa + a0), "v"(sa + b0) : "memory");
    asm volatile("ds_read_b128 %0, %16\n\tds_read_b128 %1, %16 offset:2048\n\tds_read_b128 %2, %16 offset:4096\n\tds_read_b128 %3, %16 offset:6144\n\t"
                 "ds_read_b128 %4, %17\n\tds_read_b128 %5, %17 offset:2048\n\tds_read_b128 %6, %17 offset:4096\n\tds_read_b128 %7, %17 offset:6144\n\t"
                 "s_waitcnt lgkmcnt(8)"
                 : "=&v"(ag[0]), "=&v"(ag[1]), "=&v"(ag[2]), "=&v"(ag[3]), "=&v"(bg[0]), "=&v"(bg[1]), "=&v"(bg[2]), "=&v"(bg[3]),
                   "+v"(af[0]), "+v"(af[1]), "+v"(af[2]), "+v"(af[3]), "+v"(bfr[0]), "+v"(bfr[1]), "+v"(bfr[2]), "+v"(bfr[3])
                 : "v"(sa + a1), "v"(sa + b1) : "memory");
#pragma unroll
    for (int mi = 0; mi < 4; ++mi)
#pragma unroll
      for (int ni = 0; ni < 4; ++ni) acc[mi][ni] = __builtin_amdgcn_mfma_f32_16x16x32_bf16(bfr[ni], af[mi], acc[mi][ni], 0, 0, 0);
    asm volatile("s_waitcnt lgkmcnt(0)" : "+v"(ag[0]), "+v"(ag[1]), "+v"(ag[2]), "+v"(ag[3]), "+v"(bg[0]), "+v"(bg[1]), "+v"(bg[2]), "+v"(bg[3]) :: "memory");
#pragma unroll
    for (int mi = 0; mi < 4; ++mi)
#pragma unroll
      for (int ni = 0; ni < 4; ++ni) acc[mi][ni] = __builtin_amdgcn_mfma_f32_16x16x32_bf16(bg[ni], ag[mi], acc[mi][ni], 0, 0, 0);
  }
  asm volatile("" ::: "memory");
  __builtin_amdgcn_s_barrier();
  asm volatile("" ::: "memory");
}
DI void zero_acc(f32x4 (&acc)[4][4]) {
#pragma unroll
  for (int i = 0; i < 4; ++i)
#pragma unroll
    for (int j = 0; j < 4; ++j) acc[i][j] = (f32x4){0.f, 0.f, 0.f, 0.f};
}

DI int xcd_tile(int r, int T) {
  const int x = blockIdx.x & 7, j = blockIdx.x >> 3, nb = gridDim.x >> 3;
  if (j >= nb) return -1;
  const int start = (int)(((long)x * T) / 8), end = (int)(((long)(x + 1) * T) / 8);
  const int g = start + r * nb + j;
  return g < end ? g : -1;
}
DI void tile_decode(int g, int nM, int nN, int& mt, int& nt) {
  const int per = 8 * nN; const int grp = g / per, idx = g - grp * per; const int gm0 = grp * 8;
  const int gsz = (nM - gm0) < 8 ? (nM - gm0) : 8;
  nt = idx / gsz; mt = gm0 + (idx - nt * gsz);
}
DI void phase_gemm_in(const Params& p, int l, char* lds) {
  const int tid = tid_(), wave = __builtin_amdgcn_readfirstlane(tid >> 6), lane = tid & 63;
  const int wm = wave >> 1, wn = wave & 1, l15 = lane & 15, quad = lane >> 4;
  const bf16_t* Wt = p.wt_in;
  const int NTN = 49, NTM = 132;
  for (int r = 0;; ++r) {
    const int g = xcd_tile(r, NTN * NTM); if (g < 0) break;
    int mt, nt; tile_decode(g, NTM, NTN, mt, nt);
    f32x4 acc[4][4]; zero_acc(acc);
    gemm_dma(acc, p.hn + (size_t)mt * 128 * DM, DM, Wt + (size_t)nt * 128 * DM, DM, DM, lds);
    const int colb = nt * 128 + wn * 64 + quad * 4;
    int kind;
    if (nt < 13) kind = 0; else if (nt < 17) kind = 1; else if (nt < 21) kind = 2; else if (nt < 25) kind = 3; else if (nt < 29) kind = 4; else if (nt < 33) kind = 1; else kind = 5;
#pragma unroll
    for (int mi = 0; mi < 4; ++mi) {
      const int R = mt * 128 + wm * 64 + mi * 16 + l15;
      const bool isp = R < MP; const int rs = R - MP;
      bf16_t* zrow = p.z + (size_t)R * NZ;
      if (kind == 0) {
        const bool last = isp ? ((R & 4095) == 4095) : ((rs & 63) == 63);
        float* so = isp ? p.out + O_SP + (size_t)(l * 4 + (R >> 12)) * SHC : p.out + O_SS + (size_t)(l * 8 + (rs >> 6)) * SHC;
#pragma unroll
        for (int ni = 0; ni < 4; ++ni) {
          const int c = colb + ni * 16; const f32x4 v = acc[mi][ni];
          u32x2 o; o[0] = pk2(v[0], v[1]); o[1] = pk2(v[2], v[3]); *(u32x2*)(zrow + c) = o;
          if (last) *(f32x4*)(so + c) = v;
        }
      } else if (kind == 1 || kind == 5) {
#pragma unroll
        for (int ni = 0; ni < 4; ++ni) {
          const int c = colb + ni * 16; f32x4 v = acc[mi][ni];
#pragma unroll
          for (int e = 0; e < 4; ++e) v[e] = (kind == 1) ? siluf_(v[e]) : sigmoidf_(v[e]);
          u32x2 o; o[0] = pk2(v[0], v[1]); o[1] = pk2(v[2], v[3]); *(u32x2*)(zrow + c) = o;
        }
      } else if (kind == 2 || kind == 3) {
        float ss = 0.f;
#pragma unroll
        for (int ni = 0; ni < 4; ++ni) { const f32x4 v = acc[mi][ni]; ss += v[0] * v[0] + v[1] * v[1] + v[2] * v[2] + v[3] * v[3]; }
        ss += __shfl_xor(ss, 16); ss += __shfl_xor(ss, 32);
        const float rstd = rsqrtf(ss * (1.0f / 64.0f) + 1e-6f);
        const float* g = (kind == 2 ? p.qng : p.kng) + l * 64;
        float* ko = isp ? p.out + O_KP + ((size_t)l * MP + R) * 512 : p.out + O_KS + ((size_t)l * MS + rs) * 512;
#pragma unroll
        for (int ni = 0; ni < 4; ++ni) {
          const int c = colb + ni * 16; const int d = ni * 16 + quad * 4;
          const f32x4 gv = *(const f32x4*)(g + d); f32x4 v = acc[mi][ni];
#pragma unroll
          for (int e = 0; e < 4; ++e) v[e] = v[e] * rstd * gv[e];
          u32x2 o; o[0] = pk2(v[0], v[1]); o[1] = pk2(v[2], v[3]); *(u32x2*)(zrow + c) = o;
          if (kind == 3) *(f32x4*)(ko + (c - C_K)) = v;
        }
      } else {
        float* vo = isp ? p.out + O_VP + ((size_t)l * MP + R) * 512 : p.out + O_VS + ((size_t)l * MS + rs) * 512;
#pragma unroll
        for (int ni = 0; ni < 4; ++ni) {
          const int cv = colb + ni * 16 - C_V; const f32x4 v = acc[mi][ni];
          *(f32x4*)(vo + cv) = v;
          const int h = cv >> 7, vd = cv & 127;
          if (isp) {
            bf16_t* vt = p.vtp + ((size_t)(((R >> 12) * 4 + h) * 128 + vd)) * 4096 + (R & 4095);
#pragma unroll
            for (int e = 0; e < 4; ++e) vt[(size_t)e * 4096] = (bf16_t)(pk2(v[e], 0.f) & 0xffff);
          } else {
            bf16_t* vt = p.vts + ((size_t)(((rs >> 6) * 4 + h) * 128 + vd)) * 64 + (rs & 63);
#pragma unroll
            for (int e = 0; e < 4; ++e) vt[(size_t)e * 64] = (bf16_t)(pk2(v[e], 0.f) & 0xffff);
          }
        }
      }
    }
  }
}

constexpr int NCH_P = 4096, NCH = 4224;
constexpr int XLD = 40;
DI f32x4 mm16(const bf16_t* Xrow, int ldx, const bf16_t* Yrow, int ldy, int ksteps, f32x4 acc, int l15, int quad) {
  for (int ks = 0; ks < ksteps; ++ks) {
    const bf16x8 a = *(const bf16x8*)(Xrow + l15 * ldx + ks * 32 + quad * 8);
    const bf16x8 b = *(const bf16x8*)(Yrow + l15 * ldy + ks * 32 + quad * 8);
    acc = __builtin_amdgcn_mfma_f32_16x16x32_bf16(a, b, acc, 0, 0, 0);
  }
  return acc;
}
DI void chunk_item(const Params& p, int l, int item, char* lds) {
  const int tid = tid_(), wave = __builtin_amdgcn_readfirstlane(tid >> 6), lane = tid & 63, l15 = lane & 15, quad = lane >> 4;
  const bool isp = item < NCH_P;
  int bh, c;
  if (isp) { bh = item >> 7; c = item & 127; } else { const int j = item - NCH_P; bh = j >> 1; c = j & 1; }
  const int b = bh >> 3, h = bh & 7;
  const int t0 = c * 32; const int row0 = (isp ? b * 4096 : MP + b * 64) + t0;
  float* s_r = (float*)lds;
  float* s_kf = s_r + 2048;
  float* s_v = s_kf + 2048;
  float* s_w = s_v + 2048;
  float* s_kk = s_w + 2048;
  float* s_bb = s_kk + 2048;
  bf16_t* s_wd = (bf16_t*)(lds + 49152);
  bf16_t* s_ad = (bf16_t*)(lds + 53760);
  float* s_bonus = (float*)(lds + 58368);
  float* s_wl = (float*)(lds + 58880);
  float* s_rhs = (float*)lds;
  bf16_t* s_A = (bf16_t*)lds;
  bf16_t* s_Bm = (bf16_t*)(lds + 4608);
  bf16_t* s_Kp = (bf16_t*)(lds + 9216);
  bf16_t* s_R = (bf16_t*)(lds + 16384);
  bf16_t* s_BmT = (bf16_t*)(lds + 20992);
  bf16_t* s_KpT = (bf16_t*)(lds + 26112);
  bf16_t* s_VmT = (bf16_t*)(lds + 31232);
  bf16_t* s_Lak = (bf16_t*)(lds + 36352);
  bf16_t* s_Mrk = (bf16_t*)(lds + 38912);
  bf16_t* s_Mrb = (bf16_t*)(lds + 41472);
  float* s_labT = (float*)(lds + 44032);
  bf16_t* s_XT = (bf16_t*)(lds + 48640);

  const int mat = wave >> 1, tt = wave & 1;
  const bf16_t* wl = (mat == 0 ? p.w2t : p.a2t) + (size_t)(h * 64) * 64;
  const float* mu = p.shift_mu + l * SHC;
  const float* w0 = p.decay_w0 + l * 512 + h * 64;
  const float* a0 = p.iclr_a0 + l * 512 + h * 64;
  const float* kkp = p.k_k + l * 512 + h * 64;
  const float* kap = p.k_a + l * 512 + h * 64;
  const float* rkp = p.r_k + l * 512 + h * 64;
  const float* lb = p.lnx_b + l * 512 + h * 64;
  const int ptok = tid >> 3, pcs = (tid & 7) * 8;
  {
    const int t = t0 + ptok; const size_t row = (size_t)(row0 + ptok);
#pragma unroll
    for (int g = 0; g < 5; ++g) {
      const int zc = (g < 3 ? g * 512 + h * 64 : 1536 + (g - 3) * 64) + pcs;
      const u32x4 cu = *(const u32x4*)(p.z + row * NZ + zc);
      float cur[8], prv[8];
#pragma unroll
      for (int e = 0; e < 4; ++e) { cur[2 * e] = bf_lo(cu[e]); cur[2 * e + 1] = bf_hi(cu[e]); }
      if (t > 0) {
        const u32x4 pu = *(const u32x4*)(p.z + (row - 1) * NZ + zc);
#pragma unroll
        for (int e = 0; e < 4; ++e) { prv[2 * e] = bf_lo(pu[e]); prv[2 * e + 1] = bf_hi(pu[e]); }
      } else if (isp) {
#pragma unroll
        for (int e = 0; e < 8; ++e) prv[e] = 0.f;
      } else {
        const float* sp = p.sshift + (size_t)(l * 8 + b) * SHC + zc;
#pragma unroll
        for (int e = 0; e < 8; ++e) prv[e] = sp[e];
      }
      float zs[8];
#pragma unroll
      for (int e = 0; e < 8; ++e) zs[e] = cur[e] + (prv[e] - cur[e]) * mu[zc + e];
      if (g < 3) {
        float* d = (g == 0 ? s_r : g == 1 ? s_kf : s_v) + ptok * 64 + pcs;
        *(f32x4*)d = (f32x4){zs[0], zs[1], zs[2], zs[3]}; *(f32x4*)(d + 4) = (f32x4){zs[4], zs[5], zs[6], zs[7]};
      } else {
        if (g == 3) {
#pragma unroll
          for (int e = 0; e < 8; ++e) { const float ex = __expf(2.f * zs[e]); zs[e] = 1.f - 2.f * __builtin_amdgcn_rcpf(ex + 1.f); }
        }
        u32x4 o; o[0] = pk2(zs[0], zs[1]); o[1] = pk2(zs[2], zs[3]); o[2] = pk2(zs[4], zs[5]); o[3] = pk2(zs[6], zs[7]);
        *(u32x4*)((g == 3 ? s_wd : s_ad) + ptok * 72 + pcs) = o;
      }
    }
  }
  __syncthreads();
  {
    const bf16_t* At = (mat == 0 ? s_wd : s_ad);
    bf16x8 af[2];
#pragma unroll
    for (int ks = 0; ks < 2; ++ks) af[ks] = *(const bf16x8*)(At + (tt * 16 + l15) * 72 + ks * 32 + quad * 8);
#pragma unroll
    for (int ct = 0; ct < 4; ++ct) {
      f32x4 d = (f32x4){0.f, 0.f, 0.f, 0.f};
#pragma unroll
      for (int ks = 0; ks < 2; ++ks) {
        const bf16x8 wfr = *(const bf16x8*)(wl + (size_t)(ct * 16 + l15) * 64 + ks * 32 + quad * 8);
        d = __builtin_amdgcn_mfma_f32_16x16x32_bf16(wfr, af[ks], d, 0, 0, 0);
      }
      const int ch = ct * 16 + quad * 4; const int tok = tt * 16 + l15;
      f32x4 o;
      if (mat == 0) {
#pragma unroll
        for (int e = 0; e < 4; ++e) {
          const float y = -(w0[ch + e] + d[e]);
          const float sp = fmaxf(y, 0.f) + __logf(1.0f + __expf(-fabsf(y)));
          o[e] = -__expf(-sp - 0.5f);
        }
        *(f32x4*)(s_w + tok * 64 + ch) = o;
      } else {
#pragma unroll
        for (int e = 0; e < 4; ++e) o[e] = sigmoidf_(a0[ch + e] + d[e]);
        *(f32x4*)(s_bb + tok * 64 + ch) = o;
      }
    }
  }
  __syncthreads();
  float r_[8], kf[8], kk[8], bbv[8], v_[8], bon;
  {
    float k_[8], a_[8];
    *(f32x4*)&k_[0] = *(const f32x4*)(s_kf + ptok * 64 + pcs); *(f32x4*)&k_[4] = *(const f32x4*)(s_kf + ptok * 64 + pcs + 4);
    *(f32x4*)&a_[0] = *(const f32x4*)(s_bb + ptok * 64 + pcs); *(f32x4*)&a_[4] = *(const f32x4*)(s_bb + ptok * 64 + pcs + 4);
    *(f32x4*)&r_[0] = *(const f32x4*)(s_r + ptok * 64 + pcs); *(f32x4*)&r_[4] = *(const f32x4*)(s_r + ptok * 64 + pcs + 4);
    *(f32x4*)&v_[0] = *(const f32x4*)(s_v + ptok * 64 + pcs); *(f32x4*)&v_[4] = *(const f32x4*)(s_v + ptok * 64 + pcs + 4);
    float ss = 0.f; bon = 0.f;
#pragma unroll
    for (int e = 0; e < 8; ++e) {
      kk[e] = k_[e] * kkp[pcs + e]; ss += kk[e] * kk[e];
      kf[e] = k_[e] * (1.f + (a_[e] - 1.f) * kap[pcs + e]);
      bon += r_[e] * kf[e] * rkp[pcs + e];
    }
    ss += __shfl_xor(ss, 1); ss += __shfl_xor(ss, 2); ss += __shfl_xor(ss, 4);
    bon += __shfl_xor(bon, 1); bon += __shfl_xor(bon, 2); bon += __shfl_xor(bon, 4);
    const float inv = 1.0f / fmaxf(sqrtf(ss), 1e-12f);
#pragma unroll
    for (int e = 0; e < 8; ++e) { kk[e] *= inv; bbv[e] = kk[e] * a_[e]; }
  }
  if (tid < 64) {
    float run = 0.f;
#pragma unroll 8
    for (int t = 0; t < 32; ++t) { run += s_w[t * 64 + tid]; s_w[t * 64 + tid] = run; }
  }
  __syncthreads();
  {
    float cw[8], cwp[8];
    *(f32x4*)&cw[0] = *(const f32x4*)(s_w + ptok * 64 + pcs); *(f32x4*)&cw[4] = *(const f32x4*)(s_w + ptok * 64 + pcs + 4);
    if (ptok > 0) { *(f32x4*)&cwp[0] = *(const f32x4*)(s_w + (ptok - 1) * 64 + pcs); *(f32x4*)&cwp[4] = *(const f32x4*)(s_w + (ptok - 1) * 64 + pcs + 4); }
    else {
#pragma unroll
      for (int e = 0; e < 8; ++e) cwp[e] = 0.f;
    }
    __syncthreads();
    float av[8], bm[8], kp[8], rr[8];
#pragma unroll
    for (int e = 0; e < 8; ++e) {
      const float ec = __expf(cw[e]), en = __expf(-cw[e]), ep = __expf(cwp[e]);
      av[e] = kk[e] * ep; bm[e] = bbv[e] * en; kp[e] = kf[e] * en; rr[e] = r_[e] * ec;
      if (ptok == 31) s_wl[pcs + e] = ec;
    }
    u32x4 o;
    o[0] = pk2(av[0], av[1]); o[1] = pk2(av[2], av[3]); o[2] = pk2(av[4], av[5]); o[3] = pk2(av[6], av[7]); *(u32x4*)(s_A + ptok * 72 + pcs) = o;
    o[0] = pk2(bm[0], bm[1]); o[1] = pk2(bm[2], bm[3]); o[2] = pk2(bm[4], bm[5]); o[3] = pk2(bm[6], bm[7]); *(u32x4*)(s_Bm + ptok * 72 + pcs) = o;
#pragma unroll
    for (int e = 0; e < 4; ++e) { s_BmT[(pcs + 2 * e) * XLD + ptok] = (bf16_t)(o[e] & 0xffff); s_BmT[(pcs + 2 * e + 1) * XLD + ptok] = (bf16_t)(o[e] >> 16); }
    o[0] = pk2(kp[0], kp[1]); o[1] = pk2(kp[2], kp[3]); o[2] = pk2(kp[4], kp[5]); o[3] = pk2(kp[6], kp[7]); *(u32x4*)(s_Kp + ptok * 72 + pcs) = o;
#pragma unroll
    for (int e = 0; e < 4; ++e) { s_KpT[(pcs + 2 * e) * XLD + ptok] = (bf16_t)(o[e] & 0xffff); s_KpT[(pcs + 2 * e + 1) * XLD + ptok] = (bf16_t)(o[e] >> 16); }
    o[0] = pk2(rr[0], rr[1]); o[1] = pk2(rr[2], rr[3]); o[2] = pk2(rr[4], rr[5]); o[3] = pk2(rr[6], rr[7]); *(u32x4*)(s_R + ptok * 72 + pcs) = o;
    o[0] = pk2(v_[0], v_[1]); o[1] = pk2(v_[2], v_[3]); o[2] = pk2(v_[4], v_[5]); o[3] = pk2(v_[6], v_[7]);
#pragma unroll
    for (int e = 0; e < 4; ++e) { s_VmT[(pcs + 2 * e) * XLD + ptok] = (bf16_t)(o[e] & 0xffff); s_VmT[(pcs + 2 * e + 1) * XLD + ptok] = (bf16_t)(o[e] >> 16); }
    u32x4 ob;
    ob[0] = pk2(lb[pcs + 0] + bon * v_[0], lb[pcs + 1] + bon * v_[1]); ob[1] = pk2(lb[pcs + 2] + bon * v_[2], lb[pcs + 3] + bon * v_[3]);
    ob[2] = pk2(lb[pcs + 4] + bon * v_[4], lb[pcs + 5] + bon * v_[5]); ob[3] = pk2(lb[pcs + 6] + bon * v_[6], lb[pcs + 7] + bon * v_[7]);
    *(u32x4*)(p.cBA + ((size_t)item * 32 + ptok) * 64 + pcs) = ob;
  }
  __syncthreads();
  {
    const bf16_t* X = (wave < 2) ? s_A : s_R;
    const bf16_t* Y = (wave == 0 || wave == 3) ? s_Bm : s_Kp;
    const bool strict = wave < 2;
#pragma unroll
    for (int ti = 0; ti < 2; ++ti)
#pragma unroll
      for (int ii = 0; ii < 2; ++ii) {
        f32x4 d = (f32x4){0.f, 0.f, 0.f, 0.f};
        if (ii <= ti) d = mm16(X + ti * 16 * 72, 72, Y + ii * 16 * 72, 72, 2, d, l15, quad);
        const int i = ii * 16 + l15;
#pragma unroll
        for (int e = 0; e < 4; ++e) {
          const int t = ti * 16 + quad * 4 + e;
          const bool keep = strict ? (i < t) : (i <= t);
          const float val = keep ? d[e] : 0.f;
          if (wave == 0) s_labT[i * 36 + t] = val;
          else { bf16_t* dst = (wave == 1 ? s_Lak : wave == 2 ? s_Mrk : s_Mrb); dst[t * XLD + i] = (bf16_t)(pk2(val, 0.f) & 0xffff); }
        }
      }
  }
  const u32x4 acap = *(const u32x4*)(s_A + ptok * 72 + pcs);
  __syncthreads();
  {
    float* d = s_rhs + ptok * 128 + pcs;
    *(f32x4*)d = (f32x4){bf_lo(acap[0]), bf_hi(acap[0]), bf_lo(acap[1]), bf_hi(acap[1])};
    *(f32x4*)(d + 4) = (f32x4){bf_lo(acap[2]), bf_hi(acap[2]), bf_lo(acap[3]), bf_hi(acap[3])};
  }
  {
    const int ti = wave & 1;
#pragma unroll
    for (int vv = 0; vv < 2; ++vv) {
      const int vi = (wave >> 1) * 2 + vv;
      f32x4 d = (f32x4){0.f, 0.f, 0.f, 0.f};
      d = mm16(s_Lak + ti * 16 * XLD, XLD, s_VmT + vi * 16 * XLD, XLD, 1, d, l15, quad);
#pragma unroll
      for (int e = 0; e < 4; ++e) s_rhs[(ti * 16 + quad * 4 + e) * 128 + 64 + vi * 16 + l15] = d[e];
    }
  }
  __syncthreads();
  if (tid < 128) {
    float x[32];
#pragma unroll
    for (int t = 0; t < 32; ++t) x[t] = s_rhs[t * 128 + tid];
#pragma unroll
    for (int i = 0; i < 31; ++i) {
      const float xi = x[i];
#pragma unroll
      for (int t4 = ((i + 1) >> 2); t4 < 8; ++t4) {
        const f32x4 lv = *(const f32x4*)(s_labT + i * 36 + t4 * 4);
#pragma unroll
        for (int e = 0; e < 4; ++e) { const int t = t4 * 4 + e; if (t > i) x[t] -= lv[e] * xi; }
      }
    }
#pragma unroll
    for (int q4 = 0; q4 < 4; ++q4) {
      u32x4 o; o[0] = pk2(x[8 * q4], x[8 * q4 + 1]); o[1] = pk2(x[8 * q4 + 2], x[8 * q4 + 3]); o[2] = pk2(x[8 * q4 + 4], x[8 * q4 + 5]); o[3] = pk2(x[8 * q4 + 6], x[8 * q4 + 7]);
      *(u32x4*)(s_XT + tid * XLD + q4 * 8) = o;
    }
  }
  __syncthreads();
  {
    const f32x4 z4 = (f32x4){0.f, 0.f, 0.f, 0.f};
    bf16_t* gPT = p.cPT + (size_t)item * 4096;
    const float wl_c = s_wl[wave * 16 + l15];
#pragma unroll
    for (int k1t = 0; k1t < 4; ++k1t) {
      f32x4 d = mm16(s_XT + k1t * 16 * XLD, XLD, s_BmT + wave * 16 * XLD, XLD, 1, z4, l15, quad);
      const int k2 = wave * 16 + l15, k1 = k1t * 16 + quad * 4;
      float o[4];
#pragma unroll
      for (int e = 0; e < 4; ++e) o[e] = ((k1 + e == k2 ? 1.f : 0.f) - d[e]) * wl_c;
      u32x2 ov; ov[0] = pk2(o[0], o[1]); ov[1] = pk2(o[2], o[3]);
      *(u32x2*)(gPT + k2 * 64 + k1) = ov;
    }
    bf16_t* gG = p.cG + (size_t)item * 4096;
#pragma unroll
    for (int k2t = 0; k2t < 4; ++k2t) {
      const f32x4 d1 = mm16(s_KpT + k2t * 16 * XLD, XLD, s_VmT + wave * 16 * XLD, XLD, 1, z4, l15, quad);
      const f32x4 d2 = mm16(s_BmT + k2t * 16 * XLD, XLD, s_XT + (64 + wave * 16) * XLD, XLD, 1, z4, l15, quad);
      const int k2 = k2t * 16 + quad * 4, v = wave * 16 + l15;
      const f32x4 wv = *(const f32x4*)(s_wl + k2);
      u32x2 ov; ov[0] = pk2((d1[0] - d2[0]) * wv[0], (d1[1] - d2[1]) * wv[1]); ov[1] = pk2((d1[2] - d2[2]) * wv[2], (d1[3] - d2[3]) * wv[3]);
      *(u32x2*)(gG + v * 64 + k2) = ov;
    }
    bf16_t* gRT = p.cRT + (size_t)item * 2048;
    bf16_t* gOI = p.cOI + (size_t)item * 2048;
#pragma unroll
    for (int ti = 0; ti < 2; ++ti) {
      const f32x4 d = mm16(s_XT + wave * 16 * XLD, XLD, s_Mrb + ti * 16 * XLD, XLD, 1, z4, l15, quad);
      const int t = ti * 16 + l15, k = wave * 16 + quad * 4;
      const u32x2 rv = *(const u32x2*)(s_R + t * 72 + k);
      u32x2 ov; ov[0] = pk2(bf_lo(rv[0]) - d[0], bf_hi(rv[0]) - d[1]); ov[1] = pk2(bf_lo(rv[1]) - d[2], bf_hi(rv[1]) - d[3]);
      *(u32x2*)(gRT + t * 64 + k) = ov;
      const f32x4 e1 = mm16(s_VmT + wave * 16 * XLD, XLD, s_Mrk + ti * 16 * XLD, XLD, 1, z4, l15, quad);
      const f32x4 e2 = mm16(s_XT + (64 + wave * 16) * XLD, XLD, s_Mrb + ti * 16 * XLD, XLD, 1, z4, l15, quad);
      u32x2 oo; oo[0] = pk2(e1[0] - e2[0], e1[1] - e2[1]); oo[1] = pk2(e1[2] - e2[2], e1[3] - e2[3]);
      *(u32x2*)(gOI + t * 64 + k) = oo;
    }
  }
  __syncthreads();
}

DI void rec_item(const Params& p, int l, int item, char* lds) {
  const int tid = tid_(), wave = __builtin_amdgcn_readfirstlane(tid >> 6), lane = tid & 63, l15 = lane & 15, quad = lane >> 4;
  const bool isp = item < 32;
  const int bh = isp ? item : item - 32; const int b = bh >> 3, h = bh & 7;
  const int nch = isp ? 128 : 2; const int cid0 = isp ? bh * 128 : NCH_P + bh * 2;
  const int row0 = isp ? b * 4096 : MP + b * 64;
  bf16_t* Sb = (bf16_t*)lds;
  {
    const int v = wave * 16 + l15;
    f32x4 a0[4];
    if (isp) {
#pragma unroll
      for (int nk = 0; nk < 4; ++nk) a0[nk] = (f32x4){0.f, 0.f, 0.f, 0.f};
    } else {
      const float* sp = p.swkv + (((size_t)(l * 8 + b) * 8 + h) * 64 + v) * 64;
#pragma unroll
      for (int nk = 0; nk < 4; ++nk) a0[nk] = *(const f32x4*)(sp + nk * 16 + quad * 4);
    }
#pragma unroll
    for (int nk = 0; nk < 4; ++nk) { u32x2 o; o[0] = pk2(a0[nk][0], a0[nk][1]); o[1] = pk2(a0[nk][2], a0[nk][3]); *(u32x2*)(Sb + v * 72 + nk * 16 + quad * 4) = o; }
  }
  __syncthreads();
  const int nmain = nch - 2;
  if (wave < 2) {
    struct PS { bf16x8 pt[4][2]; u32x2 gv[2][4]; };
    auto ldp = [&](PS& s, int c) {
      const int cc = c < nch ? c : nch - 1;
      const size_t cid = (size_t)(cid0 + cc);
      const bf16_t* gPT = p.cPT + cid * 4096; const bf16_t* gG = p.cG + cid * 4096;
#pragma unroll
      for (int nk = 0; nk < 4; ++nk) {
#pragma unroll
        for (int ks = 0; ks < 2; ++ks) s.pt[nk][ks] = *(const bf16x8*)(gPT + (nk * 16 + l15) * 64 + ks * 32 + quad * 8);
#pragma unroll
        for (int v2 = 0; v2 < 2; ++v2) s.gv[v2][nk] = *(const u32x2*)(gG + ((wave * 2 + v2) * 16 + l15) * 64 + nk * 16 + quad * 4);
      }
    };
    f32x4 acc[2][4];
    auto step = [&](PS& s, int c) {
      const int buf = c & 1;
#pragma unroll
      for (int v2 = 0; v2 < 2; ++v2) {
        const int v = (wave * 2 + v2) * 16 + l15;
        bf16x8 sf[2];
#pragma unroll
        for (int ks = 0; ks < 2; ++ks) sf[ks] = *(const bf16x8*)(Sb + (buf * 64 + v) * 72 + ks * 32 + quad * 8);
#pragma unroll
        for (int nk = 0; nk < 4; ++nk) {
          f32x4 a = (f32x4){bf_lo(s.gv[v2][nk][0]), bf_hi(s.gv[v2][nk][0]), bf_lo(s.gv[v2][nk][1]), bf_hi(s.gv[v2][nk][1])};
#pragma unroll
          for (int ks = 0; ks < 2; ++ks) a = __builtin_amdgcn_mfma_f32_16x16x32_bf16(s.pt[nk][ks], sf[ks], a, 0, 0, 0);
          acc[v2][nk] = a;
        }
      }
      ldp(s, c + 3);
#pragma unroll
      for (int v2 = 0; v2 < 2; ++v2) {
        const int v = (wave * 2 + v2) * 16 + l15;
#pragma unroll
        for (int nk = 0; nk < 4; ++nk) { u32x2 ov; ov[0] = pk2(acc[v2][nk][0], acc[v2][nk][1]); ov[1] = pk2(acc[v2][nk][2], acc[v2][nk][3]); *(u32x2*)(Sb + ((buf ^ 1) * 64 + v) * 72 + nk * 16 + quad * 4) = ov; }
      }
      asm volatile("s_waitcnt lgkmcnt(0)" ::: "memory"); __builtin_amdgcn_s_barrier(); asm volatile("" ::: "memory");
    };
    PS s0, s1, s2;
    ldp(s0, 0); ldp(s1, 1); ldp(s2, 2);
#pragma unroll 1
    for (int c = 0; c < nmain; c += 3) { step(s0, c); step(s1, c + 1); step(s2, c + 2); }
    step(s0, nmain); step(s1, nmain + 1);
#pragma unroll
    for (int v2 = 0; v2 < 2; ++v2) {
      const int v = (wave * 2 + v2) * 16 + l15;
      float* so = (isp ? p.out + O_WP + (((size_t)(l * 4 + b) * 8 + h) * 64 + v) * 64 : p.out + O_WS + (((size_t)(l * 8 + b) * 8 + h) * 64 + v) * 64);
#pragma unroll
      for (int nk = 0; nk < 4; ++nk) *(f32x4*)(so + nk * 16 + quad * 4) = acc[v2][nk];
    }
  } else {
    struct CS { bf16x8 rt[2]; u32x2 oi[4], ba[4], gt[4]; };
    const int tok = (wave - 2) * 16 + l15;
    auto ldc = [&](CS& s, int c) {
      const int cc = c < nch ? c : nch - 1;
      const size_t cid = (size_t)(cid0 + cc); const size_t row = (size_t)(row0 + cc * 32 + tok);
#pragma unroll
      for (int ks = 0; ks < 2; ++ks) s.rt[ks] = *(const bf16x8*)(p.cRT + cid * 2048 + tok * 64 + ks * 32 + quad * 8);
#pragma unroll
      for (int vt = 0; vt < 4; ++vt) {
        s.oi[vt] = *(const u32x2*)(p.cOI + cid * 2048 + tok * 64 + vt * 16 + quad * 4);
        s.ba[vt] = *(const u32x2*)(p.cBA + cid * 2048 + tok * 64 + vt * 16 + quad * 4);
        s.gt[vt] = *(const u32x2*)(p.z + row * NZ + C_GR + h * 64 + vt * 16 + quad * 4);
      }
    };
    const float* lg = p.lnx_g + l * 512 + h * 64;
    f32x4 lgv[4];
#pragma unroll
    for (int vt = 0; vt < 4; ++vt) lgv[vt] = *(const f32x4*)(lg + vt * 16 + quad * 4);
    auto step = [&](CS& s, int c) {
      const int buf = c & 1; const size_t row = (size_t)(row0 + c * 32 + tok);
      f32x4 ao[4];
#pragma unroll
      for (int vt = 0; vt < 4; ++vt) {
        f32x4 a = (f32x4){bf_lo(s.oi[vt][0]), bf_hi(s.oi[vt][0]), bf_lo(s.oi[vt][1]), bf_hi(s.oi[vt][1])};
#pragma unroll
        for (int ks = 0; ks < 2; ++ks) {
          const bf16x8 sa = *(const bf16x8*)(Sb + (buf * 64 + vt * 16 + l15) * 72 + ks * 32 + quad * 8);
          a = __builtin_amdgcn_mfma_f32_16x16x32_bf16(sa, s.rt[ks], a, 0, 0, 0);
        }
        ao[vt] = a;
      }
      float sm = 0.f;
#pragma unroll
      for (int vt = 0; vt < 4; ++vt) sm += (ao[vt][0] + ao[vt][1]) + (ao[vt][2] + ao[vt][3]);
      sm += __shfl_xor(sm, 16); sm += __shfl_xor(sm, 32);
      const float mean = sm * (1.0f / 64.0f);
      float vr = 0.f;
#pragma unroll
      for (int vt = 0; vt < 4; ++vt)
#pragma unroll
        for (int e = 0; e < 4; ++e) { const float d = ao[vt][e] - mean; vr += d * d; }
      vr += __shfl_xor(vr, 16); vr += __shfl_xor(vr, 32);
      const float rstd = rsqrtf(vr * (1.0f / 64.0f) + 64e-5f);
#pragma unroll
      for (int vt = 0; vt < 4; ++vt) {
        const int vv = vt * 16 + quad * 4;
        const f32x4 g4 = lgv[vt];
        const float y0 = ((ao[vt][0] - mean) * rstd * g4[0] + bf_lo(s.ba[vt][0])) * bf_lo(s.gt[vt][0]);
        const float y1 = ((ao[vt][1] - mean) * rstd * g4[1] + bf_hi(s.ba[vt][0])) * bf_hi(s.gt[vt][0]);
        const float y2 = ((ao[vt][2] - mean) * rstd * g4[2] + bf_lo(s.ba[vt][1])) * bf_lo(s.gt[vt][1]);
        const float y3 = ((ao[vt][3] - mean) * rstd * g4[3] + bf_hi(s.ba[vt][1])) * bf_hi(s.gt[vt][1]);
        u32x2 ov; ov[0] = pk2(y0, y1); ov[1] = pk2(y2, y3);
        *(u32x2*)(p.o_r + row * 512 + h * 64 + vv) = ov;
      }
      ldc(s, c + 3);
      asm volatile("s_waitcnt lgkmcnt(0)" ::: "memory"); __builtin_amdgcn_s_barrier(); asm volatile("" ::: "memory");
    };
    CS s0, s1, s2;
    ldc(s0, 0); ldc(s1, 1); ldc(s2, 2);
#pragma unroll 1
    for (int c = 0; c < nmain; c += 3) { step(s0, c); step(s1, c + 1); step(s2, c + 2); }
    step(s0, nmain); step(s1, nmain + 1);
  }
  __syncthreads();
}
DI void phase_chunk(const Params& p, int l, char* lds) {
  for (int it = blockIdx.x; it < NCH; it += gridDim.x) chunk_item(p, l, it, lds);
}

constexpr int ALD = 72;
DI void attn_item(const Params& p, int l, int item, char* lds) {
  const int tid = tid_(), wave = __builtin_amdgcn_readfirstlane(tid >> 6), lane = tid & 63;
  const int m = wave & 1, qh = wave >> 1, q = lane & 31, hh = lane >> 5;
  bf16_t* Ks = (bf16_t*)lds;
  bf16_t* Vs = Ks + 2 * 64 * ALD;
  float* xb = (float*)lds;
  bool samp; int b, h, nch, qrow0, qpos0;
  if (item < 32) { samp = true; b = item >> 2; h = item & 3; nch = 17; qrow0 = MP + b * 64; qpos0 = 1024; }
  else { samp = false; const int a = item - 32; const int qc = 63 - (a >> 4); const int bh = a & 15; b = bh >> 2; h = bh & 3; nch = qc + 1; qrow0 = b * 4096 + qc * 64; qpos0 = qc * 64; }
  bf16x8 qf[4];
  {
    const bf16_t* qp = p.z + (size_t)(qrow0 + qh * 32 + q) * NZ + C_Q + h * 128 + m * 64;
#pragma unroll
    for (int ks = 0; ks < 4; ++ks) qf[ks] = *(const bf16x8*)(qp + ks * 16 + hh * 8);
  }
  const float slope = exp2f(-2.0f * (float)(h + 1));
  const float LOG2E = 1.4426950408889634f;
  const float c1 = 0.125f * LOG2E, sl2 = slope * LOG2E;
  const float qposf = (float)(qpos0 + qh * 32 + q);
  f32x16 O[4];
#pragma unroll
  for (int i = 0; i < 4; ++i)
#pragma unroll
    for (int e = 0; e < 16; ++e) O[i][e] = 0.f;
  float mrun = -1e30f, lrun = 0.f;
  u32x4 rk[4], rv[4];
  auto gload = [&](int j) {
    const bf16_t* kb; size_t kld; const bf16_t* vb; size_t vld;
    if (!samp) { kb = p.z + (size_t)(b * 4096 + j * 64) * NZ + C_K + h * 128; kld = NZ; vb = p.vtp + (size_t)((b * 4 + h) * 128) * 4096 + j * 64; vld = 4096; }
    else if (j < 16) { kb = p.kc + (size_t)(b * 1024 + j * 64) * 512 + h * 128; kld = 512; vb = p.vct + (size_t)((b * 4 + h) * 128) * 1024 + j * 64; vld = 1024; }
    else { kb = p.z + (size_t)(MP + b * 64) * NZ + C_K + h * 128; kld = NZ; vb = p.vts + (size_t)((b * 4 + h) * 128) * 64; vld = 64; }
#pragma unroll
    for (int i = 0; i < 4; ++i) {
      const int c = tid + 256 * i;
      const int mm = c >> 9, key = (c >> 3) & 63, d8 = (c & 7) * 8;
      rk[i] = *(const u32x4*)(kb + (size_t)key * kld + mm * 64 + d8);
      const int vd = c >> 3, k8 = (c & 7) * 8;
      rv[i] = *(const u32x4*)(vb + (size_t)vd * vld + k8);
    }
  };
  auto sstore = [&]() {
#pragma unroll
    for (int i = 0; i < 4; ++i) {
      const int c = tid + 256 * i;
      const int mm = c >> 9, key = (c >> 3) & 63, d8 = (c & 7) * 8;
      *(u32x4*)(Ks + (mm * 64 + key) * ALD + d8) = rk[i];
      const int vd = c >> 3, k8 = (c & 7) * 8;
      *(u32x4*)(Vs + vd * ALD + k8) = rv[i];
    }
  };
  gload(0); sstore(); __syncthreads();
  for (int j = 0; j < nch; ++j) {
    if (j + 1 < nch) gload(j + 1);
    f32x16 s[2];
#pragma unroll
    for (int kt = 0; kt < 2; ++kt) {
#pragma unroll
      for (int e = 0; e < 16; ++e) s[kt][e] = 0.f;
#pragma unroll
      for (int ks = 0; ks < 4; ++ks) {
        const bf16x8 kf = *(const bf16x8*)(Ks + (m * 64 + kt * 32 + q) * ALD + ks * 16 + hh * 8);
        s[kt] = __builtin_amdgcn_mfma_f32_32x32x16_bf16(kf, qf[ks], s[kt], 0, 0, 0);
      }
    }
    float mx = -1e30f;
    const float dbase = qposf - (float)(j * 64 + 4 * hh);
#pragma unroll
    for (int kt = 0; kt < 2; ++kt)
#pragma unroll
      for (int e = 0; e < 16; ++e) {
        const float dd = dbase - (float)(kt * 32 + (e & 3) + 8 * (e >> 2));
        const float v = s[kt][e] * c1 - sl2 * fabsf(dd);
        s[kt][e] = v; mx = fmaxf(mx, v);
      }
    mx = fmaxf(mx, __shfl_xor(mx, 32));
    const float mnew = fmaxf(mrun, mx);
    const float alpha = __builtin_amdgcn_exp2f(mrun - mnew);
    const bool resc = mnew > mrun;
    mrun = mnew;
    float ps = 0.f;
#pragma unroll
    for (int kt = 0; kt < 2; ++kt)
#pragma unroll
      for (int e = 0; e < 16; ++e) { const float pe = __builtin_amdgcn_exp2f(s[kt][e] - mnew); s[kt][e] = pe; ps += pe; }
    lrun = lrun * alpha + ps;
    if (__any(resc)) {
#pragma unroll
      for (int i = 0; i < 4; ++i)
#pragma unroll
        for (int e = 0; e < 16; ++e) O[i][e] *= alpha;
    }
#pragma unroll
    for (int kt = 0; kt < 2; ++kt)
#pragma unroll
      for (int sx = 0; sx < 2; ++sx) {
        u32x4 pb;
        pb[0] = pk2(s[kt][8 * sx + 0], s[kt][8 * sx + 1]); pb[1] = pk2(s[kt][8 * sx + 2], s[kt][8 * sx + 3]);
        pb[2] = pk2(s[kt][8 * sx + 4], s[kt][8 * sx + 5]); pb[3] = pk2(s[kt][8 * sx + 6], s[kt][8 * sx + 7]);
        const bf16x8 pf = __builtin_bit_cast(bf16x8, pb);
#pragma unroll
        for (int vt = 0; vt < 4; ++vt) {
          const bf16_t* vp = Vs + (vt * 32 + q) * ALD + kt * 32 + 16 * sx + 4 * hh;
          const s16x4 lo = *(const s16x4*)vp, hi = *(const s16x4*)(vp + 8);
          const bf16x8 vf = __builtin_shufflevector(lo, hi, 0, 1, 2, 3, 4, 5, 6, 7);
          O[vt] = __builtin_amdgcn_mfma_f32_32x32x16_bf16(vf, pf, O[vt], 0, 0, 0);
        }
      }
    __syncthreads();
    if (j + 1 < nch) sstore();
    __syncthreads();
  }
  const float ltot = lrun + __shfl_xor(lrun, 32);
  const float inv = 1.0f / ltot;
#pragma unroll
  for (int i = 0; i < 4; ++i)
#pragma unroll
    for (int e = 0; e < 16; ++e) O[i][e] *= inv;
  if (m == 1) {
#pragma unroll
    for (int vt = 0; vt < 4; ++vt)
#pragma unroll
      for (int e = 0; e < 16; ++e) { const int vd = vt * 32 + (e & 3) + 8 * (e >> 2) + 4 * hh; xb[(qh * 128 + vd) * 32 + q] = O[vt][e]; }
  }
  __syncthreads();
  if (m == 0) {
    float d1 = 0.f, d2 = 0.f;
    for (int i = 0; i < 64; ++i) { d1 += p.lq1[l * 64 + i] * p.lk1[l * 64 + i]; d2 += p.lq2[l * 64 + i] * p.lk2[l * 64 + i]; }
    const float lam_init = 0.8f - 0.6f * __expf(-0.3f * (float)l);
    const float lam = __expf(d1) - __expf(d2) + lam_init;
    float ss = 0.f;
#pragma unroll
    for (int vt = 0; vt < 4; ++vt)
#pragma unroll
      for (int e = 0; e < 16; ++e) {
        const int vd = vt * 32 + (e & 3) + 8 * (e >> 2) + 4 * hh;
        const float o2 = xb[(qh * 128 + vd) * 32 + q];
        const float o = O[vt][e] - lam * o2; O[vt][e] = o; ss += o * o;
      }
    ss += __shfl_xor(ss, 32);
    const float rstd = rsqrtf(ss * (1.0f / 128.0f) + 1e-5f) * (1.0f - lam_init);
    const size_t row = (size_t)(qrow0 + qh * 32 + q);
    const float* sg = p.subln_g + l * 128;
#pragma unroll
    for (int vt = 0; vt < 4; ++vt)
#pragma unroll
      for (int e4 = 0; e4 < 4; ++e4) {
        const int vd = vt * 32 + 8 * e4 + 4 * hh;
        const u32x2 gu = *(const u32x2*)(p.z + row * NZ + C_GA + h * 128 + vd);
        const f32x4 gv = *(const f32x4*)(sg + vd);
        const float y0 = O[vt][4 * e4 + 0] * rstd * gv[0] * bf_lo(gu[0]);
        const float y1 = O[vt][4 * e4 + 1] * rstd * gv[1] * bf_hi(gu[0]);
        const float y2 = O[vt][4 * e4 + 2] * rstd * gv[2] * bf_lo(gu[1]);
        const float y3 = O[vt][4 * e4 + 3] * rstd * gv[3] * bf_hi(gu[1]);
        u32x2 ov; ov[0] = pk2(y0, y1); ov[1] = pk2(y2, y3);
        *(u32x2*)(p.o_a + row * 512 + h * 128 + vd) = ov;
      }
  }
  __syncthreads();
}

DI void phase_mix(const Params& p, int l, char* lds) {
  __shared__ int s_next;
  if (blockIdx.x < 96) rec_item(p, l, blockIdx.x, lds);
  unsigned* ctr = p.bar + XCD_BAR_WORDS + 64 * l;
  for (;;) {
    __syncthreads();
    if (threadIdx.x == 0) s_next = (int)atomicAdd(ctr, 1u);
    __syncthreads();
    const int it = s_next;
    if (it >= 1056) break;
    attn_item(p, l, it, lds);
  }
}

DI void phase_merge(const Params& p, int l, char* lds) {
  const int tid = tid_(), wave = __builtin_amdgcn_readfirstlane(tid >> 6), lane = tid & 63;
  const int wm = wave >> 1, wn = wave & 1, l15 = lane & 15, quad = lane >> 4;
  for (int r = 0;; ++r) {
    const int g = xcd_tile(r, 132 * 8); if (g < 0) break;
    int mt, nt; tile_decode(g, 132, 8, mt, nt);
    f32x4 a1[4][4]; zero_acc(a1);
    gemm_dma(a1, p.o_r + (size_t)mt * 128 * 512, 512, p.wt_brr + (size_t)nt * 128 * 512, 512, 512, lds);
    u32x2 pk[4][4];
#pragma unroll
    for (int mi = 0; mi < 4; ++mi) {
      const int R = mt * 128 + wm * 64 + mi * 16 + l15;
#pragma unroll
      for (int ni = 0; ni < 4; ++ni) {
        const int c = nt * 128 + wn * 64 + ni * 16 + quad * 4;
        const u32x2 g1 = *(const u32x2*)(p.z + (size_t)R * NZ + C_MR + c);
        const f32x4 v1 = a1[mi][ni];
        pk[mi][ni][0] = pk2(bf_lo(g1[0]) * v1[0], bf_hi(g1[0]) * v1[1]);
        pk[mi][ni][1] = pk2(bf_lo(g1[1]) * v1[2], bf_hi(g1[1]) * v1[3]);
      }
    }
    zero_acc(a1);
    gemm_dma(a1, p.o_a + (size_t)mt * 128 * 512, 512, p.wt_bra + (size_t)nt * 128 * 512, 512, 512, lds);
#pragma unroll
    for (int mi = 0; mi < 4; ++mi) {
      const int R = mt * 128 + wm * 64 + mi * 16 + l15;
#pragma unroll
      for (int ni = 0; ni < 4; ++ni) {
        const int c = nt * 128 + wn * 64 + ni * 16 + quad * 4;
        const u32x2 g2 = *(const u32x2*)(p.z + (size_t)R * NZ + C_MA + c);
        const f32x4 v2 = a1[mi][ni]; const u32x2 u1 = pk[mi][ni];
        u32x2 o;
        o[0] = pk2(bf_lo(u1[0]) + bf_lo(g2[0]) * v2[0], bf_hi(u1[0]) + bf_hi(g2[0]) * v2[1]);
        o[1] = pk2(bf_lo(u1[1]) + bf_lo(g2[1]) * v2[2], bf_hi(u1[1]) + bf_hi(g2[1]) * v2[3]);
        *(u32x2*)(p.hn + (size_t)R * DM + c) = o;
      }
    }
  }
}
DI void phase_out(const Params& p, int l, char* lds) {
  const int tid = tid_(), wave = __builtin_amdgcn_readfirstlane(tid >> 6), lane = tid & 63;
  const int wm = wave >> 1, wn = wave & 1, l15 = lane & 15, quad = lane >> 4;
  for (int r = 0;; ++r) {
    const int g = xcd_tile(r, 132 * 8); if (g < 0) break;
    int mt, nt; tile_decode(g, 132, 8, mt, nt);
    f32x4 acc[4][4]; zero_acc(acc);
    gemm_dma(acc, p.hn + (size_t)mt * 128 * DM, DM, p.wt_out + (size_t)nt * 128 * DM, DM, DM, lds);
#pragma unroll
    for (int mi = 0; mi < 4; ++mi) {
      const int R = mt * 128 + wm * 64 + mi * 16 + l15;
      const float* xr = x_row(p, l, R);
#pragma unroll
      for (int ni = 0; ni < 4; ++ni) {
        const int c = nt * 128 + wn * 64 + ni * 16 + quad * 4;
        const f32x4 xv = *(const f32x4*)(xr + c);
        *(f32x4*)(p.out + (size_t)R * DM + c) = xv + acc[mi][ni];
      }
    }
  }
}
DI void phase_ple(const Params& p, int l, char* lds) {
  const int tid = tid_(), wave = __builtin_amdgcn_readfirstlane(tid >> 6), lane = tid & 63;
  const int wm = wave >> 1, wn = wave & 1, l15 = lane & 15, quad = lane >> 4;
  for (int r = 0;; ++r) {
    const int g = xcd_tile(r, 132 * 8); if (g < 0) break;
    int mt, nt; tile_decode(g, 132, 8, mt, nt);
    f32x4 a1[4][4]; zero_acc(a1);
    gemm_dma(a1, p.hn + (size_t)mt * 128 * DM, DM, p.wt_gate + (size_t)nt * 128 * DM, DM, DM, lds);
    u32x2 pk[4][4];
#pragma unroll
    for (int mi = 0; mi < 4; ++mi)
#pragma unroll
      for (int ni = 0; ni < 4; ++ni) { const f32x4 v = a1[mi][ni]; pk[mi][ni][0] = pk2(sigmoidf_(v[0]), sigmoidf_(v[1])); pk[mi][ni][1] = pk2(sigmoidf_(v[2]), sigmoidf_(v[3])); }
    zero_acc(a1);
    const int r0 = mt * 128;
    const float* pa = r0 < MP ? p.pp + ((size_t)l * MP + r0) * 256 : p.ps + ((size_t)l * MS + (r0 - MP)) * 256;
    gemm_core<true>(a1, pa, 256, p.wt_ple + (size_t)nt * 128 * 256, 256, 256, lds);
#pragma unroll
    for (int mi = 0; mi < 4; ++mi) {
      const int R = mt * 128 + wm * 64 + mi * 16 + l15;
#pragma unroll
      for (int ni = 0; ni < 4; ++ni) {
        const int c = nt * 128 + wn * 64 + ni * 16 + quad * 4;
        float* xo = p.out + (size_t)R * DM + c;
        const f32x4 xv = *(const f32x4*)xo; const f32x4 e = a1[mi][ni]; const u32x2 g = pk[mi][ni];
        f32x4 o;
        o[0] = xv[0] + e[0] * bf_lo(g[0]); o[1] = xv[1] + e[1] * bf_hi(g[0]);
        o[2] = xv[2] + e[2] * bf_lo(g[1]); o[3] = xv[3] + e[3] * bf_hi(g[1]);
        *(f32x4*)xo = o;
      }
    }
  }
}


#define XB_TMO      128
#define XB_XCNT(j)  (256  + 64 * (j))
#define XB_XSUB(j)  (1280 + 64 * (j))
#define XB_XGEN(j)  (2304 + 64 * (j))
#define XB_TOP      3328
#define XB_TOPGEN   3392
#define XB_SPIN_CAP (1u << 18)
#define LAS __attribute__((address_space(3)))
DI unsigned xb_ld(unsigned* p)              { return __hip_atomic_load(p, __ATOMIC_RELAXED, __HIP_MEMORY_SCOPE_AGENT); }
DI unsigned xb_add(unsigned* p, unsigned v) { return __hip_atomic_fetch_add(p, v, __ATOMIC_RELAXED, __HIP_MEMORY_SCOPE_AGENT); }
DI unsigned xb_xcc_id() { return (unsigned)__builtin_amdgcn_s_getreg((3 << 11) | 20) & 0xFu; }
#define XB_SPIN(cond, bar) do { unsigned _sp = 0; while (cond) { __builtin_amdgcn_s_sleep(1); \
    if ((++_sp & 255u) == 0u) { if (xb_ld(&(bar)[XB_TMO])) break; if (_sp > XB_SPIN_CAP) { atomicAdd(&(bar)[XB_TMO], 1u); break; } } } } while (0)
struct XcdBarrier { unsigned* bar; unsigned x; volatile LAS unsigned* st; };
DI XcdBarrier xcd_barrier_post(unsigned* bar, volatile LAS unsigned* st) {
  XcdBarrier b; b.bar = bar; b.x = xb_xcc_id(); b.st = st;
  if (threadIdx.x == 0) (void)xb_add(&bar[XB_XCNT(b.x)], 1u);
  return b;
}
DI void xcd_barrier_complete(unsigned* bar, unsigned x, unsigned& nloc, unsigned& nx) {
  const unsigned G = gridDim.x * gridDim.y * gridDim.z;
  unsigned sum, cnt, mine, sp = 0u;
  for (;;) {
    sum = 0u; cnt = 0u; mine = 0u;
#pragma unroll
    for (unsigned j = 0; j < 16; ++j) { const unsigned c = xb_ld(&bar[XB_XCNT(j)]); sum += c; cnt += (c > 0u) ? 1u : 0u; mine = (j == x) ? c : mine; }
    if (sum == G) break;
    __builtin_amdgcn_s_sleep(1);
    if ((++sp & 255u) == 0u) { if (xb_ld(&bar[XB_TMO])) break; if (sp > XB_SPIN_CAP) { atomicAdd(&bar[XB_TMO], 1u); break; } }
  }
  nloc = mine > 0u ? mine : 1u; nx = cnt > 0u ? cnt : 1u;
}
DI void xcd_barrier(const XcdBarrier& b) {
  asm volatile("s_waitcnt vmcnt(0)" ::: "memory");
  __syncthreads();
  if (threadIdx.x == 0) {
    unsigned* bar = b.bar;
    __builtin_amdgcn_s_waitcnt(0);
    unsigned nloc = b.st[0], nx = b.st[1];
    if (nloc == 0u) { xcd_barrier_complete(bar, b.x, nloc, nx); b.st[0] = nloc; b.st[1] = nx; }
    const unsigned old = xb_add(&bar[XB_XSUB(b.x)], 1u);
    const unsigned gen = old / nloc;
    if (old + 1u == (gen + 1u) * nloc) {
      __builtin_amdgcn_fence(__ATOMIC_RELEASE, "agent");
      asm volatile("s_waitcnt vmcnt(0)" ::: "memory");
      const unsigned og = xb_add(&bar[XB_TOP], 1u);
      const unsigned tg = og / nx;
      if (og + 1u == (tg + 1u) * nx) xb_add(&bar[XB_TOPGEN], 1u);
      else XB_SPIN(xb_ld(&bar[XB_TOPGEN]) == tg, bar);
      __builtin_amdgcn_fence(__ATOMIC_ACQUIRE, "agent");
      xb_add(&bar[XB_XGEN(b.x)], 1u);
      asm volatile("s_waitcnt vmcnt(0)" ::: "memory");
    } else {
      XB_SPIN(xb_ld(&bar[XB_XGEN(b.x)]) == gen, bar);
      __builtin_amdgcn_fence(__ATOMIC_ACQUIRE, "agent");
      asm volatile("s_waitcnt vmcnt(0)" ::: "memory");
    }
  }
  __syncthreads();
}
constexpr int LDS_BYTES = 73728;
DI void run_phase(const Params& p, int ph, int l, char* lds) {
  switch (ph) {
    case 1: phase_norm(p, l, true, lds); break;
    case 2: phase_gemm_in(p, l, lds); break;
    case 3: phase_mix(p, l, lds); break;
    case 4: phase_merge(p, l, lds); break;
    case 5: phase_out(p, l, lds); break;
    case 6: phase_norm(p, l, false, lds); break;
    case 7: phase_ple(p, l, lds); break;
    case 8: phase_chunk(p, l, lds); break;
  }
}

#if MEGA
__global__ void __launch_bounds__(256, 2) k_mega(Params p) {
  __shared__ __attribute__((aligned(16))) char lds[LDS_BYTES];
  __shared__ uint4 xb_words;
  cg::grid_group grid = cg::this_grid();
  if (threadIdx.x == 0) xb_words = make_uint4(0u, 0u, 0u, 0u);
  __syncthreads();
  const XcdBarrier xb = xcd_barrier_post(p.bar, (volatile LAS unsigned*)&xb_words);
#pragma unroll 1
  for (int l = 0; l < NL; ++l) {
    phase_norm(p, l, true, lds);
    if (l == 0) grid.sync(); else xcd_barrier(xb);
    phase_gemm_in(p, l, lds); xcd_barrier(xb);
    phase_chunk(p, l, lds); xcd_barrier(xb);
    phase_mix(p, l, lds); xcd_barrier(xb);
    phase_merge(p, l, lds); xcd_barrier(xb);
    phase_out(p, l, lds); xcd_barrier(xb);
    phase_norm(p, l, false, lds); xcd_barrier(xb);
    phase_ple(p, l, lds); if (l + 1 < NL) xcd_barrier(xb);
  }
}
#else
template <int PH>
__global__ void __launch_bounds__(256, 2) k_phase(Params p, int l) {
  __shared__ __attribute__((aligned(16))) char lds[LDS_BYTES];
  run_phase(p, PH, l, lds);
}
#endif

extern "C" void kernel_launch(void* const* d_in, const int* in_sizes, int n_in, void* d_out, int out_size, void* d_ws, size_t ws_size,
                              hipStream_t stream) {
  Params p{};
  const float** pf = (const float**)&p;
  for (int i = 0; i < 33; ++i) pf[i] = (const float*)d_in[i];
  p.out = (float*)d_out;
  char* w = (char*)d_ws; size_t off = 0;
  auto take = [&](size_t bytes) { char* r = w + off; off += (bytes + 255) & ~(size_t)255; return (bf16_t*)r; };
  p.bar = (unsigned*)take((size_t)(XCD_BAR_WORDS + 64 * NL) * 4);
  p.wt_in = take((size_t)NZ * 1024 * 2);
  p.wt_brr = take((size_t)1024 * 512 * 2);
  p.wt_bra = take((size_t)1024 * 512 * 2);
  p.wt_out = take((size_t)1024 * 1024 * 2);
  p.wt_ple = take((size_t)1024 * 256 * 2);
  p.wt_gate = take((size_t)1024 * 1024 * 2);
  p.w2t = take((size_t)512 * 64 * 2);
  p.a2t = take((size_t)512 * 64 * 2);
  p.z = take((size_t)MT * NZ * 2);
  p.vtp = take((size_t)16 * 128 * 4096 * 2);
  p.vts = take((size_t)32 * 128 * 64 * 2);
  p.kc = take((size_t)8 * 1024 * 512 * 2);
  p.vct = take((size_t)32 * 128 * 1024 * 2);
  p.o_r = take((size_t)MT * 512 * 2);
  p.o_a = take((size_t)MT * 512 * 2);
  p.hn = take((size_t)MT * DM * 2);
  p.cPT = p.hn;
  p.cG = take((size_t)NCH * 4096 * 2);
  p.cRT = take((size_t)NCH * 2048 * 2);
  p.cOI = take((size_t)NCH * 2048 * 2);
  p.cBA = take((size_t)NCH * 2048 * 2);
  if (off > ws_size) { fprintf(stderr, "workspace too small: need %zu have %zu\n", off, ws_size); return; }
#if MEGA
  hipMemsetAsync(p.bar, 0, (size_t)(XCD_BAR_WORDS + 64 * NL) * 4, stream);
  static int grid_blocks = 0;
  if (!grid_blocks) {
    int dev = 0, cus = 0, per_cu = 0;
    hipGetDevice(&dev);
    hipDeviceGetAttribute(&cus, hipDeviceAttributeMultiprocessorCount, dev);
    hipOccupancyMaxActiveBlocksPerMultiprocessor(&per_cu, k_mega, 256, 0);
    if (per_cu > 2) per_cu = 2;
    grid_blocks = cus * per_cu;
  }
  void* args[] = {&p};
  hipError_t e = hipLaunchCooperativeKernel((void*)k_mega, dim3(grid_blocks), dim3(256), args, 0, stream);
  if (e != hipSuccess) fprintf(stderr, "cooperative launch failed: %s (grid %d)\n", hipGetErrorString(e), grid_blocks);
#else
  const int G = 512;
  for (int l = 0; l < NL; ++l) {
    k_phase<1><<<G, 256, 0, stream>>>(p, l);
    k_phase<2><<<G, 256, 0, stream>>>(p, l);
    k_phase<8><<<G, 256, 0, stream>>>(p, l);
    k_phase<3><<<G, 256, 0, stream>>>(p, l);
    k_phase<4><<<G, 256, 0, stream>>>(p, l);
    k_phase<5><<<G, 256, 0, stream>>>(p, l);
    k_phase<6><<<G, 256, 0, stream>>>(p, l);
    k_phase<7><<<G, 256, 0, stream>>>(p, l);
  }
#endif
}
```

```cpp
#include <hip/hip_runtime.h>
#include <hip/hip_cooperative_groups.h>
#include <stdint.h>
#include <stdio.h>
namespace cg = cooperative_groups;

#ifndef MEGA
#define MEGA 1
#endif

typedef unsigned short bf16_t;
typedef short bf16x8 __attribute__((ext_vector_type(8)));
typedef short s16x4 __attribute__((ext_vector_type(4)));
typedef float f32x4 __attribute__((ext_vector_type(4)));
typedef float f32x2 __attribute__((ext_vector_type(2)));
typedef float f32x16 __attribute__((ext_vector_type(16)));
typedef unsigned u32x4 __attribute__((ext_vector_type(4)));
typedef unsigned u32x2 __attribute__((ext_vector_type(2)));
typedef __bf16 bfv2 __attribute__((ext_vector_type(2)));

#define DI __device__ __forceinline__
#define XCD_BAR_WORDS 3456
DI int tid_() { int t = threadIdx.x; asm volatile("" : "+v"(t)); return t; }

constexpr int DM = 1024, MP = 16384, MS = 512, MT = 16896, NZ = 6272, NL = 4;
constexpr int C_GR = 1664, C_Q = 2176, C_K = 2688, C_V = 3200, C_GA = 3712, C_MR = 4224, C_MA = 5248;
constexpr int SHC = 1664;
constexpr size_t O_YP = 0, O_YS = 16777216, O_KP = 17301504, O_VP = 50855936, O_WP = 84410368, O_SP = 84934656,
                 O_KS = 84961280, O_VS = 86009856, O_WS = 87058432, O_SS = 88107008;

struct Params {
  const float *xp, *xs, *pp, *ps, *ck, *cv, *swkv, *sshift;
  const float *norm_g, *w_in, *shift_mu, *decay_w0, *decay_w2, *iclr_a0, *iclr_a2, *k_k, *k_a, *r_k, *lnx_g, *lnx_b,
      *qng, *kng, *lq1, *lk1, *lq2, *lk2, *subln_g, *w_br_r, *w_br_a, *w_out, *ple_w, *ple_gate_w, *ple_norm_g;
  float* out;
  bf16_t *wt_in, *wt_brr, *wt_bra, *wt_out, *wt_ple, *wt_gate, *w2t, *a2t;
  bf16_t *hn, *z, *vtp, *vts, *kc, *vct, *o_r, *o_a;
  bf16_t *cPT, *cG, *cRT, *cOI, *cBA;
  unsigned* bar;
};

DI unsigned pk2(float a, float b) { f32x2 v = {a, b}; bfv2 r = __builtin_convertvector(v, bfv2); return __builtin_bit_cast(unsigned, r); }
DI float bf_lo(unsigned u) { return __uint_as_float(u << 16); }
DI float bf_hi(unsigned u) { return __uint_as_float(u & 0xffff0000u); }
DI float bf1(bf16_t u) { return __uint_as_float(((unsigned)u) << 16); }
DI float sigmoidf_(float x) { return __builtin_amdgcn_rcpf(1.0f + __expf(-x)); }
DI float siluf_(float x) { return x * __builtin_amdgcn_rcpf(1.0f + __expf(-x)); }

DI void tr_tile(const float* __restrict__ src, int ld_src, bf16_t* __restrict__ dst, int ld_dst, float* sm) {
  const int tid = tid_();
  const int r = tid >> 4, c4 = (tid & 15) * 4;
#pragma unroll
  for (int i = 0; i < 4; ++i) {
    const int row = r + 16 * i;
    f32x4 v = *(const f32x4*)(src + (size_t)row * ld_src + c4);
    sm[row * 65 + c4 + 0] = v[0]; sm[row * 65 + c4 + 1] = v[1]; sm[row * 65 + c4 + 2] = v[2]; sm[row * 65 + c4 + 3] = v[3];
  }
  __syncthreads();
  const int n = tid >> 2, ks = (tid & 3) * 16;
  u32x4 o0, o1;
  o0[0] = pk2(sm[(ks + 0) * 65 + n], sm[(ks + 1) * 65 + n]);   o0[1] = pk2(sm[(ks + 2) * 65 + n], sm[(ks + 3) * 65 + n]);
  o0[2] = pk2(sm[(ks + 4) * 65 + n], sm[(ks + 5) * 65 + n]);   o0[3] = pk2(sm[(ks + 6) * 65 + n], sm[(ks + 7) * 65 + n]);
  o1[0] = pk2(sm[(ks + 8) * 65 + n], sm[(ks + 9) * 65 + n]);   o1[1] = pk2(sm[(ks + 10) * 65 + n], sm[(ks + 11) * 65 + n]);
  o1[2] = pk2(sm[(ks + 12) * 65 + n], sm[(ks + 13) * 65 + n]); o1[3] = pk2(sm[(ks + 14) * 65 + n], sm[(ks + 15) * 65 + n]);
  *(u32x4*)(dst + (size_t)n * ld_dst + ks) = o0;
  *(u32x4*)(dst + (size_t)n * ld_dst + ks + 8) = o1;
  __syncthreads();
}

constexpr int WCONV_TILES = 1568 + 128 + 128 + 256 + 64 + 256 + 8 + 8;
DI void wconv_tile(const Params& p, int l, int t, float* sm) {
  const float* src; bf16_t* dst; int K, N;
  if (t < 1568) { src = p.w_in + (size_t)l * 1024 * NZ; dst = p.wt_in; K = 1024; N = NZ; }
  else if ((t -= 1568) < 128) { src = p.w_br_r + (size_t)l * 512 * 1024; dst = p.wt_brr; K = 512; N = 1024; }
  else if ((t -= 128) < 128) { src = p.w_br_a + (size_t)l * 512 * 1024; dst = p.wt_bra; K = 512; N = 1024; }
  else if ((t -= 128) < 256) { src = p.w_out + (size_t)l * 1024 * 1024; dst = p.wt_out; K = 1024; N = 1024; }
  else if ((t -= 256) < 64) { src = p.ple_w + (size_t)l * 256 * 1024; dst = p.wt_ple; K = 256; N = 1024; }
  else if ((t -= 64) < 256) { src = p.ple_gate_w + (size_t)l * 1024 * 1024; dst = p.wt_gate; K = 1024; N = 1024; }
  else if ((t -= 256) < 8) { src = p.decay_w2 + (size_t)l * 64 * 512; dst = p.w2t; K = 64; N = 512; }
  else { t -= 8; src = p.iclr_a2 + (size_t)l * 64 * 512; dst = p.a2t; K = 64; N = 512; }
  const int ntn = N / 64; const int tk = t / ntn, tn = t % ntn;
  tr_tile(src + (size_t)(tk * 64) * N + tn * 64, N, dst + (size_t)(tn * 64) * K + tk * 64, K, sm);
}

DI const float* x_row(const Params& p, int l, int r) {
  if (l == 0) return r < MP ? p.xp + (size_t)r * DM : p.xs + (size_t)(r - MP) * DM;
  return p.out + (size_t)r * DM;
}
DI void phase_norm(const Params& p, int l, bool first, char* lds) {
  const int tid = tid_(), wave = __builtin_amdgcn_readfirstlane(tid >> 6), lane = tid & 63;
  const float* g = (first ? p.norm_g : p.ple_norm_g) + l * DM;
  const int n_norm = MT / 8;
  const int n_items = n_norm + (first ? 2048 + WCONV_TILES : 0);
  for (int it = blockIdx.x; it < n_items; it += gridDim.x) {
    if (it < n_norm) {
      const int r0 = it * 8 + wave * 2;
      f32x4 v[2][4]; float ss[2] = {0.f, 0.f};
#pragma unroll
      for (int k = 0; k < 2; ++k) {
        const float* x = first ? x_row(p, l, r0 + k) : p.out + (size_t)(r0 + k) * DM;
#pragma unroll
        for (int i = 0; i < 4; ++i) v[k][i] = *(const f32x4*)(x + lane * 4 + 256 * i);
      }
      f32x4 gv[4];
#pragma unroll
      for (int i = 0; i < 4; ++i) gv[i] = *(const f32x4*)(g + lane * 4 + 256 * i);
#pragma unroll
      for (int k = 0; k < 2; ++k) {
#pragma unroll
        for (int i = 0; i < 4; ++i) ss[k] += v[k][i][0] * v[k][i][0] + v[k][i][1] * v[k][i][1] + v[k][i][2] * v[k][i][2] + v[k][i][3] * v[k][i][3];
#pragma unroll
        for (int o = 32; o >= 1; o >>= 1) ss[k] += __shfl_xor(ss[k], o);
        const float rstd = rsqrtf(ss[k] * (1.0f / 1024.0f) + 1e-6f);
#pragma unroll
        for (int i = 0; i < 4; ++i) {
          u32x2 o; o[0] = pk2(v[k][i][0] * rstd * gv[i][0], v[k][i][1] * rstd * gv[i][1]); o[1] = pk2(v[k][i][2] * rstd * gv[i][2], v[k][i][3] * rstd * gv[i][3]);
          *(u32x2*)(p.hn + (size_t)(r0 + k) * DM + lane * 4 + 256 * i) = o;
        }
      }
    } else if (it < n_norm + 1024) {
      const int c = it - n_norm;
      const float* src = p.ck + (size_t)l * 8 * 1024 * 512 + (size_t)c * 4096 + tid * 16;
      bf16_t* dst = p.kc + (size_t)c * 4096 + tid * 16;
      f32x4 a0 = *(const f32x4*)(src), a1 = *(const f32x4*)(src + 4), a2 = *(const f32x4*)(src + 8), a3 = *(const f32x4*)(src + 12);
      u32x4 o0, o1;
      o0[0] = pk2(a0[0], a0[1]); o0[1] = pk2(a0[2], a0[3]); o0[2] = pk2(a1[0], a1[1]); o0[3] = pk2(a1[2], a1[3]);
      o1[0] = pk2(a2[0], a2[1]); o1[1] = pk2(a2[2], a2[3]); o1[2] = pk2(a3[0], a3[1]); o1[3] = pk2(a3[2], a3[3]);
      *(u32x4*)dst = o0; *(u32x4*)(dst + 8) = o1;
    } else if (it >= n_norm + 2048) {
      wconv_tile(p, l, it - n_norm - 2048, (float*)lds);
    } else {
      const int c = it - n_norm - 1024;
      const int bh = c >> 5, tt = c & 31; const int b = bh >> 2, h = bh & 3; const int tk = tt >> 1, tn = tt & 1;
      const float* src = p.cv + (size_t)l * 8 * 1024 * 512 + ((size_t)(b * 1024 + tk * 64)) * 512 + h * 128 + tn * 64;
      bf16_t* dst = p.vct + ((size_t)(bh * 128 + tn * 64)) * 1024 + tk * 64;
      tr_tile(src, 512, dst, 1024, (float*)lds);
    }
  }
}

constexpr int GLD = 72;
template <bool A_F32>
DI void gemm_core(f32x4 (&acc)[4][4], const void* Ap, int lda, const bf16_t* Bp, int ldb, int K, char* lds) {
  bf16_t* As = (bf16_t*)lds;
  bf16_t* Bs = (bf16_t*)(lds + 2 * 128 * GLD * 2);
  const int tid = tid_(), wave = __builtin_amdgcn_readfirstlane(tid >> 6), lane = tid & 63;
  const int wm = wave >> 1, wn = wave & 1, l15 = lane & 15, quad = lane >> 4;
  const int nk = K / 64;
  u32x4 ra[4], rb[4];
  auto gload = [&](int kt) {
#pragma unroll
    for (int i = 0; i < 4; ++i) {
      const int c = tid + 256 * i; const int row = c >> 3, c8 = (c & 7) * 8;
      if (!A_F32) ra[i] = *(const u32x4*)((const bf16_t*)Ap + (size_t)row * lda + kt * 64 + c8);
      rb[i] = *(const u32x4*)(Bp + (size_t)row * ldb + kt * 64 + c8);
    }
  };
  auto sstore = [&](int buf, int kt) {
#pragma unroll
    for (int i = 0; i < 4; ++i) {
      const int c = tid + 256 * i; const int row = c >> 3, c8 = (c & 7) * 8;
      if (A_F32) {
        const float* a = (const float*)Ap + (size_t)row * lda + kt * 64 + c8;
        const f32x4 v0 = *(const f32x4*)a, v1 = *(const f32x4*)(a + 4);
        u32x4 t; t[0] = pk2(v0[0], v0[1]); t[1] = pk2(v0[2], v0[3]); t[2] = pk2(v1[0], v1[1]); t[3] = pk2(v1[2], v1[3]);
        *(u32x4*)(As + (buf * 128 + row) * GLD + c8) = t;
      } else {
        *(u32x4*)(As + (buf * 128 + row) * GLD + c8) = ra[i];
      }
      *(u32x4*)(Bs + (buf * 128 + row) * GLD + c8) = rb[i];
    }
  };
  gload(0); sstore(0, 0); __syncthreads();
  for (int kt = 0; kt < nk; ++kt) {
    const int buf = kt & 1;
    if (kt + 1 < nk) gload(kt + 1);
#pragma unroll
    for (int ks = 0; ks < 2; ++ks) {
      bf16x8 af[4], bfr[4];
#pragma unroll
      for (int i = 0; i < 4; ++i) {
        af[i] = *(const bf16x8*)(As + (buf * 128 + wm * 64 + i * 16 + l15) * GLD + ks * 32 + quad * 8);
        bfr[i] = *(const bf16x8*)(Bs + (buf * 128 + wn * 64 + i * 16 + l15) * GLD + ks * 32 + quad * 8);
      }
#pragma unroll
      for (int mi = 0; mi < 4; ++mi)
#pragma unroll
        for (int ni = 0; ni < 4; ++ni) acc[mi][ni] = __builtin_amdgcn_mfma_f32_16x16x32_bf16(bfr[ni], af[mi], acc[mi][ni], 0, 0, 0);
    }
    if (kt + 1 < nk) sstore(buf ^ 1, kt + 1);
    __syncthreads();
  }
}
#define LASP __attribute__((address_space(3)))
DI void gemm_dma(f32x4 (&acc)[4][4], const bf16_t* Ap, int lda, const bf16_t* Bp, int ldb, int K, char* lds) {
  const int tid = tid_(), wave = __builtin_amdgcn_readfirstlane(tid >> 6), lane = tid & 63;
  const int wm = wave >> 1, wn = wave & 1, l15 = lane & 15, quad = lane >> 4;
  const int nk = K / 64;
  const int lrow = lane >> 3, lpc = lane & 7;
  const bf16_t* ga[4]; const bf16_t* gb[4];
#pragma unroll
  for (int i = 0; i < 4; ++i) {
    const int row = (wave * 4 + i) * 8 + lrow; const int q = lpc ^ (row & 7);
    ga[i] = Ap + (size_t)row * lda + q * 8; gb[i] = Bp + (size_t)row * ldb + q * 8;
  }
  auto issue = [&](int kt) {
    char* sb = lds + (kt & 1) * 32768 + wave * 4096;
#pragma unroll
    for (int i = 0; i < 4; ++i) {
      __builtin_amdgcn_global_load_lds((const unsigned*)(ga[i] + kt * 64), (LASP unsigned*)(sb + i * 1024), 16, 0, 0);
      __builtin_amdgcn_global_load_lds((const unsigned*)(gb[i] + kt * 64), (LASP unsigned*)(sb + 16384 + i * 1024), 16, 0, 0);
    }
  };
  const int sw = l15 & 7;
  const unsigned lbase = (unsigned)(size_t)(LASP char*)lds;
  const unsigned a0 = (unsigned)((wm * 64 + l15) * 128 + ((quad ^ sw) * 16)), a1 = (unsigned)((wm * 64 + l15) * 128 + (((4 + quad) ^ sw) * 16));
  const unsigned b0 = 16384u + (unsigned)((wn * 64 + l15) * 128 + ((quad ^ sw) * 16)), b1 = 16384u + (unsigned)((wn * 64 + l15) * 128 + (((4 + quad) ^ sw) * 16));
  asm volatile("s_waitcnt vmcnt(0)" ::: "memory");
  __builtin_amdgcn_s_barrier();
  asm volatile("" ::: "memory");
  issue(0);
  for (int kt = 0; kt < nk; ++kt) {
    asm volatile("s_waitcnt vmcnt(0)" ::: "memory");
    __builtin_amdgcn_s_barrier();
    asm volatile("" ::: "memory");
    if (kt + 1 < nk) issue(kt + 1);
    const unsigned sa = lbase + (unsigned)((kt & 1) * 32768);
    bf16x8 af[4], bfr[4], ag[4], bg[4];
    asm volatile("ds_read_b128 %0, %8\n\tds_read_b128 %1, %8 offset:2048\n\tds_read_b128 %2, %8 offset:4096\n\tds_read_b128 %3, %8 offset:6144\n\t"
                 "ds_read_b128 %4, %9\n\tds_read_b128 %5, %9 offset:2048\n\tds_read_b128 %6, %9 offset:4096\n\tds_read_b128 %7, %9 offset:6144"
                 : "=&v"(af[0]), "=&v"(af[1]), "=&v"(af[2]), "=&v"(af[3]), "=&v"(bfr[0]), "=&v"(bfr[1]), "=&v"(bfr[2]), "=&v"(bfr[3])
                 : "v"(sa + a0), "v"(sa + b0) : "memory");
    asm volatile("ds_read_b128 %0, %16\n\tds_read_b128 %1, %16 offset:2048\n\tds_read_b128 %2, %16 offset:4096\n\tds_read_b128 %3, %16 offset:6144\n\t"
                 "ds_read_b128 %4, %17\n\tds_read_b128 %5, %17 offset:2048\n\tds_read_b128 %6, %17 offset:4096\n\tds_read_b128 %7, %17 offset:6144\n\t"
                 "s_waitcnt lgkmcnt(8)"
                 : "=&v"(ag[0]), "=&v"(ag[1]), "=&v"(ag[2]), "=&v"(ag[3]), "=&v"(bg[0]), "=&v"(bg[1]), "=&v"(bg[2]), "=&v"(bg[3]),
                   "+v"(af[0]), "+v"(af[1]), "+v"(af[2]), "+v"(af[3]), "+v"(bfr[0]), "+v"(bfr[1]), "+v"(bfr[2]), "+v"(bfr[3])
                 : "v"(sa + a1), "v"(sa + b1) : "memory");
#pragma unroll
    for (int mi = 0; mi < 4; ++mi)
#pragma unroll
      for (int ni = 0; ni < 4; ++ni) acc[mi][ni] = __builtin_amdgcn_mfma_f32_16x16x32_bf16(bfr[ni], af[mi], acc[mi][ni], 0, 0, 0);
    asm volatile("s_waitcnt lgkmcnt(0)" : "+v"(ag[0]), "+v"(ag[1]), "+v"(ag[2]), "+v"(ag[3]), "+v"(bg[0]), "+v"(bg[1]), "+v"(bg[2]), "+v"(bg[3]) :: "memory");
#pragma unroll
    for (int mi = 0; mi < 4; ++mi)
#pragma unroll
      for (int ni = 0; ni < 4; ++ni) acc[mi][ni] = __builtin_amdgcn_mfma_f32_16x16x32_bf16(bg[ni], ag[mi], acc[mi][ni], 0, 0, 0);
  }
  asm volatile("" ::: "memory");
  __builtin_amdgcn_s_barrier();
  asm volatile("" ::: "memory");
}
DI void zero_acc(f32x4 (&acc)[4][4]) {
#pragma unroll
  for (int i = 0; i < 4; ++i)
#pragma unroll
    for (int j = 0; j < 4; ++j) acc[i][j] = (f32x4){0.f, 0.f, 0.f, 0.f};
}

DI int xcd_tile(int r, int T) {
  const int x = blockIdx.x & 7, j = blockIdx.x >> 3, nb = gridDim.x >> 3;
  if (j >= nb) return -1;
  const int start = (int)(((long)x * T) / 8), end = (int)(((long)(x + 1) * T) / 8);
  const int g = start + r * nb + j;
  return g < end ? g : -1;
}
DI void tile_decode(int g, int nM, int nN, int& mt, int& nt) {
  const int per = 8 * nN; const int grp = g / per, idx = g - grp * per; const int gm0 = grp * 8;
  const int gsz = (nM - gm0) < 8 ? (nM - gm0) : 8;
  nt = idx / gsz; mt = gm0 + (idx - nt * gsz);
}
DI void phase_gemm_in(const Params& p, int l, char* lds) {
  const int tid = tid_(), wave = __builtin_amdgcn_readfirstlane(tid >> 6), lane = tid & 63;
  const int wm = wave >> 1, wn = wave & 1, l15 = lane & 15, quad = lane >> 4;
  const bf16_t* Wt = p.wt_in;
  const int NTN = 49, NTM = 132;
  for (int r = 0;; ++r) {
    const int g = xcd_tile(r, NTN * NTM); if (g < 0) break;
    int mt, nt; tile_decode(g, NTM, NTN, mt, nt);
    f32x4 acc[4][4]; zero_acc(acc);
    gemm_dma(acc, p.hn + (size_t)mt * 128 * DM, DM, Wt + (size_t)nt * 128 * DM, DM, DM, lds);
    const int colb = nt * 128 + wn * 64 + quad * 4;
    int kind;
    if (nt < 13) kind = 0; else if (nt < 17) kind = 1; else if (nt < 21) kind = 2; else if (nt < 25) kind = 3; else if (nt < 29) kind = 4; else if (nt < 33) kind = 1; else kind = 5;
#pragma unroll
    for (int mi = 0; mi < 4; ++mi) {
      const int R = mt * 128 + wm * 64 + mi * 16 + l15;
      const bool isp = R < MP; const int rs = R - MP;
      bf16_t* zrow = p.z + (size_t)R * NZ;
      if (kind == 0) {
        const bool last = isp ? ((R & 4095) == 4095) : ((rs & 63) == 63);
        float* so = isp ? p.out + O_SP + (size_t)(l * 4 + (R >> 12)) * SHC : p.out + O_SS + (size_t)(l * 8 + (rs >> 6)) * SHC;
#pragma unroll
        for (int ni = 0; ni < 4; ++ni) {
          const int c = colb + ni * 16; const f32x4 v = acc[mi][ni];
          u32x2 o; o[0] = pk2(v[0], v[1]); o[1] = pk2(v[2], v[3]); *(u32x2*)(zrow + c) = o;
          if (last) *(f32x4*)(so + c) = v;
        }
      } else if (kind == 1 || kind == 5) {
#pragma unroll
        for (int ni = 0; ni < 4; ++ni) {
          const int c = colb + ni * 16; f32x4 v = acc[mi][ni];
#pragma unroll
          for (int e = 0; e < 4; ++e) v[e] = (kind == 1) ? siluf_(v[e]) : sigmoidf_(v[e]);
          u32x2 o; o[0] = pk2(v[0], v[1]); o[1] = pk2(v[2], v[3]); *(u32x2*)(zrow + c) = o;
        }
      } else if (kind == 2 || kind == 3) {
        float ss = 0.f;
#pragma unroll
        for (int ni = 0; ni < 4; ++ni) { const f32x4 v = acc[mi][ni]; ss += v[0] * v[0] + v[1] * v[1] + v[2] * v[2] + v[3] * v[3]; }
        ss += __shfl_xor(ss, 16); ss += __shfl_xor(ss, 32);
        const float rstd = rsqrtf(ss * (1.0f / 64.0f) + 1e-6f);
        const float* g = (kind == 2 ? p.qng : p.kng) + l * 64;
        float* ko = isp ? p.out + O_KP + ((size_t)l * MP + R) * 512 : p.out + O_KS + ((size_t)l * MS + rs) * 512;
#pragma unroll
        for (int ni = 0; ni < 4; ++ni) {
          const int c = colb + ni * 16; const int d = ni * 16 + quad * 4;
          const f32x4 gv = *(const f32x4*)(g + d); f32x4 v = acc[mi][ni];
#pragma unroll
          for (int e = 0; e < 4; ++e) v[e] = v[e] * rstd * gv[e];
          u32x2 o; o[0] = pk2(v[0], v[1]); o[1] = pk2(v[2], v[3]); *(u32x2*)(zrow + c) = o;
          if (kind == 3) *(f32x4*)(ko + (c - C_K)) = v;
        }
      } else {
        float* vo = isp ? p.out + O_VP + ((size_t)l * MP + R) * 512 : p.out + O_VS + ((size_t)l * MS + rs) * 512;
#pragma unroll
        for (int ni = 0; ni < 4; ++ni) {
          const int cv = colb + ni * 16 - C_V; const f32x4 v = acc[mi][ni];
          *(f32x4*)(vo + cv) = v;
          const int h = cv >> 7, vd = cv & 127;
          if (isp) {
            bf16_t* vt = p.vtp + ((size_t)(((R >> 12) * 4 + h) * 128 + vd)) * 4096 + (R & 4095);
#pragma unroll
            for (int e = 0; e < 4; ++e) vt[(size_t)e * 4096] = (bf16_t)(pk2(v[e], 0.f) & 0xffff);
          } else {
            bf16_t* vt = p.vts + ((size_t)(((rs >> 6) * 4 + h) * 128 + vd)) * 64 + (rs & 63);
#pragma unroll
            for (int e = 0; e < 4; ++e) vt[(size_t)e * 64] = (bf16_t)(pk2(v[e], 0.f) & 0xffff);
          }
        }
      }
    }
  }
}

constexpr int NCH_P = 4096, NCH = 4224;
constexpr int XLD = 40;
DI f32x4 mm16(const bf16_t* Xrow, int ldx, const bf16_t* Yrow, int ldy, int ksteps, f32x4 acc, int l15, int quad) {
  for (int ks = 0; ks < ksteps; ++ks) {
    const bf16x8 a = *(const bf16x8*)(Xrow + l15 * ldx + ks * 32 + quad * 8);
    const bf16x8 b = *(const bf16x8*)(Yrow + l15 * ldy + ks * 32 + quad * 8);
    acc = __builtin_amdgcn_mfma_f32_16x16x32_bf16(a, b, acc, 0, 0, 0);
  }
  return acc;
}
DI void chunk_item(const Params& p, int l, int item, char* lds) {
  const int tid = tid_(), wave = __builtin_amdgcn_readfirstlane(tid >> 6), lane = tid & 63, l15 = lane & 15, quad = lane >> 4;
  const bool isp = item < NCH_P;
  int bh, c;
  if (isp) { bh = item >> 7; c = item & 127; } else { const int j = item - NCH_P; bh = j >> 1; c = j & 1; }
  const int b = bh >> 3, h = bh & 7;
  const int t0 = c * 32; const int row0 = (isp ? b * 4096 : MP + b * 64) + t0;
  float* s_r = (float*)lds;
  float* s_kf = s_r + 2048;
  float* s_v = s_kf + 2048;
  float* s_w = s_v + 2048;
  float* s_kk = s_w + 2048;
  float* s_bb = s_kk + 2048;
  bf16_t* s_wd = (bf16_t*)(lds + 49152);
  bf16_t* s_ad = (bf16_t*)(lds + 53760);
  float* s_bonus = (float*)(lds + 58368);
  float* s_wl = (float*)(lds + 58880);
  float* s_rhs = (float*)lds;
  bf16_t* s_A = (bf16_t*)lds;
  bf16_t* s_Bm = (bf16_t*)(lds + 4608);
  bf16_t* s_Kp = (bf16_t*)(lds + 9216);
  bf16_t* s_R = (bf16_t*)(lds + 16384);
  bf16_t* s_BmT = (bf16_t*)(lds + 20992);
  bf16_t* s_KpT = (bf16_t*)(lds + 26112);
  bf16_t* s_VmT = (bf16_t*)(lds + 31232);
  bf16_t* s_Lak = (bf16_t*)(lds + 36352);
  bf16_t* s_Mrk = (bf16_t*)(lds + 38912);
  bf16_t* s_Mrb = (bf16_t*)(lds + 41472);
  float* s_labT = (float*)(lds + 44032);
  bf16_t* s_XT = (bf16_t*)(lds + 48640);

  const int mat = wave >> 1, tt = wave & 1;
  const bf16_t* wl = (mat == 0 ? p.w2t : p.a2t) + (size_t)(h * 64) * 64;
  const float* mu = p.shift_mu + l * SHC;
  const float* w0 = p.decay_w0 + l * 512 + h * 64;
  const float* a0 = p.iclr_a0 + l * 512 + h * 64;
  const float* kkp = p.k_k + l * 512 + h * 64;
  const float* kap = p.k_a + l * 512 + h * 64;
  const float* rkp = p.r_k + l * 512 + h * 64;
  const float* lb = p.lnx_b + l * 512 + h * 64;
  const int ptok = tid >> 3, pcs = (tid & 7) * 8;
  {
    const int t = t0 + ptok; const size_t row = (size_t)(row0 + ptok);
#pragma unroll
    for (int g = 0; g < 5; ++g) {
      const int zc = (g < 3 ? g * 512 + h * 64 : 1536 + (g - 3) * 64) + pcs;
      const u32x4 cu = *(const u32x4*)(p.z + row * NZ + zc);
      float cur[8], prv[8];
#pragma unroll
      for (int e = 0; e < 4; ++e) { cur[2 * e] = bf_lo(cu[e]); cur[2 * e + 1] = bf_hi(cu[e]); }
      if (t > 0) {
        const u32x4 pu = *(const u32x4*)(p.z + (row - 1) * NZ + zc);
#pragma unroll
        for (int e = 0; e < 4; ++e) { prv[2 * e] = bf_lo(pu[e]); prv[2 * e + 1] = bf_hi(pu[e]); }
      } else if (isp) {
#pragma unroll
        for (int e = 0; e < 8; ++e) prv[e] = 0.f;
      } else {
        const float* sp = p.sshift + (size_t)(l * 8 + b) * SHC + zc;
#pragma unroll
        for (int e = 0; e < 8; ++e) prv[e] = sp[e];
      }
      float zs[8];
#pragma unroll
      for (int e = 0; e < 8; ++e) zs[e] = cur[e] + (prv[e] - cur[e]) * mu[zc + e];
      if (g < 3) {
        float* d = (g == 0 ? s_r : g == 1 ? s_kf : s_v) + ptok * 64 + pcs;
        *(f32x4*)d = (f32x4){zs[0], zs[1], zs[2], zs[3]}; *(f32x4*)(d + 4) = (f32x4){zs[4], zs[5], zs[6], zs[7]};
      } else {
        if (g == 3) {
#pragma unroll
          for (int e = 0; e < 8; ++e) { const float ex = __expf(2.f * zs[e]); zs[e] = 1.f - 2.f * __builtin_amdgcn_rcpf(ex + 1.f); }
        }
        u32x4 o; o[0] = pk2(zs[0], zs[1]); o[1] = pk2(zs[2], zs[3]); o[2] = pk2(zs[4], zs[5]); o[3] = pk2(zs[6], zs[7]);
        *(u32x4*)((g == 3 ? s_wd : s_ad) + ptok * 72 + pcs) = o;
      }
    }
  }
  __syncthreads();
  {
    const bf16_t* At = (mat == 0 ? s_wd : s_ad);
    bf16x8 af[2];
#pragma unroll
    for (int ks = 0; ks < 2; ++ks) af[ks] = *(const bf16x8*)(At + (tt * 16 + l15) * 72 + ks * 32 + quad * 8);
#pragma unroll
    for (int ct = 0; ct < 4; ++ct) {
      f32x4 d = (f32x4){0.f, 0.f, 0.f, 0.f};
#pragma unroll
      for (int ks = 0; ks < 2; ++ks) {
        const bf16x8 wfr = *(const bf16x8*)(wl + (size_t)(ct * 16 + l15) * 64 + ks * 32 + quad * 8);
        d = __builtin_amdgcn_mfma_f32_16x16x32_bf16(wfr, af[ks], d, 0, 0, 0);
      }
      const int ch = ct * 16 + quad * 4; const int tok = tt * 16 + l15;
      f32x4 o;
      if (mat == 0) {
#pragma unroll
        for (int e = 0; e < 4; ++e) {
          const float y = -(w0[ch + e] + d[e]);
          const float sp = fmaxf(y, 0.f) + __logf(1.0f + __expf(-fabsf(y)));
          o[e] = -__expf(-sp - 0.5f);
        }
        *(f32x4*)(s_w + tok * 64 + ch) = o;
      } else {
#pragma unroll
        for (int e = 0; e < 4; ++e) o[e] = sigmoidf_(a0[ch + e] + d[e]);
        *(f32x4*)(s_bb + tok * 64 + ch) = o;
      }
    }
  }
  __syncthreads();
  float r_[8], kf[8], kk[8], bbv[8], v_[8], bon;
  {
    float k_[8], a_[8];
    *(f32x4*)&k_[0] = *(const f32x4*)(s_kf + ptok * 64 + pcs); *(f32x4*)&k_[4] = *(const f32x4*)(s_kf + ptok * 64 + pcs + 4);
    *(f32x4*)&a_[0] = *(const f32x4*)(s_bb + ptok * 64 + pcs); *(f32x4*)&a_[4] = *(const f32x4*)(s_bb + ptok * 64 + pcs + 4);
    *(f32x4*)&r_[0] = *(const f32x4*)(s_r + ptok * 64 + pcs); *(f32x4*)&r_[4] = *(const f32x4*)(s_r + ptok * 64 + pcs + 4);
    *(f32x4*)&v_[0] = *(const f32x4*)(s_v + ptok * 64 + pcs); *(f32x4*)&v_[4] = *(const f32x4*)(s_v + ptok * 64 + pcs + 4);
    float ss = 0.f; bon = 0.f;
#pragma unroll
    for (int e = 0; e < 8; ++e) {
      kk[e] = k_[e] * kkp[pcs + e]; ss += kk[e] * kk[e];
      kf[e] = k_[e] * (1.f + (a_[e] - 1.f) * kap[pcs + e]);
      bon += r_[e] * kf[e] * rkp[pcs + e];
    }
    ss += __shfl_xor(ss, 1); ss += __shfl_xor(ss, 2); ss += __shfl_xor(ss, 4);
    bon += __shfl_xor(bon, 1); bon += __shfl_xor(bon, 2); bon += __shfl_xor(bon, 4);
    const float inv = 1.0f / fmaxf(sqrtf(ss), 1e-12f);
#pragma unroll
    for (int e = 0; e < 8; ++e) { kk[e] *= inv; bbv[e] = kk[e] * a_[e]; }
  }
  if (tid < 64) {
    float run = 0.f;
#pragma unroll 8
    for (int t = 0; t < 32; ++t) { run += s_w[t * 64 + tid]; s_w[t * 64 + tid] = run; }
  }
  __syncthreads();
  {
    float cw[8], cwp[8];
    *(f32x4*)&cw[0] = *(const f32x4*)(s_w + ptok * 64 + pcs); *(f32x4*)&cw[4] = *(const f32x4*)(s_w + ptok * 64 + pcs + 4);
    if (ptok > 0) { *(f32x4*)&cwp[0] = *(const f32x4*)(s_w + (ptok - 1) * 64 + pcs); *(f32x4*)&cwp[4] = *(const f32x4*)(s_w + (ptok - 1) * 64 + pcs + 4); }
    else {
#pragma unroll
      for (int e = 0; e < 8; ++e) cwp[e] = 0.f;
    }
    __syncthreads();
    float av[8], bm[8], kp[8], rr[8];
#pragma unroll
    for (int e = 0; e < 8; ++e) {
      const float ec = __expf(cw[e]), en = __expf(-cw[e]), ep = __expf(cwp[e]);
      av[e] = kk[e] * ep; bm[e] = bbv[e] * en; kp[e] = kf[e] * en; rr[e] = r_[e] * ec;
      if (ptok == 31) s_wl[pcs + e] = ec;
    }
    u32x4 o;
    o[0] = pk2(av[0], av[1]); o[1] = pk2(av[2], av[3]); o[2] = pk2(av[4], av[5]); o[3] = pk2(av[6], av[7]); *(u32x4*)(s_A + ptok * 72 + pcs) = o;
    o[0] = pk2(bm[0], bm[1]); o[1] = pk2(bm[2], bm[3]); o[2] = pk2(bm[4], bm[5]); o[3] = pk2(bm[6], bm[7]); *(u32x4*)(s_Bm + ptok * 72 + pcs) = o;
#pragma unroll
    for (int e = 0; e < 4; ++e) { s_BmT[(pcs + 2 * e) * XLD + ptok] = (bf16_t)(o[e] & 0xffff); s_BmT[(pcs + 2 * e + 1) * XLD + ptok] = (bf16_t)(o[e] >> 16); }
    o[0] = pk2(kp[0], kp[1]); o[1] = pk2(kp[2], kp[3]); o[2] = pk2(kp[4], kp[5]); o[3] = pk2(kp[6], kp[7]); *(u32x4*)(s_Kp + ptok * 72 + pcs) = o;
#pragma unroll
    for (int e = 0; e < 4; ++e) { s_KpT[(pcs + 2 * e) * XLD + ptok] = (bf16_t)(o[e] & 0xffff); s_KpT[(pcs + 2 * e + 1) * XLD + ptok] = (bf16_t)(o[e] >> 16); }
    o[0] = pk2(rr[0], rr[1]); o[1] = pk2(rr[2], rr[3]); o[2] = pk2(rr[4], rr[5]); o[3] = pk2(rr[6], rr[7]); *(u32x4*)(s_R + ptok * 72 + pcs) = o;
    o[0] = pk2(v_[0], v_[1]); o[1] = pk2(v_[2], v_[3]); o[2] = pk2(v_[4], v_[5]); o[3] = pk2(v_[6], v_[7]);
#pragma unroll
    for (int e = 0; e < 4; ++e) { s_VmT[(pcs + 2 * e) * XLD + ptok] = (bf16_t)(o[e] & 0xffff); s_VmT[(pcs + 2 * e + 1) * XLD + ptok] = (bf16_t)(o[e] >> 16); }
    u32x4 ob;
    ob[0] = pk2(lb[pcs + 0] + bon * v_[0], lb[pcs + 1] + bon * v_[1]); ob[1] = pk2(lb[pcs + 2] + bon * v_[2], lb[pcs + 3] + bon * v_[3]);
    ob[2] = pk2(lb[pcs + 4] + bon * v_[4], lb[pcs + 5] + bon * v_[5]); ob[3] = pk2(lb[pcs + 6] + bon * v_[6], lb[pcs + 7] + bon * v_[7]);
    *(u32x4*)(p.cBA + ((size_t)item * 32 + ptok) * 64 + pcs) = ob;
  }
  __syncthreads();
  {
    const bf16_t* X = (wave < 2) ? s_A : s_R;
    const bf16_t* Y = (wave == 0 || wave == 3) ? s_Bm : s_Kp;
    const bool strict = wave < 2;
#pragma unroll
    for (int ti = 0; ti < 2; ++ti)
#pragma unroll
      for (int ii = 0; ii < 2; ++ii) {
        f32x4 d = (f32x4){0.f, 0.f, 0.f, 0.f};
        if (ii <= ti) d = mm16(X + ti * 16 * 72, 72, Y + ii * 16 * 72, 72, 2, d, l15, quad);
        const int i = ii * 16 + l15;
#pragma unroll
        for (int e = 0; e < 4; ++e) {
          const int t = ti * 16 + quad * 4 + e;
          const bool keep = strict ? (i < t) : (i <= t);
          const float val = keep ? d[e] : 0.f;
          if (wave == 0) s_labT[i * 36 + t] = val;
          else { bf16_t* dst = (wave == 1 ? s_Lak : wave == 2 ? s_Mrk : s_Mrb); dst[t * XLD + i] = (bf16_t)(pk2(val, 0.f) & 0xffff); }
        }
      }
  }
  const u32x4 acap = *(const u32x4*)(s_A + ptok * 72 + pcs);
  __syncthreads();
  {
    float* d = s_rhs + ptok * 128 + pcs;
    *(f32x4*)d = (f32x4){bf_lo(acap[0]), bf_hi(acap[0]), bf_lo(acap[1]), bf_hi(acap[1])};
    *(f32x4*)(d + 4) = (f32x4){bf_lo(acap[2]), bf_hi(acap[2]), bf_lo(acap[3]), bf_hi(acap[3])};
  }
  {
    const int ti = wave & 1;
#pragma unroll
    for (int vv = 0; vv < 2; ++vv) {
      const int vi = (wave >> 1) * 2 + vv;
      f32x4 d = (f32x4){0.f, 0.f, 0.f, 0.f};
      d = mm16(s_Lak + ti * 16 * XLD, XLD, s_VmT + vi * 16 * XLD, XLD, 1, d, l15, quad);
#pragma unroll
      for (int e = 0; e < 4; ++e) s_rhs[(ti * 16 + quad * 4 + e) * 128 + 64 + vi * 16 + l15] = d[e];
    }
  }
  __syncthreads();
  if (tid < 128) {
    float x[32];
#pragma unroll
    for (int t = 0; t < 32; ++t) x[t] = s_rhs[t * 128 + tid];
#pragma unroll
    for (int i = 0; i < 31; ++i) {
      const float xi = x[i];
#pragma unroll
      for (int t4 = ((i + 1) >> 2); t4 < 8; ++t4) {
        const f32x4 lv = *(const f32x4*)(s_labT + i * 36 + t4 * 4);
#pragma unroll
        for (int e = 0; e < 4; ++e) { const int t = t4 * 4 + e; if (t > i) x[t] -= lv[e] * xi; }
      }
    }
#pragma unroll
    for (int q4 = 0; q4 < 4; ++q4) {
      u32x4 o; o[0] = pk2(x[8 * q4], x[8 * q4 + 1]); o[1] = pk2(x[8 * q4 + 2], x[8 * q4 + 3]); o[2] = pk2(x[8 * q4 + 4], x[8 * q4 + 5]); o[3] = pk2(x[8 * q4 + 6], x[8 * q4 + 7]);
      *(u32x4*)(s_XT + tid * XLD + q4 * 8) = o;
    }
  }
  __syncthreads();
  {
    const f32x4 z4 = (f32x4){0.f, 0.f, 0.f, 0.f};
    bf16_t* gPT = p.cPT + (size_t)item * 4096;
    const float wl_c = s_wl[wave * 16 + l15];
#pragma unroll
    for (int k1t = 0; k1t < 4; ++k1t) {
      f32x4 d = mm16(s_XT + k1t * 16 * XLD, XLD, s_BmT + wave * 16 * XLD, XLD, 1, z4, l15, quad);
      const int k2 = wave * 16 + l15, k1 = k1t * 16 + quad * 4;
      float o[4];
#pragma unroll
      for (int e = 0; e < 4; ++e) o[e] = ((k1 + e == k2 ? 1.f : 0.f) - d[e]) * wl_c;
      u32x2 ov; ov[0] = pk2(o[0], o[1]); ov[1] = pk2(o[2], o[3]);
      *(u32x2*)(gPT + k2 * 64 + k1) = ov;
    }
    bf16_t* gG = p.cG + (size_t)item * 4096;
#pragma unroll
    for (int k2t = 0; k2t < 4; ++k2t) {
      const f32x4 d1 = mm16(s_KpT + k2t * 16 * XLD, XLD, s_VmT + wave * 16 * XLD, XLD, 1, z4, l15, quad);
      const f32x4 d2 = mm16(s_BmT + k2t * 16 * XLD, XLD, s_XT + (64 + wave * 16) * XLD, XLD, 1, z4, l15, quad);
      const int k2 = k2t * 16 + quad * 4, v = wave * 16 + l15;
      const f32x4 wv = *(const f32x4*)(s_wl + k2);
      u32x2 ov; ov[0] = pk2((d1[0] - d2[0]) * wv[0], (d1[1] - d2[1]) * wv[1]); ov[1] = pk2((d1[2] - d2[2]) * wv[2], (d1[3] - d2[3]) * wv[3]);
      *(u32x2*)(gG + v * 64 + k2) = ov;
    }
    bf16_t* gRT = p.cRT + (size_t)item * 2048;
    bf16_t* gOI = p.cOI + (size_t)item * 2048;
#pragma unroll
    for (int ti = 0; ti < 2; ++ti) {
      const f32x4 d = mm16(s_XT + wave * 16 * XLD, XLD, s_Mrb + ti * 16 * XLD, XLD, 1, z4, l15, quad);
      const int t = ti * 16 + l15, k = wave * 16 + quad * 4;
      const u32x2 rv = *(const u32x2*)(s_R + t * 72 + k);
      u32x2 ov; ov[0] = pk2(bf_lo(rv[0]) - d[0], bf_hi(rv[0]) - d[1]); ov[1] = pk2(bf_lo(rv[1]) - d[2], bf_hi(rv[1]) - d[3]);
      *(u32x2*)(gRT + t * 64 + k) = ov;
      const f32x4 e1 = mm16(s_VmT + wave * 16 * XLD, XLD, s_Mrk + ti * 16 * XLD, XLD, 1, z4, l15, quad);
      const f32x4 e2 = mm16(s_XT + (64 + wave * 16) * XLD, XLD, s_Mrb + ti * 16 * XLD, XLD, 1, z4, l15, quad);
      u32x2 oo; oo[0] = pk2(e1[0] - e2[0], e1[1] - e2[1]); oo[1] = pk2(e1[2] - e2[2], e1[3] - e2[3]);
      *(u32x2*)(gOI + t * 64 + k) = oo;
    }
  }
  __syncthreads();
}

DI void rec_item(const Params& p, int l, int item, char* lds) {
  const int tid = tid_(), wave = __builtin_amdgcn_readfirstlane(tid >> 6), lane = tid & 63, l15 = lane & 15, quad = lane >> 4;
  const bool isp = item < 32;
  const int bh = isp ? item : item - 32; const int b = bh >> 3, h = bh & 7;
  const int nch = isp ? 128 : 2; const int cid0 = isp ? bh * 128 : NCH_P + bh * 2;
  const int row0 = isp ? b * 4096 : MP + b * 64;
  bf16_t* Sb = (bf16_t*)lds;
  {
    const int v = wave * 16 + l15;
    f32x4 a0[4];
    if (isp) {
#pragma unroll
      for (int nk = 0; nk < 4; ++nk) a0[nk] = (f32x4){0.f, 0.f, 0.f, 0.f};
    } else {
      const float* sp = p.swkv + (((size_t)(l * 8 + b) * 8 + h) * 64 + v) * 64;
#pragma unroll
      for (int nk = 0; nk < 4; ++nk) a0[nk] = *(const f32x4*)(sp + nk * 16 + quad * 4);
    }
#pragma unroll
    for (int nk = 0; nk < 4; ++nk) { u32x2 o; o[0] = pk2(a0[nk][0], a0[nk][1]); o[1] = pk2(a0[nk][2], a0[nk][3]); *(u32x2*)(Sb + v * 72 + nk * 16 + quad * 4) = o; }
  }
  __syncthreads();
  const int nmain = nch - 2;
  if (wave < 2) {
    struct PS { bf16x8 pt[4][2]; u32x2 gv[2][4]; };
    auto ldp = [&](PS& s, int c) {
      const int cc = c < nch ? c : nch - 1;
      const size_t cid = (size_t)(cid0 + cc);
      const bf16_t* gPT = p.cPT + cid * 4096; const bf16_t* gG = p.cG + cid * 4096;
#pragma unroll
      for (int nk = 0; nk < 4; ++nk) {
#pragma unroll
        for (int ks = 0; ks < 2; ++ks) s.pt[nk][ks] = *(const bf16x8*)(gPT + (nk * 16 + l15) * 64 + ks * 32 + quad * 8);
#pragma unroll
        for (int v2 = 0; v2 < 2; ++v2) s.gv[v2][nk] = *(const u32x2*)(gG + ((wave * 2 + v2) * 16 + l15) * 64 + nk * 16 + quad * 4);
      }
    };
    f32x4 acc[2][4];
    auto step = [&](PS& s, int c) {
      const int buf = c & 1;
#pragma unroll
      for (int v2 = 0; v2 < 2; ++v2) {
        const int v = (wave * 2 + v2) * 16 + l15;
        bf16x8 sf[2];
#pragma unroll
        for (int ks = 0; ks < 2; ++ks) sf[ks] = *(const bf16x8*)(Sb + (buf * 64 + v) * 72 + ks * 32 + quad * 8);
#pragma unroll
        for (int nk = 0; nk < 4; ++nk) {
          f32x4 a = (f32x4){bf_lo(s.gv[v2][nk][0]), bf_hi(s.gv[v2][nk][0]), bf_lo(s.gv[v2][nk][1]), bf_hi(s.gv[v2][nk][1])};
#pragma unroll
          for (int ks = 0; ks < 2; ++ks) a = __builtin_amdgcn_mfma_f32_16x16x32_bf16(s.pt[nk][ks], sf[ks], a, 0, 0, 0);
          acc[v2][nk] = a;
        }
      }
      ldp(s, c + 3);
#pragma unroll
      for (int v2 = 0; v2 < 2; ++v2) {
        const int v = (wave * 2 + v2) * 16 + l15;
#pragma unroll
        for (int nk = 0; nk < 4; ++nk) { u32x2 ov; ov[0] = pk2(acc[v2][nk][0], acc[v2][nk][1]); ov[1] = pk2(acc[v2][nk][2], acc[v2][nk][3]); *(u32x2*)(Sb + ((buf ^ 1) * 64 + v) * 72 + nk * 16 + quad * 4) = ov; }
      }
      asm volatile("s_waitcnt lgkmcnt(0)" ::: "memory"); __builtin_amdgcn_s_barrier(); asm volatile("" ::: "memory");
    };
    PS s0, s1, s2;
    ldp(s0, 0); ldp(s1, 1); ldp(s2, 2);
#pragma unroll 1
    for (int c = 0; c < nmain; c += 3) { step(s0, c); step(s1, c + 1); step(s2, c + 2); }
    step(s0, nmain); step(s1, nmain + 1);
#pragma unroll
    for (int v2 = 0; v2 < 2; ++v2) {
      const int v = (wave * 2 + v2) * 16 + l15;
      float* so = (isp ? p.out + O_WP + (((size_t)(l * 4 + b) * 8 + h) * 64 + v) * 64 : p.out + O_WS + (((size_t)(l * 8 + b) * 8 + h) * 64 + v) * 64);
#pragma unroll
      for (int nk = 0; nk < 4; ++nk) *(f32x4*)(so + nk * 16 + quad * 4) = acc[v2][nk];
    }
  } else {
    struct CS { bf16x8 rt[2]; u32x2 oi[4], ba[4], gt[4]; };
    const int tok = (wave - 2) * 16 + l15;
    auto ldc = [&](CS& s, int c) {
      const int cc = c < nch ? c : nch - 1;
      const size_t cid = (size_t)(cid0 + cc); const size_t row = (size_t)(row0 + cc * 32 + tok);
#pragma unroll
      for (int ks = 0; ks < 2; ++ks) s.rt[ks] = *(const bf16x8*)(p.cRT + cid * 2048 + tok * 64 + ks * 32 + quad * 8);
#pragma unroll
      for (int vt = 0; vt < 4; ++vt) {
        s.oi[vt] = *(const u32x2*)(p.cOI + cid * 2048 + tok * 64 + vt * 16 + quad * 4);
        s.ba[vt] = *(const u32x2*)(p.cBA + cid * 2048 + tok * 64 + vt * 16 + quad * 4);
        s.gt[vt] = *(const u32x2*)(p.z + row * NZ + C_GR + h * 64 + vt * 16 + quad * 4);
      }
    };
    const float* lg = p.lnx_g + l * 512 + h * 64;
    f32x4 lgv[4];
#pragma unroll
    for (int vt = 0; vt < 4; ++vt) lgv[vt] = *(const f32x4*)(lg + vt * 16 + quad * 4);
    auto step = [&](CS& s, int c) {
      const int buf = c & 1; const size_t row = (size_t)(row0 + c * 32 + tok);
      f32x4 ao[4];
#pragma unroll
      for (int vt = 0; vt < 4; ++vt) {
        f32x4 a = (f32x4){bf_lo(s.oi[vt][0]), bf_hi(s.oi[vt][0]), bf_lo(s.oi[vt][1]), bf_hi(s.oi[vt][1])};
#pragma unroll
        for (int ks = 0; ks < 2; ++ks) {
          const bf16x8 sa = *(const bf16x8*)(Sb + (buf * 64 + vt * 16 + l15) * 72 + ks * 32 + quad * 8);
          a = __builtin_amdgcn_mfma_f32_16x16x32_bf16(sa, s.rt[ks], a, 0, 0, 0);
        }
        ao[vt] = a;
      }
      float sm = 0.f;
#pragma unroll
      for (int vt = 0; vt < 4; ++vt) sm += (ao[vt][0] + ao[vt][1]) + (ao[vt][2] + ao[vt][3]);
      sm += __shfl_xor(sm, 16); sm += __shfl_xor(sm, 32);
      const float mean = sm * (1.0f / 64.0f);
      float vr = 0.f;
#pragma unroll
      for (int vt = 0; vt < 4; ++vt)
#pragma unroll
        for (int e = 0; e < 4; ++e) { const float d = ao[vt][e] - mean; vr += d * d; }
      vr += __shfl_xor(vr, 16); vr += __shfl_xor(vr, 32);
      const float rstd = rsqrtf(vr * (1.0f / 64.0f) + 64e-5f);
#pragma unroll
      for (int vt = 0; vt < 4; ++vt) {
        const int vv = vt * 16 + quad * 4;
        const f32x4 g4 = lgv[vt];
        const float y0 = ((ao[vt][0] - mean) * rstd * g4[0] + bf_lo(s.ba[vt][0])) * bf_lo(s.gt[vt][0]);
        const float y1 = ((ao[vt][1] - mean) * rstd * g4[1] + bf_hi(s.ba[vt][0])) * bf_hi(s.gt[vt][0]);
        const float y2 = ((ao[vt][2] - mean) * rstd * g4[2] + bf_lo(s.ba[vt][1])) * bf_lo(s.gt[vt][1]);
        const float y3 = ((ao[vt][3] - mean) * rstd * g4[3] + bf_hi(s.ba[vt][1])) * bf_hi(s.gt[vt][1]);
        u32x2 ov; ov[0] = pk2(y0, y1); ov[1] = pk2(y2, y3);
        *(u32x2*)(p.o_r + row * 512 + h * 64 + vv) = ov;
      }
      ldc(s, c + 3);
      asm volatile("s_waitcnt lgkmcnt(0)" ::: "memory"); __builtin_amdgcn_s_barrier(); asm volatile("" ::: "memory");
    };
    CS s0, s1, s2;
    ldc(s0, 0); ldc(s1, 1); ldc(s2, 2);
#pragma unroll 1
    for (int c = 0; c < nmain; c += 3) { step(s0, c); step(s1, c + 1); step(s2, c + 2); }
    step(s0, nmain); step(s1, nmain + 1);
  }
  __syncthreads();
}
DI void phase_chunk(const Params& p, int l, char* lds) {
  for (int it = blockIdx.x; it < NCH; it += gridDim.x) chunk_item(p, l, it, lds);
}

constexpr int ALD = 72;
DI void attn_item(const Params& p, int l, int item, char* lds) {
  const int tid = tid_(), wave = __builtin_amdgcn_readfirstlane(tid >> 6), lane = tid & 63;
  const int m = wave & 1, qh = wave >> 1, q = lane & 31, hh = lane >> 5;
  bf16_t* Ks = (bf16_t*)lds;
  bf16_t* Vs = Ks + 2 * 64 * ALD;
  float* xb = (float*)lds;
  bool samp; int b, h, nch, qrow0, qpos0;
  if (item < 32) { samp = true; b = item >> 2; h = item & 3; nch = 17; qrow0 = MP + b * 64; qpos0 = 1024; }
  else { samp = false; const int a = item - 32; const int qc = 63 - (a >> 4); const int bh = a & 15; b = bh >> 2; h = bh & 3; nch = qc + 1; qrow0 = b * 4096 + qc * 64; qpos0 = qc * 64; }
  bf16x8 qf[4];
  {
    const bf16_t* qp = p.z + (size_t)(qrow0 + qh * 32 + q) * NZ + C_Q + h * 128 + m * 64;
#pragma unroll
    for (int ks = 0; ks < 4; ++ks) qf[ks] = *(const bf16x8*)(qp + ks * 16 + hh * 8);
  }
  const float slope = exp2f(-2.0f * (float)(h + 1));
  const float LOG2E = 1.4426950408889634f;
  const float c1 = 0.125f * LOG2E, sl2 = slope * LOG2E;
  const float qposf = (float)(qpos0 + qh * 32 + q);
  f32x16 O[4];
#pragma unroll
  for (int i = 0; i < 4; ++i)
#pragma unroll
    for (int e = 0; e < 16; ++e) O[i][e] = 0.f;
  float mrun = -1e30f, lrun = 0.f;
  u32x4 rk[4], rv[4];
  auto gload = [&](int j) {
    const bf16_t* kb; size_t kld; const bf16_t* vb; size_t vld;
    if (!samp) { kb = p.z + (size_t)(b * 4096 + j * 64) * NZ + C_K + h * 128; kld = NZ; vb = p.vtp + (size_t)((b * 4 + h) * 128) * 4096 + j * 64; vld = 4096; }
    else if (j < 16) { kb = p.kc + (size_t)(b * 1024 + j * 64) * 512 + h * 128; kld = 512; vb = p.vct + (size_t)((b * 4 + h) * 128) * 1024 + j * 64; vld = 1024; }
    else { kb = p.z + (size_t)(MP + b * 64) * NZ + C_K + h * 128; kld = NZ; vb = p.vts + (size_t)((b * 4 + h) * 128) * 64; vld = 64; }
#pragma unroll
    for (int i = 0; i < 4; ++i) {
      const int c = tid + 256 * i;
      const int mm = c >> 9, key = (c >> 3) & 63, d8 = (c & 7) * 8;
      rk[i] = *(const u32x4*)(kb + (size_t)key * kld + mm * 64 + d8);
      const int vd = c >> 3, k8 = (c & 7) * 8;
      rv[i] = *(const u32x4*)(vb + (size_t)vd * vld + k8);
    }
  };
  auto sstore = [&]() {
#pragma unroll
    for (int i = 0; i < 4; ++i) {
      const int c = tid + 256 * i;
      const int mm = c >> 9, key = (c >> 3) & 63, d8 = (c & 7) * 8;
      *(u32x4*)(Ks + (mm * 64 + key) * ALD + d8) = rk[i];
      const int vd = c >> 3, k8 = (c & 7) * 8;
      *(u32x4*)(Vs + vd * ALD + k8) = rv[i];
    }
  };
  gload(0); sstore(); __syncthreads();
  for (int j = 0; j < nch; ++j) {
    if (j + 1 < nch) gload(j + 1);
    f32x16 s[2];
#pragma unroll
    for (int kt = 0; kt < 2; ++kt) {
#pragma unroll
      for (int e = 0; e < 16; ++e) s[kt][e] = 0.f;
#pragma unroll
      for (int ks = 0; ks < 4; ++ks) {
        const bf16x8 kf = *(const bf16x8*)(Ks + (m * 64 + kt * 32 + q) * ALD + ks * 16 + hh * 8);
        s[kt] = __builtin_amdgcn_mfma_f32_32x32x16_bf16(kf, qf[ks], s[kt], 0, 0, 0);
      }
    }
    float mx = -1e30f;
    const float dbase = qposf - (float)(j * 64 + 4 * hh);
#pragma unroll
    for (int kt = 0; kt < 2; ++kt)
#pragma unroll
      for (int e = 0; e < 16; ++e) {
        const float dd = dbase - (float)(kt * 32 + (e & 3) + 8 * (e >> 2));
        const float v = s[kt][e] * c1 - sl2 * fabsf(dd);
        s[kt][e] = v; mx = fmaxf(mx, v);
      }
    mx = fmaxf(mx, __shfl_xor(mx, 32));
    const float mnew = fmaxf(mrun, mx);
    const float alpha = __builtin_amdgcn_exp2f(mrun - mnew);
    const bool resc = mnew > mrun;
    mrun = mnew;
    float ps = 0.f;
#pragma unroll
    for (int kt = 0; kt < 2; ++kt)
#pragma unroll
      for (int e = 0; e < 16; ++e) { const float pe = __builtin_amdgcn_exp2f(s[kt][e] - mnew); s[kt][e] = pe; ps += pe; }
    lrun = lrun * alpha + ps;
    if (__any(resc)) {
#pragma unroll
      for (int i = 0; i < 4; ++i)
#pragma unroll
        for (int e = 0; e < 16; ++e) O[i][e] *= alpha;
    }
#pragma unroll
    for (int kt = 0; kt < 2; ++kt)
#pragma unroll
      for (int sx = 0; sx < 2; ++sx) {
        u32x4 pb;
        pb[0] = pk2(s[kt][8 * sx + 0], s[kt][8 * sx + 1]); pb[1] = pk2(s[kt][8 * sx + 2], s[kt][8 * sx + 3]);
        pb[2] = pk2(s[kt][8 * sx + 4], s[kt][8 * sx + 5]); pb[3] = pk2(s[kt][8 * sx + 6], s[kt][8 * sx + 7]);
        const bf16x8 pf = __builtin_bit_cast(bf16x8, pb);
#pragma unroll
        for (int vt = 0; vt < 4; ++vt) {
          const bf16_t* vp = Vs + (vt * 32 + q) * ALD + kt * 32 + 16 * sx + 4 * hh;
          const s16x4 lo = *(const s16x4*)vp, hi = *(const s16x4*)(vp + 8);
          const bf16x8 vf = __builtin_shufflevector(lo, hi, 0, 1, 2, 3, 4, 5, 6, 7);
          O[vt] = __builtin_amdgcn_mfma_f32_32x32x16_bf16(vf, pf, O[vt], 0, 0, 0);
        }
      }
    __syncthreads();
    if (j + 1 < nch) sstore();
    __syncthreads();
  }
  const float ltot = lrun + __shfl_xor(lrun, 32);
  const float inv = 1.0f / ltot;
#pragma unroll
  for (int i = 0; i < 4; ++i)
#pragma unroll
    for (int e = 0; e < 16; ++e) O[i][e] *= inv;
  if (m == 1) {
#pragma unroll
    for (int vt = 0; vt < 4; ++vt)
#pragma unroll
      for (int e = 0; e < 16; ++e) { const int vd = vt * 32 + (e & 3) + 8 * (e >> 2) + 4 * hh; xb[(qh * 128 + vd) * 32 + q] = O[vt][e]; }
  }
  __syncthreads();
  if (m == 0) {
    float d1 = 0.f, d2 = 0.f;
    for (int i = 0; i < 64; ++i) { d1 += p.lq1[l * 64 + i] * p.lk1[l * 64 + i]; d2 += p.lq2[l * 64 + i] * p.lk2[l * 64 + i]; }
    const float lam_init = 0.8f - 0.6f * __expf(-0.3f * (float)l);
    const float lam = __expf(d1) - __expf(d2) + lam_init;
    float ss = 0.f;
#pragma unroll
    for (int vt = 0; vt < 4; ++vt)
#pragma unroll
      for (int e = 0; e < 16; ++e) {
        const int vd = vt * 32 + (e & 3) + 8 * (e >> 2) + 4 * hh;
        const float o2 = xb[(qh * 128 + vd) * 32 + q];
        const float o = O[vt][e] - lam * o2; O[vt][e] = o; ss += o * o;
      }
    ss += __shfl_xor(ss, 32);
    const float rstd = rsqrtf(ss * (1.0f / 128.0f) + 1e-5f) * (1.0f - lam_init);
    const size_t row = (size_t)(qrow0 + qh * 32 + q);
    const float* sg = p.subln_g + l * 128;
#pragma unroll
    for (int vt = 0; vt < 4; ++vt)
#pragma unroll
      for (int e4 = 0; e4 < 4; ++e4) {
        const int vd = vt * 32 + 8 * e4 + 4 * hh;
        const u32x2 gu = *(const u32x2*)(p.z + row * NZ + C_GA + h * 128 + vd);
        const f32x4 gv = *(const f32x4*)(sg + vd);
        const float y0 = O[vt][4 * e4 + 0] * rstd * gv[0] * bf_lo(gu[0]);
        const float y1 = O[vt][4 * e4 + 1] * rstd * gv[1] * bf_hi(gu[0]);
        const float y2 = O[vt][4 * e4 + 2] * rstd * gv[2] * bf_lo(gu[1]);
        const float y3 = O[vt][4 * e4 + 3] * rstd * gv[3] * bf_hi(gu[1]);
        u32x2 ov; ov[0] = pk2(y0, y1); ov[1] = pk2(y2, y3);
        *(u32x2*)(p.o_a + row * 512 + h * 128 + vd) = ov;
      }
  }
  __syncthreads();
}

DI void phase_mix(const Params& p, int l, char* lds) {
  __shared__ int s_next;
  if (blockIdx.x < 96) rec_item(p, l, blockIdx.x, lds);
  unsigned* ctr = p.bar + XCD_BAR_WORDS + 64 * l;
  for (;;) {
    __syncthreads();
    if (threadIdx.x == 0) s_next = (int)atomicAdd(ctr, 1u);
    __syncthreads();
    const int it = s_next;
    if (it >= 1056) break;
    attn_item(p, l, it, lds);
  }
}

DI void phase_merge(const Params& p, int l, char* lds) {
  const int tid = tid_(), wave = __builtin_amdgcn_readfirstlane(tid >> 6), lane = tid & 63;
  const int wm = wave >> 1, wn = wave & 1, l15 = lane & 15, quad = lane >> 4;
  for (int r = 0;; ++r) {
    const int g = xcd_tile(r, 132 * 8); if (g < 0) break;
    int mt, nt; tile_decode(g, 132, 8, mt, nt);
    f32x4 a1[4][4]; zero_acc(a1);
    gemm_dma(a1, p.o_r + (size_t)mt * 128 * 512, 512, p.wt_brr + (size_t)nt * 128 * 512, 512, 512, lds);
    u32x2 pk[4][4];
#pragma unroll
    for (int mi = 0; mi < 4; ++mi) {
      const int R = mt * 128 + wm * 64 + mi * 16 + l15;
#pragma unroll
      for (int ni = 0; ni < 4; ++ni) {
        const int c = nt * 128 + wn * 64 + ni * 16 + quad * 4;
        const u32x2 g1 = *(const u32x2*)(p.z + (size_t)R * NZ + C_MR + c);
        const f32x4 v1 = a1[mi][ni];
        pk[mi][ni][0] = pk2(bf_lo(g1[0]) * v1[0], bf_hi(g1[0]) * v1[1]);
        pk[mi][ni][1] = pk2(bf_lo(g1[1]) * v1[2], bf_hi(g1[1]) * v1[3]);
      }
    }
    zero_acc(a1);
    gemm_dma(a1, p.o_a + (size_t)mt * 128 * 512, 512, p.wt_bra + (size_t)nt * 128 * 512, 512, 512, lds);
#pragma unroll
    for (int mi = 0; mi < 4; ++mi) {
      const int R = mt * 128 + wm * 64 + mi * 16 + l15;
#pragma unroll
      for (int ni = 0; ni < 4; ++ni) {
        const int c = nt * 128 + wn * 64 + ni * 16 + quad * 4;
        const u32x2 g2 = *(const u32x2*)(p.z + (size_t)R * NZ + C_MA + c);
        const f32x4 v2 = a1[mi][ni]; const u32x2 u1 = pk[mi][ni];
        u32x2 o;
        o[0] = pk2(bf_lo(u1[0]) + bf_lo(g2[0]) * v2[0], bf_hi(u1[0]) + bf_hi(g2[0]) * v2[1]);
        o[1] = pk2(bf_lo(u1[1]) + bf_lo(g2[1]) * v2[2], bf_hi(u1[1]) + bf_hi(g2[1]) * v2[3]);
        *(u32x2*)(p.hn + (size_t)R * DM + c) = o;
      }
    }
  }
}
DI void phase_out(const Params& p, int l, char* lds) {
  const int tid = tid_(), wave = __builtin_amdgcn_readfirstlane(tid >> 6), lane = tid & 63;
  const int wm = wave >> 1, wn = wave & 1, l15 = lane & 15, quad = lane >> 4;
  for (int r = 0;; ++r) {
    const int g = xcd_tile(r, 132 * 8); if (g < 0) break;
    int mt, nt; tile_decode(g, 132, 8, mt, nt);
    f32x4 acc[4][4]; zero_acc(acc);
    gemm_dma(acc, p.hn + (size_t)mt * 128 * DM, DM, p.wt_out + (size_t)nt * 128 * DM, DM, DM, lds);
#pragma unroll
    for (int mi = 0; mi < 4; ++mi) {
      const int R = mt * 128 + wm * 64 + mi * 16 + l15;
      const float* xr = x_row(p, l, R);
#pragma unroll
      for (int ni = 0; ni < 4; ++ni) {
        const int c = nt * 128 + wn * 64 + ni * 16 + quad * 4;
        const f32x4 xv = *(const f32x4*)(xr + c);
        *(f32x4*)(p.out + (size_t)R * DM + c) = xv + acc[mi][ni];
      }
    }
  }
}
DI void phase_ple(const Params& p, int l, char* lds) {
  const int tid = tid_(), wave = __builtin_amdgcn_readfirstlane(tid >> 6), lane = tid & 63;
  const int wm = wave >> 1, wn = wave & 1, l15 = lane & 15, quad = lane >> 4;
  for (int r = 0;; ++r) {
    const int g = xcd_tile(r, 132 * 8); if (g < 0) break;
    int mt, nt; tile_decode(g, 132, 8, mt, nt);
    f32x4 a1[4][4]; zero_acc(a1);
    gemm_dma(a1, p.hn + (size_t)mt * 128 * DM, DM, p.wt_gate + (size_t)nt * 128 * DM, DM, DM, lds);
    u32x2 pk[4][4];
#pragma unroll
    for (int mi = 0; mi < 4; ++mi)
#pragma unroll
      for (int ni = 0; ni < 4; ++ni) { const f32x4 v = a1[mi][ni]; pk[mi][ni][0] = pk2(sigmoidf_(v[0]), sigmoidf_(v[1])); pk[mi][ni][1] = pk2(sigmoidf_(v[2]), sigmoidf_(v[3])); }
    zero_acc(a1);
    const int r0 = mt * 128;
    const float* pa = r0 < MP ? p.pp + ((size_t)l * MP + r0) * 256 : p.ps + ((size_t)l * MS + (r0 - MP)) * 256;
    gemm_core<true>(a1, pa, 256, p.wt_ple + (size_t)nt * 128 * 256, 256, 256, lds);
#pragma unroll
    for (int mi = 0; mi < 4; ++mi) {
      const int R = mt * 128 + wm * 64 + mi * 16 + l15;
#pragma unroll
      for (int ni = 0; ni < 4; ++ni) {
        const int c = nt * 128 + wn * 64 + ni * 16 + quad * 4;
        float* xo = p.out + (size_t)R * DM + c;
        const f32x4 xv = *(const f32x4*)xo; const f32x4 e = a1[mi][ni]; const u32x2 g = pk[mi][ni];
        f32x4 o;
        o[0] = xv[0] + e[0] * bf_lo(g[0]); o[1] = xv[1] + e[1] * bf_hi(g[0]);
        o[2] = xv[2] + e[2] * bf_lo(g[1]); o[3] = xv[3] + e[3] * bf_hi(g[1]);
        *(f32x4*)xo = o;
      }
    }
  }
}


#define XB_TMO      128
#define XB_XCNT(j)  (256  + 64 * (j))
#define XB_XSUB(j)  (1280 + 64 * (j))
#define XB_XGEN(j)  (2304 + 64 * (j))
#define XB_TOP      3328
#define XB_TOPGEN   3392
#define XB_SPIN_CAP (1u << 18)
#define LAS __attribute__((address_space(3)))
DI unsigned xb_ld(unsigned* p)              { return __hip_atomic_load(p, __ATOMIC_RELAXED, __HIP_MEMORY_SCOPE_AGENT); }
DI unsigned xb_add(unsigned* p, unsigned v) { return __hip_atomic_fetch_add(p, v, __ATOMIC_RELAXED, __HIP_MEMORY_SCOPE_AGENT); }
DI unsigned xb_xcc_id() { return (unsigned)__builtin_amdgcn_s_getreg((3 << 11) | 20) & 0xFu; }
#define XB_SPIN(cond, bar) do { unsigned _sp = 0; while (cond) { __builtin_amdgcn_s_sleep(1); \
    if ((++_sp & 255u) == 0u) { if (xb_ld(&(bar)[XB_TMO])) break; if (_sp > XB_SPIN_CAP) { atomicAdd(&(bar)[XB_TMO], 1u); break; } } } } while (0)
struct XcdBarrier { unsigned* bar; unsigned x; volatile LAS unsigned* st; };
DI XcdBarrier xcd_barrier_post(unsigned* bar, volatile LAS unsigned* st) {
  XcdBarrier b; b.bar = bar; b.x = xb_xcc_id(); b.st = st;
  if (threadIdx.x == 0) (void)xb_add(&bar[XB_XCNT(b.x)], 1u);
  return b;
}
DI void xcd_barrier_complete(unsigned* bar, unsigned x, unsigned& nloc, unsigned& nx) {
  const unsigned G = gridDim.x * gridDim.y * gridDim.z;
  unsigned sum, cnt, mine, sp = 0u;
  for (;;) {
    sum = 0u; cnt = 0u; mine = 0u;
#pragma unroll
    for (unsigned j = 0; j < 16; ++j) { const unsigned c = xb_ld(&bar[XB_XCNT(j)]); sum += c; cnt += (c > 0u) ? 1u : 0u; mine = (j == x) ? c : mine; }
    if (sum == G) break;
    __builtin_amdgcn_s_sleep(1);
    if ((++sp & 255u) == 0u) { if (xb_ld(&bar[XB_TMO])) break; if (sp > XB_SPIN_CAP) { atomicAdd(&bar[XB_TMO], 1u); break; } }
  }
  nloc = mine > 0u ? mine : 1u; nx = cnt > 0u ? cnt : 1u;
}
DI void xcd_barrier(const XcdBarrier& b) {
  asm volatile("s_waitcnt vmcnt(0)" ::: "memory");
  __syncthreads();
  if (threadIdx.x == 0) {
    unsigned* bar = b.bar;
    __builtin_amdgcn_s_waitcnt(0);
    unsigned nloc = b.st[0], nx = b.st[1];
    if (nloc == 0u) { xcd_barrier_complete(bar, b.x, nloc, nx); b.st[0] = nloc; b.st[1] = nx; }
    const unsigned old = xb_add(&bar[XB_XSUB(b.x)], 1u);
    const unsigned gen = old / nloc;
    if (old + 1u == (gen + 1u) * nloc) {
      __builtin_amdgcn_fence(__ATOMIC_RELEASE, "agent");
      asm volatile("s_waitcnt vmcnt(0)" ::: "memory");
      const unsigned og = xb_add(&bar[XB_TOP], 1u);
      const unsigned tg = og / nx;
      if (og + 1u == (tg + 1u) * nx) xb_add(&bar[XB_TOPGEN], 1u);
      else XB_SPIN(xb_ld(&bar[XB_TOPGEN]) == tg, bar);
      __builtin_amdgcn_fence(__ATOMIC_ACQUIRE, "agent");
      xb_add(&bar[XB_XGEN(b.x)], 1u);
      asm volatile("s_waitcnt vmcnt(0)" ::: "memory");
    } else {
      XB_SPIN(xb_ld(&bar[XB_XGEN(b.x)]) == gen, bar);
      __builtin_amdgcn_fence(__ATOMIC_ACQUIRE, "agent");
      asm volatile("s_waitcnt vmcnt(0)" ::: "memory");
    }
  }
  __syncthreads();
}
constexpr int LDS_BYTES = 73728;
DI void run_phase(const Params& p, int ph, int l, char* lds) {
  switch (ph) {
    case 1: phase_norm(p, l, true, lds); break;
    case 2: phase_gemm_in(p, l, lds); break;
    case 3: phase_mix(p, l, lds); break;
    case 4: phase_merge(p, l, lds); break;
    case 5: phase_out(p, l, lds); break;
    case 6: phase_norm(p, l, false, lds); break;
    case 7: phase_ple(p, l, lds); break;
    case 8: phase_chunk(p, l, lds); break;
  }
}

#if MEGA
__global__ void __launch_bounds__(256, 2) k_mega(Params p) {
  __shared__ __attribute__((aligned(16))) char lds[LDS_BYTES];
  __shared__ uint4 xb_words;
  cg::grid_group grid = cg::this_grid();
  if (threadIdx.x == 0) xb_words = make_uint4(0u, 0u, 0u, 0u);
  __syncthreads();
  const XcdBarrier xb = xcd_barrier_post(p.bar, (volatile LAS unsigned*)&xb_words);
#pragma unroll 1
  for (int l = 0; l < NL; ++l) {
    phase_norm(p, l, true, lds);
    if (l == 0) grid.sync(); else xcd_barrier(xb);
    phase_gemm_in(p, l, lds); xcd_barrier(xb);
    phase_chunk(p, l, lds); xcd_barrier(xb);
    phase_mix(p, l, lds); xcd_barrier(xb);
    phase_merge(p, l, lds); xcd_barrier(xb);
    phase_out(p, l, lds); xcd_barrier(xb);
    phase_norm(p, l, false, lds); xcd_barrier(xb);
    phase_ple(p, l, lds); if (l + 1 < NL) xcd_barrier(xb);
  }
}
#else
template <int PH>
__global__ void __launch_bounds__(256, 2) k_phase(Params p, int l) {
  __shared__ __attribute__((aligned(16))) char lds[LDS_BYTES];
  run_phase(p, PH, l, lds);
}
#endif

extern "C" void kernel_launch(void* const* d_in, const int* in_sizes, int n_in, void* d_out, int out_size, void* d_ws, size_t ws_size,
                              hipStream_t stream) {
  Params p{};
  const float** pf = (const float**)&p;
  for (int i = 0; i < 33; ++i) pf[i] = (const float*)d_in[i];
  p.out = (float*)d_out;
  char* w = (char*)d_ws; size_t off = 0;
  auto take = [&](size_t bytes) { char* r = w + off; off += (bytes + 255) & ~(size_t)255; return (bf16_t*)r; };
  p.bar = (unsigned*)take((size_t)(XCD_BAR_WORDS + 64 * NL) * 4);
  p.wt_in = take((size_t)NZ * 1024 * 2);
  p.wt_brr = take((size_t)1024 * 512 * 2);
  p.wt_bra = take((size_t)1024 * 512 * 2);
  p.wt_out = take((size_t)1024 * 1024 * 2);
  p.wt_ple = take((size_t)1024 * 256 * 2);
  p.wt_gate = take((size_t)1024 * 1024 * 2);
  p.w2t = take((size_t)512 * 64 * 2);
  p.a2t = take((size_t)512 * 64 * 2);
  p.z = take((size_t)MT * NZ * 2);
  p.vtp = take((size_t)16 * 128 * 4096 * 2);
  p.vts = take((size_t)32 * 128 * 64 * 2);
  p.kc = take((size_t)8 * 1024 * 512 * 2);
  p.vct = take((size_t)32 * 128 * 1024 * 2);
  p.o_r = take((size_t)MT * 512 * 2);
  p.o_a = take((size_t)MT * 512 * 2);
  p.hn = take((size_t)MT * DM * 2);
  p.cPT = p.hn;
  p.cG = take((size_t)NCH * 4096 * 2);
  p.cRT = take((size_t)NCH * 2048 * 2);
  p.cOI = take((size_t)NCH * 2048 * 2);
  p.cBA = take((size_t)NCH * 2048 * 2);
  if (off > ws_size) { fprintf(stderr, "workspace too small: need %zu have %zu\n", off, ws_size); return; }
#if MEGA
  hipMemsetAsync(p.bar, 0, (size_t)(XCD_BAR_WORDS + 64 * NL) * 4, stream);
  static int grid_blocks = 0;
  if (!grid_blocks) {
    int dev = 0, cus = 0, per_cu = 0;
    hipGetDevice(&dev);
    hipDeviceGetAttribute(&cus, hipDeviceAttributeMultiprocessorCount, dev);
    hipOccupancyMaxActiveBlocksPerMultiprocessor(&per_cu, k_mega, 256, 0);
    if (per_cu > 2) per_cu = 2;
    grid_blocks = cus * per_cu;
  }
  void* args[] = {&p};
  hipError_t e = hipLaunchCooperativeKernel((void*)k_mega, dim3(grid_blocks), dim3(256), args, 0, stream);
  if (e != hipSuccess) fprintf(stderr, "cooperative launch failed: %s (grid %d)\n", hipGetErrorString(e), grid_blocks);
#else
  const int G = 512;
  for (int l = 0; l < NL; ++l) {
    k_phase<1><<<G, 256, 0, stream>>>(p, l);
    k_phase<2><<<G, 256, 0, stream>>>(p, l);
    k_phase<8><<<G, 256, 0, stream>>>(p, l);
    k_phase<3><<<G, 256, 0, stream>>>(p, l);
    k_phase<4><<<G, 256, 0, stream>>>(p, l);
    k_phase<5><<<G, 256, 0, stream>>>(p, l);
    k_phase<6><<<G, 256, 0, stream>>>(p, l);
    k_phase<7><<<G, 256, 0, stream>>>(p, l);
  }
#endif
}
```

```cpp
#include <hip/hip_runtime.h>
#include <hip/hip_cooperative_groups.h>
#include <stdint.h>
#include <stdio.h>
namespace cg = cooperative_groups;

#ifndef MEGA
#define MEGA 1
#endif

typedef unsigned short bf16_t;
typedef short bf16x8 __attribute__((ext_vector_type(8)));
typedef short s16x4 __attribute__((ext_vector_type(4)));
typedef float f32x4 __attribute__((ext_vector_type(4)));
typedef float f32x2 __attribute__((ext_vector_type(2)));
typedef float f32x16 __attribute__((ext_vector_type(16)));
typedef unsigned u32x4 __attribute__((ext_vector_type(4)));
typedef unsigned u32x2 __attribute__((ext_vector_type(2)));
typedef __bf16 bfv2 __attribute__((ext_vector_type(2)));

#define DI __device__ __forceinline__
#define XCD_BAR_WORDS 3456
DI int tid_() { int t = threadIdx.x; asm volatile("" : "+v"(t)); return t; }

constexpr int DM = 1024, MP = 16384, MS = 512, MT = 16896, NZ = 6272, NL = 4;
constexpr int C_GR = 1664, C_Q = 2176, C_K = 2688, C_V = 3200, C_GA = 3712, C_MR = 4224, C_MA = 5248;
constexpr int SHC = 1664;
constexpr size_t O_YP = 0, O_YS = 16777216, O_KP = 17301504, O_VP = 50855936, O_WP = 84410368, O_SP = 84934656,
                 O_KS = 84961280, O_VS = 86009856, O_WS = 87058432, O_SS = 88107008;

struct Params {
  const float *xp, *xs, *pp, *ps, *ck, *cv, *swkv, *sshift;
  const float *norm_g, *w_in, *shift_mu, *decay_w0, *decay_w2, *iclr_a0, *iclr_a2, *k_k, *k_a, *r_k, *lnx_g, *lnx_b,
      *qng, *kng, *lq1, *lk1, *lq2, *lk2, *subln_g, *w_br_r, *w_br_a, *w_out, *ple_w, *ple_gate_w, *ple_norm_g;
  float* out;
  bf16_t *wt_in, *wt_brr, *wt_bra, *wt_out, *wt_ple, *wt_gate, *w2t, *a2t;
  bf16_t *hn, *z, *vtp, *vts, *kc, *vct, *o_r, *o_a;
  bf16_t *cPT, *cG, *cRT, *cOI, *cBA;
  unsigned* bar;
  float *ss1, *ss2;
};

DI unsigned pk2(float a, float b) { f32x2 v = {a, b}; bfv2 r = __builtin_convertvector(v, bfv2); return __builtin_bit_cast(unsigned, r); }
DI float bf_lo(unsigned u) { return __uint_as_float(u << 16); }
DI float bf_hi(unsigned u) { return __uint_as_float(u & 0xffff0000u); }
DI float bf1(bf16_t u) { return __uint_as_float(((unsigned)u) << 16); }
DI float sigmoidf_(float x) { return __builtin_amdgcn_rcpf(1.0f + __expf(-x)); }
DI float siluf_(float x) { return x * __builtin_amdgcn_rcpf(1.0f + __expf(-x)); }

DI void tr_tile(const float* __restrict__ src, int ld_src, bf16_t* __restrict__ dst, int ld_dst, float* sm) {
  const int tid = tid_();
  const int r = tid >> 4, c4 = (tid & 15) * 4;
#pragma unroll
  for (int i = 0; i < 4; ++i) {
    const int row = r + 16 * i;
    f32x4 v = *(const f32x4*)(src + (size_t)row * ld_src + c4);
    sm[row * 65 + c4 + 0] = v[0]; sm[row * 65 + c4 + 1] = v[1]; sm[row * 65 + c4 + 2] = v[2]; sm[row * 65 + c4 + 3] = v[3];
  }
  __syncthreads();
  const int n = tid >> 2, ks = (tid & 3) * 16;
  u32x4 o0, o1;
  o0[0] = pk2(sm[(ks + 0) * 65 + n], sm[(ks + 1) * 65 + n]);   o0[1] = pk2(sm[(ks + 2) * 65 + n], sm[(ks + 3) * 65 + n]);
  o0[2] = pk2(sm[(ks + 4) * 65 + n], sm[(ks + 5) * 65 + n]);   o0[3] = pk2(sm[(ks + 6) * 65 + n], sm[(ks + 7) * 65 + n]);
  o1[0] = pk2(sm[(ks + 8) * 65 + n], sm[(ks + 9) * 65 + n]);   o1[1] = pk2(sm[(ks + 10) * 65 + n], sm[(ks + 11) * 65 + n]);
  o1[2] = pk2(sm[(ks + 12) * 65 + n], sm[(ks + 13) * 65 + n]); o1[3] = pk2(sm[(ks + 14) * 65 + n], sm[(ks + 15) * 65 + n]);
  *(u32x4*)(dst + (size_t)n * ld_dst + ks) = o0;
  *(u32x4*)(dst + (size_t)n * ld_dst + ks + 8) = o1;
  __syncthreads();
}

constexpr int WCONV_TILES = 1568 + 128 + 128 + 256 + 64 + 256 + 8 + 8;
DI void wconv_tile(const Params& p, int l, int t, float* sm) {
  const float* src; bf16_t* dst; int K, N;
  if (t < 1568) { src = p.w_in + (size_t)l * 1024 * NZ; dst = p.wt_in; K = 1024; N = NZ; }
  else if ((t -= 1568) < 128) { src = p.w_br_r + (size_t)l * 512 * 1024; dst = p.wt_brr; K = 512; N = 1024; }
  else if ((t -= 128) < 128) { src = p.w_br_a + (size_t)l * 512 * 1024; dst = p.wt_bra; K = 512; N = 1024; }
  else if ((t -= 128) < 256) { src = p.w_out + (size_t)l * 1024 * 1024; dst = p.wt_out; K = 1024; N = 1024; }
  else if ((t -= 256) < 64) { src = p.ple_w + (size_t)l * 256 * 1024; dst = p.wt_ple; K = 256; N = 1024; }
  else if ((t -= 64) < 256) { src = p.ple_gate_w + (size_t)l * 1024 * 1024; dst = p.wt_gate; K = 1024; N = 1024; }
  else if ((t -= 256) < 8) { src = p.decay_w2 + (size_t)l * 64 * 512; dst = p.w2t; K = 64; N = 512; }
  else { t -= 8; src = p.iclr_a2 + (size_t)l * 64 * 512; dst = p.a2t; K = 64; N = 512; }
  const int ntn = N / 64; const int tk = t / ntn, tn = t % ntn;
  tr_tile(src + (size_t)(tk * 64) * N + tn * 64, N, dst + (size_t)(tn * 64) * K + tk * 64, K, sm);
}

DI const float* x_row(const Params& p, int l, int r) {
  if (l == 0) return r < MP ? p.xp + (size_t)r * DM : p.xs + (size_t)(r - MP) * DM;
  return p.out + (size_t)r * DM;
}
DI void cache_item(const Params& p, int l, int c, char* lds) {
  const int tid = tid_();
  if (c < 1024) {
    const float* src = p.ck + (size_t)l * 8 * 1024 * 512 + (size_t)c * 4096 + tid * 16;
    bf16_t* dst = p.kc + (size_t)c * 4096 + tid * 16;
    f32x4 a0 = *(const f32x4*)(src), a1 = *(const f32x4*)(src + 4), a2 = *(const f32x4*)(src + 8), a3 = *(const f32x4*)(src + 12);
    u32x4 o0, o1;
    o0[0] = pk2(a0[0], a0[1]); o0[1] = pk2(a0[2], a0[3]); o0[2] = pk2(a1[0], a1[1]); o0[3] = pk2(a1[2], a1[3]);
    o1[0] = pk2(a2[0], a2[1]); o1[1] = pk2(a2[2], a2[3]); o1[2] = pk2(a3[0], a3[1]); o1[3] = pk2(a3[2], a3[3]);
    *(u32x4*)dst = o0; *(u32x4*)(dst + 8) = o1;
  } else {
    c -= 1024;
    const int bh = c >> 5, tt = c & 31; const int b = bh >> 2, h = bh & 3; const int tk = tt >> 1, tn = tt & 1;
    const float* src = p.cv + (size_t)l * 8 * 1024 * 512 + ((size_t)(b * 1024 + tk * 64)) * 512 + h * 128 + tn * 64;
    bf16_t* dst = p.vct + ((size_t)(bh * 128 + tn * 64)) * 1024 + tk * 64;
    tr_tile(src, 512, dst, 1024, (float*)lds);
  }
}
DI void phase_norm0(const Params& p, char* lds) {
  const int tid = tid_(), wave = __builtin_amdgcn_readfirstlane(tid >> 6), lane = tid & 63;
  const float* g = p.norm_g;
  const int n_norm = MT / 8;
  const int n_items = n_norm + 2048 + WCONV_TILES;
  for (int it = blockIdx.x; it < n_items; it += gridDim.x) {
    if (it < n_norm) {
      const int r0 = it * 8 + wave * 2;
      f32x4 v[2][4]; float ss[2] = {0.f, 0.f};
#pragma unroll
      for (int k = 0; k < 2; ++k) {
        const float* x = x_row(p, 0, r0 + k);
#pragma unroll
        for (int i = 0; i < 4; ++i) v[k][i] = *(const f32x4*)(x + lane * 4 + 256 * i);
      }
      f32x4 gv[4];
#pragma unroll
      for (int i = 0; i < 4; ++i) gv[i] = *(const f32x4*)(g + lane * 4 + 256 * i);
#pragma unroll
      for (int k = 0; k < 2; ++k) {
#pragma unroll
        for (int i = 0; i < 4; ++i) ss[k] += v[k][i][0] * v[k][i][0] + v[k][i][1] * v[k][i][1] + v[k][i][2] * v[k][i][2] + v[k][i][3] * v[k][i][3];
#pragma unroll
        for (int o = 32; o >= 1; o >>= 1) ss[k] += __shfl_xor(ss[k], o);
        const float rstd = rsqrtf(ss[k] * (1.0f / 1024.0f) + 1e-6f);
#pragma unroll
        for (int i = 0; i < 4; ++i) {
          u32x2 o; o[0] = pk2(v[k][i][0] * rstd * gv[i][0], v[k][i][1] * rstd * gv[i][1]); o[1] = pk2(v[k][i][2] * rstd * gv[i][2], v[k][i][3] * rstd * gv[i][3]);
          *(u32x2*)(p.hn + (size_t)(r0 + k) * DM + lane * 4 + 256 * i) = o;
        }
        if (lane == 0) p.ss1[r0 + k] = 1024.0f * (1.0f - 1e-6f);
      }
    } else if (it < n_norm + 2048) {
      cache_item(p, 0, it - n_norm, lds);
    } else {
      wconv_tile(p, 0, it - n_norm - 2048, (float*)lds);
    }
  }
}
DI void zero_f32(float* a, int n) {
  for (int i = blockIdx.x * 256 + (int)threadIdx.x; i < n; i += gridDim.x * 256) a[i] = 0.f;
}

constexpr int GLD = 72;
template <bool A_F32>
DI void gemm_core(f32x4 (&acc)[4][4], const void* Ap, int lda, const bf16_t* Bp, int ldb, int K, char* lds) {
  bf16_t* As = (bf16_t*)lds;
  bf16_t* Bs = (bf16_t*)(lds + 2 * 128 * GLD * 2);
  const int tid = tid_(), wave = __builtin_amdgcn_readfirstlane(tid >> 6), lane = tid & 63;
  const int wm = wave >> 1, wn = wave & 1, l15 = lane & 15, quad = lane >> 4;
  const int nk = K / 64;
  u32x4 ra[4], rb[4];
  auto gload = [&](int kt) {
#pragma unroll
    for (int i = 0; i < 4; ++i) {
      const int c = tid + 256 * i; const int row = c >> 3, c8 = (c & 7) * 8;
      if (!A_F32) ra[i] = *(const u32x4*)((const bf16_t*)Ap + (size_t)row * lda + kt * 64 + c8);
      rb[i] = *(const u32x4*)(Bp + (size_t)row * ldb + kt * 64 + c8);
    }
  };
  auto sstore = [&](int buf, int kt) {
#pragma unroll
    for (int i = 0; i < 4; ++i) {
      const int c = tid + 256 * i; const int row = c >> 3, c8 = (c & 7) * 8;
      if (A_F32) {
        const float* a = (const float*)Ap + (size_t)row * lda + kt * 64 + c8;
        const f32x4 v0 = *(const f32x4*)a, v1 = *(const f32x4*)(a + 4);
        u32x4 t; t[0] = pk2(v0[0], v0[1]); t[1] = pk2(v0[2], v0[3]); t[2] = pk2(v1[0], v1[1]); t[3] = pk2(v1[2], v1[3]);
        *(u32x4*)(As + (buf * 128 + row) * GLD + c8) = t;
      } else {
        *(u32x4*)(As + (buf * 128 + row) * GLD + c8) = ra[i];
      }
      *(u32x4*)(Bs + (buf * 128 + row) * GLD + c8) = rb[i];
    }
  };
  gload(0); sstore(0, 0); __syncthreads();
  for (int kt = 0; kt < nk; ++kt) {
    const int buf = kt & 1;
    if (kt + 1 < nk) gload(kt + 1);
#pragma unroll
    for (int ks = 0; ks < 2; ++ks) {
      bf16x8 af[4], bfr[4];
#pragma unroll
      for (int i = 0; i < 4; ++i) {
        af[i] = *(const bf16x8*)(As + (buf * 128 + wm * 64 + i * 16 + l15) * GLD + ks * 32 + quad * 8);
        bfr[i] = *(const bf16x8*)(Bs + (buf * 128 + wn * 64 + i * 16 + l15) * GLD + ks * 32 + quad * 8);
      }
#pragma unroll
      for (int mi = 0; mi < 4; ++mi)
#pragma unroll
        for (int ni = 0; ni < 4; ++ni) acc[mi][ni] = __builtin_amdgcn_mfma_f32_16x16x32_bf16(bfr[ni], af[mi], acc[mi][ni], 0, 0, 0);
    }
    if (kt + 1 < nk) sstore(buf ^ 1, kt + 1);
    __syncthreads();
  }
}
#define LASP __attribute__((address_space(3)))
DI void gemm_dma(f32x4 (&acc)[4][4], const bf16_t* Ap, int lda, const bf16_t* Bp, int ldb, int K, char* lds) {
  const int tid = tid_(), wave = __builtin_amdgcn_readfirstlane(tid >> 6), lane = tid & 63;
  const int wm = wave >> 1, wn = wave & 1, l15 = lane & 15, quad = lane >> 4;
  const int nk = K / 64;
  const int lrow = lane >> 3, lpc = lane & 7;
  const bf16_t* ga[4]; const bf16_t* gb[4];
#pragma unroll
  for (int i = 0; i < 4; ++i) {
    const int row = (wave * 4 + i) * 8 + lrow; const int q = lpc ^ (row & 7);
    ga[i] = Ap + (size_t)row * lda + q * 8; gb[i] = Bp + (size_t)row * ldb + q * 8;
  }
  auto issue = [&](int kt) {
    char* sb = lds + (kt & 1) * 32768 + wave * 4096;
#pragma unroll
    for (int i = 0; i < 4; ++i) {
      __builtin_amdgcn_global_load_lds((const unsigned*)(ga[i] + kt * 64), (LASP unsigned*)(sb + i * 1024), 16, 0, 0);
      __builtin_amdgcn_global_load_lds((const unsigned*)(gb[i] + kt * 64), (LASP unsigned*)(sb + 16384 + i * 1024), 16, 0, 0);
    }
  };
  const int sw = l15 & 7;
  const unsigned lbase = (unsigned)(size_t)(LASP char*)lds;
  const unsigned a0 = (unsigned)((wm * 64 + l15) * 128 + ((quad ^ sw) * 16)), a1 = (unsigned)((wm * 64 + l15) * 128 + (((4 + quad) ^ sw) * 16));
  const unsigned b0 = 16384u + (unsigned)((wn * 64 + l15) * 128 + ((quad ^ sw) * 16)), b1 = 16384u + (unsigned)((wn * 64 + l15) * 128 + (((4 + quad) ^ sw) * 16));
  asm volatile("s_waitcnt vmcnt(0)" ::: "memory");
  __builtin_amdgcn_s_barrier();
  asm volatile("" ::: "memory");
  issue(0);
  for (int kt = 0; kt < nk; ++kt) {
    asm volatile("s_waitcnt vmcnt(0)" ::: "memory");
    __builtin_amdgcn_s_barrier();
    asm volatile("" ::: "memory");
    if (kt + 1 < nk) issue(kt + 1);
    const unsigned sa = lbase + (unsigned)((kt & 1) * 32768);
    bf16x8 af[4], bfr[4], ag[4], bg[4];
    asm volatile("ds_read_b128 %0, %8\n\tds_read_b128 %1, %8 offset:2048\n\tds_read_b128 %2, %8 offset:4096\n\tds_read_b128 %3, %8 offset:6144\n\t"
                 "ds_read_b128 %4, %9\n\tds_read_b128 %5, %9 offset:2048\n\tds_read_b128 %6, %9 offset:4096\n\tds_read_b128 %7, %9 offset:6144"
                 : "=&v"(af[0]), "=&v"(af[1]), "=&v"(af[2]), "=&v"(af[3]), "=&v"(bfr[0]), "=&v"(bfr[1]), "=&v"(bfr[2]), "=&v"(bfr[3])
                 : "v"(sa + a0), "v"(sa + b0) : "memory");
    asm volatile("ds_read_b128 %0, %16\n\tds_read_b128 %1, %16 offset:2048\n\tds_read_b128 %2, %16 offset:4096\n\tds_read_b128 %3, %16 offset:6144\n\t"
                 "ds_read_b128 %4, %17\n\tds_read_b128 %5, %17 offset:2048\n\tds_read_b128 %6, %17 offset:4096\n\tds_read_b128 %7, %17 offset:6144\n\t"
                 "s_waitcnt lgkmcnt(8)"
                 : "=&v"(ag[0]), "=&v"(ag[1]), "=&v"(ag[2]), "=&v"(ag[3]), "=&v"(bg[0]), "=&v"(bg[1]), "=&v"(bg[2]), "=&v"(bg[3]),
                   "+v"(af[0]), "+v"(af[1]), "+v"(af[2]), "+v"(af[3]), "+v"(bfr[0]), "+v"(bfr[1]), "+v"(bfr[2]), "+v"(bfr[3])
                 : "v"(sa + a1), "v"(sa + b1) : "memory");
#pragma unroll
    for (int mi = 0; mi < 4; ++mi)
#pragma unroll
      for (int ni = 0; ni < 4; ++ni) acc[mi][ni] = __builtin_amdgcn_mfma_f32_16x16x32_bf16(bfr[ni], af[mi], acc[mi][ni], 0, 0, 0);
    asm volatile("s_waitcnt lgkmcnt(0)" : "+v"(ag[0]), "+v"(ag[1]), "+v"(ag[2]), "+v"(ag[3]), "+v"(bg[0]), "+v"(bg[1]), "+v"(bg[2]), "+v"(bg[3]) :: "memory");
#pragma unroll
    for (int mi = 0; mi < 4; ++mi)
#pragma unroll
      for (int ni = 0; ni < 4; ++ni) acc[mi][ni] = __builtin_amdgcn_mfma_f32_16x16x32_bf16(bg[ni], ag[mi], acc[mi][ni], 0, 0, 0);
  }
  asm volatile("" ::: "memory");
  __builtin_amdgcn_s_barrier();
  asm volatile("" ::: "memory");
}
DI void zero_acc(f32x4 (&acc)[4][4]) {
#pragma unroll
  for (int i = 0; i < 4; ++i)
#pragma unroll
    for (int j = 0; j < 4; ++j) acc[i][j] = (f32x4){0.f, 0.f, 0.f, 0.f};
}

DI int xcd_tile(int r, int T) {
  const int x = blockIdx.x & 7, j = blockIdx.x >> 3, nb = gridDim.x >> 3;
  if (j >= nb) return -1;
  const int start = (int)(((long)x * T) / 8), end = (int)(((long)(x + 1) * T) / 8);
  const int g = start + r * nb + j;
  return g < end ? g : -1;
}
DI void tile_decode(int g, int nM, int nN, int& mt, int& nt) {
  const int per = 8 * nN; const int grp = g / per, idx = g - grp * per; const int gm0 = grp * 8;
  const int gsz = (nM - gm0) < 8 ? (nM - gm0) : 8;
  nt = idx / gsz; mt = gm0 + (idx - nt * gsz);
}
DI void phase_gemm_in(const Params& p, int l, char* lds) {
  const int tid = tid_(), wave = __builtin_amdgcn_readfirstlane(tid >> 6), lane = tid & 63;
  const int wm = wave >> 1, wn = wave & 1, l15 = lane & 15, quad = lane >> 4;
  const bf16_t* Wt = p.wt_in;
  const int NTN = 49, NTM = 132;
  for (int r = 0;; ++r) {
    const int g = xcd_tile(r, NTN * NTM); if (g < 0) break;
    int mt, nt; tile_decode(g, NTM, NTN, mt, nt);
    f32x4 acc[4][4]; zero_acc(acc);
    gemm_dma(acc, p.hn + (size_t)mt * 128 * DM, DM, Wt + (size_t)nt * 128 * DM, DM, DM, lds);
    const int colb = nt * 128 + wn * 64 + quad * 4;
    {
#pragma unroll
      for (int mi = 0; mi < 4; ++mi) {
        const float rs = rsqrtf(p.ss1[mt * 128 + wm * 64 + mi * 16 + l15] * (1.0f / 1024.0f) + 1e-6f);
#pragma unroll
        for (int ni = 0; ni < 4; ++ni) acc[mi][ni] = acc[mi][ni] * rs;
      }
    }
    int kind;
    if (nt < 13) kind = 0; else if (nt < 17) kind = 1; else if (nt < 21) kind = 2; else if (nt < 25) kind = 3; else if (nt < 29) kind = 4; else if (nt < 33) kind = 1; else kind = 5;
#pragma unroll
    for (int mi = 0; mi < 4; ++mi) {
      const int R = mt * 128 + wm * 64 + mi * 16 + l15;
      const bool isp = R < MP; const int rs = R - MP;
      bf16_t* zrow = p.z + (size_t)R * NZ;
      if (kind == 0) {
        const bool last = isp ? ((R & 4095) == 4095) : ((rs & 63) == 63);
        float* so = isp ? p.out + O_SP + (size_t)(l * 4 + (R >> 12)) * SHC : p.out + O_SS + (size_t)(l * 8 + (rs >> 6)) * SHC;
#pragma unroll
        for (int ni = 0; ni < 4; ++ni) {
          const int c = colb + ni * 16; const f32x4 v = acc[mi][ni];
          u32x2 o; o[0] = pk2(v[0], v[1]); o[1] = pk2(v[2], v[3]); *(u32x2*)(zrow + c) = o;
          if (last) *(f32x4*)(so + c) = v;
        }
      } else if (kind == 1 || kind == 5) {
#pragma unroll
        for (int ni = 0; ni < 4; ++ni) {
          const int c = colb + ni * 16; f32x4 v = acc[mi][ni];
#pragma unroll
          for (int e = 0; e < 4; ++e) v[e] = (kind == 1) ? siluf_(v[e]) : sigmoidf_(v[e]);
          u32x2 o; o[0] = pk2(v[0], v[1]); o[1] = pk2(v[2], v[3]); *(u32x2*)(zrow + c) = o;
        }
      } else if (kind == 2 || kind == 3) {
        float ss = 0.f;
#pragma unroll
        for (int ni = 0; ni < 4; ++ni) { const f32x4 v = acc[mi][ni]; ss += v[0] * v[0] + v[1] * v[1] + v[2] * v[2] + v[3] * v[3]; }
        ss += __shfl_xor(ss, 16); ss += __shfl_xor(ss, 32);
        const float rstd = rsqrtf(ss * (1.0f / 64.0f) + 1e-6f);
        const float* g = (kind == 2 ? p.qng : p.kng) + l * 64;
        float* ko = isp ? p.out + O_KP + ((size_t)l * MP + R) * 512 : p.out + O_KS + ((size_t)l * MS + rs) * 512;
#pragma unroll
        for (int ni = 0; ni < 4; ++ni) {
          const int c = colb + ni * 16; const int d = ni * 16 + quad * 4;
          const f32x4 gv = *(const f32x4*)(g + d); f32x4 v = acc[mi][ni];
#pragma unroll
          for (int e = 0; e < 4; ++e) v[e] = v[e] * rstd * gv[e];
          u32x2 o; o[0] = pk2(v[0], v[1]); o[1] = pk2(v[2], v[3]); *(u32x2*)(zrow + c) = o;
          if (kind == 3) *(f32x4*)(ko + (c - C_K)) = v;
        }
      } else {
        float* vo = isp ? p.out + O_VP + ((size_t)l * MP + R) * 512 : p.out + O_VS + ((size_t)l * MS + rs) * 512;
#pragma unroll
        for (int ni = 0; ni < 4; ++ni) {
          const int cv = colb + ni * 16 - C_V; const f32x4 v = acc[mi][ni];
          *(f32x4*)(vo + cv) = v;
          const int h = cv >> 7, vd = cv & 127;
          if (isp) {
            bf16_t* vt = p.vtp + ((size_t)(((R >> 12) * 4 + h) * 128 + vd)) * 4096 + (R & 4095);
#pragma unroll
            for (int e = 0; e < 4; ++e) vt[(size_t)e * 4096] = (bf16_t)(pk2(v[e], 0.f) & 0xffff);
          } else {
            bf16_t* vt = p.vts + ((size_t)(((rs >> 6) * 4 + h) * 128 + vd)) * 64 + (rs & 63);
#pragma unroll
            for (int e = 0; e < 4; ++e) vt[(size_t)e * 64] = (bf16_t)(pk2(v[e], 0.f) & 0xffff);
          }
        }
      }
    }
  }
  zero_f32(p.ss2, MT);
  if (l > 0) for (int it = blockIdx.x; it < 320; it += gridDim.x) wconv_tile(p, l, 2080 + it, (float*)lds);
}

constexpr int NCH_P = 4096, NCH = 4224;
constexpr int XLD = 40;
DI f32x4 mm16(const bf16_t* Xrow, int ldx, const bf16_t* Yrow, int ldy, int ksteps, f32x4 acc, int l15, int quad) {
  for (int ks = 0; ks < ksteps; ++ks) {
    const bf16x8 a = *(const bf16x8*)(Xrow + l15 * ldx + ks * 32 + quad * 8);
    const bf16x8 b = *(const bf16x8*)(Yrow + l15 * ldy + ks * 32 + quad * 8);
    acc = __builtin_amdgcn_mfma_f32_16x16x32_bf16(a, b, acc, 0, 0, 0);
  }
  return acc;
}
DI void chunk_item(const Params& p, int l, int item, char* lds) {
  const int tid = tid_(), wave = __builtin_amdgcn_readfirstlane(tid >> 6), lane = tid & 63, l15 = lane & 15, quad = lane >> 4;
  const bool isp = item < NCH_P;
  int bh, c;
  if (isp) { bh = item >> 7; c = item & 127; } else { const int j = item - NCH_P; bh = j >> 1; c = j & 1; }
  const int b = bh >> 3, h = bh & 7;
  const int t0 = c * 32; const int row0 = (isp ? b * 4096 : MP + b * 64) + t0;
  float* s_r = (float*)lds;
  float* s_kf = s_r + 2048;
  float* s_v = s_kf + 2048;
  float* s_w = s_v + 2048;
  float* s_kk = s_w + 2048;
  float* s_bb = s_kk + 2048;
  bf16_t* s_wd = (bf16_t*)(lds + 49152);
  bf16_t* s_ad = (bf16_t*)(lds + 53760);
  float* s_bonus = (float*)(lds + 58368);
  float* s_wl = (float*)(lds + 58880);
  float* s_rhs = (float*)lds;
  bf16_t* s_A = (bf16_t*)lds;
  bf16_t* s_Bm = (bf16_t*)(lds + 4608);
  bf16_t* s_Kp = (bf16_t*)(lds + 9216);
  bf16_t* s_R = (bf16_t*)(lds + 16384);
  bf16_t* s_BmT = (bf16_t*)(lds + 20992);
  bf16_t* s_KpT = (bf16_t*)(lds + 26112);
  bf16_t* s_VmT = (bf16_t*)(lds + 31232);
  bf16_t* s_Lak = (bf16_t*)(lds + 36352);
  bf16_t* s_Mrk = (bf16_t*)(lds + 38912);
  bf16_t* s_Mrb = (bf16_t*)(lds + 41472);
  float* s_labT = (float*)(lds + 44032);
  bf16_t* s_XT = (bf16_t*)(lds + 48640);

  const int mat = wave >> 1, tt = wave & 1;
  const bf16_t* wl = (mat == 0 ? p.w2t : p.a2t) + (size_t)(h * 64) * 64;
  const float* mu = p.shift_mu + l * SHC;
  const float* w0 = p.decay_w0 + l * 512 + h * 64;
  const float* a0 = p.iclr_a0 + l * 512 + h * 64;
  const float* kkp = p.k_k + l * 512 + h * 64;
  const float* kap = p.k_a + l * 512 + h * 64;
  const float* rkp = p.r_k + l * 512 + h * 64;
  const float* lb = p.lnx_b + l * 512 + h * 64;
  const int ptok = tid >> 3, pcs = (tid & 7) * 8;
  {
    const int t = t0 + ptok; const size_t row = (size_t)(row0 + ptok);
#pragma unroll
    for (int g = 0; g < 5; ++g) {
      const int zc = (g < 3 ? g * 512 + h * 64 : 1536 + (g - 3) * 64) + pcs;
      const u32x4 cu = *(const u32x4*)(p.z + row * NZ + zc);
      float cur[8], prv[8];
#pragma unroll
      for (int e = 0; e < 4; ++e) { cur[2 * e] = bf_lo(cu[e]); cur[2 * e + 1] = bf_hi(cu[e]); }
      if (t > 0) {
        const u32x4 pu = *(const u32x4*)(p.z + (row - 1) * NZ + zc);
#pragma unroll
        for (int e = 0; e < 4; ++e) { prv[2 * e] = bf_lo(pu[e]); prv[2 * e + 1] = bf_hi(pu[e]); }
      } else if (isp) {
#pragma unroll
        for (int e = 0; e < 8; ++e) prv[e] = 0.f;
      } else {
        const float* sp = p.sshift + (size_t)(l * 8 + b) * SHC + zc;
#pragma unroll
        for (int e = 0; e < 8; ++e) prv[e] = sp[e];
      }
      float zs[8];
#pragma unroll
      for (int e = 0; e < 8; ++e) zs[e] = cur[e] + (prv[e] - cur[e]) * mu[zc + e];
      if (g < 3) {
        float* d = (g == 0 ? s_r : g == 1 ? s_kf : s_v) + ptok * 64 + pcs;
        *(f32x4*)d = (f32x4){zs[0], zs[1], zs[2], zs[3]}; *(f32x4*)(d + 4) = (f32x4){zs[4], zs[5], zs[6], zs[7]};
      } else {
        if (g == 3) {
#pragma unroll
          for (int e = 0; e < 8; ++e) { const float ex = __expf(2.f * zs[e]); zs[e] = 1.f - 2.f * __builtin_amdgcn_rcpf(ex + 1.f); }
        }
        u32x4 o; o[0] = pk2(zs[0], zs[1]); o[1] = pk2(zs[2], zs[3]); o[2] = pk2(zs[4], zs[5]); o[3] = pk2(zs[6], zs[7]);
        *(u32x4*)((g == 3 ? s_wd : s_ad) + ptok * 72 + pcs) = o;
      }
    }
  }
  __syncthreads();
  {
    const bf16_t* At = (mat == 0 ? s_wd : s_ad);
    bf16x8 af[2];
#pragma unroll
    for (int ks = 0; ks < 2; ++ks) af[ks] = *(const bf16x8*)(At + (tt * 16 + l15) * 72 + ks * 32 + quad * 8);
#pragma unroll
    for (int ct = 0; ct < 4; ++ct) {
      f32x4 d = (f32x4){0.f, 0.f, 0.f, 0.f};
#pragma unroll
      for (int ks = 0; ks < 2; ++ks) {
        const bf16x8 wfr = *(const bf16x8*)(wl + (size_t)(ct * 16 + l15) * 64 + ks * 32 + quad * 8);
        d = __builtin_amdgcn_mfma_f32_16x16x32_bf16(wfr, af[ks], d, 0, 0, 0);
      }
      const int ch = ct * 16 + quad * 4; const int tok = tt * 16 + l15;
      f32x4 o;
      if (mat == 0) {
#pragma unroll
        for (int e = 0; e < 4; ++e) {
          const float y = -(w0[ch + e] + d[e]);
          const float sp = fmaxf(y, 0.f) + __logf(1.0f + __expf(-fabsf(y)));
          o[e] = -__expf(-sp - 0.5f);
        }
        *(f32x4*)(s_w + tok * 64 + ch) = o;
      } else {
#pragma unroll
        for (int e = 0; e < 4; ++e) o[e] = sigmoidf_(a0[ch + e] + d[e]);
        *(f32x4*)(s_bb + tok * 64 + ch) = o;
      }
    }
  }
  __syncthreads();
  float r_[8], kf[8], kk[8], bbv[8], v_[8], bon;
  {
    float k_[8], a_[8];
    *(f32x4*)&k_[0] = *(const f32x4*)(s_kf + ptok * 64 + pcs); *(f32x4*)&k_[4] = *(const f32x4*)(s_kf + ptok * 64 + pcs + 4);
    *(f32x4*)&a_[0] = *(const f32x4*)(s_bb + ptok * 64 + pcs); *(f32x4*)&a_[4] = *(const f32x4*)(s_bb + ptok * 64 + pcs + 4);
    *(f32x4*)&r_[0] = *(const f32x4*)(s_r + ptok * 64 + pcs); *(f32x4*)&r_[4] = *(const f32x4*)(s_r + ptok * 64 + pcs + 4);
    *(f32x4*)&v_[0] = *(const f32x4*)(s_v + ptok * 64 + pcs); *(f32x4*)&v_[4] = *(const f32x4*)(s_v + ptok * 64 + pcs + 4);
    float ss = 0.f; bon = 0.f;
#pragma unroll
    for (int e = 0; e < 8; ++e) {
      kk[e] = k_[e] * kkp[pcs + e]; ss += kk[e] * kk[e];
      kf[e] = k_[e] * (1.f + (a_[e] - 1.f) * kap[pcs + e]);
      bon += r_[e] * kf[e] * rkp[pcs + e];
    }
    ss += __shfl_xor(ss, 1); ss += __shfl_xor(ss, 2); ss += __shfl_xor(ss, 4);
    bon += __shfl_xor(bon, 1); bon += __shfl_xor(bon, 2); bon += __shfl_xor(bon, 4);
    const float inv = 1.0f / fmaxf(sqrtf(ss), 1e-12f);
#pragma unroll
    for (int e = 0; e < 8; ++e) { kk[e] *= inv; bbv[e] = kk[e] * a_[e]; }
  }
  if (tid < 64) {
    float run = 0.f;
#pragma unroll 8
    for (int t = 0; t < 32; ++t) { run += s_w[t * 64 + tid]; s_w[t * 64 + tid] = run; }
  }
  __syncthreads();
  {
    float cw[8], cwp[8];
    *(f32x4*)&cw[0] = *(const f32x4*)(s_w + ptok * 64 + pcs); *(f32x4*)&cw[4] = *(const f32x4*)(s_w + ptok * 64 + pcs + 4);
    if (ptok > 0) { *(f32x4*)&cwp[0] = *(const f32x4*)(s_w + (ptok - 1) * 64 + pcs); *(f32x4*)&cwp[4] = *(const f32x4*)(s_w + (ptok - 1) * 64 + pcs + 4); }
    else {
#pragma unroll
      for (int e = 0; e < 8; ++e) cwp[e] = 0.f;
    }
    __syncthreads();
    float av[8], bm[8], kp[8], rr[8];
#pragma unroll
    for (int e = 0; e < 8; ++e) {
      const float ec = __expf(cw[e]), en = __expf(-cw[e]), ep = __expf(cwp[e]);
      av[e] = kk[e] * ep; bm[e] = bbv[e] * en; kp[e] = kf[e] * en; rr[e] = r_[e] * ec;
      if (ptok == 31) s_wl[pcs + e] = ec;
    }
    u32x4 o;
    o[0] = pk2(av[0], av[1]); o[1] = pk2(av[2], av[3]); o[2] = pk2(av[4], av[5]); o[3] = pk2(av[6], av[7]); *(u32x4*)(s_A + ptok * 72 + pcs) = o;
    o[0] = pk2(bm[0], bm[1]); o[1] = pk2(bm[2], bm[3]); o[2] = pk2(bm[4], bm[5]); o[3] = pk2(bm[6], bm[7]); *(u32x4*)(s_Bm + ptok * 72 + pcs) = o;
#pragma unroll
    for (int e = 0; e < 4; ++e) { s_BmT[(pcs + 2 * e) * XLD + ptok] = (bf16_t)(o[e] & 0xffff); s_BmT[(pcs + 2 * e + 1) * XLD + ptok] = (bf16_t)(o[e] >> 16); }
    o[0] = pk2(kp[0], kp[1]); o[1] = pk2(kp[2], kp[3]); o[2] = pk2(kp[4], kp[5]); o[3] = pk2(kp[6], kp[7]); *(u32x4*)(s_Kp + ptok * 72 + pcs) = o;
#pragma unroll
    for (int e = 0; e < 4; ++e) { s_KpT[(pcs + 2 * e) * XLD + ptok] = (bf16_t)(o[e] & 0xffff); s_KpT[(pcs + 2 * e + 1) * XLD + ptok] = (bf16_t)(o[e] >> 16); }
    o[0] = pk2(rr[0], rr[1]); o[1] = pk2(rr[2], rr[3]); o[2] = pk2(rr[4], rr[5]); o[3] = pk2(rr[6], rr[7]); *(u32x4*)(s_R + ptok * 72 + pcs) = o;
    o[0] = pk2(v_[0], v_[1]); o[1] = pk2(v_[2], v_[3]); o[2] = pk2(v_[4], v_[5]); o[3] = pk2(v_[6], v_[7]);
#pragma unroll
    for (int e = 0; e < 4; ++e) { s_VmT[(pcs + 2 * e) * XLD + ptok] = (bf16_t)(o[e] & 0xffff); s_VmT[(pcs + 2 * e + 1) * XLD + ptok] = (bf16_t)(o[e] >> 16); }
    u32x4 ob;
    ob[0] = pk2(lb[pcs + 0] + bon * v_[0], lb[pcs + 1] + bon * v_[1]); ob[1] = pk2(lb[pcs + 2] + bon * v_[2], lb[pcs + 3] + bon * v_[3]);
    ob[2] = pk2(lb[pcs + 4] + bon * v_[4], lb[pcs + 5] + bon * v_[5]); ob[3] = pk2(lb[pcs + 6] + bon * v_[6], lb[pcs + 7] + bon * v_[7]);
    *(u32x4*)(p.cBA + ((size_t)item * 32 + ptok) * 64 + pcs) = ob;
  }
  __syncthreads();
  {
    const bf16_t* X = (wave < 2) ? s_A : s_R;
    const bf16_t* Y = (wave == 0 || wave == 3) ? s_Bm : s_Kp;
    const bool strict = wave < 2;
#pragma unroll
    for (int ti = 0; ti < 2; ++ti)
#pragma unroll
      for (int ii = 0; ii < 2; ++ii) {
        f32x4 d = (f32x4){0.f, 0.f, 0.f, 0.f};
        if (ii <= ti) d = mm16(X + ti * 16 * 72, 72, Y + ii * 16 * 72, 72, 2, d, l15, quad);
        const int i = ii * 16 + l15;
#pragma unroll
        for (int e = 0; e < 4; ++e) {
          const int t = ti * 16 + quad * 4 + e;
          const bool keep = strict ? (i < t) : (i <= t);
          const float val = keep ? d[e] : 0.f;
          if (wave == 0) s_labT[i * 36 + t] = val;
          else { bf16_t* dst = (wave == 1 ? s_Lak : wave == 2 ? s_Mrk : s_Mrb); dst[t * XLD + i] = (bf16_t)(pk2(val, 0.f) & 0xffff); }
        }
      }
  }
  const u32x4 acap = *(const u32x4*)(s_A + ptok * 72 + pcs);
  __syncthreads();
  {
    float* d = s_rhs + ptok * 128 + pcs;
    *(f32x4*)d = (f32x4){bf_lo(acap[0]), bf_hi(acap[0]), bf_lo(acap[1]), bf_hi(acap[1])};
    *(f32x4*)(d + 4) = (f32x4){bf_lo(acap[2]), bf_hi(acap[2]), bf_lo(acap[3]), bf_hi(acap[3])};
  }
  {
    const int ti = wave & 1;
#pragma unroll
    for (int vv = 0; vv < 2; ++vv) {
      const int vi = (wave >> 1) * 2 + vv;
      f32x4 d = (f32x4){0.f, 0.f, 0.f, 0.f};
      d = mm16(s_Lak + ti * 16 * XLD, XLD, s_VmT + vi * 16 * XLD, XLD, 1, d, l15, quad);
#pragma unroll
      for (int e = 0; e < 4; ++e) s_rhs[(ti * 16 + quad * 4 + e) * 128 + 64 + vi * 16 + l15] = d[e];
    }
  }
  __syncthreads();
  if (tid < 128) {
    float x[32];
#pragma unroll
    for (int t = 0; t < 32; ++t) x[t] = s_rhs[t * 128 + tid];
#pragma unroll
    for (int i = 0; i < 31; ++i) {
      const float xi = x[i];
#pragma unroll
      for (int t4 = ((i + 1) >> 2); t4 < 8; ++t4) {
        const f32x4 lv = *(const f32x4*)(s_labT + i * 36 + t4 * 4);
#pragma unroll
        for (int e = 0; e < 4; ++e) { const int t = t4 * 4 + e; if (t > i) x[t] -= lv[e] * xi; }
      }
    }
#pragma unroll
    for (int q4 = 0; q4 < 4; ++q4) {
      u32x4 o; o[0] = pk2(x[8 * q4], x[8 * q4 + 1]); o[1] = pk2(x[8 * q4 + 2], x[8 * q4 + 3]); o[2] = pk2(x[8 * q4 + 4], x[8 * q4 + 5]); o[3] = pk2(x[8 * q4 + 6], x[8 * q4 + 7]);
      *(u32x4*)(s_XT + tid * XLD + q4 * 8) = o;
    }
  }
  __syncthreads();
  {
    const f32x4 z4 = (f32x4){0.f, 0.f, 0.f, 0.f};
    bf16_t* gPT = p.cPT + (size_t)item * 4096;
    const float wl_c = s_wl[wave * 16 + l15];
#pragma unroll
    for (int k1t = 0; k1t < 4; ++k1t) {
      f32x4 d = mm16(s_XT + k1t * 16 * XLD, XLD, s_BmT + wave * 16 * XLD, XLD, 1, z4, l15, quad);
      const int k2 = wave * 16 + l15, k1 = k1t * 16 + quad * 4;
      float o[4];
#pragma unroll
      for (int e = 0; e < 4; ++e) o[e] = ((k1 + e == k2 ? 1.f : 0.f) - d[e]) * wl_c;
      u32x2 ov; ov[0] = pk2(o[0], o[1]); ov[1] = pk2(o[2], o[3]);
      *(u32x2*)(gPT + k2 * 64 + k1) = ov;
    }
    bf16_t* gG = p.cG + (size_t)item * 4096;
#pragma unroll
    for (int k2t = 0; k2t < 4; ++k2t) {
      const f32x4 d1 = mm16(s_KpT + k2t * 16 * XLD, XLD, s_VmT + wave * 16 * XLD, XLD, 1, z4, l15, quad);
      const f32x4 d2 = mm16(s_BmT + k2t * 16 * XLD, XLD, s_XT + (64 + wave * 16) * XLD, XLD, 1, z4, l15, quad);
      const int k2 = k2t * 16 + quad * 4, v = wave * 16 + l15;
      const f32x4 wv = *(const f32x4*)(s_wl + k2);
      u32x2 ov; ov[0] = pk2((d1[0] - d2[0]) * wv[0], (d1[1] - d2[1]) * wv[1]); ov[1] = pk2((d1[2] - d2[2]) * wv[2], (d1[3] - d2[3]) * wv[3]);
      *(u32x2*)(gG + v * 64 + k2) = ov;
    }
    bf16_t* gRT = p.cRT + (size_t)item * 2048;
    bf16_t* gOI = p.cOI + (size_t)item * 2048;
#pragma unroll
    for (int ti = 0; ti < 2; ++ti) {
      const f32x4 d = mm16(s_XT + wave * 16 * XLD, XLD, s_Mrb + ti * 16 * XLD, XLD, 1, z4, l15, quad);
      const int t = ti * 16 + l15, k = wave * 16 + quad * 4;
      const u32x2 rv = *(const u32x2*)(s_R + t * 72 + k);
      u32x2 ov; ov[0] = pk2(bf_lo(rv[0]) - d[0], bf_hi(rv[0]) - d[1]); ov[1] = pk2(bf_lo(rv[1]) - d[2], bf_hi(rv[1]) - d[3]);
      *(u32x2*)(gRT + t * 64 + k) = ov;
      const f32x4 e1 = mm16(s_VmT + wave * 16 * XLD, XLD, s_Mrk + ti * 16 * XLD, XLD, 1, z4, l15, quad);
      const f32x4 e2 = mm16(s_XT + (64 + wave * 16) * XLD, XLD, s_Mrb + ti * 16 * XLD, XLD, 1, z4, l15, quad);
      u32x2 oo; oo[0] = pk2(e1[0] - e2[0], e1[1] - e2[1]); oo[1] = pk2(e1[2] - e2[2], e1[3] - e2[3]);
      *(u32x2*)(gOI + t * 64 + k) = oo;
    }
  }
  __syncthreads();
}

DI void rec_item(const Params& p, int l, int item, char* lds) {
  const int tid = tid_(), wave = __builtin_amdgcn_readfirstlane(tid >> 6), lane = tid & 63, l15 = lane & 15, quad = lane >> 4;
  const bool isp = item < 32;
  const int bh = isp ? item : item - 32; const int b = bh >> 3, h = bh & 7;
  const int nch = isp ? 128 : 2; const int cid0 = isp ? bh * 128 : NCH_P + bh * 2;
  const int row0 = isp ? b * 4096 : MP + b * 64;
  bf16_t* Sb = (bf16_t*)lds;
  {
    const int v = wave * 16 + l15;
    f32x4 a0[4];
    if (isp) {
#pragma unroll
      for (int nk = 0; nk < 4; ++nk) a0[nk] = (f32x4){0.f, 0.f, 0.f, 0.f};
    } else {
      const float* sp = p.swkv + (((size_t)(l * 8 + b) * 8 + h) * 64 + v) * 64;
#pragma unroll
      for (int nk = 0; nk < 4; ++nk) a0[nk] = *(const f32x4*)(sp + nk * 16 + quad * 4);
    }
#pragma unroll
    for (int nk = 0; nk < 4; ++nk) { u32x2 o; o[0] = pk2(a0[nk][0], a0[nk][1]); o[1] = pk2(a0[nk][2], a0[nk][3]); *(u32x2*)(Sb + v * 72 + nk * 16 + quad * 4) = o; }
  }
  __syncthreads();
  const int nmain = nch - 2;
  if (wave < 2) {
    struct PS { bf16x8 pt[4][2]; u32x2 gv[2][4]; };
    auto ldp = [&](PS& s, int c) {
      const int cc = c < nch ? c : nch - 1;
      const size_t cid = (size_t)(cid0 + cc);
      const bf16_t* gPT = p.cPT + cid * 4096; const bf16_t* gG = p.cG + cid * 4096;
#pragma unroll
      for (int nk = 0; nk < 4; ++nk) {
#pragma unroll
        for (int ks = 0; ks < 2; ++ks) s.pt[nk][ks] = *(const bf16x8*)(gPT + (nk * 16 + l15) * 64 + ks * 32 + quad * 8);
#pragma unroll
        for (int v2 = 0; v2 < 2; ++v2) s.gv[v2][nk] = *(const u32x2*)(gG + ((wave * 2 + v2) * 16 + l15) * 64 + nk * 16 + quad * 4);
      }
    };
    f32x4 acc[2][4];
    auto step = [&](PS& s, int c) {
      const int buf = c & 1;
#pragma unroll
      for (int v2 = 0; v2 < 2; ++v2) {
        const int v = (wave * 2 + v2) * 16 + l15;
        bf16x8 sf[2];
#pragma unroll
        for (int ks = 0; ks < 2; ++ks) sf[ks] = *(const bf16x8*)(Sb + (buf * 64 + v) * 72 + ks * 32 + quad * 8);
#pragma unroll
        for (int nk = 0; nk < 4; ++nk) {
          f32x4 a = (f32x4){bf_lo(s.gv[v2][nk][0]), bf_hi(s.gv[v2][nk][0]), bf_lo(s.gv[v2][nk][1]), bf_hi(s.gv[v2][nk][1])};
#pragma unroll
          for (int ks = 0; ks < 2; ++ks) a = __builtin_amdgcn_mfma_f32_16x16x32_bf16(s.pt[nk][ks], sf[ks], a, 0, 0, 0);
          acc[v2][nk] = a;
        }
      }
      ldp(s, c + 3);
#pragma unroll
      for (int v2 = 0; v2 < 2; ++v2) {
        const int v = (wave * 2 + v2) * 16 + l15;
#pragma unroll
        for (int nk = 0; nk < 4; ++nk) { u32x2 ov; ov[0] = pk2(acc[v2][nk][0], acc[v2][nk][1]); ov[1] = pk2(acc[v2][nk][2], acc[v2][nk][3]); *(u32x2*)(Sb + ((buf ^ 1) * 64 + v) * 72 + nk * 16 + quad * 4) = ov; }
      }
      asm volatile("s_waitcnt lgkmcnt(0)" ::: "memory"); __builtin_amdgcn_s_barrier(); asm volatile("" ::: "memory");
    };
    PS s0, s1, s2;
    ldp(s0, 0); ldp(s1, 1); ldp(s2, 2);
#pragma unroll 1
    for (int c = 0; c < nmain; c += 3) { step(s0, c); step(s1, c + 1); step(s2, c + 2); }
    step(s0, nmain); step(s1, nmain + 1);
#pragma unroll
    for (int v2 = 0; v2 < 2; ++v2) {
      const int v = (wave * 2 + v2) * 16 + l15;
      float* so = (isp ? p.out + O_WP + (((size_t)(l * 4 + b) * 8 + h) * 64 + v) * 64 : p.out + O_WS + (((size_t)(l * 8 + b) * 8 + h) * 64 + v) * 64);
#pragma unroll
      for (int nk = 0; nk < 4; ++nk) *(f32x4*)(so + nk * 16 + quad * 4) = acc[v2][nk];
    }
  } else {
    struct CS { bf16x8 rt[2]; u32x2 oi[4], ba[4], gt[4]; };
    const int tok = (wave - 2) * 16 + l15;
    auto ldc = [&](CS& s, int c) {
      const int cc = c < nch ? c : nch - 1;
      const size_t cid = (size_t)(cid0 + cc); const size_t row = (size_t)(row0 + cc * 32 + tok);
#pragma unroll
      for (int ks = 0; ks < 2; ++ks) s.rt[ks] = *(const bf16x8*)(p.cRT + cid * 2048 + tok * 64 + ks * 32 + quad * 8);
#pragma unroll
      for (int vt = 0; vt < 4; ++vt) {
        s.oi[vt] = *(const u32x2*)(p.cOI + cid * 2048 + tok * 64 + vt * 16 + quad * 4);
        s.ba[vt] = *(const u32x2*)(p.cBA + cid * 2048 + tok * 64 + vt * 16 + quad * 4);
        s.gt[vt] = *(const u32x2*)(p.z + row * NZ + C_GR + h * 64 + vt * 16 + quad * 4);
      }
    };
    const float* lg = p.lnx_g + l * 512 + h * 64;
    f32x4 lgv[4];
#pragma unroll
    for (int vt = 0; vt < 4; ++vt) lgv[vt] = *(const f32x4*)(lg + vt * 16 + quad * 4);
    auto step = [&](CS& s, int c) {
      const int buf = c & 1; const size_t row = (size_t)(row0 + c * 32 + tok);
      f32x4 ao[4];
#pragma unroll
      for (int vt = 0; vt < 4; ++vt) {
        f32x4 a = (f32x4){bf_lo(s.oi[vt][0]), bf_hi(s.oi[vt][0]), bf_lo(s.oi[vt][1]), bf_hi(s.oi[vt][1])};
#pragma unroll
        for (int ks = 0; ks < 2; ++ks) {
          const bf16x8 sa = *(const bf16x8*)(Sb + (buf * 64 + vt * 16 + l15) * 72 + ks * 32 + quad * 8);
          a = __builtin_amdgcn_mfma_f32_16x16x32_bf16(sa, s.rt[ks], a, 0, 0, 0);
        }
        ao[vt] = a;
      }
      float sm = 0.f;
#pragma unroll
      for (int vt = 0; vt < 4; ++vt) sm += (ao[vt][0] + ao[vt][1]) + (ao[vt][2] + ao[vt][3]);
      sm += __shfl_xor(sm, 16); sm += __shfl_xor(sm, 32);
      const float mean = sm * (1.0f / 64.0f);
      float vr = 0.f;
#pragma unroll
      for (int vt = 0; vt < 4; ++vt)
#pragma unroll
        for (int e = 0; e < 4; ++e) { const float d = ao[vt][e] - mean; vr += d * d; }
      vr += __shfl_xor(vr, 16); vr += __shfl_xor(vr, 32);
      const float rstd = rsqrtf(vr * (1.0f / 64.0f) + 64e-5f);
#pragma unroll
      for (int vt = 0; vt < 4; ++vt) {
        const int vv = vt * 16 + quad * 4;
        const f32x4 g4 = lgv[vt];
        const float y0 = ((ao[vt][0] - mean) * rstd * g4[0] + bf_lo(s.ba[vt][0])) * bf_lo(s.gt[vt][0]);
        const float y1 = ((ao[vt][1] - mean) * rstd * g4[1] + bf_hi(s.ba[vt][0])) * bf_hi(s.gt[vt][0]);
        const float y2 = ((ao[vt][2] - mean) * rstd * g4[2] + bf_lo(s.ba[vt][1])) * bf_lo(s.gt[vt][1]);
        const float y3 = ((ao[vt][3] - mean) * rstd * g4[3] + bf_hi(s.ba[vt][1])) * bf_hi(s.gt[vt][1]);
        u32x2 ov; ov[0] = pk2(y0, y1); ov[1] = pk2(y2, y3);
        *(u32x2*)(p.o_r + row * 512 + h * 64 + vv) = ov;
      }
      ldc(s, c + 3);
      asm volatile("s_waitcnt lgkmcnt(0)" ::: "memory"); __builtin_amdgcn_s_barrier(); asm volatile("" ::: "memory");
    };
    CS s0, s1, s2;
    ldc(s0, 0); ldc(s1, 1); ldc(s2, 2);
#pragma unroll 1
    for (int c = 0; c < nmain; c += 3) { step(s0, c); step(s1, c + 1); step(s2, c + 2); }
    step(s0, nmain); step(s1, nmain + 1);
  }
  __syncthreads();
}
DI void phase_chunk(const Params& p, int l, char* lds) {
  for (int it = blockIdx.x; it < NCH; it += gridDim.x) chunk_item(p, l, it, lds);
  zero_f32(p.ss1, MT);
}

constexpr int ALD = 72;
DI void attn_item(const Params& p, int l, int item, char* lds) {
  const int tid = tid_(), wave = __builtin_amdgcn_readfirstlane(tid >> 6), lane = tid & 63;
  const int m = wave & 1, qh = wave >> 1, q = lane & 31, hh = lane >> 5;
  bf16_t* Ks = (bf16_t*)lds;
  bf16_t* Vs = Ks + 2 * 64 * ALD;
  float* xb = (float*)lds;
  bool samp; int b, h, nch, qrow0, qpos0;
  if (item < 32) { samp = true; b = item >> 2; h = item & 3; nch = 17; qrow0 = MP + b * 64; qpos0 = 1024; }
  else { samp = false; const int a = item - 32; const int qc = 63 - (a >> 4); const int bh = a & 15; b = bh >> 2; h = bh & 3; nch = qc + 1; qrow0 = b * 4096 + qc * 64; qpos0 = qc * 64; }
  bf16x8 qf[4];
  {
    const bf16_t* qp = p.z + (size_t)(qrow0 + qh * 32 + q) * NZ + C_Q + h * 128 + m * 64;
#pragma unroll
    for (int ks = 0; ks < 4; ++ks) qf[ks] = *(const bf16x8*)(qp + ks * 16 + hh * 8);
  }
  const float slope = exp2f(-2.0f * (float)(h + 1));
  const float LOG2E = 1.4426950408889634f;
  const float c1 = 0.125f * LOG2E, sl2 = slope * LOG2E;
  const float qposf = (float)(qpos0 + qh * 32 + q);
  f32x16 O[4];
#pragma unroll
  for (int i = 0; i < 4; ++i)
#pragma unroll
    for (int e = 0; e < 16; ++e) O[i][e] = 0.f;
  float mrun = -1e30f, lrun = 0.f;
  u32x4 rk[4], rv[4];
  auto gload = [&](int j) {
    const bf16_t* kb; size_t kld; const bf16_t* vb; size_t vld;
    if (!samp) { kb = p.z + (size_t)(b * 4096 + j * 64) * NZ + C_K + h * 128; kld = NZ; vb = p.vtp + (size_t)((b * 4 + h) * 128) * 4096 + j * 64; vld = 4096; }
    else if (j < 16) { kb = p.kc + (size_t)(b * 1024 + j * 64) * 512 + h * 128; kld = 512; vb = p.vct + (size_t)((b * 4 + h) * 128) * 1024 + j * 64; vld = 1024; }
    else { kb = p.z + (size_t)(MP + b * 64) * NZ + C_K + h * 128; kld = NZ; vb = p.vts + (size_t)((b * 4 + h) * 128) * 64; vld = 64; }
#pragma unroll
    for (int i = 0; i < 4; ++i) {
      const int c = tid + 256 * i;
      const int mm = c >> 9, key = (c >> 3) & 63, d8 = (c & 7) * 8;
      rk[i] = *(const u32x4*)(kb + (size_t)key * kld + mm * 64 + d8);
      const int vd = c >> 3, k8 = (c & 7) * 8;
      rv[i] = *(const u32x4*)(vb + (size_t)vd * vld + k8);
    }
  };
  auto sstore = [&]() {
#pragma unroll
    for (int i = 0; i < 4; ++i) {
      const int c = tid + 256 * i;
      const int mm = c >> 9, key = (c >> 3) & 63, d8 = (c & 7) * 8;
      *(u32x4*)(Ks + (mm * 64 + key) * ALD + d8) = rk[i];
      const int vd = c >> 3, k8 = (c & 7) * 8;
      *(u32x4*)(Vs + vd * ALD + k8) = rv[i];
    }
  };
  gload(0); sstore(); __syncthreads();
  for (int j = 0; j < nch; ++j) {
    if (j + 1 < nch) gload(j + 1);
    f32x16 s[2];
#pragma unroll
    for (int kt = 0; kt < 2; ++kt) {
#pragma unroll
      for (int e = 0; e < 16; ++e) s[kt][e] = 0.f;
#pragma unroll
      for (int ks = 0; ks < 4; ++ks) {
        const bf16x8 kf = *(const bf16x8*)(Ks + (m * 64 + kt * 32 + q) * ALD + ks * 16 + hh * 8);
        s[kt] = __builtin_amdgcn_mfma_f32_32x32x16_bf16(kf, qf[ks], s[kt], 0, 0, 0);
      }
    }
    float mx = -1e30f;
    const float dbase = qposf - (float)(j * 64 + 4 * hh);
#pragma unroll
    for (int kt = 0; kt < 2; ++kt)
#pragma unroll
      for (int e = 0; e < 16; ++e) {
        const float dd = dbase - (float)(kt * 32 + (e & 3) + 8 * (e >> 2));
        const float v = s[kt][e] * c1 - sl2 * fabsf(dd);
        s[kt][e] = v; mx = fmaxf(mx, v);
      }
    mx = fmaxf(mx, __shfl_xor(mx, 32));
    const float mnew = fmaxf(mrun, mx);
    const float alpha = __builtin_amdgcn_exp2f(mrun - mnew);
    const bool resc = mnew > mrun;
    mrun = mnew;
    float ps = 0.f;
#pragma unroll
    for (int kt = 0; kt < 2; ++kt)
#pragma unroll
      for (int e = 0; e < 16; ++e) { const float pe = __builtin_amdgcn_exp2f(s[kt][e] - mnew); s[kt][e] = pe; ps += pe; }
    lrun = lrun * alpha + ps;
    if (__any(resc)) {
#pragma unroll
      for (int i = 0; i < 4; ++i)
#pragma unroll
        for (int e = 0; e < 16; ++e) O[i][e] *= alpha;
    }
#pragma unroll
    for (int kt = 0; kt < 2; ++kt)
#pragma unroll
      for (int sx = 0; sx < 2; ++sx) {
        u32x4 pb;
        pb[0] = pk2(s[kt][8 * sx + 0], s[kt][8 * sx + 1]); pb[1] = pk2(s[kt][8 * sx + 2], s[kt][8 * sx + 3]);
        pb[2] = pk2(s[kt][8 * sx + 4], s[kt][8 * sx + 5]); pb[3] = pk2(s[kt][8 * sx + 6], s[kt][8 * sx + 7]);
        const bf16x8 pf = __builtin_bit_cast(bf16x8, pb);
#pragma unroll
        for (int vt = 0; vt < 4; ++vt) {
          const bf16_t* vp = Vs + (vt * 32 + q) * ALD + kt * 32 + 16 * sx + 4 * hh;
          const s16x4 lo = *(const s16x4*)vp, hi = *(const s16x4*)(vp + 8);
          const bf16x8 vf = __builtin_shufflevector(lo, hi, 0, 1, 2, 3, 4, 5, 6, 7);
          O[vt] = __builtin_amdgcn_mfma_f32_32x32x16_bf16(vf, pf, O[vt], 0, 0, 0);
        }
      }
    __syncthreads();
    if (j + 1 < nch) sstore();
    __syncthreads();
  }
  const float ltot = lrun + __shfl_xor(lrun, 32);
  const float inv = 1.0f / ltot;
#pragma unroll
  for (int i = 0; i < 4; ++i)
#pragma unroll
    for (int e = 0; e < 16; ++e) O[i][e] *= inv;
  if (m == 1) {
#pragma unroll
    for (int vt = 0; vt < 4; ++vt)
#pragma unroll
      for (int e = 0; e < 16; ++e) { const int vd = vt * 32 + (e & 3) + 8 * (e >> 2) + 4 * hh; xb[(qh * 128 + vd) * 32 + q] = O[vt][e]; }
  }
  __syncthreads();
  if (m == 0) {
    float d1 = 0.f, d2 = 0.f;
    for (int i = 0; i < 64; ++i) { d1 += p.lq1[l * 64 + i] * p.lk1[l * 64 + i]; d2 += p.lq2[l * 64 + i] * p.lk2[l * 64 + i]; }
    const float lam_init = 0.8f - 0.6f * __expf(-0.3f * (float)l);
    const float lam = __expf(d1) - __expf(d2) + lam_init;
    float ss = 0.f;
#pragma unroll
    for (int vt = 0; vt < 4; ++vt)
#pragma unroll
      for (int e = 0; e < 16; ++e) {
        const int vd = vt * 32 + (e & 3) + 8 * (e >> 2) + 4 * hh;
        const float o2 = xb[(qh * 128 + vd) * 32 + q];
        const float o = O[vt][e] - lam * o2; O[vt][e] = o; ss += o * o;
      }
    ss += __shfl_xor(ss, 32);
    const float rstd = rsqrtf(ss * (1.0f / 128.0f) + 1e-5f) * (1.0f - lam_init);
    const size_t row = (size_t)(qrow0 + qh * 32 + q);
    const float* sg = p.subln_g + l * 128;
#pragma unroll
    for (int vt = 0; vt < 4; ++vt)
#pragma unroll
      for (int e4 = 0; e4 < 4; ++e4) {
        const int vd = vt * 32 + 8 * e4 + 4 * hh;
        const u32x2 gu = *(const u32x2*)(p.z + row * NZ + C_GA + h * 128 + vd);
        const f32x4 gv = *(const f32x4*)(sg + vd);
        const float y0 = O[vt][4 * e4 + 0] * rstd * gv[0] * bf_lo(gu[0]);
        const float y1 = O[vt][4 * e4 + 1] * rstd * gv[1] * bf_hi(gu[0]);
        const float y2 = O[vt][4 * e4 + 2] * rstd * gv[2] * bf_lo(gu[1]);
        const float y3 = O[vt][4 * e4 + 3] * rstd * gv[3] * bf_hi(gu[1]);
        u32x2 ov; ov[0] = pk2(y0, y1); ov[1] = pk2(y2, y3);
        *(u32x2*)(p.o_a + row * 512 + h * 128 + vd) = ov;
      }
  }
  __syncthreads();
}

DI void phase_mix(const Params& p, int l, char* lds) {
  __shared__ int s_next;
  if (blockIdx.x < 96) rec_item(p, l, blockIdx.x, lds);
  unsigned* ctr = p.bar + XCD_BAR_WORDS + 64 * l;
  for (;;) {
    __syncthreads();
    if (threadIdx.x == 0) s_next = (int)atomicAdd(ctr, 1u);
    __syncthreads();
    const int it = s_next;
    if (it >= 1056) break;
    attn_item(p, l, it, lds);
  }
}

DI void phase_merge(const Params& p, int l, char* lds) {
  const int tid = tid_(), wave = __builtin_amdgcn_readfirstlane(tid >> 6), lane = tid & 63;
  const int wm = wave >> 1, wn = wave & 1, l15 = lane & 15, quad = lane >> 4;
  for (int r = 0;; ++r) {
    const int g = xcd_tile(r, 132 * 8); if (g < 0) break;
    int mt, nt; tile_decode(g, 132, 8, mt, nt);
    f32x4 a1[4][4]; zero_acc(a1);
    gemm_dma(a1, p.o_r + (size_t)mt * 128 * 512, 512, p.wt_brr + (size_t)nt * 128 * 512, 512, 512, lds);
    u32x2 pk[4][4];
#pragma unroll
    for (int mi = 0; mi < 4; ++mi) {
      const int R = mt * 128 + wm * 64 + mi * 16 + l15;
#pragma unroll
      for (int ni = 0; ni < 4; ++ni) {
        const int c = nt * 128 + wn * 64 + ni * 16 + quad * 4;
        const u32x2 g1 = *(const u32x2*)(p.z + (size_t)R * NZ + C_MR + c);
        const f32x4 v1 = a1[mi][ni];
        pk[mi][ni][0] = pk2(bf_lo(g1[0]) * v1[0], bf_hi(g1[0]) * v1[1]);
        pk[mi][ni][1] = pk2(bf_lo(g1[1]) * v1[2], bf_hi(g1[1]) * v1[3]);
      }
    }
    zero_acc(a1);
    gemm_dma(a1, p.o_a + (size_t)mt * 128 * 512, 512, p.wt_bra + (size_t)nt * 128 * 512, 512, 512, lds);
#pragma unroll
    for (int mi = 0; mi < 4; ++mi) {
      const int R = mt * 128 + wm * 64 + mi * 16 + l15;
#pragma unroll
      for (int ni = 0; ni < 4; ++ni) {
        const int c = nt * 128 + wn * 64 + ni * 16 + quad * 4;
        const u32x2 g2 = *(const u32x2*)(p.z + (size_t)R * NZ + C_MA + c);
        const f32x4 v2 = a1[mi][ni]; const u32x2 u1 = pk[mi][ni];
        u32x2 o;
        o[0] = pk2(bf_lo(u1[0]) + bf_lo(g2[0]) * v2[0], bf_hi(u1[0]) + bf_hi(g2[0]) * v2[1]);
        o[1] = pk2(bf_lo(u1[1]) + bf_lo(g2[1]) * v2[2], bf_hi(u1[1]) + bf_hi(g2[1]) * v2[3]);
        *(u32x2*)(p.hn + (size_t)R * DM + c) = o;
      }
    }
  }
}
DI void phase_out(const Params& p, int l, char* lds) {
  const int tid = tid_(), wave = __builtin_amdgcn_readfirstlane(tid >> 6), lane = tid & 63;
  const int wm = wave >> 1, wn = wave & 1, l15 = lane & 15, quad = lane >> 4;
  for (int r = 0;; ++r) {
    const int g = xcd_tile(r, 132 * 8); if (g < 0) break;
    int mt, nt; tile_decode(g, 132, 8, mt, nt);
    f32x4 acc[4][4]; zero_acc(acc);
    gemm_dma(acc, p.hn + (size_t)mt * 128 * DM, DM, p.wt_out + (size_t)nt * 128 * DM, DM, DM, lds);
#pragma unroll
    for (int mi = 0; mi < 4; ++mi) {
      const int R = mt * 128 + wm * 64 + mi * 16 + l15;
      const float* xr = x_row(p, l, R);
      const float* g2 = p.ple_norm_g + l * DM;
      bf16_t* xb = p.o_r + (size_t)R * DM;
      float sq = 0.f;
#pragma unroll
      for (int ni = 0; ni < 4; ++ni) {
        const int c = nt * 128 + wn * 64 + ni * 16 + quad * 4;
        const f32x4 xv = *(const f32x4*)(xr + c);
        const f32x4 x1 = xv + acc[mi][ni];
        *(f32x4*)(p.out + (size_t)R * DM + c) = x1;
        const f32x4 gv = *(const f32x4*)(g2 + c);
        u32x2 o; o[0] = pk2(x1[0] * gv[0], x1[1] * gv[1]); o[1] = pk2(x1[2] * gv[2], x1[3] * gv[3]);
        *(u32x2*)(xb + c) = o;
        sq += x1[0] * x1[0] + x1[1] * x1[1] + x1[2] * x1[2] + x1[3] * x1[3];
      }
      sq += __shfl_xor(sq, 16); sq += __shfl_xor(sq, 32);
      if (quad == 0) atomicAdd(p.ss2 + R, sq);
    }
  }
}
DI void phase_ple(const Params& p, int l, char* lds) {
  const int tid = tid_(), wave = __builtin_amdgcn_readfirstlane(tid >> 6), lane = tid & 63;
  const int wm = wave >> 1, wn = wave & 1, l15 = lane & 15, quad = lane >> 4;
  for (int r = 0;; ++r) {
    const int g = xcd_tile(r, 132 * 8); if (g < 0) break;
    int mt, nt; tile_decode(g, 132, 8, mt, nt);
    f32x4 a1[4][4]; zero_acc(a1);
    gemm_dma(a1, p.o_r + (size_t)mt * 128 * DM, DM, p.wt_gate + (size_t)nt * 128 * DM, DM, DM, lds);
    u32x2 pk[4][4];
#pragma unroll
    for (int mi = 0; mi < 4; ++mi) {
      const float rs = rsqrtf(p.ss2[mt * 128 + wm * 64 + mi * 16 + l15] * (1.0f / 1024.0f) + 1e-6f);
#pragma unroll
      for (int ni = 0; ni < 4; ++ni) { const f32x4 v = a1[mi][ni] * rs; pk[mi][ni][0] = pk2(sigmoidf_(v[0]), sigmoidf_(v[1])); pk[mi][ni][1] = pk2(sigmoidf_(v[2]), sigmoidf_(v[3])); }
    }
    zero_acc(a1);
    const int r0 = mt * 128;
    const float* pa = r0 < MP ? p.pp + ((size_t)l * MP + r0) * 256 : p.ps + ((size_t)l * MS + (r0 - MP)) * 256;
    gemm_core<true>(a1, pa, 256, p.wt_ple + (size_t)nt * 128 * 256, 256, 256, lds);
#pragma unroll
    for (int mi = 0; mi < 4; ++mi) {
      const int R = mt * 128 + wm * 64 + mi * 16 + l15;
      float sq = 0.f;
#pragma unroll
      for (int ni = 0; ni < 4; ++ni) {
        const int c = nt * 128 + wn * 64 + ni * 16 + quad * 4;
        float* xo = p.out + (size_t)R * DM + c;
        const f32x4 xv = *(const f32x4*)xo; const f32x4 e = a1[mi][ni]; const u32x2 g = pk[mi][ni];
        f32x4 o;
        o[0] = xv[0] + e[0] * bf_lo(g[0]); o[1] = xv[1] + e[1] * bf_hi(g[0]);
        o[2] = xv[2] + e[2] * bf_lo(g[1]); o[3] = xv[3] + e[3] * bf_hi(g[1]);
        *(f32x4*)xo = o;
        if (l + 1 < NL) {
          const f32x4 gn = *(const f32x4*)(p.norm_g + (l + 1) * DM + c);
          u32x2 hv; hv[0] = pk2(o[0] * gn[0], o[1] * gn[1]); hv[1] = pk2(o[2] * gn[2], o[3] * gn[3]);
          *(u32x2*)(p.hn + (size_t)R * DM + c) = hv;
          sq += o[0] * o[0] + o[1] * o[1] + o[2] * o[2] + o[3] * o[3];
        }
      }
      if (l + 1 < NL) {
        sq += __shfl_xor(sq, 16); sq += __shfl_xor(sq, 32);
        if (quad == 0) atomicAdd(p.ss1 + R, sq);
      }
    }
  }
  if (l + 1 < NL) {
    for (int it = blockIdx.x; it < 2080 + 16 + 2048; it += gridDim.x) {
      if (it < 2080) wconv_tile(p, l + 1, it, (float*)lds);
      else if (it < 2096) wconv_tile(p, l + 1, 2400 + (it - 2080), (float*)lds);
      else cache_item(p, l + 1, it - 2096, lds);
    }
  }
}


#define XB_TMO      128
#define XB_XCNT(j)  (256  + 64 * (j))
#define XB_XSUB(j)  (1280 + 64 * (j))
#define XB_XGEN(j)  (2304 + 64 * (j))
#define XB_TOP      3328
#define XB_TOPGEN   3392
#define XB_SPIN_CAP (1u << 18)
#define LAS __attribute__((address_space(3)))
DI unsigned xb_ld(unsigned* p)              { return __hip_atomic_load(p, __ATOMIC_RELAXED, __HIP_MEMORY_SCOPE_AGENT); }
DI unsigned xb_add(unsigned* p, unsigned v) { return __hip_atomic_fetch_add(p, v, __ATOMIC_RELAXED, __HIP_MEMORY_SCOPE_AGENT); }
DI unsigned xb_xcc_id() { return (unsigned)__builtin_amdgcn_s_getreg((3 << 11) | 20) & 0xFu; }
#define XB_SPIN(cond, bar) do { unsigned _sp = 0; while (cond) { __builtin_amdgcn_s_sleep(1); \
    if ((++_sp & 255u) == 0u) { if (xb_ld(&(bar)[XB_TMO])) break; if (_sp > XB_SPIN_CAP) { atomicAdd(&(bar)[XB_TMO], 1u); break; } } } } while (0)
struct XcdBarrier { unsigned* bar; unsigned x; volatile LAS unsigned* st; };
DI XcdBarrier xcd_barrier_post(unsigned* bar, volatile LAS unsigned* st) {
  XcdBarrier b; b.bar = bar; b.x = xb_xcc_id(); b.st = st;
  if (threadIdx.x == 0) (void)xb_add(&bar[XB_XCNT(b.x)], 1u);
  return b;
}
DI void xcd_barrier_complete(unsigned* bar, unsigned x, unsigned& nloc, unsigned& nx) {
  const unsigned G = gridDim.x * gridDim.y * gridDim.z;
  unsigned sum, cnt, mine, sp = 0u;
  for (;;) {
    sum = 0u; cnt = 0u; mine = 0u;
#pragma unroll
    for (unsigned j = 0; j < 16; ++j) { const unsigned c = xb_ld(&bar[XB_XCNT(j)]); sum += c; cnt += (c > 0u) ? 1u : 0u; mine = (j == x) ? c : mine; }
    if (sum == G) break;
    __builtin_amdgcn_s_sleep(1);
    if ((++sp & 255u) == 0u) { if (xb_ld(&bar[XB_TMO])) break; if (sp > XB_SPIN_CAP) { atomicAdd(&bar[XB_TMO], 1u); break; } }
  }
  nloc = mine > 0u ? mine : 1u; nx = cnt > 0u ? cnt : 1u;
}
DI void xcd_barrier(const XcdBarrier& b) {
  asm volatile("s_waitcnt vmcnt(0)" ::: "memory");
  __syncthreads();
  if (threadIdx.x == 0) {
    unsigned* bar = b.bar;
    __builtin_amdgcn_s_waitcnt(0);
    unsigned nloc = b.st[0], nx = b.st[1];
    if (nloc == 0u) { xcd_barrier_complete(bar, b.x, nloc, nx); b.st[0] = nloc; b.st[1] = nx; }
    const unsigned old = xb_add(&bar[XB_XSUB(b.x)], 1u);
    const unsigned gen = old / nloc;
    if (old + 1u == (gen + 1u) * nloc) {
      __builtin_amdgcn_fence(__ATOMIC_RELEASE, "agent");
      asm volatile("s_waitcnt vmcnt(0)" ::: "memory");
      const unsigned og = xb_add(&bar[XB_TOP], 1u);
      const unsigned tg = og / nx;
      if (og + 1u == (tg + 1u) * nx) xb_add(&bar[XB_TOPGEN], 1u);
      else XB_SPIN(xb_ld(&bar[XB_TOPGEN]) == tg, bar);
      __builtin_amdgcn_fence(__ATOMIC_ACQUIRE, "agent");
      xb_add(&bar[XB_XGEN(b.x)], 1u);
      asm volatile("s_waitcnt vmcnt(0)" ::: "memory");
    } else {
      XB_SPIN(xb_ld(&bar[XB_XGEN(b.x)]) == gen, bar);
      __builtin_amdgcn_fence(__ATOMIC_ACQUIRE, "agent");
      asm volatile("s_waitcnt vmcnt(0)" ::: "memory");
    }
  }
  __syncthreads();
}
constexpr int LDS_BYTES = 73728;
DI void run_phase(const Params& p, int ph, int l, char* lds) {
  switch (ph) {
    case 1: phase_norm0(p, lds); break;
    case 2: phase_gemm_in(p, l, lds); break;
    case 3: phase_mix(p, l, lds); break;
    case 4: phase_merge(p, l, lds); break;
    case 5: phase_out(p, l, lds); break;
    case 6: break;
    case 7: phase_ple(p, l, lds); break;
    case 8: phase_chunk(p, l, lds); break;
  }
}

#if MEGA
__global__ void __launch_bounds__(256, 2) k_mega(Params p) {
  __shared__ __attribute__((aligned(16))) char lds[LDS_BYTES];
  __shared__ uint4 xb_words;
  cg::grid_group grid = cg::this_grid();
  if (threadIdx.x == 0) xb_words = make_uint4(0u, 0u, 0u, 0u);
  __syncthreads();
  const XcdBarrier xb = xcd_barrier_post(p.bar, (volatile LAS unsigned*)&xb_words);
  phase_norm0(p, lds);
  grid.sync();
#pragma unroll 1
  for (int l = 0; l < NL; ++l) {
    phase_gemm_in(p, l, lds); xcd_barrier(xb);
    phase_chunk(p, l, lds); xcd_barrier(xb);
    phase_mix(p, l, lds); xcd_barrier(xb);
    phase_merge(p, l, lds); xcd_barrier(xb);
    phase_out(p, l, lds); xcd_barrier(xb);
    phase_ple(p, l, lds); if (l + 1 < NL) xcd_barrier(xb);
  }
}
#else
template <int PH>
__global__ void __launch_bounds__(256, 2) k_phase(Params p, int l) {
  __shared__ __attribute__((aligned(16))) char lds[LDS_BYTES];
  run_phase(p, PH, l, lds);
}
#endif

extern "C" void kernel_launch(void* const* d_in, const int* in_sizes, int n_in, void* d_out, int out_size, void* d_ws, size_t ws_size,
                              hipStream_t stream) {
  Params p{};
  const float** pf = (const float**)&p;
  for (int i = 0; i < 33; ++i) pf[i] = (const float*)d_in[i];
  p.out = (float*)d_out;
  char* w = (char*)d_ws; size_t off = 0;
  auto take = [&](size_t bytes) { char* r = w + off; off += (bytes + 255) & ~(size_t)255; return (bf16_t*)r; };
  p.ss1 = (float*)take((size_t)MT * 4); p.ss2 = (float*)take((size_t)MT * 4);
  p.bar = (unsigned*)take((size_t)(XCD_BAR_WORDS + 64 * NL) * 4);
  p.wt_in = take((size_t)NZ * 1024 * 2);
  p.wt_brr = take((size_t)1024 * 512 * 2);
  p.wt_bra = take((size_t)1024 * 512 * 2);
  p.wt_out = take((size_t)1024 * 1024 * 2);
  p.wt_ple = take((size_t)1024 * 256 * 2);
  p.wt_gate = take((size_t)1024 * 1024 * 2);
  p.w2t = take((size_t)512 * 64 * 2);
  p.a2t = take((size_t)512 * 64 * 2);
  p.z = take((size_t)MT * NZ * 2);
  p.vtp = take((size_t)16 * 128 * 4096 * 2);
  p.vts = take((size_t)32 * 128 * 64 * 2);
  p.kc = take((size_t)8 * 1024 * 512 * 2);
  p.vct = take((size_t)32 * 128 * 1024 * 2);
  p.o_r = take((size_t)MT * 512 * 2);
  p.o_a = take((size_t)MT * 512 * 2);
  p.hn = take((size_t)MT * DM * 2);
  p.cPT = p.hn;
  p.cG = take((size_t)NCH * 4096 * 2);
  p.cRT = take((size_t)NCH * 2048 * 2);
  p.cOI = take((size_t)NCH * 2048 * 2);
  p.cBA = take((size_t)NCH * 2048 * 2);
  if (off > ws_size) { fprintf(stderr, "workspace too small: need %zu have %zu\n", off, ws_size); return; }
#if MEGA
  hipMemsetAsync(p.bar, 0, (size_t)(XCD_BAR_WORDS + 64 * NL) * 4, stream);
  static int grid_blocks = 0;
  if (!grid_blocks) {
    int dev = 0, cus = 0, per_cu = 0;
    hipGetDevice(&dev);
    hipDeviceGetAttribute(&cus, hipDeviceAttributeMultiprocessorCount, dev);
    hipOccupancyMaxActiveBlocksPerMultiprocessor(&per_cu, k_mega, 256, 0);
    if (per_cu > 2) per_cu = 2;
    grid_blocks = cus * per_cu;
  }
  void* args[] = {&p};
  hipError_t e = hipLaunchCooperativeKernel((void*)k_mega, dim3(grid_blocks), dim3(256), args, 0, stream);
  if (e != hipSuccess) fprintf(stderr, "cooperative launch failed: %s (grid %d)\n", hipGetErrorString(e), grid_blocks);
#else
  const int G = 512;
  for (int l = 0; l < NL; ++l) {
    k_phase<1><<<G, 256, 0, stream>>>(p, l);
    k_phase<2><<<G, 256, 0, stream>>>(p, l);
    k_phase<8><<<G, 256, 0, stream>>>(p, l);
    k_phase<3><<<G, 256, 0, stream>>>(p, l);
    k_phase<4><<<G, 256, 0, stream>>>(p, l);
    k_phase<5><<<G, 256, 0, stream>>>(p, l);
    k_phase<6><<<G, 256, 0, stream>>>(p, l);
    k_phase<7><<<G, 256, 0, stream>>>(p, l);
  }
#endif
}
```

```cpp
#include <hip/hip_runtime.h>
#include <hip/hip_cooperative_groups.h>
#include <stdint.h>
#include <stdio.h>
namespace cg = cooperative_groups;

#ifndef MEGA
#define MEGA 1
#endif

typedef unsigned short bf16_t;
typedef short bf16x8 __attribute__((ext_vector_type(8)));
typedef short s16x4 __attribute__((ext_vector_type(4)));
typedef float f32x4 __attribute__((ext_vector_type(4)));
typedef float f32x2 __attribute__((ext_vector_type(2)));
typedef float f32x16 __attribute__((ext_vector_type(16)));
typedef unsigned u32x4 __attribute__((ext_vector_type(4)));
typedef unsigned u32x2 __attribute__((ext_vector_type(2)));
typedef __bf16 bfv2 __attribute__((ext_vector_type(2)));

#define DI __device__ __forceinline__
#define XCD_BAR_WORDS 3456
DI int tid_() { int t = threadIdx.x; asm volatile("" : "+v"(t)); return t; }

constexpr int DM = 1024, MP = 16384, MS = 512, MT = 16896, NZ = 6272, NL = 4;
constexpr int C_GR = 1664, C_Q = 2176, C_K = 2688, C_V = 3200, C_GA = 3712, C_MR = 4224, C_MA = 5248;
constexpr int SHC = 1664;
constexpr size_t O_YP = 0, O_YS = 16777216, O_KP = 17301504, O_VP = 50855936, O_WP = 84410368, O_SP = 84934656,
                 O_KS = 84961280, O_VS = 86009856, O_WS = 87058432, O_SS = 88107008;

struct Params {
  const float *xp, *xs, *pp, *ps, *ck, *cv, *swkv, *sshift;
  const float *norm_g, *w_in, *shift_mu, *decay_w0, *decay_w2, *iclr_a0, *iclr_a2, *k_k, *k_a, *r_k, *lnx_g, *lnx_b,
      *qng, *kng, *lq1, *lk1, *lq2, *lk2, *subln_g, *w_br_r, *w_br_a, *w_out, *ple_w, *ple_gate_w, *ple_norm_g;
  float* out;
  bf16_t *wt_in, *wt_brr, *wt_bra, *wt_out, *wt_ple, *wt_gate, *w2t, *a2t;
  bf16_t *hn, *z, *vtp, *vts, *kc, *vct, *o_r, *o_a;
  bf16_t *cPT, *cG, *cRT, *cOI, *cBA;
  unsigned* bar;
  float *ss1, *ss2;
  bf16_t* gS;
};

DI unsigned pk2(float a, float b) { f32x2 v = {a, b}; bfv2 r = __builtin_convertvector(v, bfv2); return __builtin_bit_cast(unsigned, r); }
DI float bf_lo(unsigned u) { return __uint_as_float(u << 16); }
DI float bf_hi(unsigned u) { return __uint_as_float(u & 0xffff0000u); }
DI float bf1(bf16_t u) { return __uint_as_float(((unsigned)u) << 16); }
DI float sigmoidf_(float x) { return __builtin_amdgcn_rcpf(1.0f + __expf(-x)); }
DI float siluf_(float x) { return x * __builtin_amdgcn_rcpf(1.0f + __expf(-x)); }

DI void tr_tile(const float* __restrict__ src, int ld_src, bf16_t* __restrict__ dst, int ld_dst, float* sm) {
  const int tid = tid_();
  const int r = tid >> 4, c4 = (tid & 15) * 4;
#pragma unroll
  for (int i = 0; i < 4; ++i) {
    const int row = r + 16 * i;
    f32x4 v = *(const f32x4*)(src + (size_t)row * ld_src + c4);
    sm[row * 65 + c4 + 0] = v[0]; sm[row * 65 + c4 + 1] = v[1]; sm[row * 65 + c4 + 2] = v[2]; sm[row * 65 + c4 + 3] = v[3];
  }
  __syncthreads();
  const int n = tid >> 2, ks = (tid & 3) * 16;
  u32x4 o0, o1;
  o0[0] = pk2(sm[(ks + 0) * 65 + n], sm[(ks + 1) * 65 + n]);   o0[1] = pk2(sm[(ks + 2) * 65 + n], sm[(ks + 3) * 65 + n]);
  o0[2] = pk2(sm[(ks + 4) * 65 + n], sm[(ks + 5) * 65 + n]);   o0[3] = pk2(sm[(ks + 6) * 65 + n], sm[(ks + 7) * 65 + n]);
  o1[0] = pk2(sm[(ks + 8) * 65 + n], sm[(ks + 9) * 65 + n]);   o1[1] = pk2(sm[(ks + 10) * 65 + n], sm[(ks + 11) * 65 + n]);
  o1[2] = pk2(sm[(ks + 12) * 65 + n], sm[(ks + 13) * 65 + n]); o1[3] = pk2(sm[(ks + 14) * 65 + n], sm[(ks + 15) * 65 + n]);
  *(u32x4*)(dst + (size_t)n * ld_dst + ks) = o0;
  *(u32x4*)(dst + (size_t)n * ld_dst + ks + 8) = o1;
  __syncthreads();
}

constexpr int WCONV_TILES = 1568 + 128 + 128 + 256 + 64 + 256 + 8 + 8;
DI void wconv_tile(const Params& p, int l, int t, float* sm) {
  const float* src; bf16_t* dst; int K, N;
  if (t < 1568) { src = p.w_in + (size_t)l * 1024 * NZ; dst = p.wt_in; K = 1024; N = NZ; }
  else if ((t -= 1568) < 128) { src = p.w_br_r + (size_t)l * 512 * 1024; dst = p.wt_brr; K = 512; N = 1024; }
  else if ((t -= 128) < 128) { src = p.w_br_a + (size_t)l * 512 * 1024; dst = p.wt_bra; K = 512; N = 1024; }
  else if ((t -= 128) < 256) { src = p.w_out + (size_t)l * 1024 * 1024; dst = p.wt_out; K = 1024; N = 1024; }
  else if ((t -= 256) < 64) { src = p.ple_w + (size_t)l * 256 * 1024; dst = p.wt_ple; K = 256; N = 1024; }
  else if ((t -= 64) < 256) { src = p.ple_gate_w + (size_t)l * 1024 * 1024; dst = p.wt_gate; K = 1024; N = 1024; }
  else if ((t -= 256) < 8) { src = p.decay_w2 + (size_t)l * 64 * 512; dst = p.w2t; K = 64; N = 512; }
  else { t -= 8; src = p.iclr_a2 + (size_t)l * 64 * 512; dst = p.a2t; K = 64; N = 512; }
  const int ntn = N / 64; const int tk = t / ntn, tn = t % ntn;
  tr_tile(src + (size_t)(tk * 64) * N + tn * 64, N, dst + (size_t)(tn * 64) * K + tk * 64, K, sm);
}

DI const float* x_row(const Params& p, int l, int r) {
  if (l == 0) return r < MP ? p.xp + (size_t)r * DM : p.xs + (size_t)(r - MP) * DM;
  return p.out + (size_t)r * DM;
}
DI void cache_item(const Params& p, int l, int c, char* lds) {
  const int tid = tid_();
  if (c < 1024) {
    const float* src = p.ck + (size_t)l * 8 * 1024 * 512 + (size_t)c * 4096 + tid * 16;
    bf16_t* dst = p.kc + (size_t)c * 4096 + tid * 16;
    f32x4 a0 = *(const f32x4*)(src), a1 = *(const f32x4*)(src + 4), a2 = *(const f32x4*)(src + 8), a3 = *(const f32x4*)(src + 12);
    u32x4 o0, o1;
    o0[0] = pk2(a0[0], a0[1]); o0[1] = pk2(a0[2], a0[3]); o0[2] = pk2(a1[0], a1[1]); o0[3] = pk2(a1[2], a1[3]);
    o1[0] = pk2(a2[0], a2[1]); o1[1] = pk2(a2[2], a2[3]); o1[2] = pk2(a3[0], a3[1]); o1[3] = pk2(a3[2], a3[3]);
    *(u32x4*)dst = o0; *(u32x4*)(dst + 8) = o1;
  } else {
    c -= 1024;
    const int bh = c >> 5, tt = c & 31; const int b = bh >> 2, h = bh & 3; const int tk = tt >> 1, tn = tt & 1;
    const float* src = p.cv + (size_t)l * 8 * 1024 * 512 + ((size_t)(b * 1024 + tk * 64)) * 512 + h * 128 + tn * 64;
    bf16_t* dst = p.vct + ((size_t)(bh * 128 + tn * 64)) * 1024 + tk * 64;
    tr_tile(src, 512, dst, 1024, (float*)lds);
  }
}
DI void phase_norm0(const Params& p, char* lds) {
  const int tid = tid_(), wave = __builtin_amdgcn_readfirstlane(tid >> 6), lane = tid & 63;
  const float* g = p.norm_g;
  const int n_norm = MT / 8;
  const int n_items = n_norm + 2048 + WCONV_TILES;
  for (int it = blockIdx.x; it < n_items; it += gridDim.x) {
    if (it < n_norm) {
      const int r0 = it * 8 + wave * 2;
      f32x4 v[2][4]; float ss[2] = {0.f, 0.f};
#pragma unroll
      for (int k = 0; k < 2; ++k) {
        const float* x = x_row(p, 0, r0 + k);
#pragma unroll
        for (int i = 0; i < 4; ++i) v[k][i] = *(const f32x4*)(x + lane * 4 + 256 * i);
      }
      f32x4 gv[4];
#pragma unroll
      for (int i = 0; i < 4; ++i) gv[i] = *(const f32x4*)(g + lane * 4 + 256 * i);
#pragma unroll
      for (int k = 0; k < 2; ++k) {
#pragma unroll
        for (int i = 0; i < 4; ++i) ss[k] += v[k][i][0] * v[k][i][0] + v[k][i][1] * v[k][i][1] + v[k][i][2] * v[k][i][2] + v[k][i][3] * v[k][i][3];
#pragma unroll
        for (int o = 32; o >= 1; o >>= 1) ss[k] += __shfl_xor(ss[k], o);
        const float rstd = rsqrtf(ss[k] * (1.0f / 1024.0f) + 1e-6f);
#pragma unroll
        for (int i = 0; i < 4; ++i) {
          u32x2 o; o[0] = pk2(v[k][i][0] * rstd * gv[i][0], v[k][i][1] * rstd * gv[i][1]); o[1] = pk2(v[k][i][2] * rstd * gv[i][2], v[k][i][3] * rstd * gv[i][3]);
          *(u32x2*)(p.hn + (size_t)(r0 + k) * DM + lane * 4 + 256 * i) = o;
        }
        if (lane == 0) p.ss1[r0 + k] = 1024.0f * (1.0f - 1e-6f);
      }
    } else if (it < n_norm + 2048) {
      cache_item(p, 0, it - n_norm, lds);
    } else {
      wconv_tile(p, 0, it - n_norm - 2048, (float*)lds);
    }
  }
}
DI void zero_f32(float* a, int n) {
  for (int i = blockIdx.x * 256 + (int)threadIdx.x; i < n; i += gridDim.x * 256) a[i] = 0.f;
}

constexpr int GLD = 72;
template <bool A_F32>
DI void gemm_core(f32x4 (&acc)[4][4], const void* Ap, int lda, const bf16_t* Bp, int ldb, int K, char* lds) {
  bf16_t* As = (bf16_t*)lds;
  bf16_t* Bs = (bf16_t*)(lds + 2 * 128 * GLD * 2);
  const int tid = tid_(), wave = __builtin_amdgcn_readfirstlane(tid >> 6), lane = tid & 63;
  const int wm = wave >> 1, wn = wave & 1, l15 = lane & 15, quad = lane >> 4;
  const int nk = K / 64;
  u32x4 ra[4], rb[4];
  auto gload = [&](int kt) {
#pragma unroll
    for (int i = 0; i < 4; ++i) {
      const int c = tid + 256 * i; const int row = c >> 3, c8 = (c & 7) * 8;
      if (!A_F32) ra[i] = *(const u32x4*)((const bf16_t*)Ap + (size_t)row * lda + kt * 64 + c8);
      rb[i] = *(const u32x4*)(Bp + (size_t)row * ldb + kt * 64 + c8);
    }
  };
  auto sstore = [&](int buf, int kt) {
#pragma unroll
    for (int i = 0; i < 4; ++i) {
      const int c = tid + 256 * i; const int row = c >> 3, c8 = (c & 7) * 8;
      if (A_F32) {
        const float* a = (const float*)Ap + (size_t)row * lda + kt * 64 + c8;
        const f32x4 v0 = *(const f32x4*)a, v1 = *(const f32x4*)(a + 4);
        u32x4 t; t[0] = pk2(v0[0], v0[1]); t[1] = pk2(v0[2], v0[3]); t[2] = pk2(v1[0], v1[1]); t[3] = pk2(v1[2], v1[3]);
        *(u32x4*)(As + (buf * 128 + row) * GLD + c8) = t;
      } else {
        *(u32x4*)(As + (buf * 128 + row) * GLD + c8) = ra[i];
      }
      *(u32x4*)(Bs + (buf * 128 + row) * GLD + c8) = rb[i];
    }
  };
  gload(0); sstore(0, 0); __syncthreads();
  for (int kt = 0; kt < nk; ++kt) {
    const int buf = kt & 1;
    if (kt + 1 < nk) gload(kt + 1);
#pragma unroll
    for (int ks = 0; ks < 2; ++ks) {
      bf16x8 af[4], bfr[4];
#pragma unroll
      for (int i = 0; i < 4; ++i) {
        af[i] = *(const bf16x8*)(As + (buf * 128 + wm * 64 + i * 16 + l15) * GLD + ks * 32 + quad * 8);
        bfr[i] = *(const bf16x8*)(Bs + (buf * 128 + wn * 64 + i * 16 + l15) * GLD + ks * 32 + quad * 8);
      }
#pragma unroll
      for (int mi = 0; mi < 4; ++mi)
#pragma unroll
        for (int ni = 0; ni < 4; ++ni) acc[mi][ni] = __builtin_amdgcn_mfma_f32_16x16x32_bf16(bfr[ni], af[mi], acc[mi][ni], 0, 0, 0);
    }
    if (kt + 1 < nk) sstore(buf ^ 1, kt + 1);
    __syncthreads();
  }
}
#define LASP __attribute__((address_space(3)))
DI void gemm_dma(f32x4 (&acc)[4][4], const bf16_t* Ap, int lda, const bf16_t* Bp, int ldb, int K, char* lds) {
  const int tid = tid_(), wave = __builtin_amdgcn_readfirstlane(tid >> 6), lane = tid & 63;
  const int wm = wave >> 1, wn = wave & 1, l15 = lane & 15, quad = lane >> 4;
  const int nk = K / 64;
  const int lrow = lane >> 3, lpc = lane & 7;
  const bf16_t* ga[4]; const bf16_t* gb[4];
#pragma unroll
  for (int i = 0; i < 4; ++i) {
    const int row = (wave * 4 + i) * 8 + lrow; const int q = lpc ^ (row & 7);
    ga[i] = Ap + (size_t)row * lda + q * 8; gb[i] = Bp + (size_t)row * ldb + q * 8;
  }
  auto issue = [&](int kt) {
    char* sb = lds + (kt & 1) * 32768 + wave * 4096;
#pragma unroll
    for (int i = 0; i < 4; ++i) {
      __builtin_amdgcn_global_load_lds((const unsigned*)(ga[i] + kt * 64), (LASP unsigned*)(sb + i * 1024), 16, 0, 0);
      __builtin_amdgcn_global_load_lds((const unsigned*)(gb[i] + kt * 64), (LASP unsigned*)(sb + 16384 + i * 1024), 16, 0, 0);
    }
  };
  const int sw = l15 & 7;
  const unsigned lbase = (unsigned)(size_t)(LASP char*)lds;
  const unsigned a0 = (unsigned)((wm * 64 + l15) * 128 + ((quad ^ sw) * 16)), a1 = (unsigned)((wm * 64 + l15) * 128 + (((4 + quad) ^ sw) * 16));
  const unsigned b0 = 16384u + (unsigned)((wn * 64 + l15) * 128 + ((quad ^ sw) * 16)), b1 = 16384u + (unsigned)((wn * 64 + l15) * 128 + (((4 + quad) ^ sw) * 16));
  asm volatile("s_waitcnt vmcnt(0)" ::: "memory");
  __builtin_amdgcn_s_barrier();
  asm volatile("" ::: "memory");
  issue(0);
  for (int kt = 0; kt < nk; ++kt) {
    asm volatile("s_waitcnt vmcnt(0)" ::: "memory");
    __builtin_amdgcn_s_barrier();
    asm volatile("" ::: "memory");
    if (kt + 1 < nk) issue(kt + 1);
    const unsigned sa = lbase + (unsigned)((kt & 1) * 32768);
    bf16x8 af[4], bfr[4], ag[4], bg[4];
    asm volatile("ds_read_b128 %0, %8\n\tds_read_b128 %1, %8 offset:2048\n\tds_read_b128 %2, %8 offset:4096\n\tds_read_b128 %3, %8 offset:6144\n\t"
                 "ds_read_b128 %4, %9\n\tds_read_b128 %5, %9 offset:2048\n\tds_read_b128 %6, %9 offset:4096\n\tds_read_b128 %7, %9 offset:6144"
                 : "=&v"(af[0]), "=&v"(af[1]), "=&v"(af[2]), "=&v"(af[3]), "=&v"(bfr[0]), "=&v"(bfr[1]), "=&v"(bfr[2]), "=&v"(bfr[3])
                 : "v"(sa + a0), "v"(sa + b0) : "memory");
    asm volatile("ds_read_b128 %0, %16\n\tds_read_b128 %1, %16 offset:2048\n\tds_read_b128 %2, %16 offset:4096\n\tds_read_b128 %3, %16 offset:6144\n\t"
                 "ds_read_b128 %4, %17\n\tds_read_b128 %5, %17 offset:2048\n\tds_read_b128 %6, %17 offset:4096\n\tds_read_b128 %7, %17 offset:6144\n\t"
                 "s_waitcnt lgkmcnt(8)"
                 : "=&v"(ag[0]), "=&v"(ag[1]), "=&v"(ag[2]), "=&v"(ag[3]), "=&v"(bg[0]), "=&v"(bg[1]), "=&v"(bg[2]), "=&v"(bg[3]),
                   "+v"(af[0]), "+v"(af[1]), "+v"(af[2]), "+v"(af[3]), "+v"(bfr[0]), "+v"(bfr[1]), "+v"(bfr[2]), "+v"(bfr[3])
                 : "v"(sa + a1), "v"(sa + b1) : "memory");
#pragma unroll
    for (int mi = 0; mi < 4; ++mi)
#pragma unroll
      for (int ni = 0; ni < 4; ++ni) acc[mi][ni] = __builtin_amdgcn_mfma_f32_16x16x32_bf16(bfr[ni], af[mi], acc[mi][ni], 0, 0, 0);
    asm volatile("s_waitcnt lgkmcnt(0)" : "+v"(ag[0]), "+v"(ag[1]), "+v"(ag[2]), "+v"(ag[3]), "+v"(bg[0]), "+v"(bg[1]), "+v"(bg[2]), "+v"(bg[3]) :: "memory");
#pragma unroll
    for (int mi = 0; mi < 4; ++mi)
#pragma unroll
      for (int ni = 0; ni < 4; ++ni) acc[mi][ni] = __builtin_amdgcn_mfma_f32_16x16x32_bf16(bg[ni], ag[mi], acc[mi][ni], 0, 0, 0);
  }
  asm volatile("" ::: "memory");
  __builtin_amdgcn_s_barrier();
  asm volatile("" ::: "memory");
}
DI void zero_acc(f32x4 (&acc)[4][4]) {
#pragma unroll
  for (int i = 0; i < 4; ++i)
#pragma unroll
    for (int j = 0; j < 4; ++j) acc[i][j] = (f32x4){0.f, 0.f, 0.f, 0.f};
}

DI int xcd_tile(int r, int T) {
  const int x = blockIdx.x & 7, j = blockIdx.x >> 3, nb = gridDim.x >> 3;
  if (j >= nb) return -1;
  const int start = (int)(((long)x * T) / 8), end = (int)(((long)(x + 1) * T) / 8);
  const int g = start + r * nb + j;
  return g < end ? g : -1;
}
DI void tile_decode(int g, int nM, int nN, int& mt, int& nt) {
  const int per = 8 * nN; const int grp = g / per, idx = g - grp * per; const int gm0 = grp * 8;
  const int gsz = (nM - gm0) < 8 ? (nM - gm0) : 8;
  nt = idx / gsz; mt = gm0 + (idx - nt * gsz);
}
DI void phase_gemm_in(const Params& p, int l, char* lds) {
  const int tid = tid_(), wave = __builtin_amdgcn_readfirstlane(tid >> 6), lane = tid & 63;
  const int wm = wave >> 1, wn = wave & 1, l15 = lane & 15, quad = lane >> 4;
  const bf16_t* Wt = p.wt_in;
  const int NTN = 49, NTM = 132;
  for (int r = 0;; ++r) {
    const int g = xcd_tile(r, NTN * NTM); if (g < 0) break;
    int mt, nt; tile_decode(g, NTM, NTN, mt, nt);
    f32x4 acc[4][4]; zero_acc(acc);
    gemm_dma(acc, p.hn + (size_t)mt * 128 * DM, DM, Wt + (size_t)nt * 128 * DM, DM, DM, lds);
    const int colb = nt * 128 + wn * 64 + quad * 4;
    {
#pragma unroll
      for (int mi = 0; mi < 4; ++mi) {
        const float rs = rsqrtf(p.ss1[mt * 128 + wm * 64 + mi * 16 + l15] * (1.0f / 1024.0f) + 1e-6f);
#pragma unroll
        for (int ni = 0; ni < 4; ++ni) acc[mi][ni] = acc[mi][ni] * rs;
      }
    }
    int kind;
    if (nt < 13) kind = 0; else if (nt < 17) kind = 1; else if (nt < 21) kind = 2; else if (nt < 25) kind = 3; else if (nt < 29) kind = 4; else if (nt < 33) kind = 1; else kind = 5;
#pragma unroll
    for (int mi = 0; mi < 4; ++mi) {
      const int R = mt * 128 + wm * 64 + mi * 16 + l15;
      const bool isp = R < MP; const int rs = R - MP;
      bf16_t* zrow = p.z + (size_t)R * NZ;
      if (kind == 0) {
        const bool last = isp ? ((R & 4095) == 4095) : ((rs & 63) == 63);
        float* so = isp ? p.out + O_SP + (size_t)(l * 4 + (R >> 12)) * SHC : p.out + O_SS + (size_t)(l * 8 + (rs >> 6)) * SHC;
#pragma unroll
        for (int ni = 0; ni < 4; ++ni) {
          const int c = colb + ni * 16; const f32x4 v = acc[mi][ni];
          u32x2 o; o[0] = pk2(v[0], v[1]); o[1] = pk2(v[2], v[3]); *(u32x2*)(zrow + c) = o;
          if (last) *(f32x4*)(so + c) = v;
        }
      } else if (kind == 1 || kind == 5) {
#pragma unroll
        for (int ni = 0; ni < 4; ++ni) {
          const int c = colb + ni * 16; f32x4 v = acc[mi][ni];
#pragma unroll
          for (int e = 0; e < 4; ++e) v[e] = (kind == 1) ? siluf_(v[e]) : sigmoidf_(v[e]);
          u32x2 o; o[0] = pk2(v[0], v[1]); o[1] = pk2(v[2], v[3]); *(u32x2*)(zrow + c) = o;
        }
      } else if (kind == 2 || kind == 3) {
        float ss = 0.f;
#pragma unroll
        for (int ni = 0; ni < 4; ++ni) { const f32x4 v = acc[mi][ni]; ss += v[0] * v[0] + v[1] * v[1] + v[2] * v[2] + v[3] * v[3]; }
        ss += __shfl_xor(ss, 16); ss += __shfl_xor(ss, 32);
        const float rstd = rsqrtf(ss * (1.0f / 64.0f) + 1e-6f);
        const float* g = (kind == 2 ? p.qng : p.kng) + l * 64;
        float* ko = isp ? p.out + O_KP + ((size_t)l * MP + R) * 512 : p.out + O_KS + ((size_t)l * MS + rs) * 512;
#pragma unroll
        for (int ni = 0; ni < 4; ++ni) {
          const int c = colb + ni * 16; const int d = ni * 16 + quad * 4;
          const f32x4 gv = *(const f32x4*)(g + d); f32x4 v = acc[mi][ni];
#pragma unroll
          for (int e = 0; e < 4; ++e) v[e] = v[e] * rstd * gv[e];
          u32x2 o; o[0] = pk2(v[0], v[1]); o[1] = pk2(v[2], v[3]); *(u32x2*)(zrow + c) = o;
          if (kind == 3) *(f32x4*)(ko + (c - C_K)) = v;
        }
      } else {
        float* vo = isp ? p.out + O_VP + ((size_t)l * MP + R) * 512 : p.out + O_VS + ((size_t)l * MS + rs) * 512;
#pragma unroll
        for (int ni = 0; ni < 4; ++ni) {
          const int cv = colb + ni * 16 - C_V; const f32x4 v = acc[mi][ni];
          *(f32x4*)(vo + cv) = v;
          const int h = cv >> 7, vd = cv & 127;
          if (isp) {
            bf16_t* vt = p.vtp + ((size_t)(((R >> 12) * 4 + h) * 128 + vd)) * 4096 + (R & 4095);
#pragma unroll
            for (int e = 0; e < 4; ++e) vt[(size_t)e * 4096] = (bf16_t)(pk2(v[e], 0.f) & 0xffff);
          } else {
            bf16_t* vt = p.vts + ((size_t)(((rs >> 6) * 4 + h) * 128 + vd)) * 64 + (rs & 63);
#pragma unroll
            for (int e = 0; e < 4; ++e) vt[(size_t)e * 64] = (bf16_t)(pk2(v[e], 0.f) & 0xffff);
          }
        }
      }
    }
  }
  zero_f32(p.ss2, MT);
  if (l > 0) for (int it = blockIdx.x; it < 320; it += gridDim.x) wconv_tile(p, l, 2080 + it, (float*)lds);
}

constexpr int NCH_P = 4096, NCH = 4224;
constexpr int XLD = 40;
DI f32x4 mm16(const bf16_t* Xrow, int ldx, const bf16_t* Yrow, int ldy, int ksteps, f32x4 acc, int l15, int quad) {
  for (int ks = 0; ks < ksteps; ++ks) {
    const bf16x8 a = *(const bf16x8*)(Xrow + l15 * ldx + ks * 32 + quad * 8);
    const bf16x8 b = *(const bf16x8*)(Yrow + l15 * ldy + ks * 32 + quad * 8);
    acc = __builtin_amdgcn_mfma_f32_16x16x32_bf16(a, b, acc, 0, 0, 0);
  }
  return acc;
}
DI void chunk_item(const Params& p, int l, int item, char* lds) {
  const int tid = tid_(), wave = __builtin_amdgcn_readfirstlane(tid >> 6), lane = tid & 63, l15 = lane & 15, quad = lane >> 4;
  const bool isp = item < NCH_P;
  int bh, c;
  if (isp) { bh = item >> 7; c = item & 127; } else { const int j = item - NCH_P; bh = j >> 1; c = j & 1; }
  const int b = bh >> 3, h = bh & 7;
  const int t0 = c * 32; const int row0 = (isp ? b * 4096 : MP + b * 64) + t0;
  float* s_r = (float*)lds;
  float* s_kf = s_r + 2048;
  float* s_v = s_kf + 2048;
  float* s_w = s_v + 2048;
  float* s_kk = s_w + 2048;
  float* s_bb = s_kk + 2048;
  bf16_t* s_wd = (bf16_t*)(lds + 49152);
  bf16_t* s_ad = (bf16_t*)(lds + 53760);
  float* s_bonus = (float*)(lds + 58368);
  float* s_wl = (float*)(lds + 58880);
  float* s_rhs = (float*)lds;
  bf16_t* s_A = (bf16_t*)lds;
  bf16_t* s_Bm = (bf16_t*)(lds + 4608);
  bf16_t* s_Kp = (bf16_t*)(lds + 9216);
  bf16_t* s_R = (bf16_t*)(lds + 16384);
  bf16_t* s_BmT = (bf16_t*)(lds + 20992);
  bf16_t* s_KpT = (bf16_t*)(lds + 26112);
  bf16_t* s_VmT = (bf16_t*)(lds + 31232);
  bf16_t* s_Lak = (bf16_t*)(lds + 36352);
  bf16_t* s_Mrk = (bf16_t*)(lds + 38912);
  bf16_t* s_Mrb = (bf16_t*)(lds + 41472);
  float* s_labT = (float*)(lds + 44032);
  bf16_t* s_XT = (bf16_t*)(lds + 48640);

  const int mat = wave >> 1, tt = wave & 1;
  const bf16_t* wl = (mat == 0 ? p.w2t : p.a2t) + (size_t)(h * 64) * 64;
  const float* mu = p.shift_mu + l * SHC;
  const float* w0 = p.decay_w0 + l * 512 + h * 64;
  const float* a0 = p.iclr_a0 + l * 512 + h * 64;
  const float* kkp = p.k_k + l * 512 + h * 64;
  const float* kap = p.k_a + l * 512 + h * 64;
  const float* rkp = p.r_k + l * 512 + h * 64;
  const float* lb = p.lnx_b + l * 512 + h * 64;
  const int ptok = tid >> 3, pcs = (tid & 7) * 8;
  {
    const int t = t0 + ptok; const size_t row = (size_t)(row0 + ptok);
#pragma unroll
    for (int g = 0; g < 5; ++g) {
      const int zc = (g < 3 ? g * 512 + h * 64 : 1536 + (g - 3) * 64) + pcs;
      const u32x4 cu = *(const u32x4*)(p.z + row * NZ + zc);
      float cur[8], prv[8];
#pragma unroll
      for (int e = 0; e < 4; ++e) { cur[2 * e] = bf_lo(cu[e]); cur[2 * e + 1] = bf_hi(cu[e]); }
      if (t > 0) {
        const u32x4 pu = *(const u32x4*)(p.z + (row - 1) * NZ + zc);
#pragma unroll
        for (int e = 0; e < 4; ++e) { prv[2 * e] = bf_lo(pu[e]); prv[2 * e + 1] = bf_hi(pu[e]); }
      } else if (isp) {
#pragma unroll
        for (int e = 0; e < 8; ++e) prv[e] = 0.f;
      } else {
        const float* sp = p.sshift + (size_t)(l * 8 + b) * SHC + zc;
#pragma unroll
        for (int e = 0; e < 8; ++e) prv[e] = sp[e];
      }
      float zs[8];
#pragma unroll
      for (int e = 0; e < 8; ++e) zs[e] = cur[e] + (prv[e] - cur[e]) * mu[zc + e];
      if (g < 3) {
        float* d = (g == 0 ? s_r : g == 1 ? s_kf : s_v) + ptok * 64 + pcs;
        *(f32x4*)d = (f32x4){zs[0], zs[1], zs[2], zs[3]}; *(f32x4*)(d + 4) = (f32x4){zs[4], zs[5], zs[6], zs[7]};
      } else {
        if (g == 3) {
#pragma unroll
          for (int e = 0; e < 8; ++e) { const float ex = __expf(2.f * zs[e]); zs[e] = 1.f - 2.f * __builtin_amdgcn_rcpf(ex + 1.f); }
        }
        u32x4 o; o[0] = pk2(zs[0], zs[1]); o[1] = pk2(zs[2], zs[3]); o[2] = pk2(zs[4], zs[5]); o[3] = pk2(zs[6], zs[7]);
        *(u32x4*)((g == 3 ? s_wd : s_ad) + ptok * 72 + pcs) = o;
      }
    }
  }
  __syncthreads();
  {
    const bf16_t* At = (mat == 0 ? s_wd : s_ad);
    bf16x8 af[2];
#pragma unroll
    for (int ks = 0; ks < 2; ++ks) af[ks] = *(const bf16x8*)(At + (tt * 16 + l15) * 72 + ks * 32 + quad * 8);
#pragma unroll
    for (int ct = 0; ct < 4; ++ct) {
      f32x4 d = (f32x4){0.f, 0.f, 0.f, 0.f};
#pragma unroll
      for (int ks = 0; ks < 2; ++ks) {
        const bf16x8 wfr = *(const bf16x8*)(wl + (size_t)(ct * 16 + l15) * 64 + ks * 32 + quad * 8);
        d = __builtin_amdgcn_mfma_f32_16x16x32_bf16(wfr, af[ks], d, 0, 0, 0);
      }
      const int ch = ct * 16 + quad * 4; const int tok = tt * 16 + l15;
      f32x4 o;
      if (mat == 0) {
#pragma unroll
        for (int e = 0; e < 4; ++e) {
          const float y = -(w0[ch + e] + d[e]);
          const float sp = fmaxf(y, 0.f) + __logf(1.0f + __expf(-fabsf(y)));
          o[e] = -__expf(-sp - 0.5f);
        }
        *(f32x4*)(s_w + tok * 64 + ch) = o;
      } else {
#pragma unroll
        for (int e = 0; e < 4; ++e) o[e] = sigmoidf_(a0[ch + e] + d[e]);
        *(f32x4*)(s_bb + tok * 64 + ch) = o;
      }
    }
  }
  __syncthreads();
  float r_[8], kf[8], kk[8], bbv[8], v_[8], bon;
  {
    float k_[8], a_[8];
    *(f32x4*)&k_[0] = *(const f32x4*)(s_kf + ptok * 64 + pcs); *(f32x4*)&k_[4] = *(const f32x4*)(s_kf + ptok * 64 + pcs + 4);
    *(f32x4*)&a_[0] = *(const f32x4*)(s_bb + ptok * 64 + pcs); *(f32x4*)&a_[4] = *(const f32x4*)(s_bb + ptok * 64 + pcs + 4);
    *(f32x4*)&r_[0] = *(const f32x4*)(s_r + ptok * 64 + pcs); *(f32x4*)&r_[4] = *(const f32x4*)(s_r + ptok * 64 + pcs + 4);
    *(f32x4*)&v_[0] = *(const f32x4*)(s_v + ptok * 64 + pcs); *(f32x4*)&v_[4] = *(const f32x4*)(s_v + ptok * 64 + pcs + 4);
    float ss = 0.f; bon = 0.f;
#pragma unroll
    for (int e = 0; e < 8; ++e) {
      kk[e] = k_[e] * kkp[pcs + e]; ss += kk[e] * kk[e];
      kf[e] = k_[e] * (1.f + (a_[e] - 1.f) * kap[pcs + e]);
      bon += r_[e] * kf[e] * rkp[pcs + e];
    }
    ss += __shfl_xor(ss, 1); ss += __shfl_xor(ss, 2); ss += __shfl_xor(ss, 4);
    bon += __shfl_xor(bon, 1); bon += __shfl_xor(bon, 2); bon += __shfl_xor(bon, 4);
    const float inv = 1.0f / fmaxf(sqrtf(ss), 1e-12f);
#pragma unroll
    for (int e = 0; e < 8; ++e) { kk[e] *= inv; bbv[e] = kk[e] * a_[e]; }
  }
  if (tid < 64) {
    float run = 0.f;
#pragma unroll 8
    for (int t = 0; t < 32; ++t) { run += s_w[t * 64 + tid]; s_w[t * 64 + tid] = run; }
  }
  __syncthreads();
  {
    float cw[8], cwp[8];
    *(f32x4*)&cw[0] = *(const f32x4*)(s_w + ptok * 64 + pcs); *(f32x4*)&cw[4] = *(const f32x4*)(s_w + ptok * 64 + pcs + 4);
    if (ptok > 0) { *(f32x4*)&cwp[0] = *(const f32x4*)(s_w + (ptok - 1) * 64 + pcs); *(f32x4*)&cwp[4] = *(const f32x4*)(s_w + (ptok - 1) * 64 + pcs + 4); }
    else {
#pragma unroll
      for (int e = 0; e < 8; ++e) cwp[e] = 0.f;
    }
    __syncthreads();
    float av[8], bm[8], kp[8], rr[8];
#pragma unroll
    for (int e = 0; e < 8; ++e) {
      const float ec = __expf(cw[e]), en = __expf(-cw[e]), ep = __expf(cwp[e]);
      av[e] = kk[e] * ep; bm[e] = bbv[e] * en; kp[e] = kf[e] * en; rr[e] = r_[e] * ec;
      if (ptok == 31) s_wl[pcs + e] = ec;
    }
    u32x4 o;
    o[0] = pk2(av[0], av[1]); o[1] = pk2(av[2], av[3]); o[2] = pk2(av[4], av[5]); o[3] = pk2(av[6], av[7]); *(u32x4*)(s_A + ptok * 72 + pcs) = o;
    o[0] = pk2(bm[0], bm[1]); o[1] = pk2(bm[2], bm[3]); o[2] = pk2(bm[4], bm[5]); o[3] = pk2(bm[6], bm[7]); *(u32x4*)(s_Bm + ptok * 72 + pcs) = o;
#pragma unroll
    for (int e = 0; e < 4; ++e) { s_BmT[(pcs + 2 * e) * XLD + ptok] = (bf16_t)(o[e] & 0xffff); s_BmT[(pcs + 2 * e + 1) * XLD + ptok] = (bf16_t)(o[e] >> 16); }
    o[0] = pk2(kp[0], kp[1]); o[1] = pk2(kp[2], kp[3]); o[2] = pk2(kp[4], kp[5]); o[3] = pk2(kp[6], kp[7]); *(u32x4*)(s_Kp + ptok * 72 + pcs) = o;
#pragma unroll
    for (int e = 0; e < 4; ++e) { s_KpT[(pcs + 2 * e) * XLD + ptok] = (bf16_t)(o[e] & 0xffff); s_KpT[(pcs + 2 * e + 1) * XLD + ptok] = (bf16_t)(o[e] >> 16); }
    o[0] = pk2(rr[0], rr[1]); o[1] = pk2(rr[2], rr[3]); o[2] = pk2(rr[4], rr[5]); o[3] = pk2(rr[6], rr[7]); *(u32x4*)(s_R + ptok * 72 + pcs) = o;
    o[0] = pk2(v_[0], v_[1]); o[1] = pk2(v_[2], v_[3]); o[2] = pk2(v_[4], v_[5]); o[3] = pk2(v_[6], v_[7]);
#pragma unroll
    for (int e = 0; e < 4; ++e) { s_VmT[(pcs + 2 * e) * XLD + ptok] = (bf16_t)(o[e] & 0xffff); s_VmT[(pcs + 2 * e + 1) * XLD + ptok] = (bf16_t)(o[e] >> 16); }
    u32x4 ob;
    ob[0] = pk2(lb[pcs + 0] + bon * v_[0], lb[pcs + 1] + bon * v_[1]); ob[1] = pk2(lb[pcs + 2] + bon * v_[2], lb[pcs + 3] + bon * v_[3]);
    ob[2] = pk2(lb[pcs + 4] + bon * v_[4], lb[pcs + 5] + bon * v_[5]); ob[3] = pk2(lb[pcs + 6] + bon * v_[6], lb[pcs + 7] + bon * v_[7]);
    *(u32x4*)(p.cBA + ((size_t)item * 32 + ptok) * 64 + pcs) = ob;
  }
  __syncthreads();
  {
    const bf16_t* X = (wave < 2) ? s_A : s_R;
    const bf16_t* Y = (wave == 0 || wave == 3) ? s_Bm : s_Kp;
    const bool strict = wave < 2;
#pragma unroll
    for (int ti = 0; ti < 2; ++ti)
#pragma unroll
      for (int ii = 0; ii < 2; ++ii) {
        f32x4 d = (f32x4){0.f, 0.f, 0.f, 0.f};
        if (ii <= ti) d = mm16(X + ti * 16 * 72, 72, Y + ii * 16 * 72, 72, 2, d, l15, quad);
        const int i = ii * 16 + l15;
#pragma unroll
        for (int e = 0; e < 4; ++e) {
          const int t = ti * 16 + quad * 4 + e;
          const bool keep = strict ? (i < t) : (i <= t);
          const float val = keep ? d[e] : 0.f;
          if (wave == 0) s_labT[i * 36 + t] = val;
          else { bf16_t* dst = (wave == 1 ? s_Lak : wave == 2 ? s_Mrk : s_Mrb); dst[t * XLD + i] = (bf16_t)(pk2(val, 0.f) & 0xffff); }
        }
      }
  }
  const u32x4 acap = *(const u32x4*)(s_A + ptok * 72 + pcs);
  __syncthreads();
  {
    float* d = s_rhs + ptok * 128 + pcs;
    *(f32x4*)d = (f32x4){bf_lo(acap[0]), bf_hi(acap[0]), bf_lo(acap[1]), bf_hi(acap[1])};
    *(f32x4*)(d + 4) = (f32x4){bf_lo(acap[2]), bf_hi(acap[2]), bf_lo(acap[3]), bf_hi(acap[3])};
  }
  {
    const int ti = wave & 1;
#pragma unroll
    for (int vv = 0; vv < 2; ++vv) {
      const int vi = (wave >> 1) * 2 + vv;
      f32x4 d = (f32x4){0.f, 0.f, 0.f, 0.f};
      d = mm16(s_Lak + ti * 16 * XLD, XLD, s_VmT + vi * 16 * XLD, XLD, 1, d, l15, quad);
#pragma unroll
      for (int e = 0; e < 4; ++e) s_rhs[(ti * 16 + quad * 4 + e) * 128 + 64 + vi * 16 + l15] = d[e];
    }
  }
  __syncthreads();
  if (tid < 128) {
    float x[32];
#pragma unroll
    for (int t = 0; t < 32; ++t) x[t] = s_rhs[t * 128 + tid];
#pragma unroll
    for (int i = 0; i < 31; ++i) {
      const float xi = x[i];
#pragma unroll
      for (int t4 = ((i + 1) >> 2); t4 < 8; ++t4) {
        const f32x4 lv = *(const f32x4*)(s_labT + i * 36 + t4 * 4);
#pragma unroll
        for (int e = 0; e < 4; ++e) { const int t = t4 * 4 + e; if (t > i) x[t] -= lv[e] * xi; }
      }
    }
#pragma unroll
    for (int q4 = 0; q4 < 4; ++q4) {
      u32x4 o; o[0] = pk2(x[8 * q4], x[8 * q4 + 1]); o[1] = pk2(x[8 * q4 + 2], x[8 * q4 + 3]); o[2] = pk2(x[8 * q4 + 4], x[8 * q4 + 5]); o[3] = pk2(x[8 * q4 + 6], x[8 * q4 + 7]);
      *(u32x4*)(s_XT + tid * XLD + q4 * 8) = o;
    }
  }
  __syncthreads();
  {
    const f32x4 z4 = (f32x4){0.f, 0.f, 0.f, 0.f};
    bf16_t* gPT = p.cPT + (size_t)item * 4096;
    const float wl_c = s_wl[wave * 16 + l15];
#pragma unroll
    for (int k1t = 0; k1t < 4; ++k1t) {
      f32x4 d = mm16(s_XT + k1t * 16 * XLD, XLD, s_BmT + wave * 16 * XLD, XLD, 1, z4, l15, quad);
      const int k2 = wave * 16 + l15, k1 = k1t * 16 + quad * 4;
      float o[4];
#pragma unroll
      for (int e = 0; e < 4; ++e) o[e] = ((k1 + e == k2 ? 1.f : 0.f) - d[e]) * wl_c;
      u32x2 ov; ov[0] = pk2(o[0], o[1]); ov[1] = pk2(o[2], o[3]);
      *(u32x2*)(gPT + k2 * 64 + k1) = ov;
    }
    bf16_t* gG = p.cG + (size_t)item * 4096;
#pragma unroll
    for (int k2t = 0; k2t < 4; ++k2t) {
      const f32x4 d1 = mm16(s_KpT + k2t * 16 * XLD, XLD, s_VmT + wave * 16 * XLD, XLD, 1, z4, l15, quad);
      const f32x4 d2 = mm16(s_BmT + k2t * 16 * XLD, XLD, s_XT + (64 + wave * 16) * XLD, XLD, 1, z4, l15, quad);
      const int k2 = k2t * 16 + quad * 4, v = wave * 16 + l15;
      const f32x4 wv = *(const f32x4*)(s_wl + k2);
      u32x2 ov; ov[0] = pk2((d1[0] - d2[0]) * wv[0], (d1[1] - d2[1]) * wv[1]); ov[1] = pk2((d1[2] - d2[2]) * wv[2], (d1[3] - d2[3]) * wv[3]);
      *(u32x2*)(gG + v * 64 + k2) = ov;
    }
    bf16_t* gRT = p.cRT + (size_t)item * 2048;
    bf16_t* gOI = p.cOI + (size_t)item * 2048;
#pragma unroll
    for (int ti = 0; ti < 2; ++ti) {
      const f32x4 d = mm16(s_XT + wave * 16 * XLD, XLD, s_Mrb + ti * 16 * XLD, XLD, 1, z4, l15, quad);
      const int t = ti * 16 + l15, k = wave * 16 + quad * 4;
      const u32x2 rv = *(const u32x2*)(s_R + t * 72 + k);
      u32x2 ov; ov[0] = pk2(bf_lo(rv[0]) - d[0], bf_hi(rv[0]) - d[1]); ov[1] = pk2(bf_lo(rv[1]) - d[2], bf_hi(rv[1]) - d[3]);
      *(u32x2*)(gRT + t * 64 + k) = ov;
      const f32x4 e1 = mm16(s_VmT + wave * 16 * XLD, XLD, s_Mrk + ti * 16 * XLD, XLD, 1, z4, l15, quad);
      const f32x4 e2 = mm16(s_XT + (64 + wave * 16) * XLD, XLD, s_Mrb + ti * 16 * XLD, XLD, 1, z4, l15, quad);
      u32x2 oo; oo[0] = pk2(e1[0] - e2[0], e1[1] - e2[1]); oo[1] = pk2(e1[2] - e2[2], e1[3] - e2[3]);
      *(u32x2*)(gOI + t * 64 + k) = oo;
    }
  }
  __syncthreads();
}

DI void rec_item(const Params& p, int l, int item, char* lds) {
  const int tid = tid_(), wave = __builtin_amdgcn_readfirstlane(tid >> 6), lane = tid & 63, l15 = lane & 15, quad = lane >> 4;
  const bool isp = item < 32;
  const int bh = isp ? item : item - 32; const int b = bh >> 3, h = bh & 7;
  const int nch = isp ? 128 : 2; const int cid0 = isp ? bh * 128 : NCH_P + bh * 2;
  bf16_t* Sb = (bf16_t*)lds;
  const unsigned lbase = (unsigned)(size_t)(LASP char*)lds;
  __syncthreads();
  if (wave < 2) {
    f32x4 acc[2][4];
#pragma unroll
    for (int v2 = 0; v2 < 2; ++v2) {
      const int v = (wave * 2 + v2) * 16 + l15;
      if (isp) {
#pragma unroll
        for (int nk = 0; nk < 4; ++nk) acc[v2][nk] = (f32x4){0.f, 0.f, 0.f, 0.f};
      } else {
        const float* sp = p.swkv + (((size_t)(l * 8 + b) * 8 + h) * 64 + v) * 64;
#pragma unroll
        for (int nk = 0; nk < 4; ++nk) acc[v2][nk] = *(const f32x4*)(sp + nk * 16 + quad * 4);
      }
#pragma unroll
      for (int nk = 0; nk < 4; ++nk) {
        u32x2 o; o[0] = pk2(acc[v2][nk][0], acc[v2][nk][1]); o[1] = pk2(acc[v2][nk][2], acc[v2][nk][3]);
        *(u32x2*)(Sb + v * 72 + nk * 16 + quad * 4) = o;
        *(u32x2*)(p.gS + (size_t)cid0 * 4096 + v * 64 + nk * 16 + quad * 4) = o;
      }
    }
    const int nmain = nch - 2;
    struct PS { bf16x8 pt[4][2]; u32x2 gv[2][4]; };
    auto ldp = [&](PS& s, int c) {
      const int cc = c < nch ? c : nch - 1;
      const size_t cid = (size_t)(cid0 + cc);
      const bf16_t* gPT = p.cPT + cid * 4096; const bf16_t* gG = p.cG + cid * 4096;
#pragma unroll
      for (int nk = 0; nk < 4; ++nk) {
#pragma unroll
        for (int ks = 0; ks < 2; ++ks) s.pt[nk][ks] = *(const bf16x8*)(gPT + (nk * 16 + l15) * 64 + ks * 32 + quad * 8);
#pragma unroll
        for (int v2 = 0; v2 < 2; ++v2) s.gv[v2][nk] = *(const u32x2*)(gG + ((wave * 2 + v2) * 16 + l15) * 64 + nk * 16 + quad * 4);
      }
    };
    auto step = [&](PS& s, int c) {
      const int buf = c & 1;
      bf16x8 sf[2][2];
      {
        const unsigned sad = lbase + (unsigned)(((buf * 64 + wave * 32 + l15) * 72 + quad * 8) * 2);
        asm volatile("ds_read_b128 %0, %4\n\tds_read_b128 %1, %4 offset:64\n\tds_read_b128 %2, %4 offset:2304\n\tds_read_b128 %3, %4 offset:2368\n\ts_waitcnt lgkmcnt(0)"
                     : "=&v"(sf[0][0]), "=&v"(sf[0][1]), "=&v"(sf[1][0]), "=&v"(sf[1][1]) : "v"(sad) : "memory");
      }
#pragma unroll
      for (int v2 = 0; v2 < 2; ++v2) {
#pragma unroll
        for (int nk = 0; nk < 4; ++nk) {
          f32x4 a = (f32x4){bf_lo(s.gv[v2][nk][0]), bf_hi(s.gv[v2][nk][0]), bf_lo(s.gv[v2][nk][1]), bf_hi(s.gv[v2][nk][1])};
#pragma unroll
          for (int ks = 0; ks < 2; ++ks) a = __builtin_amdgcn_mfma_f32_16x16x32_bf16(s.pt[nk][ks], sf[v2][ks], a, 0, 0, 0);
          acc[v2][nk] = a;
        }
      }
      ldp(s, c + 3);
      const size_t scid = (c + 1 < nch) ? (size_t)(cid0 + c + 1) : (size_t)NCH;
#pragma unroll
      for (int v2 = 0; v2 < 2; ++v2) {
        const int v = (wave * 2 + v2) * 16 + l15;
#pragma unroll
        for (int nk = 0; nk < 4; ++nk) {
          u32x2 ov; ov[0] = pk2(acc[v2][nk][0], acc[v2][nk][1]); ov[1] = pk2(acc[v2][nk][2], acc[v2][nk][3]);
          *(u32x2*)(Sb + ((buf ^ 1) * 64 + v) * 72 + nk * 16 + quad * 4) = ov;
          *(u32x2*)(p.gS + scid * 4096 + v * 64 + nk * 16 + quad * 4) = ov;
        }
      }
      asm volatile("s_waitcnt lgkmcnt(0)" ::: "memory");
    };
    PS s0, s1, s2;
    ldp(s0, 0); ldp(s1, 1); ldp(s2, 2);
#pragma unroll 1
    for (int c = 0; c < nmain; c += 3) { step(s0, c); step(s1, c + 1); step(s2, c + 2); }
    step(s0, nmain); step(s1, nmain + 1);
#pragma unroll
    for (int v2 = 0; v2 < 2; ++v2) {
      const int v = (wave * 2 + v2) * 16 + l15;
      float* so = (isp ? p.out + O_WP + (((size_t)(l * 4 + b) * 8 + h) * 64 + v) * 64 : p.out + O_WS + (((size_t)(l * 8 + b) * 8 + h) * 64 + v) * 64);
#pragma unroll
      for (int nk = 0; nk < 4; ++nk) *(f32x4*)(so + nk * 16 + quad * 4) = acc[v2][nk];
    }
  }
  __syncthreads();
}
DI void phase_o(const Params& p, int l) {
  const int tid = tid_(), wave = __builtin_amdgcn_readfirstlane(tid >> 6), lane = tid & 63, l15 = lane & 15, quad = lane >> 4;
  for (int pi = blockIdx.x; pi < NCH / 2; pi += gridDim.x) {
    const int cid = pi * 2 + (wave >> 1);
    const bool isp = cid < NCH_P;
    int bh, c;
    if (isp) { bh = cid >> 7; c = cid & 127; } else { const int j = cid - NCH_P; bh = j >> 1; c = j & 1; }
    const int b = bh >> 3, h = bh & 7;
    const int tok = (wave & 1) * 16 + l15;
    const size_t row = (size_t)((isp ? b * 4096 : MP + b * 64) + c * 32 + tok);
    bf16x8 rt[2], sa[4][2]; u32x2 oi[4], ba[4], gt[4];
#pragma unroll
    for (int ks = 0; ks < 2; ++ks) rt[ks] = *(const bf16x8*)(p.cRT + (size_t)cid * 2048 + tok * 64 + ks * 32 + quad * 8);
#pragma unroll
    for (int vt = 0; vt < 4; ++vt) {
#pragma unroll
      for (int ks = 0; ks < 2; ++ks) sa[vt][ks] = *(const bf16x8*)(p.gS + (size_t)cid * 4096 + (vt * 16 + l15) * 64 + ks * 32 + quad * 8);
      oi[vt] = *(const u32x2*)(p.cOI + (size_t)cid * 2048 + tok * 64 + vt * 16 + quad * 4);
      ba[vt] = *(const u32x2*)(p.cBA + (size_t)cid * 2048 + tok * 64 + vt * 16 + quad * 4);
      gt[vt] = *(const u32x2*)(p.z + row * NZ + C_GR + h * 64 + vt * 16 + quad * 4);
    }
    f32x4 ao[4];
#pragma unroll
    for (int vt = 0; vt < 4; ++vt) {
      f32x4 a = (f32x4){bf_lo(oi[vt][0]), bf_hi(oi[vt][0]), bf_lo(oi[vt][1]), bf_hi(oi[vt][1])};
#pragma unroll
      for (int ks = 0; ks < 2; ++ks) a = __builtin_amdgcn_mfma_f32_16x16x32_bf16(sa[vt][ks], rt[ks], a, 0, 0, 0);
      ao[vt] = a;
    }
    float sm = 0.f, sq = 0.f;
#pragma unroll
    for (int vt = 0; vt < 4; ++vt)
#pragma unroll
      for (int e = 0; e < 4; ++e) { sm += ao[vt][e]; sq += ao[vt][e] * ao[vt][e]; }
    { const float a1 = __shfl_xor(sm, 16), b1 = __shfl_xor(sq, 16); sm += a1; sq += b1; }
    { const float a1 = __shfl_xor(sm, 32), b1 = __shfl_xor(sq, 32); sm += a1; sq += b1; }
    const float mean = sm * (1.0f / 64.0f);
    const float rstd = rsqrtf(fmaxf(sq * (1.0f / 64.0f) - mean * mean, 0.f) + 64e-5f);
    const float* lg = p.lnx_g + l * 512 + h * 64;
#pragma unroll
    for (int vt = 0; vt < 4; ++vt) {
      const int vv = vt * 16 + quad * 4;
      const f32x4 g4 = *(const f32x4*)(lg + vv);
      const float y0 = ((ao[vt][0] - mean) * rstd * g4[0] + bf_lo(ba[vt][0])) * bf_lo(gt[vt][0]);
      const float y1 = ((ao[vt][1] - mean) * rstd * g4[1] + bf_hi(ba[vt][0])) * bf_hi(gt[vt][0]);
      const float y2 = ((ao[vt][2] - mean) * rstd * g4[2] + bf_lo(ba[vt][1])) * bf_lo(gt[vt][1]);
      const float y3 = ((ao[vt][3] - mean) * rstd * g4[3] + bf_hi(ba[vt][1])) * bf_hi(gt[vt][1]);
      u32x2 ov; ov[0] = pk2(y0, y1); ov[1] = pk2(y2, y3);
      *(u32x2*)(p.o_r + row * 512 + h * 64 + vv) = ov;
    }
  }
}
DI void phase_chunk(const Params& p, int l, char* lds) {
  for (int it = blockIdx.x; it < NCH; it += gridDim.x) chunk_item(p, l, it, lds);
  zero_f32(p.ss1, MT);
}

constexpr int ALD = 72;
DI void attn_item(const Params& p, int l, int item, char* lds) {
  const int tid = tid_(), wave = __builtin_amdgcn_readfirstlane(tid >> 6), lane = tid & 63;
  const int m = wave & 1, qh = wave >> 1, q = lane & 31, hh = lane >> 5;
  bf16_t* Ks = (bf16_t*)lds;
  bf16_t* Vs = Ks + 2 * 64 * ALD;
  float* xb = (float*)lds;
  bool samp; int b, h, nch, qrow0, qpos0;
  const int xq = item & 7, tk = item >> 3;
  if (tk < 4) { samp = true; const int bhs = xq + 8 * tk; b = bhs >> 2; h = bhs & 3; nch = 17; qrow0 = MP + b * 64; qpos0 = 1024; }
  else { samp = false; const int kk = tk - 4; const int qc = 63 - (kk >> 1); const int bh = xq + 8 * (kk & 1); b = bh >> 2; h = bh & 3; nch = qc + 1; qrow0 = b * 4096 + qc * 64; qpos0 = qc * 64; }
  bf16x8 qf[4];
  {
    const bf16_t* qp = p.z + (size_t)(qrow0 + qh * 32 + q) * NZ + C_Q + h * 128 + m * 64;
#pragma unroll
    for (int ks = 0; ks < 4; ++ks) qf[ks] = *(const bf16x8*)(qp + ks * 16 + hh * 8);
  }
  const float slope = exp2f(-2.0f * (float)(h + 1));
  const float LOG2E = 1.4426950408889634f;
  const float c1 = 0.125f * LOG2E, sl2 = slope * LOG2E;
  const float qposf = (float)(qpos0 + qh * 32 + q);
  f32x16 O[4];
#pragma unroll
  for (int i = 0; i < 4; ++i)
#pragma unroll
    for (int e = 0; e < 16; ++e) O[i][e] = 0.f;
  float mrun = -1e30f, lrun = 0.f;
  u32x4 rk[4], rv[4];
  auto gload = [&](int j) {
    const bf16_t* kb; size_t kld; const bf16_t* vb; size_t vld;
    if (!samp) { kb = p.z + (size_t)(b * 4096 + j * 64) * NZ + C_K + h * 128; kld = NZ; vb = p.vtp + (size_t)((b * 4 + h) * 128) * 4096 + j * 64; vld = 4096; }
    else if (j < 16) { kb = p.kc + (size_t)(b * 1024 + j * 64) * 512 + h * 128; kld = 512; vb = p.vct + (size_t)((b * 4 + h) * 128) * 1024 + j * 64; vld = 1024; }
    else { kb = p.z + (size_t)(MP + b * 64) * NZ + C_K + h * 128; kld = NZ; vb = p.vts + (size_t)((b * 4 + h) * 128) * 64; vld = 64; }
#pragma unroll
    for (int i = 0; i < 4; ++i) {
      const int c = tid + 256 * i;
      const int mm = c >> 9, key = (c >> 3) & 63, d8 = (c & 7) * 8;
      rk[i] = *(const u32x4*)(kb + (size_t)key * kld + mm * 64 + d8);
      const int vd = c >> 3, k8 = (c & 7) * 8;
      rv[i] = *(const u32x4*)(vb + (size_t)vd * vld + k8);
    }
  };
  auto sstore = [&]() {
#pragma unroll
    for (int i = 0; i < 4; ++i) {
      const int c = tid + 256 * i;
      const int mm = c >> 9, key = (c >> 3) & 63, d8 = (c & 7) * 8;
      *(u32x4*)(Ks + (mm * 64 + key) * ALD + d8) = rk[i];
      const int vd = c >> 3, k8 = (c & 7) * 8;
      *(u32x4*)(Vs + vd * ALD + k8) = rv[i];
    }
  };
  gload(0); sstore(); __syncthreads();
  for (int j = 0; j < nch; ++j) {
    if (j + 1 < nch) gload(j + 1);
    f32x16 s[2];
#pragma unroll
    for (int kt = 0; kt < 2; ++kt) {
#pragma unroll
      for (int e = 0; e < 16; ++e) s[kt][e] = 0.f;
#pragma unroll
      for (int ks = 0; ks < 4; ++ks) {
        const bf16x8 kf = *(const bf16x8*)(Ks + (m * 64 + kt * 32 + q) * ALD + ks * 16 + hh * 8);
        s[kt] = __builtin_amdgcn_mfma_f32_32x32x16_bf16(kf, qf[ks], s[kt], 0, 0, 0);
      }
    }
    float mx = -1e30f;
    const float dbase = qposf - (float)(j * 64 + 4 * hh);
#pragma unroll
    for (int kt = 0; kt < 2; ++kt)
#pragma unroll
      for (int e = 0; e < 16; ++e) {
        const float dd = dbase - (float)(kt * 32 + (e & 3) + 8 * (e >> 2));
        const float v = s[kt][e] * c1 - sl2 * fabsf(dd);
        s[kt][e] = v; mx = fmaxf(mx, v);
      }
    mx = fmaxf(mx, __shfl_xor(mx, 32));
    const float mnew = fmaxf(mrun, mx);
    const float alpha = __builtin_amdgcn_exp2f(mrun - mnew);
    const bool resc = mnew > mrun;
    mrun = mnew;
    float ps = 0.f;
#pragma unroll
    for (int kt = 0; kt < 2; ++kt)
#pragma unroll
      for (int e = 0; e < 16; ++e) { const float pe = __builtin_amdgcn_exp2f(s[kt][e] - mnew); s[kt][e] = pe; ps += pe; }
    lrun = lrun * alpha + ps;
    if (__any(resc)) {
#pragma unroll
      for (int i = 0; i < 4; ++i)
#pragma unroll
        for (int e = 0; e < 16; ++e) O[i][e] *= alpha;
    }
#pragma unroll
    for (int kt = 0; kt < 2; ++kt)
#pragma unroll
      for (int sx = 0; sx < 2; ++sx) {
        u32x4 pb;
        pb[0] = pk2(s[kt][8 * sx + 0], s[kt][8 * sx + 1]); pb[1] = pk2(s[kt][8 * sx + 2], s[kt][8 * sx + 3]);
        pb[2] = pk2(s[kt][8 * sx + 4], s[kt][8 * sx + 5]); pb[3] = pk2(s[kt][8 * sx + 6], s[kt][8 * sx + 7]);
        const bf16x8 pf = __builtin_bit_cast(bf16x8, pb);
#pragma unroll
        for (int vt = 0; vt < 4; ++vt) {
          const bf16_t* vp = Vs + (vt * 32 + q) * ALD + kt * 32 + 16 * sx + 4 * hh;
          const s16x4 lo = *(const s16x4*)vp, hi = *(const s16x4*)(vp + 8);
          const bf16x8 vf = __builtin_shufflevector(lo, hi, 0, 1, 2, 3, 4, 5, 6, 7);
          O[vt] = __builtin_amdgcn_mfma_f32_32x32x16_bf16(vf, pf, O[vt], 0, 0, 0);
        }
      }
    __syncthreads();
    if (j + 1 < nch) sstore();
    __syncthreads();
  }
  const float ltot = lrun + __shfl_xor(lrun, 32);
  const float inv = 1.0f / ltot;
#pragma unroll
  for (int i = 0; i < 4; ++i)
#pragma unroll
    for (int e = 0; e < 16; ++e) O[i][e] *= inv;
  if (m == 1) {
#pragma unroll
    for (int vt = 0; vt < 4; ++vt)
#pragma unroll
      for (int e = 0; e < 16; ++e) { const int vd = vt * 32 + (e & 3) + 8 * (e >> 2) + 4 * hh; xb[(qh * 128 + vd) * 32 + q] = O[vt][e]; }
  }
  __syncthreads();
  if (m == 0) {
    float d1 = 0.f, d2 = 0.f;
    for (int i = 0; i < 64; ++i) { d1 += p.lq1[l * 64 + i] * p.lk1[l * 64 + i]; d2 += p.lq2[l * 64 + i] * p.lk2[l * 64 + i]; }
    const float lam_init = 0.8f - 0.6f * __expf(-0.3f * (float)l);
    const float lam = __expf(d1) - __expf(d2) + lam_init;
    float ss = 0.f;
#pragma unroll
    for (int vt = 0; vt < 4; ++vt)
#pragma unroll
      for (int e = 0; e < 16; ++e) {
        const int vd = vt * 32 + (e & 3) + 8 * (e >> 2) + 4 * hh;
        const float o2 = xb[(qh * 128 + vd) * 32 + q];
        const float o = O[vt][e] - lam * o2; O[vt][e] = o; ss += o * o;
      }
    ss += __shfl_xor(ss, 32);
    const float rstd = rsqrtf(ss * (1.0f / 128.0f) + 1e-5f) * (1.0f - lam_init);
    const size_t row = (size_t)(qrow0 + qh * 32 + q);
    const float* sg = p.subln_g + l * 128;
#pragma unroll
    for (int vt = 0; vt < 4; ++vt)
#pragma unroll
      for (int e4 = 0; e4 < 4; ++e4) {
        const int vd = vt * 32 + 8 * e4 + 4 * hh;
        const u32x2 gu = *(const u32x2*)(p.z + row * NZ + C_GA + h * 128 + vd);
        const f32x4 gv = *(const f32x4*)(sg + vd);
        const float y0 = O[vt][4 * e4 + 0] * rstd * gv[0] * bf_lo(gu[0]);
        const float y1 = O[vt][4 * e4 + 1] * rstd * gv[1] * bf_hi(gu[0]);
        const float y2 = O[vt][4 * e4 + 2] * rstd * gv[2] * bf_lo(gu[1]);
        const float y3 = O[vt][4 * e4 + 3] * rstd * gv[3] * bf_hi(gu[1]);
        u32x2 ov; ov[0] = pk2(y0, y1); ov[1] = pk2(y2, y3);
        *(u32x2*)(p.o_a + row * 512 + h * 128 + vd) = ov;
      }
  }
  __syncthreads();
}

DI void phase_mix(const Params& p, int l, char* lds) {
  __shared__ int s_next;
  if (blockIdx.x < 96) rec_item(p, l, blockIdx.x, lds);
  unsigned* ctr = p.bar + XCD_BAR_WORDS + 64 * l + (blockIdx.x & 7);
  for (;;) {
    __syncthreads();
    if (threadIdx.x == 0) { const int k = (int)atomicAdd(ctr, 1u); s_next = k < 132 ? k * 8 + (int)(blockIdx.x & 7) : 1 << 20; }
    __syncthreads();
    const int it = s_next;
    if (it >= (1 << 20)) break;
    attn_item(p, l, it, lds);
  }
}

DI void phase_merge(const Params& p, int l, char* lds) {
  const int tid = tid_(), wave = __builtin_amdgcn_readfirstlane(tid >> 6), lane = tid & 63;
  const int wm = wave >> 1, wn = wave & 1, l15 = lane & 15, quad = lane >> 4;
  for (int r = 0;; ++r) {
    const int g = xcd_tile(r, 132 * 8); if (g < 0) break;
    int mt, nt; tile_decode(g, 132, 8, mt, nt);
    f32x4 a1[4][4]; zero_acc(a1);
    gemm_dma(a1, p.o_r + (size_t)mt * 128 * 512, 512, p.wt_brr + (size_t)nt * 128 * 512, 512, 512, lds);
    u32x2 pk[4][4];
#pragma unroll
    for (int mi = 0; mi < 4; ++mi) {
      const int R = mt * 128 + wm * 64 + mi * 16 + l15;
#pragma unroll
      for (int ni = 0; ni < 4; ++ni) {
        const int c = nt * 128 + wn * 64 + ni * 16 + quad * 4;
        const u32x2 g1 = *(const u32x2*)(p.z + (size_t)R * NZ + C_MR + c);
        const f32x4 v1 = a1[mi][ni];
        pk[mi][ni][0] = pk2(bf_lo(g1[0]) * v1[0], bf_hi(g1[0]) * v1[1]);
        pk[mi][ni][1] = pk2(bf_lo(g1[1]) * v1[2], bf_hi(g1[1]) * v1[3]);
      }
    }
    zero_acc(a1);
    gemm_dma(a1, p.o_a + (size_t)mt * 128 * 512, 512, p.wt_bra + (size_t)nt * 128 * 512, 512, 512, lds);
#pragma unroll
    for (int mi = 0; mi < 4; ++mi) {
      const int R = mt * 128 + wm * 64 + mi * 16 + l15;
#pragma unroll
      for (int ni = 0; ni < 4; ++ni) {
        const int c = nt * 128 + wn * 64 + ni * 16 + quad * 4;
        const u32x2 g2 = *(const u32x2*)(p.z + (size_t)R * NZ + C_MA + c);
        const f32x4 v2 = a1[mi][ni]; const u32x2 u1 = pk[mi][ni];
        u32x2 o;
        o[0] = pk2(bf_lo(u1[0]) + bf_lo(g2[0]) * v2[0], bf_hi(u1[0]) + bf_hi(g2[0]) * v2[1]);
        o[1] = pk2(bf_lo(u1[1]) + bf_lo(g2[1]) * v2[2], bf_hi(u1[1]) + bf_hi(g2[1]) * v2[3]);
        *(u32x2*)(p.hn + (size_t)R * DM + c) = o;
      }
    }
  }
}
DI void phase_out(const Params& p, int l, char* lds) {
  const int tid = tid_(), wave = __builtin_amdgcn_readfirstlane(tid >> 6), lane = tid & 63;
  const int wm = wave >> 1, wn = wave & 1, l15 = lane & 15, quad = lane >> 4;
  for (int r = 0;; ++r) {
    const int g = xcd_tile(r, 132 * 8); if (g < 0) break;
    int mt, nt; tile_decode(g, 132, 8, mt, nt);
    f32x4 acc[4][4]; zero_acc(acc);
    gemm_dma(acc, p.hn + (size_t)mt * 128 * DM, DM, p.wt_out + (size_t)nt * 128 * DM, DM, DM, lds);
#pragma unroll
    for (int mi = 0; mi < 4; ++mi) {
      const int R = mt * 128 + wm * 64 + mi * 16 + l15;
      const float* xr = x_row(p, l, R);
      const float* g2 = p.ple_norm_g + l * DM;
      bf16_t* xb = p.o_r + (size_t)R * DM;
      float sq = 0.f;
#pragma unroll
      for (int ni = 0; ni < 4; ++ni) {
        const int c = nt * 128 + wn * 64 + ni * 16 + quad * 4;
        const f32x4 xv = *(const f32x4*)(xr + c);
        const f32x4 x1 = xv + acc[mi][ni];
        *(f32x4*)(p.out + (size_t)R * DM + c) = x1;
        const f32x4 gv = *(const f32x4*)(g2 + c);
        u32x2 o; o[0] = pk2(x1[0] * gv[0], x1[1] * gv[1]); o[1] = pk2(x1[2] * gv[2], x1[3] * gv[3]);
        *(u32x2*)(xb + c) = o;
        sq += x1[0] * x1[0] + x1[1] * x1[1] + x1[2] * x1[2] + x1[3] * x1[3];
      }
      sq += __shfl_xor(sq, 16); sq += __shfl_xor(sq, 32);
      if (quad == 0) atomicAdd(p.ss2 + R, sq);
    }
  }
}
DI void phase_ple(const Params& p, int l, char* lds) {
  const int tid = tid_(), wave = __builtin_amdgcn_readfirstlane(tid >> 6), lane = tid & 63;
  const int wm = wave >> 1, wn = wave & 1, l15 = lane & 15, quad = lane >> 4;
  for (int r = 0;; ++r) {
    const int g = xcd_tile(r, 132 * 8); if (g < 0) break;
    int mt, nt; tile_decode(g, 132, 8, mt, nt);
    f32x4 a1[4][4]; zero_acc(a1);
    gemm_dma(a1, p.o_r + (size_t)mt * 128 * DM, DM, p.wt_gate + (size_t)nt * 128 * DM, DM, DM, lds);
    u32x2 pk[4][4];
#pragma unroll
    for (int mi = 0; mi < 4; ++mi) {
      const float rs = rsqrtf(p.ss2[mt * 128 + wm * 64 + mi * 16 + l15] * (1.0f / 1024.0f) + 1e-6f);
#pragma unroll
      for (int ni = 0; ni < 4; ++ni) { const f32x4 v = a1[mi][ni] * rs; pk[mi][ni][0] = pk2(sigmoidf_(v[0]), sigmoidf_(v[1])); pk[mi][ni][1] = pk2(sigmoidf_(v[2]), sigmoidf_(v[3])); }
    }
    zero_acc(a1);
    const int r0 = mt * 128;
    const float* pa = r0 < MP ? p.pp + ((size_t)l * MP + r0) * 256 : p.ps + ((size_t)l * MS + (r0 - MP)) * 256;
    gemm_core<true>(a1, pa, 256, p.wt_ple + (size_t)nt * 128 * 256, 256, 256, lds);
#pragma unroll
    for (int mi = 0; mi < 4; ++mi) {
      const int R = mt * 128 + wm * 64 + mi * 16 + l15;
      float sq = 0.f;
#pragma unroll
      for (int ni = 0; ni < 4; ++ni) {
        const int c = nt * 128 + wn * 64 + ni * 16 + quad * 4;
        float* xo = p.out + (size_t)R * DM + c;
        const f32x4 xv = *(const f32x4*)xo; const f32x4 e = a1[mi][ni]; const u32x2 g = pk[mi][ni];
        f32x4 o;
        o[0] = xv[0] + e[0] * bf_lo(g[0]); o[1] = xv[1] + e[1] * bf_hi(g[0]);
        o[2] = xv[2] + e[2] * bf_lo(g[1]); o[3] = xv[3] + e[3] * bf_hi(g[1]);
        *(f32x4*)xo = o;
        if (l + 1 < NL) {
          const f32x4 gn = *(const f32x4*)(p.norm_g + (l + 1) * DM + c);
          u32x2 hv; hv[0] = pk2(o[0] * gn[0], o[1] * gn[1]); hv[1] = pk2(o[2] * gn[2], o[3] * gn[3]);
          *(u32x2*)(p.hn + (size_t)R * DM + c) = hv;
          sq += o[0] * o[0] + o[1] * o[1] + o[2] * o[2] + o[3] * o[3];
        }
      }
      if (l + 1 < NL) {
        sq += __shfl_xor(sq, 16); sq += __shfl_xor(sq, 32);
        if (quad == 0) atomicAdd(p.ss1 + R, sq);
      }
    }
  }
  if (l + 1 < NL) {
    for (int it = blockIdx.x; it < 2080 + 16 + 2048; it += gridDim.x) {
      if (it < 2080) wconv_tile(p, l + 1, it, (float*)lds);
      else if (it < 2096) wconv_tile(p, l + 1, 2400 + (it - 2080), (float*)lds);
      else cache_item(p, l + 1, it - 2096, lds);
    }
  }
}


#define XB_TMO      128
#define XB_XCNT(j)  (256  + 64 * (j))
#define XB_XSUB(j)  (1280 + 64 * (j))
#define XB_XGEN(j)  (2304 + 64 * (j))
#define XB_TOP      3328
#define XB_TOPGEN   3392
#define XB_SPIN_CAP (1u << 18)
#define LAS __attribute__((address_space(3)))
DI unsigned xb_ld(unsigned* p)              { return __hip_atomic_load(p, __ATOMIC_RELAXED, __HIP_MEMORY_SCOPE_AGENT); }
DI unsigned xb_add(unsigned* p, unsigned v) { return __hip_atomic_fetch_add(p, v, __ATOMIC_RELAXED, __HIP_MEMORY_SCOPE_AGENT); }
DI unsigned xb_xcc_id() { return (unsigned)__builtin_amdgcn_s_getreg((3 << 11) | 20) & 0xFu; }
#define XB_SPIN(cond, bar) do { unsigned _sp = 0; while (cond) { __builtin_amdgcn_s_sleep(1); \
    if ((++_sp & 255u) == 0u) { if (xb_ld(&(bar)[XB_TMO])) break; if (_sp > XB_SPIN_CAP) { atomicAdd(&(bar)[XB_TMO], 1u); break; } } } } while (0)
struct XcdBarrier { unsigned* bar; unsigned x; volatile LAS unsigned* st; };
DI XcdBarrier xcd_barrier_post(unsigned* bar, volatile LAS unsigned* st) {
  XcdBarrier b; b.bar = bar; b.x = xb_xcc_id(); b.st = st;
  if (threadIdx.x == 0) (void)xb_add(&bar[XB_XCNT(b.x)], 1u);
  return b;
}
DI void xcd_barrier_complete(unsigned* bar, unsigned x, unsigned& nloc, unsigned& nx) {
  const unsigned G = gridDim.x * gridDim.y * gridDim.z;
  unsigned sum, cnt, mine, sp = 0u;
  for (;;) {
    sum = 0u; cnt = 0u; mine = 0u;
#pragma unroll
    for (unsigned j = 0; j < 16; ++j) { const unsigned c = xb_ld(&bar[XB_XCNT(j)]); sum += c; cnt += (c > 0u) ? 1u : 0u; mine = (j == x) ? c : mine; }
    if (sum == G) break;
    __builtin_amdgcn_s_sleep(1);
    if ((++sp & 255u) == 0u) { if (xb_ld(&bar[XB_TMO])) break; if (sp > XB_SPIN_CAP) { atomicAdd(&bar[XB_TMO], 1u); break; } }
  }
  nloc = mine > 0u ? mine : 1u; nx = cnt > 0u ? cnt : 1u;
}
DI void xcd_barrier(const XcdBarrier& b) {
  asm volatile("s_waitcnt vmcnt(0)" ::: "memory");
  __syncthreads();
  if (threadIdx.x == 0) {
    unsigned* bar = b.bar;
    __builtin_amdgcn_s_waitcnt(0);
    unsigned nloc = b.st[0], nx = b.st[1];
    if (nloc == 0u) { xcd_barrier_complete(bar, b.x, nloc, nx); b.st[0] = nloc; b.st[1] = nx; }
    const unsigned old = xb_add(&bar[XB_XSUB(b.x)], 1u);
    const unsigned gen = old / nloc;
    if (old + 1u == (gen + 1u) * nloc) {
      __builtin_amdgcn_fence(__ATOMIC_RELEASE, "agent");
      asm volatile("s_waitcnt vmcnt(0)" ::: "memory");
      const unsigned og = xb_add(&bar[XB_TOP], 1u);
      const unsigned tg = og / nx;
      if (og + 1u == (tg + 1u) * nx) xb_add(&bar[XB_TOPGEN], 1u);
      else XB_SPIN(xb_ld(&bar[XB_TOPGEN]) == tg, bar);
      __builtin_amdgcn_fence(__ATOMIC_ACQUIRE, "agent");
      xb_add(&bar[XB_XGEN(b.x)], 1u);
      asm volatile("s_waitcnt vmcnt(0)" ::: "memory");
    } else {
      XB_SPIN(xb_ld(&bar[XB_XGEN(b.x)]) == gen, bar);
      __builtin_amdgcn_fence(__ATOMIC_ACQUIRE, "agent");
      asm volatile("s_waitcnt vmcnt(0)" ::: "memory");
    }
  }
  __syncthreads();
}
constexpr int LDS_BYTES = 73728;
DI void run_phase(const Params& p, int ph, int l, char* lds) {
  switch (ph) {
    case 1: phase_norm0(p, lds); break;
    case 2: phase_gemm_in(p, l, lds); break;
    case 3: phase_mix(p, l, lds); break;
    case 4: phase_merge(p, l, lds); break;
    case 5: phase_out(p, l, lds); break;
    case 6: break;
    case 7: phase_ple(p, l, lds); break;
    case 8: phase_chunk(p, l, lds); break;
  }
}

#if MEGA
__global__ void __launch_bounds__(256, 2) k_mega(Params p) {
  __shared__ __attribute__((aligned(16))) char lds[LDS_BYTES];
  __shared__ uint4 xb_words;
  cg::grid_group grid = cg::this_grid();
  if (threadIdx.x == 0) xb_words = make_uint4(0u, 0u, 0u, 0u);
  __syncthreads();
  const XcdBarrier xb = xcd_barrier_post(p.bar, (volatile LAS unsigned*)&xb_words);
  phase_norm0(p, lds);
  grid.sync();
#pragma unroll 1
  for (int l = 0; l < NL; ++l) {
    phase_gemm_in(p, l, lds); xcd_barrier(xb);
    phase_chunk(p, l, lds); xcd_barrier(xb);
    phase_mix(p, l, lds); xcd_barrier(xb);
    phase_o(p, l); xcd_barrier(xb);
    phase_merge(p, l, lds); xcd_barrier(xb);
    phase_out(p, l, lds); xcd_barrier(xb);
    phase_ple(p, l, lds); if (l + 1 < NL) xcd_barrier(xb);
  }
}
#else
template <int PH>
__global__ void __launch_bounds__(256, 2) k_phase(Params p, int l) {
  __shared__ __attribute__((aligned(16))) char lds[LDS_BYTES];
  run_phase(p, PH, l, lds);
}
#endif

extern "C" void kernel_launch(void* const* d_in, const int* in_sizes, int n_in, void* d_out, int out_size, void* d_ws, size_t ws_size,
                              hipStream_t stream) {
  Params p{};
  const float** pf = (const float**)&p;
  for (int i = 0; i < 33; ++i) pf[i] = (const float*)d_in[i];
  p.out = (float*)d_out;
  char* w = (char*)d_ws; size_t off = 0;
  auto take = [&](size_t bytes) { char* r = w + off; off += (bytes + 255) & ~(size_t)255; return (bf16_t*)r; };
  p.gS = take((size_t)(NCH + 1) * 4096 * 2);
  p.ss1 = (float*)take((size_t)MT * 4); p.ss2 = (float*)take((size_t)MT * 4);
  p.bar = (unsigned*)take((size_t)(XCD_BAR_WORDS + 64 * NL) * 4);
  p.wt_in = take((size_t)NZ * 1024 * 2);
  p.wt_brr = take((size_t)1024 * 512 * 2);
  p.wt_bra = take((size_t)1024 * 512 * 2);
  p.wt_out = take((size_t)1024 * 1024 * 2);
  p.wt_ple = take((size_t)1024 * 256 * 2);
  p.wt_gate = take((size_t)1024 * 1024 * 2);
  p.w2t = take((size_t)512 * 64 * 2);
  p.a2t = take((size_t)512 * 64 * 2);
  p.z = take((size_t)MT * NZ * 2);
  p.vtp = take((size_t)16 * 128 * 4096 * 2);
  p.vts = take((size_t)32 * 128 * 64 * 2);
  p.kc = take((size_t)8 * 1024 * 512 * 2);
  p.vct = take((size_t)32 * 128 * 1024 * 2);
  p.o_r = take((size_t)MT * 512 * 2);
  p.o_a = take((size_t)MT * 512 * 2);
  p.hn = take((size_t)MT * DM * 2);
  p.cPT = p.hn;
  p.cG = take((size_t)NCH * 4096 * 2);
  p.cRT = take((size_t)NCH * 2048 * 2);
  p.cOI = take((size_t)NCH * 2048 * 2);
  p.cBA = take((size_t)NCH * 2048 * 2);
  if (off > ws_size) { fprintf(stderr, "workspace too small: need %zu have %zu\n", off, ws_size); return; }
#if MEGA
  hipMemsetAsync(p.bar, 0, (size_t)(XCD_BAR_WORDS + 64 * NL) * 4, stream);
  static int grid_blocks = 0;
  if (!grid_blocks) {
    int dev = 0, cus = 0, per_cu = 0;
    hipGetDevice(&dev);
    hipDeviceGetAttribute(&cus, hipDeviceAttributeMultiprocessorCount, dev);
    hipOccupancyMaxActiveBlocksPerMultiprocessor(&per_cu, k_mega, 256, 0);
    if (per_cu > 2) per_cu = 2;
    grid_blocks = cus * per_cu;
  }
  void* args[] = {&p};
  hipError_t e = hipLaunchCooperativeKernel((void*)k_mega, dim3(grid_blocks), dim3(256), args, 0, stream);
  if (e != hipSuccess) fprintf(stderr, "cooperative launch failed: %s (grid %d)\n", hipGetErrorString(e), grid_blocks);
#else
  const int G = 512;
  for (int l = 0; l < NL; ++l) {
    k_phase<1><<<G, 256, 0, stream>>>(p, l);
    k_phase<2><<<G, 256, 0, stream>>>(p, l);
    k_phase<8><<<G, 256, 0, stream>>>(p, l);
    k_phase<3><<<G, 256, 0, stream>>>(p, l);
    k_phase<4><<<G, 256, 0, stream>>>(p, l);
    k_phase<5><<<G, 256, 0, stream>>>(p, l);
    k_phase<6><<<G, 256, 0, stream>>>(p, l);
    k_phase<7><<<G, 256, 0, stream>>>(p, l);
  }
#endif
}
```

```cpp
#include <hip/hip_runtime.h>
#include <hip/hip_cooperative_groups.h>
#include <stdint.h>
#include <stdio.h>
namespace cg = cooperative_groups;

#ifndef MEGA
#define MEGA 1
#endif

typedef unsigned short bf16_t;
typedef short bf16x8 __attribute__((ext_vector_type(8)));
typedef short s16x4 __attribute__((ext_vector_type(4)));
typedef float f32x4 __attribute__((ext_vector_type(4)));
typedef float f32x2 __attribute__((ext_vector_type(2)));
typedef float f32x16 __attribute__((ext_vector_type(16)));
typedef unsigned u32x4 __attribute__((ext_vector_type(4)));
typedef unsigned u32x2 __attribute__((ext_vector_type(2)));
typedef __bf16 bfv2 __attribute__((ext_vector_type(2)));

#define DI __device__ __forceinline__
#define XCD_BAR_WORDS 3456
DI int tid_() { int t = threadIdx.x; asm volatile("" : "+v"(t)); return t; }

constexpr int DM = 1024, MP = 16384, MS = 512, MT = 16896, NZ = 6272, NL = 4;
constexpr int C_GR = 1664, C_Q = 2176, C_K = 2688, C_V = 3200, C_GA = 3712, C_MR = 4224, C_MA = 5248;
constexpr int SHC = 1664;
constexpr size_t O_YP = 0, O_YS = 16777216, O_KP = 17301504, O_VP = 50855936, O_WP = 84410368, O_SP = 84934656,
                 O_KS = 84961280, O_VS = 86009856, O_WS = 87058432, O_SS = 88107008;

struct Params {
  const float *xp, *xs, *pp, *ps, *ck, *cv, *swkv, *sshift;
  const float *norm_g, *w_in, *shift_mu, *decay_w0, *decay_w2, *iclr_a0, *iclr_a2, *k_k, *k_a, *r_k, *lnx_g, *lnx_b,
      *qng, *kng, *lq1, *lk1, *lq2, *lk2, *subln_g, *w_br_r, *w_br_a, *w_out, *ple_w, *ple_gate_w, *ple_norm_g;
  float* out;
  bf16_t *wt_in, *wt_brr, *wt_bra, *wt_out, *wt_ple, *wt_gate, *w2t, *a2t;
  bf16_t *hn, *z, *vtp, *vts, *kc, *vct, *o_r, *o_a;
  bf16_t *cPT, *cG, *cRT, *cOI, *cBA;
  unsigned* bar;
  float *ss1, *ss2;
  bf16_t* gS;
};

DI unsigned pk2(float a, float b) { f32x2 v = {a, b}; bfv2 r = __builtin_convertvector(v, bfv2); return __builtin_bit_cast(unsigned, r); }
DI float bf_lo(unsigned u) { return __uint_as_float(u << 16); }
DI float bf_hi(unsigned u) { return __uint_as_float(u & 0xffff0000u); }
DI float bf1(bf16_t u) { return __uint_as_float(((unsigned)u) << 16); }
DI float sigmoidf_(float x) { return __builtin_amdgcn_rcpf(1.0f + __expf(-x)); }
DI float siluf_(float x) { return x * __builtin_amdgcn_rcpf(1.0f + __expf(-x)); }

DI void tr_tile(const float* __restrict__ src, int ld_src, bf16_t* __restrict__ dst, int ld_dst, float* sm) {
  const int tid = tid_();
  const int r = tid >> 4, c4 = (tid & 15) * 4;
#pragma unroll
  for (int i = 0; i < 4; ++i) {
    const int row = r + 16 * i;
    f32x4 v = *(const f32x4*)(src + (size_t)row * ld_src + c4);
    sm[row * 65 + c4 + 0] = v[0]; sm[row * 65 + c4 + 1] = v[1]; sm[row * 65 + c4 + 2] = v[2]; sm[row * 65 + c4 + 3] = v[3];
  }
  __syncthreads();
  const int n = tid >> 2, ks = (tid & 3) * 16;
  u32x4 o0, o1;
  o0[0] = pk2(sm[(ks + 0) * 65 + n], sm[(ks + 1) * 65 + n]);   o0[1] = pk2(sm[(ks + 2) * 65 + n], sm[(ks + 3) * 65 + n]);
  o0[2] = pk2(sm[(ks + 4) * 65 + n], sm[(ks + 5) * 65 + n]);   o0[3] = pk2(sm[(ks + 6) * 65 + n], sm[(ks + 7) * 65 + n]);
  o1[0] = pk2(sm[(ks + 8) * 65 + n], sm[(ks + 9) * 65 + n]);   o1[1] = pk2(sm[(ks + 10) * 65 + n], sm[(ks + 11) * 65 + n]);
  o1[2] = pk2(sm[(ks + 12) * 65 + n], sm[(ks + 13) * 65 + n]); o1[3] = pk2(sm[(ks + 14) * 65 + n], sm[(ks + 15) * 65 + n]);
  *(u32x4*)(dst + (size_t)n * ld_dst + ks) = o0;
  *(u32x4*)(dst + (size_t)n * ld_dst + ks + 8) = o1;
  __syncthreads();
}

constexpr int WCONV_TILES = 1568 + 128 + 128 + 256 + 64 + 256 + 8 + 8;
DI void wconv_tile(const Params& p, int l, int t, float* sm) {
  const float* src; bf16_t* dst; int K, N;
  if (t < 1568) { src = p.w_in + (size_t)l * 1024 * NZ; dst = p.wt_in; K = 1024; N = NZ; }
  else if ((t -= 1568) < 128) { src = p.w_br_r + (size_t)l * 512 * 1024; dst = p.wt_brr; K = 512; N = 1024; }
  else if ((t -= 128) < 128) { src = p.w_br_a + (size_t)l * 512 * 1024; dst = p.wt_bra; K = 512; N = 1024; }
  else if ((t -= 128) < 256) { src = p.w_out + (size_t)l * 1024 * 1024; dst = p.wt_out; K = 1024; N = 1024; }
  else if ((t -= 256) < 64) { src = p.ple_w + (size_t)l * 256 * 1024; dst = p.wt_ple; K = 256; N = 1024; }
  else if ((t -= 64) < 256) { src = p.ple_gate_w + (size_t)l * 1024 * 1024; dst = p.wt_gate; K = 1024; N = 1024; }
  else if ((t -= 256) < 8) { src = p.decay_w2 + (size_t)l * 64 * 512; dst = p.w2t; K = 64; N = 512; }
  else { t -= 8; src = p.iclr_a2 + (size_t)l * 64 * 512; dst = p.a2t; K = 64; N = 512; }
  const int ntn = N / 64; const int tk = t / ntn, tn = t % ntn;
  tr_tile(src + (size_t)(tk * 64) * N + tn * 64, N, dst + (size_t)(tn * 64) * K + tk * 64, K, sm);
}

DI const float* x_row(const Params& p, int l, int r) {
  if (l == 0) return r < MP ? p.xp + (size_t)r * DM : p.xs + (size_t)(r - MP) * DM;
  return p.out + (size_t)r * DM;
}
DI void cache_item(const Params& p, int l, int c, char* lds) {
  const int tid = tid_();
  if (c < 1024) {
    const float* src = p.ck + (size_t)l * 8 * 1024 * 512 + (size_t)c * 4096 + tid * 16;
    bf16_t* dst = p.kc + (size_t)c * 4096 + tid * 16;
    f32x4 a0 = *(const f32x4*)(src), a1 = *(const f32x4*)(src + 4), a2 = *(const f32x4*)(src + 8), a3 = *(const f32x4*)(src + 12);
    u32x4 o0, o1;
    o0[0] = pk2(a0[0], a0[1]); o0[1] = pk2(a0[2], a0[3]); o0[2] = pk2(a1[0], a1[1]); o0[3] = pk2(a1[2], a1[3]);
    o1[0] = pk2(a2[0], a2[1]); o1[1] = pk2(a2[2], a2[3]); o1[2] = pk2(a3[0], a3[1]); o1[3] = pk2(a3[2], a3[3]);
    *(u32x4*)dst = o0; *(u32x4*)(dst + 8) = o1;
  } else {
    c -= 1024;
    const int bh = c >> 5, tt = c & 31; const int b = bh >> 2, h = bh & 3; const int tk = tt >> 1, tn = tt & 1;
    const float* src = p.cv + (size_t)l * 8 * 1024 * 512 + ((size_t)(b * 1024 + tk * 64)) * 512 + h * 128 + tn * 64;
    bf16_t* dst = p.vct + ((size_t)(bh * 128 + tn * 64)) * 1024 + tk * 64;
    tr_tile(src, 512, dst, 1024, (float*)lds);
  }
}
DI void phase_norm0(const Params& p, char* lds) {
  const int tid = tid_(), wave = __builtin_amdgcn_readfirstlane(tid >> 6), lane = tid & 63;
  const float* g = p.norm_g;
  const int n_norm = MT / 8;
  const int n_items = n_norm + 2048 + WCONV_TILES;
  for (int it = blockIdx.x; it < n_items; it += gridDim.x) {
    if (it < n_norm) {
      const int r0 = it * 8 + wave * 2;
      f32x4 v[2][4]; float ss[2] = {0.f, 0.f};
#pragma unroll
      for (int k = 0; k < 2; ++k) {
        const float* x = x_row(p, 0, r0 + k);
#pragma unroll
        for (int i = 0; i < 4; ++i) v[k][i] = *(const f32x4*)(x + lane * 4 + 256 * i);
      }
      f32x4 gv[4];
#pragma unroll
      for (int i = 0; i < 4; ++i) gv[i] = *(const f32x4*)(g + lane * 4 + 256 * i);
#pragma unroll
      for (int k = 0; k < 2; ++k) {
#pragma unroll
        for (int i = 0; i < 4; ++i) ss[k] += v[k][i][0] * v[k][i][0] + v[k][i][1] * v[k][i][1] + v[k][i][2] * v[k][i][2] + v[k][i][3] * v[k][i][3];
#pragma unroll
        for (int o = 32; o >= 1; o >>= 1) ss[k] += __shfl_xor(ss[k], o);
        const float rstd = rsqrtf(ss[k] * (1.0f / 1024.0f) + 1e-6f);
#pragma unroll
        for (int i = 0; i < 4; ++i) {
          u32x2 o; o[0] = pk2(v[k][i][0] * rstd * gv[i][0], v[k][i][1] * rstd * gv[i][1]); o[1] = pk2(v[k][i][2] * rstd * gv[i][2], v[k][i][3] * rstd * gv[i][3]);
          *(u32x2*)(p.hn + (size_t)(r0 + k) * DM + lane * 4 + 256 * i) = o;
        }
        if (lane == 0) p.ss1[r0 + k] = 1024.0f * (1.0f - 1e-6f);
      }
    } else if (it < n_norm + 2048) {
      cache_item(p, 0, it - n_norm, lds);
    } else {
      wconv_tile(p, 0, it - n_norm - 2048, (float*)lds);
    }
  }
}
DI void zero_f32(float* a, int n) {
  for (int i = blockIdx.x * 256 + (int)threadIdx.x; i < n; i += gridDim.x * 256) a[i] = 0.f;
}

constexpr int GLD = 72;
template <bool A_F32>
DI void gemm_core(f32x4 (&acc)[4][4], const void* Ap, int lda, const bf16_t* Bp, int ldb, int K, char* lds) {
  bf16_t* As = (bf16_t*)lds;
  bf16_t* Bs = (bf16_t*)(lds + 2 * 128 * GLD * 2);
  const int tid = tid_(), wave = __builtin_amdgcn_readfirstlane(tid >> 6), lane = tid & 63;
  const int wm = wave >> 1, wn = wave & 1, l15 = lane & 15, quad = lane >> 4;
  const int nk = K / 64;
  u32x4 ra[4], rb[4];
  auto gload = [&](int kt) {
#pragma unroll
    for (int i = 0; i < 4; ++i) {
      const int c = tid + 256 * i; const int row = c >> 3, c8 = (c & 7) * 8;
      if (!A_F32) ra[i] = *(const u32x4*)((const bf16_t*)Ap + (size_t)row * lda + kt * 64 + c8);
      rb[i] = *(const u32x4*)(Bp + (size_t)row * ldb + kt * 64 + c8);
    }
  };
  auto sstore = [&](int buf, int kt) {
#pragma unroll
    for (int i = 0; i < 4; ++i) {
      const int c = tid + 256 * i; const int row = c >> 3, c8 = (c & 7) * 8;
      if (A_F32) {
        const float* a = (const float*)Ap + (size_t)row * lda + kt * 64 + c8;
        const f32x4 v0 = *(const f32x4*)a, v1 = *(const f32x4*)(a + 4);
        u32x4 t; t[0] = pk2(v0[0], v0[1]); t[1] = pk2(v0[2], v0[3]); t[2] = pk2(v1[0], v1[1]); t[3] = pk2(v1[2], v1[3]);
        *(u32x4*)(As + (buf * 128 + row) * GLD + c8) = t;
      } else {
        *(u32x4*)(As + (buf * 128 + row) * GLD + c8) = ra[i];
      }
      *(u32x4*)(Bs + (buf * 128 + row) * GLD + c8) = rb[i];
    }
  };
  gload(0); sstore(0, 0); __syncthreads();
  for (int kt = 0; kt < nk; ++kt) {
    const int buf = kt & 1;
    if (kt + 1 < nk) gload(kt + 1);
#pragma unroll
    for (int ks = 0; ks < 2; ++ks) {
      bf16x8 af[4], bfr[4];
#pragma unroll
      for (int i = 0; i < 4; ++i) {
        af[i] = *(const bf16x8*)(As + (buf * 128 + wm * 64 + i * 16 + l15) * GLD + ks * 32 + quad * 8);
        bfr[i] = *(const bf16x8*)(Bs + (buf * 128 + wn * 64 + i * 16 + l15) * GLD + ks * 32 + quad * 8);
      }
#pragma unroll
      for (int mi = 0; mi < 4; ++mi)
#pragma unroll
        for (int ni = 0; ni < 4; ++ni) acc[mi][ni] = __builtin_amdgcn_mfma_f32_16x16x32_bf16(bfr[ni], af[mi], acc[mi][ni], 0, 0, 0);
    }
    if (kt + 1 < nk) sstore(buf ^ 1, kt + 1);
    __syncthreads();
  }
}
#define LASP __attribute__((address_space(3)))
DI void gemm_dma(f32x4 (&acc)[4][4], const bf16_t* Ap, int lda, const bf16_t* Bp, int ldb, int K, char* lds) {
  const int tid = tid_(), wave = __builtin_amdgcn_readfirstlane(tid >> 6), lane = tid & 63;
  const int wm = wave >> 1, wn = wave & 1, l15 = lane & 15, quad = lane >> 4;
  const int nk = K / 64;
  const int lrow = lane >> 3, lpc = lane & 7;
  const bf16_t* ga[4]; const bf16_t* gb[4];
#pragma unroll
  for (int i = 0; i < 4; ++i) {
    const int row = (wave * 4 + i) * 8 + lrow; const int q = lpc ^ (row & 7);
    ga[i] = Ap + (size_t)row * lda + q * 8; gb[i] = Bp + (size_t)row * ldb + q * 8;
  }
  auto issue = [&](int kt) {
    char* sb = lds + (kt & 1) * 32768 + wave * 4096;
#pragma unroll
    for (int i = 0; i < 4; ++i) {
      __builtin_amdgcn_global_load_lds((const unsigned*)(ga[i] + kt * 64), (LASP unsigned*)(sb + i * 1024), 16, 0, 0);
      __builtin_amdgcn_global_load_lds((const unsigned*)(gb[i] + kt * 64), (LASP unsigned*)(sb + 16384 + i * 1024), 16, 0, 0);
    }
  };
  const int sw = l15 & 7;
  const unsigned lbase = (unsigned)(size_t)(LASP char*)lds;
  const unsigned a0 = (unsigned)((wm * 64 + l15) * 128 + ((quad ^ sw) * 16)), a1 = (unsigned)((wm * 64 + l15) * 128 + (((4 + quad) ^ sw) * 16));
  const unsigned b0 = 16384u + (unsigned)((wn * 64 + l15) * 128 + ((quad ^ sw) * 16)), b1 = 16384u + (unsigned)((wn * 64 + l15) * 128 + (((4 + quad) ^ sw) * 16));
  asm volatile("s_waitcnt vmcnt(0)" ::: "memory");
  __builtin_amdgcn_s_barrier();
  asm volatile("" ::: "memory");
  issue(0);
  for (int kt = 0; kt < nk; ++kt) {
    asm volatile("s_waitcnt vmcnt(0)" ::: "memory");
    __builtin_amdgcn_s_barrier();
    asm volatile("" ::: "memory");
    if (kt + 1 < nk) issue(kt + 1);
    const unsigned sa = lbase + (unsigned)((kt & 1) * 32768);
    bf16x8 af[4], bfr[4], ag[4], bg[4];
    asm volatile("ds_read_b128 %0, %8\n\tds_read_b128 %1, %8 offset:2048\n\tds_read_b128 %2, %8 offset:4096\n\tds_read_b128 %3, %8 offset:6144\n\t"
                 "ds_read_b128 %4, %9\n\tds_read_b128 %5, %9 offset:2048\n\tds_read_b128 %6, %9 offset:4096\n\tds_read_b128 %7, %9 offset:6144"
                 : "=&v"(af[0]), "=&v"(af[1]), "=&v"(af[2]), "=&v"(af[3]), "=&v"(bfr[0]), "=&v"(bfr[1]), "=&v"(bfr[2]), "=&v"(bfr[3])
                 : "v"(sa + a0), "v"(sa + b0) : "memory");
    asm volatile("ds_read_b128 %0, %16\n\tds_read_b128 %1, %16 offset:2048\n\tds_read_b128 %2, %16 offset:4096\n\tds_read_b128 %3, %16 offset:6144\n\t"
                 "ds_read_b128 %4, %17\n\tds_read_b128 %5, %17 offset:2048\n\tds_read_b128 %6, %17 offset:4096\n\tds_read_b128 %7, %17 offset:6144\n\t"
                 "s_waitcnt lgkmcnt(8)"
                 : "=&v"(ag[0]), "=&v"(ag[1]), "=&v"(ag[2]), "=&v"(ag[3]), "=&v"(bg[0]), "=&v"(bg[1]), "=&v"(bg[2]), "=&v"(bg[3]),
                   "+v"(af[0]), "+v"(af[1]), "+v"(af[2]), "+v"(af[3]), "+v"(bfr[0]), "+v"(bfr[1]), "+v"(bfr[2]), "+v"(bfr[3])
                 : "v"(sa + a1), "v"(sa + b1) : "memory");
#pragma unroll
    for (int mi = 0; mi < 4; ++mi)
#pragma unroll
      for (int ni = 0; ni < 4; ++ni) acc[mi][ni] = __builtin_amdgcn_mfma_f32_16x16x32_bf16(bfr[ni], af[mi], acc[mi][ni], 0, 0, 0);
    asm volatile("s_waitcnt lgkmcnt(0)" : "+v"(ag[0]), "+v"(ag[1]), "+v"(ag[2]), "+v"(ag[3]), "+v"(bg[0]), "+v"(bg[1]), "+v"(bg[2]), "+v"(bg[3]) :: "memory");
#pragma unroll
    for (int mi = 0; mi < 4; ++mi)
#pragma unroll
      for (int ni = 0; ni < 4; ++ni) acc[mi][ni] = __builtin_amdgcn_mfma_f32_16x16x32_bf16(bg[ni], ag[mi], acc[mi][ni], 0, 0, 0);
  }
  asm volatile("" ::: "memory");
  __builtin_amdgcn_s_barrier();
  asm volatile("" ::: "memory");
}
DI void zero_acc(f32x4 (&acc)[4][4]) {
#pragma unroll
  for (int i = 0; i < 4; ++i)
#pragma unroll
    for (int j = 0; j < 4; ++j) acc[i][j] = (f32x4){0.f, 0.f, 0.f, 0.f};
}

DI int xcd_tile(int r, int T) {
  const int x = blockIdx.x & 7, j = blockIdx.x >> 3, nb = gridDim.x >> 3;
  if (j >= nb) return -1;
  const int start = (int)(((long)x * T) / 8), end = (int)(((long)(x + 1) * T) / 8);
  const int g = start + r * nb + j;
  return g < end ? g : -1;
}
DI void tile_decode(int g, int nM, int nN, int& mt, int& nt) {
  const int per = 8 * nN; const int grp = g / per, idx = g - grp * per; const int gm0 = grp * 8;
  const int gsz = (nM - gm0) < 8 ? (nM - gm0) : 8;
  nt = idx / gsz; mt = gm0 + (idx - nt * gsz);
}
DI void phase_gemm_in(const Params& p, int l, char* lds) {
  const int tid = tid_(), wave = __builtin_amdgcn_readfirstlane(tid >> 6), lane = tid & 63;
  const int wm = wave >> 1, wn = wave & 1, l15 = lane & 15, quad = lane >> 4;
  const bf16_t* Wt = p.wt_in;
  const int NTN = 49, NTM = 132;
  for (int r = 0;; ++r) {
    const int g = xcd_tile(r, NTN * NTM); if (g < 0) break;
    int mt, nt; tile_decode(g, NTM, NTN, mt, nt);
    f32x4 acc[4][4]; zero_acc(acc);
    gemm_dma(acc, p.hn + (size_t)mt * 128 * DM, DM, Wt + (size_t)nt * 128 * DM, DM, DM, lds);
    const int colb = nt * 128 + wn * 64 + quad * 4;
    {
#pragma unroll
      for (int mi = 0; mi < 4; ++mi) {
        const float rs = rsqrtf(p.ss1[mt * 128 + wm * 64 + mi * 16 + l15] * (1.0f / 1024.0f) + 1e-6f);
#pragma unroll
        for (int ni = 0; ni < 4; ++ni) acc[mi][ni] = acc[mi][ni] * rs;
      }
    }
    int kind;
    if (nt < 13) kind = 0; else if (nt < 17) kind = 1; else if (nt < 21) kind = 2; else if (nt < 25) kind = 3; else if (nt < 29) kind = 4; else if (nt < 33) kind = 1; else kind = 5;
#pragma unroll
    for (int mi = 0; mi < 4; ++mi) {
      const int R = mt * 128 + wm * 64 + mi * 16 + l15;
      const bool isp = R < MP; const int rs = R - MP;
      bf16_t* zrow = p.z + (size_t)R * NZ;
      if (kind == 0) {
        const bool last = isp ? ((R & 4095) == 4095) : ((rs & 63) == 63);
        float* so = isp ? p.out + O_SP + (size_t)(l * 4 + (R >> 12)) * SHC : p.out + O_SS + (size_t)(l * 8 + (rs >> 6)) * SHC;
#pragma unroll
        for (int ni = 0; ni < 4; ++ni) {
          const int c = colb + ni * 16; const f32x4 v = acc[mi][ni];
          u32x2 o; o[0] = pk2(v[0], v[1]); o[1] = pk2(v[2], v[3]); *(u32x2*)(zrow + c) = o;
          if (last) *(f32x4*)(so + c) = v;
        }
      } else if (kind == 1 || kind == 5) {
#pragma unroll
        for (int ni = 0; ni < 4; ++ni) {
          const int c = colb + ni * 16; f32x4 v = acc[mi][ni];
#pragma unroll
          for (int e = 0; e < 4; ++e) v[e] = (kind == 1) ? siluf_(v[e]) : sigmoidf_(v[e]);
          u32x2 o; o[0] = pk2(v[0], v[1]); o[1] = pk2(v[2], v[3]); *(u32x2*)(zrow + c) = o;
        }
      } else if (kind == 2 || kind == 3) {
        float ss = 0.f;
#pragma unroll
        for (int ni = 0; ni < 4; ++ni) { const f32x4 v = acc[mi][ni]; ss += v[0] * v[0] + v[1] * v[1] + v[2] * v[2] + v[3] * v[3]; }
        ss += __shfl_xor(ss, 16); ss += __shfl_xor(ss, 32);
        const float rstd = rsqrtf(ss * (1.0f / 64.0f) + 1e-6f);
        const float* g = (kind == 2 ? p.qng : p.kng) + l * 64;
        float* ko = isp ? p.out + O_KP + ((size_t)l * MP + R) * 512 : p.out + O_KS + ((size_t)l * MS + rs) * 512;
#pragma unroll
        for (int ni = 0; ni < 4; ++ni) {
          const int c = colb + ni * 16; const int d = ni * 16 + quad * 4;
          const f32x4 gv = *(const f32x4*)(g + d); f32x4 v = acc[mi][ni];
#pragma unroll
          for (int e = 0; e < 4; ++e) v[e] = v[e] * rstd * gv[e];
          u32x2 o; o[0] = pk2(v[0], v[1]); o[1] = pk2(v[2], v[3]); *(u32x2*)(zrow + c) = o;
          if (kind == 3) *(f32x4*)(ko + (c - C_K)) = v;
        }
      } else {
        float* vo = isp ? p.out + O_VP + ((size_t)l * MP + R) * 512 : p.out + O_VS + ((size_t)l * MS + rs) * 512;
#pragma unroll
        for (int ni = 0; ni < 4; ++ni) {
          const int cv = colb + ni * 16 - C_V; const f32x4 v = acc[mi][ni];
          *(f32x4*)(vo + cv) = v;
          const int h = cv >> 7, vd = cv & 127;
          if (isp) {
            bf16_t* vt = p.vtp + ((size_t)(((R >> 12) * 4 + h) * 128 + vd)) * 4096 + (R & 4095);
#pragma unroll
            for (int e = 0; e < 4; ++e) vt[(size_t)e * 4096] = (bf16_t)(pk2(v[e], 0.f) & 0xffff);
          } else {
            bf16_t* vt = p.vts + ((size_t)(((rs >> 6) * 4 + h) * 128 + vd)) * 64 + (rs & 63);
#pragma unroll
            for (int e = 0; e < 4; ++e) vt[(size_t)e * 64] = (bf16_t)(pk2(v[e], 0.f) & 0xffff);
          }
        }
      }
    }
  }
  zero_f32(p.ss2, MT);
  if (l > 0) for (int it = blockIdx.x; it < 320; it += gridDim.x) wconv_tile(p, l, 2080 + it, (float*)lds);
}

constexpr int NCH_P = 4096, NCH = 4224;
constexpr int XLD = 40;
DI f32x4 mm16(const bf16_t* Xrow, int ldx, const bf16_t* Yrow, int ldy, int ksteps, f32x4 acc, int l15, int quad) {
  for (int ks = 0; ks < ksteps; ++ks) {
    const bf16x8 a = *(const bf16x8*)(Xrow + l15 * ldx + ks * 32 + quad * 8);
    const bf16x8 b = *(const bf16x8*)(Yrow + l15 * ldy + ks * 32 + quad * 8);
    acc = __builtin_amdgcn_mfma_f32_16x16x32_bf16(a, b, acc, 0, 0, 0);
  }
  return acc;
}
DI void chunk_item(const Params& p, int l, int item, char* lds) {
  const int tid = tid_(), wave = __builtin_amdgcn_readfirstlane(tid >> 6), lane = tid & 63, l15 = lane & 15, quad = lane >> 4;
  const bool isp = item < NCH_P;
  int bh, c;
  if (isp) { bh = item >> 7; c = item & 127; } else { const int j = item - NCH_P; bh = j >> 1; c = j & 1; }
  const int b = bh >> 3, h = bh & 7;
  const int t0 = c * 32; const int row0 = (isp ? b * 4096 : MP + b * 64) + t0;
  float* s_r = (float*)lds;
  float* s_kf = s_r + 2048;
  float* s_v = s_kf + 2048;
  float* s_w = s_v + 2048;
  float* s_kk = s_w + 2048;
  float* s_bb = s_kk + 2048;
  bf16_t* s_wd = (bf16_t*)(lds + 49152);
  bf16_t* s_ad = (bf16_t*)(lds + 53760);
  float* s_bonus = (float*)(lds + 58368);
  float* s_wl = (float*)(lds + 58880);
  float* s_rhs = (float*)lds;
  bf16_t* s_A = (bf16_t*)lds;
  bf16_t* s_Bm = (bf16_t*)(lds + 4608);
  bf16_t* s_Kp = (bf16_t*)(lds + 9216);
  bf16_t* s_R = (bf16_t*)(lds + 16384);
  bf16_t* s_BmT = (bf16_t*)(lds + 20992);
  bf16_t* s_KpT = (bf16_t*)(lds + 26112);
  bf16_t* s_VmT = (bf16_t*)(lds + 31232);
  bf16_t* s_Lak = (bf16_t*)(lds + 36352);
  bf16_t* s_Mrk = (bf16_t*)(lds + 38912);
  bf16_t* s_Mrb = (bf16_t*)(lds + 41472);
  float* s_labT = (float*)(lds + 44032);
  bf16_t* s_XT = (bf16_t*)(lds + 48640);

  const int mat = wave >> 1, tt = wave & 1;
  const bf16_t* wl = (mat == 0 ? p.w2t : p.a2t) + (size_t)(h * 64) * 64;
  const float* mu = p.shift_mu + l * SHC;
  const float* w0 = p.decay_w0 + l * 512 + h * 64;
  const float* a0 = p.iclr_a0 + l * 512 + h * 64;
  const float* kkp = p.k_k + l * 512 + h * 64;
  const float* kap = p.k_a + l * 512 + h * 64;
  const float* rkp = p.r_k + l * 512 + h * 64;
  const float* lb = p.lnx_b + l * 512 + h * 64;
  const int ptok = tid >> 3, pcs = (tid & 7) * 8;
  {
    const int t = t0 + ptok; const size_t row = (size_t)(row0 + ptok);
#pragma unroll
    for (int g = 0; g < 5; ++g) {
      const int zc = (g < 3 ? g * 512 + h * 64 : 1536 + (g - 3) * 64) + pcs;
      const u32x4 cu = *(const u32x4*)(p.z + row * NZ + zc);
      float cur[8], prv[8];
#pragma unroll
      for (int e = 0; e < 4; ++e) { cur[2 * e] = bf_lo(cu[e]); cur[2 * e + 1] = bf_hi(cu[e]); }
      if (t > 0) {
        const u32x4 pu = *(const u32x4*)(p.z + (row - 1) * NZ + zc);
#pragma unroll
        for (int e = 0; e < 4; ++e) { prv[2 * e] = bf_lo(pu[e]); prv[2 * e + 1] = bf_hi(pu[e]); }
      } else if (isp) {
#pragma unroll
        for (int e = 0; e < 8; ++e) prv[e] = 0.f;
      } else {
        const float* sp = p.sshift + (size_t)(l * 8 + b) * SHC + zc;
#pragma unroll
        for (int e = 0; e < 8; ++e) prv[e] = sp[e];
      }
      float zs[8];
#pragma unroll
      for (int e = 0; e < 8; ++e) zs[e] = cur[e] + (prv[e] - cur[e]) * mu[zc + e];
      if (g < 3) {
        float* d = (g == 0 ? s_r : g == 1 ? s_kf : s_v) + ptok * 64 + pcs;
        *(f32x4*)d = (f32x4){zs[0], zs[1], zs[2], zs[3]}; *(f32x4*)(d + 4) = (f32x4){zs[4], zs[5], zs[6], zs[7]};
      } else {
        if (g == 3) {
#pragma unroll
          for (int e = 0; e < 8; ++e) { const float ex = __expf(2.f * zs[e]); zs[e] = 1.f - 2.f * __builtin_amdgcn_rcpf(ex + 1.f); }
        }
        u32x4 o; o[0] = pk2(zs[0], zs[1]); o[1] = pk2(zs[2], zs[3]); o[2] = pk2(zs[4], zs[5]); o[3] = pk2(zs[6], zs[7]);
        *(u32x4*)((g == 3 ? s_wd : s_ad) + ptok * 72 + pcs) = o;
      }
    }
  }
  __syncthreads();
  {
    const bf16_t* At = (mat == 0 ? s_wd : s_ad);
    bf16x8 af[2];
#pragma unroll
    for (int ks = 0; ks < 2; ++ks) af[ks] = *(const bf16x8*)(At + (tt * 16 + l15) * 72 + ks * 32 + quad * 8);
#pragma unroll
    for (int ct = 0; ct < 4; ++ct) {
      f32x4 d = (f32x4){0.f, 0.f, 0.f, 0.f};
#pragma unroll
      for (int ks = 0; ks < 2; ++ks) {
        const bf16x8 wfr = *(const bf16x8*)(wl + (size_t)(ct * 16 + l15) * 64 + ks * 32 + quad * 8);
        d = __builtin_amdgcn_mfma_f32_16x16x32_bf16(wfr, af[ks], d, 0, 0, 0);
      }
      const int ch = ct * 16 + quad * 4; const int tok = tt * 16 + l15;
      f32x4 o;
      if (mat == 0) {
#pragma unroll
        for (int e = 0; e < 4; ++e) {
          const float y = -(w0[ch + e] + d[e]);
          const float sp = fmaxf(y, 0.f) + __logf(1.0f + __expf(-fabsf(y)));
          o[e] = -__expf(-sp - 0.5f);
        }
        *(f32x4*)(s_w + tok * 64 + ch) = o;
      } else {
#pragma unroll
        for (int e = 0; e < 4; ++e) o[e] = sigmoidf_(a0[ch + e] + d[e]);
        *(f32x4*)(s_bb + tok * 64 + ch) = o;
      }
    }
  }
  __syncthreads();
  float r_[8], kf[8], kk[8], bbv[8], v_[8], bon;
  {
    float k_[8], a_[8];
    *(f32x4*)&k_[0] = *(const f32x4*)(s_kf + ptok * 64 + pcs); *(f32x4*)&k_[4] = *(const f32x4*)(s_kf + ptok * 64 + pcs + 4);
    *(f32x4*)&a_[0] = *(const f32x4*)(s_bb + ptok * 64 + pcs); *(f32x4*)&a_[4] = *(const f32x4*)(s_bb + ptok * 64 + pcs + 4);
    *(f32x4*)&r_[0] = *(const f32x4*)(s_r + ptok * 64 + pcs); *(f32x4*)&r_[4] = *(const f32x4*)(s_r + ptok * 64 + pcs + 4);
    *(f32x4*)&v_[0] = *(const f32x4*)(s_v + ptok * 64 + pcs); *(f32x4*)&v_[4] = *(const f32x4*)(s_v + ptok * 64 + pcs + 4);
    float ss = 0.f; bon = 0.f;
#pragma unroll
    for (int e = 0; e < 8; ++e) {
      kk[e] = k_[e] * kkp[pcs + e]; ss += kk[e] * kk[e];
      kf[e] = k_[e] * (1.f + (a_[e] - 1.f) * kap[pcs + e]);
      bon += r_[e] * kf[e] * rkp[pcs + e];
    }
    ss += __shfl_xor(ss, 1); ss += __shfl_xor(ss, 2); ss += __shfl_xor(ss, 4);
    bon += __shfl_xor(bon, 1); bon += __shfl_xor(bon, 2); bon += __shfl_xor(bon, 4);
    const float inv = 1.0f / fmaxf(sqrtf(ss), 1e-12f);
#pragma unroll
    for (int e = 0; e < 8; ++e) { kk[e] *= inv; bbv[e] = kk[e] * a_[e]; }
  }
  if (tid < 64) {
    float run = 0.f;
#pragma unroll 8
    for (int t = 0; t < 32; ++t) { run += s_w[t * 64 + tid]; s_w[t * 64 + tid] = run; }
  }
  __syncthreads();
  {
    float cw[8], cwp[8];
    *(f32x4*)&cw[0] = *(const f32x4*)(s_w + ptok * 64 + pcs); *(f32x4*)&cw[4] = *(const f32x4*)(s_w + ptok * 64 + pcs + 4);
    if (ptok > 0) { *(f32x4*)&cwp[0] = *(const f32x4*)(s_w + (ptok - 1) * 64 + pcs); *(f32x4*)&cwp[4] = *(const f32x4*)(s_w + (ptok - 1) * 64 + pcs + 4); }
    else {
#pragma unroll
      for (int e = 0; e < 8; ++e) cwp[e] = 0.f;
    }
    __syncthreads();
    float av[8], bm[8], kp[8], rr[8];
#pragma unroll
    for (int e = 0; e < 8; ++e) {
      const float ec = __expf(cw[e]), en = __expf(-cw[e]), ep = __expf(cwp[e]);
      av[e] = kk[e] * ep; bm[e] = bbv[e] * en; kp[e] = kf[e] * en; rr[e] = r_[e] * ec;
      if (ptok == 31) s_wl[pcs + e] = ec;
    }
    u32x4 o;
    o[0] = pk2(av[0], av[1]); o[1] = pk2(av[2], av[3]); o[2] = pk2(av[4], av[5]); o[3] = pk2(av[6], av[7]); *(u32x4*)(s_A + ptok * 72 + pcs) = o;
    o[0] = pk2(bm[0], bm[1]); o[1] = pk2(bm[2], bm[3]); o[2] = pk2(bm[4], bm[5]); o[3] = pk2(bm[6], bm[7]); *(u32x4*)(s_Bm + ptok * 72 + pcs) = o;
#pragma unroll
    for (int e = 0; e < 4; ++e) { s_BmT[(pcs + 2 * e) * XLD + ptok] = (bf16_t)(o[e] & 0xffff); s_BmT[(pcs + 2 * e + 1) * XLD + ptok] = (bf16_t)(o[e] >> 16); }
    o[0] = pk2(kp[0], kp[1]); o[1] = pk2(kp[2], kp[3]); o[2] = pk2(kp[4], kp[5]); o[3] = pk2(kp[6], kp[7]); *(u32x4*)(s_Kp + ptok * 72 + pcs) = o;
#pragma unroll
    for (int e = 0; e < 4; ++e) { s_KpT[(pcs + 2 * e) * XLD + ptok] = (bf16_t)(o[e] & 0xffff); s_KpT[(pcs + 2 * e + 1) * XLD + ptok] = (bf16_t)(o[e] >> 16); }
    o[0] = pk2(rr[0], rr[1]); o[1] = pk2(rr[2], rr[3]); o[2] = pk2(rr[4], rr[5]); o[3] = pk2(rr[6], rr[7]); *(u32x4*)(s_R + ptok * 72 + pcs) = o;
    o[0] = pk2(v_[0], v_[1]); o[1] = pk2(v_[2], v_[3]); o[2] = pk2(v_[4], v_[5]); o[3] = pk2(v_[6], v_[7]);
#pragma unroll
    for (int e = 0; e < 4; ++e) { s_VmT[(pcs + 2 * e) * XLD + ptok] = (bf16_t)(o[e] & 0xffff); s_VmT[(pcs + 2 * e + 1) * XLD + ptok] = (bf16_t)(o[e] >> 16); }
    u32x4 ob;
    ob[0] = pk2(lb[pcs + 0] + bon * v_[0], lb[pcs + 1] + bon * v_[1]); ob[1] = pk2(lb[pcs + 2] + bon * v_[2], lb[pcs + 3] + bon * v_[3]);
    ob[2] = pk2(lb[pcs + 4] + bon * v_[4], lb[pcs + 5] + bon * v_[5]); ob[3] = pk2(lb[pcs + 6] + bon * v_[6], lb[pcs + 7] + bon * v_[7]);
    *(u32x4*)(p.cBA + ((size_t)item * 32 + ptok) * 64 + pcs) = ob;
  }
  __syncthreads();
  {
    const bf16_t* X = (wave < 2) ? s_A : s_R;
    const bf16_t* Y = (wave == 0 || wave == 3) ? s_Bm : s_Kp;
    const bool strict = wave < 2;
#pragma unroll
    for (int ti = 0; ti < 2; ++ti)
#pragma unroll
      for (int ii = 0; ii < 2; ++ii) {
        f32x4 d = (f32x4){0.f, 0.f, 0.f, 0.f};
        if (ii <= ti) d = mm16(X + ti * 16 * 72, 72, Y + ii * 16 * 72, 72, 2, d, l15, quad);
        const int i = ii * 16 + l15;
#pragma unroll
        for (int e = 0; e < 4; ++e) {
          const int t = ti * 16 + quad * 4 + e;
          const bool keep = strict ? (i < t) : (i <= t);
          const float val = keep ? d[e] : 0.f;
          if (wave == 0) s_labT[i * 36 + t] = val;
          else { bf16_t* dst = (wave == 1 ? s_Lak : wave == 2 ? s_Mrk : s_Mrb); dst[t * XLD + i] = (bf16_t)(pk2(val, 0.f) & 0xffff); }
        }
      }
  }
  const u32x4 acap = *(const u32x4*)(s_A + ptok * 72 + pcs);
  __syncthreads();
  {
    float* d = s_rhs + ptok * 128 + pcs;
    *(f32x4*)d = (f32x4){bf_lo(acap[0]), bf_hi(acap[0]), bf_lo(acap[1]), bf_hi(acap[1])};
    *(f32x4*)(d + 4) = (f32x4){bf_lo(acap[2]), bf_hi(acap[2]), bf_lo(acap[3]), bf_hi(acap[3])};
  }
  {
    const int ti = wave & 1;
#pragma unroll
    for (int vv = 0; vv < 2; ++vv) {
      const int vi = (wave >> 1) * 2 + vv;
      f32x4 d = (f32x4){0.f, 0.f, 0.f, 0.f};
      d = mm16(s_Lak + ti * 16 * XLD, XLD, s_VmT + vi * 16 * XLD, XLD, 1, d, l15, quad);
#pragma unroll
      for (int e = 0; e < 4; ++e) s_rhs[(ti * 16 + quad * 4 + e) * 128 + 64 + vi * 16 + l15] = d[e];
    }
  }
  __syncthreads();
  if (tid < 128) {
    float x[32];
#pragma unroll
    for (int t = 0; t < 32; ++t) x[t] = s_rhs[t * 128 + tid];
#pragma unroll
    for (int i = 0; i < 31; ++i) {
      const float xi = x[i];
#pragma unroll
      for (int t4 = ((i + 1) >> 2); t4 < 8; ++t4) {
        const f32x4 lv = *(const f32x4*)(s_labT + i * 36 + t4 * 4);
#pragma unroll
        for (int e = 0; e < 4; ++e) { const int t = t4 * 4 + e; if (t > i) x[t] -= lv[e] * xi; }
      }
    }
#pragma unroll
    for (int q4 = 0; q4 < 4; ++q4) {
      u32x4 o; o[0] = pk2(x[8 * q4], x[8 * q4 + 1]); o[1] = pk2(x[8 * q4 + 2], x[8 * q4 + 3]); o[2] = pk2(x[8 * q4 + 4], x[8 * q4 + 5]); o[3] = pk2(x[8 * q4 + 6], x[8 * q4 + 7]);
      *(u32x4*)(s_XT + tid * XLD + q4 * 8) = o;
    }
  }
  __syncthreads();
  {
    const f32x4 z4 = (f32x4){0.f, 0.f, 0.f, 0.f};
    bf16_t* gPT = p.cPT + (size_t)item * 4096;
    const float wl_c = s_wl[wave * 16 + l15];
#pragma unroll
    for (int k1t = 0; k1t < 4; ++k1t) {
      f32x4 d = mm16(s_XT + k1t * 16 * XLD, XLD, s_BmT + wave * 16 * XLD, XLD, 1, z4, l15, quad);
      const int k2 = wave * 16 + l15, k1 = k1t * 16 + quad * 4;
      float o[4];
#pragma unroll
      for (int e = 0; e < 4; ++e) o[e] = ((k1 + e == k2 ? 1.f : 0.f) - d[e]) * wl_c;
      u32x2 ov; ov[0] = pk2(o[0], o[1]); ov[1] = pk2(o[2], o[3]);
      *(u32x2*)(gPT + k2 * 64 + k1) = ov;
    }
    bf16_t* gG = p.cG + (size_t)item * 4096;
#pragma unroll
    for (int k2t = 0; k2t < 4; ++k2t) {
      const f32x4 d1 = mm16(s_KpT + k2t * 16 * XLD, XLD, s_VmT + wave * 16 * XLD, XLD, 1, z4, l15, quad);
      const f32x4 d2 = mm16(s_BmT + k2t * 16 * XLD, XLD, s_XT + (64 + wave * 16) * XLD, XLD, 1, z4, l15, quad);
      const int k2 = k2t * 16 + quad * 4, v = wave * 16 + l15;
      const f32x4 wv = *(const f32x4*)(s_wl + k2);
      u32x2 ov; ov[0] = pk2((d1[0] - d2[0]) * wv[0], (d1[1] - d2[1]) * wv[1]); ov[1] = pk2((d1[2] - d2[2]) * wv[2], (d1[3] - d2[3]) * wv[3]);
      *(u32x2*)(gG + v * 64 + k2) = ov;
    }
    bf16_t* gRT = p.cRT + (size_t)item * 2048;
    bf16_t* gOI = p.cOI + (size_t)item * 2048;
#pragma unroll
    for (int ti = 0; ti < 2; ++ti) {
      const f32x4 d = mm16(s_XT + wave * 16 * XLD, XLD, s_Mrb + ti * 16 * XLD, XLD, 1, z4, l15, quad);
      const int t = ti * 16 + l15, k = wave * 16 + quad * 4;
      const u32x2 rv = *(const u32x2*)(s_R + t * 72 + k);
      u32x2 ov; ov[0] = pk2(bf_lo(rv[0]) - d[0], bf_hi(rv[0]) - d[1]); ov[1] = pk2(bf_lo(rv[1]) - d[2], bf_hi(rv[1]) - d[3]);
      *(u32x2*)(gRT + t * 64 + k) = ov;
      const f32x4 e1 = mm16(s_VmT + wave * 16 * XLD, XLD, s_Mrk + ti * 16 * XLD, XLD, 1, z4, l15, quad);
      const f32x4 e2 = mm16(s_XT + (64 + wave * 16) * XLD, XLD, s_Mrb + ti * 16 * XLD, XLD, 1, z4, l15, quad);
      u32x2 oo; oo[0] = pk2(e1[0] - e2[0], e1[1] - e2[1]); oo[1] = pk2(e1[2] - e2[2], e1[3] - e2[3]);
      *(u32x2*)(gOI + t * 64 + k) = oo;
    }
  }
  __syncthreads();
}

DI void rec_item(const Params& p, int l, int item, char* lds) {
  const int tid = tid_(), wave = __builtin_amdgcn_readfirstlane(tid >> 6), lane = tid & 63, l15 = lane & 15, quad = lane >> 4;
  const bool isp = item < 32;
  const int bh = isp ? item : item - 32; const int b = bh >> 3, h = bh & 7;
  const int nch = isp ? 128 : 2; const int cid0 = isp ? bh * 128 : NCH_P + bh * 2;
  bf16_t* Sb = (bf16_t*)lds;
  const unsigned lbase = (unsigned)(size_t)(LASP char*)lds;
  __syncthreads();
  if (wave < 2) {
    f32x4 acc[2][4];
#pragma unroll
    for (int v2 = 0; v2 < 2; ++v2) {
      const int v = (wave * 2 + v2) * 16 + l15;
      if (isp) {
#pragma unroll
        for (int nk = 0; nk < 4; ++nk) acc[v2][nk] = (f32x4){0.f, 0.f, 0.f, 0.f};
      } else {
        const float* sp = p.swkv + (((size_t)(l * 8 + b) * 8 + h) * 64 + v) * 64;
#pragma unroll
        for (int nk = 0; nk < 4; ++nk) acc[v2][nk] = *(const f32x4*)(sp + nk * 16 + quad * 4);
      }
#pragma unroll
      for (int nk = 0; nk < 4; ++nk) {
        u32x2 o; o[0] = pk2(acc[v2][nk][0], acc[v2][nk][1]); o[1] = pk2(acc[v2][nk][2], acc[v2][nk][3]);
        *(u32x2*)(Sb + v * 72 + nk * 16 + quad * 4) = o;
        *(u32x2*)(p.gS + (size_t)cid0 * 4096 + v * 64 + nk * 16 + quad * 4) = o;
      }
    }
    const int nmain = nch - 2;
    struct PS { bf16x8 pt[4][2]; u32x2 gv[2][4]; };
    auto ldp = [&](PS& s, int c) {
      const int cc = c < nch ? c : nch - 1;
      const size_t cid = (size_t)(cid0 + cc);
      const bf16_t* gPT = p.cPT + cid * 4096; const bf16_t* gG = p.cG + cid * 4096;
#pragma unroll
      for (int nk = 0; nk < 4; ++nk) {
#pragma unroll
        for (int ks = 0; ks < 2; ++ks) s.pt[nk][ks] = *(const bf16x8*)(gPT + (nk * 16 + l15) * 64 + ks * 32 + quad * 8);
#pragma unroll
        for (int v2 = 0; v2 < 2; ++v2) s.gv[v2][nk] = *(const u32x2*)(gG + ((wave * 2 + v2) * 16 + l15) * 64 + nk * 16 + quad * 4);
      }
    };
    auto step = [&](PS& s, int c) {
      const int buf = c & 1;
      bf16x8 sf[2][2];
      {
        const unsigned sad = lbase + (unsigned)(((buf * 64 + wave * 32 + l15) * 72 + quad * 8) * 2);
        asm volatile("ds_read_b128 %0, %4\n\tds_read_b128 %1, %4 offset:64\n\tds_read_b128 %2, %4 offset:2304\n\tds_read_b128 %3, %4 offset:2368\n\ts_waitcnt lgkmcnt(0)"
                     : "=&v"(sf[0][0]), "=&v"(sf[0][1]), "=&v"(sf[1][0]), "=&v"(sf[1][1]) : "v"(sad) : "memory");
      }
#pragma unroll
      for (int v2 = 0; v2 < 2; ++v2) {
#pragma unroll
        for (int nk = 0; nk < 4; ++nk) {
          f32x4 a = (f32x4){bf_lo(s.gv[v2][nk][0]), bf_hi(s.gv[v2][nk][0]), bf_lo(s.gv[v2][nk][1]), bf_hi(s.gv[v2][nk][1])};
#pragma unroll
          for (int ks = 0; ks < 2; ++ks) a = __builtin_amdgcn_mfma_f32_16x16x32_bf16(s.pt[nk][ks], sf[v2][ks], a, 0, 0, 0);
          acc[v2][nk] = a;
        }
      }
      ldp(s, c + 3);
      const size_t scid = (c + 1 < nch) ? (size_t)(cid0 + c + 1) : (size_t)NCH;
#pragma unroll
      for (int v2 = 0; v2 < 2; ++v2) {
        const int v = (wave * 2 + v2) * 16 + l15;
#pragma unroll
        for (int nk = 0; nk < 4; ++nk) {
          u32x2 ov; ov[0] = pk2(acc[v2][nk][0], acc[v2][nk][1]); ov[1] = pk2(acc[v2][nk][2], acc[v2][nk][3]);
          *(u32x2*)(Sb + ((buf ^ 1) * 64 + v) * 72 + nk * 16 + quad * 4) = ov;
          *(u32x2*)(p.gS + scid * 4096 + v * 64 + nk * 16 + quad * 4) = ov;
        }
      }
      asm volatile("s_waitcnt lgkmcnt(0)" ::: "memory");
    };
    PS s0, s1, s2;
    ldp(s0, 0); ldp(s1, 1); ldp(s2, 2);
#pragma unroll 1
    for (int c = 0; c < nmain; c += 3) { step(s0, c); step(s1, c + 1); step(s2, c + 2); }
    step(s0, nmain); step(s1, nmain + 1);
#pragma unroll
    for (int v2 = 0; v2 < 2; ++v2) {
      const int v = (wave * 2 + v2) * 16 + l15;
      float* so = (isp ? p.out + O_WP + (((size_t)(l * 4 + b) * 8 + h) * 64 + v) * 64 : p.out + O_WS + (((size_t)(l * 8 + b) * 8 + h) * 64 + v) * 64);
#pragma unroll
      for (int nk = 0; nk < 4; ++nk) *(f32x4*)(so + nk * 16 + quad * 4) = acc[v2][nk];
    }
  }
  __syncthreads();
}
DI void phase_o(const Params& p, int l) {
  const int tid = tid_(), wave = __builtin_amdgcn_readfirstlane(tid >> 6), lane = tid & 63, l15 = lane & 15, quad = lane >> 4;
  for (int pi = blockIdx.x; pi < NCH / 2; pi += gridDim.x) {
    const int cid = pi * 2 + (wave >> 1);
    const bool isp = cid < NCH_P;
    int bh, c;
    if (isp) { bh = cid >> 7; c = cid & 127; } else { const int j = cid - NCH_P; bh = j >> 1; c = j & 1; }
    const int b = bh >> 3, h = bh & 7;
    const int tok = (wave & 1) * 16 + l15;
    const size_t row = (size_t)((isp ? b * 4096 : MP + b * 64) + c * 32 + tok);
    bf16x8 rt[2], sa[4][2]; u32x2 oi[4], ba[4], gt[4];
#pragma unroll
    for (int ks = 0; ks < 2; ++ks) rt[ks] = *(const bf16x8*)(p.cRT + (size_t)cid * 2048 + tok * 64 + ks * 32 + quad * 8);
#pragma unroll
    for (int vt = 0; vt < 4; ++vt) {
#pragma unroll
      for (int ks = 0; ks < 2; ++ks) sa[vt][ks] = *(const bf16x8*)(p.gS + (size_t)cid * 4096 + (vt * 16 + l15) * 64 + ks * 32 + quad * 8);
      oi[vt] = *(const u32x2*)(p.cOI + (size_t)cid * 2048 + tok * 64 + vt * 16 + quad * 4);
      ba[vt] = *(const u32x2*)(p.cBA + (size_t)cid * 2048 + tok * 64 + vt * 16 + quad * 4);
      gt[vt] = *(const u32x2*)(p.z + row * NZ + C_GR + h * 64 + vt * 16 + quad * 4);
    }
    f32x4 ao[4];
#pragma unroll
    for (int vt = 0; vt < 4; ++vt) {
      f32x4 a = (f32x4){bf_lo(oi[vt][0]), bf_hi(oi[vt][0]), bf_lo(oi[vt][1]), bf_hi(oi[vt][1])};
#pragma unroll
      for (int ks = 0; ks < 2; ++ks) a = __builtin_amdgcn_mfma_f32_16x16x32_bf16(sa[vt][ks], rt[ks], a, 0, 0, 0);
      ao[vt] = a;
    }
    float sm = 0.f, sq = 0.f;
#pragma unroll
    for (int vt = 0; vt < 4; ++vt)
#pragma unroll
      for (int e = 0; e < 4; ++e) { sm += ao[vt][e]; sq += ao[vt][e] * ao[vt][e]; }
    { const float a1 = __shfl_xor(sm, 16), b1 = __shfl_xor(sq, 16); sm += a1; sq += b1; }
    { const float a1 = __shfl_xor(sm, 32), b1 = __shfl_xor(sq, 32); sm += a1; sq += b1; }
    const float mean = sm * (1.0f / 64.0f);
    const float rstd = rsqrtf(fmaxf(sq * (1.0f / 64.0f) - mean * mean, 0.f) + 64e-5f);
    const float* lg = p.lnx_g + l * 512 + h * 64;
#pragma unroll
    for (int vt = 0; vt < 4; ++vt) {
      const int vv = vt * 16 + quad * 4;
      const f32x4 g4 = *(const f32x4*)(lg + vv);
      const float y0 = ((ao[vt][0] - mean) * rstd * g4[0] + bf_lo(ba[vt][0])) * bf_lo(gt[vt][0]);
      const float y1 = ((ao[vt][1] - mean) * rstd * g4[1] + bf_hi(ba[vt][0])) * bf_hi(gt[vt][0]);
      const float y2 = ((ao[vt][2] - mean) * rstd * g4[2] + bf_lo(ba[vt][1])) * bf_lo(gt[vt][1]);
      const float y3 = ((ao[vt][3] - mean) * rstd * g4[3] + bf_hi(ba[vt][1])) * bf_hi(gt[vt][1]);
      u32x2 ov; ov[0] = pk2(y0, y1); ov[1] = pk2(y2, y3);
      *(u32x2*)(p.o_r + row * 512 + h * 64 + vv) = ov;
    }
  }
}
DI void phase_chunk(const Params& p, int l, char* lds) {
  for (int it = blockIdx.x; it < NCH; it += gridDim.x) chunk_item(p, l, it, lds);
  zero_f32(p.ss1, MT);
}

constexpr int ALD = 72;
DI void attn_item(const Params& p, int l, int item, char* lds) {
  const int tid = tid_(), wave = __builtin_amdgcn_readfirstlane(tid >> 6), lane = tid & 63;
  const int m = wave & 1, qh = wave >> 1, q = lane & 31, hh = lane >> 5;
  bf16_t* Ks = (bf16_t*)lds;
  bf16_t* Vs = Ks + 2 * 64 * ALD;
  float* xb = (float*)lds;
  bool samp; int b, h, nch, qrow0, qpos0;
  const int xq = item & 7, tk = item >> 3;
  if (tk < 4) { samp = true; const int bhs = xq + 8 * tk; b = bhs >> 2; h = bhs & 3; nch = 17; qrow0 = MP + b * 64; qpos0 = 1024; }
  else { samp = false; const int kk = tk - 4; const int qc = 63 - (kk >> 1); const int bh = xq + 8 * (kk & 1); b = bh >> 2; h = bh & 3; nch = qc + 1; qrow0 = b * 4096 + qc * 64; qpos0 = qc * 64; }
  bf16x8 qf[4];
  {
    const bf16_t* qp = p.z + (size_t)(qrow0 + qh * 32 + q) * NZ + C_Q + h * 128 + m * 64;
#pragma unroll
    for (int ks = 0; ks < 4; ++ks) qf[ks] = *(const bf16x8*)(qp + ks * 16 + hh * 8);
  }
  const float slope = exp2f(-2.0f * (float)(h + 1));
  const float LOG2E = 1.4426950408889634f;
  const float c1 = 0.125f * LOG2E, sl2 = slope * LOG2E;
  const float qposf = (float)(qpos0 + qh * 32 + q);
  f32x16 O[4];
#pragma unroll
  for (int i = 0; i < 4; ++i)
#pragma unroll
    for (int e = 0; e < 16; ++e) O[i][e] = 0.f;
  float mrun = -1e30f, lrun = 0.f;
  u32x4 rk[4], rv[4];
  auto gload = [&](int j) {
    const bf16_t* kb; size_t kld; const bf16_t* vb; size_t vld;
    if (!samp) { kb = p.z + (size_t)(b * 4096 + j * 64) * NZ + C_K + h * 128; kld = NZ; vb = p.vtp + (size_t)((b * 4 + h) * 128) * 4096 + j * 64; vld = 4096; }
    else if (j < 16) { kb = p.kc + (size_t)(b * 1024 + j * 64) * 512 + h * 128; kld = 512; vb = p.vct + (size_t)((b * 4 + h) * 128) * 1024 + j * 64; vld = 1024; }
    else { kb = p.z + (size_t)(MP + b * 64) * NZ + C_K + h * 128; kld = NZ; vb = p.vts + (size_t)((b * 4 + h) * 128) * 64; vld = 64; }
#pragma unroll
    for (int i = 0; i < 4; ++i) {
      const int c = tid + 256 * i;
      const int mm = c >> 9, key = (c >> 3) & 63, d8 = (c & 7) * 8;
      rk[i] = *(const u32x4*)(kb + (size_t)key * kld + mm * 64 + d8);
      const int vd = c >> 3, k8 = (c & 7) * 8;
      rv[i] = *(const u32x4*)(vb + (size_t)vd * vld + k8);
    }
  };
  auto sstore = [&]() {
#pragma unroll
    for (int i = 0; i < 4; ++i) {
      const int c = tid + 256 * i;
      const int mm = c >> 9, key = (c >> 3) & 63, d8 = (c & 7) * 8;
      *(u32x4*)(Ks + (mm * 64 + key) * ALD + d8) = rk[i];
      const int vd = c >> 3, k8 = (c & 7) * 8;
      *(u32x4*)(Vs + vd * ALD + k8) = rv[i];
    }
  };
  gload(0); sstore(); __syncthreads();
  for (int j = 0; j < nch; ++j) {
    if (j + 1 < nch) gload(j + 1);
    f32x16 s[2];
#pragma unroll
    for (int kt = 0; kt < 2; ++kt) {
#pragma unroll
      for (int e = 0; e < 16; ++e) s[kt][e] = 0.f;
#pragma unroll
      for (int ks = 0; ks < 4; ++ks) {
        const bf16x8 kf = *(const bf16x8*)(Ks + (m * 64 + kt * 32 + q) * ALD + ks * 16 + hh * 8);
        s[kt] = __builtin_amdgcn_mfma_f32_32x32x16_bf16(kf, qf[ks], s[kt], 0, 0, 0);
      }
    }
    float mx = -1e30f;
    const float dbase = qposf - (float)(j * 64 + 4 * hh);
#pragma unroll
    for (int kt = 0; kt < 2; ++kt)
#pragma unroll
      for (int e = 0; e < 16; ++e) {
        const float dd = dbase - (float)(kt * 32 + (e & 3) + 8 * (e >> 2));
        const float v = s[kt][e] * c1 - sl2 * fabsf(dd);
        s[kt][e] = v; mx = fmaxf(mx, v);
      }
    mx = fmaxf(mx, __shfl_xor(mx, 32));
    const float mnew = fmaxf(mrun, mx);
    const float alpha = __builtin_amdgcn_exp2f(mrun - mnew);
    const bool resc = mnew > mrun;
    mrun = mnew;
    float ps = 0.f;
#pragma unroll
    for (int kt = 0; kt < 2; ++kt)
#pragma unroll
      for (int e = 0; e < 16; ++e) { const float pe = __builtin_amdgcn_exp2f(s[kt][e] - mnew); s[kt][e] = pe; ps += pe; }
    lrun = lrun * alpha + ps;
    if (__any(resc)) {
#pragma unroll
      for (int i = 0; i < 4; ++i)
#pragma unroll
        for (int e = 0; e < 16; ++e) O[i][e] *= alpha;
    }
#pragma unroll
    for (int kt = 0; kt < 2; ++kt)
#pragma unroll
      for (int sx = 0; sx < 2; ++sx) {
        u32x4 pb;
        pb[0] = pk2(s[kt][8 * sx + 0], s[kt][8 * sx + 1]); pb[1] = pk2(s[kt][8 * sx + 2], s[kt][8 * sx + 3]);
        pb[2] = pk2(s[kt][8 * sx + 4], s[kt][8 * sx + 5]); pb[3] = pk2(s[kt][8 * sx + 6], s[kt][8 * sx + 7]);
        const bf16x8 pf = __builtin_bit_cast(bf16x8, pb);
#pragma unroll
        for (int vt = 0; vt < 4; ++vt) {
          const bf16_t* vp = Vs + (vt * 32 + q) * ALD + kt * 32 + 16 * sx + 4 * hh;
          const s16x4 lo = *(const s16x4*)vp, hi = *(const s16x4*)(vp + 8);
          const bf16x8 vf = __builtin_shufflevector(lo, hi, 0, 1, 2, 3, 4, 5, 6, 7);
          O[vt] = __builtin_amdgcn_mfma_f32_32x32x16_bf16(vf, pf, O[vt], 0, 0, 0);
        }
      }
    __syncthreads();
    if (j + 1 < nch) sstore();
    __syncthreads();
  }
  const float ltot = lrun + __shfl_xor(lrun, 32);
  const float inv = 1.0f / ltot;
#pragma unroll
  for (int i = 0; i < 4; ++i)
#pragma unroll
    for (int e = 0; e < 16; ++e) O[i][e] *= inv;
  if (m == 1) {
#pragma unroll
    for (int vt = 0; vt < 4; ++vt)
#pragma unroll
      for (int e = 0; e < 16; ++e) { const int vd = vt * 32 + (e & 3) + 8 * (e >> 2) + 4 * hh; xb[(qh * 128 + vd) * 32 + q] = O[vt][e]; }
  }
  __syncthreads();
  if (m == 0) {
    float d1 = 0.f, d2 = 0.f;
    for (int i = 0; i < 64; ++i) { d1 += p.lq1[l * 64 + i] * p.lk1[l * 64 + i]; d2 += p.lq2[l * 64 + i] * p.lk2[l * 64 + i]; }
    const float lam_init = 0.8f - 0.6f * __expf(-0.3f * (float)l);
    const float lam = __expf(d1) - __expf(d2) + lam_init;
    float ss = 0.f;
#pragma unroll
    for (int vt = 0; vt < 4; ++vt)
#pragma unroll
      for (int e = 0; e < 16; ++e) {
        const int vd = vt * 32 + (e & 3) + 8 * (e >> 2) + 4 * hh;
        const float o2 = xb[(qh * 128 + vd) * 32 + q];
        const float o = O[vt][e] - lam * o2; O[vt][e] = o; ss += o * o;
      }
    ss += __shfl_xor(ss, 32);
    const float rstd = rsqrtf(ss * (1.0f / 128.0f) + 1e-5f) * (1.0f - lam_init);
    const size_t row = (size_t)(qrow0 + qh * 32 + q);
    const float* sg = p.subln_g + l * 128;
#pragma unroll
    for (int vt = 0; vt < 4; ++vt)
#pragma unroll
      for (int e4 = 0; e4 < 4; ++e4) {
        const int vd = vt * 32 + 8 * e4 + 4 * hh;
        const u32x2 gu = *(const u32x2*)(p.z + row * NZ + C_GA + h * 128 + vd);
        const f32x4 gv = *(const f32x4*)(sg + vd);
        const float y0 = O[vt][4 * e4 + 0] * rstd * gv[0] * bf_lo(gu[0]);
        const float y1 = O[vt][4 * e4 + 1] * rstd * gv[1] * bf_hi(gu[0]);
        const float y2 = O[vt][4 * e4 + 2] * rstd * gv[2] * bf_lo(gu[1]);
        const float y3 = O[vt][4 * e4 + 3] * rstd * gv[3] * bf_hi(gu[1]);
        u32x2 ov; ov[0] = pk2(y0, y1); ov[1] = pk2(y2, y3);
        *(u32x2*)(p.o_a + row * 512 + h * 128 + vd) = ov;
      }
  }
  __syncthreads();
}

DI void phase_mix(const Params& p, int l, char* lds) {
  __shared__ int s_next;
  if (blockIdx.x < 96) rec_item(p, l, blockIdx.x, lds);
  unsigned* ctr = p.bar + XCD_BAR_WORDS + 64 * l + (blockIdx.x & 7);
  for (;;) {
    __syncthreads();
    if (threadIdx.x == 0) { const int k = (int)atomicAdd(ctr, 1u); s_next = k < 132 ? k * 8 + (int)(blockIdx.x & 7) : 1 << 20; }
    __syncthreads();
    const int it = s_next;
    if (it >= (1 << 20)) break;
    attn_item(p, l, it, lds);
  }
}

template <bool A_F32>
DI void mini_gemm(f32x4 (&acc)[2][2], const void* Ap, int lda, const bf16_t* Bp, int ldb, int K, int wave, int l15, int quad) {
  const int kw = K >> 2, k0 = wave * kw;
#pragma unroll 2
  for (int ks = 0; ks < kw; ks += 32) {
    bf16x8 a[2], b[2];
#pragma unroll
    for (int mi = 0; mi < 2; ++mi) {
      if (A_F32) {
        const float* ap = (const float*)Ap + (size_t)(mi * 16 + l15) * lda + k0 + ks + quad * 8;
        const f32x4 v0 = *(const f32x4*)ap, v1 = *(const f32x4*)(ap + 4);
        u32x4 t; t[0] = pk2(v0[0], v0[1]); t[1] = pk2(v0[2], v0[3]); t[2] = pk2(v1[0], v1[1]); t[3] = pk2(v1[2], v1[3]);
        a[mi] = __builtin_bit_cast(bf16x8, t);
      } else {
        a[mi] = *(const bf16x8*)((const bf16_t*)Ap + (size_t)(mi * 16 + l15) * lda + k0 + ks + quad * 8);
      }
      b[mi] = *(const bf16x8*)(Bp + (size_t)(mi * 16 + l15) * ldb + k0 + ks + quad * 8);
    }
#pragma unroll
    for (int mi = 0; mi < 2; ++mi)
#pragma unroll
      for (int ni = 0; ni < 2; ++ni) acc[mi][ni] = __builtin_amdgcn_mfma_f32_16x16x32_bf16(b[ni], a[mi], acc[mi][ni], 0, 0, 0);
  }
}
DI f32x4 mini_reduce(const f32x4 (&acc)[2][2], char* lds, int wave, int lane) {
  float* red = (float*)lds;
  __syncthreads();
#pragma unroll
  for (int i = 0; i < 2; ++i)
#pragma unroll
    for (int j = 0; j < 2; ++j)
#pragma unroll
      for (int e = 0; e < 4; ++e) red[((wave * 4 + i * 2 + j) * 4 + e) * 64 + lane] = acc[i][j][e];
  __syncthreads();
  f32x4 r;
#pragma unroll
  for (int e = 0; e < 4; ++e) r[e] = (red[((0 * 4 + wave) * 4 + e) * 64 + lane] + red[((1 * 4 + wave) * 4 + e) * 64 + lane]) + (red[((2 * 4 + wave) * 4 + e) * 64 + lane] + red[((3 * 4 + wave) * 4 + e) * 64 + lane]);
  return r;
}
DI void zero_mini(f32x4 (&acc)[2][2]) {
#pragma unroll
  for (int i = 0; i < 2; ++i)
#pragma unroll
    for (int j = 0; j < 2; ++j) acc[i][j] = (f32x4){0.f, 0.f, 0.f, 0.f};
}
DI void mini_merge(const Params& p, int l, int t, char* lds) {
  const int tid = tid_(), wave = __builtin_amdgcn_readfirstlane(tid >> 6), lane = tid & 63, l15 = lane & 15, quad = lane >> 4;
  const int R0 = MP + (t >> 5) * 32, C0 = (t & 31) * 32;
  f32x4 acc[2][2]; zero_mini(acc);
  mini_gemm<false>(acc, p.o_r + (size_t)R0 * 512, 512, p.wt_brr + (size_t)C0 * 512, 512, 512, wave, l15, quad);
  const f32x4 v1 = mini_reduce(acc, lds, wave, lane);
  zero_mini(acc);
  mini_gemm<false>(acc, p.o_a + (size_t)R0 * 512, 512, p.wt_bra + (size_t)C0 * 512, 512, 512, wave, l15, quad);
  const f32x4 v2 = mini_reduce(acc, lds, wave, lane);
  const int R = R0 + (wave >> 1) * 16 + l15, c = C0 + (wave & 1) * 16 + quad * 4;
  const u32x2 g1 = *(const u32x2*)(p.z + (size_t)R * NZ + C_MR + c), g2 = *(const u32x2*)(p.z + (size_t)R * NZ + C_MA + c);
  u32x2 o;
  o[0] = pk2(bf_lo(g1[0]) * v1[0] + bf_lo(g2[0]) * v2[0], bf_hi(g1[0]) * v1[1] + bf_hi(g2[0]) * v2[1]);
  o[1] = pk2(bf_lo(g1[1]) * v1[2] + bf_lo(g2[1]) * v2[2], bf_hi(g1[1]) * v1[3] + bf_hi(g2[1]) * v2[3]);
  *(u32x2*)(p.hn + (size_t)R * DM + c) = o;
}
DI void mini_out(const Params& p, int l, int t, char* lds) {
  const int tid = tid_(), wave = __builtin_amdgcn_readfirstlane(tid >> 6), lane = tid & 63, l15 = lane & 15, quad = lane >> 4;
  const int R0 = MP + (t >> 5) * 32, C0 = (t & 31) * 32;
  f32x4 acc[2][2]; zero_mini(acc);
  mini_gemm<false>(acc, p.hn + (size_t)R0 * DM, DM, p.wt_out + (size_t)C0 * DM, DM, DM, wave, l15, quad);
  const f32x4 v = mini_reduce(acc, lds, wave, lane);
  const int R = R0 + (wave >> 1) * 16 + l15, c = C0 + (wave & 1) * 16 + quad * 4;
  const f32x4 xv = *(const f32x4*)(x_row(p, l, R) + c);
  const f32x4 x1 = xv + v;
  *(f32x4*)(p.out + (size_t)R * DM + c) = x1;
  const f32x4 gv = *(const f32x4*)(p.ple_norm_g + l * DM + c);
  u32x2 o; o[0] = pk2(x1[0] * gv[0], x1[1] * gv[1]); o[1] = pk2(x1[2] * gv[2], x1[3] * gv[3]);
  *(u32x2*)(p.o_r + (size_t)R * DM + c) = o;
  float sq = x1[0] * x1[0] + x1[1] * x1[1] + x1[2] * x1[2] + x1[3] * x1[3];
  sq += __shfl_xor(sq, 16); sq += __shfl_xor(sq, 32);
  if (quad == 0) atomicAdd(p.ss2 + R, sq);
}
DI void mini_ple(const Params& p, int l, int t, char* lds) {
  const int tid = tid_(), wave = __builtin_amdgcn_readfirstlane(tid >> 6), lane = tid & 63, l15 = lane & 15, quad = lane >> 4;
  const int R0 = MP + (t >> 5) * 32, C0 = (t & 31) * 32;
  f32x4 acc[2][2]; zero_mini(acc);
  mini_gemm<false>(acc, p.o_r + (size_t)R0 * DM, DM, p.wt_gate + (size_t)C0 * DM, DM, DM, wave, l15, quad);
  const f32x4 g = mini_reduce(acc, lds, wave, lane);
  zero_mini(acc);
  mini_gemm<true>(acc, p.ps + ((size_t)l * MS + (R0 - MP)) * 256, 256, p.wt_ple + (size_t)C0 * 256, 256, 256, wave, l15, quad);
  const f32x4 e = mini_reduce(acc, lds, wave, lane);
  const int R = R0 + (wave >> 1) * 16 + l15, c = C0 + (wave & 1) * 16 + quad * 4;
  const float rs = rsqrtf(p.ss2[R] * (1.0f / 1024.0f) + 1e-6f);
  float* xo = p.out + (size_t)R * DM + c;
  const f32x4 xv = *(const f32x4*)xo;
  f32x4 o;
#pragma unroll
  for (int k = 0; k < 4; ++k) o[k] = xv[k] + e[k] * bf1((bf16_t)(pk2(sigmoidf_(g[k] * rs), 0.f) & 0xffff));
  *(f32x4*)xo = o;
  if (l + 1 < NL) {
    const f32x4 gn = *(const f32x4*)(p.norm_g + (l + 1) * DM + c);
    u32x2 hv; hv[0] = pk2(o[0] * gn[0], o[1] * gn[1]); hv[1] = pk2(o[2] * gn[2], o[3] * gn[3]);
    *(u32x2*)(p.hn + (size_t)R * DM + c) = hv;
    float sq = o[0] * o[0] + o[1] * o[1] + o[2] * o[2] + o[3] * o[3];
    sq += __shfl_xor(sq, 16); sq += __shfl_xor(sq, 32);
    if (quad == 0) atomicAdd(p.ss1 + R, sq);
  }
}
DI void phase_merge(const Params& p, int l, char* lds) {
  const int tid = tid_(), wave = __builtin_amdgcn_readfirstlane(tid >> 6), lane = tid & 63;
  const int wm = wave >> 1, wn = wave & 1, l15 = lane & 15, quad = lane >> 4;
  for (int r = 0;; ++r) {
    const int g = xcd_tile(r, 128 * 8); if (g < 0) break;
    int mt, nt; tile_decode(g, 128, 8, mt, nt);
    f32x4 a1[4][4]; zero_acc(a1);
    gemm_dma(a1, p.o_r + (size_t)mt * 128 * 512, 512, p.wt_brr + (size_t)nt * 128 * 512, 512, 512, lds);
    u32x2 pk[4][4];
#pragma unroll
    for (int mi = 0; mi < 4; ++mi) {
      const int R = mt * 128 + wm * 64 + mi * 16 + l15;
#pragma unroll
      for (int ni = 0; ni < 4; ++ni) {
        const int c = nt * 128 + wn * 64 + ni * 16 + quad * 4;
        const u32x2 g1 = *(const u32x2*)(p.z + (size_t)R * NZ + C_MR + c);
        const f32x4 v1 = a1[mi][ni];
        pk[mi][ni][0] = pk2(bf_lo(g1[0]) * v1[0], bf_hi(g1[0]) * v1[1]);
        pk[mi][ni][1] = pk2(bf_lo(g1[1]) * v1[2], bf_hi(g1[1]) * v1[3]);
      }
    }
    zero_acc(a1);
    gemm_dma(a1, p.o_a + (size_t)mt * 128 * 512, 512, p.wt_bra + (size_t)nt * 128 * 512, 512, 512, lds);
#pragma unroll
    for (int mi = 0; mi < 4; ++mi) {
      const int R = mt * 128 + wm * 64 + mi * 16 + l15;
#pragma unroll
      for (int ni = 0; ni < 4; ++ni) {
        const int c = nt * 128 + wn * 64 + ni * 16 + quad * 4;
        const u32x2 g2 = *(const u32x2*)(p.z + (size_t)R * NZ + C_MA + c);
        const f32x4 v2 = a1[mi][ni]; const u32x2 u1 = pk[mi][ni];
        u32x2 o;
        o[0] = pk2(bf_lo(u1[0]) + bf_lo(g2[0]) * v2[0], bf_hi(u1[0]) + bf_hi(g2[0]) * v2[1]);
        o[1] = pk2(bf_lo(u1[1]) + bf_lo(g2[1]) * v2[2], bf_hi(u1[1]) + bf_hi(g2[1]) * v2[3]);
        *(u32x2*)(p.hn + (size_t)R * DM + c) = o;
      }
    }
  }
  for (int t = blockIdx.x; t < 512; t += gridDim.x) mini_merge(p, l, t, lds);
}
DI void phase_out(const Params& p, int l, char* lds) {
  const int tid = tid_(), wave = __builtin_amdgcn_readfirstlane(tid >> 6), lane = tid & 63;
  const int wm = wave >> 1, wn = wave & 1, l15 = lane & 15, quad = lane >> 4;
  for (int r = 0;; ++r) {
    const int g = xcd_tile(r, 128 * 8); if (g < 0) break;
    int mt, nt; tile_decode(g, 128, 8, mt, nt);
    f32x4 acc[4][4]; zero_acc(acc);
    gemm_dma(acc, p.hn + (size_t)mt * 128 * DM, DM, p.wt_out + (size_t)nt * 128 * DM, DM, DM, lds);
#pragma unroll
    for (int mi = 0; mi < 4; ++mi) {
      const int R = mt * 128 + wm * 64 + mi * 16 + l15;
      const float* xr = x_row(p, l, R);
      const float* g2 = p.ple_norm_g + l * DM;
      bf16_t* xb = p.o_r + (size_t)R * DM;
      float sq = 0.f;
#pragma unroll
      for (int ni = 0; ni < 4; ++ni) {
        const int c = nt * 128 + wn * 64 + ni * 16 + quad * 4;
        const f32x4 xv = *(const f32x4*)(xr + c);
        const f32x4 x1 = xv + acc[mi][ni];
        *(f32x4*)(p.out + (size_t)R * DM + c) = x1;
        const f32x4 gv = *(const f32x4*)(g2 + c);
        u32x2 o; o[0] = pk2(x1[0] * gv[0], x1[1] * gv[1]); o[1] = pk2(x1[2] * gv[2], x1[3] * gv[3]);
        *(u32x2*)(xb + c) = o;
        sq += x1[0] * x1[0] + x1[1] * x1[1] + x1[2] * x1[2] + x1[3] * x1[3];
      }
      sq += __shfl_xor(sq, 16); sq += __shfl_xor(sq, 32);
      if (quad == 0) atomicAdd(p.ss2 + R, sq);
    }
  }
  for (int t = blockIdx.x; t < 512; t += gridDim.x) mini_out(p, l, t, lds);
}
DI void phase_ple(const Params& p, int l, char* lds) {
  const int tid = tid_(), wave = __builtin_amdgcn_readfirstlane(tid >> 6), lane = tid & 63;
  const int wm = wave >> 1, wn = wave & 1, l15 = lane & 15, quad = lane >> 4;
  for (int r = 0;; ++r) {
    const int g = xcd_tile(r, 128 * 8); if (g < 0) break;
    int mt, nt; tile_decode(g, 128, 8, mt, nt);
    f32x4 a1[4][4]; zero_acc(a1);
    gemm_dma(a1, p.o_r + (size_t)mt * 128 * DM, DM, p.wt_gate + (size_t)nt * 128 * DM, DM, DM, lds);
    u32x2 pk[4][4];
#pragma unroll
    for (int mi = 0; mi < 4; ++mi) {
      const float rs = rsqrtf(p.ss2[mt * 128 + wm * 64 + mi * 16 + l15] * (1.0f / 1024.0f) + 1e-6f);
#pragma unroll
      for (int ni = 0; ni < 4; ++ni) { const f32x4 v = a1[mi][ni] * rs; pk[mi][ni][0] = pk2(sigmoidf_(v[0]), sigmoidf_(v[1])); pk[mi][ni][1] = pk2(sigmoidf_(v[2]), sigmoidf_(v[3])); }
    }
    zero_acc(a1);
    const int r0 = mt * 128;
    const float* pa = r0 < MP ? p.pp + ((size_t)l * MP + r0) * 256 : p.ps + ((size_t)l * MS + (r0 - MP)) * 256;
    gemm_core<true>(a1, pa, 256, p.wt_ple + (size_t)nt * 128 * 256, 256, 256, lds);
#pragma unroll
    for (int mi = 0; mi < 4; ++mi) {
      const int R = mt * 128 + wm * 64 + mi * 16 + l15;
      float sq = 0.f;
#pragma unroll
      for (int ni = 0; ni < 4; ++ni) {
        const int c = nt * 128 + wn * 64 + ni * 16 + quad * 4;
        float* xo = p.out + (size_t)R * DM + c;
        const f32x4 xv = *(const f32x4*)xo; const f32x4 e = a1[mi][ni]; const u32x2 g = pk[mi][ni];
        f32x4 o;
        o[0] = xv[0] + e[0] * bf_lo(g[0]); o[1] = xv[1] + e[1] * bf_hi(g[0]);
        o[2] = xv[2] + e[2] * bf_lo(g[1]); o[3] = xv[3] + e[3] * bf_hi(g[1]);
        *(f32x4*)xo = o;
        if (l + 1 < NL) {
          const f32x4 gn = *(const f32x4*)(p.norm_g + (l + 1) * DM + c);
          u32x2 hv; hv[0] = pk2(o[0] * gn[0], o[1] * gn[1]); hv[1] = pk2(o[2] * gn[2], o[3] * gn[3]);
          *(u32x2*)(p.hn + (size_t)R * DM + c) = hv;
          sq += o[0] * o[0] + o[1] * o[1] + o[2] * o[2] + o[3] * o[3];
        }
      }
      if (l + 1 < NL) {
        sq += __shfl_xor(sq, 16); sq += __shfl_xor(sq, 32);
        if (quad == 0) atomicAdd(p.ss1 + R, sq);
      }
    }
  }
  for (int t = blockIdx.x; t < 512; t += gridDim.x) mini_ple(p, l, t, lds);
  if (l + 1 < NL) {
    for (int it = blockIdx.x; it < 2080 + 16 + 2048; it += gridDim.x) {
      if (it < 2080) wconv_tile(p, l + 1, it, (float*)lds);
      else if (it < 2096) wconv_tile(p, l + 1, 2400 + (it - 2080), (float*)lds);
      else cache_item(p, l + 1, it - 2096, lds);
    }
  }
}


#define XB_TMO      128
#define XB_XCNT(j)  (256  + 64 * (j))
#define XB_XSUB(j)  (1280 + 64 * (j))
#define XB_XGEN(j)  (2304 + 64 * (j))
#define XB_TOP      3328
#define XB_TOPGEN   3392
#define XB_SPIN_CAP (1u << 18)
#define LAS __attribute__((address_space(3)))
DI unsigned xb_ld(unsigned* p)              { return __hip_atomic_load(p, __ATOMIC_RELAXED, __HIP_MEMORY_SCOPE_AGENT); }
DI unsigned xb_add(unsigned* p, unsigned v) { return __hip_atomic_fetch_add(p, v, __ATOMIC_RELAXED, __HIP_MEMORY_SCOPE_AGENT); }
DI unsigned xb_xcc_id() { return (unsigned)__builtin_amdgcn_s_getreg((3 << 11) | 20) & 0xFu; }
#define XB_SPIN(cond, bar) do { unsigned _sp = 0; while (cond) { __builtin_amdgcn_s_sleep(1); \
    if ((++_sp & 255u) == 0u) { if (xb_ld(&(bar)[XB_TMO])) break; if (_sp > XB_SPIN_CAP) { atomicAdd(&(bar)[XB_TMO], 1u); break; } } } } while (0)
struct XcdBarrier { unsigned* bar; unsigned x; volatile LAS unsigned* st; };
DI XcdBarrier xcd_barrier_post(unsigned* bar, volatile LAS unsigned* st) {
  XcdBarrier b; b.bar = bar; b.x = xb_xcc_id(); b.st = st;
  if (threadIdx.x == 0) (void)xb_add(&bar[XB_XCNT(b.x)], 1u);
  return b;
}
DI void xcd_barrier_complete(unsigned* bar, unsigned x, unsigned& nloc, unsigned& nx) {
  const unsigned G = gridDim.x * gridDim.y * gridDim.z;
  unsigned sum, cnt, mine, sp = 0u;
  for (;;) {
    sum = 0u; cnt = 0u; mine = 0u;
#pragma unroll
    for (unsigned j = 0; j < 16; ++j) { const unsigned c = xb_ld(&bar[XB_XCNT(j)]); sum += c; cnt += (c > 0u) ? 1u : 0u; mine = (j == x) ? c : mine; }
    if (sum == G) break;
    __builtin_amdgcn_s_sleep(1);
    if ((++sp & 255u) == 0u) { if (xb_ld(&bar[XB_TMO])) break; if (sp > XB_SPIN_CAP) { atomicAdd(&bar[XB_TMO], 1u); break; } }
  }
  nloc = mine > 0u ? mine : 1u; nx = cnt > 0u ? cnt : 1u;
}
DI void xcd_barrier(const XcdBarrier& b) {
  asm volatile("s_waitcnt vmcnt(0)" ::: "memory");
  __syncthreads();
  if (threadIdx.x == 0) {
    unsigned* bar = b.bar;
    __builtin_amdgcn_s_waitcnt(0);
    unsigned nloc = b.st[0], nx = b.st[1];
    if (nloc == 0u) { xcd_barrier_complete(bar, b.x, nloc, nx); b.st[0] = nloc; b.st[1] = nx; }
    const unsigned old = xb_add(&bar[XB_XSUB(b.x)], 1u);
    const unsigned gen = old / nloc;
    if (old + 1u == (gen + 1u) * nloc) {
      __builtin_amdgcn_fence(__ATOMIC_RELEASE, "agent");
      asm volatile("s_waitcnt vmcnt(0)" ::: "memory");
      const unsigned og = xb_add(&bar[XB_TOP], 1u);
      const unsigned tg = og / nx;
      if (og + 1u == (tg + 1u) * nx) xb_add(&bar[XB_TOPGEN], 1u);
      else XB_SPIN(xb_ld(&bar[XB_TOPGEN]) == tg, bar);
      __builtin_amdgcn_fence(__ATOMIC_ACQUIRE, "agent");
      xb_add(&bar[XB_XGEN(b.x)], 1u);
      asm volatile("s_waitcnt vmcnt(0)" ::: "memory");
    } else {
      XB_SPIN(xb_ld(&bar[XB_XGEN(b.x)]) == gen, bar);
      __builtin_amdgcn_fence(__ATOMIC_ACQUIRE, "agent");
      asm volatile("s_waitcnt vmcnt(0)" ::: "memory");
    }
  }
  __syncthreads();
}
constexpr int LDS_BYTES = 73728;
DI void run_phase(const Params& p, int ph, int l, char* lds) {
  switch (ph) {
    case 1: phase_norm0(p, lds); break;
    case 2: phase_gemm_in(p, l, lds); break;
    case 3: phase_mix(p, l, lds); break;
    case 4: phase_merge(p, l, lds); break;
    case 5: phase_out(p, l, lds); break;
    case 6: break;
    case 7: phase_ple(p, l, lds); break;
    case 8: phase_chunk(p, l, lds); break;
  }
}

#if MEGA
__global__ void __launch_bounds__(256, 2) k_mega(Params p) {
  __shared__ __attribute__((aligned(16))) char lds[LDS_BYTES];
  __shared__ uint4 xb_words;
  cg::grid_group grid = cg::this_grid();
  if (threadIdx.x == 0) xb_words = make_uint4(0u, 0u, 0u, 0u);
  __syncthreads();
  const XcdBarrier xb = xcd_barrier_post(p.bar, (volatile LAS unsigned*)&xb_words);
  phase_norm0(p, lds);
  grid.sync();
#pragma unroll 1
  for (int l = 0; l < NL; ++l) {
    phase_gemm_in(p, l, lds); xcd_barrier(xb);
    phase_chunk(p, l, lds); xcd_barrier(xb);
    phase_mix(p, l, lds); xcd_barrier(xb);
    phase_o(p, l); xcd_barrier(xb);
    phase_merge(p, l, lds); xcd_barrier(xb);
    phase_out(p, l, lds); xcd_barrier(xb);
    phase_ple(p, l, lds); if (l + 1 < NL) xcd_barrier(xb);
  }
}
#else
template <int PH>
__global__ void __launch_bounds__(256, 2) k_phase(Params p, int l) {
  __shared__ __attribute__((aligned(16))) char lds[LDS_BYTES];
  run_phase(p, PH, l, lds);
}
#endif

extern "C" void kernel_launch(void* const* d_in, const int* in_sizes, int n_in, void* d_out, int out_size, void* d_ws, size_t ws_size,
                              hipStream_t stream) {
  Params p{};
  const float** pf = (const float**)&p;
  for (int i = 0; i < 33; ++i) pf[i] = (const float*)d_in[i];
  p.out = (float*)d_out;
  char* w = (char*)d_ws; size_t off = 0;
  auto take = [&](size_t bytes) { char* r = w + off; off += (bytes + 255) & ~(size_t)255; return (bf16_t*)r; };
  p.gS = take((size_t)(NCH + 1) * 4096 * 2);
  p.ss1 = (float*)take((size_t)MT * 4); p.ss2 = (float*)take((size_t)MT * 4);
  p.bar = (unsigned*)take((size_t)(XCD_BAR_WORDS + 64 * NL) * 4);
  p.wt_in = take((size_t)NZ * 1024 * 2);
  p.wt_brr = take((size_t)1024 * 512 * 2);
  p.wt_bra = take((size_t)1024 * 512 * 2);
  p.wt_out = take((size_t)1024 * 1024 * 2);
  p.wt_ple = take((size_t)1024 * 256 * 2);
  p.wt_gate = take((size_t)1024 * 1024 * 2);
  p.w2t = take((size_t)512 * 64 * 2);
  p.a2t = take((size_t)512 * 64 * 2);
  p.z = take((size_t)MT * NZ * 2);
  p.vtp = take((size_t)16 * 128 * 4096 * 2);
  p.vts = take((size_t)32 * 128 * 64 * 2);
  p.kc = take((size_t)8 * 1024 * 512 * 2);
  p.vct = take((size_t)32 * 128 * 1024 * 2);
  p.o_r = take((size_t)MT * 512 * 2);
  p.o_a = take((size_t)MT * 512 * 2);
  p.hn = take((size_t)MT * DM * 2);
  p.cPT = p.hn;
  p.cG = take((size_t)NCH * 4096 * 2);
  p.cRT = take((size_t)NCH * 2048 * 2);
  p.cOI = take((size_t)NCH * 2048 * 2);
  p.cBA = take((size_t)NCH * 2048 * 2);
  if (off > ws_size) { fprintf(stderr, "workspace too small: need %zu have %zu\n", off, ws_size); return; }
#if MEGA
  hipMemsetAsync(p.bar, 0, (size_t)(XCD_BAR_WORDS + 64 * NL) * 4, stream);
  static int grid_blocks = 0;
  if (!grid_blocks) {
    int dev = 0, cus = 0, per_cu = 0;
    hipGetDevice(&dev);
    hipDeviceGetAttribute(&cus, hipDeviceAttributeMultiprocessorCount, dev);
    hipOccupancyMaxActiveBlocksPerMultiprocessor(&per_cu, k_mega, 256, 0);
    if (per_cu > 2) per_cu = 2;
    grid_blocks = cus * per_cu;
  }
  void* args[] = {&p};
  hipError_t e = hipLaunchCooperativeKernel((void*)k_mega, dim3(grid_blocks), dim3(256), args, 0, stream);
  if (e != hipSuccess) fprintf(stderr, "cooperative launch failed: %s (grid %d)\n", hipGetErrorString(e), grid_blocks);
#else
  const int G = 512;
  for (int l = 0; l < NL; ++l) {
    k_phase<1><<<G, 256, 0, stream>>>(p, l);
    k_phase<2><<<G, 256, 0, stream>>>(p, l);
    k_phase<8><<<G, 256, 0, stream>>>(p, l);
    k_phase<3><<<G, 256, 0, stream>>>(p, l);
    k_phase<4><<<G, 256, 0, stream>>>(p, l);
    k_phase<5><<<G, 256, 0, stream>>>(p, l);
    k_phase<6><<<G, 256, 0, stream>>>(p, l);
    k_phase<7><<<G, 256, 0, stream>>>(p, l);
  }
#endif
}
```

```cpp
#include <hip/hip_runtime.h>
#include <hip/hip_cooperative_groups.h>
#include <stdint.h>
#include <stdio.h>
namespace cg = cooperative_groups;

#ifndef MEGA
#define MEGA 1
#endif

typedef unsigned short bf16_t;
typedef short bf16x8 __attribute__((ext_vector_type(8)));
typedef short s16x4 __attribute__((ext_vector_type(4)));
typedef float f32x4 __attribute__((ext_vector_type(4)));
typedef float f32x2 __attribute__((ext_vector_type(2)));
typedef float f32x16 __attribute__((ext_vector_type(16)));
typedef unsigned u32x4 __attribute__((ext_vector_type(4)));
typedef unsigned u32x2 __attribute__((ext_vector_type(2)));
typedef __bf16 bfv2 __attribute__((ext_vector_type(2)));

#define DI __device__ __forceinline__
#define XCD_BAR_WORDS 3456
DI int tid_() { int t = threadIdx.x; asm volatile("" : "+v"(t)); return t; }

constexpr int DM = 1024, MP = 16384, MS = 512, MT = 16896, NZ = 6272, NL = 4;
constexpr int C_GR = 1664, C_Q = 2176, C_K = 2688, C_V = 3200, C_GA = 3712, C_MR = 4224, C_MA = 5248;
constexpr int SHC = 1664;
constexpr size_t O_YP = 0, O_YS = 16777216, O_KP = 17301504, O_VP = 50855936, O_WP = 84410368, O_SP = 84934656,
                 O_KS = 84961280, O_VS = 86009856, O_WS = 87058432, O_SS = 88107008;

struct Params {
  const float *xp, *xs, *pp, *ps, *ck, *cv, *swkv, *sshift;
  const float *norm_g, *w_in, *shift_mu, *decay_w0, *decay_w2, *iclr_a0, *iclr_a2, *k_k, *k_a, *r_k, *lnx_g, *lnx_b,
      *qng, *kng, *lq1, *lk1, *lq2, *lk2, *subln_g, *w_br_r, *w_br_a, *w_out, *ple_w, *ple_gate_w, *ple_norm_g;
  float* out;
  bf16_t *wt_in, *wt_brr, *wt_bra, *wt_out, *wt_ple, *wt_gate, *w2t, *a2t;
  bf16_t *hn, *z, *vtp, *vts, *kc, *vct, *o_r, *o_a;
  bf16_t *cPT, *cG, *cRT, *cOI, *cBA;
  unsigned* bar;
  float *ss1, *ss2;
  bf16_t* gS;
};

DI unsigned pk2(float a, float b) { f32x2 v = {a, b}; bfv2 r = __builtin_convertvector(v, bfv2); return __builtin_bit_cast(unsigned, r); }
DI float bf_lo(unsigned u) { return __uint_as_float(u << 16); }
DI float bf_hi(unsigned u) { return __uint_as_float(u & 0xffff0000u); }
DI float bf1(bf16_t u) { return __uint_as_float(((unsigned)u) << 16); }
DI float sigmoidf_(float x) { return __builtin_amdgcn_rcpf(1.0f + __expf(-x)); }
DI float siluf_(float x) { return x * __builtin_amdgcn_rcpf(1.0f + __expf(-x)); }

DI void tr_tile(const float* __restrict__ src, int ld_src, bf16_t* __restrict__ dst, int ld_dst, float* sm) {
  const int tid = tid_();
  const int r = tid >> 4, c4 = (tid & 15) * 4;
#pragma unroll
  for (int i = 0; i < 4; ++i) {
    const int row = r + 16 * i;
    f32x4 v = *(const f32x4*)(src + (size_t)row * ld_src + c4);
    sm[row * 65 + c4 + 0] = v[0]; sm[row * 65 + c4 + 1] = v[1]; sm[row * 65 + c4 + 2] = v[2]; sm[row * 65 + c4 + 3] = v[3];
  }
  __syncthreads();
  const int n = tid >> 2, ks = (tid & 3) * 16;
  u32x4 o0, o1;
  o0[0] = pk2(sm[(ks + 0) * 65 + n], sm[(ks + 1) * 65 + n]);   o0[1] = pk2(sm[(ks + 2) * 65 + n], sm[(ks + 3) * 65 + n]);
  o0[2] = pk2(sm[(ks + 4) * 65 + n], sm[(ks + 5) * 65 + n]);   o0[3] = pk2(sm[(ks + 6) * 65 + n], sm[(ks + 7) * 65 + n]);
  o1[0] = pk2(sm[(ks + 8) * 65 + n], sm[(ks + 9) * 65 + n]);   o1[1] = pk2(sm[(ks + 10) * 65 + n], sm[(ks + 11) * 65 + n]);
  o1[2] = pk2(sm[(ks + 12) * 65 + n], sm[(ks + 13) * 65 + n]); o1[3] = pk2(sm[(ks + 14) * 65 + n], sm[(ks + 15) * 65 + n]);
  *(u32x4*)(dst + (size_t)n * ld_dst + ks) = o0;
  *(u32x4*)(dst + (size_t)n * ld_dst + ks + 8) = o1;
  __syncthreads();
}

constexpr int WCONV_TILES = 1568 + 128 + 128 + 256 + 64 + 256 + 8 + 8;
DI void wconv_tile(const Params& p, int l, int t, float* sm) {
  const float* src; bf16_t* dst; int K, N;
  if (t < 1568) { src = p.w_in + (size_t)l * 1024 * NZ; dst = p.wt_in; K = 1024; N = NZ; }
  else if ((t -= 1568) < 128) { src = p.w_br_r + (size_t)l * 512 * 1024; dst = p.wt_brr; K = 512; N = 1024; }
  else if ((t -= 128) < 128) { src = p.w_br_a + (size_t)l * 512 * 1024; dst = p.wt_bra; K = 512; N = 1024; }
  else if ((t -= 128) < 256) { src = p.w_out + (size_t)l * 1024 * 1024; dst = p.wt_out; K = 1024; N = 1024; }
  else if ((t -= 256) < 64) { src = p.ple_w + (size_t)l * 256 * 1024; dst = p.wt_ple; K = 256; N = 1024; }
  else if ((t -= 64) < 256) { src = p.ple_gate_w + (size_t)l * 1024 * 1024; dst = p.wt_gate; K = 1024; N = 1024; }
  else if ((t -= 256) < 8) { src = p.decay_w2 + (size_t)l * 64 * 512; dst = p.w2t; K = 64; N = 512; }
  else { t -= 8; src = p.iclr_a2 + (size_t)l * 64 * 512; dst = p.a2t; K = 64; N = 512; }
  const int ntn = N / 64; const int tk = t / ntn, tn = t % ntn;
  tr_tile(src + (size_t)(tk * 64) * N + tn * 64, N, dst + (size_t)(tn * 64) * K + tk * 64, K, sm);
}

DI const float* x_row(const Params& p, int l, int r) {
  if (l == 0) return r < MP ? p.xp + (size_t)r * DM : p.xs + (size_t)(r - MP) * DM;
  return p.out + (size_t)r * DM;
}
DI void cache_item(const Params& p, int l, int c, char* lds) {
  const int tid = tid_();
  if (c < 1024) {
    const float* src = p.ck + (size_t)l * 8 * 1024 * 512 + (size_t)c * 4096 + tid * 16;
    bf16_t* dst = p.kc + (size_t)c * 4096 + tid * 16;
    f32x4 a0 = *(const f32x4*)(src), a1 = *(const f32x4*)(src + 4), a2 = *(const f32x4*)(src + 8), a3 = *(const f32x4*)(src + 12);
    u32x4 o0, o1;
    o0[0] = pk2(a0[0], a0[1]); o0[1] = pk2(a0[2], a0[3]); o0[2] = pk2(a1[0], a1[1]); o0[3] = pk2(a1[2], a1[3]);
    o1[0] = pk2(a2[0], a2[1]); o1[1] = pk2(a2[2], a2[3]); o1[2] = pk2(a3[0], a3[1]); o1[3] = pk2(a3[2], a3[3]);
    *(u32x4*)dst = o0; *(u32x4*)(dst + 8) = o1;
  } else {
    c -= 1024;
    const int bh = c >> 5, tt = c & 31; const int b = bh >> 2, h = bh & 3; const int tk = tt >> 1, tn = tt & 1;
    const float* src = p.cv + (size_t)l * 8 * 1024 * 512 + ((size_t)(b * 1024 + tk * 64)) * 512 + h * 128 + tn * 64;
    bf16_t* dst = p.vct + ((size_t)(bh * 128 + tn * 64)) * 1024 + tk * 64;
    tr_tile(src, 512, dst, 1024, (float*)lds);
  }
}
DI void phase_norm0(const Params& p, char* lds) {
  const int tid = tid_(), wave = __builtin_amdgcn_readfirstlane(tid >> 6), lane = tid & 63;
  const float* g = p.norm_g;
  const int n_norm = MT / 8;
  const int n_items = n_norm + 2048 + WCONV_TILES;
  for (int it = blockIdx.x; it < n_items; it += gridDim.x) {
    if (it < n_norm) {
      const int r0 = it * 8 + wave * 2;
      f32x4 v[2][4]; float ss[2] = {0.f, 0.f};
#pragma unroll
      for (int k = 0; k < 2; ++k) {
        const float* x = x_row(p, 0, r0 + k);
#pragma unroll
        for (int i = 0; i < 4; ++i) v[k][i] = *(const f32x4*)(x + lane * 4 + 256 * i);
      }
      f32x4 gv[4];
#pragma unroll
      for (int i = 0; i < 4; ++i) gv[i] = *(const f32x4*)(g + lane * 4 + 256 * i);
#pragma unroll
      for (int k = 0; k < 2; ++k) {
#pragma unroll
        for (int i = 0; i < 4; ++i) ss[k] += v[k][i][0] * v[k][i][0] + v[k][i][1] * v[k][i][1] + v[k][i][2] * v[k][i][2] + v[k][i][3] * v[k][i][3];
#pragma unroll
        for (int o = 32; o >= 1; o >>= 1) ss[k] += __shfl_xor(ss[k], o);
        const float rstd = rsqrtf(ss[k] * (1.0f / 1024.0f) + 1e-6f);
#pragma unroll
        for (int i = 0; i < 4; ++i) {
          u32x2 o; o[0] = pk2(v[k][i][0] * rstd * gv[i][0], v[k][i][1] * rstd * gv[i][1]); o[1] = pk2(v[k][i][2] * rstd * gv[i][2], v[k][i][3] * rstd * gv[i][3]);
          *(u32x2*)(p.hn + (size_t)(r0 + k) * DM + lane * 4 + 256 * i) = o;
        }
        if (lane == 0) p.ss1[r0 + k] = 1024.0f * (1.0f - 1e-6f);
      }
    } else if (it < n_norm + 2048) {
      cache_item(p, 0, it - n_norm, lds);
    } else {
      wconv_tile(p, 0, it - n_norm - 2048, (float*)lds);
    }
  }
}
DI void zero_f32(float* a, int n) {
  for (int i = blockIdx.x * 256 + (int)threadIdx.x; i < n; i += gridDim.x * 256) a[i] = 0.f;
}

constexpr int GLD = 72;
template <bool A_F32>
DI void gemm_core(f32x4 (&acc)[4][4], const void* Ap, int lda, const bf16_t* Bp, int ldb, int K, char* lds) {
  bf16_t* As = (bf16_t*)lds;
  bf16_t* Bs = (bf16_t*)(lds + 2 * 128 * GLD * 2);
  const int tid = tid_(), wave = __builtin_amdgcn_readfirstlane(tid >> 6), lane = tid & 63;
  const int wm = wave >> 1, wn = wave & 1, l15 = lane & 15, quad = lane >> 4;
  const int nk = K / 64;
  u32x4 ra[4], rb[4];
  auto gload = [&](int kt) {
#pragma unroll
    for (int i = 0; i < 4; ++i) {
      const int c = tid + 256 * i; const int row = c >> 3, c8 = (c & 7) * 8;
      if (!A_F32) ra[i] = *(const u32x4*)((const bf16_t*)Ap + (size_t)row * lda + kt * 64 + c8);
      rb[i] = *(const u32x4*)(Bp + (size_t)row * ldb + kt * 64 + c8);
    }
  };
  auto sstore = [&](int buf, int kt) {
#pragma unroll
    for (int i = 0; i < 4; ++i) {
      const int c = tid + 256 * i; const int row = c >> 3, c8 = (c & 7) * 8;
      if (A_F32) {
        const float* a = (const float*)Ap + (size_t)row * lda + kt * 64 + c8;
        const f32x4 v0 = *(const f32x4*)a, v1 = *(const f32x4*)(a + 4);
        u32x4 t; t[0] = pk2(v0[0], v0[1]); t[1] = pk2(v0[2], v0[3]); t[2] = pk2(v1[0], v1[1]); t[3] = pk2(v1[2], v1[3]);
        *(u32x4*)(As + (buf * 128 + row) * GLD + c8) = t;
      } else {
        *(u32x4*)(As + (buf * 128 + row) * GLD + c8) = ra[i];
      }
      *(u32x4*)(Bs + (buf * 128 + row) * GLD + c8) = rb[i];
    }
  };
  gload(0); sstore(0, 0); __syncthreads();
  for (int kt = 0; kt < nk; ++kt) {
    const int buf = kt & 1;
    if (kt + 1 < nk) gload(kt + 1);
#pragma unroll
    for (int ks = 0; ks < 2; ++ks) {
      bf16x8 af[4], bfr[4];
#pragma unroll
      for (int i = 0; i < 4; ++i) {
        af[i] = *(const bf16x8*)(As + (buf * 128 + wm * 64 + i * 16 + l15) * GLD + ks * 32 + quad * 8);
        bfr[i] = *(const bf16x8*)(Bs + (buf * 128 + wn * 64 + i * 16 + l15) * GLD + ks * 32 + quad * 8);
      }
#pragma unroll
      for (int mi = 0; mi < 4; ++mi)
#pragma unroll
        for (int ni = 0; ni < 4; ++ni) acc[mi][ni] = __builtin_amdgcn_mfma_f32_16x16x32_bf16(bfr[ni], af[mi], acc[mi][ni], 0, 0, 0);
    }
    if (kt + 1 < nk) sstore(buf ^ 1, kt + 1);
    __syncthreads();
  }
}
#define LASP __attribute__((address_space(3)))
DI void gemm_dma(f32x4 (&acc)[4][4], const bf16_t* Ap, int lda, const bf16_t* Bp, int ldb, int K, char* lds) {
  const int tid = tid_(), wave = __builtin_amdgcn_readfirstlane(tid >> 6), lane = tid & 63;
  const int wm = wave >> 1, wn = wave & 1, l15 = lane & 15, quad = lane >> 4;
  const int nk = K / 64;
  const int lrow = lane >> 3, lpc = lane & 7;
  const bf16_t* ga[4]; const bf16_t* gb[4];
#pragma unroll
  for (int i = 0; i < 4; ++i) {
    const int row = (wave * 4 + i) * 8 + lrow; const int q = lpc ^ (row & 7);
    ga[i] = Ap + (size_t)row * lda + q * 8; gb[i] = Bp + (size_t)row * ldb + q * 8;
  }
  auto issue = [&](int kt) {
    char* sb = lds + (kt & 1) * 32768 + wave * 4096;
#pragma unroll
    for (int i = 0; i < 4; ++i) {
      __builtin_amdgcn_global_load_lds((const unsigned*)(ga[i] + kt * 64), (LASP unsigned*)(sb + i * 1024), 16, 0, 0);
      __builtin_amdgcn_global_load_lds((const unsigned*)(gb[i] + kt * 64), (LASP unsigned*)(sb + 16384 + i * 1024), 16, 0, 0);
    }
  };
  const int sw = l15 & 7;
  const unsigned lbase = (unsigned)(size_t)(LASP char*)lds;
  const unsigned a0 = (unsigned)((wm * 64 + l15) * 128 + ((quad ^ sw) * 16)), a1 = (unsigned)((wm * 64 + l15) * 128 + (((4 + quad) ^ sw) * 16));
  const unsigned b0 = 16384u + (unsigned)((wn * 64 + l15) * 128 + ((quad ^ sw) * 16)), b1 = 16384u + (unsigned)((wn * 64 + l15) * 128 + (((4 + quad) ^ sw) * 16));
  asm volatile("s_waitcnt vmcnt(0)" ::: "memory");
  __builtin_amdgcn_s_barrier();
  asm volatile("" ::: "memory");
  issue(0);
  for (int kt = 0; kt < nk; ++kt) {
    asm volatile("s_waitcnt vmcnt(0)" ::: "memory");
    __builtin_amdgcn_s_barrier();
    asm volatile("" ::: "memory");
    if (kt + 1 < nk) issue(kt + 1);
    const unsigned sa = lbase + (unsigned)((kt & 1) * 32768);
    bf16x8 af[4], bfr[4], ag[4], bg[4];
    asm volatile("ds_read_b128 %0, %8\n\tds_read_b128 %1, %8 offset:2048\n\tds_read_b128 %2, %8 offset:4096\n\tds_read_b128 %3, %8 offset:6144\n\t"
                 "ds_read_b128 %4, %9\n\tds_read_b128 %5, %9 offset:2048\n\tds_read_b128 %6, %9 offset:4096\n\tds_read_b128 %7, %9 offset:6144"
                 : "=&v"(af[0]), "=&v"(af[1]), "=&v"(af[2]), "=&v"(af[3]), "=&v"(bfr[0]), "=&v"(bfr[1]), "=&v"(bfr[2]), "=&v"(bfr[3])
                 : "v"(sa + a0), "v"(sa + b0) : "memory");
    asm volatile("ds_read_b128 %0, %16\n\tds_read_b128 %1, %16 offset:2048\n\tds_read_b128 %2, %16 offset:4096\n\tds_read_b128 %3, %16 offset:6144\n\t"
                 "ds_read_b128 %4, %17\n\tds_read_b128 %5, %17 offset:2048\n\tds_read_b128 %6, %17 offset:4096\n\tds_read_b128 %7, %17 offset:6144\n\t"
                 "s_waitcnt lgkmcnt(8)"
                 : "=&v"(ag[0]), "=&v"(ag[1]), "=&v"(ag[2]), "=&v"(ag[3]), "=&v"(bg[0]), "=&v"(bg[1]), "=&v"(bg[2]), "=&v"(bg[3]),
                   "+v"(af[0]), "+v"(af[1]), "+v"(af[2]), "+v"(af[3]), "+v"(bfr[0]), "+v"(bfr[1]), "+v"(bfr[2]), "+v"(bfr[3])
                 : "v"(sa + a1), "v"(sa + b1) : "memory");
#pragma unroll
    for (int mi = 0; mi < 4; ++mi)
#pragma unroll
      for (int ni = 0; ni < 4; ++ni) acc[mi][ni] = __builtin_amdgcn_mfma_f32_16x16x32_bf16(bfr[ni], af[mi], acc[mi][ni], 0, 0, 0);
    asm volatile("s_waitcnt lgkmcnt(0)" : "+v"(ag[0]), "+v"(ag[1]), "+v"(ag[2]), "+v"(ag[3]), "+v"(bg[0]), "+v"(bg[1]), "+v"(bg[2]), "+v"(bg[3]) :: "memory");
#pragma unroll
    for (int mi = 0; mi < 4; ++mi)
#pragma unroll
      for (int ni = 0; ni < 4; ++ni) acc[mi][ni] = __builtin_amdgcn_mfma_f32_16x16x32_bf16(bg[ni], ag[mi], acc[mi][ni], 0, 0, 0);
  }
  asm volatile("" ::: "memory");
  __builtin_amdgcn_s_barrier();
  asm volatile("" ::: "memory");
}
DI void zero_acc(f32x4 (&acc)[4][4]) {
#pragma unroll
  for (int i = 0; i < 4; ++i)
#pragma unroll
    for (int j = 0; j < 4; ++j) acc[i][j] = (f32x4){0.f, 0.f, 0.f, 0.f};
}

DI int xcd_tile(int r, int T) {
  const int x = blockIdx.x & 7, j = blockIdx.x >> 3, nb = gridDim.x >> 3;
  if (j >= nb) return -1;
  const int start = (int)(((long)x * T) / 8), end = (int)(((long)(x + 1) * T) / 8);
  const int g = start + r * nb + j;
  return g < end ? g : -1;
}
DI void tile_decode(int g, int nM, int nN, int& mt, int& nt) {
  const int per = 8 * nN; const int grp = g / per, idx = g - grp * per; const int gm0 = grp * 8;
  const int gsz = (nM - gm0) < 8 ? (nM - gm0) : 8;
  nt = idx / gsz; mt = gm0 + (idx - nt * gsz);
}
DI void phase_gemm_in(const Params& p, int l, char* lds) {
  const int tid = tid_(), wave = __builtin_amdgcn_readfirstlane(tid >> 6), lane = tid & 63;
  const int wm = wave >> 1, wn = wave & 1, l15 = lane & 15, quad = lane >> 4;
  const bf16_t* Wt = p.wt_in;
  const int NTN = 49, NTM = 132;
  for (int r = 0;; ++r) {
    const int g = xcd_tile(r, NTN * NTM); if (g < 0) break;
    int mt, nt; tile_decode(g, NTM, NTN, mt, nt);
    f32x4 acc[4][4]; zero_acc(acc);
    gemm_dma(acc, p.hn + (size_t)mt * 128 * DM, DM, Wt + (size_t)nt * 128 * DM, DM, DM, lds);
    const int colb = nt * 128 + wn * 64 + quad * 4;
    {
#pragma unroll
      for (int mi = 0; mi < 4; ++mi) {
        const float rs = rsqrtf(p.ss1[mt * 128 + wm * 64 + mi * 16 + l15] * (1.0f / 1024.0f) + 1e-6f);
#pragma unroll
        for (int ni = 0; ni < 4; ++ni) acc[mi][ni] = acc[mi][ni] * rs;
      }
    }
    int kind;
    if (nt < 13) kind = 0; else if (nt < 17) kind = 1; else if (nt < 21) kind = 2; else if (nt < 25) kind = 3; else if (nt < 29) kind = 4; else if (nt < 33) kind = 1; else kind = 5;
#pragma unroll
    for (int mi = 0; mi < 4; ++mi) {
      const int R = mt * 128 + wm * 64 + mi * 16 + l15;
      const bool isp = R < MP; const int rs = R - MP;
      bf16_t* zrow = p.z + (size_t)R * NZ;
      if (kind == 0) {
        const bool last = isp ? ((R & 4095) == 4095) : ((rs & 63) == 63);
        float* so = isp ? p.out + O_SP + (size_t)(l * 4 + (R >> 12)) * SHC : p.out + O_SS + (size_t)(l * 8 + (rs >> 6)) * SHC;
#pragma unroll
        for (int ni = 0; ni < 4; ++ni) {
          const int c = colb + ni * 16; const f32x4 v = acc[mi][ni];
          u32x2 o; o[0] = pk2(v[0], v[1]); o[1] = pk2(v[2], v[3]); *(u32x2*)(zrow + c) = o;
          if (last) *(f32x4*)(so + c) = v;
        }
      } else if (kind == 1 || kind == 5) {
#pragma unroll
        for (int ni = 0; ni < 4; ++ni) {
          const int c = colb + ni * 16; f32x4 v = acc[mi][ni];
#pragma unroll
          for (int e = 0; e < 4; ++e) v[e] = (kind == 1) ? siluf_(v[e]) : sigmoidf_(v[e]);
          u32x2 o; o[0] = pk2(v[0], v[1]); o[1] = pk2(v[2], v[3]); *(u32x2*)(zrow + c) = o;
        }
      } else if (kind == 2 || kind == 3) {
        float ss = 0.f;
#pragma unroll
        for (int ni = 0; ni < 4; ++ni) { const f32x4 v = acc[mi][ni]; ss += v[0] * v[0] + v[1] * v[1] + v[2] * v[2] + v[3] * v[3]; }
        ss += __shfl_xor(ss, 16); ss += __shfl_xor(ss, 32);
        const float rstd = rsqrtf(ss * (1.0f / 64.0f) + 1e-6f);
        const float* g = (kind == 2 ? p.qng : p.kng) + l * 64;
        float* ko = isp ? p.out + O_KP + ((size_t)l * MP + R) * 512 : p.out + O_KS + ((size_t)l * MS + rs) * 512;
#pragma unroll
        for (int ni = 0; ni < 4; ++ni) {
          const int c = colb + ni * 16; const int d = ni * 16 + quad * 4;
          const f32x4 gv = *(const f32x4*)(g + d); f32x4 v = acc[mi][ni];
#pragma unroll
          for (int e = 0; e < 4; ++e) v[e] = v[e] * rstd * gv[e];
          u32x2 o; o[0] = pk2(v[0], v[1]); o[1] = pk2(v[2], v[3]); *(u32x2*)(zrow + c) = o;
          if (kind == 3) *(f32x4*)(ko + (c - C_K)) = v;
        }
      } else {
        float* vo = isp ? p.out + O_VP + ((size_t)l * MP + R) * 512 : p.out + O_VS + ((size_t)l * MS + rs) * 512;
#pragma unroll
        for (int ni = 0; ni < 4; ++ni) {
          const int cv = colb + ni * 16 - C_V; const f32x4 v = acc[mi][ni];
          *(f32x4*)(vo + cv) = v;
          const int h = cv >> 7, vd = cv & 127;
          if (isp) {
            bf16_t* vt = p.vtp + ((size_t)(((R >> 12) * 4 + h) * 128 + vd)) * 4096 + (R & 4095);
#pragma unroll
            for (int e = 0; e < 4; ++e) vt[(size_t)e * 4096] = (bf16_t)(pk2(v[e], 0.f) & 0xffff);
          } else {
            bf16_t* vt = p.vts + ((size_t)(((rs >> 6) * 4 + h) * 128 + vd)) * 64 + (rs & 63);
#pragma unroll
            for (int e = 0; e < 4; ++e) vt[(size_t)e * 64] = (bf16_t)(pk2(v[e], 0.f) & 0xffff);
          }
        }
      }
    }
  }
  zero_f32(p.ss2, MT);
  if (l > 0) for (int it = blockIdx.x; it < 320; it += gridDim.x) wconv_tile(p, l, 2080 + it, (float*)lds);
}

constexpr int NCH_P = 4096, NCH = 4224;
constexpr int XLD = 40;
DI f32x4 mm16(const bf16_t* Xrow, int ldx, const bf16_t* Yrow, int ldy, int ksteps, f32x4 acc, int l15, int quad) {
  for (int ks = 0; ks < ksteps; ++ks) {
    const bf16x8 a = *(const bf16x8*)(Xrow + l15 * ldx + ks * 32 + quad * 8);
    const bf16x8 b = *(const bf16x8*)(Yrow + l15 * ldy + ks * 32 + quad * 8);
    acc = __builtin_amdgcn_mfma_f32_16x16x32_bf16(a, b, acc, 0, 0, 0);
  }
  return acc;
}
DI void chunk_item(const Params& p, int l, int item, char* lds) {
  const int tid = tid_(), wave = __builtin_amdgcn_readfirstlane(tid >> 6), lane = tid & 63, l15 = lane & 15, quad = lane >> 4;
  const bool isp = item < NCH_P;
  int bh, c;
  if (isp) { bh = item >> 7; c = item & 127; } else { const int j = item - NCH_P; bh = j >> 1; c = j & 1; }
  const int b = bh >> 3, h = bh & 7;
  const int t0 = c * 32; const int row0 = (isp ? b * 4096 : MP + b * 64) + t0;
  float* s_r = (float*)lds;
  float* s_kf = s_r + 2048;
  float* s_v = s_kf + 2048;
  float* s_w = s_v + 2048;
  float* s_kk = s_w + 2048;
  float* s_bb = s_kk + 2048;
  bf16_t* s_wd = (bf16_t*)(lds + 49152);
  bf16_t* s_ad = (bf16_t*)(lds + 53760);
  float* s_bonus = (float*)(lds + 58368);
  float* s_wl = (float*)(lds + 58880);
  float* s_rhs = (float*)lds;
  bf16_t* s_A = (bf16_t*)lds;
  bf16_t* s_Bm = (bf16_t*)(lds + 4608);
  bf16_t* s_Kp = (bf16_t*)(lds + 9216);
  bf16_t* s_R = (bf16_t*)(lds + 16384);
  bf16_t* s_BmT = (bf16_t*)(lds + 20992);
  bf16_t* s_KpT = (bf16_t*)(lds + 26112);
  bf16_t* s_VmT = (bf16_t*)(lds + 31232);
  bf16_t* s_Lak = (bf16_t*)(lds + 36352);
  bf16_t* s_Mrk = (bf16_t*)(lds + 38912);
  bf16_t* s_Mrb = (bf16_t*)(lds + 41472);
  float* s_labT = (float*)(lds + 44032);
  bf16_t* s_XT = (bf16_t*)(lds + 48640);

  const int mat = wave >> 1, tt = wave & 1;
  const bf16_t* wl = (mat == 0 ? p.w2t : p.a2t) + (size_t)(h * 64) * 64;
  const float* mu = p.shift_mu + l * SHC;
  const float* w0 = p.decay_w0 + l * 512 + h * 64;
  const float* a0 = p.iclr_a0 + l * 512 + h * 64;
  const float* kkp = p.k_k + l * 512 + h * 64;
  const float* kap = p.k_a + l * 512 + h * 64;
  const float* rkp = p.r_k + l * 512 + h * 64;
  const float* lb = p.lnx_b + l * 512 + h * 64;
  const int ptok = tid >> 3, pcs = (tid & 7) * 8;
  {
    const int t = t0 + ptok; const size_t row = (size_t)(row0 + ptok);
#pragma unroll
    for (int g = 0; g < 5; ++g) {
      const int zc = (g < 3 ? g * 512 + h * 64 : 1536 + (g - 3) * 64) + pcs;
      const u32x4 cu = *(const u32x4*)(p.z + row * NZ + zc);
      float cur[8], prv[8];
#pragma unroll
      for (int e = 0; e < 4; ++e) { cur[2 * e] = bf_lo(cu[e]); cur[2 * e + 1] = bf_hi(cu[e]); }
      if (t > 0) {
        const u32x4 pu = *(const u32x4*)(p.z + (row - 1) * NZ + zc);
#pragma unroll
        for (int e = 0; e < 4; ++e) { prv[2 * e] = bf_lo(pu[e]); prv[2 * e + 1] = bf_hi(pu[e]); }
      } else if (isp) {
#pragma unroll
        for (int e = 0; e < 8; ++e) prv[e] = 0.f;
      } else {
        const float* sp = p.sshift + (size_t)(l * 8 + b) * SHC + zc;
#pragma unroll
        for (int e = 0; e < 8; ++e) prv[e] = sp[e];
      }
      float zs[8];
#pragma unroll
      for (int e = 0; e < 8; ++e) zs[e] = cur[e] + (prv[e] - cur[e]) * mu[zc + e];
      if (g < 3) {
        float* d = (g == 0 ? s_r : g == 1 ? s_kf : s_v) + ptok * 64 + pcs;
        *(f32x4*)d = (f32x4){zs[0], zs[1], zs[2], zs[3]}; *(f32x4*)(d + 4) = (f32x4){zs[4], zs[5], zs[6], zs[7]};
      } else {
        if (g == 3) {
#pragma unroll
          for (int e = 0; e < 8; ++e) { const float ex = __expf(2.f * zs[e]); zs[e] = 1.f - 2.f * __builtin_amdgcn_rcpf(ex + 1.f); }
        }
        u32x4 o; o[0] = pk2(zs[0], zs[1]); o[1] = pk2(zs[2], zs[3]); o[2] = pk2(zs[4], zs[5]); o[3] = pk2(zs[6], zs[7]);
        *(u32x4*)((g == 3 ? s_wd : s_ad) + ptok * 72 + pcs) = o;
      }
    }
  }
  __syncthreads();
  {
    const bf16_t* At = (mat == 0 ? s_wd : s_ad);
    bf16x8 af[2];
#pragma unroll
    for (int ks = 0; ks < 2; ++ks) af[ks] = *(const bf16x8*)(At + (tt * 16 + l15) * 72 + ks * 32 + quad * 8);
#pragma unroll
    for (int ct = 0; ct < 4; ++ct) {
      f32x4 d = (f32x4){0.f, 0.f, 0.f, 0.f};
#pragma unroll
      for (int ks = 0; ks < 2; ++ks) {
        const bf16x8 wfr = *(const bf16x8*)(wl + (size_t)(ct * 16 + l15) * 64 + ks * 32 + quad * 8);
        d = __builtin_amdgcn_mfma_f32_16x16x32_bf16(wfr, af[ks], d, 0, 0, 0);
      }
      const int ch = ct * 16 + quad * 4; const int tok = tt * 16 + l15;
      f32x4 o;
      if (mat == 0) {
#pragma unroll
        for (int e = 0; e < 4; ++e) {
          const float y = -(w0[ch + e] + d[e]);
          const float sp = fmaxf(y, 0.f) + __logf(1.0f + __expf(-fabsf(y)));
          o[e] = -__expf(-sp - 0.5f);
        }
        *(f32x4*)(s_w + tok * 64 + ch) = o;
      } else {
#pragma unroll
        for (int e = 0; e < 4; ++e) o[e] = sigmoidf_(a0[ch + e] + d[e]);
        *(f32x4*)(s_bb + tok * 64 + ch) = o;
      }
    }
  }
  __syncthreads();
  float r_[8], kf[8], kk[8], bbv[8], v_[8], bon;
  {
    float k_[8], a_[8];
    *(f32x4*)&k_[0] = *(const f32x4*)(s_kf + ptok * 64 + pcs); *(f32x4*)&k_[4] = *(const f32x4*)(s_kf + ptok * 64 + pcs + 4);
    *(f32x4*)&a_[0] = *(const f32x4*)(s_bb + ptok * 64 + pcs); *(f32x4*)&a_[4] = *(const f32x4*)(s_bb + ptok * 64 + pcs + 4);
    *(f32x4*)&r_[0] = *(const f32x4*)(s_r + ptok * 64 + pcs); *(f32x4*)&r_[4] = *(const f32x4*)(s_r + ptok * 64 + pcs + 4);
    *(f32x4*)&v_[0] = *(const f32x4*)(s_v + ptok * 64 + pcs); *(f32x4*)&v_[4] = *(const f32x4*)(s_v + ptok * 64 + pcs + 4);
    float ss = 0.f; bon = 0.f;
#pragma unroll
    for (int e = 0; e < 8; ++e) {
      kk[e] = k_[e] * kkp[pcs + e]; ss += kk[e] * kk[e];
      kf[e] = k_[e] * (1.f + (a_[e] - 1.f) * kap[pcs + e]);
      bon += r_[e] * kf[e] * rkp[pcs + e];
    }
    ss += __shfl_xor(ss, 1); ss += __shfl_xor(ss, 2); ss += __shfl_xor(ss, 4);
    bon += __shfl_xor(bon, 1); bon += __shfl_xor(bon, 2); bon += __shfl_xor(bon, 4);
    const float inv = 1.0f / fmaxf(sqrtf(ss), 1e-12f);
#pragma unroll
    for (int e = 0; e < 8; ++e) { kk[e] *= inv; bbv[e] = kk[e] * a_[e]; }
  }
  if (tid < 64) {
    float run = 0.f;
#pragma unroll 8
    for (int t = 0; t < 32; ++t) { run += s_w[t * 64 + tid]; s_w[t * 64 + tid] = run; }
  }
  __syncthreads();
  {
    float cw[8], cwp[8];
    *(f32x4*)&cw[0] = *(const f32x4*)(s_w + ptok * 64 + pcs); *(f32x4*)&cw[4] = *(const f32x4*)(s_w + ptok * 64 + pcs + 4);
    if (ptok > 0) { *(f32x4*)&cwp[0] = *(const f32x4*)(s_w + (ptok - 1) * 64 + pcs); *(f32x4*)&cwp[4] = *(const f32x4*)(s_w + (ptok - 1) * 64 + pcs + 4); }
    else {
#pragma unroll
      for (int e = 0; e < 8; ++e) cwp[e] = 0.f;
    }
    __syncthreads();
    float av[8], bm[8], kp[8], rr[8];
#pragma unroll
    for (int e = 0; e < 8; ++e) {
      const float ec = __expf(cw[e]), en = __expf(-cw[e]), ep = __expf(cwp[e]);
      av[e] = kk[e] * ep; bm[e] = bbv[e] * en; kp[e] = kf[e] * en; rr[e] = r_[e] * ec;
      if (ptok == 31) s_wl[pcs + e] = ec;
    }
    u32x4 o;
    o[0] = pk2(av[0], av[1]); o[1] = pk2(av[2], av[3]); o[2] = pk2(av[4], av[5]); o[3] = pk2(av[6], av[7]); *(u32x4*)(s_A + ptok * 72 + pcs) = o;
    o[0] = pk2(bm[0], bm[1]); o[1] = pk2(bm[2], bm[3]); o[2] = pk2(bm[4], bm[5]); o[3] = pk2(bm[6], bm[7]); *(u32x4*)(s_Bm + ptok * 72 + pcs) = o;
#pragma unroll
    for (int e = 0; e < 4; ++e) { s_BmT[(pcs + 2 * e) * XLD + ptok] = (bf16_t)(o[e] & 0xffff); s_BmT[(pcs + 2 * e + 1) * XLD + ptok] = (bf16_t)(o[e] >> 16); }
    o[0] = pk2(kp[0], kp[1]); o[1] = pk2(kp[2], kp[3]); o[2] = pk2(kp[4], kp[5]); o[3] = pk2(kp[6], kp[7]); *(u32x4*)(s_Kp + ptok * 72 + pcs) = o;
#pragma unroll
    for (int e = 0; e < 4; ++e) { s_KpT[(pcs + 2 * e) * XLD + ptok] = (bf16_t)(o[e] & 0xffff); s_KpT[(pcs + 2 * e + 1) * XLD + ptok] = (bf16_t)(o[e] >> 16); }
    o[0] = pk2(rr[0], rr[1]); o[1] = pk2(rr[2], rr[3]); o[2] = pk2(rr[4], rr[5]); o[3] = pk2(rr[6], rr[7]); *(u32x4*)(s_R + ptok * 72 + pcs) = o;
    o[0] = pk2(v_[0], v_[1]); o[1] = pk2(v_[2], v_[3]); o[2] = pk2(v_[4], v_[5]); o[3] = pk2(v_[6], v_[7]);
#pragma unroll
    for (int e = 0; e < 4; ++e) { s_VmT[(pcs + 2 * e) * XLD + ptok] = (bf16_t)(o[e] & 0xffff); s_VmT[(pcs + 2 * e + 1) * XLD + ptok] = (bf16_t)(o[e] >> 16); }
    u32x4 ob;
    ob[0] = pk2(lb[pcs + 0] + bon * v_[0], lb[pcs + 1] + bon * v_[1]); ob[1] = pk2(lb[pcs + 2] + bon * v_[2], lb[pcs + 3] + bon * v_[3]);
    ob[2] = pk2(lb[pcs + 4] + bon * v_[4], lb[pcs + 5] + bon * v_[5]); ob[3] = pk2(lb[pcs + 6] + bon * v_[6], lb[pcs + 7] + bon * v_[7]);
    *(u32x4*)(p.cBA + ((size_t)item * 32 + ptok) * 64 + pcs) = ob;
  }
  __syncthreads();
  {
    const bf16_t* X = (wave < 2) ? s_A : s_R;
    const bf16_t* Y = (wave == 0 || wave == 3) ? s_Bm : s_Kp;
    const bool strict = wave < 2;
#pragma unroll
    for (int ti = 0; ti < 2; ++ti)
#pragma unroll
      for (int ii = 0; ii < 2; ++ii) {
        f32x4 d = (f32x4){0.f, 0.f, 0.f, 0.f};
        if (ii <= ti) d = mm16(X + ti * 16 * 72, 72, Y + ii * 16 * 72, 72, 2, d, l15, quad);
        const int i = ii * 16 + l15;
#pragma unroll
        for (int e = 0; e < 4; ++e) {
          const int t = ti * 16 + quad * 4 + e;
          const bool keep = strict ? (i < t) : (i <= t);
          const float val = keep ? d[e] : 0.f;
          if (wave == 0) s_labT[i * 36 + t] = val;
          else { bf16_t* dst = (wave == 1 ? s_Lak : wave == 2 ? s_Mrk : s_Mrb); dst[t * XLD + i] = (bf16_t)(pk2(val, 0.f) & 0xffff); }
        }
      }
  }
  const u32x4 acap = *(const u32x4*)(s_A + ptok * 72 + pcs);
  __syncthreads();
  {
    float* d = s_rhs + ptok * 128 + pcs;
    *(f32x4*)d = (f32x4){bf_lo(acap[0]), bf_hi(acap[0]), bf_lo(acap[1]), bf_hi(acap[1])};
    *(f32x4*)(d + 4) = (f32x4){bf_lo(acap[2]), bf_hi(acap[2]), bf_lo(acap[3]), bf_hi(acap[3])};
  }
  {
    const int ti = wave & 1;
#pragma unroll
    for (int vv = 0; vv < 2; ++vv) {
      const int vi = (wave >> 1) * 2 + vv;
      f32x4 d = (f32x4){0.f, 0.f, 0.f, 0.f};
      d = mm16(s_Lak + ti * 16 * XLD, XLD, s_VmT + vi * 16 * XLD, XLD, 1, d, l15, quad);
#pragma unroll
      for (int e = 0; e < 4; ++e) s_rhs[(ti * 16 + quad * 4 + e) * 128 + 64 + vi * 16 + l15] = d[e];
    }
  }
  __syncthreads();
  if (tid < 128) {
    float x[32];
#pragma unroll
    for (int t = 0; t < 32; ++t) x[t] = s_rhs[t * 128 + tid];
#pragma unroll
    for (int i = 0; i < 31; ++i) {
      const float xi = x[i];
#pragma unroll
      for (int t4 = ((i + 1) >> 2); t4 < 8; ++t4) {
        const f32x4 lv = *(const f32x4*)(s_labT + i * 36 + t4 * 4);
#pragma unroll
        for (int e = 0; e < 4; ++e) { const int t = t4 * 4 + e; if (t > i) x[t] -= lv[e] * xi; }
      }
    }
#pragma unroll
    for (int q4 = 0; q4 < 4; ++q4) {
      u32x4 o; o[0] = pk2(x[8 * q4], x[8 * q4 + 1]); o[1] = pk2(x[8 * q4 + 2], x[8 * q4 + 3]); o[2] = pk2(x[8 * q4 + 4], x[8 * q4 + 5]); o[3] = pk2(x[8 * q4 + 6], x[8 * q4 + 7]);
      *(u32x4*)(s_XT + tid * XLD + q4 * 8) = o;
    }
  }
  __syncthreads();
  {
    const f32x4 z4 = (f32x4){0.f, 0.f, 0.f, 0.f};
    bf16_t* gPT = p.cPT + (size_t)item * 4096;
    const float wl_c = s_wl[wave * 16 + l15];
#pragma unroll
    for (int k1t = 0; k1t < 4; ++k1t) {
      f32x4 d = mm16(s_XT + k1t * 16 * XLD, XLD, s_BmT + wave * 16 * XLD, XLD, 1, z4, l15, quad);
      const int k2 = wave * 16 + l15, k1 = k1t * 16 + quad * 4;
      float o[4];
#pragma unroll
      for (int e = 0; e < 4; ++e) o[e] = ((k1 + e == k2 ? 1.f : 0.f) - d[e]) * wl_c;
      u32x2 ov; ov[0] = pk2(o[0], o[1]); ov[1] = pk2(o[2], o[3]);
      *(u32x2*)(gPT + k2 * 64 + k1) = ov;
    }
    bf16_t* gG = p.cG + (size_t)item * 4096;
#pragma unroll
    for (int k2t = 0; k2t < 4; ++k2t) {
      const f32x4 d1 = mm16(s_KpT + k2t * 16 * XLD, XLD, s_VmT + wave * 16 * XLD, XLD, 1, z4, l15, quad);
      const f32x4 d2 = mm16(s_BmT + k2t * 16 * XLD, XLD, s_XT + (64 + wave * 16) * XLD, XLD, 1, z4, l15, quad);
      const int k2 = k2t * 16 + quad * 4, v = wave * 16 + l15;
      const f32x4 wv = *(const f32x4*)(s_wl + k2);
      u32x2 ov; ov[0] = pk2((d1[0] - d2[0]) * wv[0], (d1[1] - d2[1]) * wv[1]); ov[1] = pk2((d1[2] - d2[2]) * wv[2], (d1[3] - d2[3]) * wv[3]);
      *(u32x2*)(gG + v * 64 + k2) = ov;
    }
    bf16_t* gRT = p.cRT + (size_t)item * 2048;
    bf16_t* gOI = p.cOI + (size_t)item * 2048;
#pragma unroll
    for (int ti = 0; ti < 2; ++ti) {
      const f32x4 d = mm16(s_XT + wave * 16 * XLD, XLD, s_Mrb + ti * 16 * XLD, XLD, 1, z4, l15, quad);
      const int t = ti * 16 + l15, k = wave * 16 + quad * 4;
      const u32x2 rv = *(const u32x2*)(s_R + t * 72 + k);
      u32x2 ov; ov[0] = pk2(bf_lo(rv[0]) - d[0], bf_hi(rv[0]) - d[1]); ov[1] = pk2(bf_lo(rv[1]) - d[2], bf_hi(rv[1]) - d[3]);
      *(u32x2*)(gRT + t * 64 + k) = ov;
      const f32x4 e1 = mm16(s_VmT + wave * 16 * XLD, XLD, s_Mrk + ti * 16 * XLD, XLD, 1, z4, l15, quad);
      const f32x4 e2 = mm16(s_XT + (64 + wave * 16) * XLD, XLD, s_Mrb + ti * 16 * XLD, XLD, 1, z4, l15, quad);
      u32x2 oo; oo[0] = pk2(e1[0] - e2[0], e1[1] - e2[1]); oo[1] = pk2(e1[2] - e2[2], e1[3] - e2[3]);
      *(u32x2*)(gOI + t * 64 + k) = oo;
    }
  }
  __syncthreads();
}

DI void rec_item(const Params& p, int l, int item, char* lds) {
  const int tid = tid_(), wave = __builtin_amdgcn_readfirstlane(tid >> 6), lane = tid & 63, l15 = lane & 15, quad = lane >> 4;
  const bool isp = item < 32;
  const int bh = isp ? item : item - 32; const int b = bh >> 3, h = bh & 7;
  const int nch = isp ? 128 : 2; const int cid0 = isp ? bh * 128 : NCH_P + bh * 2;
  bf16_t* Sb = (bf16_t*)lds;
  const unsigned lbase = (unsigned)(size_t)(LASP char*)lds;
  __syncthreads();
  if (wave < 2) {
    f32x4 acc[2][4];
#pragma unroll
    for (int v2 = 0; v2 < 2; ++v2) {
      const int v = (wave * 2 + v2) * 16 + l15;
      if (isp) {
#pragma unroll
        for (int nk = 0; nk < 4; ++nk) acc[v2][nk] = (f32x4){0.f, 0.f, 0.f, 0.f};
      } else {
        const float* sp = p.swkv + (((size_t)(l * 8 + b) * 8 + h) * 64 + v) * 64;
#pragma unroll
        for (int nk = 0; nk < 4; ++nk) acc[v2][nk] = *(const f32x4*)(sp + nk * 16 + quad * 4);
      }
#pragma unroll
      for (int nk = 0; nk < 4; ++nk) {
        u32x2 o; o[0] = pk2(acc[v2][nk][0], acc[v2][nk][1]); o[1] = pk2(acc[v2][nk][2], acc[v2][nk][3]);
        *(u32x2*)(Sb + v * 72 + nk * 16 + quad * 4) = o;
        *(u32x2*)(p.gS + (size_t)cid0 * 4096 + v * 64 + nk * 16 + quad * 4) = o;
      }
    }
    const int nmain = nch - 2;
    struct PS { bf16x8 pt[4][2]; u32x2 gv[2][4]; };
    auto ldp = [&](PS& s, int c) {
      const int cc = c < nch ? c : nch - 1;
      const size_t cid = (size_t)(cid0 + cc);
      const bf16_t* gPT = p.cPT + cid * 4096; const bf16_t* gG = p.cG + cid * 4096;
#pragma unroll
      for (int nk = 0; nk < 4; ++nk) {
#pragma unroll
        for (int ks = 0; ks < 2; ++ks) s.pt[nk][ks] = *(const bf16x8*)(gPT + (nk * 16 + l15) * 64 + ks * 32 + quad * 8);
#pragma unroll
        for (int v2 = 0; v2 < 2; ++v2) s.gv[v2][nk] = *(const u32x2*)(gG + ((wave * 2 + v2) * 16 + l15) * 64 + nk * 16 + quad * 4);
      }
    };
    auto step = [&](PS& s, int c) {
      const int buf = c & 1;
      bf16x8 sf[2][2];
      {
        const unsigned sad = lbase + (unsigned)(((buf * 64 + wave * 32 + l15) * 72 + quad * 8) * 2);
        asm volatile("ds_read_b128 %0, %4\n\tds_read_b128 %1, %4 offset:64\n\tds_read_b128 %2, %4 offset:2304\n\tds_read_b128 %3, %4 offset:2368\n\ts_waitcnt lgkmcnt(0)"
                     : "=&v"(sf[0][0]), "=&v"(sf[0][1]), "=&v"(sf[1][0]), "=&v"(sf[1][1]) : "v"(sad) : "memory");
      }
#pragma unroll
      for (int v2 = 0; v2 < 2; ++v2) {
#pragma unroll
        for (int nk = 0; nk < 4; ++nk) {
          f32x4 a = (f32x4){bf_lo(s.gv[v2][nk][0]), bf_hi(s.gv[v2][nk][0]), bf_lo(s.gv[v2][nk][1]), bf_hi(s.gv[v2][nk][1])};
#pragma unroll
          for (int ks = 0; ks < 2; ++ks) a = __builtin_amdgcn_mfma_f32_16x16x32_bf16(s.pt[nk][ks], sf[v2][ks], a, 0, 0, 0);
          acc[v2][nk] = a;
        }
      }
      ldp(s, c + 3);
      const size_t scid = (c + 1 < nch) ? (size_t)(cid0 + c + 1) : (size_t)NCH;
#pragma unroll
      for (int v2 = 0; v2 < 2; ++v2) {
        const int v = (wave * 2 + v2) * 16 + l15;
#pragma unroll
        for (int nk = 0; nk < 4; ++nk) {
          u32x2 ov; ov[0] = pk2(acc[v2][nk][0], acc[v2][nk][1]); ov[1] = pk2(acc[v2][nk][2], acc[v2][nk][3]);
          *(u32x2*)(Sb + ((buf ^ 1) * 64 + v) * 72 + nk * 16 + quad * 4) = ov;
          *(u32x2*)(p.gS + scid * 4096 + v * 64 + nk * 16 + quad * 4) = ov;
        }
      }
      asm volatile("s_waitcnt lgkmcnt(0)" ::: "memory");
    };
    PS s0, s1, s2;
    ldp(s0, 0); ldp(s1, 1); ldp(s2, 2);
#pragma unroll 1
    for (int c = 0; c < nmain; c += 3) { step(s0, c); step(s1, c + 1); step(s2, c + 2); }
    step(s0, nmain); step(s1, nmain + 1);
#pragma unroll
    for (int v2 = 0; v2 < 2; ++v2) {
      const int v = (wave * 2 + v2) * 16 + l15;
      float* so = (isp ? p.out + O_WP + (((size_t)(l * 4 + b) * 8 + h) * 64 + v) * 64 : p.out + O_WS + (((size_t)(l * 8 + b) * 8 + h) * 64 + v) * 64);
#pragma unroll
      for (int nk = 0; nk < 4; ++nk) *(f32x4*)(so + nk * 16 + quad * 4) = acc[v2][nk];
    }
  }
  __syncthreads();
}
DI void phase_o(const Params& p, int l) {
  const int tid = tid_(), wave = __builtin_amdgcn_readfirstlane(tid >> 6), lane = tid & 63, l15 = lane & 15, quad = lane >> 4;
  for (int pi = blockIdx.x; pi < NCH / 2; pi += gridDim.x) {
    const int cid = pi * 2 + (wave >> 1);
    const bool isp = cid < NCH_P;
    int bh, c;
    if (isp) { bh = cid >> 7; c = cid & 127; } else { const int j = cid - NCH_P; bh = j >> 1; c = j & 1; }
    const int b = bh >> 3, h = bh & 7;
    const int tok = (wave & 1) * 16 + l15;
    const size_t row = (size_t)((isp ? b * 4096 : MP + b * 64) + c * 32 + tok);
    bf16x8 rt[2], sa[4][2]; u32x2 oi[4], ba[4], gt[4];
#pragma unroll
    for (int ks = 0; ks < 2; ++ks) rt[ks] = *(const bf16x8*)(p.cRT + (size_t)cid * 2048 + tok * 64 + ks * 32 + quad * 8);
#pragma unroll
    for (int vt = 0; vt < 4; ++vt) {
#pragma unroll
      for (int ks = 0; ks < 2; ++ks) sa[vt][ks] = *(const bf16x8*)(p.gS + (size_t)cid * 4096 + (vt * 16 + l15) * 64 + ks * 32 + quad * 8);
      oi[vt] = *(const u32x2*)(p.cOI + (size_t)cid * 2048 + tok * 64 + vt * 16 + quad * 4);
      ba[vt] = *(const u32x2*)(p.cBA + (size_t)cid * 2048 + tok * 64 + vt * 16 + quad * 4);
      gt[vt] = *(const u32x2*)(p.z + row * NZ + C_GR + h * 64 + vt * 16 + quad * 4);
    }
    f32x4 ao[4];
#pragma unroll
    for (int vt = 0; vt < 4; ++vt) {
      f32x4 a = (f32x4){bf_lo(oi[vt][0]), bf_hi(oi[vt][0]), bf_lo(oi[vt][1]), bf_hi(oi[vt][1])};
#pragma unroll
      for (int ks = 0; ks < 2; ++ks) a = __builtin_amdgcn_mfma_f32_16x16x32_bf16(sa[vt][ks], rt[ks], a, 0, 0, 0);
      ao[vt] = a;
    }
    float sm = 0.f, sq = 0.f;
#pragma unroll
    for (int vt = 0; vt < 4; ++vt)
#pragma unroll
      for (int e = 0; e < 4; ++e) { sm += ao[vt][e]; sq += ao[vt][e] * ao[vt][e]; }
    { const float a1 = __shfl_xor(sm, 16), b1 = __shfl_xor(sq, 16); sm += a1; sq += b1; }
    { const float a1 = __shfl_xor(sm, 32), b1 = __shfl_xor(sq, 32); sm += a1; sq += b1; }
    const float mean = sm * (1.0f / 64.0f);
    const float rstd = rsqrtf(fmaxf(sq * (1.0f / 64.0f) - mean * mean, 0.f) + 64e-5f);
    const float* lg = p.lnx_g + l * 512 + h * 64;
#pragma unroll
    for (int vt = 0; vt < 4; ++vt) {
      const int vv = vt * 16 + quad * 4;
      const f32x4 g4 = *(const f32x4*)(lg + vv);
      const float y0 = ((ao[vt][0] - mean) * rstd * g4[0] + bf_lo(ba[vt][0])) * bf_lo(gt[vt][0]);
      const float y1 = ((ao[vt][1] - mean) * rstd * g4[1] + bf_hi(ba[vt][0])) * bf_hi(gt[vt][0]);
      const float y2 = ((ao[vt][2] - mean) * rstd * g4[2] + bf_lo(ba[vt][1])) * bf_lo(gt[vt][1]);
      const float y3 = ((ao[vt][3] - mean) * rstd * g4[3] + bf_hi(ba[vt][1])) * bf_hi(gt[vt][1]);
      u32x2 ov; ov[0] = pk2(y0, y1); ov[1] = pk2(y2, y3);
      *(u32x2*)(p.o_r + row * 512 + h * 64 + vv) = ov;
    }
  }
}
DI void phase_chunk(const Params& p, int l, char* lds) {
  for (int it = blockIdx.x; it < NCH; it += gridDim.x) chunk_item(p, l, it, lds);
  zero_f32(p.ss1, MT);
}

constexpr int ALD = 72;
DI void attn_item(const Params& p, int l, int item, char* lds) {
  const int tid = tid_(), wave = __builtin_amdgcn_readfirstlane(tid >> 6), lane = tid & 63;
  const int m = wave & 1, qh = wave >> 1, q = lane & 31, hh = lane >> 5;
  bf16_t* Ks = (bf16_t*)lds;
  bf16_t* Vs = Ks + 2 * 64 * ALD;
  float* xb = (float*)lds;
  bool samp; int b, h, nch, qrow0, qpos0;
  const int xq = item & 7, tk = item >> 3;
  if (tk < 4) { samp = true; const int bhs = xq + 8 * tk; b = bhs >> 2; h = bhs & 3; nch = 17; qrow0 = MP + b * 64; qpos0 = 1024; }
  else { samp = false; const int kk = tk - 4; const int qc = 63 - (kk >> 1); const int bh = xq + 8 * (kk & 1); b = bh >> 2; h = bh & 3; nch = qc + 1; qrow0 = b * 4096 + qc * 64; qpos0 = qc * 64; }
  bf16x8 qf[4];
  {
    const bf16_t* qp = p.z + (size_t)(qrow0 + qh * 32 + q) * NZ + C_Q + h * 128 + m * 64;
#pragma unroll
    for (int ks = 0; ks < 4; ++ks) qf[ks] = *(const bf16x8*)(qp + ks * 16 + hh * 8);
  }
  const float slope = exp2f(-2.0f * (float)(h + 1));
  const float LOG2E = 1.4426950408889634f;
  const float c1 = 0.125f * LOG2E, sl2 = slope * LOG2E;
  const float qposf = (float)(qpos0 + qh * 32 + q);
  f32x16 O[4];
#pragma unroll
  for (int i = 0; i < 4; ++i)
#pragma unroll
    for (int e = 0; e < 16; ++e) O[i][e] = 0.f;
  float mrun = -1e30f, lrun = 0.f;
  u32x4 rk[4], rv[4];
  auto gload = [&](int j) {
    const bf16_t* kb; size_t kld; const bf16_t* vb; size_t vld;
    if (!samp) { kb = p.z + (size_t)(b * 4096 + j * 64) * NZ + C_K + h * 128; kld = NZ; vb = p.vtp + (size_t)((b * 4 + h) * 128) * 4096 + j * 64; vld = 4096; }
    else if (j < 16) { kb = p.kc + (size_t)(b * 1024 + j * 64) * 512 + h * 128; kld = 512; vb = p.vct + (size_t)((b * 4 + h) * 128) * 1024 + j * 64; vld = 1024; }
    else { kb = p.z + (size_t)(MP + b * 64) * NZ + C_K + h * 128; kld = NZ; vb = p.vts + (size_t)((b * 4 + h) * 128) * 64; vld = 64; }
#pragma unroll
    for (int i = 0; i < 4; ++i) {
      const int c = tid + 256 * i;
      const int mm = c >> 9, key = (c >> 3) & 63, d8 = (c & 7) * 8;
      rk[i] = *(const u32x4*)(kb + (size_t)key * kld + mm * 64 + d8);
      const int vd = c >> 3, k8 = (c & 7) * 8;
      rv[i] = *(const u32x4*)(vb + (size_t)vd * vld + k8);
    }
  };
  auto sstore = [&]() {
#pragma unroll
    for (int i = 0; i < 4; ++i) {
      const int c = tid + 256 * i;
      const int mm = c >> 9, key = (c >> 3) & 63, d8 = (c & 7) * 8;
      *(u32x4*)(Ks + (mm * 64 + key) * ALD + d8) = rk[i];
      const int vd = c >> 3, k8 = (c & 7) * 8;
      *(u32x4*)(Vs + vd * ALD + k8) = rv[i];
    }
  };
  gload(0); sstore(); __syncthreads();
  for (int j = 0; j < nch; ++j) {
    if (j + 1 < nch) gload(j + 1);
    f32x16 s[2];
#pragma unroll
    for (int kt = 0; kt < 2; ++kt) {
#pragma unroll
      for (int e = 0; e < 16; ++e) s[kt][e] = 0.f;
#pragma unroll
      for (int ks = 0; ks < 4; ++ks) {
        const bf16x8 kf = *(const bf16x8*)(Ks + (m * 64 + kt * 32 + q) * ALD + ks * 16 + hh * 8);
        s[kt] = __builtin_amdgcn_mfma_f32_32x32x16_bf16(kf, qf[ks], s[kt], 0, 0, 0);
      }
    }
    float mx = -1e30f;
    const float dbase = qposf - (float)(j * 64 + 4 * hh);
#pragma unroll
    for (int kt = 0; kt < 2; ++kt)
#pragma unroll
      for (int e = 0; e < 16; ++e) {
        const float dd = dbase - (float)(kt * 32 + (e & 3) + 8 * (e >> 2));
        const float v = s[kt][e] * c1 - sl2 * fabsf(dd);
        s[kt][e] = v; mx = fmaxf(mx, v);
      }
    mx = fmaxf(mx, __shfl_xor(mx, 32));
    const float mnew = fmaxf(mrun, mx);
    const float alpha = __builtin_amdgcn_exp2f(mrun - mnew);
    const bool resc = mnew > mrun;
    mrun = mnew;
    float ps = 0.f;
#pragma unroll
    for (int kt = 0; kt < 2; ++kt)
#pragma unroll
      for (int e = 0; e < 16; ++e) { const float pe = __builtin_amdgcn_exp2f(s[kt][e] - mnew); s[kt][e] = pe; ps += pe; }
    lrun = lrun * alpha + ps;
    if (__any(resc)) {
#pragma unroll
      for (int i = 0; i < 4; ++i)
#pragma unroll
        for (int e = 0; e < 16; ++e) O[i][e] *= alpha;
    }
#pragma unroll
    for (int kt = 0; kt < 2; ++kt)
#pragma unroll
      for (int sx = 0; sx < 2; ++sx) {
        u32x4 pb;
        pb[0] = pk2(s[kt][8 * sx + 0], s[kt][8 * sx + 1]); pb[1] = pk2(s[kt][8 * sx + 2], s[kt][8 * sx + 3]);
        pb[2] = pk2(s[kt][8 * sx + 4], s[kt][8 * sx + 5]); pb[3] = pk2(s[kt][8 * sx + 6], s[kt][8 * sx + 7]);
        const bf16x8 pf = __builtin_bit_cast(bf16x8, pb);
#pragma unroll
        for (int vt = 0; vt < 4; ++vt) {
          const bf16_t* vp = Vs + (vt * 32 + q) * ALD + kt * 32 + 16 * sx + 4 * hh;
          const s16x4 lo = *(const s16x4*)vp, hi = *(const s16x4*)(vp + 8);
          const bf16x8 vf = __builtin_shufflevector(lo, hi, 0, 1, 2, 3, 4, 5, 6, 7);
          O[vt] = __builtin_amdgcn_mfma_f32_32x32x16_bf16(vf, pf, O[vt], 0, 0, 0);
        }
      }
    __syncthreads();
    if (j + 1 < nch) sstore();
    __syncthreads();
  }
  const float ltot = lrun + __shfl_xor(lrun, 32);
  const float inv = 1.0f / ltot;
#pragma unroll
  for (int i = 0; i < 4; ++i)
#pragma unroll
    for (int e = 0; e < 16; ++e) O[i][e] *= inv;
  if (m == 1) {
#pragma unroll
    for (int vt = 0; vt < 4; ++vt)
#pragma unroll
      for (int e = 0; e < 16; ++e) { const int vd = vt * 32 + (e & 3) + 8 * (e >> 2) + 4 * hh; xb[(qh * 128 + vd) * 32 + q] = O[vt][e]; }
  }
  __syncthreads();
  if (m == 0) {
    float d1 = 0.f, d2 = 0.f;
    for (int i = 0; i < 64; ++i) { d1 += p.lq1[l * 64 + i] * p.lk1[l * 64 + i]; d2 += p.lq2[l * 64 + i] * p.lk2[l * 64 + i]; }
    const float lam_init = 0.8f - 0.6f * __expf(-0.3f * (float)l);
    const float lam = __expf(d1) - __expf(d2) + lam_init;
    float ss = 0.f;
#pragma unroll
    for (int vt = 0; vt < 4; ++vt)
#pragma unroll
      for (int e = 0; e < 16; ++e) {
        const int vd = vt * 32 + (e & 3) + 8 * (e >> 2) + 4 * hh;
        const float o2 = xb[(qh * 128 + vd) * 32 + q];
        const float o = O[vt][e] - lam * o2; O[vt][e] = o; ss += o * o;
      }
    ss += __shfl_xor(ss, 32);
    const float rstd = rsqrtf(ss * (1.0f / 128.0f) + 1e-5f) * (1.0f - lam_init);
    const size_t row = (size_t)(qrow0 + qh * 32 + q);
    const float* sg = p.subln_g + l * 128;
#pragma unroll
    for (int vt = 0; vt < 4; ++vt)
#pragma unroll
      for (int e4 = 0; e4 < 4; ++e4) {
        const int vd = vt * 32 + 8 * e4 + 4 * hh;
        const u32x2 gu = *(const u32x2*)(p.z + row * NZ + C_GA + h * 128 + vd);
        const f32x4 gv = *(const f32x4*)(sg + vd);
        const float y0 = O[vt][4 * e4 + 0] * rstd * gv[0] * bf_lo(gu[0]);
        const float y1 = O[vt][4 * e4 + 1] * rstd * gv[1] * bf_hi(gu[0]);
        const float y2 = O[vt][4 * e4 + 2] * rstd * gv[2] * bf_lo(gu[1]);
        const float y3 = O[vt][4 * e4 + 3] * rstd * gv[3] * bf_hi(gu[1]);
        u32x2 ov; ov[0] = pk2(y0, y1); ov[1] = pk2(y2, y3);
        *(u32x2*)(p.o_a + row * 512 + h * 128 + vd) = ov;
      }
  }
  __syncthreads();
}

DI void phase_mix(const Params& p, int l, char* lds) {
  __shared__ int s_next;
  if (blockIdx.x < 96) { __builtin_amdgcn_s_setprio(3); rec_item(p, l, blockIdx.x, lds); __builtin_amdgcn_s_setprio(0); }
  unsigned* ctr = p.bar + XCD_BAR_WORDS + 64 * l + (blockIdx.x & 7);
  for (;;) {
    __syncthreads();
    if (threadIdx.x == 0) { const int k = (int)atomicAdd(ctr, 1u); s_next = k < 132 ? k * 8 + (int)(blockIdx.x & 7) : 1 << 20; }
    __syncthreads();
    const int it = s_next;
    if (it >= (1 << 20)) break;
    attn_item(p, l, it, lds);
  }
}

template <bool A_F32>
DI void mini_gemm(f32x4 (&acc)[2][2], const void* Ap, int lda, const bf16_t* Bp, int ldb, int K, int wave, int l15, int quad) {
  const int kw = K >> 2, k0 = wave * kw;
#pragma unroll 2
  for (int ks = 0; ks < kw; ks += 32) {
    bf16x8 a[2], b[2];
#pragma unroll
    for (int mi = 0; mi < 2; ++mi) {
      if (A_F32) {
        const float* ap = (const float*)Ap + (size_t)(mi * 16 + l15) * lda + k0 + ks + quad * 8;
        const f32x4 v0 = *(const f32x4*)ap, v1 = *(const f32x4*)(ap + 4);
        u32x4 t; t[0] = pk2(v0[0], v0[1]); t[1] = pk2(v0[2], v0[3]); t[2] = pk2(v1[0], v1[1]); t[3] = pk2(v1[2], v1[3]);
        a[mi] = __builtin_bit_cast(bf16x8, t);
      } else {
        a[mi] = *(const bf16x8*)((const bf16_t*)Ap + (size_t)(mi * 16 + l15) * lda + k0 + ks + quad * 8);
      }
      b[mi] = *(const bf16x8*)(Bp + (size_t)(mi * 16 + l15) * ldb + k0 + ks + quad * 8);
    }
#pragma unroll
    for (int mi = 0; mi < 2; ++mi)
#pragma unroll
      for (int ni = 0; ni < 2; ++ni) acc[mi][ni] = __builtin_amdgcn_mfma_f32_16x16x32_bf16(b[ni], a[mi], acc[mi][ni], 0, 0, 0);
  }
}
DI f32x4 mini_reduce(const f32x4 (&acc)[2][2], char* lds, int wave, int lane) {
  float* red = (float*)lds;
  __syncthreads();
#pragma unroll
  for (int i = 0; i < 2; ++i)
#pragma unroll
    for (int j = 0; j < 2; ++j)
#pragma unroll
      for (int e = 0; e < 4; ++e) red[((wave * 4 + i * 2 + j) * 4 + e) * 64 + lane] = acc[i][j][e];
  __syncthreads();
  f32x4 r;
#pragma unroll
  for (int e = 0; e < 4; ++e) r[e] = (red[((0 * 4 + wave) * 4 + e) * 64 + lane] + red[((1 * 4 + wave) * 4 + e) * 64 + lane]) + (red[((2 * 4 + wave) * 4 + e) * 64 + lane] + red[((3 * 4 + wave) * 4 + e) * 64 + lane]);
  return r;
}
DI void zero_mini(f32x4 (&acc)[2][2]) {
#pragma unroll
  for (int i = 0; i < 2; ++i)
#pragma unroll
    for (int j = 0; j < 2; ++j) acc[i][j] = (f32x4){0.f, 0.f, 0.f, 0.f};
}
DI void mini_merge(const Params& p, int l, int t, char* lds) {
  const int tid = tid_(), wave = __builtin_amdgcn_readfirstlane(tid >> 6), lane = tid & 63, l15 = lane & 15, quad = lane >> 4;
  const int R0 = MP + (t >> 5) * 32, C0 = (t & 31) * 32;
  f32x4 acc[2][2]; zero_mini(acc);
  mini_gemm<false>(acc, p.o_r + (size_t)R0 * 512, 512, p.wt_brr + (size_t)C0 * 512, 512, 512, wave, l15, quad);
  const f32x4 v1 = mini_reduce(acc, lds, wave, lane);
  zero_mini(acc);
  mini_gemm<false>(acc, p.o_a + (size_t)R0 * 512, 512, p.wt_bra + (size_t)C0 * 512, 512, 512, wave, l15, quad);
  const f32x4 v2 = mini_reduce(acc, lds, wave, lane);
  const int R = R0 + (wave >> 1) * 16 + l15, c = C0 + (wave & 1) * 16 + quad * 4;
  const u32x2 g1 = *(const u32x2*)(p.z + (size_t)R * NZ + C_MR + c), g2 = *(const u32x2*)(p.z + (size_t)R * NZ + C_MA + c);
  u32x2 o;
  o[0] = pk2(bf_lo(g1[0]) * v1[0] + bf_lo(g2[0]) * v2[0], bf_hi(g1[0]) * v1[1] + bf_hi(g2[0]) * v2[1]);
  o[1] = pk2(bf_lo(g1[1]) * v1[2] + bf_lo(g2[1]) * v2[2], bf_hi(g1[1]) * v1[3] + bf_hi(g2[1]) * v2[3]);
  *(u32x2*)(p.hn + (size_t)R * DM + c) = o;
}
DI void mini_out(const Params& p, int l, int t, char* lds) {
  const int tid = tid_(), wave = __builtin_amdgcn_readfirstlane(tid >> 6), lane = tid & 63, l15 = lane & 15, quad = lane >> 4;
  const int R0 = MP + (t >> 5) * 32, C0 = (t & 31) * 32;
  f32x4 acc[2][2]; zero_mini(acc);
  mini_gemm<false>(acc, p.hn + (size_t)R0 * DM, DM, p.wt_out + (size_t)C0 * DM, DM, DM, wave, l15, quad);
  const f32x4 v = mini_reduce(acc, lds, wave, lane);
  const int R = R0 + (wave >> 1) * 16 + l15, c = C0 + (wave & 1) * 16 + quad * 4;
  const f32x4 xv = *(const f32x4*)(x_row(p, l, R) + c);
  const f32x4 x1 = xv + v;
  *(f32x4*)(p.out + (size_t)R * DM + c) = x1;
  const f32x4 gv = *(const f32x4*)(p.ple_norm_g + l * DM + c);
  u32x2 o; o[0] = pk2(x1[0] * gv[0], x1[1] * gv[1]); o[1] = pk2(x1[2] * gv[2], x1[3] * gv[3]);
  *(u32x2*)(p.o_r + (size_t)R * DM + c) = o;
  float sq = x1[0] * x1[0] + x1[1] * x1[1] + x1[2] * x1[2] + x1[3] * x1[3];
  sq += __shfl_xor(sq, 16); sq += __shfl_xor(sq, 32);
  if (quad == 0) atomicAdd(p.ss2 + R, sq);
}
DI void mini_ple(const Params& p, int l, int t, char* lds) {
  const int tid = tid_(), wave = __builtin_amdgcn_readfirstlane(tid >> 6), lane = tid & 63, l15 = lane & 15, quad = lane >> 4;
  const int R0 = MP + (t >> 5) * 32, C0 = (t & 31) * 32;
  f32x4 acc[2][2]; zero_mini(acc);
  mini_gemm<false>(acc, p.o_r + (size_t)R0 * DM, DM, p.wt_gate + (size_t)C0 * DM, DM, DM, wave, l15, quad);
  const f32x4 g = mini_reduce(acc, lds, wave, lane);
  zero_mini(acc);
  mini_gemm<true>(acc, p.ps + ((size_t)l * MS + (R0 - MP)) * 256, 256, p.wt_ple + (size_t)C0 * 256, 256, 256, wave, l15, quad);
  const f32x4 e = mini_reduce(acc, lds, wave, lane);
  const int R = R0 + (wave >> 1) * 16 + l15, c = C0 + (wave & 1) * 16 + quad * 4;
  const float rs = rsqrtf(p.ss2[R] * (1.0f / 1024.0f) + 1e-6f);
  float* xo = p.out + (size_t)R * DM + c;
  const f32x4 xv = *(const f32x4*)xo;
  f32x4 o;
#pragma unroll
  for (int k = 0; k < 4; ++k) o[k] = xv[k] + e[k] * bf1((bf16_t)(pk2(sigmoidf_(g[k] * rs), 0.f) & 0xffff));
  *(f32x4*)xo = o;
  if (l + 1 < NL) {
    const f32x4 gn = *(const f32x4*)(p.norm_g + (l + 1) * DM + c);
    u32x2 hv; hv[0] = pk2(o[0] * gn[0], o[1] * gn[1]); hv[1] = pk2(o[2] * gn[2], o[3] * gn[3]);
    *(u32x2*)(p.hn + (size_t)R * DM + c) = hv;
    float sq = o[0] * o[0] + o[1] * o[1] + o[2] * o[2] + o[3] * o[3];
    sq += __shfl_xor(sq, 16); sq += __shfl_xor(sq, 32);
    if (quad == 0) atomicAdd(p.ss1 + R, sq);
  }
}
DI void phase_merge(const Params& p, int l, char* lds) {
  const int tid = tid_(), wave = __builtin_amdgcn_readfirstlane(tid >> 6), lane = tid & 63;
  const int wm = wave >> 1, wn = wave & 1, l15 = lane & 15, quad = lane >> 4;
  for (int r = 0;; ++r) {
    const int g = xcd_tile(r, 128 * 8); if (g < 0) break;
    int mt, nt; tile_decode(g, 128, 8, mt, nt);
    f32x4 a1[4][4]; zero_acc(a1);
    gemm_dma(a1, p.o_r + (size_t)mt * 128 * 512, 512, p.wt_brr + (size_t)nt * 128 * 512, 512, 512, lds);
    u32x2 pk[4][4];
#pragma unroll
    for (int mi = 0; mi < 4; ++mi) {
      const int R = mt * 128 + wm * 64 + mi * 16 + l15;
#pragma unroll
      for (int ni = 0; ni < 4; ++ni) {
        const int c = nt * 128 + wn * 64 + ni * 16 + quad * 4;
        const u32x2 g1 = *(const u32x2*)(p.z + (size_t)R * NZ + C_MR + c);
        const f32x4 v1 = a1[mi][ni];
        pk[mi][ni][0] = pk2(bf_lo(g1[0]) * v1[0], bf_hi(g1[0]) * v1[1]);
        pk[mi][ni][1] = pk2(bf_lo(g1[1]) * v1[2], bf_hi(g1[1]) * v1[3]);
      }
    }
    zero_acc(a1);
    gemm_dma(a1, p.o_a + (size_t)mt * 128 * 512, 512, p.wt_bra + (size_t)nt * 128 * 512, 512, 512, lds);
#pragma unroll
    for (int mi = 0; mi < 4; ++mi) {
      const int R = mt * 128 + wm * 64 + mi * 16 + l15;
#pragma unroll
      for (int ni = 0; ni < 4; ++ni) {
        const int c = nt * 128 + wn * 64 + ni * 16 + quad * 4;
        const u32x2 g2 = *(const u32x2*)(p.z + (size_t)R * NZ + C_MA + c);
        const f32x4 v2 = a1[mi][ni]; const u32x2 u1 = pk[mi][ni];
        u32x2 o;
        o[0] = pk2(bf_lo(u1[0]) + bf_lo(g2[0]) * v2[0], bf_hi(u1[0]) + bf_hi(g2[0]) * v2[1]);
        o[1] = pk2(bf_lo(u1[1]) + bf_lo(g2[1]) * v2[2], bf_hi(u1[1]) + bf_hi(g2[1]) * v2[3]);
        *(u32x2*)(p.hn + (size_t)R * DM + c) = o;
      }
    }
  }
  for (int t = blockIdx.x; t < 512; t += gridDim.x) mini_merge(p, l, t, lds);
}
DI void phase_out(const Params& p, int l, char* lds) {
  const int tid = tid_(), wave = __builtin_amdgcn_readfirstlane(tid >> 6), lane = tid & 63;
  const int wm = wave >> 1, wn = wave & 1, l15 = lane & 15, quad = lane >> 4;
  for (int r = 0;; ++r) {
    const int g = xcd_tile(r, 128 * 8); if (g < 0) break;
    int mt, nt; tile_decode(g, 128, 8, mt, nt);
    f32x4 acc[4][4]; zero_acc(acc);
    gemm_dma(acc, p.hn + (size_t)mt * 128 * DM, DM, p.wt_out + (size_t)nt * 128 * DM, DM, DM, lds);
#pragma unroll
    for (int mi = 0; mi < 4; ++mi) {
      const int R = mt * 128 + wm * 64 + mi * 16 + l15;
      const float* xr = x_row(p, l, R);
      const float* g2 = p.ple_norm_g + l * DM;
      bf16_t* xb = p.o_r + (size_t)R * DM;
      float sq = 0.f;
#pragma unroll
      for (int ni = 0; ni < 4; ++ni) {
        const int c = nt * 128 + wn * 64 + ni * 16 + quad * 4;
        const f32x4 xv = *(const f32x4*)(xr + c);
        const f32x4 x1 = xv + acc[mi][ni];
        *(f32x4*)(p.out + (size_t)R * DM + c) = x1;
        const f32x4 gv = *(const f32x4*)(g2 + c);
        u32x2 o; o[0] = pk2(x1[0] * gv[0], x1[1] * gv[1]); o[1] = pk2(x1[2] * gv[2], x1[3] * gv[3]);
        *(u32x2*)(xb + c) = o;
        sq += x1[0] * x1[0] + x1[1] * x1[1] + x1[2] * x1[2] + x1[3] * x1[3];
      }
      sq += __shfl_xor(sq, 16); sq += __shfl_xor(sq, 32);
      if (quad == 0) atomicAdd(p.ss2 + R, sq);
    }
  }
  for (int t = blockIdx.x; t < 512; t += gridDim.x) mini_out(p, l, t, lds);
}
DI void phase_ple(const Params& p, int l, char* lds) {
  const int tid = tid_(), wave = __builtin_amdgcn_readfirstlane(tid >> 6), lane = tid & 63;
  const int wm = wave >> 1, wn = wave & 1, l15 = lane & 15, quad = lane >> 4;
  for (int r = 0;; ++r) {
    const int g = xcd_tile(r, 128 * 8); if (g < 0) break;
    int mt, nt; tile_decode(g, 128, 8, mt, nt);
    f32x4 a1[4][4]; zero_acc(a1);
    gemm_dma(a1, p.o_r + (size_t)mt * 128 * DM, DM, p.wt_gate + (size_t)nt * 128 * DM, DM, DM, lds);
    u32x2 pk[4][4];
#pragma unroll
    for (int mi = 0; mi < 4; ++mi) {
      const float rs = rsqrtf(p.ss2[mt * 128 + wm * 64 + mi * 16 + l15] * (1.0f / 1024.0f) + 1e-6f);
#pragma unroll
      for (int ni = 0; ni < 4; ++ni) { const f32x4 v = a1[mi][ni] * rs; pk[mi][ni][0] = pk2(sigmoidf_(v[0]), sigmoidf_(v[1])); pk[mi][ni][1] = pk2(sigmoidf_(v[2]), sigmoidf_(v[3])); }
    }
    zero_acc(a1);
    const int r0 = mt * 128;
    const float* pa = r0 < MP ? p.pp + ((size_t)l * MP + r0) * 256 : p.ps + ((size_t)l * MS + (r0 - MP)) * 256;
    gemm_core<true>(a1, pa, 256, p.wt_ple + (size_t)nt * 128 * 256, 256, 256, lds);
#pragma unroll
    for (int mi = 0; mi < 4; ++mi) {
      const int R = mt * 128 + wm * 64 + mi * 16 + l15;
      float sq = 0.f;
#pragma unroll
      for (int ni = 0; ni < 4; ++ni) {
        const int c = nt * 128 + wn * 64 + ni * 16 + quad * 4;
        float* xo = p.out + (size_t)R * DM + c;
        const f32x4 xv = *(const f32x4*)xo; const f32x4 e = a1[mi][ni]; const u32x2 g = pk[mi][ni];
        f32x4 o;
        o[0] = xv[0] + e[0] * bf_lo(g[0]); o[1] = xv[1] + e[1] * bf_hi(g[0]);
        o[2] = xv[2] + e[2] * bf_lo(g[1]); o[3] = xv[3] + e[3] * bf_hi(g[1]);
        *(f32x4*)xo = o;
        if (l + 1 < NL) {
          const f32x4 gn = *(const f32x4*)(p.norm_g + (l + 1) * DM + c);
          u32x2 hv; hv[0] = pk2(o[0] * gn[0], o[1] * gn[1]); hv[1] = pk2(o[2] * gn[2], o[3] * gn[3]);
          *(u32x2*)(p.hn + (size_t)R * DM + c) = hv;
          sq += o[0] * o[0] + o[1] * o[1] + o[2] * o[2] + o[3] * o[3];
        }
      }
      if (l + 1 < NL) {
        sq += __shfl_xor(sq, 16); sq += __shfl_xor(sq, 32);
        if (quad == 0) atomicAdd(p.ss1 + R, sq);
      }
    }
  }
  for (int t = blockIdx.x; t < 512; t += gridDim.x) mini_ple(p, l, t, lds);
  if (l + 1 < NL) {
    for (int it = blockIdx.x; it < 2080 + 16 + 2048; it += gridDim.x) {
      if (it < 2080) wconv_tile(p, l + 1, it, (float*)lds);
      else if (it < 2096) wconv_tile(p, l + 1, 2400 + (it - 2080), (float*)lds);
      else cache_item(p, l + 1, it - 2096, lds);
    }
  }
}


#define XB_TMO      128
#define XB_XCNT(j)  (256  + 64 * (j))
#define XB_XSUB(j)  (1280 + 64 * (j))
#define XB_XGEN(j)  (2304 + 64 * (j))
#define XB_TOP      3328
#define XB_TOPGEN   3392
#define XB_SPIN_CAP (1u << 18)
#define LAS __attribute__((address_space(3)))
DI unsigned xb_ld(unsigned* p)              { return __hip_atomic_load(p, __ATOMIC_RELAXED, __HIP_MEMORY_SCOPE_AGENT); }
DI unsigned xb_add(unsigned* p, unsigned v) { return __hip_atomic_fetch_add(p, v, __ATOMIC_RELAXED, __HIP_MEMORY_SCOPE_AGENT); }
DI unsigned xb_xcc_id() { return (unsigned)__builtin_amdgcn_s_getreg((3 << 11) | 20) & 0xFu; }
#define XB_SPIN(cond, bar) do { unsigned _sp = 0; while (cond) { __builtin_amdgcn_s_sleep(1); \
    if ((++_sp & 255u) == 0u) { if (xb_ld(&(bar)[XB_TMO])) break; if (_sp > XB_SPIN_CAP) { atomicAdd(&(bar)[XB_TMO], 1u); break; } } } } while (0)
struct XcdBarrier { unsigned* bar; unsigned x; volatile LAS unsigned* st; };
DI XcdBarrier xcd_barrier_post(unsigned* bar, volatile LAS unsigned* st) {
  XcdBarrier b; b.bar = bar; b.x = xb_xcc_id(); b.st = st;
  if (threadIdx.x == 0) (void)xb_add(&bar[XB_XCNT(b.x)], 1u);
  return b;
}
DI void xcd_barrier_complete(unsigned* bar, unsigned x, unsigned& nloc, unsigned& nx) {
  const unsigned G = gridDim.x * gridDim.y * gridDim.z;
  unsigned sum, cnt, mine, sp = 0u;
  for (;;) {
    sum = 0u; cnt = 0u; mine = 0u;
#pragma unroll
    for (unsigned j = 0; j < 16; ++j) { const unsigned c = xb_ld(&bar[XB_XCNT(j)]); sum += c; cnt += (c > 0u) ? 1u : 0u; mine = (j == x) ? c : mine; }
    if (sum == G) break;
    __builtin_amdgcn_s_sleep(1);
    if ((++sp & 255u) == 0u) { if (xb_ld(&bar[XB_TMO])) break; if (sp > XB_SPIN_CAP) { atomicAdd(&bar[XB_TMO], 1u); break; } }
  }
  nloc = mine > 0u ? mine : 1u; nx = cnt > 0u ? cnt : 1u;
}
DI void xcd_barrier(const XcdBarrier& b) {
  asm volatile("s_waitcnt vmcnt(0)" ::: "memory");
  __syncthreads();
  if (threadIdx.x == 0) {
    unsigned* bar = b.bar;
    __builtin_amdgcn_s_waitcnt(0);
    unsigned nloc = b.st[0], nx = b.st[1];
    if (nloc == 0u) { xcd_barrier_complete(bar, b.x, nloc, nx); b.st[0] = nloc; b.st[1] = nx; }
    const unsigned old = xb_add(&bar[XB_XSUB(b.x)], 1u);
    const unsigned gen = old / nloc;
    if (old + 1u == (gen + 1u) * nloc) {
      __builtin_amdgcn_fence(__ATOMIC_RELEASE, "agent");
      asm volatile("s_waitcnt vmcnt(0)" ::: "memory");
      const unsigned og = xb_add(&bar[XB_TOP], 1u);
      const unsigned tg = og / nx;
      if (og + 1u == (tg + 1u) * nx) xb_add(&bar[XB_TOPGEN], 1u);
      else XB_SPIN(xb_ld(&bar[XB_TOPGEN]) == tg, bar);
      __builtin_amdgcn_fence(__ATOMIC_ACQUIRE, "agent");
      xb_add(&bar[XB_XGEN(b.x)], 1u);
      asm volatile("s_waitcnt vmcnt(0)" ::: "memory");
    } else {
      XB_SPIN(xb_ld(&bar[XB_XGEN(b.x)]) == gen, bar);
      __builtin_amdgcn_fence(__ATOMIC_ACQUIRE, "agent");
      asm volatile("s_waitcnt vmcnt(0)" ::: "memory");
    }
  }
  __syncthreads();
}
constexpr int LDS_BYTES = 73728;
DI void run_phase(const Params& p, int ph, int l, char* lds) {
  switch (ph) {
    case 1: phase_norm0(p, lds); break;
    case 2: phase_gemm_in(p, l, lds); break;
    case 3: phase_mix(p, l, lds); break;
    case 4: phase_merge(p, l, lds); break;
    case 5: phase_out(p, l, lds); break;
    case 6: break;
    case 7: phase_ple(p, l, lds); break;
    case 8: phase_chunk(p, l, lds); break;
  }
}

#if MEGA
__global__ void __launch_bounds__(256, 2) k_mega(Params p) {
  __shared__ __attribute__((aligned(16))) char lds[LDS_BYTES];
  __shared__ uint4 xb_words;
  cg::grid_group grid = cg::this_grid();
  if (threadIdx.x == 0) xb_words = make_uint4(0u, 0u, 0u, 0u);
  __syncthreads();
  const XcdBarrier xb = xcd_barrier_post(p.bar, (volatile LAS unsigned*)&xb_words);
  phase_norm0(p, lds);
  grid.sync();
#pragma unroll 1
  for (int l = 0; l < NL; ++l) {
    phase_gemm_in(p, l, lds); xcd_barrier(xb);
    phase_chunk(p, l, lds); xcd_barrier(xb);
    phase_mix(p, l, lds); xcd_barrier(xb);
    phase_o(p, l); xcd_barrier(xb);
    phase_merge(p, l, lds); xcd_barrier(xb);
    phase_out(p, l, lds); xcd_barrier(xb);
    phase_ple(p, l, lds); if (l + 1 < NL) xcd_barrier(xb);
  }
}
#else
template <int PH>
__global__ void __launch_bounds__(256, 2) k_phase(Params p, int l) {
  __shared__ __attribute__((aligned(16))) char lds[LDS_BYTES];
  run_phase(p, PH, l, lds);
}
#endif

extern "C" void kernel_launch(void* const* d_in, const int* in_sizes, int n_in, void* d_out, int out_size, void* d_ws, size_t ws_size,
                              hipStream_t stream) {
  Params p{};
  const float** pf = (const float**)&p;
  for (int i = 0; i < 33; ++i) pf[i] = (const float*)d_in[i];
  p.out = (float*)d_out;
  char* w = (char*)d_ws; size_t off = 0;
  auto take = [&](size_t bytes) { char* r = w + off; off += (bytes + 255) & ~(size_t)255; return (bf16_t*)r; };
  p.gS = take((size_t)(NCH + 1) * 4096 * 2);
  p.ss1 = (float*)take((size_t)MT * 4); p.ss2 = (float*)take((size_t)MT * 4);
  p.bar = (unsigned*)take((size_t)(XCD_BAR_WORDS + 64 * NL) * 4);
  p.wt_in = take((size_t)NZ * 1024 * 2);
  p.wt_brr = take((size_t)1024 * 512 * 2);
  p.wt_bra = take((size_t)1024 * 512 * 2);
  p.wt_out = take((size_t)1024 * 1024 * 2);
  p.wt_ple = take((size_t)1024 * 256 * 2);
  p.wt_gate = take((size_t)1024 * 1024 * 2);
  p.w2t = take((size_t)512 * 64 * 2);
  p.a2t = take((size_t)512 * 64 * 2);
  p.z = take((size_t)MT * NZ * 2);
  p.vtp = take((size_t)16 * 128 * 4096 * 2);
  p.vts = take((size_t)32 * 128 * 64 * 2);
  p.kc = take((size_t)8 * 1024 * 512 * 2);
  p.vct = take((size_t)32 * 128 * 1024 * 2);
  p.o_r = take((size_t)MT * 512 * 2);
  p.o_a = take((size_t)MT * 512 * 2);
  p.hn = take((size_t)MT * DM * 2);
  p.cPT = p.hn;
  p.cG = take((size_t)NCH * 4096 * 2);
  p.cRT = take((size_t)NCH * 2048 * 2);
  p.cOI = take((size_t)NCH * 2048 * 2);
  p.cBA = take((size_t)NCH * 2048 * 2);
  if (off > ws_size) { fprintf(stderr, "workspace too small: need %zu have %zu\n", off, ws_size); return; }
#if MEGA
  hipMemsetAsync(p.bar, 0, (size_t)(XCD_BAR_WORDS + 64 * NL) * 4, stream);
  static int grid_blocks = 0;
  if (!grid_blocks) {
    int dev = 0, cus = 0, per_cu = 0;
    hipGetDevice(&dev);
    hipDeviceGetAttribute(&cus, hipDeviceAttributeMultiprocessorCount, dev);
    hipOccupancyMaxActiveBlocksPerMultiprocessor(&per_cu, k_mega, 256, 0);
    if (per_cu > 2) per_cu = 2;
    grid_blocks = cus * per_cu;
  }
  void* args[] = {&p};
  hipError_t e = hipLaunchCooperativeKernel((void*)k_mega, dim3(grid_blocks), dim3(256), args, 0, stream);
  if (e != hipSuccess) fprintf(stderr, "cooperative launch failed: %s (grid %d)\n", hipGetErrorString(e), grid_blocks);
#else
  const int G = 512;
  for (int l = 0; l < NL; ++l) {
    k_phase<1><<<G, 256, 0, stream>>>(p, l);
    k_phase<2><<<G, 256, 0, stream>>>(p, l);
    k_phase<8><<<G, 256, 0, stream>>>(p, l);
    k_phase<3><<<G, 256, 0, stream>>>(p, l);
    k_phase<4><<<G, 256, 0, stream>>>(p, l);
    k_phase<5><<<G, 256, 0, stream>>>(p, l);
    k_phase<6><<<G, 256, 0, stream>>>(p, l);
    k_phase<7><<<G, 256, 0, stream>>>(p, l);
  }
#endif
}
```

```cpp
#include <hip/hip_runtime.h>
#include <hip/hip_cooperative_groups.h>
#include <stdint.h>
#include <stdio.h>
namespace cg = cooperative_groups;

#ifndef MEGA
#define MEGA 1
#endif

typedef unsigned short bf16_t;
typedef short bf16x8 __attribute__((ext_vector_type(8)));
typedef short s16x4 __attribute__((ext_vector_type(4)));
typedef float f32x4 __attribute__((ext_vector_type(4)));
typedef float f32x2 __attribute__((ext_vector_type(2)));
typedef float f32x16 __attribute__((ext_vector_type(16)));
typedef unsigned u32x4 __attribute__((ext_vector_type(4)));
typedef unsigned u32x2 __attribute__((ext_vector_type(2)));
typedef __bf16 bfv2 __attribute__((ext_vector_type(2)));

#define DI __device__ __forceinline__
#define XCD_BAR_WORDS 3456
DI int tid_() { int t = threadIdx.x; asm volatile("" : "+v"(t)); return t; }

constexpr int DM = 1024, MP = 16384, MS = 512, MT = 16896, NZ = 6272, NL = 4;
constexpr int C_GR = 1664, C_Q = 2176, C_K = 2688, C_V = 3200, C_GA = 3712, C_MR = 4224, C_MA = 5248;
constexpr int SHC = 1664;
constexpr size_t O_YP = 0, O_YS = 16777216, O_KP = 17301504, O_VP = 50855936, O_WP = 84410368, O_SP = 84934656,
                 O_KS = 84961280, O_VS = 86009856, O_WS = 87058432, O_SS = 88107008;

struct Params {
  const float *xp, *xs, *pp, *ps, *ck, *cv, *swkv, *sshift;
  const float *norm_g, *w_in, *shift_mu, *decay_w0, *decay_w2, *iclr_a0, *iclr_a2, *k_k, *k_a, *r_k, *lnx_g, *lnx_b,
      *qng, *kng, *lq1, *lk1, *lq2, *lk2, *subln_g, *w_br_r, *w_br_a, *w_out, *ple_w, *ple_gate_w, *ple_norm_g;
  float* out;
  bf16_t *wt_in, *wt_brr, *wt_bra, *wt_out, *wt_ple, *wt_gate, *w2t, *a2t;
  bf16_t *hn, *z, *vtp, *vts, *kc, *vct, *o_r, *o_a;
  bf16_t *cPT, *cG, *cRT, *cOI, *cBA;
  unsigned* bar;
  float *ss1, *ss2;
  bf16_t* gS;
};

DI unsigned pk2(float a, float b) { f32x2 v = {a, b}; bfv2 r = __builtin_convertvector(v, bfv2); return __builtin_bit_cast(unsigned, r); }
DI float bf_lo(unsigned u) { return __uint_as_float(u << 16); }
DI float bf_hi(unsigned u) { return __uint_as_float(u & 0xffff0000u); }
DI float bf1(bf16_t u) { return __uint_as_float(((unsigned)u) << 16); }
DI float sigmoidf_(float x) { return __builtin_amdgcn_rcpf(1.0f + __expf(-x)); }
DI float siluf_(float x) { return x * __builtin_amdgcn_rcpf(1.0f + __expf(-x)); }

DI void tr_tile(const float* __restrict__ src, int ld_src, bf16_t* __restrict__ dst, int ld_dst, float* sm) {
  const int tid = tid_();
  const int r = tid >> 4, c4 = (tid & 15) * 4;
#pragma unroll
  for (int i = 0; i < 4; ++i) {
    const int row = r + 16 * i;
    f32x4 v = *(const f32x4*)(src + (size_t)row * ld_src + c4);
    sm[row * 65 + c4 + 0] = v[0]; sm[row * 65 + c4 + 1] = v[1]; sm[row * 65 + c4 + 2] = v[2]; sm[row * 65 + c4 + 3] = v[3];
  }
  __syncthreads();
  const int n = tid >> 2, ks = (tid & 3) * 16;
  u32x4 o0, o1;
  o0[0] = pk2(sm[(ks + 0) * 65 + n], sm[(ks + 1) * 65 + n]);   o0[1] = pk2(sm[(ks + 2) * 65 + n], sm[(ks + 3) * 65 + n]);
  o0[2] = pk2(sm[(ks + 4) * 65 + n], sm[(ks + 5) * 65 + n]);   o0[3] = pk2(sm[(ks + 6) * 65 + n], sm[(ks + 7) * 65 + n]);
  o1[0] = pk2(sm[(ks + 8) * 65 + n], sm[(ks + 9) * 65 + n]);   o1[1] = pk2(sm[(ks + 10) * 65 + n], sm[(ks + 11) * 65 + n]);
  o1[2] = pk2(sm[(ks + 12) * 65 + n], sm[(ks + 13) * 65 + n]); o1[3] = pk2(sm[(ks + 14) * 65 + n], sm[(ks + 15) * 65 + n]);
  *(u32x4*)(dst + (size_t)n * ld_dst + ks) = o0;
  *(u32x4*)(dst + (size_t)n * ld_dst + ks + 8) = o1;
  __syncthreads();
}

constexpr int WCONV_TILES = 1568 + 128 + 128 + 256 + 64 + 256 + 8 + 8;
DI void wconv_tile(const Params& p, int l, int t, float* sm) {
  const float* src; bf16_t* dst; int K, N;
  if (t < 1568) { src = p.w_in + (size_t)l * 1024 * NZ; dst = p.wt_in; K = 1024; N = NZ; }
  else if ((t -= 1568) < 128) { src = p.w_br_r + (size_t)l * 512 * 1024; dst = p.wt_brr; K = 512; N = 1024; }
  else if ((t -= 128) < 128) { src = p.w_br_a + (size_t)l * 512 * 1024; dst = p.wt_bra; K = 512; N = 1024; }
  else if ((t -= 128) < 256) { src = p.w_out + (size_t)l * 1024 * 1024; dst = p.wt_out; K = 1024; N = 1024; }
  else if ((t -= 256) < 64) { src = p.ple_w + (size_t)l * 256 * 1024; dst = p.wt_ple; K = 256; N = 1024; }
  else if ((t -= 64) < 256) { src = p.ple_gate_w + (size_t)l * 1024 * 1024; dst = p.wt_gate; K = 1024; N = 1024; }
  else if ((t -= 256) < 8) { src = p.decay_w2 + (size_t)l * 64 * 512; dst = p.w2t; K = 64; N = 512; }
  else { t -= 8; src = p.iclr_a2 + (size_t)l * 64 * 512; dst = p.a2t; K = 64; N = 512; }
  const int ntn = N / 64; const int tk = t / ntn, tn = t % ntn;
  tr_tile(src + (size_t)(tk * 64) * N + tn * 64, N, dst + (size_t)(tn * 64) * K + tk * 64, K, sm);
}

DI const float* x_row(const Params& p, int l, int r) {
  if (l == 0) return r < MP ? p.xp + (size_t)r * DM : p.xs + (size_t)(r - MP) * DM;
  return p.out + (size_t)r * DM;
}
DI void cache_item(const Params& p, int l, int c, char* lds) {
  const int tid = tid_();
  if (c < 1024) {
    const float* src = p.ck + (size_t)l * 8 * 1024 * 512 + (size_t)c * 4096 + tid * 16;
    bf16_t* dst = p.kc + (size_t)c * 4096 + tid * 16;
    f32x4 a0 = *(const f32x4*)(src), a1 = *(const f32x4*)(src + 4), a2 = *(const f32x4*)(src + 8), a3 = *(const f32x4*)(src + 12);
    u32x4 o0, o1;
    o0[0] = pk2(a0[0], a0[1]); o0[1] = pk2(a0[2], a0[3]); o0[2] = pk2(a1[0], a1[1]); o0[3] = pk2(a1[2], a1[3]);
    o1[0] = pk2(a2[0], a2[1]); o1[1] = pk2(a2[2], a2[3]); o1[2] = pk2(a3[0], a3[1]); o1[3] = pk2(a3[2], a3[3]);
    *(u32x4*)dst = o0; *(u32x4*)(dst + 8) = o1;
  } else {
    c -= 1024;
    const int bh = c >> 5, tt = c & 31; const int b = bh >> 2, h = bh & 3; const int tk = tt >> 1, tn = tt & 1;
    const float* src = p.cv + (size_t)l * 8 * 1024 * 512 + ((size_t)(b * 1024 + tk * 64)) * 512 + h * 128 + tn * 64;
    bf16_t* dst = p.vct + ((size_t)(bh * 128 + tn * 64)) * 1024 + tk * 64;
    tr_tile(src, 512, dst, 1024, (float*)lds);
  }
}
DI void phase_norm0(const Params& p, char* lds) {
  const int tid = tid_(), wave = __builtin_amdgcn_readfirstlane(tid >> 6), lane = tid & 63;
  const float* g = p.norm_g;
  const int n_norm = MT / 8;
  const int n_items = n_norm + 2048 + WCONV_TILES;
  for (int it = blockIdx.x; it < n_items; it += gridDim.x) {
    if (it < n_norm) {
      const int r0 = it * 8 + wave * 2;
      f32x4 v[2][4]; float ss[2] = {0.f, 0.f};
#pragma unroll
      for (int k = 0; k < 2; ++k) {
        const float* x = x_row(p, 0, r0 + k);
#pragma unroll
        for (int i = 0; i < 4; ++i) v[k][i] = *(const f32x4*)(x + lane * 4 + 256 * i);
      }
      f32x4 gv[4];
#pragma unroll
      for (int i = 0; i < 4; ++i) gv[i] = *(const f32x4*)(g + lane * 4 + 256 * i);
#pragma unroll
      for (int k = 0; k < 2; ++k) {
#pragma unroll
        for (int i = 0; i < 4; ++i) ss[k] += v[k][i][0] * v[k][i][0] + v[k][i][1] * v[k][i][1] + v[k][i][2] * v[k][i][2] + v[k][i][3] * v[k][i][3];
#pragma unroll
        for (int o = 32; o >= 1; o >>= 1) ss[k] += __shfl_xor(ss[k], o);
        const float rstd = rsqrtf(ss[k] * (1.0f / 1024.0f) + 1e-6f);
#pragma unroll
        for (int i = 0; i < 4; ++i) {
          u32x2 o; o[0] = pk2(v[k][i][0] * rstd * gv[i][0], v[k][i][1] * rstd * gv[i][1]); o[1] = pk2(v[k][i][2] * rstd * gv[i][2], v[k][i][3] * rstd * gv[i][3]);
          *(u32x2*)(p.hn + (size_t)(r0 + k) * DM + lane * 4 + 256 * i) = o;
        }
        if (lane == 0) p.ss1[r0 + k] = 1024.0f * (1.0f - 1e-6f);
      }
    } else if (it < n_norm + 2048) {
      cache_item(p, 0, it - n_norm, lds);
    } else {
      wconv_tile(p, 0, it - n_norm - 2048, (float*)lds);
    }
  }
}
DI void zero_f32(float* a, int n) {
  for (int i = blockIdx.x * 256 + tid_(); i < n; i += gridDim.x * 256) a[i] = 0.f;
}

constexpr int GLD = 72;
template <bool A_F32>
DI void gemm_core(f32x4 (&acc)[4][4], const void* Ap, int lda, const bf16_t* Bp, int ldb, int K, char* lds) {
  bf16_t* As = (bf16_t*)lds;
  bf16_t* Bs = (bf16_t*)(lds + 2 * 128 * GLD * 2);
  const int tid = tid_(), wave = __builtin_amdgcn_readfirstlane(tid >> 6), lane = tid & 63;
  const int wm = wave >> 1, wn = wave & 1, l15 = lane & 15, quad = lane >> 4;
  const int nk = K / 64;
  u32x4 ra[4], rb[4];
  auto gload = [&](int kt) {
#pragma unroll
    for (int i = 0; i < 4; ++i) {
      const int c = tid + 256 * i; const int row = c >> 3, c8 = (c & 7) * 8;
      if (!A_F32) ra[i] = *(const u32x4*)((const bf16_t*)Ap + (size_t)row * lda + kt * 64 + c8);
      rb[i] = *(const u32x4*)(Bp + (size_t)row * ldb + kt * 64 + c8);
    }
  };
  auto sstore = [&](int buf, int kt) {
#pragma unroll
    for (int i = 0; i < 4; ++i) {
      const int c = tid + 256 * i; const int row = c >> 3, c8 = (c & 7) * 8;
      if (A_F32) {
        const float* a = (const float*)Ap + (size_t)row * lda + kt * 64 + c8;
        const f32x4 v0 = *(const f32x4*)a, v1 = *(const f32x4*)(a + 4);
        u32x4 t; t[0] = pk2(v0[0], v0[1]); t[1] = pk2(v0[2], v0[3]); t[2] = pk2(v1[0], v1[1]); t[3] = pk2(v1[2], v1[3]);
        *(u32x4*)(As + (buf * 128 + row) * GLD + c8) = t;
      } else {
        *(u32x4*)(As + (buf * 128 + row) * GLD + c8) = ra[i];
      }
      *(u32x4*)(Bs + (buf * 128 + row) * GLD + c8) = rb[i];
    }
  };
  gload(0); sstore(0, 0); __syncthreads();
  for (int kt = 0; kt < nk; ++kt) {
    const int buf = kt & 1;
    if (kt + 1 < nk) gload(kt + 1);
#pragma unroll
    for (int ks = 0; ks < 2; ++ks) {
      bf16x8 af[4], bfr[4];
#pragma unroll
      for (int i = 0; i < 4; ++i) {
        af[i] = *(const bf16x8*)(As + (buf * 128 + wm * 64 + i * 16 + l15) * GLD + ks * 32 + quad * 8);
        bfr[i] = *(const bf16x8*)(Bs + (buf * 128 + wn * 64 + i * 16 + l15) * GLD + ks * 32 + quad * 8);
      }
#pragma unroll
      for (int mi = 0; mi < 4; ++mi)
#pragma unroll
        for (int ni = 0; ni < 4; ++ni) acc[mi][ni] = __builtin_amdgcn_mfma_f32_16x16x32_bf16(bfr[ni], af[mi], acc[mi][ni], 0, 0, 0);
    }
    if (kt + 1 < nk) sstore(buf ^ 1, kt + 1);
    __syncthreads();
  }
}
#define LASP __attribute__((address_space(3)))
DI void gemm_dma(f32x4 (&acc)[4][4], const bf16_t* Ap, int lda, const bf16_t* Bp, int ldb, int K, char* lds) {
  const int tid = tid_(), wave = __builtin_amdgcn_readfirstlane(tid >> 6), lane = tid & 63;
  const int wm = wave >> 1, wn = wave & 1, l15 = lane & 15, quad = lane >> 4;
  const int nk = K / 64;
  const int lrow = lane >> 3, lpc = lane & 7;
  const bf16_t* ga[4]; const bf16_t* gb[4];
#pragma unroll
  for (int i = 0; i < 4; ++i) {
    const int row = (wave * 4 + i) * 8 + lrow; const int q = lpc ^ (row & 7);
    ga[i] = Ap + (size_t)row * lda + q * 8; gb[i] = Bp + (size_t)row * ldb + q * 8;
  }
  auto issue = [&](int kt) {
    char* sb = lds + (kt & 1) * 32768 + wave * 4096;
#pragma unroll
    for (int i = 0; i < 4; ++i) {
      __builtin_amdgcn_global_load_lds((const unsigned*)(ga[i] + kt * 64), (LASP unsigned*)(sb + i * 1024), 16, 0, 0);
      __builtin_amdgcn_global_load_lds((const unsigned*)(gb[i] + kt * 64), (LASP unsigned*)(sb + 16384 + i * 1024), 16, 0, 0);
    }
  };
  const int sw = l15 & 7;
  const unsigned lbase = (unsigned)(size_t)(LASP char*)lds;
  const unsigned a0 = (unsigned)((wm * 64 + l15) * 128 + ((quad ^ sw) * 16)), a1 = (unsigned)((wm * 64 + l15) * 128 + (((4 + quad) ^ sw) * 16));
  const unsigned b0 = 16384u + (unsigned)((wn * 64 + l15) * 128 + ((quad ^ sw) * 16)), b1 = 16384u + (unsigned)((wn * 64 + l15) * 128 + (((4 + quad) ^ sw) * 16));
  asm volatile("s_waitcnt vmcnt(0)" ::: "memory");
  __builtin_amdgcn_s_barrier();
  asm volatile("" ::: "memory");
  issue(0);
  for (int kt = 0; kt < nk; ++kt) {
    asm volatile("s_waitcnt vmcnt(0)" ::: "memory");
    __builtin_amdgcn_s_barrier();
    asm volatile("" ::: "memory");
    if (kt + 1 < nk) issue(kt + 1);
    const unsigned sa = lbase + (unsigned)((kt & 1) * 32768);
    bf16x8 af[4], bfr[4], ag[4], bg[4];
    asm volatile("ds_read_b128 %0, %8\n\tds_read_b128 %1, %8 offset:2048\n\tds_read_b128 %2, %8 offset:4096\n\tds_read_b128 %3, %8 offset:6144\n\t"
                 "ds_read_b128 %4, %9\n\tds_read_b128 %5, %9 offset:2048\n\tds_read_b128 %6, %9 offset:4096\n\tds_read_b128 %7, %9 offset:6144"
                 : "=&v"(af[0]), "=&v"(af[1]), "=&v"(af[2]), "=&v"(af[3]), "=&v"(bfr[0]), "=&v"(bfr[1]), "=&v"(bfr[2]), "=&v"(bfr[3])
                 : "v"(sa + a0), "v"(sa + b0) : "memory");
    asm volatile("ds_read_b128 %0, %16\n\tds_read_b128 %1, %16 offset:2048\n\tds_read_b128 %2, %16 offset:4096\n\tds_read_b128 %3, %16 offset:6144\n\t"
                 "ds_read_b128 %4, %17\n\tds_read_b128 %5, %17 offset:2048\n\tds_read_b128 %6, %17 offset:4096\n\tds_read_b128 %7, %17 offset:6144\n\t"
                 "s_waitcnt lgkmcnt(8)"
                 : "=&v"(ag[0]), "=&v"(ag[1]), "=&v"(ag[2]), "=&v"(ag[3]), "=&v"(bg[0]), "=&v"(bg[1]), "=&v"(bg[2]), "=&v"(bg[3]),
                   "+v"(af[0]), "+v"(af[1]), "+v"(af[2]), "+v"(af[3]), "+v"(bfr[0]), "+v"(bfr[1]), "+v"(bfr[2]), "+v"(bfr[3])
                 : "v"(sa + a1), "v"(sa + b1) : "memory");
#pragma unroll
    for (int mi = 0; mi < 4; ++mi)
#pragma unroll
      for (int ni = 0; ni < 4; ++ni) acc[mi][ni] = __builtin_amdgcn_mfma_f32_16x16x32_bf16(bfr[ni], af[mi], acc[mi][ni], 0, 0, 0);
    asm volatile("s_waitcnt lgkmcnt(0)" : "+v"(ag[0]), "+v"(ag[1]), "+v"(ag[2]), "+v"(ag[3]), "+v"(bg[0]), "+v"(bg[1]), "+v"(bg[2]), "+v"(bg[3]) :: "memory");
#pragma unroll
    for (int mi = 0; mi < 4; ++mi)
#pragma unroll
      for (int ni = 0; ni < 4; ++ni) acc[mi][ni] = __builtin_amdgcn_mfma_f32_16x16x32_bf16(bg[ni], ag[mi], acc[mi][ni], 0, 0, 0);
  }
  asm volatile("" ::: "memory");
  __builtin_amdgcn_s_barrier();
  asm volatile("" ::: "memory");
}
DI void zero_acc(f32x4 (&acc)[4][4]) {
#pragma unroll
  for (int i = 0; i < 4; ++i)
#pragma unroll
    for (int j = 0; j < 4; ++j) acc[i][j] = (f32x4){0.f, 0.f, 0.f, 0.f};
}

DI int xcd_tile(int r, int T) {
  const int x = blockIdx.x & 7, j = blockIdx.x >> 3, nb = gridDim.x >> 3;
  if (j >= nb) return -1;
  const int start = (int)(((long)x * T) / 8), end = (int)(((long)(x + 1) * T) / 8);
  const int g = start + r * nb + j;
  return g < end ? g : -1;
}
DI void tile_decode(int g, int nM, int nN, int& mt, int& nt) {
  const int per = 8 * nN; const int grp = g / per, idx = g - grp * per; const int gm0 = grp * 8;
  const int gsz = (nM - gm0) < 8 ? (nM - gm0) : 8;
  nt = idx / gsz; mt = gm0 + (idx - nt * gsz);
}
DI void phase_gemm_in(const Params& p, int l, char* lds) {
  const int tid = tid_(), wave = __builtin_amdgcn_readfirstlane(tid >> 6), lane = tid & 63;
  const int wm = wave >> 1, wn = wave & 1, l15 = lane & 15, quad = lane >> 4;
  const bf16_t* Wt = p.wt_in;
  const int NTN = 49, NTM = 132;
  for (int r = 0;; ++r) {
    const int g = xcd_tile(r, NTN * NTM); if (g < 0) break;
    int mt, nt; tile_decode(g, NTM, NTN, mt, nt);
    f32x4 acc[4][4]; zero_acc(acc);
    gemm_dma(acc, p.hn + (size_t)mt * 128 * DM, DM, Wt + (size_t)nt * 128 * DM, DM, DM, lds);
    const int colb = nt * 128 + wn * 64 + quad * 4;
    {
#pragma unroll
      for (int mi = 0; mi < 4; ++mi) {
        const float rs = rsqrtf(p.ss1[mt * 128 + wm * 64 + mi * 16 + l15] * (1.0f / 1024.0f) + 1e-6f);
#pragma unroll
        for (int ni = 0; ni < 4; ++ni) acc[mi][ni] = acc[mi][ni] * rs;
      }
    }
    int kind;
    if (nt < 13) kind = 0; else if (nt < 17) kind = 1; else if (nt < 21) kind = 2; else if (nt < 25) kind = 3; else if (nt < 29) kind = 4; else if (nt < 33) kind = 1; else kind = 5;
#pragma unroll
    for (int mi = 0; mi < 4; ++mi) {
      const int R = mt * 128 + wm * 64 + mi * 16 + l15;
      const bool isp = R < MP; const int rs = R - MP;
      bf16_t* zrow = p.z + (size_t)R * NZ;
      if (kind == 0) {
        const bool last = isp ? ((R & 4095) == 4095) : ((rs & 63) == 63);
        float* so = isp ? p.out + O_SP + (size_t)(l * 4 + (R >> 12)) * SHC : p.out + O_SS + (size_t)(l * 8 + (rs >> 6)) * SHC;
#pragma unroll
        for (int ni = 0; ni < 4; ++ni) {
          const int c = colb + ni * 16; const f32x4 v = acc[mi][ni];
          u32x2 o; o[0] = pk2(v[0], v[1]); o[1] = pk2(v[2], v[3]); *(u32x2*)(zrow + c) = o;
          if (last) *(f32x4*)(so + c) = v;
        }
      } else if (kind == 1 || kind == 5) {
#pragma unroll
        for (int ni = 0; ni < 4; ++ni) {
          const int c = colb + ni * 16; f32x4 v = acc[mi][ni];
#pragma unroll
          for (int e = 0; e < 4; ++e) v[e] = (kind == 1) ? siluf_(v[e]) : sigmoidf_(v[e]);
          u32x2 o; o[0] = pk2(v[0], v[1]); o[1] = pk2(v[2], v[3]); *(u32x2*)(zrow + c) = o;
        }
      } else if (kind == 2 || kind == 3) {
        float ss = 0.f;
#pragma unroll
        for (int ni = 0; ni < 4; ++ni) { const f32x4 v = acc[mi][ni]; ss += v[0] * v[0] + v[1] * v[1] + v[2] * v[2] + v[3] * v[3]; }
        ss += __shfl_xor(ss, 16); ss += __shfl_xor(ss, 32);
        const float rstd = rsqrtf(ss * (1.0f / 64.0f) + 1e-6f);
        const float* g = (kind == 2 ? p.qng : p.kng) + l * 64;
        float* ko = isp ? p.out + O_KP + ((size_t)l * MP + R) * 512 : p.out + O_KS + ((size_t)l * MS + rs) * 512;
#pragma unroll
        for (int ni = 0; ni < 4; ++ni) {
          const int c = colb + ni * 16; const int d = ni * 16 + quad * 4;
          const f32x4 gv = *(const f32x4*)(g + d); f32x4 v = acc[mi][ni];
#pragma unroll
          for (int e = 0; e < 4; ++e) v[e] = v[e] * rstd * gv[e];
          u32x2 o; o[0] = pk2(v[0], v[1]); o[1] = pk2(v[2], v[3]); *(u32x2*)(zrow + c) = o;
          if (kind == 3) *(f32x4*)(ko + (c - C_K)) = v;
        }
      } else {
        float* vo = isp ? p.out + O_VP + ((size_t)l * MP + R) * 512 : p.out + O_VS + ((size_t)l * MS + rs) * 512;
#pragma unroll
        for (int ni = 0; ni < 4; ++ni) {
          const int cv = colb + ni * 16 - C_V; const f32x4 v = acc[mi][ni];
          *(f32x4*)(vo + cv) = v;
          const int h = cv >> 7, vd = cv & 127;
          if (isp) {
            bf16_t* vt = p.vtp + ((size_t)(((R >> 12) * 4 + h) * 128 + vd)) * 4096 + (R & 4095);
#pragma unroll
            for (int e = 0; e < 4; ++e) vt[(size_t)e * 4096] = (bf16_t)(pk2(v[e], 0.f) & 0xffff);
          } else {
            bf16_t* vt = p.vts + ((size_t)(((rs >> 6) * 4 + h) * 128 + vd)) * 64 + (rs & 63);
#pragma unroll
            for (int e = 0; e < 4; ++e) vt[(size_t)e * 64] = (bf16_t)(pk2(v[e], 0.f) & 0xffff);
          }
        }
      }
    }
  }
  zero_f32(p.ss2, MT);
  if (l > 0) for (int it = blockIdx.x; it < 320; it += gridDim.x) wconv_tile(p, l, 2080 + it, (float*)lds);
}

constexpr int NCH_P = 4096, NCH = 4224;
constexpr int XLD = 40;
DI f32x4 mm16(const bf16_t* Xrow, int ldx, const bf16_t* Yrow, int ldy, int ksteps, f32x4 acc, int l15, int quad) {
  for (int ks = 0; ks < ksteps; ++ks) {
    const bf16x8 a = *(const bf16x8*)(Xrow + l15 * ldx + ks * 32 + quad * 8);
    const bf16x8 b = *(const bf16x8*)(Yrow + l15 * ldy + ks * 32 + quad * 8);
    acc = __builtin_amdgcn_mfma_f32_16x16x32_bf16(a, b, acc, 0, 0, 0);
  }
  return acc;
}
DI void chunk_item(const Params& p, int l, int item, char* lds) {
  const int tid = tid_(), wave = __builtin_amdgcn_readfirstlane(tid >> 6), lane = tid & 63, l15 = lane & 15, quad = lane >> 4;
  const bool isp = item < NCH_P;
  int bh, c;
  if (isp) { bh = item >> 7; c = item & 127; } else { const int j = item - NCH_P; bh = j >> 1; c = j & 1; }
  const int b = bh >> 3, h = bh & 7;
  const int t0 = c * 32; const int row0 = (isp ? b * 4096 : MP + b * 64) + t0;
  float* s_r = (float*)lds;
  float* s_kf = s_r + 2048;
  float* s_v = s_kf + 2048;
  float* s_w = s_v + 2048;
  float* s_kk = s_w + 2048;
  float* s_bb = s_kk + 2048;
  bf16_t* s_wd = (bf16_t*)(lds + 49152);
  bf16_t* s_ad = (bf16_t*)(lds + 53760);
  float* s_bonus = (float*)(lds + 58368);
  float* s_wl = (float*)(lds + 58880);
  float* s_rhs = (float*)lds;
  bf16_t* s_A = (bf16_t*)lds;
  bf16_t* s_Bm = (bf16_t*)(lds + 4608);
  bf16_t* s_Kp = (bf16_t*)(lds + 9216);
  bf16_t* s_R = (bf16_t*)(lds + 16384);
  bf16_t* s_BmT = (bf16_t*)(lds + 20992);
  bf16_t* s_KpT = (bf16_t*)(lds + 26112);
  bf16_t* s_VmT = (bf16_t*)(lds + 31232);
  bf16_t* s_Lak = (bf16_t*)(lds + 36352);
  bf16_t* s_Mrk = (bf16_t*)(lds + 38912);
  bf16_t* s_Mrb = (bf16_t*)(lds + 41472);
  float* s_labT = (float*)(lds + 44032);
  bf16_t* s_XT = (bf16_t*)(lds + 48640);

  const int mat = wave >> 1, tt = wave & 1;
  const bf16_t* wl = (mat == 0 ? p.w2t : p.a2t) + (size_t)(h * 64) * 64;
  const float* mu = p.shift_mu + l * SHC;
  const float* w0 = p.decay_w0 + l * 512 + h * 64;
  const float* a0 = p.iclr_a0 + l * 512 + h * 64;
  const float* kkp = p.k_k + l * 512 + h * 64;
  const float* kap = p.k_a + l * 512 + h * 64;
  const float* rkp = p.r_k + l * 512 + h * 64;
  const float* lb = p.lnx_b + l * 512 + h * 64;
  const int ptok = tid >> 3, pcs = (tid & 7) * 8;
  {
    const int t = t0 + ptok; const size_t row = (size_t)(row0 + ptok);
#pragma unroll
    for (int g = 0; g < 5; ++g) {
      const int zc = (g < 3 ? g * 512 + h * 64 : 1536 + (g - 3) * 64) + pcs;
      const u32x4 cu = *(const u32x4*)(p.z + row * NZ + zc);
      float cur[8], prv[8];
#pragma unroll
      for (int e = 0; e < 4; ++e) { cur[2 * e] = bf_lo(cu[e]); cur[2 * e + 1] = bf_hi(cu[e]); }
      if (t > 0) {
        const u32x4 pu = *(const u32x4*)(p.z + (row - 1) * NZ + zc);
#pragma unroll
        for (int e = 0; e < 4; ++e) { prv[2 * e] = bf_lo(pu[e]); prv[2 * e + 1] = bf_hi(pu[e]); }
      } else if (isp) {
#pragma unroll
        for (int e = 0; e < 8; ++e) prv[e] = 0.f;
      } else {
        const float* sp = p.sshift + (size_t)(l * 8 + b) * SHC + zc;
#pragma unroll
        for (int e = 0; e < 8; ++e) prv[e] = sp[e];
      }
      float zs[8];
#pragma unroll
      for (int e = 0; e < 8; ++e) zs[e] = cur[e] + (prv[e] - cur[e]) * mu[zc + e];
      if (g < 3) {
        float* d = (g == 0 ? s_r : g == 1 ? s_kf : s_v) + ptok * 64 + pcs;
        *(f32x4*)d = (f32x4){zs[0], zs[1], zs[2], zs[3]}; *(f32x4*)(d + 4) = (f32x4){zs[4], zs[5], zs[6], zs[7]};
      } else {
        if (g == 3) {
#pragma unroll
          for (int e = 0; e < 8; ++e) { const float ex = __expf(2.f * zs[e]); zs[e] = 1.f - 2.f * __builtin_amdgcn_rcpf(ex + 1.f); }
        }
        u32x4 o; o[0] = pk2(zs[0], zs[1]); o[1] = pk2(zs[2], zs[3]); o[2] = pk2(zs[4], zs[5]); o[3] = pk2(zs[6], zs[7]);
        *(u32x4*)((g == 3 ? s_wd : s_ad) + ptok * 72 + pcs) = o;
      }
    }
  }
  __syncthreads();
  {
    const bf16_t* At = (mat == 0 ? s_wd : s_ad);
    bf16x8 af[2];
#pragma unroll
    for (int ks = 0; ks < 2; ++ks) af[ks] = *(const bf16x8*)(At + (tt * 16 + l15) * 72 + ks * 32 + quad * 8);
#pragma unroll
    for (int ct = 0; ct < 4; ++ct) {
      f32x4 d = (f32x4){0.f, 0.f, 0.f, 0.f};
#pragma unroll
      for (int ks = 0; ks < 2; ++ks) {
        const bf16x8 wfr = *(const bf16x8*)(wl + (size_t)(ct * 16 + l15) * 64 + ks * 32 + quad * 8);
        d = __builtin_amdgcn_mfma_f32_16x16x32_bf16(wfr, af[ks], d, 0, 0, 0);
      }
      const int ch = ct * 16 + quad * 4; const int tok = tt * 16 + l15;
      f32x4 o;
      if (mat == 0) {
#pragma unroll
        for (int e = 0; e < 4; ++e) {
          const float y = -(w0[ch + e] + d[e]);
          const float sp = fmaxf(y, 0.f) + __logf(1.0f + __expf(-fabsf(y)));
          o[e] = -__expf(-sp - 0.5f);
        }
        *(f32x4*)(s_w + tok * 64 + ch) = o;
      } else {
#pragma unroll
        for (int e = 0; e < 4; ++e) o[e] = sigmoidf_(a0[ch + e] + d[e]);
        *(f32x4*)(s_bb + tok * 64 + ch) = o;
      }
    }
  }
  __syncthreads();
  float r_[8], kf[8], kk[8], bbv[8], v_[8], bon;
  {
    float k_[8], a_[8];
    *(f32x4*)&k_[0] = *(const f32x4*)(s_kf + ptok * 64 + pcs); *(f32x4*)&k_[4] = *(const f32x4*)(s_kf + ptok * 64 + pcs + 4);
    *(f32x4*)&a_[0] = *(const f32x4*)(s_bb + ptok * 64 + pcs); *(f32x4*)&a_[4] = *(const f32x4*)(s_bb + ptok * 64 + pcs + 4);
    *(f32x4*)&r_[0] = *(const f32x4*)(s_r + ptok * 64 + pcs); *(f32x4*)&r_[4] = *(const f32x4*)(s_r + ptok * 64 + pcs + 4);
    *(f32x4*)&v_[0] = *(const f32x4*)(s_v + ptok * 64 + pcs); *(f32x4*)&v_[4] = *(const f32x4*)(s_v + ptok * 64 + pcs + 4);
    float ss = 0.f; bon = 0.f;
#pragma unroll
    for (int e = 0; e < 8; ++e) {
      kk[e] = k_[e] * kkp[pcs + e]; ss += kk[e] * kk[e];
      kf[e] = k_[e] * (1.f + (a_[e] - 1.f) * kap[pcs + e]);
      bon += r_[e] * kf[e] * rkp[pcs + e];
    }
    ss += __shfl_xor(ss, 1); ss += __shfl_xor(ss, 2); ss += __shfl_xor(ss, 4);
    bon += __shfl_xor(bon, 1); bon += __shfl_xor(bon, 2); bon += __shfl_xor(bon, 4);
    const float inv = 1.0f / fmaxf(sqrtf(ss), 1e-12f);
#pragma unroll
    for (int e = 0; e < 8; ++e) { kk[e] *= inv; bbv[e] = kk[e] * a_[e]; }
  }
  if (tid < 64) {
    float run = 0.f;
#pragma unroll 8
    for (int t = 0; t < 32; ++t) { run += s_w[t * 64 + tid]; s_w[t * 64 + tid] = run; }
  }
  __syncthreads();
  {
    float cw[8], cwp[8];
    *(f32x4*)&cw[0] = *(const f32x4*)(s_w + ptok * 64 + pcs); *(f32x4*)&cw[4] = *(const f32x4*)(s_w + ptok * 64 + pcs + 4);
    if (ptok > 0) { *(f32x4*)&cwp[0] = *(const f32x4*)(s_w + (ptok - 1) * 64 + pcs); *(f32x4*)&cwp[4] = *(const f32x4*)(s_w + (ptok - 1) * 64 + pcs + 4); }
    else {
#pragma unroll
      for (int e = 0; e < 8; ++e) cwp[e] = 0.f;
    }
    __syncthreads();
    float av[8], bm[8], kp[8], rr[8];
#pragma unroll
    for (int e = 0; e < 8; ++e) {
      const float ec = __expf(cw[e]), en = __expf(-cw[e]), ep = __expf(cwp[e]);
      av[e] = kk[e] * ep; bm[e] = bbv[e] * en; kp[e] = kf[e] * en; rr[e] = r_[e] * ec;
      if (ptok == 31) s_wl[pcs + e] = ec;
    }
    u32x4 o;
    o[0] = pk2(av[0], av[1]); o[1] = pk2(av[2], av[3]); o[2] = pk2(av[4], av[5]); o[3] = pk2(av[6], av[7]); *(u32x4*)(s_A + ptok * 72 + pcs) = o;
    o[0] = pk2(bm[0], bm[1]); o[1] = pk2(bm[2], bm[3]); o[2] = pk2(bm[4], bm[5]); o[3] = pk2(bm[6], bm[7]); *(u32x4*)(s_Bm + ptok * 72 + pcs) = o;
#pragma unroll
    for (int e = 0; e < 4; ++e) { s_BmT[(pcs + 2 * e) * XLD + ptok] = (bf16_t)(o[e] & 0xffff); s_BmT[(pcs + 2 * e + 1) * XLD + ptok] = (bf16_t)(o[e] >> 16); }
    o[0] = pk2(kp[0], kp[1]); o[1] = pk2(kp[2], kp[3]); o[2] = pk2(kp[4], kp[5]); o[3] = pk2(kp[6], kp[7]); *(u32x4*)(s_Kp + ptok * 72 + pcs) = o;
#pragma unroll
    for (int e = 0; e < 4; ++e) { s_KpT[(pcs + 2 * e) * XLD + ptok] = (bf16_t)(o[e] & 0xffff); s_KpT[(pcs + 2 * e + 1) * XLD + ptok] = (bf16_t)(o[e] >> 16); }
    o[0] = pk2(rr[0], rr[1]); o[1] = pk2(rr[2], rr[3]); o[2] = pk2(rr[4], rr[5]); o[3] = pk2(rr[6], rr[7]); *(u32x4*)(s_R + ptok * 72 + pcs) = o;
    o[0] = pk2(v_[0], v_[1]); o[1] = pk2(v_[2], v_[3]); o[2] = pk2(v_[4], v_[5]); o[3] = pk2(v_[6], v_[7]);
#pragma unroll
    for (int e = 0; e < 4; ++e) { s_VmT[(pcs + 2 * e) * XLD + ptok] = (bf16_t)(o[e] & 0xffff); s_VmT[(pcs + 2 * e + 1) * XLD + ptok] = (bf16_t)(o[e] >> 16); }
    u32x4 ob;
    ob[0] = pk2(lb[pcs + 0] + bon * v_[0], lb[pcs + 1] + bon * v_[1]); ob[1] = pk2(lb[pcs + 2] + bon * v_[2], lb[pcs + 3] + bon * v_[3]);
    ob[2] = pk2(lb[pcs + 4] + bon * v_[4], lb[pcs + 5] + bon * v_[5]); ob[3] = pk2(lb[pcs + 6] + bon * v_[6], lb[pcs + 7] + bon * v_[7]);
    *(u32x4*)(p.cBA + ((size_t)item * 32 + ptok) * 64 + pcs) = ob;
  }
  __syncthreads();
  {
    const bf16_t* X = (wave < 2) ? s_A : s_R;
    const bf16_t* Y = (wave == 0 || wave == 3) ? s_Bm : s_Kp;
    const bool strict = wave < 2;
#pragma unroll
    for (int ti = 0; ti < 2; ++ti)
#pragma unroll
      for (int ii = 0; ii < 2; ++ii) {
        f32x4 d = (f32x4){0.f, 0.f, 0.f, 0.f};
        if (ii <= ti) d = mm16(X + ti * 16 * 72, 72, Y + ii * 16 * 72, 72, 2, d, l15, quad);
        const int i = ii * 16 + l15;
#pragma unroll
        for (int e = 0; e < 4; ++e) {
          const int t = ti * 16 + quad * 4 + e;
          const bool keep = strict ? (i < t) : (i <= t);
          const float val = keep ? d[e] : 0.f;
          if (wave == 0) s_labT[i * 36 + t] = val;
          else { bf16_t* dst = (wave == 1 ? s_Lak : wave == 2 ? s_Mrk : s_Mrb); dst[t * XLD + i] = (bf16_t)(pk2(val, 0.f) & 0xffff); }
        }
      }
  }
  const u32x4 acap = *(const u32x4*)(s_A + ptok * 72 + pcs);
  __syncthreads();
  {
    float* d = s_rhs + ptok * 128 + pcs;
    *(f32x4*)d = (f32x4){bf_lo(acap[0]), bf_hi(acap[0]), bf_lo(acap[1]), bf_hi(acap[1])};
    *(f32x4*)(d + 4) = (f32x4){bf_lo(acap[2]), bf_hi(acap[2]), bf_lo(acap[3]), bf_hi(acap[3])};
  }
  {
    const int ti = wave & 1;
#pragma unroll
    for (int vv = 0; vv < 2; ++vv) {
      const int vi = (wave >> 1) * 2 + vv;
      f32x4 d = (f32x4){0.f, 0.f, 0.f, 0.f};
      d = mm16(s_Lak + ti * 16 * XLD, XLD, s_VmT + vi * 16 * XLD, XLD, 1, d, l15, quad);
#pragma unroll
      for (int e = 0; e < 4; ++e) s_rhs[(ti * 16 + quad * 4 + e) * 128 + 64 + vi * 16 + l15] = d[e];
    }
  }
  __syncthreads();
  if (tid < 128) {
    float x[32];
#pragma unroll
    for (int t = 0; t < 32; ++t) x[t] = s_rhs[t * 128 + tid];
#pragma unroll
    for (int i = 0; i < 31; ++i) {
      const float xi = x[i];
#pragma unroll
      for (int t4 = ((i + 1) >> 2); t4 < 8; ++t4) {
        const f32x4 lv = *(const f32x4*)(s_labT + i * 36 + t4 * 4);
#pragma unroll
        for (int e = 0; e < 4; ++e) { const int t = t4 * 4 + e; if (t > i) x[t] -= lv[e] * xi; }
      }
    }
#pragma unroll
    for (int q4 = 0; q4 < 4; ++q4) {
      u32x4 o; o[0] = pk2(x[8 * q4], x[8 * q4 + 1]); o[1] = pk2(x[8 * q4 + 2], x[8 * q4 + 3]); o[2] = pk2(x[8 * q4 + 4], x[8 * q4 + 5]); o[3] = pk2(x[8 * q4 + 6], x[8 * q4 + 7]);
      *(u32x4*)(s_XT + tid * XLD + q4 * 8) = o;
    }
  }
  __syncthreads();
  {
    const f32x4 z4 = (f32x4){0.f, 0.f, 0.f, 0.f};
    bf16_t* gPT = p.cPT + (size_t)item * 4096;
    const float wl_c = s_wl[wave * 16 + l15];
#pragma unroll
    for (int k1t = 0; k1t < 4; ++k1t) {
      f32x4 d = mm16(s_XT + k1t * 16 * XLD, XLD, s_BmT + wave * 16 * XLD, XLD, 1, z4, l15, quad);
      const int k2 = wave * 16 + l15, k1 = k1t * 16 + quad * 4;
      float o[4];
#pragma unroll
      for (int e = 0; e < 4; ++e) o[e] = ((k1 + e == k2 ? 1.f : 0.f) - d[e]) * wl_c;
      u32x2 ov; ov[0] = pk2(o[0], o[1]); ov[1] = pk2(o[2], o[3]);
      *(u32x2*)(gPT + k2 * 64 + k1) = ov;
    }
    bf16_t* gG = p.cG + (size_t)item * 4096;
#pragma unroll
    for (int k2t = 0; k2t < 4; ++k2t) {
      const f32x4 d1 = mm16(s_KpT + k2t * 16 * XLD, XLD, s_VmT + wave * 16 * XLD, XLD, 1, z4, l15, quad);
      const f32x4 d2 = mm16(s_BmT + k2t * 16 * XLD, XLD, s_XT + (64 + wave * 16) * XLD, XLD, 1, z4, l15, quad);
      const int k2 = k2t * 16 + quad * 4, v = wave * 16 + l15;
      const f32x4 wv = *(const f32x4*)(s_wl + k2);
      u32x2 ov; ov[0] = pk2((d1[0] - d2[0]) * wv[0], (d1[1] - d2[1]) * wv[1]); ov[1] = pk2((d1[2] - d2[2]) * wv[2], (d1[3] - d2[3]) * wv[3]);
      *(u32x2*)(gG + v * 64 + k2) = ov;
    }
    bf16_t* gRT = p.cRT + (size_t)item * 2048;
    bf16_t* gOI = p.cOI + (size_t)item * 2048;
#pragma unroll
    for (int ti = 0; ti < 2; ++ti) {
      const f32x4 d = mm16(s_XT + wave * 16 * XLD, XLD, s_Mrb + ti * 16 * XLD, XLD, 1, z4, l15, quad);
      const int t = ti * 16 + l15, k = wave * 16 + quad * 4;
      const u32x2 rv = *(const u32x2*)(s_R + t * 72 + k);
      u32x2 ov; ov[0] = pk2(bf_lo(rv[0]) - d[0], bf_hi(rv[0]) - d[1]); ov[1] = pk2(bf_lo(rv[1]) - d[2], bf_hi(rv[1]) - d[3]);
      *(u32x2*)(gRT + t * 64 + k) = ov;
      const f32x4 e1 = mm16(s_VmT + wave * 16 * XLD, XLD, s_Mrk + ti * 16 * XLD, XLD, 1, z4, l15, quad);
      const f32x4 e2 = mm16(s_XT + (64 + wave * 16) * XLD, XLD, s_Mrb + ti * 16 * XLD, XLD, 1, z4, l15, quad);
      u32x2 oo; oo[0] = pk2(e1[0] - e2[0], e1[1] - e2[1]); oo[1] = pk2(e1[2] - e2[2], e1[3] - e2[3]);
      *(u32x2*)(gOI + t * 64 + k) = oo;
    }
  }
  __syncthreads();
}

DI void rec_item(const Params& p, int l, int item, char* lds) {
  const int tid = tid_(), wave = __builtin_amdgcn_readfirstlane(tid >> 6), lane = tid & 63, l15 = lane & 15, quad = lane >> 4;
  const bool isp = item < 32;
  const int bh = isp ? item : item - 32; const int b = bh >> 3, h = bh & 7;
  const int nch = isp ? 128 : 2; const int cid0 = isp ? bh * 128 : NCH_P + bh * 2;
  bf16_t* Sb = (bf16_t*)lds;
  const unsigned lbase = (unsigned)(size_t)(LASP char*)lds;
  __syncthreads();
  if (wave < 2) {
    f32x4 acc[2][4];
#pragma unroll
    for (int v2 = 0; v2 < 2; ++v2) {
      const int v = (wave * 2 + v2) * 16 + l15;
      if (isp) {
#pragma unroll
        for (int nk = 0; nk < 4; ++nk) acc[v2][nk] = (f32x4){0.f, 0.f, 0.f, 0.f};
      } else {
        const float* sp = p.swkv + (((size_t)(l * 8 + b) * 8 + h) * 64 + v) * 64;
#pragma unroll
        for (int nk = 0; nk < 4; ++nk) acc[v2][nk] = *(const f32x4*)(sp + nk * 16 + quad * 4);
      }
#pragma unroll
      for (int nk = 0; nk < 4; ++nk) {
        u32x2 o; o[0] = pk2(acc[v2][nk][0], acc[v2][nk][1]); o[1] = pk2(acc[v2][nk][2], acc[v2][nk][3]);
        *(u32x2*)(Sb + v * 72 + nk * 16 + quad * 4) = o;
        *(u32x2*)(p.gS + (size_t)cid0 * 4096 + v * 64 + nk * 16 + quad * 4) = o;
      }
    }
    const int nmain = nch - 2;
    struct PS { bf16x8 pt[4][2]; u32x2 gv[2][4]; };
    auto ldp = [&](PS& s, int c) {
      const int cc = c < nch ? c : nch - 1;
      const size_t cid = (size_t)(cid0 + cc);
      const bf16_t* gPT = p.cPT + cid * 4096; const bf16_t* gG = p.cG + cid * 4096;
#pragma unroll
      for (int nk = 0; nk < 4; ++nk) {
#pragma unroll
        for (int ks = 0; ks < 2; ++ks) s.pt[nk][ks] = *(const bf16x8*)(gPT + (nk * 16 + l15) * 64 + ks * 32 + quad * 8);
#pragma unroll
        for (int v2 = 0; v2 < 2; ++v2) s.gv[v2][nk] = *(const u32x2*)(gG + ((wave * 2 + v2) * 16 + l15) * 64 + nk * 16 + quad * 4);
      }
    };
    auto step = [&](PS& s, int c) {
      const int buf = c & 1;
      bf16x8 sf[2][2];
      {
        const unsigned sad = lbase + (unsigned)(((buf * 64 + wave * 32 + l15) * 72 + quad * 8) * 2);
        asm volatile("ds_read_b128 %0, %4\n\tds_read_b128 %1, %4 offset:64\n\tds_read_b128 %2, %4 offset:2304\n\tds_read_b128 %3, %4 offset:2368\n\ts_waitcnt lgkmcnt(0)"
                     : "=&v"(sf[0][0]), "=&v"(sf[0][1]), "=&v"(sf[1][0]), "=&v"(sf[1][1]) : "v"(sad) : "memory");
      }
#pragma unroll
      for (int v2 = 0; v2 < 2; ++v2) {
#pragma unroll
        for (int nk = 0; nk < 4; ++nk) {
          f32x4 a = (f32x4){bf_lo(s.gv[v2][nk][0]), bf_hi(s.gv[v2][nk][0]), bf_lo(s.gv[v2][nk][1]), bf_hi(s.gv[v2][nk][1])};
#pragma unroll
          for (int ks = 0; ks < 2; ++ks) a = __builtin_amdgcn_mfma_f32_16x16x32_bf16(s.pt[nk][ks], sf[v2][ks], a, 0, 0, 0);
          acc[v2][nk] = a;
        }
      }
      ldp(s, c + 3);
      const size_t scid = (c + 1 < nch) ? (size_t)(cid0 + c + 1) : (size_t)NCH;
#pragma unroll
      for (int v2 = 0; v2 < 2; ++v2) {
        const int v = (wave * 2 + v2) * 16 + l15;
#pragma unroll
        for (int nk = 0; nk < 4; ++nk) {
          u32x2 ov; ov[0] = pk2(acc[v2][nk][0], acc[v2][nk][1]); ov[1] = pk2(acc[v2][nk][2], acc[v2][nk][3]);
          *(u32x2*)(Sb + ((buf ^ 1) * 64 + v) * 72 + nk * 16 + quad * 4) = ov;
          *(u32x2*)(p.gS + scid * 4096 + v * 64 + nk * 16 + quad * 4) = ov;
        }
      }
      asm volatile("s_waitcnt lgkmcnt(0)" ::: "memory");
    };
    PS s0, s1, s2;
    ldp(s0, 0); ldp(s1, 1); ldp(s2, 2);
#pragma unroll 1
    for (int c = 0; c < nmain; c += 3) { step(s0, c); step(s1, c + 1); step(s2, c + 2); }
    step(s0, nmain); step(s1, nmain + 1);
#pragma unroll
    for (int v2 = 0; v2 < 2; ++v2) {
      const int v = (wave * 2 + v2) * 16 + l15;
      float* so = (isp ? p.out + O_WP + (((size_t)(l * 4 + b) * 8 + h) * 64 + v) * 64 : p.out + O_WS + (((size_t)(l * 8 + b) * 8 + h) * 64 + v) * 64);
#pragma unroll
      for (int nk = 0; nk < 4; ++nk) *(f32x4*)(so + nk * 16 + quad * 4) = acc[v2][nk];
    }
  }
  __syncthreads();
}
DI void phase_o(const Params& p, int l) {
  const int tid = tid_(), wave = __builtin_amdgcn_readfirstlane(tid >> 6), lane = tid & 63, l15 = lane & 15, quad = lane >> 4;
  for (int pi = blockIdx.x; pi < NCH / 2; pi += gridDim.x) {
    const int cid = pi * 2 + (wave >> 1);
    const bool isp = cid < NCH_P;
    int bh, c;
    if (isp) { bh = cid >> 7; c = cid & 127; } else { const int j = cid - NCH_P; bh = j >> 1; c = j & 1; }
    const int b = bh >> 3, h = bh & 7;
    const int tok = (wave & 1) * 16 + l15;
    const size_t row = (size_t)((isp ? b * 4096 : MP + b * 64) + c * 32 + tok);
    bf16x8 rt[2], sa[4][2]; u32x2 oi[4], ba[4], gt[4];
#pragma unroll
    for (int ks = 0; ks < 2; ++ks) rt[ks] = *(const bf16x8*)(p.cRT + (size_t)cid * 2048 + tok * 64 + ks * 32 + quad * 8);
#pragma unroll
    for (int vt = 0; vt < 4; ++vt) {
#pragma unroll
      for (int ks = 0; ks < 2; ++ks) sa[vt][ks] = *(const bf16x8*)(p.gS + (size_t)cid * 4096 + (vt * 16 + l15) * 64 + ks * 32 + quad * 8);
      oi[vt] = *(const u32x2*)(p.cOI + (size_t)cid * 2048 + tok * 64 + vt * 16 + quad * 4);
      ba[vt] = *(const u32x2*)(p.cBA + (size_t)cid * 2048 + tok * 64 + vt * 16 + quad * 4);
      gt[vt] = *(const u32x2*)(p.z + row * NZ + C_GR + h * 64 + vt * 16 + quad * 4);
    }
    f32x4 ao[4];
#pragma unroll
    for (int vt = 0; vt < 4; ++vt) {
      f32x4 a = (f32x4){bf_lo(oi[vt][0]), bf_hi(oi[vt][0]), bf_lo(oi[vt][1]), bf_hi(oi[vt][1])};
#pragma unroll
      for (int ks = 0; ks < 2; ++ks) a = __builtin_amdgcn_mfma_f32_16x16x32_bf16(sa[vt][ks], rt[ks], a, 0, 0, 0);
      ao[vt] = a;
    }
    float sm = 0.f, sq = 0.f;
#pragma unroll
    for (int vt = 0; vt < 4; ++vt)
#pragma unroll
      for (int e = 0; e < 4; ++e) { sm += ao[vt][e]; sq += ao[vt][e] * ao[vt][e]; }
    { const float a1 = __shfl_xor(sm, 16), b1 = __shfl_xor(sq, 16); sm += a1; sq += b1; }
    { const float a1 = __shfl_xor(sm, 32), b1 = __shfl_xor(sq, 32); sm += a1; sq += b1; }
    const float mean = sm * (1.0f / 64.0f);
    const float rstd = rsqrtf(fmaxf(sq * (1.0f / 64.0f) - mean * mean, 0.f) + 64e-5f);
    const float* lg = p.lnx_g + l * 512 + h * 64;
#pragma unroll
    for (int vt = 0; vt < 4; ++vt) {
      const int vv = vt * 16 + quad * 4;
      const f32x4 g4 = *(const f32x4*)(lg + vv);
      const float y0 = ((ao[vt][0] - mean) * rstd * g4[0] + bf_lo(ba[vt][0])) * bf_lo(gt[vt][0]);
      const float y1 = ((ao[vt][1] - mean) * rstd * g4[1] + bf_hi(ba[vt][0])) * bf_hi(gt[vt][0]);
      const float y2 = ((ao[vt][2] - mean) * rstd * g4[2] + bf_lo(ba[vt][1])) * bf_lo(gt[vt][1]);
      const float y3 = ((ao[vt][3] - mean) * rstd * g4[3] + bf_hi(ba[vt][1])) * bf_hi(gt[vt][1]);
      u32x2 ov; ov[0] = pk2(y0, y1); ov[1] = pk2(y2, y3);
      *(u32x2*)(p.o_r + row * 512 + h * 64 + vv) = ov;
    }
  }
}
DI void phase_chunk(const Params& p, int l, char* lds) {
  for (int it = blockIdx.x; it < NCH; it += gridDim.x) chunk_item(p, l, it, lds);
  zero_f32(p.ss1, MT);
}

constexpr int ALD = 72;
DI void attn_item(const Params& p, int l, int item, char* lds) {
  const int tid = tid_(), wave = __builtin_amdgcn_readfirstlane(tid >> 6), lane = tid & 63;
  const int m = wave & 1, qh = wave >> 1, q = lane & 31, hh = lane >> 5;
  bf16_t* Ks = (bf16_t*)lds;
  bf16_t* Vs = Ks + 2 * 64 * ALD;
  float* xb = (float*)lds;
  bool samp; int b, h, nch, qrow0, qpos0;
  const int xq = item & 7, tk = item >> 3;
  if (tk < 4) { samp = true; const int bhs = xq + 8 * tk; b = bhs >> 2; h = bhs & 3; nch = 17; qrow0 = MP + b * 64; qpos0 = 1024; }
  else { samp = false; const int kk = tk - 4; const int qc = 63 - (kk >> 1); const int bh = xq + 8 * (kk & 1); b = bh >> 2; h = bh & 3; nch = qc + 1; qrow0 = b * 4096 + qc * 64; qpos0 = qc * 64; }
  bf16x8 qf[4];
  {
    const bf16_t* qp = p.z + (size_t)(qrow0 + qh * 32 + q) * NZ + C_Q + h * 128 + m * 64;
#pragma unroll
    for (int ks = 0; ks < 4; ++ks) qf[ks] = *(const bf16x8*)(qp + ks * 16 + hh * 8);
  }
  const float slope = exp2f(-2.0f * (float)(h + 1));
  const float LOG2E = 1.4426950408889634f;
  const float c1 = 0.125f * LOG2E, sl2 = slope * LOG2E;
  const float qposf = (float)(qpos0 + qh * 32 + q);
  f32x16 O[4];
#pragma unroll
  for (int i = 0; i < 4; ++i)
#pragma unroll
    for (int e = 0; e < 16; ++e) O[i][e] = 0.f;
  float mrun = -1e30f, lrun = 0.f;
  u32x4 rk[4], rv[4];
  auto gload = [&](int j) {
    const bf16_t* kb; size_t kld; const bf16_t* vb; size_t vld;
    if (!samp) { kb = p.z + (size_t)(b * 4096 + j * 64) * NZ + C_K + h * 128; kld = NZ; vb = p.vtp + (size_t)((b * 4 + h) * 128) * 4096 + j * 64; vld = 4096; }
    else if (j < 16) { kb = p.kc + (size_t)(b * 1024 + j * 64) * 512 + h * 128; kld = 512; vb = p.vct + (size_t)((b * 4 + h) * 128) * 1024 + j * 64; vld = 1024; }
    else { kb = p.z + (size_t)(MP + b * 64) * NZ + C_K + h * 128; kld = NZ; vb = p.vts + (size_t)((b * 4 + h) * 128) * 64; vld = 64; }
#pragma unroll
    for (int i = 0; i < 4; ++i) {
      const int c = tid + 256 * i;
      const int mm = c >> 9, key = (c >> 3) & 63, d8 = (c & 7) * 8;
      rk[i] = *(const u32x4*)(kb + (size_t)key * kld + mm * 64 + d8);
      const int vd = c >> 3, k8 = (c & 7) * 8;
      rv[i] = *(const u32x4*)(vb + (size_t)vd * vld + k8);
    }
  };
  auto sstore = [&]() {
#pragma unroll
    for (int i = 0; i < 4; ++i) {
      const int c = tid + 256 * i;
      const int mm = c >> 9, key = (c >> 3) & 63, d8 = (c & 7) * 8;
      *(u32x4*)(Ks + (mm * 64 + key) * ALD + d8) = rk[i];
      const int vd = c >> 3, k8 = (c & 7) * 8;
      *(u32x4*)(Vs + vd * ALD + k8) = rv[i];
    }
  };
  gload(0); sstore(); __syncthreads();
  for (int j = 0; j < nch; ++j) {
    if (j + 1 < nch) gload(j + 1);
    f32x16 s[2];
#pragma unroll
    for (int kt = 0; kt < 2; ++kt) {
#pragma unroll
      for (int e = 0; e < 16; ++e) s[kt][e] = 0.f;
#pragma unroll
      for (int ks = 0; ks < 4; ++ks) {
        const bf16x8 kf = *(const bf16x8*)(Ks + (m * 64 + kt * 32 + q) * ALD + ks * 16 + hh * 8);
        s[kt] = __builtin_amdgcn_mfma_f32_32x32x16_bf16(kf, qf[ks], s[kt], 0, 0, 0);
      }
    }
    float mx = -1e30f;
    const float dbase = qposf - (float)(j * 64 + 4 * hh);
#pragma unroll
    for (int kt = 0; kt < 2; ++kt)
#pragma unroll
      for (int e = 0; e < 16; ++e) {
        const float dd = dbase - (float)(kt * 32 + (e & 3) + 8 * (e >> 2));
        const float v = s[kt][e] * c1 - sl2 * fabsf(dd);
        s[kt][e] = v; mx = fmaxf(mx, v);
      }
    mx = fmaxf(mx, __shfl_xor(mx, 32));
    const float mnew = fmaxf(mrun, mx);
    const float alpha = __builtin_amdgcn_exp2f(mrun - mnew);
    const bool resc = mnew > mrun;
    mrun = mnew;
    float ps = 0.f;
#pragma unroll
    for (int kt = 0; kt < 2; ++kt)
#pragma unroll
      for (int e = 0; e < 16; ++e) { const float pe = __builtin_amdgcn_exp2f(s[kt][e] - mnew); s[kt][e] = pe; ps += pe; }
    lrun = lrun * alpha + ps;
    if (__any(resc)) {
#pragma unroll
      for (int i = 0; i < 4; ++i)
#pragma unroll
        for (int e = 0; e < 16; ++e) O[i][e] *= alpha;
    }
#pragma unroll
    for (int kt = 0; kt < 2; ++kt)
#pragma unroll
      for (int sx = 0; sx < 2; ++sx) {
        u32x4 pb;
        pb[0] = pk2(s[kt][8 * sx + 0], s[kt][8 * sx + 1]); pb[1] = pk2(s[kt][8 * sx + 2], s[kt][8 * sx + 3]);
        pb[2] = pk2(s[kt][8 * sx + 4], s[kt][8 * sx + 5]); pb[3] = pk2(s[kt][8 * sx + 6], s[kt][8 * sx + 7]);
        const bf16x8 pf = __builtin_bit_cast(bf16x8, pb);
#pragma unroll
        for (int vt = 0; vt < 4; ++vt) {
          const bf16_t* vp = Vs + (vt * 32 + q) * ALD + kt * 32 + 16 * sx + 4 * hh;
          const s16x4 lo = *(const s16x4*)vp, hi = *(const s16x4*)(vp + 8);
          const bf16x8 vf = __builtin_shufflevector(lo, hi, 0, 1, 2, 3, 4, 5, 6, 7);
          O[vt] = __builtin_amdgcn_mfma_f32_32x32x16_bf16(vf, pf, O[vt], 0, 0, 0);
        }
      }
    __syncthreads();
    if (j + 1 < nch) sstore();
    __syncthreads();
  }
  const float ltot = lrun + __shfl_xor(lrun, 32);
  const float inv = 1.0f / ltot;
#pragma unroll
  for (int i = 0; i < 4; ++i)
#pragma unroll
    for (int e = 0; e < 16; ++e) O[i][e] *= inv;
  if (m == 1) {
#pragma unroll
    for (int vt = 0; vt < 4; ++vt)
#pragma unroll
      for (int e = 0; e < 16; ++e) { const int vd = vt * 32 + (e & 3) + 8 * (e >> 2) + 4 * hh; xb[(qh * 128 + vd) * 32 + q] = O[vt][e]; }
  }
  __syncthreads();
  if (m == 0) {
    float d1 = 0.f, d2 = 0.f;
    for (int i = 0; i < 64; ++i) { d1 += p.lq1[l * 64 + i] * p.lk1[l * 64 + i]; d2 += p.lq2[l * 64 + i] * p.lk2[l * 64 + i]; }
    const float lam_init = 0.8f - 0.6f * __expf(-0.3f * (float)l);
    const float lam = __expf(d1) - __expf(d2) + lam_init;
    float ss = 0.f;
#pragma unroll
    for (int vt = 0; vt < 4; ++vt)
#pragma unroll
      for (int e = 0; e < 16; ++e) {
        const int vd = vt * 32 + (e & 3) + 8 * (e >> 2) + 4 * hh;
        const float o2 = xb[(qh * 128 + vd) * 32 + q];
        const float o = O[vt][e] - lam * o2; O[vt][e] = o; ss += o * o;
      }
    ss += __shfl_xor(ss, 32);
    const float rstd = rsqrtf(ss * (1.0f / 128.0f) + 1e-5f) * (1.0f - lam_init);
    const size_t row = (size_t)(qrow0 + qh * 32 + q);
    const float* sg = p.subln_g + l * 128;
#pragma unroll
    for (int vt = 0; vt < 4; ++vt)
#pragma unroll
      for (int e4 = 0; e4 < 4; ++e4) {
        const int vd = vt * 32 + 8 * e4 + 4 * hh;
        const u32x2 gu = *(const u32x2*)(p.z + row * NZ + C_GA + h * 128 + vd);
        const f32x4 gv = *(const f32x4*)(sg + vd);
        const float y0 = O[vt][4 * e4 + 0] * rstd * gv[0] * bf_lo(gu[0]);
        const float y1 = O[vt][4 * e4 + 1] * rstd * gv[1] * bf_hi(gu[0]);
        const float y2 = O[vt][4 * e4 + 2] * rstd * gv[2] * bf_lo(gu[1]);
        const float y3 = O[vt][4 * e4 + 3] * rstd * gv[3] * bf_hi(gu[1]);
        u32x2 ov; ov[0] = pk2(y0, y1); ov[1] = pk2(y2, y3);
        *(u32x2*)(p.o_a + row * 512 + h * 128 + vd) = ov;
      }
  }
  __syncthreads();
}

DI void phase_mix(const Params& p, int l, char* lds) {
  __shared__ int s_next;
  if (blockIdx.x < 96) { __builtin_amdgcn_s_setprio(3); rec_item(p, l, blockIdx.x, lds); __builtin_amdgcn_s_setprio(0); }
  unsigned* ctr = p.bar + XCD_BAR_WORDS + 64 * l + (blockIdx.x & 7);
  for (;;) {
    __syncthreads();
    if (threadIdx.x == 0) { const int k = (int)atomicAdd(ctr, 1u); s_next = k < 132 ? k * 8 + (int)(blockIdx.x & 7) : 1 << 20; }
    __syncthreads();
    const int it = s_next;
    if (it >= (1 << 20)) break;
    attn_item(p, l, it, lds);
  }
}

template <bool A_F32>
DI void mini_gemm(f32x4 (&acc)[2][2], const void* Ap, int lda, const bf16_t* Bp, int ldb, int K, int wave, int l15, int quad) {
  const int kw = K >> 2, k0 = wave * kw;
#pragma unroll 2
  for (int ks = 0; ks < kw; ks += 32) {
    bf16x8 a[2], b[2];
#pragma unroll
    for (int mi = 0; mi < 2; ++mi) {
      if (A_F32) {
        const float* ap = (const float*)Ap + (size_t)(mi * 16 + l15) * lda + k0 + ks + quad * 8;
        const f32x4 v0 = *(const f32x4*)ap, v1 = *(const f32x4*)(ap + 4);
        u32x4 t; t[0] = pk2(v0[0], v0[1]); t[1] = pk2(v0[2], v0[3]); t[2] = pk2(v1[0], v1[1]); t[3] = pk2(v1[2], v1[3]);
        a[mi] = __builtin_bit_cast(bf16x8, t);
      } else {
        a[mi] = *(const bf16x8*)((const bf16_t*)Ap + (size_t)(mi * 16 + l15) * lda + k0 + ks + quad * 8);
      }
      b[mi] = *(const bf16x8*)(Bp + (size_t)(mi * 16 + l15) * ldb + k0 + ks + quad * 8);
    }
#pragma unroll
    for (int mi = 0; mi < 2; ++mi)
#pragma unroll
      for (int ni = 0; ni < 2; ++ni) acc[mi][ni] = __builtin_amdgcn_mfma_f32_16x16x32_bf16(b[ni], a[mi], acc[mi][ni], 0, 0, 0);
  }
}
DI f32x4 mini_reduce(const f32x4 (&acc)[2][2], char* lds, int wave, int lane) {
  float* red = (float*)lds;
  __syncthreads();
#pragma unroll
  for (int i = 0; i < 2; ++i)
#pragma unroll
    for (int j = 0; j < 2; ++j)
#pragma unroll
      for (int e = 0; e < 4; ++e) red[((wave * 4 + i * 2 + j) * 4 + e) * 64 + lane] = acc[i][j][e];
  __syncthreads();
  f32x4 r;
#pragma unroll
  for (int e = 0; e < 4; ++e) r[e] = (red[((0 * 4 + wave) * 4 + e) * 64 + lane] + red[((1 * 4 + wave) * 4 + e) * 64 + lane]) + (red[((2 * 4 + wave) * 4 + e) * 64 + lane] + red[((3 * 4 + wave) * 4 + e) * 64 + lane]);
  return r;
}
DI void zero_mini(f32x4 (&acc)[2][2]) {
#pragma unroll
  for (int i = 0; i < 2; ++i)
#pragma unroll
    for (int j = 0; j < 2; ++j) acc[i][j] = (f32x4){0.f, 0.f, 0.f, 0.f};
}
DI void mini_merge(const Params& p, int l, int t, char* lds) {
  const int tid = tid_(), wave = __builtin_amdgcn_readfirstlane(tid >> 6), lane = tid & 63, l15 = lane & 15, quad = lane >> 4;
  const int R0 = MP + (t >> 5) * 32, C0 = (t & 31) * 32;
  f32x4 acc[2][2]; zero_mini(acc);
  mini_gemm<false>(acc, p.o_r + (size_t)R0 * 512, 512, p.wt_brr + (size_t)C0 * 512, 512, 512, wave, l15, quad);
  const f32x4 v1 = mini_reduce(acc, lds, wave, lane);
  zero_mini(acc);
  mini_gemm<false>(acc, p.o_a + (size_t)R0 * 512, 512, p.wt_bra + (size_t)C0 * 512, 512, 512, wave, l15, quad);
  const f32x4 v2 = mini_reduce(acc, lds, wave, lane);
  const int R = R0 + (wave >> 1) * 16 + l15, c = C0 + (wave & 1) * 16 + quad * 4;
  const u32x2 g1 = *(const u32x2*)(p.z + (size_t)R * NZ + C_MR + c), g2 = *(const u32x2*)(p.z + (size_t)R * NZ + C_MA + c);
  u32x2 o;
  o[0] = pk2(bf_lo(g1[0]) * v1[0] + bf_lo(g2[0]) * v2[0], bf_hi(g1[0]) * v1[1] + bf_hi(g2[0]) * v2[1]);
  o[1] = pk2(bf_lo(g1[1]) * v1[2] + bf_lo(g2[1]) * v2[2], bf_hi(g1[1]) * v1[3] + bf_hi(g2[1]) * v2[3]);
  *(u32x2*)(p.hn + (size_t)R * DM + c) = o;
}
DI void mini_out(const Params& p, int l, int t, char* lds) {
  const int tid = tid_(), wave = __builtin_amdgcn_readfirstlane(tid >> 6), lane = tid & 63, l15 = lane & 15, quad = lane >> 4;
  const int R0 = MP + (t >> 5) * 32, C0 = (t & 31) * 32;
  f32x4 acc[2][2]; zero_mini(acc);
  mini_gemm<false>(acc, p.hn + (size_t)R0 * DM, DM, p.wt_out + (size_t)C0 * DM, DM, DM, wave, l15, quad);
  const f32x4 v = mini_reduce(acc, lds, wave, lane);
  const int R = R0 + (wave >> 1) * 16 + l15, c = C0 + (wave & 1) * 16 + quad * 4;
  const f32x4 xv = *(const f32x4*)(x_row(p, l, R) + c);
  const f32x4 x1 = xv + v;
  *(f32x4*)(p.out + (size_t)R * DM + c) = x1;
  const f32x4 gv = *(const f32x4*)(p.ple_norm_g + l * DM + c);
  u32x2 o; o[0] = pk2(x1[0] * gv[0], x1[1] * gv[1]); o[1] = pk2(x1[2] * gv[2], x1[3] * gv[3]);
  *(u32x2*)(p.o_r + (size_t)R * DM + c) = o;
  float sq = x1[0] * x1[0] + x1[1] * x1[1] + x1[2] * x1[2] + x1[3] * x1[3];
  sq += __shfl_xor(sq, 16); sq += __shfl_xor(sq, 32);
  if (quad == 0) atomicAdd(p.ss2 + R, sq);
}
DI void mini_ple(const Params& p, int l, int t, char* lds) {
  const int tid = tid_(), wave = __builtin_amdgcn_readfirstlane(tid >> 6), lane = tid & 63, l15 = lane & 15, quad = lane >> 4;
  const int R0 = MP + (t >> 5) * 32, C0 = (t & 31) * 32;
  f32x4 acc[2][2]; zero_mini(acc);
  mini_gemm<false>(acc, p.o_r + (size_t)R0 * DM, DM, p.wt_gate + (size_t)C0 * DM, DM, DM, wave, l15, quad);
  const f32x4 g = mini_reduce(acc, lds, wave, lane);
  zero_mini(acc);
  mini_gemm<true>(acc, p.ps + ((size_t)l * MS + (R0 - MP)) * 256, 256, p.wt_ple + (size_t)C0 * 256, 256, 256, wave, l15, quad);
  const f32x4 e = mini_reduce(acc, lds, wave, lane);
  const int R = R0 + (wave >> 1) * 16 + l15, c = C0 + (wave & 1) * 16 + quad * 4;
  const float rs = rsqrtf(p.ss2[R] * (1.0f / 1024.0f) + 1e-6f);
  float* xo = p.out + (size_t)R * DM + c;
  const f32x4 xv = *(const f32x4*)xo;
  f32x4 o;
#pragma unroll
  for (int k = 0; k < 4; ++k) o[k] = xv[k] + e[k] * bf1((bf16_t)(pk2(sigmoidf_(g[k] * rs), 0.f) & 0xffff));
  *(f32x4*)xo = o;
  if (l + 1 < NL) {
    const f32x4 gn = *(const f32x4*)(p.norm_g + (l + 1) * DM + c);
    u32x2 hv; hv[0] = pk2(o[0] * gn[0], o[1] * gn[1]); hv[1] = pk2(o[2] * gn[2], o[3] * gn[3]);
    *(u32x2*)(p.hn + (size_t)R * DM + c) = hv;
    float sq = o[0] * o[0] + o[1] * o[1] + o[2] * o[2] + o[3] * o[3];
    sq += __shfl_xor(sq, 16); sq += __shfl_xor(sq, 32);
    if (quad == 0) atomicAdd(p.ss1 + R, sq);
  }
}
DI void phase_merge(const Params& p, int l, char* lds) {
  const int tid = tid_(), wave = __builtin_amdgcn_readfirstlane(tid >> 6), lane = tid & 63;
  const int wm = wave >> 1, wn = wave & 1, l15 = lane & 15, quad = lane >> 4;
  for (int r = 0;; ++r) {
    const int g = xcd_tile(r, 128 * 8); if (g < 0) break;
    int mt, nt; tile_decode(g, 128, 8, mt, nt);
    f32x4 a1[4][4]; zero_acc(a1);
    gemm_dma(a1, p.o_r + (size_t)mt * 128 * 512, 512, p.wt_brr + (size_t)nt * 128 * 512, 512, 512, lds);
    u32x2 pk[4][4];
#pragma unroll
    for (int mi = 0; mi < 4; ++mi) {
      const int R = mt * 128 + wm * 64 + mi * 16 + l15;
#pragma unroll
      for (int ni = 0; ni < 4; ++ni) {
        const int c = nt * 128 + wn * 64 + ni * 16 + quad * 4;
        const u32x2 g1 = *(const u32x2*)(p.z + (size_t)R * NZ + C_MR + c);
        const f32x4 v1 = a1[mi][ni];
        pk[mi][ni][0] = pk2(bf_lo(g1[0]) * v1[0], bf_hi(g1[0]) * v1[1]);
        pk[mi][ni][1] = pk2(bf_lo(g1[1]) * v1[2], bf_hi(g1[1]) * v1[3]);
      }
    }
    zero_acc(a1);
    gemm_dma(a1, p.o_a + (size_t)mt * 128 * 512, 512, p.wt_bra + (size_t)nt * 128 * 512, 512, 512, lds);
#pragma unroll
    for (int mi = 0; mi < 4; ++mi) {
      const int R = mt * 128 + wm * 64 + mi * 16 + l15;
#pragma unroll
      for (int ni = 0; ni < 4; ++ni) {
        const int c = nt * 128 + wn * 64 + ni * 16 + quad * 4;
        const u32x2 g2 = *(const u32x2*)(p.z + (size_t)R * NZ + C_MA + c);
        const f32x4 v2 = a1[mi][ni]; const u32x2 u1 = pk[mi][ni];
        u32x2 o;
        o[0] = pk2(bf_lo(u1[0]) + bf_lo(g2[0]) * v2[0], bf_hi(u1[0]) + bf_hi(g2[0]) * v2[1]);
        o[1] = pk2(bf_lo(u1[1]) + bf_lo(g2[1]) * v2[2], bf_hi(u1[1]) + bf_hi(g2[1]) * v2[3]);
        *(u32x2*)(p.hn + (size_t)R * DM + c) = o;
      }
    }
  }
  for (int t = blockIdx.x; t < 512; t += gridDim.x) mini_merge(p, l, t, lds);
}
DI void phase_out(const Params& p, int l, char* lds) {
  const int tid = tid_(), wave = __builtin_amdgcn_readfirstlane(tid >> 6), lane = tid & 63;
  const int wm = wave >> 1, wn = wave & 1, l15 = lane & 15, quad = lane >> 4;
  for (int r = 0;; ++r) {
    const int g = xcd_tile(r, 128 * 8); if (g < 0) break;
    int mt, nt; tile_decode(g, 128, 8, mt, nt);
    f32x4 acc[4][4]; zero_acc(acc);
    gemm_dma(acc, p.hn + (size_t)mt * 128 * DM, DM, p.wt_out + (size_t)nt * 128 * DM, DM, DM, lds);
#pragma unroll
    for (int mi = 0; mi < 4; ++mi) {
      const int R = mt * 128 + wm * 64 + mi * 16 + l15;
      const float* xr = x_row(p, l, R);
      const float* g2 = p.ple_norm_g + l * DM;
      bf16_t* xb = p.o_r + (size_t)R * DM;
      float sq = 0.f;
#pragma unroll
      for (int ni = 0; ni < 4; ++ni) {
        const int c = nt * 128 + wn * 64 + ni * 16 + quad * 4;
        const f32x4 xv = *(const f32x4*)(xr + c);
        const f32x4 x1 = xv + acc[mi][ni];
        *(f32x4*)(p.out + (size_t)R * DM + c) = x1;
        const f32x4 gv = *(const f32x4*)(g2 + c);
        u32x2 o; o[0] = pk2(x1[0] * gv[0], x1[1] * gv[1]); o[1] = pk2(x1[2] * gv[2], x1[3] * gv[3]);
        *(u32x2*)(xb + c) = o;
        sq += x1[0] * x1[0] + x1[1] * x1[1] + x1[2] * x1[2] + x1[3] * x1[3];
      }
      sq += __shfl_xor(sq, 16); sq += __shfl_xor(sq, 32);
      if (quad == 0) atomicAdd(p.ss2 + R, sq);
    }
  }
  for (int t = blockIdx.x; t < 512; t += gridDim.x) mini_out(p, l, t, lds);
}
DI void phase_ple(const Params& p, int l, char* lds) {
  const int tid = tid_(), wave = __builtin_amdgcn_readfirstlane(tid >> 6), lane = tid & 63;
  const int wm = wave >> 1, wn = wave & 1, l15 = lane & 15, quad = lane >> 4;
  for (int r = 0;; ++r) {
    const int g = xcd_tile(r, 128 * 8); if (g < 0) break;
    int mt, nt; tile_decode(g, 128, 8, mt, nt);
    f32x4 a1[4][4]; zero_acc(a1);
    gemm_dma(a1, p.o_r + (size_t)mt * 128 * DM, DM, p.wt_gate + (size_t)nt * 128 * DM, DM, DM, lds);
    u32x2 pk[4][4];
#pragma unroll
    for (int mi = 0; mi < 4; ++mi) {
      const float rs = rsqrtf(p.ss2[mt * 128 + wm * 64 + mi * 16 + l15] * (1.0f / 1024.0f) + 1e-6f);
#pragma unroll
      for (int ni = 0; ni < 4; ++ni) { const f32x4 v = a1[mi][ni] * rs; pk[mi][ni][0] = pk2(sigmoidf_(v[0]), sigmoidf_(v[1])); pk[mi][ni][1] = pk2(sigmoidf_(v[2]), sigmoidf_(v[3])); }
    }
    zero_acc(a1);
    const int r0 = mt * 128;
    const float* pa = r0 < MP ? p.pp + ((size_t)l * MP + r0) * 256 : p.ps + ((size_t)l * MS + (r0 - MP)) * 256;
    gemm_core<true>(a1, pa, 256, p.wt_ple + (size_t)nt * 128 * 256, 256, 256, lds);
#pragma unroll
    for (int mi = 0; mi < 4; ++mi) {
      const int R = mt * 128 + wm * 64 + mi * 16 + l15;
      float sq = 0.f;
#pragma unroll
      for (int ni = 0; ni < 4; ++ni) {
        const int c = nt * 128 + wn * 64 + ni * 16 + quad * 4;
        float* xo = p.out + (size_t)R * DM + c;
        const f32x4 xv = *(const f32x4*)xo; const f32x4 e = a1[mi][ni]; const u32x2 g = pk[mi][ni];
        f32x4 o;
        o[0] = xv[0] + e[0] * bf_lo(g[0]); o[1] = xv[1] + e[1] * bf_hi(g[0]);
        o[2] = xv[2] + e[2] * bf_lo(g[1]); o[3] = xv[3] + e[3] * bf_hi(g[1]);
        *(f32x4*)xo = o;
        if (l + 1 < NL) {
          const f32x4 gn = *(const f32x4*)(p.norm_g + (l + 1) * DM + c);
          u32x2 hv; hv[0] = pk2(o[0] * gn[0], o[1] * gn[1]); hv[1] = pk2(o[2] * gn[2], o[3] * gn[3]);
          *(u32x2*)(p.hn + (size_t)R * DM + c) = hv;
          sq += o[0] * o[0] + o[1] * o[1] + o[2] * o[2] + o[3] * o[3];
        }
      }
      if (l + 1 < NL) {
        sq += __shfl_xor(sq, 16); sq += __shfl_xor(sq, 32);
        if (quad == 0) atomicAdd(p.ss1 + R, sq);
      }
    }
  }
  for (int t = blockIdx.x; t < 512; t += gridDim.x) mini_ple(p, l, t, lds);
  if (l + 1 < NL) {
    for (int it = blockIdx.x; it < 2080 + 16 + 2048; it += gridDim.x) {
      if (it < 2080) wconv_tile(p, l + 1, it, (float*)lds);
      else if (it < 2096) wconv_tile(p, l + 1, 2400 + (it - 2080), (float*)lds);
      else cache_item(p, l + 1, it - 2096, lds);
    }
  }
}


#define XB_TMO      128
#define XB_XCNT(j)  (256  + 64 * (j))
#define XB_XSUB(j)  (1280 + 64 * (j))
#define XB_XGEN(j)  (2304 + 64 * (j))
#define XB_TOP      3328
#define XB_TOPGEN   3392
#define XB_SPIN_CAP (1u << 18)
#define LAS __attribute__((address_space(3)))
DI unsigned xb_ld(unsigned* p)              { return __hip_atomic_load(p, __ATOMIC_RELAXED, __HIP_MEMORY_SCOPE_AGENT); }
DI unsigned xb_add(unsigned* p, unsigned v) { return __hip_atomic_fetch_add(p, v, __ATOMIC_RELAXED, __HIP_MEMORY_SCOPE_AGENT); }
DI unsigned xb_xcc_id() { return (unsigned)__builtin_amdgcn_s_getreg((3 << 11) | 20) & 0xFu; }
#define XB_SPIN(cond, bar) do { unsigned _sp = 0; while (cond) { __builtin_amdgcn_s_sleep(1); \
    if ((++_sp & 255u) == 0u) { if (xb_ld(&(bar)[XB_TMO])) break; if (_sp > XB_SPIN_CAP) { atomicAdd(&(bar)[XB_TMO], 1u); break; } } } } while (0)
struct XcdBarrier { unsigned* bar; unsigned x; volatile LAS unsigned* st; };
DI XcdBarrier xcd_barrier_post(unsigned* bar, volatile LAS unsigned* st) {
  XcdBarrier b; b.bar = bar; b.x = xb_xcc_id(); b.st = st;
  if (threadIdx.x == 0) (void)xb_add(&bar[XB_XCNT(b.x)], 1u);
  return b;
}
DI void xcd_barrier_complete(unsigned* bar, unsigned x, unsigned& nloc, unsigned& nx) {
  const unsigned G = gridDim.x * gridDim.y * gridDim.z;
  unsigned sum, cnt, mine, sp = 0u;
  for (;;) {
    sum = 0u; cnt = 0u; mine = 0u;
#pragma unroll
    for (unsigned j = 0; j < 16; ++j) { const unsigned c = xb_ld(&bar[XB_XCNT(j)]); sum += c; cnt += (c > 0u) ? 1u : 0u; mine = (j == x) ? c : mine; }
    if (sum == G) break;
    __builtin_amdgcn_s_sleep(1);
    if ((++sp & 255u) == 0u) { if (xb_ld(&bar[XB_TMO])) break; if (sp > XB_SPIN_CAP) { atomicAdd(&bar[XB_TMO], 1u); break; } }
  }
  nloc = mine > 0u ? mine : 1u; nx = cnt > 0u ? cnt : 1u;
}
DI void xcd_barrier(const XcdBarrier& b) {
  asm volatile("s_waitcnt vmcnt(0)" ::: "memory");
  __syncthreads();
  if (threadIdx.x == 0) {
    unsigned* bar = b.bar;
    __builtin_amdgcn_s_waitcnt(0);
    unsigned nloc = b.st[0], nx = b.st[1];
    if (nloc == 0u) { xcd_barrier_complete(bar, b.x, nloc, nx); b.st[0] = nloc; b.st[1] = nx; }
    const unsigned old = xb_add(&bar[XB_XSUB(b.x)], 1u);
    const unsigned gen = old / nloc;
    if (old + 1u == (gen + 1u) * nloc) {
      __builtin_amdgcn_fence(__ATOMIC_RELEASE, "agent");
      asm volatile("s_waitcnt vmcnt(0)" ::: "memory");
      const unsigned og = xb_add(&bar[XB_TOP], 1u);
      const unsigned tg = og / nx;
      if (og + 1u == (tg + 1u) * nx) xb_add(&bar[XB_TOPGEN], 1u);
      else XB_SPIN(xb_ld(&bar[XB_TOPGEN]) == tg, bar);
      __builtin_amdgcn_fence(__ATOMIC_ACQUIRE, "agent");
      xb_add(&bar[XB_XGEN(b.x)], 1u);
      asm volatile("s_waitcnt vmcnt(0)" ::: "memory");
    } else {
      XB_SPIN(xb_ld(&bar[XB_XGEN(b.x)]) == gen, bar);
      __builtin_amdgcn_fence(__ATOMIC_ACQUIRE, "agent");
      asm volatile("s_waitcnt vmcnt(0)" ::: "memory");
    }
  }
  __syncthreads();
}
constexpr int LDS_BYTES = 73728;
DI void run_phase(const Params& p, int ph, int l, char* lds) {
  switch (ph) {
    case 1: phase_norm0(p, lds); break;
    case 2: phase_gemm_in(p, l, lds); break;
    case 3: phase_mix(p, l, lds); break;
    case 4: phase_merge(p, l, lds); break;
    case 5: phase_out(p, l, lds); break;
    case 6: break;
    case 7: phase_ple(p, l, lds); break;
    case 8: phase_chunk(p, l, lds); break;
  }
}

#if MEGA
__global__ void __launch_bounds__(256, 2) k_mega(Params p) {
  __shared__ __attribute__((aligned(16))) char lds[LDS_BYTES];
  __shared__ uint4 xb_words;
  cg::grid_group grid = cg::this_grid();
  if (threadIdx.x == 0) xb_words = make_uint4(0u, 0u, 0u, 0u);
  __syncthreads();
  const XcdBarrier xb = xcd_barrier_post(p.bar, (volatile LAS unsigned*)&xb_words);
  phase_norm0(p, lds);
  grid.sync();
#pragma unroll 1
  for (int l = 0; l < NL; ++l) {
    phase_gemm_in(p, l, lds); xcd_barrier(xb);
    phase_chunk(p, l, lds); xcd_barrier(xb);
    phase_mix(p, l, lds); xcd_barrier(xb);
    phase_o(p, l); xcd_barrier(xb);
    phase_merge(p, l, lds); xcd_barrier(xb);
    phase_out(p, l, lds); xcd_barrier(xb);
    phase_ple(p, l, lds); if (l + 1 < NL) xcd_barrier(xb);
  }
}
#else
template <int PH>
__global__ void __launch_bounds__(256, 2) k_phase(Params p, int l) {
  __shared__ __attribute__((aligned(16))) char lds[LDS_BYTES];
  run_phase(p, PH, l, lds);
}
#endif

extern "C" void kernel_launch(void* const* d_in, const int* in_sizes, int n_in, void* d_out, int out_size, void* d_ws, size_t ws_size,
                              hipStream_t stream) {
  Params p{};
  const float** pf = (const float**)&p;
  for (int i = 0; i < 33; ++i) pf[i] = (const float*)d_in[i];
  p.out = (float*)d_out;
  char* w = (char*)d_ws; size_t off = 0;
  auto take = [&](size_t bytes) { char* r = w + off; off += (bytes + 255) & ~(size_t)255; return (bf16_t*)r; };
  p.gS = take((size_t)(NCH + 1) * 4096 * 2);
  p.ss1 = (float*)take((size_t)MT * 4); p.ss2 = (float*)take((size_t)MT * 4);
  p.bar = (unsigned*)take((size_t)(XCD_BAR_WORDS + 64 * NL) * 4);
  p.wt_in = take((size_t)NZ * 1024 * 2);
  p.wt_brr = take((size_t)1024 * 512 * 2);
  p.wt_bra = take((size_t)1024 * 512 * 2);
  p.wt_out = take((size_t)1024 * 1024 * 2);
  p.wt_ple = take((size_t)1024 * 256 * 2);
  p.wt_gate = take((size_t)1024 * 1024 * 2);
  p.w2t = take((size_t)512 * 64 * 2);
  p.a2t = take((size_t)512 * 64 * 2);
  p.z = take((size_t)MT * NZ * 2);
  p.vtp = take((size_t)16 * 128 * 4096 * 2);
  p.vts = take((size_t)32 * 128 * 64 * 2);
  p.kc = take((size_t)8 * 1024 * 512 * 2);
  p.vct = take((size_t)32 * 128 * 1024 * 2);
  p.o_r = take((size_t)MT * 512 * 2);
  p.o_a = take((size_t)MT * 512 * 2);
  p.hn = take((size_t)MT * DM * 2);
  p.cPT = p.hn;
  p.cG = take((size_t)NCH * 4096 * 2);
  p.cRT = take((size_t)NCH * 2048 * 2);
  p.cOI = take((size_t)NCH * 2048 * 2);
  p.cBA = take((size_t)NCH * 2048 * 2);
  if (off > ws_size) { fprintf(stderr, "workspace too small: need %zu have %zu\n", off, ws_size); return; }
#if MEGA
  hipMemsetAsync(p.bar, 0, (size_t)(XCD_BAR_WORDS + 64 * NL) * 4, stream);
  static int grid_blocks = 0;
  if (!grid_blocks) {
    int dev = 0, cus = 0, per_cu = 0;
    hipGetDevice(&dev);
    hipDeviceGetAttribute(&cus, hipDeviceAttributeMultiprocessorCount, dev);
    hipOccupancyMaxActiveBlocksPerMultiprocessor(&per_cu, k_mega, 256, 0);
    if (per_cu > 2) per_cu = 2;
    grid_blocks = cus * per_cu;
  }
  void* args[] = {&p};
  hipError_t e = hipLaunchCooperativeKernel((void*)k_mega, dim3(grid_blocks), dim3(256), args, 0, stream);
  if (e != hipSuccess) fprintf(stderr, "cooperative launch failed: %s (grid %d)\n", hipGetErrorString(e), grid_blocks);
#else
  const int G = 512;
  for (int l = 0; l < NL; ++l) {
    k_phase<1><<<G, 256, 0, stream>>>(p, l);
    k_phase<2><<<G, 256, 0, stream>>>(p, l);
    k_phase<8><<<G, 256, 0, stream>>>(p, l);
    k_phase<3><<<G, 256, 0, stream>>>(p, l);
    k_phase<4><<<G, 256, 0, stream>>>(p, l);
    k_phase<5><<<G, 256, 0, stream>>>(p, l);
    k_phase<6><<<G, 256, 0, stream>>>(p, l);
    k_phase<7><<<G, 256, 0, stream>>>(p, l);
  }
#endif
}
```

```cpp
#include <hip/hip_runtime.h>
#include <hip/hip_cooperative_groups.h>
#include <stdint.h>
#include <stdio.h>
namespace cg = cooperative_groups;

#ifndef MEGA
#define MEGA 1
#endif

typedef unsigned short bf16_t;
typedef short bf16x8 __attribute__((ext_vector_type(8)));
typedef short s16x4 __attribute__((ext_vector_type(4)));
typedef float f32x4 __attribute__((ext_vector_type(4)));
typedef float f32x2 __attribute__((ext_vector_type(2)));
typedef float f32x16 __attribute__((ext_vector_type(16)));
typedef unsigned u32x4 __attribute__((ext_vector_type(4)));
typedef unsigned u32x2 __attribute__((ext_vector_type(2)));
typedef __bf16 bfv2 __attribute__((ext_vector_type(2)));

#define DI __device__ __forceinline__
#define XCD_BAR_WORDS 3456
DI int tid_() { int t = threadIdx.x; asm volatile("" : "+v"(t)); return t; }

constexpr int DM = 1024, MP = 16384, MS = 512, MT = 16896, NZ = 6272, NL = 4;
constexpr int C_GR = 1664, C_Q = 2176, C_K = 2688, C_V = 3200, C_GA = 3712, C_MR = 4224, C_MA = 5248;
constexpr int SHC = 1664;
constexpr size_t O_YP = 0, O_YS = 16777216, O_KP = 17301504, O_VP = 50855936, O_WP = 84410368, O_SP = 84934656,
                 O_KS = 84961280, O_VS = 86009856, O_WS = 87058432, O_SS = 88107008;

struct Params {
  const float *xp, *xs, *pp, *ps, *ck, *cv, *swkv, *sshift;
  const float *norm_g, *w_in, *shift_mu, *decay_w0, *decay_w2, *iclr_a0, *iclr_a2, *k_k, *k_a, *r_k, *lnx_g, *lnx_b,
      *qng, *kng, *lq1, *lk1, *lq2, *lk2, *subln_g, *w_br_r, *w_br_a, *w_out, *ple_w, *ple_gate_w, *ple_norm_g;
  float* out;
  bf16_t *wt_in, *wt_brr, *wt_bra, *wt_out, *wt_ple, *wt_gate, *w2t, *a2t;
  bf16_t *hn, *z, *vtp, *vts, *kc, *vct, *o_r, *o_a;
  bf16_t *cPT, *cG, *cRT, *cOI, *cBA;
  unsigned* bar;
  float *ss1, *ss2;
  bf16_t* gS;
};

DI unsigned pk2(float a, float b) { f32x2 v = {a, b}; bfv2 r = __builtin_convertvector(v, bfv2); return __builtin_bit_cast(unsigned, r); }
DI float bf_lo(unsigned u) { return __uint_as_float(u << 16); }
DI float bf_hi(unsigned u) { return __uint_as_float(u & 0xffff0000u); }
DI float bf1(bf16_t u) { return __uint_as_float(((unsigned)u) << 16); }
DI float sigmoidf_(float x) { return __builtin_amdgcn_rcpf(1.0f + __expf(-x)); }
DI float siluf_(float x) { return x * __builtin_amdgcn_rcpf(1.0f + __expf(-x)); }

DI void tr_tile(const float* __restrict__ src, int ld_src, bf16_t* __restrict__ dst, int ld_dst, float* sm) {
  const int tid = tid_();
  const int r = tid >> 4, c4 = (tid & 15) * 4;
#pragma unroll
  for (int i = 0; i < 4; ++i) {
    const int row = r + 16 * i;
    f32x4 v = *(const f32x4*)(src + (size_t)row * ld_src + c4);
    sm[row * 65 + c4 + 0] = v[0]; sm[row * 65 + c4 + 1] = v[1]; sm[row * 65 + c4 + 2] = v[2]; sm[row * 65 + c4 + 3] = v[3];
  }
  __syncthreads();
  const int n = tid >> 2, ks = (tid & 3) * 16;
  u32x4 o0, o1;
  o0[0] = pk2(sm[(ks + 0) * 65 + n], sm[(ks + 1) * 65 + n]);   o0[1] = pk2(sm[(ks + 2) * 65 + n], sm[(ks + 3) * 65 + n]);
  o0[2] = pk2(sm[(ks + 4) * 65 + n], sm[(ks + 5) * 65 + n]);   o0[3] = pk2(sm[(ks + 6) * 65 + n], sm[(ks + 7) * 65 + n]);
  o1[0] = pk2(sm[(ks + 8) * 65 + n], sm[(ks + 9) * 65 + n]);   o1[1] = pk2(sm[(ks + 10) * 65 + n], sm[(ks + 11) * 65 + n]);
  o1[2] = pk2(sm[(ks + 12) * 65 + n], sm[(ks + 13) * 65 + n]); o1[3] = pk2(sm[(ks + 14) * 65 + n], sm[(ks + 15) * 65 + n]);
  *(u32x4*)(dst + (size_t)n * ld_dst + ks) = o0;
  *(u32x4*)(dst + (size_t)n * ld_dst + ks + 8) = o1;
  __syncthreads();
}

constexpr int WCONV_TILES = 1568 + 128 + 128 + 256 + 64 + 256 + 8 + 8;
DI void wconv_tile(const Params& p, int l, int t, float* sm) {
  const float* src; bf16_t* dst; int K, N;
  if (t < 1568) { src = p.w_in + (size_t)l * 1024 * NZ; dst = p.wt_in; K = 1024; N = NZ; }
  else if ((t -= 1568) < 128) { src = p.w_br_r + (size_t)l * 512 * 1024; dst = p.wt_brr; K = 512; N = 1024; }
  else if ((t -= 128) < 128) { src = p.w_br_a + (size_t)l * 512 * 1024; dst = p.wt_bra; K = 512; N = 1024; }
  else if ((t -= 128) < 256) { src = p.w_out + (size_t)l * 1024 * 1024; dst = p.wt_out; K = 1024; N = 1024; }
  else if ((t -= 256) < 64) { src = p.ple_w + (size_t)l * 256 * 1024; dst = p.wt_ple; K = 256; N = 1024; }
  else if ((t -= 64) < 256) { src = p.ple_gate_w + (size_t)l * 1024 * 1024; dst = p.wt_gate; K = 1024; N = 1024; }
  else if ((t -= 256) < 8) { src = p.decay_w2 + (size_t)l * 64 * 512; dst = p.w2t; K = 64; N = 512; }
  else { t -= 8; src = p.iclr_a2 + (size_t)l * 64 * 512; dst = p.a2t; K = 64; N = 512; }
  const int ntn = N / 64; const int tk = t / ntn, tn = t % ntn;
  tr_tile(src + (size_t)(tk * 64) * N + tn * 64, N, dst + (size_t)(tn * 64) * K + tk * 64, K, sm);
}

DI const float* x_row(const Params& p, int l, int r) {
  if (l == 0) return r < MP ? p.xp + (size_t)r * DM : p.xs + (size_t)(r - MP) * DM;
  return p.out + (size_t)r * DM;
}
DI void cache_item(const Params& p, int l, int c, char* lds) {
  const int tid = tid_();
  if (c < 1024) {
    const float* src = p.ck + (size_t)l * 8 * 1024 * 512 + (size_t)c * 4096 + tid * 16;
    bf16_t* dst = p.kc + (size_t)c * 4096 + tid * 16;
    f32x4 a0 = *(const f32x4*)(src), a1 = *(const f32x4*)(src + 4), a2 = *(const f32x4*)(src + 8), a3 = *(const f32x4*)(src + 12);
    u32x4 o0, o1;
    o0[0] = pk2(a0[0], a0[1]); o0[1] = pk2(a0[2], a0[3]); o0[2] = pk2(a1[0], a1[1]); o0[3] = pk2(a1[2], a1[3]);
    o1[0] = pk2(a2[0], a2[1]); o1[1] = pk2(a2[2], a2[3]); o1[2] = pk2(a3[0], a3[1]); o1[3] = pk2(a3[2], a3[3]);
    *(u32x4*)dst = o0; *(u32x4*)(dst + 8) = o1;
  } else {
    c -= 1024;
    const int bh = c >> 5, tt = c & 31; const int b = bh >> 2, h = bh & 3; const int tk = tt >> 1, tn = tt & 1;
    const float* src = p.cv + (size_t)l * 8 * 1024 * 512 + ((size_t)(b * 1024 + tk * 64)) * 512 + h * 128 + tn * 64;
    bf16_t* dst = p.vct + ((size_t)(bh * 128 + tn * 64)) * 1024 + tk * 64;
    tr_tile(src, 512, dst, 1024, (float*)lds);
  }
}
DI void phase_norm0(const Params& p, char* lds) {
  const int tid = tid_(), wave = __builtin_amdgcn_readfirstlane(tid >> 6), lane = tid & 63;
  const float* g = p.norm_g;
  const int n_norm = MT / 8;
  const int n_items = n_norm + 2048 + WCONV_TILES;
  for (int it = blockIdx.x; it < n_items; it += gridDim.x) {
    if (it < n_norm) {
      const int r0 = it * 8 + wave * 2;
      f32x4 v[2][4]; float ss[2] = {0.f, 0.f};
#pragma unroll
      for (int k = 0; k < 2; ++k) {
        const float* x = x_row(p, 0, r0 + k);
#pragma unroll
        for (int i = 0; i < 4; ++i) v[k][i] = *(const f32x4*)(x + lane * 4 + 256 * i);
      }
      f32x4 gv[4];
#pragma unroll
      for (int i = 0; i < 4; ++i) gv[i] = *(const f32x4*)(g + lane * 4 + 256 * i);
#pragma unroll
      for (int k = 0; k < 2; ++k) {
#pragma unroll
        for (int i = 0; i < 4; ++i) ss[k] += v[k][i][0] * v[k][i][0] + v[k][i][1] * v[k][i][1] + v[k][i][2] * v[k][i][2] + v[k][i][3] * v[k][i][3];
#pragma unroll
        for (int o = 32; o >= 1; o >>= 1) ss[k] += __shfl_xor(ss[k], o);
        const float rstd = rsqrtf(ss[k] * (1.0f / 1024.0f) + 1e-6f);
#pragma unroll
        for (int i = 0; i < 4; ++i) {
          u32x2 o; o[0] = pk2(v[k][i][0] * rstd * gv[i][0], v[k][i][1] * rstd * gv[i][1]); o[1] = pk2(v[k][i][2] * rstd * gv[i][2], v[k][i][3] * rstd * gv[i][3]);
          *(u32x2*)(p.hn + (size_t)(r0 + k) * DM + lane * 4 + 256 * i) = o;
        }
        if (lane == 0) p.ss1[r0 + k] = 1024.0f * (1.0f - 1e-6f);
      }
    } else if (it < n_norm + 2048) {
      cache_item(p, 0, it - n_norm, lds);
    } else {
      wconv_tile(p, 0, it - n_norm - 2048, (float*)lds);
    }
  }
}
DI void zero_f32(float* a, int n) {
  for (int i = blockIdx.x * 256 + tid_(); i < n; i += gridDim.x * 256) a[i] = 0.f;
}

constexpr int GLD = 72;
template <bool A_F32>
DI void gemm_core(f32x4 (&acc)[4][4], const void* Ap, int lda, const bf16_t* Bp, int ldb, int K, char* lds) {
  bf16_t* As = (bf16_t*)lds;
  bf16_t* Bs = (bf16_t*)(lds + 2 * 128 * GLD * 2);
  const int tid = tid_(), wave = __builtin_amdgcn_readfirstlane(tid >> 6), lane = tid & 63;
  const int wm = wave >> 1, wn = wave & 1, l15 = lane & 15, quad = lane >> 4;
  const int nk = K / 64;
  u32x4 ra[4], rb[4];
  auto gload = [&](int kt) {
#pragma unroll
    for (int i = 0; i < 4; ++i) {
      const int c = tid + 256 * i; const int row = c >> 3, c8 = (c & 7) * 8;
      if (!A_F32) ra[i] = *(const u32x4*)((const bf16_t*)Ap + (size_t)row * lda + kt * 64 + c8);
      rb[i] = *(const u32x4*)(Bp + (size_t)row * ldb + kt * 64 + c8);
    }
  };
  auto sstore = [&](int buf, int kt) {
#pragma unroll
    for (int i = 0; i < 4; ++i) {
      const int c = tid + 256 * i; const int row = c >> 3, c8 = (c & 7) * 8;
      if (A_F32) {
        const float* a = (const float*)Ap + (size_t)row * lda + kt * 64 + c8;
        const f32x4 v0 = *(const f32x4*)a, v1 = *(const f32x4*)(a + 4);
        u32x4 t; t[0] = pk2(v0[0], v0[1]); t[1] = pk2(v0[2], v0[3]); t[2] = pk2(v1[0], v1[1]); t[3] = pk2(v1[2], v1[3]);
        *(u32x4*)(As + (buf * 128 + row) * GLD + c8) = t;
      } else {
        *(u32x4*)(As + (buf * 128 + row) * GLD + c8) = ra[i];
      }
      *(u32x4*)(Bs + (buf * 128 + row) * GLD + c8) = rb[i];
    }
  };
  gload(0); sstore(0, 0); __syncthreads();
  for (int kt = 0; kt < nk; ++kt) {
    const int buf = kt & 1;
    if (kt + 1 < nk) gload(kt + 1);
#pragma unroll
    for (int ks = 0; ks < 2; ++ks) {
      bf16x8 af[4], bfr[4];
#pragma unroll
      for (int i = 0; i < 4; ++i) {
        af[i] = *(const bf16x8*)(As + (buf * 128 + wm * 64 + i * 16 + l15) * GLD + ks * 32 + quad * 8);
        bfr[i] = *(const bf16x8*)(Bs + (buf * 128 + wn * 64 + i * 16 + l15) * GLD + ks * 32 + quad * 8);
      }
#pragma unroll
      for (int mi = 0; mi < 4; ++mi)
#pragma unroll
        for (int ni = 0; ni < 4; ++ni) acc[mi][ni] = __builtin_amdgcn_mfma_f32_16x16x32_bf16(bfr[ni], af[mi], acc[mi][ni], 0, 0, 0);
    }
    if (kt + 1 < nk) sstore(buf ^ 1, kt + 1);
    __syncthreads();
  }
}
#define LASP __attribute__((address_space(3)))
DI void gemm_dma(f32x4 (&acc)[4][4], const bf16_t* Ap, int lda, const bf16_t* Bp, int ldb, int K, char* lds) {
  const int tid = tid_(), wave = __builtin_amdgcn_readfirstlane(tid >> 6), lane = tid & 63;
  const int wm = wave >> 1, wn = wave & 1, l15 = lane & 15, quad = lane >> 4;
  const int nk = K / 64;
  const int lrow = lane >> 3, lpc = lane & 7;
  const bf16_t* ga[4]; const bf16_t* gb[4];
#pragma unroll
  for (int i = 0; i < 4; ++i) {
    const int row = (wave * 4 + i) * 8 + lrow; const int q = lpc ^ (row & 7);
    ga[i] = Ap + (size_t)row * lda + q * 8; gb[i] = Bp + (size_t)row * ldb + q * 8;
  }
  auto issue = [&](int kt) {
    char* sb = lds + (kt & 1) * 32768 + wave * 4096;
#pragma unroll
    for (int i = 0; i < 4; ++i) {
      __builtin_amdgcn_global_load_lds((const unsigned*)(ga[i] + kt * 64), (LASP unsigned*)(sb + i * 1024), 16, 0, 0);
      __builtin_amdgcn_global_load_lds((const unsigned*)(gb[i] + kt * 64), (LASP unsigned*)(sb + 16384 + i * 1024), 16, 0, 0);
    }
  };
  const int sw = l15 & 7;
  const unsigned lbase = (unsigned)(size_t)(LASP char*)lds;
  const unsigned a0 = (unsigned)((wm * 64 + l15) * 128 + ((quad ^ sw) * 16)), a1 = (unsigned)((wm * 64 + l15) * 128 + (((4 + quad) ^ sw) * 16));
  const unsigned b0 = 16384u + (unsigned)((wn * 64 + l15) * 128 + ((quad ^ sw) * 16)), b1 = 16384u + (unsigned)((wn * 64 + l15) * 128 + (((4 + quad) ^ sw) * 16));
  asm volatile("s_waitcnt vmcnt(0)" ::: "memory");
  __builtin_amdgcn_s_barrier();
  asm volatile("" ::: "memory");
  issue(0);
  for (int kt = 0; kt < nk; ++kt) {
    asm volatile("s_waitcnt vmcnt(0)" ::: "memory");
    __builtin_amdgcn_s_barrier();
    asm volatile("" ::: "memory");
    if (kt + 1 < nk) issue(kt + 1);
    const unsigned sa = lbase + (unsigned)((kt & 1) * 32768);
    bf16x8 af[4], bfr[4], ag[4], bg[4];
    asm volatile("ds_read_b128 %0, %8\n\tds_read_b128 %1, %8 offset:2048\n\tds_read_b128 %2, %8 offset:4096\n\tds_read_b128 %3, %8 offset:6144\n\t"
                 "ds_read_b128 %4, %9\n\tds_read_b128 %5, %9 offset:2048\n\tds_read_b128 %6, %9 offset:4096\n\tds_read_b128 %7, %9 offset:6144"
                 : "=&v"(af[0]), "=&v"(af[1]), "=&v"(af[2]), "=&v"(af[3]), "=&v"(bfr[0]), "=&v"(bfr[1]), "=&v"(bfr[2]), "=&v"(bfr[3])
                 : "v"(sa + a0), "v"(sa + b0) : "memory");
    asm volatile("ds_read_b128 %0, %16\n\tds_read_b128 %1, %16 offset:2048\n\tds_read_b128 %2, %16 offset:4096\n\tds_read_b128 %3, %16 offset:6144\n\t"
                 "ds_read_b128 %4, %17\n\tds_read_b128 %5, %17 offset:2048\n\tds_read_b128 %6, %17 offset:4096\n\tds_read_b128 %7, %17 offset:6144\n\t"
                 "s_waitcnt lgkmcnt(8)"
                 : "=&v"(ag[0]), "=&v"(ag[1]), "=&v"(ag[2]), "=&v"(ag[3]), "=&v"(bg[0]), "=&v"(bg[1]), "=&v"(bg[2]), "=&v"(bg[3]),
                   "+v"(af[0]), "+v"(af[1]), "+v"(af[2]), "+v"(af[3]), "+v"(bfr[0]), "+v"(bfr[1]), "+v"(bfr[2]), "+v"(bfr[3])
                 : "v"(sa + a1), "v"(sa + b1) : "memory");
#pragma unroll
    for (int mi = 0; mi < 4; ++mi)
#pragma unroll
      for (int ni = 0; ni < 4; ++ni) acc[mi][ni] = __builtin_amdgcn_mfma_f32_16x16x32_bf16(bfr[ni], af[mi], acc[mi][ni], 0, 0, 0);
    asm volatile("s_waitcnt lgkmcnt(0)" : "+v"(ag[0]), "+v"(ag[1]), "+v"(ag[2]), "+v"(ag[3]), "+v"(bg[0]), "+v"(bg[1]), "+v"(bg[2]), "+v"(bg[3]) :: "memory");
#pragma unroll
    for (int mi = 0; mi < 4; ++mi)
#pragma unroll
      for (int ni = 0; ni < 4; ++ni) acc[mi][ni] = __builtin_amdgcn_mfma_f32_16x16x32_bf16(bg[ni], ag[mi], acc[mi][ni], 0, 0, 0);
  }
  asm volatile("" ::: "memory");
  __builtin_amdgcn_s_barrier();
  asm volatile("" ::: "memory");
}
DI void zero_acc(f32x4 (&acc)[4][4]) {
#pragma unroll
  for (int i = 0; i < 4; ++i)
#pragma unroll
    for (int j = 0; j < 4; ++j) acc[i][j] = (f32x4){0.f, 0.f, 0.f, 0.f};
}

DI int xcd_tile(int r, int T) {
  const int x = blockIdx.x & 7, j = blockIdx.x >> 3, nb = gridDim.x >> 3;
  if (j >= nb) return -1;
  const int start = (int)(((long)x * T) / 8), end = (int)(((long)(x + 1) * T) / 8);
  const int g = start + r * nb + j;
  return g < end ? g : -1;
}
DI void tile_decode(int g, int nM, int nN, int& mt, int& nt) {
  const int per = 8 * nN; const int grp = g / per, idx = g - grp * per; const int gm0 = grp * 8;
  const int gsz = (nM - gm0) < 8 ? (nM - gm0) : 8;
  nt = idx / gsz; mt = gm0 + (idx - nt * gsz);
}
DI void phase_gemm_in(const Params& p, int l, char* lds) {
  const int tid = tid_(), wave = __builtin_amdgcn_readfirstlane(tid >> 6), lane = tid & 63;
  const int wm = wave >> 1, wn = wave & 1, l15 = lane & 15, quad = lane >> 4;
  const bf16_t* Wt = p.wt_in;
  const int NTN = 49, NTM = 132;
  for (int r = 0;; ++r) {
    const int g = xcd_tile(r, NTN * NTM); if (g < 0) break;
    int mt, nt; tile_decode(g, NTM, NTN, mt, nt);
    f32x4 acc[4][4]; zero_acc(acc);
    gemm_dma(acc, p.hn + (size_t)mt * 128 * DM, DM, Wt + (size_t)nt * 128 * DM, DM, DM, lds);
    const int colb = nt * 128 + wn * 64 + quad * 4;
    {
#pragma unroll
      for (int mi = 0; mi < 4; ++mi) {
        const float rs = rsqrtf(p.ss1[mt * 128 + wm * 64 + mi * 16 + l15] * (1.0f / 1024.0f) + 1e-6f);
#pragma unroll
        for (int ni = 0; ni < 4; ++ni) acc[mi][ni] = acc[mi][ni] * rs;
      }
    }
    int kind;
    if (nt < 13) kind = 0; else if (nt < 17) kind = 1; else if (nt < 21) kind = 2; else if (nt < 25) kind = 3; else if (nt < 29) kind = 4; else if (nt < 33) kind = 1; else kind = 5;
#pragma unroll
    for (int mi = 0; mi < 4; ++mi) {
      const int R = mt * 128 + wm * 64 + mi * 16 + l15;
      const bool isp = R < MP; const int rs = R - MP;
      bf16_t* zrow = p.z + (size_t)R * NZ;
      if (kind == 0) {
        const bool last = isp ? ((R & 4095) == 4095) : ((rs & 63) == 63);
        float* so = isp ? p.out + O_SP + (size_t)(l * 4 + (R >> 12)) * SHC : p.out + O_SS + (size_t)(l * 8 + (rs >> 6)) * SHC;
#pragma unroll
        for (int ni = 0; ni < 4; ++ni) {
          const int c = colb + ni * 16; const f32x4 v = acc[mi][ni];
          u32x2 o; o[0] = pk2(v[0], v[1]); o[1] = pk2(v[2], v[3]); *(u32x2*)(zrow + c) = o;
          if (last) *(f32x4*)(so + c) = v;
        }
      } else if (kind == 1 || kind == 5) {
#pragma unroll
        for (int ni = 0; ni < 4; ++ni) {
          const int c = colb + ni * 16; f32x4 v = acc[mi][ni];
#pragma unroll
          for (int e = 0; e < 4; ++e) v[e] = (kind == 1) ? siluf_(v[e]) : sigmoidf_(v[e]);
          u32x2 o; o[0] = pk2(v[0], v[1]); o[1] = pk2(v[2], v[3]); *(u32x2*)(zrow + c) = o;
        }
      } else if (kind == 2 || kind == 3) {
        float ss = 0.f;
#pragma unroll
        for (int ni = 0; ni < 4; ++ni) { const f32x4 v = acc[mi][ni]; ss += v[0] * v[0] + v[1] * v[1] + v[2] * v[2] + v[3] * v[3]; }
        ss += __shfl_xor(ss, 16); ss += __shfl_xor(ss, 32);
        const float rstd = rsqrtf(ss * (1.0f / 64.0f) + 1e-6f);
        const float* g = (kind == 2 ? p.qng : p.kng) + l * 64;
        float* ko = isp ? p.out + O_KP + ((size_t)l * MP + R) * 512 : p.out + O_KS + ((size_t)l * MS + rs) * 512;
#pragma unroll
        for (int ni = 0; ni < 4; ++ni) {
          const int c = colb + ni * 16; const int d = ni * 16 + quad * 4;
          const f32x4 gv = *(const f32x4*)(g + d); f32x4 v = acc[mi][ni];
#pragma unroll
          for (int e = 0; e < 4; ++e) v[e] = v[e] * rstd * gv[e];
          u32x2 o; o[0] = pk2(v[0], v[1]); o[1] = pk2(v[2], v[3]); *(u32x2*)(zrow + c) = o;
          if (kind == 3) *(f32x4*)(ko + (c - C_K)) = v;
        }
      } else {
        float* vo = isp ? p.out + O_VP + ((size_t)l * MP + R) * 512 : p.out + O_VS + ((size_t)l * MS + rs) * 512;
#pragma unroll
        for (int ni = 0; ni < 4; ++ni) {
          const int cv = colb + ni * 16 - C_V; const f32x4 v = acc[mi][ni];
          *(f32x4*)(vo + cv) = v;
          const int h = cv >> 7, vd = cv & 127;
          if (isp) {
            bf16_t* vt = p.vtp + ((size_t)(((R >> 12) * 4 + h) * 128 + vd)) * 4096 + (R & 4095);
#pragma unroll
            for (int e = 0; e < 4; ++e) vt[(size_t)e * 4096] = (bf16_t)(pk2(v[e], 0.f) & 0xffff);
          } else {
            bf16_t* vt = p.vts + ((size_t)(((rs >> 6) * 4 + h) * 128 + vd)) * 64 + (rs & 63);
#pragma unroll
            for (int e = 0; e < 4; ++e) vt[(size_t)e * 64] = (bf16_t)(pk2(v[e], 0.f) & 0xffff);
          }
        }
      }
    }
  }
  zero_f32(p.ss2, MT);
  if (l > 0) for (int it = blockIdx.x; it < 320; it += gridDim.x) wconv_tile(p, l, 2080 + it, (float*)lds);
}

constexpr int NCH_P = 4096, NCH = 4224;
constexpr int XLD = 40;
DI f32x4 mm16(const bf16_t* Xrow, int ldx, const bf16_t* Yrow, int ldy, int ksteps, f32x4 acc, int l15, int quad) {
  for (int ks = 0; ks < ksteps; ++ks) {
    const bf16x8 a = *(const bf16x8*)(Xrow + l15 * ldx + ks * 32 + quad * 8);
    const bf16x8 b = *(const bf16x8*)(Yrow + l15 * ldy + ks * 32 + quad * 8);
    acc = __builtin_amdgcn_mfma_f32_16x16x32_bf16(a, b, acc, 0, 0, 0);
  }
  return acc;
}
DI void chunk_item(const Params& p, int l, int item, char* lds) {
  const int tid = tid_(), wave = __builtin_amdgcn_readfirstlane(tid >> 6), lane = tid & 63, l15 = lane & 15, quad = lane >> 4;
  const bool isp = item < NCH_P;
  int bh, c;
  if (isp) { bh = item >> 7; c = item & 127; } else { const int j = item - NCH_P; bh = j >> 1; c = j & 1; }
  const int b = bh >> 3, h = bh & 7;
  const int t0 = c * 32; const int row0 = (isp ? b * 4096 : MP + b * 64) + t0;
  float* s_r = (float*)lds;
  float* s_kf = s_r + 2048;
  float* s_v = s_kf + 2048;
  float* s_w = s_v + 2048;
  float* s_kk = s_w + 2048;
  float* s_bb = s_kk + 2048;
  bf16_t* s_wd = (bf16_t*)(lds + 49152);
  bf16_t* s_ad = (bf16_t*)(lds + 53760);
  float* s_bonus = (float*)(lds + 58368);
  float* s_wl = (float*)(lds + 58880);
  float* s_rhs = (float*)lds;
  bf16_t* s_A = (bf16_t*)lds;
  bf16_t* s_Bm = (bf16_t*)(lds + 4608);
  bf16_t* s_Kp = (bf16_t*)(lds + 9216);
  bf16_t* s_R = (bf16_t*)(lds + 16384);
  bf16_t* s_BmT = (bf16_t*)(lds + 20992);
  bf16_t* s_KpT = (bf16_t*)(lds + 26112);
  bf16_t* s_VmT = (bf16_t*)(lds + 31232);
  bf16_t* s_Lak = (bf16_t*)(lds + 36352);
  bf16_t* s_Mrk = (bf16_t*)(lds + 38912);
  bf16_t* s_Mrb = (bf16_t*)(lds + 41472);
  float* s_labT = (float*)(lds + 44032);
  bf16_t* s_XT = (bf16_t*)(lds + 48640);

  const int mat = wave >> 1, tt = wave & 1;
  const bf16_t* wl = (mat == 0 ? p.w2t : p.a2t) + (size_t)(h * 64) * 64;
  const float* mu = p.shift_mu + l * SHC;
  const float* w0 = p.decay_w0 + l * 512 + h * 64;
  const float* a0 = p.iclr_a0 + l * 512 + h * 64;
  const float* kkp = p.k_k + l * 512 + h * 64;
  const float* kap = p.k_a + l * 512 + h * 64;
  const float* rkp = p.r_k + l * 512 + h * 64;
  const float* lb = p.lnx_b + l * 512 + h * 64;
  const int ptok = tid >> 3, pcs = (tid & 7) * 8;
  {
    const int t = t0 + ptok; const size_t row = (size_t)(row0 + ptok);
#pragma unroll
    for (int g = 0; g < 5; ++g) {
      const int zc = (g < 3 ? g * 512 + h * 64 : 1536 + (g - 3) * 64) + pcs;
      const u32x4 cu = *(const u32x4*)(p.z + row * NZ + zc);
      float cur[8], prv[8];
#pragma unroll
      for (int e = 0; e < 4; ++e) { cur[2 * e] = bf_lo(cu[e]); cur[2 * e + 1] = bf_hi(cu[e]); }
      if (t > 0) {
        const u32x4 pu = *(const u32x4*)(p.z + (row - 1) * NZ + zc);
#pragma unroll
        for (int e = 0; e < 4; ++e) { prv[2 * e] = bf_lo(pu[e]); prv[2 * e + 1] = bf_hi(pu[e]); }
      } else if (isp) {
#pragma unroll
        for (int e = 0; e < 8; ++e) prv[e] = 0.f;
      } else {
        const float* sp = p.sshift + (size_t)(l * 8 + b) * SHC + zc;
#pragma unroll
        for (int e = 0; e < 8; ++e) prv[e] = sp[e];
      }
      float zs[8];
#pragma unroll
      for (int e = 0; e < 8; ++e) zs[e] = cur[e] + (prv[e] - cur[e]) * mu[zc + e];
      if (g < 3) {
        float* d = (g == 0 ? s_r : g == 1 ? s_kf : s_v) + ptok * 64 + pcs;
        *(f32x4*)d = (f32x4){zs[0], zs[1], zs[2], zs[3]}; *(f32x4*)(d + 4) = (f32x4){zs[4], zs[5], zs[6], zs[7]};
      } else {
        if (g == 3) {
#pragma unroll
          for (int e = 0; e < 8; ++e) { const float ex = __expf(2.f * zs[e]); zs[e] = 1.f - 2.f * __builtin_amdgcn_rcpf(ex + 1.f); }
        }
        u32x4 o; o[0] = pk2(zs[0], zs[1]); o[1] = pk2(zs[2], zs[3]); o[2] = pk2(zs[4], zs[5]); o[3] = pk2(zs[6], zs[7]);
        *(u32x4*)((g == 3 ? s_wd : s_ad) + ptok * 72 + pcs) = o;
      }
    }
  }
  __syncthreads();
  {
    const bf16_t* At = (mat == 0 ? s_wd : s_ad);
    bf16x8 af[2];
#pragma unroll
    for (int ks = 0; ks < 2; ++ks) af[ks] = *(const bf16x8*)(At + (tt * 16 + l15) * 72 + ks * 32 + quad * 8);
#pragma unroll
    for (int ct = 0; ct < 4; ++ct) {
      f32x4 d = (f32x4){0.f, 0.f, 0.f, 0.f};
#pragma unroll
      for (int ks = 0; ks < 2; ++ks) {
        const bf16x8 wfr = *(const bf16x8*)(wl + (size_t)(ct * 16 + l15) * 64 + ks * 32 + quad * 8);
        d = __builtin_amdgcn_mfma_f32_16x16x32_bf16(wfr, af[ks], d, 0, 0, 0);
      }
      const int ch = ct * 16 + quad * 4; const int tok = tt * 16 + l15;
      f32x4 o;
      if (mat == 0) {
#pragma unroll
        for (int e = 0; e < 4; ++e) {
          const float y = -(w0[ch + e] + d[e]);
          const float sp = fmaxf(y, 0.f) + __logf(1.0f + __expf(-fabsf(y)));
          o[e] = -__expf(-sp - 0.5f);
        }
        *(f32x4*)(s_w + tok * 64 + ch) = o;
      } else {
#pragma unroll
        for (int e = 0; e < 4; ++e) o[e] = sigmoidf_(a0[ch + e] + d[e]);
        *(f32x4*)(s_bb + tok * 64 + ch) = o;
      }
    }
  }
  __syncthreads();
  float r_[8], kf[8], kk[8], bbv[8], v_[8], bon;
  {
    float k_[8], a_[8];
    *(f32x4*)&k_[0] = *(const f32x4*)(s_kf + ptok * 64 + pcs); *(f32x4*)&k_[4] = *(const f32x4*)(s_kf + ptok * 64 + pcs + 4);
    *(f32x4*)&a_[0] = *(const f32x4*)(s_bb + ptok * 64 + pcs); *(f32x4*)&a_[4] = *(const f32x4*)(s_bb + ptok * 64 + pcs + 4);
    *(f32x4*)&r_[0] = *(const f32x4*)(s_r + ptok * 64 + pcs); *(f32x4*)&r_[4] = *(const f32x4*)(s_r + ptok * 64 + pcs + 4);
    *(f32x4*)&v_[0] = *(const f32x4*)(s_v + ptok * 64 + pcs); *(f32x4*)&v_[4] = *(const f32x4*)(s_v + ptok * 64 + pcs + 4);
    float ss = 0.f; bon = 0.f;
#pragma unroll
    for (int e = 0; e < 8; ++e) {
      kk[e] = k_[e] * kkp[pcs + e]; ss += kk[e] * kk[e];
      kf[e] = k_[e] * (1.f + (a_[e] - 1.f) * kap[pcs + e]);
      bon += r_[e] * kf[e] * rkp[pcs + e];
    }
    ss += __shfl_xor(ss, 1); ss += __shfl_xor(ss, 2); ss += __shfl_xor(ss, 4);
    bon += __shfl_xor(bon, 1); bon += __shfl_xor(bon, 2); bon += __shfl_xor(bon, 4);
    const float inv = 1.0f / fmaxf(sqrtf(ss), 1e-12f);
#pragma unroll
    for (int e = 0; e < 8; ++e) { kk[e] *= inv; bbv[e] = kk[e] * a_[e]; }
  }
  if (tid < 64) {
    float run = 0.f;
#pragma unroll 8
    for (int t = 0; t < 32; ++t) { run += s_w[t * 64 + tid]; s_w[t * 64 + tid] = run; }
  }
  __syncthreads();
  {
    float cw[8], cwp[8];
    *(f32x4*)&cw[0] = *(const f32x4*)(s_w + ptok * 64 + pcs); *(f32x4*)&cw[4] = *(const f32x4*)(s_w + ptok * 64 + pcs + 4);
    if (ptok > 0) { *(f32x4*)&cwp[0] = *(const f32x4*)(s_w + (ptok - 1) * 64 + pcs); *(f32x4*)&cwp[4] = *(const f32x4*)(s_w + (ptok - 1) * 64 + pcs + 4); }
    else {
#pragma unroll
      for (int e = 0; e < 8; ++e) cwp[e] = 0.f;
    }
    __syncthreads();
    float av[8], bm[8], kp[8], rr[8];
#pragma unroll
    for (int e = 0; e < 8; ++e) {
      const float ec = __expf(cw[e]), en = __expf(-cw[e]), ep = __expf(cwp[e]);
      av[e] = kk[e] * ep; bm[e] = bbv[e] * en; kp[e] = kf[e] * en; rr[e] = r_[e] * ec;
      if (ptok == 31) s_wl[pcs + e] = ec;
    }
    u32x4 o;
    o[0] = pk2(av[0], av[1]); o[1] = pk2(av[2], av[3]); o[2] = pk2(av[4], av[5]); o[3] = pk2(av[6], av[7]); *(u32x4*)(s_A + ptok * 72 + pcs) = o;
    o[0] = pk2(bm[0], bm[1]); o[1] = pk2(bm[2], bm[3]); o[2] = pk2(bm[4], bm[5]); o[3] = pk2(bm[6], bm[7]); *(u32x4*)(s_Bm + ptok * 72 + pcs) = o;
#pragma unroll
    for (int e = 0; e < 4; ++e) { s_BmT[(pcs + 2 * e) * XLD + ptok] = (bf16_t)(o[e] & 0xffff); s_BmT[(pcs + 2 * e + 1) * XLD + ptok] = (bf16_t)(o[e] >> 16); }
    o[0] = pk2(kp[0], kp[1]); o[1] = pk2(kp[2], kp[3]); o[2] = pk2(kp[4], kp[5]); o[3] = pk2(kp[6], kp[7]); *(u32x4*)(s_Kp + ptok * 72 + pcs) = o;
#pragma unroll
    for (int e = 0; e < 4; ++e) { s_KpT[(pcs + 2 * e) * XLD + ptok] = (bf16_t)(o[e] & 0xffff); s_KpT[(pcs + 2 * e + 1) * XLD + ptok] = (bf16_t)(o[e] >> 16); }
    o[0] = pk2(rr[0], rr[1]); o[1] = pk2(rr[2], rr[3]); o[2] = pk2(rr[4], rr[5]); o[3] = pk2(rr[6], rr[7]); *(u32x4*)(s_R + ptok * 72 + pcs) = o;
    o[0] = pk2(v_[0], v_[1]); o[1] = pk2(v_[2], v_[3]); o[2] = pk2(v_[4], v_[5]); o[3] = pk2(v_[6], v_[7]);
#pragma unroll
    for (int e = 0; e < 4; ++e) { s_VmT[(pcs + 2 * e) * XLD + ptok] = (bf16_t)(o[e] & 0xffff); s_VmT[(pcs + 2 * e + 1) * XLD + ptok] = (bf16_t)(o[e] >> 16); }
    u32x4 ob;
    ob[0] = pk2(lb[pcs + 0] + bon * v_[0], lb[pcs + 1] + bon * v_[1]); ob[1] = pk2(lb[pcs + 2] + bon * v_[2], lb[pcs + 3] + bon * v_[3]);
    ob[2] = pk2(lb[pcs + 4] + bon * v_[4], lb[pcs + 5] + bon * v_[5]); ob[3] = pk2(lb[pcs + 6] + bon * v_[6], lb[pcs + 7] + bon * v_[7]);
    *(u32x4*)(p.cBA + ((size_t)item * 32 + ptok) * 64 + pcs) = ob;
  }
  __syncthreads();
  {
    const bf16_t* X = (wave < 2) ? s_A : s_R;
    const bf16_t* Y = (wave == 0 || wave == 3) ? s_Bm : s_Kp;
    const bool strict = wave < 2;
#pragma unroll
    for (int ti = 0; ti < 2; ++ti)
#pragma unroll
      for (int ii = 0; ii < 2; ++ii) {
        f32x4 d = (f32x4){0.f, 0.f, 0.f, 0.f};
        if (ii <= ti) d = mm16(X + ti * 16 * 72, 72, Y + ii * 16 * 72, 72, 2, d, l15, quad);
        const int i = ii * 16 + l15;
#pragma unroll
        for (int e = 0; e < 4; ++e) {
          const int t = ti * 16 + quad * 4 + e;
          const bool keep = strict ? (i < t) : (i <= t);
          const float val = keep ? d[e] : 0.f;
          if (wave == 0) s_labT[i * 36 + t] = val;
          else { bf16_t* dst = (wave == 1 ? s_Lak : wave == 2 ? s_Mrk : s_Mrb); dst[t * XLD + i] = (bf16_t)(pk2(val, 0.f) & 0xffff); }
        }
      }
  }
  const u32x4 acap = *(const u32x4*)(s_A + ptok * 72 + pcs);
  __syncthreads();
  {
    float* d = s_rhs + ptok * 128 + pcs;
    *(f32x4*)d = (f32x4){bf_lo(acap[0]), bf_hi(acap[0]), bf_lo(acap[1]), bf_hi(acap[1])};
    *(f32x4*)(d + 4) = (f32x4){bf_lo(acap[2]), bf_hi(acap[2]), bf_lo(acap[3]), bf_hi(acap[3])};
  }
  {
    const int ti = wave & 1;
#pragma unroll
    for (int vv = 0; vv < 2; ++vv) {
      const int vi = (wave >> 1) * 2 + vv;
      f32x4 d = (f32x4){0.f, 0.f, 0.f, 0.f};
      d = mm16(s_Lak + ti * 16 * XLD, XLD, s_VmT + vi * 16 * XLD, XLD, 1, d, l15, quad);
#pragma unroll
      for (int e = 0; e < 4; ++e) s_rhs[(ti * 16 + quad * 4 + e) * 128 + 64 + vi * 16 + l15] = d[e];
    }
  }
  __syncthreads();
  if (tid < 128) {
    float x[32];
#pragma unroll
    for (int t = 0; t < 32; ++t) x[t] = s_rhs[t * 128 + tid];
#pragma unroll
    for (int i = 0; i < 31; ++i) {
      const float xi = x[i];
#pragma unroll
      for (int t4 = ((i + 1) >> 2); t4 < 8; ++t4) {
        const f32x4 lv = *(const f32x4*)(s_labT + i * 36 + t4 * 4);
#pragma unroll
        for (int e = 0; e < 4; ++e) { const int t = t4 * 4 + e; if (t > i) x[t] -= lv[e] * xi; }
      }
    }
#pragma unroll
    for (int q4 = 0; q4 < 4; ++q4) {
      u32x4 o; o[0] = pk2(x[8 * q4], x[8 * q4 + 1]); o[1] = pk2(x[8 * q4 + 2], x[8 * q4 + 3]); o[2] = pk2(x[8 * q4 + 4], x[8 * q4 + 5]); o[3] = pk2(x[8 * q4 + 6], x[8 * q4 + 7]);
      *(u32x4*)(s_XT + tid * XLD + q4 * 8) = o;
    }
  }
  __syncthreads();
  {
    const f32x4 z4 = (f32x4){0.f, 0.f, 0.f, 0.f};
    bf16_t* gPT = p.cPT + (size_t)item * 4096;
    const float wl_c = s_wl[wave * 16 + l15];
#pragma unroll
    for (int k1t = 0; k1t < 4; ++k1t) {
      f32x4 d = mm16(s_XT + k1t * 16 * XLD, XLD, s_BmT + wave * 16 * XLD, XLD, 1, z4, l15, quad);
      const int k2 = wave * 16 + l15, k1 = k1t * 16 + quad * 4;
      float o[4];
#pragma unroll
      for (int e = 0; e < 4; ++e) o[e] = ((k1 + e == k2 ? 1.f : 0.f) - d[e]) * wl_c;
      u32x2 ov; ov[0] = pk2(o[0], o[1]); ov[1] = pk2(o[2], o[3]);
      *(u32x2*)(gPT + k2 * 64 + k1) = ov;
    }
    bf16_t* gG = p.cG + (size_t)item * 4096;
#pragma unroll
    for (int k2t = 0; k2t < 4; ++k2t) {
      const f32x4 d1 = mm16(s_KpT + k2t * 16 * XLD, XLD, s_VmT + wave * 16 * XLD, XLD, 1, z4, l15, quad);
      const f32x4 d2 = mm16(s_BmT + k2t * 16 * XLD, XLD, s_XT + (64 + wave * 16) * XLD, XLD, 1, z4, l15, quad);
      const int k2 = k2t * 16 + quad * 4, v = wave * 16 + l15;
      const f32x4 wv = *(const f32x4*)(s_wl + k2);
      u32x2 ov; ov[0] = pk2((d1[0] - d2[0]) * wv[0], (d1[1] - d2[1]) * wv[1]); ov[1] = pk2((d1[2] - d2[2]) * wv[2], (d1[3] - d2[3]) * wv[3]);
      *(u32x2*)(gG + v * 64 + k2) = ov;
    }
    bf16_t* gRT = p.cRT + (size_t)item * 2048;
    bf16_t* gOI = p.cOI + (size_t)item * 2048;
#pragma unroll
    for (int ti = 0; ti < 2; ++ti) {
      const f32x4 d = mm16(s_XT + wave * 16 * XLD, XLD, s_Mrb + ti * 16 * XLD, XLD, 1, z4, l15, quad);
      const int t = ti * 16 + l15, k = wave * 16 + quad * 4;
      const u32x2 rv = *(const u32x2*)(s_R + t * 72 + k);
      u32x2 ov; ov[0] = pk2(bf_lo(rv[0]) - d[0], bf_hi(rv[0]) - d[1]); ov[1] = pk2(bf_lo(rv[1]) - d[2], bf_hi(rv[1]) - d[3]);
      *(u32x2*)(gRT + t * 64 + k) = ov;
      const f32x4 e1 = mm16(s_VmT + wave * 16 * XLD, XLD, s_Mrk + ti * 16 * XLD, XLD, 1, z4, l15, quad);
      const f32x4 e2 = mm16(s_XT + (64 + wave * 16) * XLD, XLD, s_Mrb + ti * 16 * XLD, XLD, 1, z4, l15, quad);
      u32x2 oo; oo[0] = pk2(e1[0] - e2[0], e1[1] - e2[1]); oo[1] = pk2(e1[2] - e2[2], e1[3] - e2[3]);
      *(u32x2*)(gOI + t * 64 + k) = oo;
    }
  }
  __syncthreads();
}

DI void rec_item(const Params& p, int l, int item, char* lds) {
  const int tid = tid_(), wave = __builtin_amdgcn_readfirstlane(tid >> 6), lane = tid & 63, l15 = lane & 15, quad = lane >> 4;
  const bool isp = item < 32;
  const int bh = isp ? item : item - 32; const int b = bh >> 3, h = bh & 7;
  const int nch = isp ? 128 : 2; const int cid0 = isp ? bh * 128 : NCH_P + bh * 2;
  bf16_t* Sb = (bf16_t*)lds;
  const unsigned lbase = (unsigned)(size_t)(LASP char*)lds;
  __syncthreads();
  if (wave < 2) {
    f32x4 acc[2][4];
#pragma unroll
    for (int v2 = 0; v2 < 2; ++v2) {
      const int v = (wave * 2 + v2) * 16 + l15;
      if (isp) {
#pragma unroll
        for (int nk = 0; nk < 4; ++nk) acc[v2][nk] = (f32x4){0.f, 0.f, 0.f, 0.f};
      } else {
        const float* sp = p.swkv + (((size_t)(l * 8 + b) * 8 + h) * 64 + v) * 64;
#pragma unroll
        for (int nk = 0; nk < 4; ++nk) acc[v2][nk] = *(const f32x4*)(sp + nk * 16 + quad * 4);
      }
#pragma unroll
      for (int nk = 0; nk < 4; ++nk) {
        u32x2 o; o[0] = pk2(acc[v2][nk][0], acc[v2][nk][1]); o[1] = pk2(acc[v2][nk][2], acc[v2][nk][3]);
        *(u32x2*)(Sb + v * 72 + nk * 16 + quad * 4) = o;
        *(u32x2*)(p.gS + (size_t)cid0 * 4096 + v * 64 + nk * 16 + quad * 4) = o;
      }
    }
    const int nmain = nch - 2;
    struct PS { bf16x8 pt[4][2]; u32x2 gv[2][4]; };
    auto ldp = [&](PS& s, int c) {
      const int cc = c < nch ? c : nch - 1;
      const size_t cid = (size_t)(cid0 + cc);
      const bf16_t* gPT = p.cPT + cid * 4096; const bf16_t* gG = p.cG + cid * 4096;
#pragma unroll
      for (int nk = 0; nk < 4; ++nk) {
#pragma unroll
        for (int ks = 0; ks < 2; ++ks) s.pt[nk][ks] = *(const bf16x8*)(gPT + (nk * 16 + l15) * 64 + ks * 32 + quad * 8);
#pragma unroll
        for (int v2 = 0; v2 < 2; ++v2) s.gv[v2][nk] = *(const u32x2*)(gG + ((wave * 2 + v2) * 16 + l15) * 64 + nk * 16 + quad * 4);
      }
    };
    auto step = [&](PS& s, int c) {
      const int buf = c & 1;
      bf16x8 sf[2][2];
      {
        const unsigned sad = lbase + (unsigned)(((buf * 64 + wave * 32 + l15) * 72 + quad * 8) * 2);
        asm volatile("ds_read_b128 %0, %4\n\tds_read_b128 %1, %4 offset:64\n\tds_read_b128 %2, %4 offset:2304\n\tds_read_b128 %3, %4 offset:2368\n\ts_waitcnt lgkmcnt(0)"
                     : "=&v"(sf[0][0]), "=&v"(sf[0][1]), "=&v"(sf[1][0]), "=&v"(sf[1][1]) : "v"(sad) : "memory");
      }
#pragma unroll
      for (int v2 = 0; v2 < 2; ++v2) {
#pragma unroll
        for (int nk = 0; nk < 4; ++nk) {
          f32x4 a = (f32x4){bf_lo(s.gv[v2][nk][0]), bf_hi(s.gv[v2][nk][0]), bf_lo(s.gv[v2][nk][1]), bf_hi(s.gv[v2][nk][1])};
#pragma unroll
          for (int ks = 0; ks < 2; ++ks) a = __builtin_amdgcn_mfma_f32_16x16x32_bf16(s.pt[nk][ks], sf[v2][ks], a, 0, 0, 0);
          acc[v2][nk] = a;
        }
      }
      ldp(s, c + 3);
      const size_t scid = (c + 1 < nch) ? (size_t)(cid0 + c + 1) : (size_t)NCH;
#pragma unroll
      for (int v2 = 0; v2 < 2; ++v2) {
        const int v = (wave * 2 + v2) * 16 + l15;
#pragma unroll
        for (int nk = 0; nk < 4; ++nk) {
          u32x2 ov; ov[0] = pk2(acc[v2][nk][0], acc[v2][nk][1]); ov[1] = pk2(acc[v2][nk][2], acc[v2][nk][3]);
          *(u32x2*)(Sb + ((buf ^ 1) * 64 + v) * 72 + nk * 16 + quad * 4) = ov;
          *(u32x2*)(p.gS + scid * 4096 + v * 64 + nk * 16 + quad * 4) = ov;
        }
      }
      asm volatile("s_waitcnt lgkmcnt(0)" ::: "memory");
    };
    PS s0, s1, s2;
    ldp(s0, 0); ldp(s1, 1); ldp(s2, 2);
#pragma unroll 1
    for (int c = 0; c < nmain; c += 3) { step(s0, c); step(s1, c + 1); step(s2, c + 2); }
    step(s0, nmain); step(s1, nmain + 1);
#pragma unroll
    for (int v2 = 0; v2 < 2; ++v2) {
      const int v = (wave * 2 + v2) * 16 + l15;
      float* so = (isp ? p.out + O_WP + (((size_t)(l * 4 + b) * 8 + h) * 64 + v) * 64 : p.out + O_WS + (((size_t)(l * 8 + b) * 8 + h) * 64 + v) * 64);
#pragma unroll
      for (int nk = 0; nk < 4; ++nk) *(f32x4*)(so + nk * 16 + quad * 4) = acc[v2][nk];
    }
  }
  __syncthreads();
}
DI void phase_o(const Params& p, int l) {
  const int tid = tid_(), wave = __builtin_amdgcn_readfirstlane(tid >> 6), lane = tid & 63, l15 = lane & 15, quad = lane >> 4;
  for (int pi = blockIdx.x; pi < NCH / 2; pi += gridDim.x) {
    const int cid = pi * 2 + (wave >> 1);
    const bool isp = cid < NCH_P;
    int bh, c;
    if (isp) { bh = cid >> 7; c = cid & 127; } else { const int j = cid - NCH_P; bh = j >> 1; c = j & 1; }
    const int b = bh >> 3, h = bh & 7;
    const int tok = (wave & 1) * 16 + l15;
    const size_t row = (size_t)((isp ? b * 4096 : MP + b * 64) + c * 32 + tok);
    bf16x8 rt[2], sa[4][2]; u32x2 oi[4], ba[4], gt[4];
#pragma unroll
    for (int ks = 0; ks < 2; ++ks) rt[ks] = *(const bf16x8*)(p.cRT + (size_t)cid * 2048 + tok * 64 + ks * 32 + quad * 8);
#pragma unroll
    for (int vt = 0; vt < 4; ++vt) {
#pragma unroll
      for (int ks = 0; ks < 2; ++ks) sa[vt][ks] = *(const bf16x8*)(p.gS + (size_t)cid * 4096 + (vt * 16 + l15) * 64 + ks * 32 + quad * 8);
      oi[vt] = *(const u32x2*)(p.cOI + (size_t)cid * 2048 + tok * 64 + vt * 16 + quad * 4);
      ba[vt] = *(const u32x2*)(p.cBA + (size_t)cid * 2048 + tok * 64 + vt * 16 + quad * 4);
      gt[vt] = *(const u32x2*)(p.z + row * NZ + C_GR + h * 64 + vt * 16 + quad * 4);
    }
    f32x4 ao[4];
#pragma unroll
    for (int vt = 0; vt < 4; ++vt) {
      f32x4 a = (f32x4){bf_lo(oi[vt][0]), bf_hi(oi[vt][0]), bf_lo(oi[vt][1]), bf_hi(oi[vt][1])};
#pragma unroll
      for (int ks = 0; ks < 2; ++ks) a = __builtin_amdgcn_mfma_f32_16x16x32_bf16(sa[vt][ks], rt[ks], a, 0, 0, 0);
      ao[vt] = a;
    }
    float sm = 0.f, sq = 0.f;
#pragma unroll
    for (int vt = 0; vt < 4; ++vt)
#pragma unroll
      for (int e = 0; e < 4; ++e) { sm += ao[vt][e]; sq += ao[vt][e] * ao[vt][e]; }
    { const float a1 = __shfl_xor(sm, 16), b1 = __shfl_xor(sq, 16); sm += a1; sq += b1; }
    { const float a1 = __shfl_xor(sm, 32), b1 = __shfl_xor(sq, 32); sm += a1; sq += b1; }
    const float mean = sm * (1.0f / 64.0f);
    const float rstd = rsqrtf(fmaxf(sq * (1.0f / 64.0f) - mean * mean, 0.f) + 64e-5f);
    const float* lg = p.lnx_g + l * 512 + h * 64;
#pragma unroll
    for (int vt = 0; vt < 4; ++vt) {
      const int vv = vt * 16 + quad * 4;
      const f32x4 g4 = *(const f32x4*)(lg + vv);
      const float y0 = ((ao[vt][0] - mean) * rstd * g4[0] + bf_lo(ba[vt][0])) * bf_lo(gt[vt][0]);
      const float y1 = ((ao[vt][1] - mean) * rstd * g4[1] + bf_hi(ba[vt][0])) * bf_hi(gt[vt][0]);
      const float y2 = ((ao[vt][2] - mean) * rstd * g4[2] + bf_lo(ba[vt][1])) * bf_lo(gt[vt][1]);
      const float y3 = ((ao[vt][3] - mean) * rstd * g4[3] + bf_hi(ba[vt][1])) * bf_hi(gt[vt][1]);
      u32x2 ov; ov[0] = pk2(y0, y1); ov[1] = pk2(y2, y3);
      *(u32x2*)(p.o_r + row * 512 + h * 64 + vv) = ov;
    }
  }
}
DI void phase_chunk(const Params& p, int l, char* lds) {
  for (int it = blockIdx.x; it < NCH_P; it += gridDim.x) chunk_item(p, l, it, lds);
  zero_f32(p.ss1, MT);
}

constexpr int ALD = 72;
DI void attn_item(const Params& p, int l, int item, char* lds) {
  const int tid = tid_(), wave = __builtin_amdgcn_readfirstlane(tid >> 6), lane = tid & 63;
  const int m = wave & 1, qh = wave >> 1, q = lane & 31, hh = lane >> 5;
  bf16_t* Ks = (bf16_t*)lds;
  bf16_t* Vs = Ks + 2 * 64 * ALD;
  float* xb = (float*)lds;
  bool samp; int b, h, nch, qrow0, qpos0;
  const int xq = item & 7, tk = item >> 3;
  if (tk < 4) { samp = true; const int bhs = xq + 8 * tk; b = bhs >> 2; h = bhs & 3; nch = 17; qrow0 = MP + b * 64; qpos0 = 1024; }
  else { samp = false; const int kk = tk - 4; const int qc = 63 - (kk >> 1); const int bh = xq + 8 * (kk & 1); b = bh >> 2; h = bh & 3; nch = qc + 1; qrow0 = b * 4096 + qc * 64; qpos0 = qc * 64; }
  bf16x8 qf[4];
  {
    const bf16_t* qp = p.z + (size_t)(qrow0 + qh * 32 + q) * NZ + C_Q + h * 128 + m * 64;
#pragma unroll
    for (int ks = 0; ks < 4; ++ks) qf[ks] = *(const bf16x8*)(qp + ks * 16 + hh * 8);
  }
  const float slope = exp2f(-2.0f * (float)(h + 1));
  const float LOG2E = 1.4426950408889634f;
  const float c1 = 0.125f * LOG2E, sl2 = slope * LOG2E;
  const float qposf = (float)(qpos0 + qh * 32 + q);
  f32x16 O[4];
#pragma unroll
  for (int i = 0; i < 4; ++i)
#pragma unroll
    for (int e = 0; e < 16; ++e) O[i][e] = 0.f;
  float mrun = -1e30f, lrun = 0.f;
  u32x4 rk[4], rv[4];
  auto gload = [&](int j) {
    const bf16_t* kb; size_t kld; const bf16_t* vb; size_t vld;
    if (!samp) { kb = p.z + (size_t)(b * 4096 + j * 64) * NZ + C_K + h * 128; kld = NZ; vb = p.vtp + (size_t)((b * 4 + h) * 128) * 4096 + j * 64; vld = 4096; }
    else if (j < 16) { kb = p.kc + (size_t)(b * 1024 + j * 64) * 512 + h * 128; kld = 512; vb = p.vct + (size_t)((b * 4 + h) * 128) * 1024 + j * 64; vld = 1024; }
    else { kb = p.z + (size_t)(MP + b * 64) * NZ + C_K + h * 128; kld = NZ; vb = p.vts + (size_t)((b * 4 + h) * 128) * 64; vld = 64; }
#pragma unroll
    for (int i = 0; i < 4; ++i) {
      const int c = tid + 256 * i;
      const int mm = c >> 9, key = (c >> 3) & 63, d8 = (c & 7) * 8;
      rk[i] = *(const u32x4*)(kb + (size_t)key * kld + mm * 64 + d8);
      const int vd = c >> 3, k8 = (c & 7) * 8;
      rv[i] = *(const u32x4*)(vb + (size_t)vd * vld + k8);
    }
  };
  auto sstore = [&]() {
#pragma unroll
    for (int i = 0; i < 4; ++i) {
      const int c = tid + 256 * i;
      const int mm = c >> 9, key = (c >> 3) & 63, d8 = (c & 7) * 8;
      *(u32x4*)(Ks + (mm * 64 + key) * ALD + d8) = rk[i];
      const int vd = c >> 3, k8 = (c & 7) * 8;
      *(u32x4*)(Vs + vd * ALD + k8) = rv[i];
    }
  };
  gload(0); sstore(); __syncthreads();
  for (int j = 0; j < nch; ++j) {
    if (j + 1 < nch) gload(j + 1);
    f32x16 s[2];
#pragma unroll
    for (int kt = 0; kt < 2; ++kt) {
#pragma unroll
      for (int e = 0; e < 16; ++e) s[kt][e] = 0.f;
#pragma unroll
      for (int ks = 0; ks < 4; ++ks) {
        const bf16x8 kf = *(const bf16x8*)(Ks + (m * 64 + kt * 32 + q) * ALD + ks * 16 + hh * 8);
        s[kt] = __builtin_amdgcn_mfma_f32_32x32x16_bf16(kf, qf[ks], s[kt], 0, 0, 0);
      }
    }
    float mx = -1e30f;
    const float dbase = qposf - (float)(j * 64 + 4 * hh);
#pragma unroll
    for (int kt = 0; kt < 2; ++kt)
#pragma unroll
      for (int e = 0; e < 16; ++e) {
        const float dd = dbase - (float)(kt * 32 + (e & 3) + 8 * (e >> 2));
        const float v = s[kt][e] * c1 - sl2 * fabsf(dd);
        s[kt][e] = v; mx = fmaxf(mx, v);
      }
    mx = fmaxf(mx, __shfl_xor(mx, 32));
    const float mnew = fmaxf(mrun, mx);
    const float alpha = __builtin_amdgcn_exp2f(mrun - mnew);
    const bool resc = mnew > mrun;
    mrun = mnew;
    float ps = 0.f;
#pragma unroll
    for (int kt = 0; kt < 2; ++kt)
#pragma unroll
      for (int e = 0; e < 16; ++e) { const float pe = __builtin_amdgcn_exp2f(s[kt][e] - mnew); s[kt][e] = pe; ps += pe; }
    lrun = lrun * alpha + ps;
    if (__any(resc)) {
#pragma unroll
      for (int i = 0; i < 4; ++i)
#pragma unroll
        for (int e = 0; e < 16; ++e) O[i][e] *= alpha;
    }
#pragma unroll
    for (int kt = 0; kt < 2; ++kt)
#pragma unroll
      for (int sx = 0; sx < 2; ++sx) {
        u32x4 pb;
        pb[0] = pk2(s[kt][8 * sx + 0], s[kt][8 * sx + 1]); pb[1] = pk2(s[kt][8 * sx + 2], s[kt][8 * sx + 3]);
        pb[2] = pk2(s[kt][8 * sx + 4], s[kt][8 * sx + 5]); pb[3] = pk2(s[kt][8 * sx + 6], s[kt][8 * sx + 7]);
        const bf16x8 pf = __builtin_bit_cast(bf16x8, pb);
#pragma unroll
        for (int vt = 0; vt < 4; ++vt) {
          const bf16_t* vp = Vs + (vt * 32 + q) * ALD + kt * 32 + 16 * sx + 4 * hh;
          const s16x4 lo = *(const s16x4*)vp, hi = *(const s16x4*)(vp + 8);
          const bf16x8 vf = __builtin_shufflevector(lo, hi, 0, 1, 2, 3, 4, 5, 6, 7);
          O[vt] = __builtin_amdgcn_mfma_f32_32x32x16_bf16(vf, pf, O[vt], 0, 0, 0);
        }
      }
    __syncthreads();
    if (j + 1 < nch) sstore();
    __syncthreads();
  }
  const float ltot = lrun + __shfl_xor(lrun, 32);
  const float inv = 1.0f / ltot;
#pragma unroll
  for (int i = 0; i < 4; ++i)
#pragma unroll
    for (int e = 0; e < 16; ++e) O[i][e] *= inv;
  if (m == 1) {
#pragma unroll
    for (int vt = 0; vt < 4; ++vt)
#pragma unroll
      for (int e = 0; e < 16; ++e) { const int vd = vt * 32 + (e & 3) + 8 * (e >> 2) + 4 * hh; xb[(qh * 128 + vd) * 32 + q] = O[vt][e]; }
  }
  __syncthreads();
  if (m == 0) {
    float d1 = 0.f, d2 = 0.f;
    for (int i = 0; i < 64; ++i) { d1 += p.lq1[l * 64 + i] * p.lk1[l * 64 + i]; d2 += p.lq2[l * 64 + i] * p.lk2[l * 64 + i]; }
    const float lam_init = 0.8f - 0.6f * __expf(-0.3f * (float)l);
    const float lam = __expf(d1) - __expf(d2) + lam_init;
    float ss = 0.f;
#pragma unroll
    for (int vt = 0; vt < 4; ++vt)
#pragma unroll
      for (int e = 0; e < 16; ++e) {
        const int vd = vt * 32 + (e & 3) + 8 * (e >> 2) + 4 * hh;
        const float o2 = xb[(qh * 128 + vd) * 32 + q];
        const float o = O[vt][e] - lam * o2; O[vt][e] = o; ss += o * o;
      }
    ss += __shfl_xor(ss, 32);
    const float rstd = rsqrtf(ss * (1.0f / 128.0f) + 1e-5f) * (1.0f - lam_init);
    const size_t row = (size_t)(qrow0 + qh * 32 + q);
    const float* sg = p.subln_g + l * 128;
#pragma unroll
    for (int vt = 0; vt < 4; ++vt)
#pragma unroll
      for (int e4 = 0; e4 < 4; ++e4) {
        const int vd = vt * 32 + 8 * e4 + 4 * hh;
        const u32x2 gu = *(const u32x2*)(p.z + row * NZ + C_GA + h * 128 + vd);
        const f32x4 gv = *(const f32x4*)(sg + vd);
        const float y0 = O[vt][4 * e4 + 0] * rstd * gv[0] * bf_lo(gu[0]);
        const float y1 = O[vt][4 * e4 + 1] * rstd * gv[1] * bf_hi(gu[0]);
        const float y2 = O[vt][4 * e4 + 2] * rstd * gv[2] * bf_lo(gu[1]);
        const float y3 = O[vt][4 * e4 + 3] * rstd * gv[3] * bf_hi(gu[1]);
        u32x2 ov; ov[0] = pk2(y0, y1); ov[1] = pk2(y2, y3);
        *(u32x2*)(p.o_a + row * 512 + h * 128 + vd) = ov;
      }
  }
  __syncthreads();
}

DI void phase_mix(const Params& p, int l, char* lds) {
  __shared__ int s_next;
  if (blockIdx.x < 96) {
    if (blockIdx.x >= 32) {
      for (int c2 = 0; c2 < 2; ++c2) chunk_item(p, l, NCH_P + (blockIdx.x - 32) * 2 + c2, lds);
      __syncthreads();
    }
    __builtin_amdgcn_s_setprio(3); rec_item(p, l, blockIdx.x, lds); __builtin_amdgcn_s_setprio(0);
  }
  unsigned* ctr = p.bar + XCD_BAR_WORDS + 64 * l + (blockIdx.x & 7);
  for (;;) {
    __syncthreads();
    if (threadIdx.x == 0) { const int k = (int)atomicAdd(ctr, 1u); s_next = k < 132 ? k * 8 + (int)(blockIdx.x & 7) : 1 << 20; }
    __syncthreads();
    const int it = s_next;
    if (it >= (1 << 20)) break;
    attn_item(p, l, it, lds);
  }
}

template <bool A_F32>
DI void mini_gemm(f32x4 (&acc)[2][2], const void* Ap, int lda, const bf16_t* Bp, int ldb, int K, int wave, int l15, int quad) {
  const int kw = K >> 2, k0 = wave * kw;
#pragma unroll 2
  for (int ks = 0; ks < kw; ks += 32) {
    bf16x8 a[2], b[2];
#pragma unroll
    for (int mi = 0; mi < 2; ++mi) {
      if (A_F32) {
        const float* ap = (const float*)Ap + (size_t)(mi * 16 + l15) * lda + k0 + ks + quad * 8;
        const f32x4 v0 = *(const f32x4*)ap, v1 = *(const f32x4*)(ap + 4);
        u32x4 t; t[0] = pk2(v0[0], v0[1]); t[1] = pk2(v0[2], v0[3]); t[2] = pk2(v1[0], v1[1]); t[3] = pk2(v1[2], v1[3]);
        a[mi] = __builtin_bit_cast(bf16x8, t);
      } else {
        a[mi] = *(const bf16x8*)((const bf16_t*)Ap + (size_t)(mi * 16 + l15) * lda + k0 + ks + quad * 8);
      }
      b[mi] = *(const bf16x8*)(Bp + (size_t)(mi * 16 + l15) * ldb + k0 + ks + quad * 8);
    }
#pragma unroll
    for (int mi = 0; mi < 2; ++mi)
#pragma unroll
      for (int ni = 0; ni < 2; ++ni) acc[mi][ni] = __builtin_amdgcn_mfma_f32_16x16x32_bf16(b[ni], a[mi], acc[mi][ni], 0, 0, 0);
  }
}
DI f32x4 mini_reduce(const f32x4 (&acc)[2][2], char* lds, int wave, int lane) {
  float* red = (float*)lds;
  __syncthreads();
#pragma unroll
  for (int i = 0; i < 2; ++i)
#pragma unroll
    for (int j = 0; j < 2; ++j)
#pragma unroll
      for (int e = 0; e < 4; ++e) red[((wave * 4 + i * 2 + j) * 4 + e) * 64 + lane] = acc[i][j][e];
  __syncthreads();
  f32x4 r;
#pragma unroll
  for (int e = 0; e < 4; ++e) r[e] = (red[((0 * 4 + wave) * 4 + e) * 64 + lane] + red[((1 * 4 + wave) * 4 + e) * 64 + lane]) + (red[((2 * 4 + wave) * 4 + e) * 64 + lane] + red[((3 * 4 + wave) * 4 + e) * 64 + lane]);
  return r;
}
DI void zero_mini(f32x4 (&acc)[2][2]) {
#pragma unroll
  for (int i = 0; i < 2; ++i)
#pragma unroll
    for (int j = 0; j < 2; ++j) acc[i][j] = (f32x4){0.f, 0.f, 0.f, 0.f};
}
DI void mini_merge(const Params& p, int l, int t, char* lds) {
  const int tid = tid_(), wave = __builtin_amdgcn_readfirstlane(tid >> 6), lane = tid & 63, l15 = lane & 15, quad = lane >> 4;
  const int R0 = MP + (t >> 5) * 32, C0 = (t & 31) * 32;
  f32x4 acc[2][2]; zero_mini(acc);
  mini_gemm<false>(acc, p.o_r + (size_t)R0 * 512, 512, p.wt_brr + (size_t)C0 * 512, 512, 512, wave, l15, quad);
  const f32x4 v1 = mini_reduce(acc, lds, wave, lane);
  zero_mini(acc);
  mini_gemm<false>(acc, p.o_a + (size_t)R0 * 512, 512, p.wt_bra + (size_t)C0 * 512, 512, 512, wave, l15, quad);
  const f32x4 v2 = mini_reduce(acc, lds, wave, lane);
  const int R = R0 + (wave >> 1) * 16 + l15, c = C0 + (wave & 1) * 16 + quad * 4;
  const u32x2 g1 = *(const u32x2*)(p.z + (size_t)R * NZ + C_MR + c), g2 = *(const u32x2*)(p.z + (size_t)R * NZ + C_MA + c);
  u32x2 o;
  o[0] = pk2(bf_lo(g1[0]) * v1[0] + bf_lo(g2[0]) * v2[0], bf_hi(g1[0]) * v1[1] + bf_hi(g2[0]) * v2[1]);
  o[1] = pk2(bf_lo(g1[1]) * v1[2] + bf_lo(g2[1]) * v2[2], bf_hi(g1[1]) * v1[3] + bf_hi(g2[1]) * v2[3]);
  *(u32x2*)(p.hn + (size_t)R * DM + c) = o;
}
DI void mini_out(const Params& p, int l, int t, char* lds) {
  const int tid = tid_(), wave = __builtin_amdgcn_readfirstlane(tid >> 6), lane = tid & 63, l15 = lane & 15, quad = lane >> 4;
  const int R0 = MP + (t >> 5) * 32, C0 = (t & 31) * 32;
  f32x4 acc[2][2]; zero_mini(acc);
  mini_gemm<false>(acc, p.hn + (size_t)R0 * DM, DM, p.wt_out + (size_t)C0 * DM, DM, DM, wave, l15, quad);
  const f32x4 v = mini_reduce(acc, lds, wave, lane);
  const int R = R0 + (wave >> 1) * 16 + l15, c = C0 + (wave & 1) * 16 + quad * 4;
  const f32x4 xv = *(const f32x4*)(x_row(p, l, R) + c);
  const f32x4 x1 = xv + v;
  *(f32x4*)(p.out + (size_t)R * DM + c) = x1;
  const f32x4 gv = *(const f32x4*)(p.ple_norm_g + l * DM + c);
  u32x2 o; o[0] = pk2(x1[0] * gv[0], x1[1] * gv[1]); o[1] = pk2(x1[2] * gv[2], x1[3] * gv[3]);
  *(u32x2*)(p.o_r + (size_t)R * DM + c) = o;
  float sq = x1[0] * x1[0] + x1[1] * x1[1] + x1[2] * x1[2] + x1[3] * x1[3];
  sq += __shfl_xor(sq, 16); sq += __shfl_xor(sq, 32);
  if (quad == 0) atomicAdd(p.ss2 + R, sq);
}
DI void mini_ple(const Params& p, int l, int t, char* lds) {
  const int tid = tid_(), wave = __builtin_amdgcn_readfirstlane(tid >> 6), lane = tid & 63, l15 = lane & 15, quad = lane >> 4;
  const int R0 = MP + (t >> 5) * 32, C0 = (t & 31) * 32;
  f32x4 acc[2][2]; zero_mini(acc);
  mini_gemm<false>(acc, p.o_r + (size_t)R0 * DM, DM, p.wt_gate + (size_t)C0 * DM, DM, DM, wave, l15, quad);
  const f32x4 g = mini_reduce(acc, lds, wave, lane);
  zero_mini(acc);
  mini_gemm<true>(acc, p.ps + ((size_t)l * MS + (R0 - MP)) * 256, 256, p.wt_ple + (size_t)C0 * 256, 256, 256, wave, l15, quad);
  const f32x4 e = mini_reduce(acc, lds, wave, lane);
  const int R = R0 + (wave >> 1) * 16 + l15, c = C0 + (wave & 1) * 16 + quad * 4;
  const float rs = rsqrtf(p.ss2[R] * (1.0f / 1024.0f) + 1e-6f);
  float* xo = p.out + (size_t)R * DM + c;
  const f32x4 xv = *(const f32x4*)xo;
  f32x4 o;
#pragma unroll
  for (int k = 0; k < 4; ++k) o[k] = xv[k] + e[k] * bf1((bf16_t)(pk2(sigmoidf_(g[k] * rs), 0.f) & 0xffff));
  *(f32x4*)xo = o;
  if (l + 1 < NL) {
    const f32x4 gn = *(const f32x4*)(p.norm_g + (l + 1) * DM + c);
    u32x2 hv; hv[0] = pk2(o[0] * gn[0], o[1] * gn[1]); hv[1] = pk2(o[2] * gn[2], o[3] * gn[3]);
    *(u32x2*)(p.hn + (size_t)R * DM + c) = hv;
    float sq = o[0] * o[0] + o[1] * o[1] + o[2] * o[2] + o[3] * o[3];
    sq += __shfl_xor(sq, 16); sq += __shfl_xor(sq, 32);
    if (quad == 0) atomicAdd(p.ss1 + R, sq);
  }
}
DI void phase_merge(const Params& p, int l, char* lds) {
  const int tid = tid_(), wave = __builtin_amdgcn_readfirstlane(tid >> 6), lane = tid & 63;
  const int wm = wave >> 1, wn = wave & 1, l15 = lane & 15, quad = lane >> 4;
  for (int r = 0;; ++r) {
    const int g = xcd_tile(r, 128 * 8); if (g < 0) break;
    int mt, nt; tile_decode(g, 128, 8, mt, nt);
    f32x4 a1[4][4]; zero_acc(a1);
    gemm_dma(a1, p.o_r + (size_t)mt * 128 * 512, 512, p.wt_brr + (size_t)nt * 128 * 512, 512, 512, lds);
    u32x2 pk[4][4];
#pragma unroll
    for (int mi = 0; mi < 4; ++mi) {
      const int R = mt * 128 + wm * 64 + mi * 16 + l15;
#pragma unroll
      for (int ni = 0; ni < 4; ++ni) {
        const int c = nt * 128 + wn * 64 + ni * 16 + quad * 4;
        const u32x2 g1 = *(const u32x2*)(p.z + (size_t)R * NZ + C_MR + c);
        const f32x4 v1 = a1[mi][ni];
        pk[mi][ni][0] = pk2(bf_lo(g1[0]) * v1[0], bf_hi(g1[0]) * v1[1]);
        pk[mi][ni][1] = pk2(bf_lo(g1[1]) * v1[2], bf_hi(g1[1]) * v1[3]);
      }
    }
    zero_acc(a1);
    gemm_dma(a1, p.o_a + (size_t)mt * 128 * 512, 512, p.wt_bra + (size_t)nt * 128 * 512, 512, 512, lds);
#pragma unroll
    for (int mi = 0; mi < 4; ++mi) {
      const int R = mt * 128 + wm * 64 + mi * 16 + l15;
#pragma unroll
      for (int ni = 0; ni < 4; ++ni) {
        const int c = nt * 128 + wn * 64 + ni * 16 + quad * 4;
        const u32x2 g2 = *(const u32x2*)(p.z + (size_t)R * NZ + C_MA + c);
        const f32x4 v2 = a1[mi][ni]; const u32x2 u1 = pk[mi][ni];
        u32x2 o;
        o[0] = pk2(bf_lo(u1[0]) + bf_lo(g2[0]) * v2[0], bf_hi(u1[0]) + bf_hi(g2[0]) * v2[1]);
        o[1] = pk2(bf_lo(u1[1]) + bf_lo(g2[1]) * v2[2], bf_hi(u1[1]) + bf_hi(g2[1]) * v2[3]);
        *(u32x2*)(p.hn + (size_t)R * DM + c) = o;
      }
    }
  }
  for (int t = blockIdx.x; t < 512; t += gridDim.x) mini_merge(p, l, t, lds);
}
DI void phase_out(const Params& p, int l, char* lds) {
  const int tid = tid_(), wave = __builtin_amdgcn_readfirstlane(tid >> 6), lane = tid & 63;
  const int wm = wave >> 1, wn = wave & 1, l15 = lane & 15, quad = lane >> 4;
  for (int r = 0;; ++r) {
    const int g = xcd_tile(r, 128 * 8); if (g < 0) break;
    int mt, nt; tile_decode(g, 128, 8, mt, nt);
    f32x4 acc[4][4]; zero_acc(acc);
    gemm_dma(acc, p.hn + (size_t)mt * 128 * DM, DM, p.wt_out + (size_t)nt * 128 * DM, DM, DM, lds);
#pragma unroll
    for (int mi = 0; mi < 4; ++mi) {
      const int R = mt * 128 + wm * 64 + mi * 16 + l15;
      const float* xr = x_row(p, l, R);
      const float* g2 = p.ple_norm_g + l * DM;
      bf16_t* xb = p.o_r + (size_t)R * DM;
      float sq = 0.f;
#pragma unroll
      for (int ni = 0; ni < 4; ++ni) {
        const int c = nt * 128 + wn * 64 + ni * 16 + quad * 4;
        const f32x4 xv = *(const f32x4*)(xr + c);
        const f32x4 x1 = xv + acc[mi][ni];
        *(f32x4*)(p.out + (size_t)R * DM + c) = x1;
        const f32x4 gv = *(const f32x4*)(g2 + c);
        u32x2 o; o[0] = pk2(x1[0] * gv[0], x1[1] * gv[1]); o[1] = pk2(x1[2] * gv[2], x1[3] * gv[3]);
        *(u32x2*)(xb + c) = o;
        sq += x1[0] * x1[0] + x1[1] * x1[1] + x1[2] * x1[2] + x1[3] * x1[3];
      }
      sq += __shfl_xor(sq, 16); sq += __shfl_xor(sq, 32);
      if (quad == 0) atomicAdd(p.ss2 + R, sq);
    }
  }
  for (int t = blockIdx.x; t < 512; t += gridDim.x) mini_out(p, l, t, lds);
}
DI void phase_ple(const Params& p, int l, char* lds) {
  const int tid = tid_(), wave = __builtin_amdgcn_readfirstlane(tid >> 6), lane = tid & 63;
  const int wm = wave >> 1, wn = wave & 1, l15 = lane & 15, quad = lane >> 4;
  for (int r = 0;; ++r) {
    const int g = xcd_tile(r, 128 * 8); if (g < 0) break;
    int mt, nt; tile_decode(g, 128, 8, mt, nt);
    f32x4 a1[4][4]; zero_acc(a1);
    gemm_dma(a1, p.o_r + (size_t)mt * 128 * DM, DM, p.wt_gate + (size_t)nt * 128 * DM, DM, DM, lds);
    u32x2 pk[4][4];
#pragma unroll
    for (int mi = 0; mi < 4; ++mi) {
      const float rs = rsqrtf(p.ss2[mt * 128 + wm * 64 + mi * 16 + l15] * (1.0f / 1024.0f) + 1e-6f);
#pragma unroll
      for (int ni = 0; ni < 4; ++ni) { const f32x4 v = a1[mi][ni] * rs; pk[mi][ni][0] = pk2(sigmoidf_(v[0]), sigmoidf_(v[1])); pk[mi][ni][1] = pk2(sigmoidf_(v[2]), sigmoidf_(v[3])); }
    }
    zero_acc(a1);
    const int r0 = mt * 128;
    const float* pa = r0 < MP ? p.pp + ((size_t)l * MP + r0) * 256 : p.ps + ((size_t)l * MS + (r0 - MP)) * 256;
    gemm_core<true>(a1, pa, 256, p.wt_ple + (size_t)nt * 128 * 256, 256, 256, lds);
#pragma unroll
    for (int mi = 0; mi < 4; ++mi) {
      const int R = mt * 128 + wm * 64 + mi * 16 + l15;
      float sq = 0.f;
#pragma unroll
      for (int ni = 0; ni < 4; ++ni) {
        const int c = nt * 128 + wn * 64 + ni * 16 + quad * 4;
        float* xo = p.out + (size_t)R * DM + c;
        const f32x4 xv = *(const f32x4*)xo; const f32x4 e = a1[mi][ni]; const u32x2 g = pk[mi][ni];
        f32x4 o;
        o[0] = xv[0] + e[0] * bf_lo(g[0]); o[1] = xv[1] + e[1] * bf_hi(g[0]);
        o[2] = xv[2] + e[2] * bf_lo(g[1]); o[3] = xv[3] + e[3] * bf_hi(g[1]);
        *(f32x4*)xo = o;
        if (l + 1 < NL) {
          const f32x4 gn = *(const f32x4*)(p.norm_g + (l + 1) * DM + c);
          u32x2 hv; hv[0] = pk2(o[0] * gn[0], o[1] * gn[1]); hv[1] = pk2(o[2] * gn[2], o[3] * gn[3]);
          *(u32x2*)(p.hn + (size_t)R * DM + c) = hv;
          sq += o[0] * o[0] + o[1] * o[1] + o[2] * o[2] + o[3] * o[3];
        }
      }
      if (l + 1 < NL) {
        sq += __shfl_xor(sq, 16); sq += __shfl_xor(sq, 32);
        if (quad == 0) atomicAdd(p.ss1 + R, sq);
      }
    }
  }
  for (int t = blockIdx.x; t < 512; t += gridDim.x) mini_ple(p, l, t, lds);
  if (l + 1 < NL) {
    for (int it = blockIdx.x; it < 2080 + 16 + 2048; it += gridDim.x) {
      if (it < 2080) wconv_tile(p, l + 1, it, (float*)lds);
      else if (it < 2096) wconv_tile(p, l + 1, 2400 + (it - 2080), (float*)lds);
      else cache_item(p, l + 1, it - 2096, lds);
    }
  }
}


#define XB_TMO      128
#define XB_XCNT(j)  (256  + 64 * (j))
#define XB_XSUB(j)  (1280 + 64 * (j))
#define XB_XGEN(j)  (2304 + 64 * (j))
#define XB_TOP      3328
#define XB_TOPGEN   3392
#define XB_SPIN_CAP (1u << 18)
#define LAS __attribute__((address_space(3)))
DI unsigned xb_ld(unsigned* p)              { return __hip_atomic_load(p, __ATOMIC_RELAXED, __HIP_MEMORY_SCOPE_AGENT); }
DI unsigned xb_add(unsigned* p, unsigned v) { return __hip_atomic_fetch_add(p, v, __ATOMIC_RELAXED, __HIP_MEMORY_SCOPE_AGENT); }
DI unsigned xb_xcc_id() { return (unsigned)__builtin_amdgcn_s_getreg((3 << 11) | 20) & 0xFu; }
#define XB_SPIN(cond, bar) do { unsigned _sp = 0; while (cond) { __builtin_amdgcn_s_sleep(1); \
    if ((++_sp & 255u) == 0u) { if (xb_ld(&(bar)[XB_TMO])) break; if (_sp > XB_SPIN_CAP) { atomicAdd(&(bar)[XB_TMO], 1u); break; } } } } while (0)
struct XcdBarrier { unsigned* bar; unsigned x; volatile LAS unsigned* st; };
DI XcdBarrier xcd_barrier_post(unsigned* bar, volatile LAS unsigned* st) {
  XcdBarrier b; b.bar = bar; b.x = xb_xcc_id(); b.st = st;
  if (threadIdx.x == 0) (void)xb_add(&bar[XB_XCNT(b.x)], 1u);
  return b;
}
DI void xcd_barrier_complete(unsigned* bar, unsigned x, unsigned& nloc, unsigned& nx) {
  const unsigned G = gridDim.x * gridDim.y * gridDim.z;
  unsigned sum, cnt, mine, sp = 0u;
  for (;;) {
    sum = 0u; cnt = 0u; mine = 0u;
#pragma unroll
    for (unsigned j = 0; j < 16; ++j) { const unsigned c = xb_ld(&bar[XB_XCNT(j)]); sum += c; cnt += (c > 0u) ? 1u : 0u; mine = (j == x) ? c : mine; }
    if (sum == G) break;
    __builtin_amdgcn_s_sleep(1);
    if ((++sp & 255u) == 0u) { if (xb_ld(&bar[XB_TMO])) break; if (sp > XB_SPIN_CAP) { atomicAdd(&bar[XB_TMO], 1u); break; } }
  }
  nloc = mine > 0u ? mine : 1u; nx = cnt > 0u ? cnt : 1u;
}
DI void xcd_barrier(const XcdBarrier& b) {
  asm volatile("s_waitcnt vmcnt(0)" ::: "memory");
  __syncthreads();
  if (threadIdx.x == 0) {
    unsigned* bar = b.bar;
    __builtin_amdgcn_s_waitcnt(0);
    unsigned nloc = b.st[0], nx = b.st[1];
    if (nloc == 0u) { xcd_barrier_complete(bar, b.x, nloc, nx); b.st[0] = nloc; b.st[1] = nx; }
    const unsigned old = xb_add(&bar[XB_XSUB(b.x)], 1u);
    const unsigned gen = old / nloc;
    if (old + 1u == (gen + 1u) * nloc) {
      __builtin_amdgcn_fence(__ATOMIC_RELEASE, "agent");
      asm volatile("s_waitcnt vmcnt(0)" ::: "memory");
      const unsigned og = xb_add(&bar[XB_TOP], 1u);
      const unsigned tg = og / nx;
      if (og + 1u == (tg + 1u) * nx) xb_add(&bar[XB_TOPGEN], 1u);
      else XB_SPIN(xb_ld(&bar[XB_TOPGEN]) == tg, bar);
      __builtin_amdgcn_fence(__ATOMIC_ACQUIRE, "agent");
      xb_add(&bar[XB_XGEN(b.x)], 1u);
      asm volatile("s_waitcnt vmcnt(0)" ::: "memory");
    } else {
      XB_SPIN(xb_ld(&bar[XB_XGEN(b.x)]) == gen, bar);
      __builtin_amdgcn_fence(__ATOMIC_ACQUIRE, "agent");
      asm volatile("s_waitcnt vmcnt(0)" ::: "memory");
    }
  }
  __syncthreads();
}
constexpr int LDS_BYTES = 73728;
DI void run_phase(const Params& p, int ph, int l, char* lds) {
  switch (ph) {
    case 1: phase_norm0(p, lds); break;
    case 2: phase_gemm_in(p, l, lds); break;
    case 3: phase_mix(p, l, lds); break;
    case 4: phase_merge(p, l, lds); break;
    case 5: phase_out(p, l, lds); break;
    case 6: break;
    case 7: phase_ple(p, l, lds); break;
    case 8: phase_chunk(p, l, lds); break;
  }
}

#if MEGA
__global__ void __launch_bounds__(256, 2) k_mega(Params p) {
  __shared__ __attribute__((aligned(16))) char lds[LDS_BYTES];
  __shared__ uint4 xb_words;
  cg::grid_group grid = cg::this_grid();
  if (threadIdx.x == 0) xb_words = make_uint4(0u, 0u, 0u, 0u);
  __syncthreads();
  const XcdBarrier xb = xcd_barrier_post(p.bar, (volatile LAS unsigned*)&xb_words);
  phase_norm0(p, lds);
  grid.sync();
#pragma unroll 1
  for (int l = 0; l < NL; ++l) {
    phase_gemm_in(p, l, lds); xcd_barrier(xb);
    phase_chunk(p, l, lds); xcd_barrier(xb);
    phase_mix(p, l, lds); xcd_barrier(xb);
    phase_o(p, l); xcd_barrier(xb);
    phase_merge(p, l, lds); xcd_barrier(xb);
    phase_out(p, l, lds); xcd_barrier(xb);
    phase_ple(p, l, lds); if (l + 1 < NL) xcd_barrier(xb);
  }
}
#else
template <int PH>
__global__ void __launch_bounds__(256, 2) k_phase(Params p, int l) {
  __shared__ __attribute__((aligned(16))) char lds[LDS_BYTES];
  run_phase(p, PH, l, lds);
}
#endif

extern "C" void kernel_launch(void* const* d_in, const int* in_sizes, int n_in, void* d_out, int out_size, void* d_ws, size_t ws_size,
                              hipStream_t stream) {
  Params p{};
  const float** pf = (const float**)&p;
  for (int i = 0; i < 33; ++i) pf[i] = (const float*)d_in[i];
  p.out = (float*)d_out;
  char* w = (char*)d_ws; size_t off = 0;
  auto take = [&](size_t bytes) { char* r = w + off; off += (bytes + 255) & ~(size_t)255; return (bf16_t*)r; };
  p.gS = take((size_t)(NCH + 1) * 4096 * 2);
  p.ss1 = (float*)take((size_t)MT * 4); p.ss2 = (float*)take((size_t)MT * 4);
  p.bar = (unsigned*)take((size_t)(XCD_BAR_WORDS + 64 * NL) * 4);
  p.wt_in = take((size_t)NZ * 1024 * 2);
  p.wt_brr = take((size_t)1024 * 512 * 2);
  p.wt_bra = take((size_t)1024 * 512 * 2);
  p.wt_out = take((size_t)1024 * 1024 * 2);
  p.wt_ple = take((size_t)1024 * 256 * 2);
  p.wt_gate = take((size_t)1024 * 1024 * 2);
  p.w2t = take((size_t)512 * 64 * 2);
  p.a2t = take((size_t)512 * 64 * 2);
  p.z = take((size_t)MT * NZ * 2);
  p.vtp = take((size_t)16 * 128 * 4096 * 2);
  p.vts = take((size_t)32 * 128 * 64 * 2);
  p.kc = take((size_t)8 * 1024 * 512 * 2);
  p.vct = take((size_t)32 * 128 * 1024 * 2);
  p.o_r = take((size_t)MT * 512 * 2);
  p.o_a = take((size_t)MT * 512 * 2);
  p.hn = take((size_t)MT * DM * 2);
  p.cPT = p.hn;
  p.cG = take((size_t)NCH * 4096 * 2);
  p.cRT = take((size_t)NCH * 2048 * 2);
  p.cOI = take((size_t)NCH * 2048 * 2);
  p.cBA = take((size_t)NCH * 2048 * 2);
  if (off > ws_size) { fprintf(stderr, "workspace too small: need %zu have %zu\n", off, ws_size); return; }
#if MEGA
  hipMemsetAsync(p.bar, 0, (size_t)(XCD_BAR_WORDS + 64 * NL) * 4, stream);
  static int grid_blocks = 0;
  if (!grid_blocks) {
    int dev = 0, cus = 0, per_cu = 0;
    hipGetDevice(&dev);
    hipDeviceGetAttribute(&cus, hipDeviceAttributeMultiprocessorCount, dev);
    hipOccupancyMaxActiveBlocksPerMultiprocessor(&per_cu, k_mega, 256, 0);
    if (per_cu > 2) per_cu = 2;
    grid_blocks = cus * per_cu;
  }
  void* args[] = {&p};
  hipError_t e = hipLaunchCooperativeKernel((void*)k_mega, dim3(grid_blocks), dim3(256), args, 0, stream);
  if (e != hipSuccess) fprintf(stderr, "cooperative launch failed: %s (grid %d)\n", hipGetErrorString(e), grid_blocks);
#else
  const int G = 512;
  for (int l = 0; l < NL; ++l) {
    k_phase<1><<<G, 256, 0, stream>>>(p, l);
    k_phase<2><<<G, 256, 0, stream>>>(p, l);
    k_phase<8><<<G, 256, 0, stream>>>(p, l);
    k_phase<3><<<G, 256, 0, stream>>>(p, l);
    k_phase<4><<<G, 256, 0, stream>>>(p, l);
    k_phase<5><<<G, 256, 0, stream>>>(p, l);
    k_phase<6><<<G, 256, 0, stream>>>(p, l);
    k_phase<7><<<G, 256, 0, stream>>>(p, l);
  }
#endif
}
```

```cpp
#include <hip/hip_runtime.h>
#include <hip/hip_cooperative_groups.h>
#include <stdint.h>
#include <stdio.h>
namespace cg = cooperative_groups;

#ifndef MEGA
#define MEGA 1
#endif

typedef unsigned short bf16_t;
typedef short bf16x8 __attribute__((ext_vector_type(8)));
typedef short s16x4 __attribute__((ext_vector_type(4)));
typedef float f32x4 __attribute__((ext_vector_type(4)));
typedef float f32x2 __attribute__((ext_vector_type(2)));
typedef float f32x16 __attribute__((ext_vector_type(16)));
typedef unsigned u32x4 __attribute__((ext_vector_type(4)));
typedef unsigned u32x2 __attribute__((ext_vector_type(2)));
typedef __bf16 bfv2 __attribute__((ext_vector_type(2)));

#define DI __device__ __forceinline__
#define XCD_BAR_WORDS 3456
DI int tid_() { int t = threadIdx.x; asm volatile("" : "+v"(t)); return t; }

constexpr int DM = 1024, MP = 16384, MS = 512, MT = 16896, NZ = 6272, NL = 4;
constexpr int C_GR = 1664, C_Q = 2176, C_K = 2688, C_V = 3200, C_GA = 3712, C_MR = 4224, C_MA = 5248;
constexpr int SHC = 1664;
constexpr size_t O_YP = 0, O_YS = 16777216, O_KP = 17301504, O_VP = 50855936, O_WP = 84410368, O_SP = 84934656,
                 O_KS = 84961280, O_VS = 86009856, O_WS = 87058432, O_SS = 88107008;

struct Params {
  const float *xp, *xs, *pp, *ps, *ck, *cv, *swkv, *sshift;
  const float *norm_g, *w_in, *shift_mu, *decay_w0, *decay_w2, *iclr_a0, *iclr_a2, *k_k, *k_a, *r_k, *lnx_g, *lnx_b,
      *qng, *kng, *lq1, *lk1, *lq2, *lk2, *subln_g, *w_br_r, *w_br_a, *w_out, *ple_w, *ple_gate_w, *ple_norm_g;
  float* out;
  bf16_t *wt_in, *wt_brr, *wt_bra, *wt_out, *wt_ple, *wt_gate, *w2t, *a2t;
  bf16_t *hn, *z, *vtp, *vts, *kc, *vct, *o_r, *o_a;
  bf16_t *cPT, *cG, *cRT, *cOI, *cBA;
  unsigned* bar;
  float *ss1, *ss2;
  bf16_t* gS;
};

DI unsigned pk2(float a, float b) { f32x2 v = {a, b}; bfv2 r = __builtin_convertvector(v, bfv2); return __builtin_bit_cast(unsigned, r); }
DI float bf_lo(unsigned u) { return __uint_as_float(u << 16); }
DI float bf_hi(unsigned u) { return __uint_as_float(u & 0xffff0000u); }
DI float bf1(bf16_t u) { return __uint_as_float(((unsigned)u) << 16); }
DI float sigmoidf_(float x) { return __builtin_amdgcn_rcpf(1.0f + __expf(-x)); }
DI float siluf_(float x) { return x * __builtin_amdgcn_rcpf(1.0f + __expf(-x)); }

DI void tr_tile(const float* __restrict__ src, int ld_src, bf16_t* __restrict__ dst, int ld_dst, float* sm) {
  const int tid = tid_();
  const int r = tid >> 4, c4 = (tid & 15) * 4;
#pragma unroll
  for (int i = 0; i < 4; ++i) {
    const int row = r + 16 * i;
    f32x4 v = *(const f32x4*)(src + (size_t)row * ld_src + c4);
    sm[row * 65 + c4 + 0] = v[0]; sm[row * 65 + c4 + 1] = v[1]; sm[row * 65 + c4 + 2] = v[2]; sm[row * 65 + c4 + 3] = v[3];
  }
  __syncthreads();
  const int n = tid >> 2, ks = (tid & 3) * 16;
  u32x4 o0, o1;
  o0[0] = pk2(sm[(ks + 0) * 65 + n], sm[(ks + 1) * 65 + n]);   o0[1] = pk2(sm[(ks + 2) * 65 + n], sm[(ks + 3) * 65 + n]);
  o0[2] = pk2(sm[(ks + 4) * 65 + n], sm[(ks + 5) * 65 + n]);   o0[3] = pk2(sm[(ks + 6) * 65 + n], sm[(ks + 7) * 65 + n]);
  o1[0] = pk2(sm[(ks + 8) * 65 + n], sm[(ks + 9) * 65 + n]);   o1[1] = pk2(sm[(ks + 10) * 65 + n], sm[(ks + 11) * 65 + n]);
  o1[2] = pk2(sm[(ks + 12) * 65 + n], sm[(ks + 13) * 65 + n]); o1[3] = pk2(sm[(ks + 14) * 65 + n], sm[(ks + 15) * 65 + n]);
  *(u32x4*)(dst + (size_t)n * ld_dst + ks) = o0;
  *(u32x4*)(dst + (size_t)n * ld_dst + ks + 8) = o1;
  __syncthreads();
}

constexpr int WCONV_TILES = 1568 + 128 + 128 + 256 + 64 + 256 + 8 + 8;
DI void wconv_tile(const Params& p, int l, int t, float* sm) {
  const float* src; bf16_t* dst; int K, N;
  if (t < 1568) { src = p.w_in + (size_t)l * 1024 * NZ; dst = p.wt_in; K = 1024; N = NZ; }
  else if ((t -= 1568) < 128) { src = p.w_br_r + (size_t)l * 512 * 1024; dst = p.wt_brr; K = 512; N = 1024; }
  else if ((t -= 128) < 128) { src = p.w_br_a + (size_t)l * 512 * 1024; dst = p.wt_bra; K = 512; N = 1024; }
  else if ((t -= 128) < 256) { src = p.w_out + (size_t)l * 1024 * 1024; dst = p.wt_out; K = 1024; N = 1024; }
  else if ((t -= 256) < 64) { src = p.ple_w + (size_t)l * 256 * 1024; dst = p.wt_ple; K = 256; N = 1024; }
  else if ((t -= 64) < 256) { src = p.ple_gate_w + (size_t)l * 1024 * 1024; dst = p.wt_gate; K = 1024; N = 1024; }
  else if ((t -= 256) < 8) { src = p.decay_w2 + (size_t)l * 64 * 512; dst = p.w2t; K = 64; N = 512; }
  else { t -= 8; src = p.iclr_a2 + (size_t)l * 64 * 512; dst = p.a2t; K = 64; N = 512; }
  const int ntn = N / 64; const int tk = t / ntn, tn = t % ntn;
  tr_tile(src + (size_t)(tk * 64) * N + tn * 64, N, dst + (size_t)(tn * 64) * K + tk * 64, K, sm);
}

DI const float* x_row(const Params& p, int l, int r) {
  if (l == 0) return r < MP ? p.xp + (size_t)r * DM : p.xs + (size_t)(r - MP) * DM;
  return p.out + (size_t)r * DM;
}
DI void cache_item(const Params& p, int l, int c, char* lds) {
  const int tid = tid_();
  if (c < 1024) {
    const float* src = p.ck + (size_t)l * 8 * 1024 * 512 + (size_t)c * 4096 + tid * 16;
    bf16_t* dst = p.kc + (size_t)c * 4096 + tid * 16;
    f32x4 a0 = *(const f32x4*)(src), a1 = *(const f32x4*)(src + 4), a2 = *(const f32x4*)(src + 8), a3 = *(const f32x4*)(src + 12);
    u32x4 o0, o1;
    o0[0] = pk2(a0[0], a0[1]); o0[1] = pk2(a0[2], a0[3]); o0[2] = pk2(a1[0], a1[1]); o0[3] = pk2(a1[2], a1[3]);
    o1[0] = pk2(a2[0], a2[1]); o1[1] = pk2(a2[2], a2[3]); o1[2] = pk2(a3[0], a3[1]); o1[3] = pk2(a3[2], a3[3]);
    *(u32x4*)dst = o0; *(u32x4*)(dst + 8) = o1;
  } else {
    c -= 1024;
    const int bh = c >> 5, tt = c & 31; const int b = bh >> 2, h = bh & 3; const int tk = tt >> 1, tn = tt & 1;
    const float* src = p.cv + (size_t)l * 8 * 1024 * 512 + ((size_t)(b * 1024 + tk * 64)) * 512 + h * 128 + tn * 64;
    bf16_t* dst = p.vct + ((size_t)(bh * 128 + tn * 64)) * 1024 + tk * 64;
    tr_tile(src, 512, dst, 1024, (float*)lds);
  }
}
DI void phase_norm0(const Params& p, char* lds) {
  const int tid = tid_(), wave = __builtin_amdgcn_readfirstlane(tid >> 6), lane = tid & 63;
  const float* g = p.norm_g;
  const int n_norm = MT / 8;
  const int n_items = n_norm + 2048 + WCONV_TILES;
  for (int it = blockIdx.x; it < n_items; it += gridDim.x) {
    if (it < n_norm) {
      const int r0 = it * 8 + wave * 2;
      f32x4 v[2][4]; float ss[2] = {0.f, 0.f};
#pragma unroll
      for (int k = 0; k < 2; ++k) {
        const float* x = x_row(p, 0, r0 + k);
#pragma unroll
        for (int i = 0; i < 4; ++i) v[k][i] = *(const f32x4*)(x + lane * 4 + 256 * i);
      }
      f32x4 gv[4];
#pragma unroll
      for (int i = 0; i < 4; ++i) gv[i] = *(const f32x4*)(g + lane * 4 + 256 * i);
#pragma unroll
      for (int k = 0; k < 2; ++k) {
#pragma unroll
        for (int i = 0; i < 4; ++i) ss[k] += v[k][i][0] * v[k][i][0] + v[k][i][1] * v[k][i][1] + v[k][i][2] * v[k][i][2] + v[k][i][3] * v[k][i][3];
#pragma unroll
        for (int o = 32; o >= 1; o >>= 1) ss[k] += __shfl_xor(ss[k], o);
        const float rstd = rsqrtf(ss[k] * (1.0f / 1024.0f) + 1e-6f);
#pragma unroll
        for (int i = 0; i < 4; ++i) {
          u32x2 o; o[0] = pk2(v[k][i][0] * rstd * gv[i][0], v[k][i][1] * rstd * gv[i][1]); o[1] = pk2(v[k][i][2] * rstd * gv[i][2], v[k][i][3] * rstd * gv[i][3]);
          *(u32x2*)(p.hn + (size_t)(r0 + k) * DM + lane * 4 + 256 * i) = o;
        }
        if (lane == 0) p.ss1[r0 + k] = 1024.0f * (1.0f - 1e-6f);
      }
    } else if (it < n_norm + 2048) {
      cache_item(p, 0, it - n_norm, lds);
    } else {
      wconv_tile(p, 0, it - n_norm - 2048, (float*)lds);
    }
  }
}
DI void zero_f32(float* a, int n) {
  for (int i = blockIdx.x * 256 + tid_(); i < n; i += gridDim.x * 256) a[i] = 0.f;
}

constexpr int GLD = 72;
template <bool A_F32>
DI void gemm_core(f32x4 (&acc)[4][4], const void* Ap, int lda, const bf16_t* Bp, int ldb, int K, char* lds) {
  bf16_t* As = (bf16_t*)lds;
  bf16_t* Bs = (bf16_t*)(lds + 2 * 128 * GLD * 2);
  const int tid = tid_(), wave = __builtin_amdgcn_readfirstlane(tid >> 6), lane = tid & 63;
  const int wm = wave >> 1, wn = wave & 1, l15 = lane & 15, quad = lane >> 4;
  const int nk = K / 64;
  u32x4 ra[4], rb[4];
  auto gload = [&](int kt) {
#pragma unroll
    for (int i = 0; i < 4; ++i) {
      const int c = tid + 256 * i; const int row = c >> 3, c8 = (c & 7) * 8;
      if (!A_F32) ra[i] = *(const u32x4*)((const bf16_t*)Ap + (size_t)row * lda + kt * 64 + c8);
      rb[i] = *(const u32x4*)(Bp + (size_t)row * ldb + kt * 64 + c8);
    }
  };
  auto sstore = [&](int buf, int kt) {
#pragma unroll
    for (int i = 0; i < 4; ++i) {
      const int c = tid + 256 * i; const int row = c >> 3, c8 = (c & 7) * 8;
      if (A_F32) {
        const float* a = (const float*)Ap + (size_t)row * lda + kt * 64 + c8;
        const f32x4 v0 = *(const f32x4*)a, v1 = *(const f32x4*)(a + 4);
        u32x4 t; t[0] = pk2(v0[0], v0[1]); t[1] = pk2(v0[2], v0[3]); t[2] = pk2(v1[0], v1[1]); t[3] = pk2(v1[2], v1[3]);
        *(u32x4*)(As + (buf * 128 + row) * GLD + c8) = t;
      } else {
        *(u32x4*)(As + (buf * 128 + row) * GLD + c8) = ra[i];
      }
      *(u32x4*)(Bs + (buf * 128 + row) * GLD + c8) = rb[i];
    }
  };
  gload(0); sstore(0, 0); __syncthreads();
  for (int kt = 0; kt < nk; ++kt) {
    const int buf = kt & 1;
    if (kt + 1 < nk) gload(kt + 1);
#pragma unroll
    for (int ks = 0; ks < 2; ++ks) {
      bf16x8 af[4], bfr[4];
#pragma unroll
      for (int i = 0; i < 4; ++i) {
        af[i] = *(const bf16x8*)(As + (buf * 128 + wm * 64 + i * 16 + l15) * GLD + ks * 32 + quad * 8);
        bfr[i] = *(const bf16x8*)(Bs + (buf * 128 + wn * 64 + i * 16 + l15) * GLD + ks * 32 + quad * 8);
      }
#pragma unroll
      for (int mi = 0; mi < 4; ++mi)
#pragma unroll
        for (int ni = 0; ni < 4; ++ni) acc[mi][ni] = __builtin_amdgcn_mfma_f32_16x16x32_bf16(bfr[ni], af[mi], acc[mi][ni], 0, 0, 0);
    }
    if (kt + 1 < nk) sstore(buf ^ 1, kt + 1);
    __syncthreads();
  }
}
#define LASP __attribute__((address_space(3)))
DI void gemm_dma(f32x4 (&acc)[4][4], const bf16_t* Ap, int lda, const bf16_t* Bp, int ldb, int K, char* lds) {
  const int tid = tid_(), wave = __builtin_amdgcn_readfirstlane(tid >> 6), lane = tid & 63;
  const int wm = wave >> 1, wn = wave & 1, l15 = lane & 15, quad = lane >> 4;
  const int nk = K / 64;
  const int lrow = lane >> 3, lpc = lane & 7;
  const bf16_t* ga[4]; const bf16_t* gb[4];
#pragma unroll
  for (int i = 0; i < 4; ++i) {
    const int row = (wave * 4 + i) * 8 + lrow; const int q = lpc ^ (row & 7);
    ga[i] = Ap + (size_t)row * lda + q * 8; gb[i] = Bp + (size_t)row * ldb + q * 8;
  }
  auto issue = [&](int kt) {
    char* sb = lds + (kt & 1) * 32768 + wave * 4096;
#pragma unroll
    for (int i = 0; i < 4; ++i) {
      __builtin_amdgcn_global_load_lds((const unsigned*)(ga[i] + kt * 64), (LASP unsigned*)(sb + i * 1024), 16, 0, 0);
      __builtin_amdgcn_global_load_lds((const unsigned*)(gb[i] + kt * 64), (LASP unsigned*)(sb + 16384 + i * 1024), 16, 0, 0);
    }
  };
  const int sw = l15 & 7;
  const unsigned lbase = (unsigned)(size_t)(LASP char*)lds;
  const unsigned a0 = (unsigned)((wm * 64 + l15) * 128 + ((quad ^ sw) * 16)), a1 = (unsigned)((wm * 64 + l15) * 128 + (((4 + quad) ^ sw) * 16));
  const unsigned b0 = 16384u + (unsigned)((wn * 64 + l15) * 128 + ((quad ^ sw) * 16)), b1 = 16384u + (unsigned)((wn * 64 + l15) * 128 + (((4 + quad) ^ sw) * 16));
  asm volatile("s_waitcnt vmcnt(0)" ::: "memory");
  __builtin_amdgcn_s_barrier();
  asm volatile("" ::: "memory");
  issue(0);
  for (int kt = 0; kt < nk; ++kt) {
    asm volatile("s_waitcnt vmcnt(0)" ::: "memory");
    __builtin_amdgcn_s_barrier();
    asm volatile("" ::: "memory");
    if (kt + 1 < nk) issue(kt + 1);
    const unsigned sa = lbase + (unsigned)((kt & 1) * 32768);
    bf16x8 af[4], bfr[4], ag[4], bg[4];
    asm volatile("ds_read_b128 %0, %8\n\tds_read_b128 %1, %8 offset:2048\n\tds_read_b128 %2, %8 offset:4096\n\tds_read_b128 %3, %8 offset:6144\n\t"
                 "ds_read_b128 %4, %9\n\tds_read_b128 %5, %9 offset:2048\n\tds_read_b128 %6, %9 offset:4096\n\tds_read_b128 %7, %9 offset:6144"
                 : "=&v"(af[0]), "=&v"(af[1]), "=&v"(af[2]), "=&v"(af[3]), "=&v"(bfr[0]), "=&v"(bfr[1]), "=&v"(bfr[2]), "=&v"(bfr[3])
                 : "v"(sa + a0), "v"(sa + b0) : "memory");
    asm volatile("ds_read_b128 %0, %16\n\tds_read_b128 %1, %16 offset:2048\n\tds_read_b128 %2, %16 offset:4096\n\tds_read_b128 %3, %16 offset:6144\n\t"
                 "ds_read_b128 %4, %17\n\tds_read_b128 %5, %17 offset:2048\n\tds_read_b128 %6, %17 offset:4096\n\tds_read_b128 %7, %17 offset:6144\n\t"
                 "s_waitcnt lgkmcnt(8)"
                 : "=&v"(ag[0]), "=&v"(ag[1]), "=&v"(ag[2]), "=&v"(ag[3]), "=&v"(bg[0]), "=&v"(bg[1]), "=&v"(bg[2]), "=&v"(bg[3]),
                   "+v"(af[0]), "+v"(af[1]), "+v"(af[2]), "+v"(af[3]), "+v"(bfr[0]), "+v"(bfr[1]), "+v"(bfr[2]), "+v"(bfr[3])
                 : "v"(sa + a1), "v"(sa + b1) : "memory");
#pragma unroll
    for (int mi = 0; mi < 4; ++mi)
#pragma unroll
      for (int ni = 0; ni < 4; ++ni) acc[mi][ni] = __builtin_amdgcn_mfma_f32_16x16x32_bf16(bfr[ni], af[mi], acc[mi][ni], 0, 0, 0);
    asm volatile("s_waitcnt lgkmcnt(0)" : "+v"(ag[0]), "+v"(ag[1]), "+v"(ag[2]), "+v"(ag[3]), "+v"(bg[0]), "+v"(bg[1]), "+v"(bg[2]), "+v"(bg[3]) :: "memory");
#pragma unroll
    for (int mi = 0; mi < 4; ++mi)
#pragma unroll
      for (int ni = 0; ni < 4; ++ni) acc[mi][ni] = __builtin_amdgcn_mfma_f32_16x16x32_bf16(bg[ni], ag[mi], acc[mi][ni], 0, 0, 0);
  }
  asm volatile("" ::: "memory");
  __builtin_amdgcn_s_barrier();
  asm volatile("" ::: "memory");
}
DI void zero_acc(f32x4 (&acc)[4][4]) {
#pragma unroll
  for (int i = 0; i < 4; ++i)
#pragma unroll
    for (int j = 0; j < 4; ++j) acc[i][j] = (f32x4){0.f, 0.f, 0.f, 0.f};
}

DI int xcd_tile(int r, int T) {
  const int x = blockIdx.x & 7, j = blockIdx.x >> 3, nb = gridDim.x >> 3;
  if (j >= nb) return -1;
  const int start = (int)(((long)x * T) / 8), end = (int)(((long)(x + 1) * T) / 8);
  const int g = start + r * nb + j;
  return g < end ? g : -1;
}
DI void tile_decode(int g, int nM, int nN, int& mt, int& nt) {
  const int per = 8 * nN; const int grp = g / per, idx = g - grp * per; const int gm0 = grp * 8;
  const int gsz = (nM - gm0) < 8 ? (nM - gm0) : 8;
  nt = idx / gsz; mt = gm0 + (idx - nt * gsz);
}
DI void phase_gemm_in(const Params& p, int l, char* lds) {
  const int tid = tid_(), wave = __builtin_amdgcn_readfirstlane(tid >> 6), lane = tid & 63;
  const int wm = wave >> 1, wn = wave & 1, l15 = lane & 15, quad = lane >> 4;
  const bf16_t* Wt = p.wt_in;
  const int NTN = 49, NTM = 132;
  for (int r = 0;; ++r) {
    const int g = xcd_tile(r, NTN * NTM); if (g < 0) break;
    int mt, nt; tile_decode(g, NTM, NTN, mt, nt);
    f32x4 acc[4][4]; zero_acc(acc);
    gemm_dma(acc, p.hn + (size_t)mt * 128 * DM, DM, Wt + (size_t)nt * 128 * DM, DM, DM, lds);
    const int colb = nt * 128 + wn * 64 + quad * 4;
    {
#pragma unroll
      for (int mi = 0; mi < 4; ++mi) {
        const float rs = rsqrtf(p.ss1[mt * 128 + wm * 64 + mi * 16 + l15] * (1.0f / 1024.0f) + 1e-6f);
#pragma unroll
        for (int ni = 0; ni < 4; ++ni) acc[mi][ni] = acc[mi][ni] * rs;
      }
    }
    int kind;
    if (nt < 13) kind = 0; else if (nt < 17) kind = 1; else if (nt < 21) kind = 2; else if (nt < 25) kind = 3; else if (nt < 29) kind = 4; else if (nt < 33) kind = 1; else kind = 5;
#pragma unroll
    for (int mi = 0; mi < 4; ++mi) {
      const int R = mt * 128 + wm * 64 + mi * 16 + l15;
      const bool isp = R < MP; const int rs = R - MP;
      bf16_t* zrow = p.z + (size_t)R * NZ;
      if (kind == 0) {
        const bool last = isp ? ((R & 4095) == 4095) : ((rs & 63) == 63);
        float* so = isp ? p.out + O_SP + (size_t)(l * 4 + (R >> 12)) * SHC : p.out + O_SS + (size_t)(l * 8 + (rs >> 6)) * SHC;
#pragma unroll
        for (int ni = 0; ni < 4; ++ni) {
          const int c = colb + ni * 16; const f32x4 v = acc[mi][ni];
          u32x2 o; o[0] = pk2(v[0], v[1]); o[1] = pk2(v[2], v[3]); *(u32x2*)(zrow + c) = o;
          if (last) *(f32x4*)(so + c) = v;
        }
      } else if (kind == 1 || kind == 5) {
#pragma unroll
        for (int ni = 0; ni < 4; ++ni) {
          const int c = colb + ni * 16; f32x4 v = acc[mi][ni];
#pragma unroll
          for (int e = 0; e < 4; ++e) v[e] = (kind == 1) ? siluf_(v[e]) : sigmoidf_(v[e]);
          u32x2 o; o[0] = pk2(v[0], v[1]); o[1] = pk2(v[2], v[3]); *(u32x2*)(zrow + c) = o;
        }
      } else if (kind == 2 || kind == 3) {
        float ss = 0.f;
#pragma unroll
        for (int ni = 0; ni < 4; ++ni) { const f32x4 v = acc[mi][ni]; ss += v[0] * v[0] + v[1] * v[1] + v[2] * v[2] + v[3] * v[3]; }
        ss += __shfl_xor(ss, 16); ss += __shfl_xor(ss, 32);
        const float rstd = rsqrtf(ss * (1.0f / 64.0f) + 1e-6f);
        const float* g = (kind == 2 ? p.qng : p.kng) + l * 64;
        float* ko = isp ? p.out + O_KP + ((size_t)l * MP + R) * 512 : p.out + O_KS + ((size_t)l * MS + rs) * 512;
#pragma unroll
        for (int ni = 0; ni < 4; ++ni) {
          const int c = colb + ni * 16; const int d = ni * 16 + quad * 4;
          const f32x4 gv = *(const f32x4*)(g + d); f32x4 v = acc[mi][ni];
#pragma unroll
          for (int e = 0; e < 4; ++e) v[e] = v[e] * rstd * gv[e];
          u32x2 o; o[0] = pk2(v[0], v[1]); o[1] = pk2(v[2], v[3]); *(u32x2*)(zrow + c) = o;
          if (kind == 3) *(f32x4*)(ko + (c - C_K)) = v;
        }
      } else {
        float* vo = isp ? p.out + O_VP + ((size_t)l * MP + R) * 512 : p.out + O_VS + ((size_t)l * MS + rs) * 512;
#pragma unroll
        for (int ni = 0; ni < 4; ++ni) {
          const int cv = colb + ni * 16 - C_V; const f32x4 v = acc[mi][ni];
          *(f32x4*)(vo + cv) = v;
          const int h = cv >> 7, vd = cv & 127;
          if (isp) {
            bf16_t* vt = p.vtp + ((size_t)(((R >> 12) * 4 + h) * 128 + vd)) * 4096 + (R & 4095);
#pragma unroll
            for (int e = 0; e < 4; ++e) vt[(size_t)e * 4096] = (bf16_t)(pk2(v[e], 0.f) & 0xffff);
          } else {
            bf16_t* vt = p.vts + ((size_t)(((rs >> 6) * 4 + h) * 128 + vd)) * 64 + (rs & 63);
#pragma unroll
            for (int e = 0; e < 4; ++e) vt[(size_t)e * 64] = (bf16_t)(pk2(v[e], 0.f) & 0xffff);
          }
        }
      }
    }
  }
  zero_f32(p.ss2, MT);
  if (l > 0) for (int it = blockIdx.x; it < 320; it += gridDim.x) wconv_tile(p, l, 2080 + it, (float*)lds);
}

constexpr int NCH_P = 4096, NCH = 4224;
constexpr int XLD = 40;
DI f32x4 mm16(const bf16_t* Xrow, int ldx, const bf16_t* Yrow, int ldy, int ksteps, f32x4 acc, int l15, int quad) {
  for (int ks = 0; ks < ksteps; ++ks) {
    const bf16x8 a = *(const bf16x8*)(Xrow + l15 * ldx + ks * 32 + quad * 8);
    const bf16x8 b = *(const bf16x8*)(Yrow + l15 * ldy + ks * 32 + quad * 8);
    acc = __builtin_amdgcn_mfma_f32_16x16x32_bf16(a, b, acc, 0, 0, 0);
  }
  return acc;
}
DI void chunk_item(const Params& p, int l, int item, char* lds) {
  const int tid = tid_(), wave = __builtin_amdgcn_readfirstlane(tid >> 6), lane = tid & 63, l15 = lane & 15, quad = lane >> 4;
  const bool isp = item < NCH_P;
  int bh, c;
  if (isp) { bh = item >> 7; c = item & 127; } else { const int j = item - NCH_P; bh = j >> 1; c = j & 1; }
  const int b = bh >> 3, h = bh & 7;
  const int t0 = c * 32; const int row0 = (isp ? b * 4096 : MP + b * 64) + t0;
  float* s_r = (float*)lds;
  float* s_kf = s_r + 2048;
  float* s_v = s_kf + 2048;
  float* s_w = s_v + 2048;
  float* s_kk = s_w + 2048;
  float* s_bb = s_kk + 2048;
  bf16_t* s_wd = (bf16_t*)(lds + 49152);
  bf16_t* s_ad = (bf16_t*)(lds + 53760);
  float* s_bonus = (float*)(lds + 58368);
  float* s_wl = (float*)(lds + 58880);
  float* s_rhs = (float*)lds;
  bf16_t* s_A = (bf16_t*)lds;
  bf16_t* s_Bm = (bf16_t*)(lds + 4608);
  bf16_t* s_Kp = (bf16_t*)(lds + 9216);
  bf16_t* s_R = (bf16_t*)(lds + 16384);
  bf16_t* s_BmT = (bf16_t*)(lds + 20992);
  bf16_t* s_KpT = (bf16_t*)(lds + 26112);
  bf16_t* s_VmT = (bf16_t*)(lds + 31232);
  bf16_t* s_Lak = (bf16_t*)(lds + 36352);
  bf16_t* s_Mrk = (bf16_t*)(lds + 38912);
  bf16_t* s_Mrb = (bf16_t*)(lds + 41472);
  float* s_labT = (float*)(lds + 44032);
  bf16_t* s_XT = (bf16_t*)(lds + 48640);

  const int mat = wave >> 1, tt = wave & 1;
  const bf16_t* wl = (mat == 0 ? p.w2t : p.a2t) + (size_t)(h * 64) * 64;
  const float* mu = p.shift_mu + l * SHC;
  const float* w0 = p.decay_w0 + l * 512 + h * 64;
  const float* a0 = p.iclr_a0 + l * 512 + h * 64;
  const float* kkp = p.k_k + l * 512 + h * 64;
  const float* kap = p.k_a + l * 512 + h * 64;
  const float* rkp = p.r_k + l * 512 + h * 64;
  const float* lb = p.lnx_b + l * 512 + h * 64;
  const int ptok = tid >> 3, pcs = (tid & 7) * 8;
  {
    const int t = t0 + ptok; const size_t row = (size_t)(row0 + ptok);
#pragma unroll
    for (int g = 0; g < 5; ++g) {
      const int zc = (g < 3 ? g * 512 + h * 64 : 1536 + (g - 3) * 64) + pcs;
      const u32x4 cu = *(const u32x4*)(p.z + row * NZ + zc);
      float cur[8], prv[8];
#pragma unroll
      for (int e = 0; e < 4; ++e) { cur[2 * e] = bf_lo(cu[e]); cur[2 * e + 1] = bf_hi(cu[e]); }
      if (t > 0) {
        const u32x4 pu = *(const u32x4*)(p.z + (row - 1) * NZ + zc);
#pragma unroll
        for (int e = 0; e < 4; ++e) { prv[2 * e] = bf_lo(pu[e]); prv[2 * e + 1] = bf_hi(pu[e]); }
      } else if (isp) {
#pragma unroll
        for (int e = 0; e < 8; ++e) prv[e] = 0.f;
      } else {
        const float* sp = p.sshift + (size_t)(l * 8 + b) * SHC + zc;
#pragma unroll
        for (int e = 0; e < 8; ++e) prv[e] = sp[e];
      }
      float zs[8];
#pragma unroll
      for (int e = 0; e < 8; ++e) zs[e] = cur[e] + (prv[e] - cur[e]) * mu[zc + e];
      if (g < 3) {
        float* d = (g == 0 ? s_r : g == 1 ? s_kf : s_v) + ptok * 64 + pcs;
        *(f32x4*)d = (f32x4){zs[0], zs[1], zs[2], zs[3]}; *(f32x4*)(d + 4) = (f32x4){zs[4], zs[5], zs[6], zs[7]};
      } else {
        if (g == 3) {
#pragma unroll
          for (int e = 0; e < 8; ++e) { const float ex = __expf(2.f * zs[e]); zs[e] = 1.f - 2.f * __builtin_amdgcn_rcpf(ex + 1.f); }
        }
        u32x4 o; o[0] = pk2(zs[0], zs[1]); o[1] = pk2(zs[2], zs[3]); o[2] = pk2(zs[4], zs[5]); o[3] = pk2(zs[6], zs[7]);
        *(u32x4*)((g == 3 ? s_wd : s_ad) + ptok * 72 + pcs) = o;
      }
    }
  }
  __syncthreads();
  {
    const bf16_t* At = (mat == 0 ? s_wd : s_ad);
    bf16x8 af[2];
#pragma unroll
    for (int ks = 0; ks < 2; ++ks) af[ks] = *(const bf16x8*)(At + (tt * 16 + l15) * 72 + ks * 32 + quad * 8);
#pragma unroll
    for (int ct = 0; ct < 4; ++ct) {
      f32x4 d = (f32x4){0.f, 0.f, 0.f, 0.f};
#pragma unroll
      for (int ks = 0; ks < 2; ++ks) {
        const bf16x8 wfr = *(const bf16x8*)(wl + (size_t)(ct * 16 + l15) * 64 + ks * 32 + quad * 8);
        d = __builtin_amdgcn_mfma_f32_16x16x32_bf16(wfr, af[ks], d, 0, 0, 0);
      }
      const int ch = ct * 16 + quad * 4; const int tok = tt * 16 + l15;
      f32x4 o;
      if (mat == 0) {
#pragma unroll
        for (int e = 0; e < 4; ++e) {
          const float y = -(w0[ch + e] + d[e]);
          const float sp = fmaxf(y, 0.f) + __logf(1.0f + __expf(-fabsf(y)));
          o[e] = -__expf(-sp - 0.5f);
        }
        *(f32x4*)(s_w + tok * 64 + ch) = o;
      } else {
#pragma unroll
        for (int e = 0; e < 4; ++e) o[e] = sigmoidf_(a0[ch + e] + d[e]);
        *(f32x4*)(s_bb + tok * 64 + ch) = o;
      }
    }
  }
  __syncthreads();
  float r_[8], kf[8], kk[8], bbv[8], v_[8], bon;
  {
    float k_[8], a_[8];
    *(f32x4*)&k_[0] = *(const f32x4*)(s_kf + ptok * 64 + pcs); *(f32x4*)&k_[4] = *(const f32x4*)(s_kf + ptok * 64 + pcs + 4);
    *(f32x4*)&a_[0] = *(const f32x4*)(s_bb + ptok * 64 + pcs); *(f32x4*)&a_[4] = *(const f32x4*)(s_bb + ptok * 64 + pcs + 4);
    *(f32x4*)&r_[0] = *(const f32x4*)(s_r + ptok * 64 + pcs); *(f32x4*)&r_[4] = *(const f32x4*)(s_r + ptok * 64 + pcs + 4);
    *(f32x4*)&v_[0] = *(const f32x4*)(s_v + ptok * 64 + pcs); *(f32x4*)&v_[4] = *(const f32x4*)(s_v + ptok * 64 + pcs + 4);
    float ss = 0.f; bon = 0.f;
#pragma unroll
    for (int e = 0; e < 8; ++e) {
      kk[e] = k_[e] * kkp[pcs + e]; ss += kk[e] * kk[e];
      kf[e] = k_[e] * (1.f + (a_[e] - 1.f) * kap[pcs + e]);
      bon += r_[e] * kf[e] * rkp[pcs + e];
    }
    ss += __shfl_xor(ss, 1); ss += __shfl_xor(ss, 2); ss += __shfl_xor(ss, 4);
    bon += __shfl_xor(bon, 1); bon += __shfl_xor(bon, 2); bon += __shfl_xor(bon, 4);
    const float inv = 1.0f / fmaxf(sqrtf(ss), 1e-12f);
#pragma unroll
    for (int e = 0; e < 8; ++e) { kk[e] *= inv; bbv[e] = kk[e] * a_[e]; }
  }
  if (tid < 64) {
    float run = 0.f;
#pragma unroll 8
    for (int t = 0; t < 32; ++t) { run += s_w[t * 64 + tid]; s_w[t * 64 + tid] = run; }
  }
  __syncthreads();
  {
    float cw[8], cwp[8];
    *(f32x4*)&cw[0] = *(const f32x4*)(s_w + ptok * 64 + pcs); *(f32x4*)&cw[4] = *(const f32x4*)(s_w + ptok * 64 + pcs + 4);
    if (ptok > 0) { *(f32x4*)&cwp[0] = *(const f32x4*)(s_w + (ptok - 1) * 64 + pcs); *(f32x4*)&cwp[4] = *(const f32x4*)(s_w + (ptok - 1) * 64 + pcs + 4); }
    else {
#pragma unroll
      for (int e = 0; e < 8; ++e) cwp[e] = 0.f;
    }
    __syncthreads();
    float av[8], bm[8], kp[8], rr[8];
#pragma unroll
    for (int e = 0; e < 8; ++e) {
      const float ec = __expf(cw[e]), en = __expf(-cw[e]), ep = __expf(cwp[e]);
      av[e] = kk[e] * ep; bm[e] = bbv[e] * en; kp[e] = kf[e] * en; rr[e] = r_[e] * ec;
      if (ptok == 31) s_wl[pcs + e] = ec;
    }
    u32x4 o;
    o[0] = pk2(av[0], av[1]); o[1] = pk2(av[2], av[3]); o[2] = pk2(av[4], av[5]); o[3] = pk2(av[6], av[7]); *(u32x4*)(s_A + ptok * 72 + pcs) = o;
    o[0] = pk2(bm[0], bm[1]); o[1] = pk2(bm[2], bm[3]); o[2] = pk2(bm[4], bm[5]); o[3] = pk2(bm[6], bm[7]); *(u32x4*)(s_Bm + ptok * 72 + pcs) = o;
#pragma unroll
    for (int e = 0; e < 4; ++e) { s_BmT[(pcs + 2 * e) * XLD + ptok] = (bf16_t)(o[e] & 0xffff); s_BmT[(pcs + 2 * e + 1) * XLD + ptok] = (bf16_t)(o[e] >> 16); }
    o[0] = pk2(kp[0], kp[1]); o[1] = pk2(kp[2], kp[3]); o[2] = pk2(kp[4], kp[5]); o[3] = pk2(kp[6], kp[7]); *(u32x4*)(s_Kp + ptok * 72 + pcs) = o;
#pragma unroll
    for (int e = 0; e < 4; ++e) { s_KpT[(pcs + 2 * e) * XLD + ptok] = (bf16_t)(o[e] & 0xffff); s_KpT[(pcs + 2 * e + 1) * XLD + ptok] = (bf16_t)(o[e] >> 16); }
    o[0] = pk2(rr[0], rr[1]); o[1] = pk2(rr[2], rr[3]); o[2] = pk2(rr[4], rr[5]); o[3] = pk2(rr[6], rr[7]); *(u32x4*)(s_R + ptok * 72 + pcs) = o;
    o[0] = pk2(v_[0], v_[1]); o[1] = pk2(v_[2], v_[3]); o[2] = pk2(v_[4], v_[5]); o[3] = pk2(v_[6], v_[7]);
#pragma unroll
    for (int e = 0; e < 4; ++e) { s_VmT[(pcs + 2 * e) * XLD + ptok] = (bf16_t)(o[e] & 0xffff); s_VmT[(pcs + 2 * e + 1) * XLD + ptok] = (bf16_t)(o[e] >> 16); }
    u32x4 ob;
    ob[0] = pk2(lb[pcs + 0] + bon * v_[0], lb[pcs + 1] + bon * v_[1]); ob[1] = pk2(lb[pcs + 2] + bon * v_[2], lb[pcs + 3] + bon * v_[3]);
    ob[2] = pk2(lb[pcs + 4] + bon * v_[4], lb[pcs + 5] + bon * v_[5]); ob[3] = pk2(lb[pcs + 6] + bon * v_[6], lb[pcs + 7] + bon * v_[7]);
    *(u32x4*)(p.cBA + ((size_t)item * 32 + ptok) * 64 + pcs) = ob;
  }
  __syncthreads();
  {
    const bf16_t* X = (wave < 2) ? s_A : s_R;
    const bf16_t* Y = (wave == 0 || wave == 3) ? s_Bm : s_Kp;
    const bool strict = wave < 2;
#pragma unroll
    for (int ti = 0; ti < 2; ++ti)
#pragma unroll
      for (int ii = 0; ii < 2; ++ii) {
        f32x4 d = (f32x4){0.f, 0.f, 0.f, 0.f};
        if (ii <= ti) d = mm16(X + ti * 16 * 72, 72, Y + ii * 16 * 72, 72, 2, d, l15, quad);
        const int i = ii * 16 + l15;
#pragma unroll
        for (int e = 0; e < 4; ++e) {
          const int t = ti * 16 + quad * 4 + e;
          const bool keep = strict ? (i < t) : (i <= t);
          const float val = keep ? d[e] : 0.f;
          if (wave == 0) s_labT[i * 36 + t] = val;
          else { bf16_t* dst = (wave == 1 ? s_Lak : wave == 2 ? s_Mrk : s_Mrb); dst[t * XLD + i] = (bf16_t)(pk2(val, 0.f) & 0xffff); }
        }
      }
  }
  const u32x4 acap = *(const u32x4*)(s_A + ptok * 72 + pcs);
  __syncthreads();
  {
    float* d = s_rhs + ptok * 128 + pcs;
    *(f32x4*)d = (f32x4){bf_lo(acap[0]), bf_hi(acap[0]), bf_lo(acap[1]), bf_hi(acap[1])};
    *(f32x4*)(d + 4) = (f32x4){bf_lo(acap[2]), bf_hi(acap[2]), bf_lo(acap[3]), bf_hi(acap[3])};
  }
  {
    const int ti = wave & 1;
#pragma unroll
    for (int vv = 0; vv < 2; ++vv) {
      const int vi = (wave >> 1) * 2 + vv;
      f32x4 d = (f32x4){0.f, 0.f, 0.f, 0.f};
      d = mm16(s_Lak + ti * 16 * XLD, XLD, s_VmT + vi * 16 * XLD, XLD, 1, d, l15, quad);
#pragma unroll
      for (int e = 0; e < 4; ++e) s_rhs[(ti * 16 + quad * 4 + e) * 128 + 64 + vi * 16 + l15] = d[e];
    }
  }
  __syncthreads();
  if (tid < 128) {
    float x[32];
#pragma unroll
    for (int t = 0; t < 32; ++t) x[t] = s_rhs[t * 128 + tid];
#pragma unroll
    for (int i = 0; i < 31; ++i) {
      const float xi = x[i];
#pragma unroll
      for (int t4 = ((i + 1) >> 2); t4 < 8; ++t4) {
        const f32x4 lv = *(const f32x4*)(s_labT + i * 36 + t4 * 4);
#pragma unroll
        for (int e = 0; e < 4; ++e) { const int t = t4 * 4 + e; if (t > i) x[t] -= lv[e] * xi; }
      }
    }
#pragma unroll
    for (int q4 = 0; q4 < 4; ++q4) {
      u32x4 o; o[0] = pk2(x[8 * q4], x[8 * q4 + 1]); o[1] = pk2(x[8 * q4 + 2], x[8 * q4 + 3]); o[2] = pk2(x[8 * q4 + 4], x[8 * q4 + 5]); o[3] = pk2(x[8 * q4 + 6], x[8 * q4 + 7]);
      *(u32x4*)(s_XT + tid * XLD + q4 * 8) = o;
    }
  }
  __syncthreads();
  {
    const f32x4 z4 = (f32x4){0.f, 0.f, 0.f, 0.f};
    bf16_t* gPT = p.cPT + (size_t)item * 4096;
    const float wl_c = s_wl[wave * 16 + l15];
#pragma unroll
    for (int k1t = 0; k1t < 4; ++k1t) {
      f32x4 d = mm16(s_XT + k1t * 16 * XLD, XLD, s_BmT + wave * 16 * XLD, XLD, 1, z4, l15, quad);
      const int k2 = wave * 16 + l15, k1 = k1t * 16 + quad * 4;
      float o[4];
#pragma unroll
      for (int e = 0; e < 4; ++e) o[e] = ((k1 + e == k2 ? 1.f : 0.f) - d[e]) * wl_c;
      u32x2 ov; ov[0] = pk2(o[0], o[1]); ov[1] = pk2(o[2], o[3]);
      *(u32x2*)(gPT + k2 * 64 + k1) = ov;
    }
    bf16_t* gG = p.cG + (size_t)item * 4096;
#pragma unroll
    for (int k2t = 0; k2t < 4; ++k2t) {
      const f32x4 d1 = mm16(s_KpT + k2t * 16 * XLD, XLD, s_VmT + wave * 16 * XLD, XLD, 1, z4, l15, quad);
      const f32x4 d2 = mm16(s_BmT + k2t * 16 * XLD, XLD, s_XT + (64 + wave * 16) * XLD, XLD, 1, z4, l15, quad);
      const int k2 = k2t * 16 + quad * 4, v = wave * 16 + l15;
      const f32x4 wv = *(const f32x4*)(s_wl + k2);
      u32x2 ov; ov[0] = pk2((d1[0] - d2[0]) * wv[0], (d1[1] - d2[1]) * wv[1]); ov[1] = pk2((d1[2] - d2[2]) * wv[2], (d1[3] - d2[3]) * wv[3]);
      *(u32x2*)(gG + v * 64 + k2) = ov;
    }
    bf16_t* gRT = p.cRT + (size_t)item * 2048;
    bf16_t* gOI = p.cOI + (size_t)item * 2048;
#pragma unroll
    for (int ti = 0; ti < 2; ++ti) {
      const f32x4 d = mm16(s_XT + wave * 16 * XLD, XLD, s_Mrb + ti * 16 * XLD, XLD, 1, z4, l15, quad);
      const int t = ti * 16 + l15, k = wave * 16 + quad * 4;
      const u32x2 rv = *(const u32x2*)(s_R + t * 72 + k);
      u32x2 ov; ov[0] = pk2(bf_lo(rv[0]) - d[0], bf_hi(rv[0]) - d[1]); ov[1] = pk2(bf_lo(rv[1]) - d[2], bf_hi(rv[1]) - d[3]);
      *(u32x2*)(gRT + t * 64 + k) = ov;
      const f32x4 e1 = mm16(s_VmT + wave * 16 * XLD, XLD, s_Mrk + ti * 16 * XLD, XLD, 1, z4, l15, quad);
      const f32x4 e2 = mm16(s_XT + (64 + wave * 16) * XLD, XLD, s_Mrb + ti * 16 * XLD, XLD, 1, z4, l15, quad);
      u32x2 oo; oo[0] = pk2(e1[0] - e2[0], e1[1] - e2[1]); oo[1] = pk2(e1[2] - e2[2], e1[3] - e2[3]);
      *(u32x2*)(gOI + t * 64 + k) = oo;
    }
  }
  __syncthreads();
}

DI void rec_item(const Params& p, int l, int item, char* lds) {
  const int tid = tid_(), wave = __builtin_amdgcn_readfirstlane(tid >> 6), lane = tid & 63, l15 = lane & 15, quad = lane >> 4;
  const bool isp = item < 32;
  const int bh = isp ? item : item - 32; const int b = bh >> 3, h = bh & 7;
  const int nch = isp ? 128 : 2; const int cid0 = isp ? bh * 128 : NCH_P + bh * 2;
  bf16_t* Sb = (bf16_t*)lds;
  const unsigned lbase = (unsigned)(size_t)(LASP char*)lds;
  __syncthreads();
  if (wave < 2) {
    f32x4 acc[2][4];
#pragma unroll
    for (int v2 = 0; v2 < 2; ++v2) {
      const int v = (wave * 2 + v2) * 16 + l15;
      if (isp) {
#pragma unroll
        for (int nk = 0; nk < 4; ++nk) acc[v2][nk] = (f32x4){0.f, 0.f, 0.f, 0.f};
      } else {
        const float* sp = p.swkv + (((size_t)(l * 8 + b) * 8 + h) * 64 + v) * 64;
#pragma unroll
        for (int nk = 0; nk < 4; ++nk) acc[v2][nk] = *(const f32x4*)(sp + nk * 16 + quad * 4);
      }
#pragma unroll
      for (int nk = 0; nk < 4; ++nk) {
        u32x2 o; o[0] = pk2(acc[v2][nk][0], acc[v2][nk][1]); o[1] = pk2(acc[v2][nk][2], acc[v2][nk][3]);
        *(u32x2*)(Sb + v * 72 + nk * 16 + quad * 4) = o;
        *(u32x2*)(p.gS + (size_t)cid0 * 4096 + v * 64 + nk * 16 + quad * 4) = o;
      }
    }
    const int nmain = nch - 2;
    struct PS { bf16x8 pt[4][2]; u32x2 gv[2][4]; };
    auto ldp = [&](PS& s, int c) {
      const int cc = c < nch ? c : nch - 1;
      const size_t cid = (size_t)(cid0 + cc);
      const bf16_t* gPT = p.cPT + cid * 4096; const bf16_t* gG = p.cG + cid * 4096;
#pragma unroll
      for (int nk = 0; nk < 4; ++nk) {
#pragma unroll
        for (int ks = 0; ks < 2; ++ks) s.pt[nk][ks] = *(const bf16x8*)(gPT + (nk * 16 + l15) * 64 + ks * 32 + quad * 8);
#pragma unroll
        for (int v2 = 0; v2 < 2; ++v2) s.gv[v2][nk] = *(const u32x2*)(gG + ((wave * 2 + v2) * 16 + l15) * 64 + nk * 16 + quad * 4);
      }
    };
    auto step = [&](PS& s, int c) {
      const int buf = c & 1;
      bf16x8 sf[2][2];
      {
        const unsigned sad = lbase + (unsigned)(((buf * 64 + wave * 32 + l15) * 72 + quad * 8) * 2);
        asm volatile("ds_read_b128 %0, %4\n\tds_read_b128 %1, %4 offset:64\n\tds_read_b128 %2, %4 offset:2304\n\tds_read_b128 %3, %4 offset:2368\n\ts_waitcnt lgkmcnt(0)"
                     : "=&v"(sf[0][0]), "=&v"(sf[0][1]), "=&v"(sf[1][0]), "=&v"(sf[1][1]) : "v"(sad) : "memory");
      }
#pragma unroll
      for (int v2 = 0; v2 < 2; ++v2) {
#pragma unroll
        for (int nk = 0; nk < 4; ++nk) {
          f32x4 a = (f32x4){bf_lo(s.gv[v2][nk][0]), bf_hi(s.gv[v2][nk][0]), bf_lo(s.gv[v2][nk][1]), bf_hi(s.gv[v2][nk][1])};
#pragma unroll
          for (int ks = 0; ks < 2; ++ks) a = __builtin_amdgcn_mfma_f32_16x16x32_bf16(s.pt[nk][ks], sf[v2][ks], a, 0, 0, 0);
          acc[v2][nk] = a;
        }
      }
      ldp(s, c + 3);
      const size_t scid = (c + 1 < nch) ? (size_t)(cid0 + c + 1) : (size_t)NCH;
#pragma unroll
      for (int v2 = 0; v2 < 2; ++v2) {
        const int v = (wave * 2 + v2) * 16 + l15;
#pragma unroll
        for (int nk = 0; nk < 4; ++nk) {
          u32x2 ov; ov[0] = pk2(acc[v2][nk][0], acc[v2][nk][1]); ov[1] = pk2(acc[v2][nk][2], acc[v2][nk][3]);
          *(u32x2*)(Sb + ((buf ^ 1) * 64 + v) * 72 + nk * 16 + quad * 4) = ov;
          *(u32x2*)(p.gS + scid * 4096 + v * 64 + nk * 16 + quad * 4) = ov;
        }
      }
      asm volatile("s_waitcnt lgkmcnt(0)" ::: "memory");
    };
    PS s0, s1, s2;
    ldp(s0, 0); ldp(s1, 1); ldp(s2, 2);
#pragma unroll 1
    for (int c = 0; c < nmain; c += 3) { step(s0, c); step(s1, c + 1); step(s2, c + 2); }
    step(s0, nmain); step(s1, nmain + 1);
#pragma unroll
    for (int v2 = 0; v2 < 2; ++v2) {
      const int v = (wave * 2 + v2) * 16 + l15;
      float* so = (isp ? p.out + O_WP + (((size_t)(l * 4 + b) * 8 + h) * 64 + v) * 64 : p.out + O_WS + (((size_t)(l * 8 + b) * 8 + h) * 64 + v) * 64);
#pragma unroll
      for (int nk = 0; nk < 4; ++nk) *(f32x4*)(so + nk * 16 + quad * 4) = acc[v2][nk];
    }
  }
  __syncthreads();
}
DI void phase_o(const Params& p, int l, int pi_first, int pi_end, int pi_step) {
  const int tid = tid_(), wave = __builtin_amdgcn_readfirstlane(tid >> 6), lane = tid & 63, l15 = lane & 15, quad = lane >> 4;
  for (int pi = pi_first; pi < pi_end; pi += pi_step) {
    const int cid = pi * 2 + (wave >> 1);
    const bool isp = cid < NCH_P;
    int bh, c;
    if (isp) { bh = cid >> 7; c = cid & 127; } else { const int j = cid - NCH_P; bh = j >> 1; c = j & 1; }
    const int b = bh >> 3, h = bh & 7;
    const int tok = (wave & 1) * 16 + l15;
    const size_t row = (size_t)((isp ? b * 4096 : MP + b * 64) + c * 32 + tok);
    bf16x8 rt[2], sa[4][2]; u32x2 oi[4], ba[4], gt[4];
#pragma unroll
    for (int ks = 0; ks < 2; ++ks) rt[ks] = *(const bf16x8*)(p.cRT + (size_t)cid * 2048 + tok * 64 + ks * 32 + quad * 8);
#pragma unroll
    for (int vt = 0; vt < 4; ++vt) {
#pragma unroll
      for (int ks = 0; ks < 2; ++ks) sa[vt][ks] = *(const bf16x8*)(p.gS + (size_t)cid * 4096 + (vt * 16 + l15) * 64 + ks * 32 + quad * 8);
      oi[vt] = *(const u32x2*)(p.cOI + (size_t)cid * 2048 + tok * 64 + vt * 16 + quad * 4);
      ba[vt] = *(const u32x2*)(p.cBA + (size_t)cid * 2048 + tok * 64 + vt * 16 + quad * 4);
      gt[vt] = *(const u32x2*)(p.z + row * NZ + C_GR + h * 64 + vt * 16 + quad * 4);
    }
    f32x4 ao[4];
#pragma unroll
    for (int vt = 0; vt < 4; ++vt) {
      f32x4 a = (f32x4){bf_lo(oi[vt][0]), bf_hi(oi[vt][0]), bf_lo(oi[vt][1]), bf_hi(oi[vt][1])};
#pragma unroll
      for (int ks = 0; ks < 2; ++ks) a = __builtin_amdgcn_mfma_f32_16x16x32_bf16(sa[vt][ks], rt[ks], a, 0, 0, 0);
      ao[vt] = a;
    }
    float sm = 0.f, sq = 0.f;
#pragma unroll
    for (int vt = 0; vt < 4; ++vt)
#pragma unroll
      for (int e = 0; e < 4; ++e) { sm += ao[vt][e]; sq += ao[vt][e] * ao[vt][e]; }
    { const float a1 = __shfl_xor(sm, 16), b1 = __shfl_xor(sq, 16); sm += a1; sq += b1; }
    { const float a1 = __shfl_xor(sm, 32), b1 = __shfl_xor(sq, 32); sm += a1; sq += b1; }
    const float mean = sm * (1.0f / 64.0f);
    const float rstd = rsqrtf(fmaxf(sq * (1.0f / 64.0f) - mean * mean, 0.f) + 64e-5f);
    const float* lg = p.lnx_g + l * 512 + h * 64;
#pragma unroll
    for (int vt = 0; vt < 4; ++vt) {
      const int vv = vt * 16 + quad * 4;
      const f32x4 g4 = *(const f32x4*)(lg + vv);
      const float y0 = ((ao[vt][0] - mean) * rstd * g4[0] + bf_lo(ba[vt][0])) * bf_lo(gt[vt][0]);
      const float y1 = ((ao[vt][1] - mean) * rstd * g4[1] + bf_hi(ba[vt][0])) * bf_hi(gt[vt][0]);
      const float y2 = ((ao[vt][2] - mean) * rstd * g4[2] + bf_lo(ba[vt][1])) * bf_lo(gt[vt][1]);
      const float y3 = ((ao[vt][3] - mean) * rstd * g4[3] + bf_hi(ba[vt][1])) * bf_hi(gt[vt][1]);
      u32x2 ov; ov[0] = pk2(y0, y1); ov[1] = pk2(y2, y3);
      *(u32x2*)(p.o_r + row * 512 + h * 64 + vv) = ov;
    }
  }
}
DI void phase_chunk(const Params& p, int l, char* lds) {
  for (int it = blockIdx.x; it < NCH_P; it += gridDim.x) chunk_item(p, l, it, lds);
  zero_f32(p.ss1, MT);
}

constexpr int ALD = 72;
DI void attn_item(const Params& p, int l, int item, char* lds) {
  const int tid = tid_(), wave = __builtin_amdgcn_readfirstlane(tid >> 6), lane = tid & 63;
  const int m = wave & 1, qh = wave >> 1, q = lane & 31, hh = lane >> 5;
  bf16_t* Ks = (bf16_t*)lds;
  bf16_t* Vs = Ks + 2 * 64 * ALD;
  float* xb = (float*)lds;
  bool samp; int b, h, nch, qrow0, qpos0;
  const int xq = item & 7, tk = item >> 3;
  if (tk < 4) { samp = true; const int bhs = xq + 8 * tk; b = bhs >> 2; h = bhs & 3; nch = 17; qrow0 = MP + b * 64; qpos0 = 1024; }
  else { samp = false; const int kk = tk - 4; const int qc = 63 - (kk >> 1); const int bh = xq + 8 * (kk & 1); b = bh >> 2; h = bh & 3; nch = qc + 1; qrow0 = b * 4096 + qc * 64; qpos0 = qc * 64; }
  bf16x8 qf[4];
  {
    const bf16_t* qp = p.z + (size_t)(qrow0 + qh * 32 + q) * NZ + C_Q + h * 128 + m * 64;
#pragma unroll
    for (int ks = 0; ks < 4; ++ks) qf[ks] = *(const bf16x8*)(qp + ks * 16 + hh * 8);
  }
  const float slope = exp2f(-2.0f * (float)(h + 1));
  const float LOG2E = 1.4426950408889634f;
  const float c1 = 0.125f * LOG2E, sl2 = slope * LOG2E;
  const float qposf = (float)(qpos0 + qh * 32 + q);
  f32x16 O[4];
#pragma unroll
  for (int i = 0; i < 4; ++i)
#pragma unroll
    for (int e = 0; e < 16; ++e) O[i][e] = 0.f;
  float mrun = -1e30f, lrun = 0.f;
  u32x4 rk[4], rv[4];
  auto gload = [&](int j) {
    const bf16_t* kb; size_t kld; const bf16_t* vb; size_t vld;
    if (!samp) { kb = p.z + (size_t)(b * 4096 + j * 64) * NZ + C_K + h * 128; kld = NZ; vb = p.vtp + (size_t)((b * 4 + h) * 128) * 4096 + j * 64; vld = 4096; }
    else if (j < 16) { kb = p.kc + (size_t)(b * 1024 + j * 64) * 512 + h * 128; kld = 512; vb = p.vct + (size_t)((b * 4 + h) * 128) * 1024 + j * 64; vld = 1024; }
    else { kb = p.z + (size_t)(MP + b * 64) * NZ + C_K + h * 128; kld = NZ; vb = p.vts + (size_t)((b * 4 + h) * 128) * 64; vld = 64; }
#pragma unroll
    for (int i = 0; i < 4; ++i) {
      const int c = tid + 256 * i;
      const int mm = c >> 9, key = (c >> 3) & 63, d8 = (c & 7) * 8;
      rk[i] = *(const u32x4*)(kb + (size_t)key * kld + mm * 64 + d8);
      const int vd = c >> 3, k8 = (c & 7) * 8;
      rv[i] = *(const u32x4*)(vb + (size_t)vd * vld + k8);
    }
  };
  auto sstore = [&]() {
#pragma unroll
    for (int i = 0; i < 4; ++i) {
      const int c = tid + 256 * i;
      const int mm = c >> 9, key = (c >> 3) & 63, d8 = (c & 7) * 8;
      *(u32x4*)(Ks + (mm * 64 + key) * ALD + d8) = rk[i];
      const int vd = c >> 3, k8 = (c & 7) * 8;
      *(u32x4*)(Vs + vd * ALD + k8) = rv[i];
    }
  };
  gload(0); sstore(); __syncthreads();
  for (int j = 0; j < nch; ++j) {
    if (j + 1 < nch) gload(j + 1);
    f32x16 s[2];
#pragma unroll
    for (int kt = 0; kt < 2; ++kt) {
#pragma unroll
      for (int e = 0; e < 16; ++e) s[kt][e] = 0.f;
#pragma unroll
      for (int ks = 0; ks < 4; ++ks) {
        const bf16x8 kf = *(const bf16x8*)(Ks + (m * 64 + kt * 32 + q) * ALD + ks * 16 + hh * 8);
        s[kt] = __builtin_amdgcn_mfma_f32_32x32x16_bf16(kf, qf[ks], s[kt], 0, 0, 0);
      }
    }
    float mx = -1e30f;
    const float dbase = qposf - (float)(j * 64 + 4 * hh);
#pragma unroll
    for (int kt = 0; kt < 2; ++kt)
#pragma unroll
      for (int e = 0; e < 16; ++e) {
        const float dd = dbase - (float)(kt * 32 + (e & 3) + 8 * (e >> 2));
        const float v = s[kt][e] * c1 - sl2 * fabsf(dd);
        s[kt][e] = v; mx = fmaxf(mx, v);
      }
    mx = fmaxf(mx, __shfl_xor(mx, 32));
    const float mnew = fmaxf(mrun, mx);
    const float alpha = __builtin_amdgcn_exp2f(mrun - mnew);
    const bool resc = mnew > mrun;
    mrun = mnew;
    float ps = 0.f;
#pragma unroll
    for (int kt = 0; kt < 2; ++kt)
#pragma unroll
      for (int e = 0; e < 16; ++e) { const float pe = __builtin_amdgcn_exp2f(s[kt][e] - mnew); s[kt][e] = pe; ps += pe; }
    lrun = lrun * alpha + ps;
    if (__any(resc)) {
#pragma unroll
      for (int i = 0; i < 4; ++i)
#pragma unroll
        for (int e = 0; e < 16; ++e) O[i][e] *= alpha;
    }
#pragma unroll
    for (int kt = 0; kt < 2; ++kt)
#pragma unroll
      for (int sx = 0; sx < 2; ++sx) {
        u32x4 pb;
        pb[0] = pk2(s[kt][8 * sx + 0], s[kt][8 * sx + 1]); pb[1] = pk2(s[kt][8 * sx + 2], s[kt][8 * sx + 3]);
        pb[2] = pk2(s[kt][8 * sx + 4], s[kt][8 * sx + 5]); pb[3] = pk2(s[kt][8 * sx + 6], s[kt][8 * sx + 7]);
        const bf16x8 pf = __builtin_bit_cast(bf16x8, pb);
#pragma unroll
        for (int vt = 0; vt < 4; ++vt) {
          const bf16_t* vp = Vs + (vt * 32 + q) * ALD + kt * 32 + 16 * sx + 4 * hh;
          const s16x4 lo = *(const s16x4*)vp, hi = *(const s16x4*)(vp + 8);
          const bf16x8 vf = __builtin_shufflevector(lo, hi, 0, 1, 2, 3, 4, 5, 6, 7);
          O[vt] = __builtin_amdgcn_mfma_f32_32x32x16_bf16(vf, pf, O[vt], 0, 0, 0);
        }
      }
    __syncthreads();
    if (j + 1 < nch) sstore();
    __syncthreads();
  }
  const float ltot = lrun + __shfl_xor(lrun, 32);
  const float inv = 1.0f / ltot;
#pragma unroll
  for (int i = 0; i < 4; ++i)
#pragma unroll
    for (int e = 0; e < 16; ++e) O[i][e] *= inv;
  if (m == 1) {
#pragma unroll
    for (int vt = 0; vt < 4; ++vt)
#pragma unroll
      for (int e = 0; e < 16; ++e) { const int vd = vt * 32 + (e & 3) + 8 * (e >> 2) + 4 * hh; xb[(qh * 128 + vd) * 32 + q] = O[vt][e]; }
  }
  __syncthreads();
  if (m == 0) {
    float d1 = 0.f, d2 = 0.f;
    for (int i = 0; i < 64; ++i) { d1 += p.lq1[l * 64 + i] * p.lk1[l * 64 + i]; d2 += p.lq2[l * 64 + i] * p.lk2[l * 64 + i]; }
    const float lam_init = 0.8f - 0.6f * __expf(-0.3f * (float)l);
    const float lam = __expf(d1) - __expf(d2) + lam_init;
    float ss = 0.f;
#pragma unroll
    for (int vt = 0; vt < 4; ++vt)
#pragma unroll
      for (int e = 0; e < 16; ++e) {
        const int vd = vt * 32 + (e & 3) + 8 * (e >> 2) + 4 * hh;
        const float o2 = xb[(qh * 128 + vd) * 32 + q];
        const float o = O[vt][e] - lam * o2; O[vt][e] = o; ss += o * o;
      }
    ss += __shfl_xor(ss, 32);
    const float rstd = rsqrtf(ss * (1.0f / 128.0f) + 1e-5f) * (1.0f - lam_init);
    const size_t row = (size_t)(qrow0 + qh * 32 + q);
    const float* sg = p.subln_g + l * 128;
#pragma unroll
    for (int vt = 0; vt < 4; ++vt)
#pragma unroll
      for (int e4 = 0; e4 < 4; ++e4) {
        const int vd = vt * 32 + 8 * e4 + 4 * hh;
        const u32x2 gu = *(const u32x2*)(p.z + row * NZ + C_GA + h * 128 + vd);
        const f32x4 gv = *(const f32x4*)(sg + vd);
        const float y0 = O[vt][4 * e4 + 0] * rstd * gv[0] * bf_lo(gu[0]);
        const float y1 = O[vt][4 * e4 + 1] * rstd * gv[1] * bf_hi(gu[0]);
        const float y2 = O[vt][4 * e4 + 2] * rstd * gv[2] * bf_lo(gu[1]);
        const float y3 = O[vt][4 * e4 + 3] * rstd * gv[3] * bf_hi(gu[1]);
        u32x2 ov; ov[0] = pk2(y0, y1); ov[1] = pk2(y2, y3);
        *(u32x2*)(p.o_a + row * 512 + h * 128 + vd) = ov;
      }
  }
  __syncthreads();
}

DI void phase_mix(const Params& p, int l, char* lds) {
  __shared__ int s_next;
  if (blockIdx.x < 96) {
    if (blockIdx.x >= 32) {
      for (int c2 = 0; c2 < 2; ++c2) chunk_item(p, l, NCH_P + (blockIdx.x - 32) * 2 + c2, lds);
      __syncthreads();
    }
    __builtin_amdgcn_s_setprio(3); rec_item(p, l, blockIdx.x, lds); __builtin_amdgcn_s_setprio(0);
    if (blockIdx.x >= 32) { const int pis = NCH_P / 2 + (blockIdx.x - 32); phase_o(p, l, pis, pis + 1, 1); }
  }
  unsigned* ctr = p.bar + XCD_BAR_WORDS + 64 * l + (blockIdx.x & 7);
  for (;;) {
    __syncthreads();
    if (threadIdx.x == 0) { const int k = (int)atomicAdd(ctr, 1u); s_next = k < 132 ? k * 8 + (int)(blockIdx.x & 7) : 1 << 20; }
    __syncthreads();
    const int it = s_next;
    if (it >= (1 << 20)) break;
    attn_item(p, l, it, lds);
  }
}

template <bool A_F32>
DI void mini_gemm(f32x4 (&acc)[2][2], const void* Ap, int lda, const bf16_t* Bp, int ldb, int K, int wave, int l15, int quad) {
  const int kw = K >> 2, k0 = wave * kw;
#pragma unroll 2
  for (int ks = 0; ks < kw; ks += 32) {
    bf16x8 a[2], b[2];
#pragma unroll
    for (int mi = 0; mi < 2; ++mi) {
      if (A_F32) {
        const float* ap = (const float*)Ap + (size_t)(mi * 16 + l15) * lda + k0 + ks + quad * 8;
        const f32x4 v0 = *(const f32x4*)ap, v1 = *(const f32x4*)(ap + 4);
        u32x4 t; t[0] = pk2(v0[0], v0[1]); t[1] = pk2(v0[2], v0[3]); t[2] = pk2(v1[0], v1[1]); t[3] = pk2(v1[2], v1[3]);
        a[mi] = __builtin_bit_cast(bf16x8, t);
      } else {
        a[mi] = *(const bf16x8*)((const bf16_t*)Ap + (size_t)(mi * 16 + l15) * lda + k0 + ks + quad * 8);
      }
      b[mi] = *(const bf16x8*)(Bp + (size_t)(mi * 16 + l15) * ldb + k0 + ks + quad * 8);
    }
#pragma unroll
    for (int mi = 0; mi < 2; ++mi)
#pragma unroll
      for (int ni = 0; ni < 2; ++ni) acc[mi][ni] = __builtin_amdgcn_mfma_f32_16x16x32_bf16(b[ni], a[mi], acc[mi][ni], 0, 0, 0);
  }
}
DI f32x4 mini_reduce(const f32x4 (&acc)[2][2], char* lds, int wave, int lane) {
  float* red = (float*)lds;
  __syncthreads();
#pragma unroll
  for (int i = 0; i < 2; ++i)
#pragma unroll
    for (int j = 0; j < 2; ++j)
#pragma unroll
      for (int e = 0; e < 4; ++e) red[((wave * 4 + i * 2 + j) * 4 + e) * 64 + lane] = acc[i][j][e];
  __syncthreads();
  f32x4 r;
#pragma unroll
  for (int e = 0; e < 4; ++e) r[e] = (red[((0 * 4 + wave) * 4 + e) * 64 + lane] + red[((1 * 4 + wave) * 4 + e) * 64 + lane]) + (red[((2 * 4 + wave) * 4 + e) * 64 + lane] + red[((3 * 4 + wave) * 4 + e) * 64 + lane]);
  return r;
}
DI void zero_mini(f32x4 (&acc)[2][2]) {
#pragma unroll
  for (int i = 0; i < 2; ++i)
#pragma unroll
    for (int j = 0; j < 2; ++j) acc[i][j] = (f32x4){0.f, 0.f, 0.f, 0.f};
}
DI void mini_merge(const Params& p, int l, int t, char* lds) {
  const int tid = tid_(), wave = __builtin_amdgcn_readfirstlane(tid >> 6), lane = tid & 63, l15 = lane & 15, quad = lane >> 4;
  const int R0 = MP + (t >> 5) * 32, C0 = (t & 31) * 32;
  f32x4 acc[2][2]; zero_mini(acc);
  mini_gemm<false>(acc, p.o_r + (size_t)R0 * 512, 512, p.wt_brr + (size_t)C0 * 512, 512, 512, wave, l15, quad);
  const f32x4 v1 = mini_reduce(acc, lds, wave, lane);
  zero_mini(acc);
  mini_gemm<false>(acc, p.o_a + (size_t)R0 * 512, 512, p.wt_bra + (size_t)C0 * 512, 512, 512, wave, l15, quad);
  const f32x4 v2 = mini_reduce(acc, lds, wave, lane);
  const int R = R0 + (wave >> 1) * 16 + l15, c = C0 + (wave & 1) * 16 + quad * 4;
  const u32x2 g1 = *(const u32x2*)(p.z + (size_t)R * NZ + C_MR + c), g2 = *(const u32x2*)(p.z + (size_t)R * NZ + C_MA + c);
  u32x2 o;
  o[0] = pk2(bf_lo(g1[0]) * v1[0] + bf_lo(g2[0]) * v2[0], bf_hi(g1[0]) * v1[1] + bf_hi(g2[0]) * v2[1]);
  o[1] = pk2(bf_lo(g1[1]) * v1[2] + bf_lo(g2[1]) * v2[2], bf_hi(g1[1]) * v1[3] + bf_hi(g2[1]) * v2[3]);
  *(u32x2*)(p.hn + (size_t)R * DM + c) = o;
}
DI void mini_out(const Params& p, int l, int t, char* lds) {
  const int tid = tid_(), wave = __builtin_amdgcn_readfirstlane(tid >> 6), lane = tid & 63, l15 = lane & 15, quad = lane >> 4;
  const int R0 = MP + (t >> 5) * 32, C0 = (t & 31) * 32;
  f32x4 acc[2][2]; zero_mini(acc);
  mini_gemm<false>(acc, p.hn + (size_t)R0 * DM, DM, p.wt_out + (size_t)C0 * DM, DM, DM, wave, l15, quad);
  const f32x4 v = mini_reduce(acc, lds, wave, lane);
  const int R = R0 + (wave >> 1) * 16 + l15, c = C0 + (wave & 1) * 16 + quad * 4;
  const f32x4 xv = *(const f32x4*)(x_row(p, l, R) + c);
  const f32x4 x1 = xv + v;
  *(f32x4*)(p.out + (size_t)R * DM + c) = x1;
  const f32x4 gv = *(const f32x4*)(p.ple_norm_g + l * DM + c);
  u32x2 o; o[0] = pk2(x1[0] * gv[0], x1[1] * gv[1]); o[1] = pk2(x1[2] * gv[2], x1[3] * gv[3]);
  *(u32x2*)(p.o_r + (size_t)R * DM + c) = o;
  float sq = x1[0] * x1[0] + x1[1] * x1[1] + x1[2] * x1[2] + x1[3] * x1[3];
  sq += __shfl_xor(sq, 16); sq += __shfl_xor(sq, 32);
  if (quad == 0) atomicAdd(p.ss2 + R, sq);
}
DI void mini_ple(const Params& p, int l, int t, char* lds) {
  const int tid = tid_(), wave = __builtin_amdgcn_readfirstlane(tid >> 6), lane = tid & 63, l15 = lane & 15, quad = lane >> 4;
  const int R0 = MP + (t >> 5) * 32, C0 = (t & 31) * 32;
  f32x4 acc[2][2]; zero_mini(acc);
  mini_gemm<false>(acc, p.o_r + (size_t)R0 * DM, DM, p.wt_gate + (size_t)C0 * DM, DM, DM, wave, l15, quad);
  const f32x4 g = mini_reduce(acc, lds, wave, lane);
  zero_mini(acc);
  mini_gemm<true>(acc, p.ps + ((size_t)l * MS + (R0 - MP)) * 256, 256, p.wt_ple + (size_t)C0 * 256, 256, 256, wave, l15, quad);
  const f32x4 e = mini_reduce(acc, lds, wave, lane);
  const int R = R0 + (wave >> 1) * 16 + l15, c = C0 + (wave & 1) * 16 + quad * 4;
  const float rs = rsqrtf(p.ss2[R] * (1.0f / 1024.0f) + 1e-6f);
  float* xo = p.out + (size_t)R * DM + c;
  const f32x4 xv = *(const f32x4*)xo;
  f32x4 o;
#pragma unroll
  for (int k = 0; k < 4; ++k) o[k] = xv[k] + e[k] * bf1((bf16_t)(pk2(sigmoidf_(g[k] * rs), 0.f) & 0xffff));
  *(f32x4*)xo = o;
  if (l + 1 < NL) {
    const f32x4 gn = *(const f32x4*)(p.norm_g + (l + 1) * DM + c);
    u32x2 hv; hv[0] = pk2(o[0] * gn[0], o[1] * gn[1]); hv[1] = pk2(o[2] * gn[2], o[3] * gn[3]);
    *(u32x2*)(p.hn + (size_t)R * DM + c) = hv;
    float sq = o[0] * o[0] + o[1] * o[1] + o[2] * o[2] + o[3] * o[3];
    sq += __shfl_xor(sq, 16); sq += __shfl_xor(sq, 32);
    if (quad == 0) atomicAdd(p.ss1 + R, sq);
  }
}
DI void phase_merge(const Params& p, int l, char* lds) {
  const int tid = tid_(), wave = __builtin_amdgcn_readfirstlane(tid >> 6), lane = tid & 63;
  const int wm = wave >> 1, wn = wave & 1, l15 = lane & 15, quad = lane >> 4;
  for (int r = 0;; ++r) {
    const int g = xcd_tile(r, 128 * 8); if (g < 0) break;
    int mt, nt; tile_decode(g, 128, 8, mt, nt);
    f32x4 a1[4][4]; zero_acc(a1);
    gemm_dma(a1, p.o_r + (size_t)mt * 128 * 512, 512, p.wt_brr + (size_t)nt * 128 * 512, 512, 512, lds);
    u32x2 pk[4][4];
#pragma unroll
    for (int mi = 0; mi < 4; ++mi) {
      const int R = mt * 128 + wm * 64 + mi * 16 + l15;
#pragma unroll
      for (int ni = 0; ni < 4; ++ni) {
        const int c = nt * 128 + wn * 64 + ni * 16 + quad * 4;
        const u32x2 g1 = *(const u32x2*)(p.z + (size_t)R * NZ + C_MR + c);
        const f32x4 v1 = a1[mi][ni];
        pk[mi][ni][0] = pk2(bf_lo(g1[0]) * v1[0], bf_hi(g1[0]) * v1[1]);
        pk[mi][ni][1] = pk2(bf_lo(g1[1]) * v1[2], bf_hi(g1[1]) * v1[3]);
      }
    }
    zero_acc(a1);
    gemm_dma(a1, p.o_a + (size_t)mt * 128 * 512, 512, p.wt_bra + (size_t)nt * 128 * 512, 512, 512, lds);
#pragma unroll
    for (int mi = 0; mi < 4; ++mi) {
      const int R = mt * 128 + wm * 64 + mi * 16 + l15;
#pragma unroll
      for (int ni = 0; ni < 4; ++ni) {
        const int c = nt * 128 + wn * 64 + ni * 16 + quad * 4;
        const u32x2 g2 = *(const u32x2*)(p.z + (size_t)R * NZ + C_MA + c);
        const f32x4 v2 = a1[mi][ni]; const u32x2 u1 = pk[mi][ni];
        u32x2 o;
        o[0] = pk2(bf_lo(u1[0]) + bf_lo(g2[0]) * v2[0], bf_hi(u1[0]) + bf_hi(g2[0]) * v2[1]);
        o[1] = pk2(bf_lo(u1[1]) + bf_lo(g2[1]) * v2[2], bf_hi(u1[1]) + bf_hi(g2[1]) * v2[3]);
        *(u32x2*)(p.hn + (size_t)R * DM + c) = o;
      }
    }
  }
  for (int t = blockIdx.x; t < 512; t += gridDim.x) mini_merge(p, l, t, lds);
}
DI void phase_out(const Params& p, int l, char* lds) {
  const int tid = tid_(), wave = __builtin_amdgcn_readfirstlane(tid >> 6), lane = tid & 63;
  const int wm = wave >> 1, wn = wave & 1, l15 = lane & 15, quad = lane >> 4;
  for (int r = 0;; ++r) {
    const int g = xcd_tile(r, 128 * 8); if (g < 0) break;
    int mt, nt; tile_decode(g, 128, 8, mt, nt);
    f32x4 acc[4][4]; zero_acc(acc);
    gemm_dma(acc, p.hn + (size_t)mt * 128 * DM, DM, p.wt_out + (size_t)nt * 128 * DM, DM, DM, lds);
#pragma unroll
    for (int mi = 0; mi < 4; ++mi) {
      const int R = mt * 128 + wm * 64 + mi * 16 + l15;
      const float* xr = x_row(p, l, R);
      const float* g2 = p.ple_norm_g + l * DM;
      bf16_t* xb = p.o_r + (size_t)R * DM;
      float sq = 0.f;
#pragma unroll
      for (int ni = 0; ni < 4; ++ni) {
        const int c = nt * 128 + wn * 64 + ni * 16 + quad * 4;
        const f32x4 xv = *(const f32x4*)(xr + c);
        const f32x4 x1 = xv + acc[mi][ni];
        *(f32x4*)(p.out + (size_t)R * DM + c) = x1;
        const f32x4 gv = *(const f32x4*)(g2 + c);
        u32x2 o; o[0] = pk2(x1[0] * gv[0], x1[1] * gv[1]); o[1] = pk2(x1[2] * gv[2], x1[3] * gv[3]);
        *(u32x2*)(xb + c) = o;
        sq += x1[0] * x1[0] + x1[1] * x1[1] + x1[2] * x1[2] + x1[3] * x1[3];
      }
      sq += __shfl_xor(sq, 16); sq += __shfl_xor(sq, 32);
      if (quad == 0) atomicAdd(p.ss2 + R, sq);
    }
  }
  for (int t = blockIdx.x; t < 512; t += gridDim.x) mini_out(p, l, t, lds);
}
DI void phase_ple(const Params& p, int l, char* lds) {
  const int tid = tid_(), wave = __builtin_amdgcn_readfirstlane(tid >> 6), lane = tid & 63;
  const int wm = wave >> 1, wn = wave & 1, l15 = lane & 15, quad = lane >> 4;
  for (int r = 0;; ++r) {
    const int g = xcd_tile(r, 128 * 8); if (g < 0) break;
    int mt, nt; tile_decode(g, 128, 8, mt, nt);
    f32x4 a1[4][4]; zero_acc(a1);
    gemm_dma(a1, p.o_r + (size_t)mt * 128 * DM, DM, p.wt_gate + (size_t)nt * 128 * DM, DM, DM, lds);
    u32x2 pk[4][4];
#pragma unroll
    for (int mi = 0; mi < 4; ++mi) {
      const float rs = rsqrtf(p.ss2[mt * 128 + wm * 64 + mi * 16 + l15] * (1.0f / 1024.0f) + 1e-6f);
#pragma unroll
      for (int ni = 0; ni < 4; ++ni) { const f32x4 v = a1[mi][ni] * rs; pk[mi][ni][0] = pk2(sigmoidf_(v[0]), sigmoidf_(v[1])); pk[mi][ni][1] = pk2(sigmoidf_(v[2]), sigmoidf_(v[3])); }
    }
    zero_acc(a1);
    const int r0 = mt * 128;
    const float* pa = r0 < MP ? p.pp + ((size_t)l * MP + r0) * 256 : p.ps + ((size_t)l * MS + (r0 - MP)) * 256;
    gemm_core<true>(a1, pa, 256, p.wt_ple + (size_t)nt * 128 * 256, 256, 256, lds);
#pragma unroll
    for (int mi = 0; mi < 4; ++mi) {
      const int R = mt * 128 + wm * 64 + mi * 16 + l15;
      float sq = 0.f;
#pragma unroll
      for (int ni = 0; ni < 4; ++ni) {
        const int c = nt * 128 + wn * 64 + ni * 16 + quad * 4;
        float* xo = p.out + (size_t)R * DM + c;
        const f32x4 xv = *(const f32x4*)xo; const f32x4 e = a1[mi][ni]; const u32x2 g = pk[mi][ni];
        f32x4 o;
        o[0] = xv[0] + e[0] * bf_lo(g[0]); o[1] = xv[1] + e[1] * bf_hi(g[0]);
        o[2] = xv[2] + e[2] * bf_lo(g[1]); o[3] = xv[3] + e[3] * bf_hi(g[1]);
        *(f32x4*)xo = o;
        if (l + 1 < NL) {
          const f32x4 gn = *(const f32x4*)(p.norm_g + (l + 1) * DM + c);
          u32x2 hv; hv[0] = pk2(o[0] * gn[0], o[1] * gn[1]); hv[1] = pk2(o[2] * gn[2], o[3] * gn[3]);
          *(u32x2*)(p.hn + (size_t)R * DM + c) = hv;
          sq += o[0] * o[0] + o[1] * o[1] + o[2] * o[2] + o[3] * o[3];
        }
      }
      if (l + 1 < NL) {
        sq += __shfl_xor(sq, 16); sq += __shfl_xor(sq, 32);
        if (quad == 0) atomicAdd(p.ss1 + R, sq);
      }
    }
  }
  for (int t = blockIdx.x; t < 512; t += gridDim.x) mini_ple(p, l, t, lds);
  if (l + 1 < NL) {
    for (int it = blockIdx.x; it < 2080 + 16 + 2048; it += gridDim.x) {
      if (it < 2080) wconv_tile(p, l + 1, it, (float*)lds);
      else if (it < 2096) wconv_tile(p, l + 1, 2400 + (it - 2080), (float*)lds);
      else cache_item(p, l + 1, it - 2096, lds);
    }
  }
}


#define XB_TMO      128
#define XB_XCNT(j)  (256  + 64 * (j))
#define XB_XSUB(j)  (1280 + 64 * (j))
#define XB_XGEN(j)  (2304 + 64 * (j))
#define XB_TOP      3328
#define XB_TOPGEN   3392
#define XB_SPIN_CAP (1u << 18)
#define LAS __attribute__((address_space(3)))
DI unsigned xb_ld(unsigned* p)              { return __hip_atomic_load(p, __ATOMIC_RELAXED, __HIP_MEMORY_SCOPE_AGENT); }
DI unsigned xb_add(unsigned* p, unsigned v) { return __hip_atomic_fetch_add(p, v, __ATOMIC_RELAXED, __HIP_MEMORY_SCOPE_AGENT); }
DI unsigned xb_xcc_id() { return (unsigned)__builtin_amdgcn_s_getreg((3 << 11) | 20) & 0xFu; }
#define XB_SPIN(cond, bar) do { unsigned _sp = 0; while (cond) { __builtin_amdgcn_s_sleep(1); \
    if ((++_sp & 255u) == 0u) { if (xb_ld(&(bar)[XB_TMO])) break; if (_sp > XB_SPIN_CAP) { atomicAdd(&(bar)[XB_TMO], 1u); break; } } } } while (0)
struct XcdBarrier { unsigned* bar; unsigned x; volatile LAS unsigned* st; };
DI XcdBarrier xcd_barrier_post(unsigned* bar, volatile LAS unsigned* st) {
  XcdBarrier b; b.bar = bar; b.x = xb_xcc_id(); b.st = st;
  if (threadIdx.x == 0) (void)xb_add(&bar[XB_XCNT(b.x)], 1u);
  return b;
}
DI void xcd_barrier_complete(unsigned* bar, unsigned x, unsigned& nloc, unsigned& nx) {
  const unsigned G = gridDim.x * gridDim.y * gridDim.z;
  unsigned sum, cnt, mine, sp = 0u;
  for (;;) {
    sum = 0u; cnt = 0u; mine = 0u;
#pragma unroll
    for (unsigned j = 0; j < 16; ++j) { const unsigned c = xb_ld(&bar[XB_XCNT(j)]); sum += c; cnt += (c > 0u) ? 1u : 0u; mine = (j == x) ? c : mine; }
    if (sum == G) break;
    __builtin_amdgcn_s_sleep(1);
    if ((++sp & 255u) == 0u) { if (xb_ld(&bar[XB_TMO])) break; if (sp > XB_SPIN_CAP) { atomicAdd(&bar[XB_TMO], 1u); break; } }
  }
  nloc = mine > 0u ? mine : 1u; nx = cnt > 0u ? cnt : 1u;
}
DI void xcd_barrier(const XcdBarrier& b) {
  asm volatile("s_waitcnt vmcnt(0)" ::: "memory");
  __syncthreads();
  if (threadIdx.x == 0) {
    unsigned* bar = b.bar;
    __builtin_amdgcn_s_waitcnt(0);
    unsigned nloc = b.st[0], nx = b.st[1];
    if (nloc == 0u) { xcd_barrier_complete(bar, b.x, nloc, nx); b.st[0] = nloc; b.st[1] = nx; }
    const unsigned old = xb_add(&bar[XB_XSUB(b.x)], 1u);
    const unsigned gen = old / nloc;
    if (old + 1u == (gen + 1u) * nloc) {
      __builtin_amdgcn_fence(__ATOMIC_RELEASE, "agent");
      asm volatile("s_waitcnt vmcnt(0)" ::: "memory");
      const unsigned og = xb_add(&bar[XB_TOP], 1u);
      const unsigned tg = og / nx;
      if (og + 1u == (tg + 1u) * nx) xb_add(&bar[XB_TOPGEN], 1u);
      else XB_SPIN(xb_ld(&bar[XB_TOPGEN]) == tg, bar);
      __builtin_amdgcn_fence(__ATOMIC_ACQUIRE, "agent");
      xb_add(&bar[XB_XGEN(b.x)], 1u);
      asm volatile("s_waitcnt vmcnt(0)" ::: "memory");
    } else {
      XB_SPIN(xb_ld(&bar[XB_XGEN(b.x)]) == gen, bar);
      __builtin_amdgcn_fence(__ATOMIC_ACQUIRE, "agent");
      asm volatile("s_waitcnt vmcnt(0)" ::: "memory");
    }
  }
  __syncthreads();
}
constexpr int LDS_BYTES = 73728;
DI void run_phase(const Params& p, int ph, int l, char* lds) {
  switch (ph) {
    case 1: phase_norm0(p, lds); break;
    case 2: phase_gemm_in(p, l, lds); break;
    case 3: phase_mix(p, l, lds); break;
    case 4: phase_merge(p, l, lds); break;
    case 5: phase_out(p, l, lds); break;
    case 6: break;
    case 7: phase_ple(p, l, lds); break;
    case 8: phase_chunk(p, l, lds); break;
  }
}

#if MEGA
__global__ void __launch_bounds__(256, 2) k_mega(Params p) {
  __shared__ __attribute__((aligned(16))) char lds[LDS_BYTES];
  __shared__ uint4 xb_words;
  cg::grid_group grid = cg::this_grid();
  if (threadIdx.x == 0) xb_words = make_uint4(0u, 0u, 0u, 0u);
  __syncthreads();
  const XcdBarrier xb = xcd_barrier_post(p.bar, (volatile LAS unsigned*)&xb_words);
  phase_norm0(p, lds);
  grid.sync();
#pragma unroll 1
  for (int l = 0; l < NL; ++l) {
    phase_gemm_in(p, l, lds); xcd_barrier(xb);
    phase_chunk(p, l, lds); xcd_barrier(xb);
    phase_mix(p, l, lds); xcd_barrier(xb);
    phase_o(p, l, blockIdx.x, NCH_P / 2, gridDim.x); xcd_barrier(xb);
    phase_merge(p, l, lds); xcd_barrier(xb);
    phase_out(p, l, lds); xcd_barrier(xb);
    phase_ple(p, l, lds); if (l + 1 < NL) xcd_barrier(xb);
  }
}
#else
template <int PH>
__global__ void __launch_bounds__(256, 2) k_phase(Params p, int l) {
  __shared__ __attribute__((aligned(16))) char lds[LDS_BYTES];
  run_phase(p, PH, l, lds);
}
#endif

extern "C" void kernel_launch(void* const* d_in, const int* in_sizes, int n_in, void* d_out, int out_size, void* d_ws, size_t ws_size,
                              hipStream_t stream) {
  Params p{};
  const float** pf = (const float**)&p;
  for (int i = 0; i < 33; ++i) pf[i] = (const float*)d_in[i];
  p.out = (float*)d_out;
  char* w = (char*)d_ws; size_t off = 0;
  auto take = [&](size_t bytes) { char* r = w + off; off += (bytes + 255) & ~(size_t)255; return (bf16_t*)r; };
  p.gS = take((size_t)(NCH + 1) * 4096 * 2);
  p.ss1 = (float*)take((size_t)MT * 4); p.ss2 = (float*)take((size_t)MT * 4);
  p.bar = (unsigned*)take((size_t)(XCD_BAR_WORDS + 64 * NL) * 4);
  p.wt_in = take((size_t)NZ * 1024 * 2);
  p.wt_brr = take((size_t)1024 * 512 * 2);
  p.wt_bra = take((size_t)1024 * 512 * 2);
  p.wt_out = take((size_t)1024 * 1024 * 2);
  p.wt_ple = take((size_t)1024 * 256 * 2);
  p.wt_gate = take((size_t)1024 * 1024 * 2);
  p.w2t = take((size_t)512 * 64 * 2);
  p.a2t = take((size_t)512 * 64 * 2);
  p.z = take((size_t)MT * NZ * 2);
  p.vtp = take((size_t)16 * 128 * 4096 * 2);
  p.vts = take((size_t)32 * 128 * 64 * 2);
  p.kc = take((size_t)8 * 1024 * 512 * 2);
  p.vct = take((size_t)32 * 128 * 1024 * 2);
  p.o_r = take((size_t)MT * 512 * 2);
  p.o_a = take((size_t)MT * 512 * 2);
  p.hn = take((size_t)MT * DM * 2);
  p.cPT = p.hn;
  p.cG = take((size_t)NCH * 4096 * 2);
  p.cRT = take((size_t)NCH * 2048 * 2);
  p.cOI = take((size_t)NCH * 2048 * 2);
  p.cBA = take((size_t)NCH * 2048 * 2);
  if (off > ws_size) { fprintf(stderr, "workspace too small: need %zu have %zu\n", off, ws_size); return; }
#if MEGA
  hipMemsetAsync(p.bar, 0, (size_t)(XCD_BAR_WORDS + 64 * NL) * 4, stream);
  static int grid_blocks = 0;
  if (!grid_blocks) {
    int dev = 0, cus = 0, per_cu = 0;
    hipGetDevice(&dev);
    hipDeviceGetAttribute(&cus, hipDeviceAttributeMultiprocessorCount, dev);
    hipOccupancyMaxActiveBlocksPerMultiprocessor(&per_cu, k_mega, 256, 0);
    if (per_cu > 2) per_cu = 2;
    grid_blocks = cus * per_cu;
  }
  void* args[] = {&p};
  hipError_t e = hipLaunchCooperativeKernel((void*)k_mega, dim3(grid_blocks), dim3(256), args, 0, stream);
  if (e != hipSuccess) fprintf(stderr, "cooperative launch failed: %s (grid %d)\n", hipGetErrorString(e), grid_blocks);
#else
  const int G = 512;
  for (int l = 0; l < NL; ++l) {
    k_phase<1><<<G, 256, 0, stream>>>(p, l);
    k_phase<2><<<G, 256, 0, stream>>>(p, l);
    k_phase<8><<<G, 256, 0, stream>>>(p, l);
    k_phase<3><<<G, 256, 0, stream>>>(p, l);
    k_phase<4><<<G, 256, 0, stream>>>(p, l);
    k_phase<5><<<G, 256, 0, stream>>>(p, l);
    k_phase<6><<<G, 256, 0, stream>>>(p, l);
    k_phase<7><<<G, 256, 0, stream>>>(p, l);
  }
#endif
}
```

```cpp
#include <hip/hip_runtime.h>
#include <hip/hip_cooperative_groups.h>
#include <stdint.h>
#include <stdio.h>
namespace cg = cooperative_groups;

#ifndef MEGA
#define MEGA 1
#endif

typedef unsigned short bf16_t;
typedef short bf16x8 __attribute__((ext_vector_type(8)));
typedef short s16x4 __attribute__((ext_vector_type(4)));
typedef float f32x4 __attribute__((ext_vector_type(4)));
typedef float f32x2 __attribute__((ext_vector_type(2)));
typedef float f32x16 __attribute__((ext_vector_type(16)));
typedef unsigned u32x4 __attribute__((ext_vector_type(4)));
typedef unsigned u32x2 __attribute__((ext_vector_type(2)));
typedef __bf16 bfv2 __attribute__((ext_vector_type(2)));

#define DI __device__ __forceinline__
#define XCD_BAR_WORDS 3456
DI int tid_() { int t = threadIdx.x; asm volatile("" : "+v"(t)); return t; }

constexpr int DM = 1024, MP = 16384, MS = 512, MT = 16896, NZ = 6272, NL = 4;
constexpr int C_GR = 1664, C_Q = 2176, C_K = 2688, C_V = 3200, C_GA = 3712, C_MR = 4224, C_MA = 5248;
constexpr int SHC = 1664;
constexpr size_t O_YP = 0, O_YS = 16777216, O_KP = 17301504, O_VP = 50855936, O_WP = 84410368, O_SP = 84934656,
                 O_KS = 84961280, O_VS = 86009856, O_WS = 87058432, O_SS = 88107008;

struct Params {
  const float *xp, *xs, *pp, *ps, *ck, *cv, *swkv, *sshift;
  const float *norm_g, *w_in, *shift_mu, *decay_w0, *decay_w2, *iclr_a0, *iclr_a2, *k_k, *k_a, *r_k, *lnx_g, *lnx_b,
      *qng, *kng, *lq1, *lk1, *lq2, *lk2, *subln_g, *w_br_r, *w_br_a, *w_out, *ple_w, *ple_gate_w, *ple_norm_g;
  float* out;
  bf16_t *wt_in, *wt_brr, *wt_bra, *wt_out, *wt_ple, *wt_gate, *w2t, *a2t;
  bf16_t *hn, *z, *vtp, *vts, *kc, *vct, *o_r, *o_a;
  bf16_t *cPT, *cG, *cRT, *cOI, *cBA;
  unsigned* bar;
  float *ss1, *ss2;
  bf16_t* gS;
};

DI unsigned pk2(float a, float b) { f32x2 v = {a, b}; bfv2 r = __builtin_convertvector(v, bfv2); return __builtin_bit_cast(unsigned, r); }
DI float bf_lo(unsigned u) { return __uint_as_float(u << 16); }
DI float bf_hi(unsigned u) { return __uint_as_float(u & 0xffff0000u); }
DI float bf1(bf16_t u) { return __uint_as_float(((unsigned)u) << 16); }
DI float sigmoidf_(float x) { return __builtin_amdgcn_rcpf(1.0f + __expf(-x)); }
DI float siluf_(float x) { return x * __builtin_amdgcn_rcpf(1.0f + __expf(-x)); }

DI void tr_tile(const float* __restrict__ src, int ld_src, bf16_t* __restrict__ dst, int ld_dst, float* sm) {
  const int tid = tid_();
  const int r = tid >> 4, c4 = (tid & 15) * 4;
#pragma unroll
  for (int i = 0; i < 4; ++i) {
    const int row = r + 16 * i;
    f32x4 v = *(const f32x4*)(src + (size_t)row * ld_src + c4);
    sm[row * 65 + c4 + 0] = v[0]; sm[row * 65 + c4 + 1] = v[1]; sm[row * 65 + c4 + 2] = v[2]; sm[row * 65 + c4 + 3] = v[3];
  }
  __syncthreads();
  const int n = tid >> 2, ks = (tid & 3) * 16;
  u32x4 o0, o1;
  o0[0] = pk2(sm[(ks + 0) * 65 + n], sm[(ks + 1) * 65 + n]);   o0[1] = pk2(sm[(ks + 2) * 65 + n], sm[(ks + 3) * 65 + n]);
  o0[2] = pk2(sm[(ks + 4) * 65 + n], sm[(ks + 5) * 65 + n]);   o0[3] = pk2(sm[(ks + 6) * 65 + n], sm[(ks + 7) * 65 + n]);
  o1[0] = pk2(sm[(ks + 8) * 65 + n], sm[(ks + 9) * 65 + n]);   o1[1] = pk2(sm[(ks + 10) * 65 + n], sm[(ks + 11) * 65 + n]);
  o1[2] = pk2(sm[(ks + 12) * 65 + n], sm[(ks + 13) * 65 + n]); o1[3] = pk2(sm[(ks + 14) * 65 + n], sm[(ks + 15) * 65 + n]);
  *(u32x4*)(dst + (size_t)n * ld_dst + ks) = o0;
  *(u32x4*)(dst + (size_t)n * ld_dst + ks + 8) = o1;
  __syncthreads();
}

constexpr int WCONV_TILES = 1568 + 128 + 128 + 256 + 64 + 256 + 8 + 8;
DI void wconv_tile(const Params& p, int l, int t, float* sm) {
  const float* src; bf16_t* dst; int K, N;
  if (t < 1568) { src = p.w_in + (size_t)l * 1024 * NZ; dst = p.wt_in; K = 1024; N = NZ; }
  else if ((t -= 1568) < 128) { src = p.w_br_r + (size_t)l * 512 * 1024; dst = p.wt_brr; K = 512; N = 1024; }
  else if ((t -= 128) < 128) { src = p.w_br_a + (size_t)l * 512 * 1024; dst = p.wt_bra; K = 512; N = 1024; }
  else if ((t -= 128) < 256) { src = p.w_out + (size_t)l * 1024 * 1024; dst = p.wt_out; K = 1024; N = 1024; }
  else if ((t -= 256) < 64) { src = p.ple_w + (size_t)l * 256 * 1024; dst = p.wt_ple; K = 256; N = 1024; }
  else if ((t -= 64) < 256) { src = p.ple_gate_w + (size_t)l * 1024 * 1024; dst = p.wt_gate; K = 1024; N = 1024; }
  else if ((t -= 256) < 8) { src = p.decay_w2 + (size_t)l * 64 * 512; dst = p.w2t; K = 64; N = 512; }
  else { t -= 8; src = p.iclr_a2 + (size_t)l * 64 * 512; dst = p.a2t; K = 64; N = 512; }
  const int ntn = N / 64; const int tk = t / ntn, tn = t % ntn;
  tr_tile(src + (size_t)(tk * 64) * N + tn * 64, N, dst + (size_t)(tn * 64) * K + tk * 64, K, sm);
}

DI const float* x_row(const Params& p, int l, int r) {
  if (l == 0) return r < MP ? p.xp + (size_t)r * DM : p.xs + (size_t)(r - MP) * DM;
  return p.out + (size_t)r * DM;
}
DI void cache_item(const Params& p, int l, int c, char* lds) {
  const int tid = tid_();
  if (c < 1024) {
    const float* src = p.ck + (size_t)l * 8 * 1024 * 512 + (size_t)c * 4096 + tid * 16;
    bf16_t* dst = p.kc + (size_t)c * 4096 + tid * 16;
    f32x4 a0 = *(const f32x4*)(src), a1 = *(const f32x4*)(src + 4), a2 = *(const f32x4*)(src + 8), a3 = *(const f32x4*)(src + 12);
    u32x4 o0, o1;
    o0[0] = pk2(a0[0], a0[1]); o0[1] = pk2(a0[2], a0[3]); o0[2] = pk2(a1[0], a1[1]); o0[3] = pk2(a1[2], a1[3]);
    o1[0] = pk2(a2[0], a2[1]); o1[1] = pk2(a2[2], a2[3]); o1[2] = pk2(a3[0], a3[1]); o1[3] = pk2(a3[2], a3[3]);
    *(u32x4*)dst = o0; *(u32x4*)(dst + 8) = o1;
  } else {
    c -= 1024;
    const int bh = c >> 5, tt = c & 31; const int b = bh >> 2, h = bh & 3; const int tk = tt >> 1, tn = tt & 1;
    const float* src = p.cv + (size_t)l * 8 * 1024 * 512 + ((size_t)(b * 1024 + tk * 64)) * 512 + h * 128 + tn * 64;
    bf16_t* dst = p.vct + ((size_t)(bh * 128 + tn * 64)) * 1024 + tk * 64;
    tr_tile(src, 512, dst, 1024, (float*)lds);
  }
}
DI void phase_norm0(const Params& p, char* lds) {
  const int tid = tid_(), wave = __builtin_amdgcn_readfirstlane(tid >> 6), lane = tid & 63;
  const float* g = p.norm_g;
  const int n_norm = MT / 8;
  const int n_items = n_norm + 2048 + WCONV_TILES;
  for (int it = blockIdx.x; it < n_items; it += gridDim.x) {
    if (it < n_norm) {
      const int r0 = it * 8 + wave * 2;
      f32x4 v[2][4]; float ss[2] = {0.f, 0.f};
#pragma unroll
      for (int k = 0; k < 2; ++k) {
        const float* x = x_row(p, 0, r0 + k);
#pragma unroll
        for (int i = 0; i < 4; ++i) v[k][i] = *(const f32x4*)(x + lane * 4 + 256 * i);
      }
      f32x4 gv[4];
#pragma unroll
      for (int i = 0; i < 4; ++i) gv[i] = *(const f32x4*)(g + lane * 4 + 256 * i);
#pragma unroll
      for (int k = 0; k < 2; ++k) {
#pragma unroll
        for (int i = 0; i < 4; ++i) ss[k] += v[k][i][0] * v[k][i][0] + v[k][i][1] * v[k][i][1] + v[k][i][2] * v[k][i][2] + v[k][i][3] * v[k][i][3];
#pragma unroll
        for (int o = 32; o >= 1; o >>= 1) ss[k] += __shfl_xor(ss[k], o);
        const float rstd = rsqrtf(ss[k] * (1.0f / 1024.0f) + 1e-6f);
#pragma unroll
        for (int i = 0; i < 4; ++i) {
          u32x2 o; o[0] = pk2(v[k][i][0] * rstd * gv[i][0], v[k][i][1] * rstd * gv[i][1]); o[1] = pk2(v[k][i][2] * rstd * gv[i][2], v[k][i][3] * rstd * gv[i][3]);
          *(u32x2*)(p.hn + (size_t)(r0 + k) * DM + lane * 4 + 256 * i) = o;
        }
        if (lane == 0) p.ss1[r0 + k] = 1024.0f * (1.0f - 1e-6f);
      }
    } else if (it < n_norm + 2048) {
      cache_item(p, 0, it - n_norm, lds);
    } else {
      wconv_tile(p, 0, it - n_norm - 2048, (float*)lds);
    }
  }
}
DI void zero_f32(float* a, int n) {
  for (int i = blockIdx.x * 256 + tid_(); i < n; i += gridDim.x * 256) a[i] = 0.f;
}

constexpr int GLD = 72;
template <bool A_F32>
DI void gemm_core(f32x4 (&acc)[4][4], const void* Ap, int lda, const bf16_t* Bp, int ldb, int K, char* lds) {
  bf16_t* As = (bf16_t*)lds;
  bf16_t* Bs = (bf16_t*)(lds + 2 * 128 * GLD * 2);
  const int tid = tid_(), wave = __builtin_amdgcn_readfirstlane(tid >> 6), lane = tid & 63;
  const int wm = wave >> 1, wn = wave & 1, l15 = lane & 15, quad = lane >> 4;
  const int nk = K / 64;
  u32x4 ra[4], rb[4];
  auto gload = [&](int kt) {
#pragma unroll
    for (int i = 0; i < 4; ++i) {
      const int c = tid + 256 * i; const int row = c >> 3, c8 = (c & 7) * 8;
      if (!A_F32) ra[i] = *(const u32x4*)((const bf16_t*)Ap + (size_t)row * lda + kt * 64 + c8);
      rb[i] = *(const u32x4*)(Bp + (size_t)row * ldb + kt * 64 + c8);
    }
  };
  auto sstore = [&](int buf, int kt) {
#pragma unroll
    for (int i = 0; i < 4; ++i) {
      const int c = tid + 256 * i; const int row = c >> 3, c8 = (c & 7) * 8;
      if (A_F32) {
        const float* a = (const float*)Ap + (size_t)row * lda + kt * 64 + c8;
        const f32x4 v0 = *(const f32x4*)a, v1 = *(const f32x4*)(a + 4);
        u32x4 t; t[0] = pk2(v0[0], v0[1]); t[1] = pk2(v0[2], v0[3]); t[2] = pk2(v1[0], v1[1]); t[3] = pk2(v1[2], v1[3]);
        *(u32x4*)(As + (buf * 128 + row) * GLD + c8) = t;
      } else {
        *(u32x4*)(As + (buf * 128 + row) * GLD + c8) = ra[i];
      }
      *(u32x4*)(Bs + (buf * 128 + row) * GLD + c8) = rb[i];
    }
  };
  gload(0); sstore(0, 0); __syncthreads();
  for (int kt = 0; kt < nk; ++kt) {
    const int buf = kt & 1;
    if (kt + 1 < nk) gload(kt + 1);
#pragma unroll
    for (int ks = 0; ks < 2; ++ks) {
      bf16x8 af[4], bfr[4];
#pragma unroll
      for (int i = 0; i < 4; ++i) {
        af[i] = *(const bf16x8*)(As + (buf * 128 + wm * 64 + i * 16 + l15) * GLD + ks * 32 + quad * 8);
        bfr[i] = *(const bf16x8*)(Bs + (buf * 128 + wn * 64 + i * 16 + l15) * GLD + ks * 32 + quad * 8);
      }
#pragma unroll
      for (int mi = 0; mi < 4; ++mi)
#pragma unroll
        for (int ni = 0; ni < 4; ++ni) acc[mi][ni] = __builtin_amdgcn_mfma_f32_16x16x32_bf16(bfr[ni], af[mi], acc[mi][ni], 0, 0, 0);
    }
    if (kt + 1 < nk) sstore(buf ^ 1, kt + 1);
    __syncthreads();
  }
}
#define LASP __attribute__((address_space(3)))
DI void gemm_dma(f32x4 (&acc)[4][4], const bf16_t* Ap, int lda, const bf16_t* Bp, int ldb, int K, char* lds) {
  const int tid = tid_(), wave = __builtin_amdgcn_readfirstlane(tid >> 6), lane = tid & 63;
  const int wm = wave >> 1, wn = wave & 1, l15 = lane & 15, quad = lane >> 4;
  const int nk = K / 64;
  const int lrow = lane >> 3, lpc = lane & 7;
  const bf16_t* ga[4]; const bf16_t* gb[4];
#pragma unroll
  for (int i = 0; i < 4; ++i) {
    const int row = (wave * 4 + i) * 8 + lrow; const int q = lpc ^ (row & 7);
    ga[i] = Ap + (size_t)row * lda + q * 8; gb[i] = Bp + (size_t)row * ldb + q * 8;
  }
  auto issue = [&](int kt) {
    char* sb = lds + (kt & 1) * 32768 + wave * 4096;
#pragma unroll
    for (int i = 0; i < 4; ++i) {
      __builtin_amdgcn_global_load_lds((const unsigned*)(ga[i] + kt * 64), (LASP unsigned*)(sb + i * 1024), 16, 0, 0);
      __builtin_amdgcn_global_load_lds((const unsigned*)(gb[i] + kt * 64), (LASP unsigned*)(sb + 16384 + i * 1024), 16, 0, 0);
    }
  };
  const int sw = l15 & 7;
  const unsigned lbase = (unsigned)(size_t)(LASP char*)lds;
  const unsigned a0 = (unsigned)((wm * 64 + l15) * 128 + ((quad ^ sw) * 16)), a1 = (unsigned)((wm * 64 + l15) * 128 + (((4 + quad) ^ sw) * 16));
  const unsigned b0 = 16384u + (unsigned)((wn * 64 + l15) * 128 + ((quad ^ sw) * 16)), b1 = 16384u + (unsigned)((wn * 64 + l15) * 128 + (((4 + quad) ^ sw) * 16));
  asm volatile("s_waitcnt vmcnt(0)" ::: "memory");
  __builtin_amdgcn_s_barrier();
  asm volatile("" ::: "memory");
  issue(0);
  for (int kt = 0; kt < nk; ++kt) {
    asm volatile("s_waitcnt vmcnt(0)" ::: "memory");
    __builtin_amdgcn_s_barrier();
    asm volatile("" ::: "memory");
    if (kt + 1 < nk) issue(kt + 1);
    const unsigned sa = lbase + (unsigned)((kt & 1) * 32768);
    bf16x8 af[4], bfr[4], ag[4], bg[4];
    asm volatile("ds_read_b128 %0, %8\n\tds_read_b128 %1, %8 offset:2048\n\tds_read_b128 %2, %8 offset:4096\n\tds_read_b128 %3, %8 offset:6144\n\t"
                 "ds_read_b128 %4, %9\n\tds_read_b128 %5, %9 offset:2048\n\tds_read_b128 %6, %9 offset:4096\n\tds_read_b128 %7, %9 offset:6144"
                 : "=&v"(af[0]), "=&v"(af[1]), "=&v"(af[2]), "=&v"(af[3]), "=&v"(bfr[0]), "=&v"(bfr[1]), "=&v"(bfr[2]), "=&v"(bfr[3])
                 : "v"(sa + a0), "v"(sa + b0) : "memory");
    asm volatile("ds_read_b128 %0, %16\n\tds_read_b128 %1, %16 offset:2048\n\tds_read_b128 %2, %16 offset:4096\n\tds_read_b128 %3, %16 offset:6144\n\t"
                 "ds_read_b128 %4, %17\n\tds_read_b128 %5, %17 offset:2048\n\tds_read_b128 %6, %17 offset:4096\n\tds_read_b128 %7, %17 offset:6144\n\t"
                 "s_waitcnt lgkmcnt(8)"
                 : "=&v"(ag[0]), "=&v"(ag[1]), "=&v"(ag[2]), "=&v"(ag[3]), "=&v"(bg[0]), "=&v"(bg[1]), "=&v"(bg[2]), "=&v"(bg[3]),
                   "+v"(af[0]), "+v"(af[1]), "+v"(af[2]), "+v"(af[3]), "+v"(bfr[0]), "+v"(bfr[1]), "+v"(bfr[2]), "+v"(bfr[3])
                 : "v"(sa + a1), "v"(sa + b1) : "memory");
#pragma unroll
    for (int mi = 0; mi < 4; ++mi)
#pragma unroll
      for (int ni = 0; ni < 4; ++ni) acc[mi][ni] = __builtin_amdgcn_mfma_f32_16x16x32_bf16(bfr[ni], af[mi], acc[mi][ni], 0, 0, 0);
    asm volatile("s_waitcnt lgkmcnt(0)" : "+v"(ag[0]), "+v"(ag[1]), "+v"(ag[2]), "+v"(ag[3]), "+v"(bg[0]), "+v"(bg[1]), "+v"(bg[2]), "+v"(bg[3]) :: "memory");
#pragma unroll
    for (int mi = 0; mi < 4; ++mi)
#pragma unroll
      for (int ni = 0; ni < 4; ++ni) acc[mi][ni] = __builtin_amdgcn_mfma_f32_16x16x32_bf16(bg[ni], ag[mi], acc[mi][ni], 0, 0, 0);
  }
  asm volatile("" ::: "memory");
  __builtin_amdgcn_s_barrier();
  asm volatile("" ::: "memory");
}
DI void zero_acc(f32x4 (&acc)[4][4]) {
#pragma unroll
  for (int i = 0; i < 4; ++i)
#pragma unroll
    for (int j = 0; j < 4; ++j) acc[i][j] = (f32x4){0.f, 0.f, 0.f, 0.f};
}

DI int xcd_tile(int r, int T) {
  const int x = blockIdx.x & 7, j = blockIdx.x >> 3, nb = gridDim.x >> 3;
  if (j >= nb) return -1;
  const int start = (int)(((long)x * T) / 8), end = (int)(((long)(x + 1) * T) / 8);
  const int g = start + r * nb + j;
  return g < end ? g : -1;
}
DI void tile_decode(int g, int nM, int nN, int& mt, int& nt) {
  const int per = 8 * nN; const int grp = g / per, idx = g - grp * per; const int gm0 = grp * 8;
  const int gsz = (nM - gm0) < 8 ? (nM - gm0) : 8;
  nt = idx / gsz; mt = gm0 + (idx - nt * gsz);
}
DI void phase_gemm_in(const Params& p, int l, char* lds) {
  const int tid = tid_(), wave = __builtin_amdgcn_readfirstlane(tid >> 6), lane = tid & 63;
  const int wm = wave >> 1, wn = wave & 1, l15 = lane & 15, quad = lane >> 4;
  const bf16_t* Wt = p.wt_in;
  const int NTN = 49, NTM = 132;
  for (int r = 0;; ++r) {
    const int g = xcd_tile(r, NTN * NTM); if (g < 0) break;
    int mt, nt; tile_decode(g, NTM, NTN, mt, nt);
    f32x4 acc[4][4]; zero_acc(acc);
    gemm_dma(acc, p.hn + (size_t)mt * 128 * DM, DM, Wt + (size_t)nt * 128 * DM, DM, DM, lds);
    const int colb = nt * 128 + wn * 64 + quad * 4;
    {
#pragma unroll
      for (int mi = 0; mi < 4; ++mi) {
        const float rs = rsqrtf(p.ss1[mt * 128 + wm * 64 + mi * 16 + l15] * (1.0f / 1024.0f) + 1e-6f);
#pragma unroll
        for (int ni = 0; ni < 4; ++ni) acc[mi][ni] = acc[mi][ni] * rs;
      }
    }
    int kind;
    if (nt < 13) kind = 0; else if (nt < 17) kind = 1; else if (nt < 21) kind = 2; else if (nt < 25) kind = 3; else if (nt < 29) kind = 4; else if (nt < 33) kind = 1; else kind = 5;
#pragma unroll
    for (int mi = 0; mi < 4; ++mi) {
      const int R = mt * 128 + wm * 64 + mi * 16 + l15;
      const bool isp = R < MP; const int rs = R - MP;
      bf16_t* zrow = p.z + (size_t)R * NZ;
      if (kind == 0) {
        const bool last = isp ? ((R & 4095) == 4095) : ((rs & 63) == 63);
        float* so = isp ? p.out + O_SP + (size_t)(l * 4 + (R >> 12)) * SHC : p.out + O_SS + (size_t)(l * 8 + (rs >> 6)) * SHC;
#pragma unroll
        for (int ni = 0; ni < 4; ++ni) {
          const int c = colb + ni * 16; const f32x4 v = acc[mi][ni];
          u32x2 o; o[0] = pk2(v[0], v[1]); o[1] = pk2(v[2], v[3]); *(u32x2*)(zrow + c) = o;
          if (last) *(f32x4*)(so + c) = v;
        }
      } else if (kind == 1 || kind == 5) {
#pragma unroll
        for (int ni = 0; ni < 4; ++ni) {
          const int c = colb + ni * 16; f32x4 v = acc[mi][ni];
#pragma unroll
          for (int e = 0; e < 4; ++e) v[e] = (kind == 1) ? siluf_(v[e]) : sigmoidf_(v[e]);
          u32x2 o; o[0] = pk2(v[0], v[1]); o[1] = pk2(v[2], v[3]); *(u32x2*)(zrow + c) = o;
        }
      } else if (kind == 2 || kind == 3) {
        float ss = 0.f;
#pragma unroll
        for (int ni = 0; ni < 4; ++ni) { const f32x4 v = acc[mi][ni]; ss += v[0] * v[0] + v[1] * v[1] + v[2] * v[2] + v[3] * v[3]; }
        ss += __shfl_xor(ss, 16); ss += __shfl_xor(ss, 32);
        const float rstd = rsqrtf(ss * (1.0f / 64.0f) + 1e-6f);
        const float* g = (kind == 2 ? p.qng : p.kng) + l * 64;
        float* ko = isp ? p.out + O_KP + ((size_t)l * MP + R) * 512 : p.out + O_KS + ((size_t)l * MS + rs) * 512;
#pragma unroll
        for (int ni = 0; ni < 4; ++ni) {
          const int c = colb + ni * 16; const int d = ni * 16 + quad * 4;
          const f32x4 gv = *(const f32x4*)(g + d); f32x4 v = acc[mi][ni];
#pragma unroll
          for (int e = 0; e < 4; ++e) v[e] = v[e] * rstd * gv[e];
          u32x2 o; o[0] = pk2(v[0], v[1]); o[1] = pk2(v[2], v[3]); *(u32x2*)(zrow + c) = o;
          if (kind == 3) *(f32x4*)(ko + (c - C_K)) = v;
        }
      } else {
        float* vo = isp ? p.out + O_VP + ((size_t)l * MP + R) * 512 : p.out + O_VS + ((size_t)l * MS + rs) * 512;
#pragma unroll
        for (int ni = 0; ni < 4; ++ni) {
          const int cv = colb + ni * 16 - C_V; const f32x4 v = acc[mi][ni];
          *(f32x4*)(vo + cv) = v;
          const int h = cv >> 7, vd = cv & 127;
          if (isp) {
            bf16_t* vt = p.vtp + ((size_t)(((R >> 12) * 4 + h) * 128 + vd)) * 4096 + (R & 4095);
#pragma unroll
            for (int e = 0; e < 4; ++e) vt[(size_t)e * 4096] = (bf16_t)(pk2(v[e], 0.f) & 0xffff);
          } else {
            bf16_t* vt = p.vts + ((size_t)(((rs >> 6) * 4 + h) * 128 + vd)) * 64 + (rs & 63);
#pragma unroll
            for (int e = 0; e < 4; ++e) vt[(size_t)e * 64] = (bf16_t)(pk2(v[e], 0.f) & 0xffff);
          }
        }
      }
    }
  }
  zero_f32(p.ss2, MT);
  if (l > 0) for (int it = blockIdx.x; it < 320; it += gridDim.x) wconv_tile(p, l, 2080 + it, (float*)lds);
}

constexpr int NCH_P = 4096, NCH = 4224;
constexpr int XLD = 40;
DI f32x4 mm16(const bf16_t* Xrow, int ldx, const bf16_t* Yrow, int ldy, int ksteps, f32x4 acc, int l15, int quad) {
  for (int ks = 0; ks < ksteps; ++ks) {
    const bf16x8 a = *(const bf16x8*)(Xrow + l15 * ldx + ks * 32 + quad * 8);
    const bf16x8 b = *(const bf16x8*)(Yrow + l15 * ldy + ks * 32 + quad * 8);
    acc = __builtin_amdgcn_mfma_f32_16x16x32_bf16(a, b, acc, 0, 0, 0);
  }
  return acc;
}
DI void chunk_item(const Params& p, int l, int item, char* lds) {
  const int tid = tid_(), wave = __builtin_amdgcn_readfirstlane(tid >> 6), lane = tid & 63, l15 = lane & 15, quad = lane >> 4;
  const bool isp = item < NCH_P;
  int bh, c;
  if (isp) { bh = item >> 7; c = item & 127; } else { const int j = item - NCH_P; bh = j >> 1; c = j & 1; }
  const int b = bh >> 3, h = bh & 7;
  const int t0 = c * 32; const int row0 = (isp ? b * 4096 : MP + b * 64) + t0;
  float* s_r = (float*)lds;
  float* s_kf = s_r + 2048;
  float* s_v = s_kf + 2048;
  float* s_w = s_v + 2048;
  float* s_kk = s_w + 2048;
  float* s_bb = s_kk + 2048;
  bf16_t* s_wd = (bf16_t*)(lds + 49152);
  bf16_t* s_ad = (bf16_t*)(lds + 53760);
  float* s_bonus = (float*)(lds + 58368);
  float* s_wl = (float*)(lds + 58880);
  float* s_rhs = (float*)lds;
  bf16_t* s_A = (bf16_t*)lds;
  bf16_t* s_Bm = (bf16_t*)(lds + 4608);
  bf16_t* s_Kp = (bf16_t*)(lds + 9216);
  bf16_t* s_R = (bf16_t*)(lds + 16384);
  bf16_t* s_BmT = (bf16_t*)(lds + 20992);
  bf16_t* s_KpT = (bf16_t*)(lds + 26112);
  bf16_t* s_VmT = (bf16_t*)(lds + 31232);
  bf16_t* s_Lak = (bf16_t*)(lds + 36352);
  bf16_t* s_Mrk = (bf16_t*)(lds + 38912);
  bf16_t* s_Mrb = (bf16_t*)(lds + 41472);
  float* s_labT = (float*)(lds + 44032);
  bf16_t* s_XT = (bf16_t*)(lds + 48640);

  const int mat = wave >> 1, tt = wave & 1;
  const bf16_t* wl = (mat == 0 ? p.w2t : p.a2t) + (size_t)(h * 64) * 64;
  const float* mu = p.shift_mu + l * SHC;
  const float* w0 = p.decay_w0 + l * 512 + h * 64;
  const float* a0 = p.iclr_a0 + l * 512 + h * 64;
  const float* kkp = p.k_k + l * 512 + h * 64;
  const float* kap = p.k_a + l * 512 + h * 64;
  const float* rkp = p.r_k + l * 512 + h * 64;
  const float* lb = p.lnx_b + l * 512 + h * 64;
  const int ptok = tid >> 3, pcs = (tid & 7) * 8;
  {
    const int t = t0 + ptok; const size_t row = (size_t)(row0 + ptok);
#pragma unroll
    for (int g = 0; g < 5; ++g) {
      const int zc = (g < 3 ? g * 512 + h * 64 : 1536 + (g - 3) * 64) + pcs;
      const u32x4 cu = *(const u32x4*)(p.z + row * NZ + zc);
      float cur[8], prv[8];
#pragma unroll
      for (int e = 0; e < 4; ++e) { cur[2 * e] = bf_lo(cu[e]); cur[2 * e + 1] = bf_hi(cu[e]); }
      if (t > 0) {
        const u32x4 pu = *(const u32x4*)(p.z + (row - 1) * NZ + zc);
#pragma unroll
        for (int e = 0; e < 4; ++e) { prv[2 * e] = bf_lo(pu[e]); prv[2 * e + 1] = bf_hi(pu[e]); }
      } else if (isp) {
#pragma unroll
        for (int e = 0; e < 8; ++e) prv[e] = 0.f;
      } else {
        const float* sp = p.sshift + (size_t)(l * 8 + b) * SHC + zc;
#pragma unroll
        for (int e = 0; e < 8; ++e) prv[e] = sp[e];
      }
      float zs[8];
#pragma unroll
      for (int e = 0; e < 8; ++e) zs[e] = cur[e] + (prv[e] - cur[e]) * mu[zc + e];
      if (g < 3) {
        float* d = (g == 0 ? s_r : g == 1 ? s_kf : s_v) + ptok * 64 + pcs;
        *(f32x4*)d = (f32x4){zs[0], zs[1], zs[2], zs[3]}; *(f32x4*)(d + 4) = (f32x4){zs[4], zs[5], zs[6], zs[7]};
      } else {
        if (g == 3) {
#pragma unroll
          for (int e = 0; e < 8; ++e) { const float ex = __expf(2.f * zs[e]); zs[e] = 1.f - 2.f * __builtin_amdgcn_rcpf(ex + 1.f); }
        }
        u32x4 o; o[0] = pk2(zs[0], zs[1]); o[1] = pk2(zs[2], zs[3]); o[2] = pk2(zs[4], zs[5]); o[3] = pk2(zs[6], zs[7]);
        *(u32x4*)((g == 3 ? s_wd : s_ad) + ptok * 72 + pcs) = o;
      }
    }
  }
  __syncthreads();
  {
    const bf16_t* At = (mat == 0 ? s_wd : s_ad);
    bf16x8 af[2];
#pragma unroll
    for (int ks = 0; ks < 2; ++ks) af[ks] = *(const bf16x8*)(At + (tt * 16 + l15) * 72 + ks * 32 + quad * 8);
#pragma unroll
    for (int ct = 0; ct < 4; ++ct) {
      f32x4 d = (f32x4){0.f, 0.f, 0.f, 0.f};
#pragma unroll
      for (int ks = 0; ks < 2; ++ks) {
        const bf16x8 wfr = *(const bf16x8*)(wl + (size_t)(ct * 16 + l15) * 64 + ks * 32 + quad * 8);
        d = __builtin_amdgcn_mfma_f32_16x16x32_bf16(wfr, af[ks], d, 0, 0, 0);
      }
      const int ch = ct * 16 + quad * 4; const int tok = tt * 16 + l15;
      f32x4 o;
      if (mat == 0) {
#pragma unroll
        for (int e = 0; e < 4; ++e) {
          const float y = -(w0[ch + e] + d[e]);
          const float sp = fmaxf(y, 0.f) + __logf(1.0f + __expf(-fabsf(y)));
          o[e] = -__expf(-sp - 0.5f);
        }
        *(f32x4*)(s_w + tok * 64 + ch) = o;
      } else {
#pragma unroll
        for (int e = 0; e < 4; ++e) o[e] = sigmoidf_(a0[ch + e] + d[e]);
        *(f32x4*)(s_bb + tok * 64 + ch) = o;
      }
    }
  }
  __syncthreads();
  float r_[8], kf[8], kk[8], bbv[8], v_[8], bon;
  {
    float k_[8], a_[8];
    *(f32x4*)&k_[0] = *(const f32x4*)(s_kf + ptok * 64 + pcs); *(f32x4*)&k_[4] = *(const f32x4*)(s_kf + ptok * 64 + pcs + 4);
    *(f32x4*)&a_[0] = *(const f32x4*)(s_bb + ptok * 64 + pcs); *(f32x4*)&a_[4] = *(const f32x4*)(s_bb + ptok * 64 + pcs + 4);
    *(f32x4*)&r_[0] = *(const f32x4*)(s_r + ptok * 64 + pcs); *(f32x4*)&r_[4] = *(const f32x4*)(s_r + ptok * 64 + pcs + 4);
    *(f32x4*)&v_[0] = *(const f32x4*)(s_v + ptok * 64 + pcs); *(f32x4*)&v_[4] = *(const f32x4*)(s_v + ptok * 64 + pcs + 4);
    float ss = 0.f; bon = 0.f;
#pragma unroll
    for (int e = 0; e < 8; ++e) {
      kk[e] = k_[e] * kkp[pcs + e]; ss += kk[e] * kk[e];
      kf[e] = k_[e] * (1.f + (a_[e] - 1.f) * kap[pcs + e]);
      bon += r_[e] * kf[e] * rkp[pcs + e];
    }
    ss += __shfl_xor(ss, 1); ss += __shfl_xor(ss, 2); ss += __shfl_xor(ss, 4);
    bon += __shfl_xor(bon, 1); bon += __shfl_xor(bon, 2); bon += __shfl_xor(bon, 4);
    const float inv = 1.0f / fmaxf(sqrtf(ss), 1e-12f);
#pragma unroll
    for (int e = 0; e < 8; ++e) { kk[e] *= inv; bbv[e] = kk[e] * a_[e]; }
  }
  if (tid < 64) {
    float run = 0.f;
#pragma unroll 8
    for (int t = 0; t < 32; ++t) { run += s_w[t * 64 + tid]; s_w[t * 64 + tid] = run; }
  }
  __syncthreads();
  {
    float cw[8], cwp[8];
    *(f32x4*)&cw[0] = *(const f32x4*)(s_w + ptok * 64 + pcs); *(f32x4*)&cw[4] = *(const f32x4*)(s_w + ptok * 64 + pcs + 4);
    if (ptok > 0) { *(f32x4*)&cwp[0] = *(const f32x4*)(s_w + (ptok - 1) * 64 + pcs); *(f32x4*)&cwp[4] = *(const f32x4*)(s_w + (ptok - 1) * 64 + pcs + 4); }
    else {
#pragma unroll
      for (int e = 0; e < 8; ++e) cwp[e] = 0.f;
    }
    __syncthreads();
    float av[8], bm[8], kp[8], rr[8];
#pragma unroll
    for (int e = 0; e < 8; ++e) {
      const float ec = __expf(cw[e]), en = __expf(-cw[e]), ep = __expf(cwp[e]);
      av[e] = kk[e] * ep; bm[e] = bbv[e] * en; kp[e] = kf[e] * en; rr[e] = r_[e] * ec;
      if (ptok == 31) s_wl[pcs + e] = ec;
    }
    u32x4 o;
    o[0] = pk2(av[0], av[1]); o[1] = pk2(av[2], av[3]); o[2] = pk2(av[4], av[5]); o[3] = pk2(av[6], av[7]); *(u32x4*)(s_A + ptok * 72 + pcs) = o;
    o[0] = pk2(bm[0], bm[1]); o[1] = pk2(bm[2], bm[3]); o[2] = pk2(bm[4], bm[5]); o[3] = pk2(bm[6], bm[7]); *(u32x4*)(s_Bm + ptok * 72 + pcs) = o;
#pragma unroll
    for (int e = 0; e < 4; ++e) { s_BmT[(pcs + 2 * e) * XLD + ptok] = (bf16_t)(o[e] & 0xffff); s_BmT[(pcs + 2 * e + 1) * XLD + ptok] = (bf16_t)(o[e] >> 16); }
    o[0] = pk2(kp[0], kp[1]); o[1] = pk2(kp[2], kp[3]); o[2] = pk2(kp[4], kp[5]); o[3] = pk2(kp[6], kp[7]); *(u32x4*)(s_Kp + ptok * 72 + pcs) = o;
#pragma unroll
    for (int e = 0; e < 4; ++e) { s_KpT[(pcs + 2 * e) * XLD + ptok] = (bf16_t)(o[e] & 0xffff); s_KpT[(pcs + 2 * e + 1) * XLD + ptok] = (bf16_t)(o[e] >> 16); }
    o[0] = pk2(rr[0], rr[1]); o[1] = pk2(rr[2], rr[3]); o[2] = pk2(rr[4], rr[5]); o[3] = pk2(rr[6], rr[7]); *(u32x4*)(s_R + ptok * 72 + pcs) = o;
    o[0] = pk2(v_[0], v_[1]); o[1] = pk2(v_[2], v_[3]); o[2] = pk2(v_[4], v_[5]); o[3] = pk2(v_[6], v_[7]);
#pragma unroll
    for (int e = 0; e < 4; ++e) { s_VmT[(pcs + 2 * e) * XLD + ptok] = (bf16_t)(o[e] & 0xffff); s_VmT[(pcs + 2 * e + 1) * XLD + ptok] = (bf16_t)(o[e] >> 16); }
    u32x4 ob;
    ob[0] = pk2(lb[pcs + 0] + bon * v_[0], lb[pcs + 1] + bon * v_[1]); ob[1] = pk2(lb[pcs + 2] + bon * v_[2], lb[pcs + 3] + bon * v_[3]);
    ob[2] = pk2(lb[pcs + 4] + bon * v_[4], lb[pcs + 5] + bon * v_[5]); ob[3] = pk2(lb[pcs + 6] + bon * v_[6], lb[pcs + 7] + bon * v_[7]);
    *(u32x4*)(p.cBA + ((size_t)item * 32 + ptok) * 64 + pcs) = ob;
  }
  __syncthreads();
  {
    const bf16_t* X = (wave < 2) ? s_A : s_R;
    const bf16_t* Y = (wave == 0 || wave == 3) ? s_Bm : s_Kp;
    const bool strict = wave < 2;
#pragma unroll
    for (int ti = 0; ti < 2; ++ti)
#pragma unroll
      for (int ii = 0; ii < 2; ++ii) {
        f32x4 d = (f32x4){0.f, 0.f, 0.f, 0.f};
        if (ii <= ti) d = mm16(X + ti * 16 * 72, 72, Y + ii * 16 * 72, 72, 2, d, l15, quad);
        const int i = ii * 16 + l15;
#pragma unroll
        for (int e = 0; e < 4; ++e) {
          const int t = ti * 16 + quad * 4 + e;
          const bool keep = strict ? (i < t) : (i <= t);
          const float val = keep ? d[e] : 0.f;
          if (wave == 0) s_labT[i * 36 + t] = val;
          else { bf16_t* dst = (wave == 1 ? s_Lak : wave == 2 ? s_Mrk : s_Mrb); dst[t * XLD + i] = (bf16_t)(pk2(val, 0.f) & 0xffff); }
        }
      }
  }
  const u32x4 acap = *(const u32x4*)(s_A + ptok * 72 + pcs);
  __syncthreads();
  {
    float* d = s_rhs + ptok * 128 + pcs;
    *(f32x4*)d = (f32x4){bf_lo(acap[0]), bf_hi(acap[0]), bf_lo(acap[1]), bf_hi(acap[1])};
    *(f32x4*)(d + 4) = (f32x4){bf_lo(acap[2]), bf_hi(acap[2]), bf_lo(acap[3]), bf_hi(acap[3])};
  }
  {
    const int ti = wave & 1;
#pragma unroll
    for (int vv = 0; vv < 2; ++vv) {
      const int vi = (wave >> 1) * 2 + vv;
      f32x4 d = (f32x4){0.f, 0.f, 0.f, 0.f};
      d = mm16(s_Lak + ti * 16 * XLD, XLD, s_VmT + vi * 16 * XLD, XLD, 1, d, l15, quad);
#pragma unroll
      for (int e = 0; e < 4; ++e) s_rhs[(ti * 16 + quad * 4 + e) * 128 + 64 + vi * 16 + l15] = d[e];
    }
  }
  __syncthreads();
  if (tid < 128) {
    float x[32];
#pragma unroll
    for (int t = 0; t < 32; ++t) x[t] = s_rhs[t * 128 + tid];
#pragma unroll
    for (int i = 0; i < 31; ++i) {
      const float xi = x[i];
#pragma unroll
      for (int t4 = ((i + 1) >> 2); t4 < 8; ++t4) {
        const f32x4 lv = *(const f32x4*)(s_labT + i * 36 + t4 * 4);
#pragma unroll
        for (int e = 0; e < 4; ++e) { const int t = t4 * 4 + e; if (t > i) x[t] -= lv[e] * xi; }
      }
    }
#pragma unroll
    for (int q4 = 0; q4 < 4; ++q4) {
      u32x4 o; o[0] = pk2(x[8 * q4], x[8 * q4 + 1]); o[1] = pk2(x[8 * q4 + 2], x[8 * q4 + 3]); o[2] = pk2(x[8 * q4 + 4], x[8 * q4 + 5]); o[3] = pk2(x[8 * q4 + 6], x[8 * q4 + 7]);
      *(u32x4*)(s_XT + tid * XLD + q4 * 8) = o;
    }
  }
  __syncthreads();
  {
    const f32x4 z4 = (f32x4){0.f, 0.f, 0.f, 0.f};
    bf16_t* gPT = p.cPT + (size_t)item * 4096;
    const float wl_c = s_wl[wave * 16 + l15];
#pragma unroll
    for (int k1t = 0; k1t < 4; ++k1t) {
      f32x4 d = mm16(s_XT + k1t * 16 * XLD, XLD, s_BmT + wave * 16 * XLD, XLD, 1, z4, l15, quad);
      const int k2 = wave * 16 + l15, k1 = k1t * 16 + quad * 4;
      float o[4];
#pragma unroll
      for (int e = 0; e < 4; ++e) o[e] = ((k1 + e == k2 ? 1.f : 0.f) - d[e]) * wl_c;
      u32x2 ov; ov[0] = pk2(o[0], o[1]); ov[1] = pk2(o[2], o[3]);
      *(u32x2*)(gPT + k2 * 64 + k1) = ov;
    }
    bf16_t* gG = p.cG + (size_t)item * 4096;
#pragma unroll
    for (int k2t = 0; k2t < 4; ++k2t) {
      const f32x4 d1 = mm16(s_KpT + k2t * 16 * XLD, XLD, s_VmT + wave * 16 * XLD, XLD, 1, z4, l15, quad);
      const f32x4 d2 = mm16(s_BmT + k2t * 16 * XLD, XLD, s_XT + (64 + wave * 16) * XLD, XLD, 1, z4, l15, quad);
      const int k2 = k2t * 16 + quad * 4, v = wave * 16 + l15;
      const f32x4 wv = *(const f32x4*)(s_wl + k2);
      u32x2 ov; ov[0] = pk2((d1[0] - d2[0]) * wv[0], (d1[1] - d2[1]) * wv[1]); ov[1] = pk2((d1[2] - d2[2]) * wv[2], (d1[3] - d2[3]) * wv[3]);
      *(u32x2*)(gG + v * 64 + k2) = ov;
    }
    bf16_t* gRT = p.cRT + (size_t)item * 2048;
    bf16_t* gOI = p.cOI + (size_t)item * 2048;
#pragma unroll
    for (int ti = 0; ti < 2; ++ti) {
      const f32x4 d = mm16(s_XT + wave * 16 * XLD, XLD, s_Mrb + ti * 16 * XLD, XLD, 1, z4, l15, quad);
      const int t = ti * 16 + l15, k = wave * 16 + quad * 4;
      const u32x2 rv = *(const u32x2*)(s_R + t * 72 + k);
      u32x2 ov; ov[0] = pk2(bf_lo(rv[0]) - d[0], bf_hi(rv[0]) - d[1]); ov[1] = pk2(bf_lo(rv[1]) - d[2], bf_hi(rv[1]) - d[3]);
      *(u32x2*)(gRT + t * 64 + k) = ov;
      const f32x4 e1 = mm16(s_VmT + wave * 16 * XLD, XLD, s_Mrk + ti * 16 * XLD, XLD, 1, z4, l15, quad);
      const f32x4 e2 = mm16(s_XT + (64 + wave * 16) * XLD, XLD, s_Mrb + ti * 16 * XLD, XLD, 1, z4, l15, quad);
      u32x2 oo; oo[0] = pk2(e1[0] - e2[0], e1[1] - e2[1]); oo[1] = pk2(e1[2] - e2[2], e1[3] - e2[3]);
      *(u32x2*)(gOI + t * 64 + k) = oo;
    }
  }
  __syncthreads();
}

DI void rec_item(const Params& p, int l, int item, char* lds) {
  const int tid = tid_(), wave = __builtin_amdgcn_readfirstlane(tid >> 6), lane = tid & 63, l15 = lane & 15, quad = lane >> 4;
  const bool isp = item < 32;
  const int bh = isp ? item : item - 32; const int b = bh >> 3, h = bh & 7;
  const int nch = isp ? 128 : 2; const int cid0 = isp ? bh * 128 : NCH_P + bh * 2;
  bf16_t* Sb = (bf16_t*)lds;
  const unsigned lbase = (unsigned)(size_t)(LASP char*)lds;
  __syncthreads();
  if (wave < 2) {
    f32x4 acc[2][4];
#pragma unroll
    for (int v2 = 0; v2 < 2; ++v2) {
      const int v = (wave * 2 + v2) * 16 + l15;
      if (isp) {
#pragma unroll
        for (int nk = 0; nk < 4; ++nk) acc[v2][nk] = (f32x4){0.f, 0.f, 0.f, 0.f};
      } else {
        const float* sp = p.swkv + (((size_t)(l * 8 + b) * 8 + h) * 64 + v) * 64;
#pragma unroll
        for (int nk = 0; nk < 4; ++nk) acc[v2][nk] = *(const f32x4*)(sp + nk * 16 + quad * 4);
      }
#pragma unroll
      for (int nk = 0; nk < 4; ++nk) {
        u32x2 o; o[0] = pk2(acc[v2][nk][0], acc[v2][nk][1]); o[1] = pk2(acc[v2][nk][2], acc[v2][nk][3]);
        *(u32x2*)(Sb + v * 72 + nk * 16 + quad * 4) = o;
        *(u32x2*)(p.gS + (size_t)cid0 * 4096 + v * 64 + nk * 16 + quad * 4) = o;
      }
    }
    const int nmain = nch - 2;
    struct PS { bf16x8 pt[4][2]; u32x2 gv[2][4]; };
    auto ldp = [&](PS& s, int c) {
      const int cc = c < nch ? c : nch - 1;
      const size_t cid = (size_t)(cid0 + cc);
      const bf16_t* gPT = p.cPT + cid * 4096; const bf16_t* gG = p.cG + cid * 4096;
#pragma unroll
      for (int nk = 0; nk < 4; ++nk) {
#pragma unroll
        for (int ks = 0; ks < 2; ++ks) s.pt[nk][ks] = *(const bf16x8*)(gPT + (nk * 16 + l15) * 64 + ks * 32 + quad * 8);
#pragma unroll
        for (int v2 = 0; v2 < 2; ++v2) s.gv[v2][nk] = *(const u32x2*)(gG + ((wave * 2 + v2) * 16 + l15) * 64 + nk * 16 + quad * 4);
      }
    };
    auto step = [&](PS& s, int c) {
      const int buf = c & 1;
      bf16x8 sf[2][2];
      {
        const unsigned sad = lbase + (unsigned)(((buf * 64 + wave * 32 + l15) * 72 + quad * 8) * 2);
        asm volatile("ds_read_b128 %0, %4\n\tds_read_b128 %1, %4 offset:64\n\tds_read_b128 %2, %4 offset:2304\n\tds_read_b128 %3, %4 offset:2368\n\ts_waitcnt lgkmcnt(0)"
                     : "=&v"(sf[0][0]), "=&v"(sf[0][1]), "=&v"(sf[1][0]), "=&v"(sf[1][1]) : "v"(sad) : "memory");
      }
#pragma unroll
      for (int v2 = 0; v2 < 2; ++v2) {
#pragma unroll
        for (int nk = 0; nk < 4; ++nk) {
          f32x4 a = (f32x4){bf_lo(s.gv[v2][nk][0]), bf_hi(s.gv[v2][nk][0]), bf_lo(s.gv[v2][nk][1]), bf_hi(s.gv[v2][nk][1])};
#pragma unroll
          for (int ks = 0; ks < 2; ++ks) a = __builtin_amdgcn_mfma_f32_16x16x32_bf16(s.pt[nk][ks], sf[v2][ks], a, 0, 0, 0);
          acc[v2][nk] = a;
        }
      }
      ldp(s, c + 3);
      const size_t scid = (c + 1 < nch) ? (size_t)(cid0 + c + 1) : (size_t)NCH;
#pragma unroll
      for (int v2 = 0; v2 < 2; ++v2) {
        const int v = (wave * 2 + v2) * 16 + l15;
#pragma unroll
        for (int nk = 0; nk < 4; ++nk) {
          u32x2 ov; ov[0] = pk2(acc[v2][nk][0], acc[v2][nk][1]); ov[1] = pk2(acc[v2][nk][2], acc[v2][nk][3]);
          *(u32x2*)(Sb + ((buf ^ 1) * 64 + v) * 72 + nk * 16 + quad * 4) = ov;
          *(u32x2*)(p.gS + scid * 4096 + v * 64 + nk * 16 + quad * 4) = ov;
        }
      }
      asm volatile("s_waitcnt lgkmcnt(0)" ::: "memory");
    };
    PS s0, s1, s2;
    ldp(s0, 0); ldp(s1, 1); ldp(s2, 2);
#pragma unroll 1
    for (int c = 0; c < nmain; c += 3) { step(s0, c); step(s1, c + 1); step(s2, c + 2); }
    step(s0, nmain); step(s1, nmain + 1);
#pragma unroll
    for (int v2 = 0; v2 < 2; ++v2) {
      const int v = (wave * 2 + v2) * 16 + l15;
      float* so = (isp ? p.out + O_WP + (((size_t)(l * 4 + b) * 8 + h) * 64 + v) * 64 : p.out + O_WS + (((size_t)(l * 8 + b) * 8 + h) * 64 + v) * 64);
#pragma unroll
      for (int nk = 0; nk < 4; ++nk) *(f32x4*)(so + nk * 16 + quad * 4) = acc[v2][nk];
    }
  }
  __syncthreads();
}
DI void phase_o(const Params& p, int l, int pi_first, int pi_end, int pi_step) {
  const int tid = tid_(), wave = __builtin_amdgcn_readfirstlane(tid >> 6), lane = tid & 63, l15 = lane & 15, quad = lane >> 4;
  for (int pi = pi_first; pi < pi_end; pi += pi_step) {
    const int cid = pi * 2 + (wave >> 1);
    const bool isp = cid < NCH_P;
    int bh, c;
    if (isp) { bh = cid >> 7; c = cid & 127; } else { const int j = cid - NCH_P; bh = j >> 1; c = j & 1; }
    const int b = bh >> 3, h = bh & 7;
    const int tok = (wave & 1) * 16 + l15;
    const size_t row = (size_t)((isp ? b * 4096 : MP + b * 64) + c * 32 + tok);
    bf16x8 rt[2], sa[4][2]; u32x2 oi[4], ba[4], gt[4];
#pragma unroll
    for (int ks = 0; ks < 2; ++ks) rt[ks] = *(const bf16x8*)(p.cRT + (size_t)cid * 2048 + tok * 64 + ks * 32 + quad * 8);
#pragma unroll
    for (int vt = 0; vt < 4; ++vt) {
#pragma unroll
      for (int ks = 0; ks < 2; ++ks) sa[vt][ks] = *(const bf16x8*)(p.gS + (size_t)cid * 4096 + (vt * 16 + l15) * 64 + ks * 32 + quad * 8);
      oi[vt] = *(const u32x2*)(p.cOI + (size_t)cid * 2048 + tok * 64 + vt * 16 + quad * 4);
      ba[vt] = *(const u32x2*)(p.cBA + (size_t)cid * 2048 + tok * 64 + vt * 16 + quad * 4);
      gt[vt] = *(const u32x2*)(p.z + row * NZ + C_GR + h * 64 + vt * 16 + quad * 4);
    }
    f32x4 ao[4];
#pragma unroll
    for (int vt = 0; vt < 4; ++vt) {
      f32x4 a = (f32x4){bf_lo(oi[vt][0]), bf_hi(oi[vt][0]), bf_lo(oi[vt][1]), bf_hi(oi[vt][1])};
#pragma unroll
      for (int ks = 0; ks < 2; ++ks) a = __builtin_amdgcn_mfma_f32_16x16x32_bf16(sa[vt][ks], rt[ks], a, 0, 0, 0);
      ao[vt] = a;
    }
    float sm = 0.f, sq = 0.f;
#pragma unroll
    for (int vt = 0; vt < 4; ++vt)
#pragma unroll
      for (int e = 0; e < 4; ++e) { sm += ao[vt][e]; sq += ao[vt][e] * ao[vt][e]; }
    { const float a1 = __shfl_xor(sm, 16), b1 = __shfl_xor(sq, 16); sm += a1; sq += b1; }
    { const float a1 = __shfl_xor(sm, 32), b1 = __shfl_xor(sq, 32); sm += a1; sq += b1; }
    const float mean = sm * (1.0f / 64.0f);
    const float rstd = rsqrtf(fmaxf(sq * (1.0f / 64.0f) - mean * mean, 0.f) + 64e-5f);
    const float* lg = p.lnx_g + l * 512 + h * 64;
#pragma unroll
    for (int vt = 0; vt < 4; ++vt) {
      const int vv = vt * 16 + quad * 4;
      const f32x4 g4 = *(const f32x4*)(lg + vv);
      const float y0 = ((ao[vt][0] - mean) * rstd * g4[0] + bf_lo(ba[vt][0])) * bf_lo(gt[vt][0]);
      const float y1 = ((ao[vt][1] - mean) * rstd * g4[1] + bf_hi(ba[vt][0])) * bf_hi(gt[vt][0]);
      const float y2 = ((ao[vt][2] - mean) * rstd * g4[2] + bf_lo(ba[vt][1])) * bf_lo(gt[vt][1]);
      const float y3 = ((ao[vt][3] - mean) * rstd * g4[3] + bf_hi(ba[vt][1])) * bf_hi(gt[vt][1]);
      u32x2 ov; ov[0] = pk2(y0, y1); ov[1] = pk2(y2, y3);
      *(u32x2*)(p.o_r + row * 512 + h * 64 + vv) = ov;
    }
  }
}
DI void phase_chunk(const Params& p, int l, char* lds) {
  for (int it = blockIdx.x; it < NCH_P; it += gridDim.x) chunk_item(p, l, it, lds);
  zero_f32(p.ss1, MT);
}

constexpr int ALD = 72;
DI void attn_item(const Params& p, int l, int item, char* lds) {
  const int tid = tid_(), wave = __builtin_amdgcn_readfirstlane(tid >> 6), lane = tid & 63;
  const int m = wave & 1, qh = wave >> 1, q = lane & 31, hh = lane >> 5;
  bf16_t* Ks = (bf16_t*)lds;
  bf16_t* Vs = Ks + 2 * 64 * ALD;
  float* xb = (float*)lds;
  bool samp; int b, h, nch, qrow0, qpos0;
  const int xq = item & 7, tk = item >> 3;
  if (tk < 4) { samp = true; const int bhs = xq + 8 * tk; b = bhs >> 2; h = bhs & 3; nch = 17; qrow0 = MP + b * 64; qpos0 = 1024; }
  else { samp = false; const int kk = tk - 4; const int qc = 63 - (kk >> 1); const int bh = xq + 8 * (kk & 1); b = bh >> 2; h = bh & 3; nch = qc + 1; qrow0 = b * 4096 + qc * 64; qpos0 = qc * 64; }
  bf16x8 qf[4];
  {
    const bf16_t* qp = p.z + (size_t)(qrow0 + qh * 32 + q) * NZ + C_Q + h * 128 + m * 64;
#pragma unroll
    for (int ks = 0; ks < 4; ++ks) qf[ks] = *(const bf16x8*)(qp + ks * 16 + hh * 8);
  }
  const float slope = exp2f(-2.0f * (float)(h + 1));
  const float LOG2E = 1.4426950408889634f;
  const float c1 = 0.125f * LOG2E, sl2 = slope * LOG2E;
  const float qposf = (float)(qpos0 + qh * 32 + q);
  f32x16 O[4];
#pragma unroll
  for (int i = 0; i < 4; ++i)
#pragma unroll
    for (int e = 0; e < 16; ++e) O[i][e] = 0.f;
  float mrun = -1e30f, lrun = 0.f;
  u32x4 rk[4], rv[4];
  auto gload = [&](int j) {
    const bf16_t* kb; size_t kld; const bf16_t* vb; size_t vld;
    if (!samp) { kb = p.z + (size_t)(b * 4096 + j * 64) * NZ + C_K + h * 128; kld = NZ; vb = p.vtp + (size_t)((b * 4 + h) * 128) * 4096 + j * 64; vld = 4096; }
    else if (j < 16) { kb = p.kc + (size_t)(b * 1024 + j * 64) * 512 + h * 128; kld = 512; vb = p.vct + (size_t)((b * 4 + h) * 128) * 1024 + j * 64; vld = 1024; }
    else { kb = p.z + (size_t)(MP + b * 64) * NZ + C_K + h * 128; kld = NZ; vb = p.vts + (size_t)((b * 4 + h) * 128) * 64; vld = 64; }
#pragma unroll
    for (int i = 0; i < 4; ++i) {
      const int c = tid + 256 * i;
      const int mm = c >> 9, key = (c >> 3) & 63, d8 = (c & 7) * 8;
      rk[i] = *(const u32x4*)(kb + (size_t)key * kld + mm * 64 + d8);
      const int vd = c >> 3, k8 = (c & 7) * 8;
      rv[i] = *(const u32x4*)(vb + (size_t)vd * vld + k8);
    }
  };
  auto sstore = [&]() {
#pragma unroll
    for (int i = 0; i < 4; ++i) {
      const int c = tid + 256 * i;
      const int mm = c >> 9, key = (c >> 3) & 63, d8 = (c & 7) * 8;
      *(u32x4*)(Ks + (mm * 64 + key) * ALD + d8) = rk[i];
      const int vd = c >> 3, k8 = (c & 7) * 8;
      *(u32x4*)(Vs + vd * ALD + k8) = rv[i];
    }
  };
  gload(0); sstore(); __syncthreads();
  for (int j = 0; j < nch; ++j) {
    if (j + 1 < nch) gload(j + 1);
    f32x16 s[2];
#pragma unroll
    for (int kt = 0; kt < 2; ++kt) {
#pragma unroll
      for (int e = 0; e < 16; ++e) s[kt][e] = 0.f;
#pragma unroll
      for (int ks = 0; ks < 4; ++ks) {
        const bf16x8 kf = *(const bf16x8*)(Ks + (m * 64 + kt * 32 + q) * ALD + ks * 16 + hh * 8);
        s[kt] = __builtin_amdgcn_mfma_f32_32x32x16_bf16(kf, qf[ks], s[kt], 0, 0, 0);
      }
    }
    float mx = -1e30f;
    const float dbase = qposf - (float)(j * 64 + 4 * hh);
#pragma unroll
    for (int kt = 0; kt < 2; ++kt)
#pragma unroll
      for (int e = 0; e < 16; ++e) {
        const float dd = dbase - (float)(kt * 32 + (e & 3) + 8 * (e >> 2));
        const float v = s[kt][e] * c1 - sl2 * fabsf(dd);
        s[kt][e] = v; mx = fmaxf(mx, v);
      }
    mx = fmaxf(mx, __shfl_xor(mx, 32));
    const float mnew = fmaxf(mrun, mx);
    const float alpha = __builtin_amdgcn_exp2f(mrun - mnew);
    const bool resc = mnew > mrun;
    mrun = mnew;
    float ps = 0.f;
#pragma unroll
    for (int kt = 0; kt < 2; ++kt)
#pragma unroll
      for (int e = 0; e < 16; ++e) { const float pe = __builtin_amdgcn_exp2f(s[kt][e] - mnew); s[kt][e] = pe; ps += pe; }
    lrun = lrun * alpha + ps;
    if (__any(resc)) {
#pragma unroll
      for (int i = 0; i < 4; ++i)
#pragma unroll
        for (int e = 0; e < 16; ++e) O[i][e] *= alpha;
    }
#pragma unroll
    for (int kt = 0; kt < 2; ++kt)
#pragma unroll
      for (int sx = 0; sx < 2; ++sx) {
        u32x4 pb;
        pb[0] = pk2(s[kt][8 * sx + 0], s[kt][8 * sx + 1]); pb[1] = pk2(s[kt][8 * sx + 2], s[kt][8 * sx + 3]);
        pb[2] = pk2(s[kt][8 * sx + 4], s[kt][8 * sx + 5]); pb[3] = pk2(s[kt][8 * sx + 6], s[kt][8 * sx + 7]);
        const bf16x8 pf = __builtin_bit_cast(bf16x8, pb);
#pragma unroll
        for (int vt = 0; vt < 4; ++vt) {
          const bf16_t* vp = Vs + (vt * 32 + q) * ALD + kt * 32 + 16 * sx + 4 * hh;
          const s16x4 lo = *(const s16x4*)vp, hi = *(const s16x4*)(vp + 8);
          const bf16x8 vf = __builtin_shufflevector(lo, hi, 0, 1, 2, 3, 4, 5, 6, 7);
          O[vt] = __builtin_amdgcn_mfma_f32_32x32x16_bf16(vf, pf, O[vt], 0, 0, 0);
        }
      }
    __syncthreads();
    if (j + 1 < nch) sstore();
    __syncthreads();
  }
  const float ltot = lrun + __shfl_xor(lrun, 32);
  const float inv = 1.0f / ltot;
#pragma unroll
  for (int i = 0; i < 4; ++i)
#pragma unroll
    for (int e = 0; e < 16; ++e) O[i][e] *= inv;
  if (m == 1) {
#pragma unroll
    for (int vt = 0; vt < 4; ++vt)
#pragma unroll
      for (int e = 0; e < 16; ++e) { const int vd = vt * 32 + (e & 3) + 8 * (e >> 2) + 4 * hh; xb[(qh * 128 + vd) * 32 + q] = O[vt][e]; }
  }
  __syncthreads();
  if (m == 0) {
    float d1 = 0.f, d2 = 0.f;
    for (int i = 0; i < 64; ++i) { d1 += p.lq1[l * 64 + i] * p.lk1[l * 64 + i]; d2 += p.lq2[l * 64 + i] * p.lk2[l * 64 + i]; }
    const float lam_init = 0.8f - 0.6f * __expf(-0.3f * (float)l);
    const float lam = __expf(d1) - __expf(d2) + lam_init;
    float ss = 0.f;
#pragma unroll
    for (int vt = 0; vt < 4; ++vt)
#pragma unroll
      for (int e = 0; e < 16; ++e) {
        const int vd = vt * 32 + (e & 3) + 8 * (e >> 2) + 4 * hh;
        const float o2 = xb[(qh * 128 + vd) * 32 + q];
        const float o = O[vt][e] - lam * o2; O[vt][e] = o; ss += o * o;
      }
    ss += __shfl_xor(ss, 32);
    const float rstd = rsqrtf(ss * (1.0f / 128.0f) + 1e-5f) * (1.0f - lam_init);
    const size_t row = (size_t)(qrow0 + qh * 32 + q);
    const float* sg = p.subln_g + l * 128;
#pragma unroll
    for (int vt = 0; vt < 4; ++vt)
#pragma unroll
      for (int e4 = 0; e4 < 4; ++e4) {
        const int vd = vt * 32 + 8 * e4 + 4 * hh;
        const u32x2 gu = *(const u32x2*)(p.z + row * NZ + C_GA + h * 128 + vd);
        const f32x4 gv = *(const f32x4*)(sg + vd);
        const float y0 = O[vt][4 * e4 + 0] * rstd * gv[0] * bf_lo(gu[0]);
        const float y1 = O[vt][4 * e4 + 1] * rstd * gv[1] * bf_hi(gu[0]);
        const float y2 = O[vt][4 * e4 + 2] * rstd * gv[2] * bf_lo(gu[1]);
        const float y3 = O[vt][4 * e4 + 3] * rstd * gv[3] * bf_hi(gu[1]);
        u32x2 ov; ov[0] = pk2(y0, y1); ov[1] = pk2(y2, y3);
        *(u32x2*)(p.o_a + row * 512 + h * 128 + vd) = ov;
      }
  }
  __syncthreads();
}

DI void phase_mix(const Params& p, int l, char* lds) {
  __shared__ int s_next;
  if (blockIdx.x < 96) {
    if (blockIdx.x >= 32) {
      for (int c2 = 0; c2 < 2; ++c2) chunk_item(p, l, NCH_P + (blockIdx.x - 32) * 2 + c2, lds);
      __syncthreads();
    }
    __builtin_amdgcn_s_setprio(3); rec_item(p, l, blockIdx.x, lds); __builtin_amdgcn_s_setprio(0);
    if (blockIdx.x >= 32) { const int pis = NCH_P / 2 + (blockIdx.x - 32); phase_o(p, l, pis, pis + 1, 1); }
  }
  if (gridDim.x == 512 && blockIdx.x >= 256 && blockIdx.x < 288) return;
  unsigned* ctr = p.bar + XCD_BAR_WORDS + 64 * l + (blockIdx.x & 7);
  for (;;) {
    __syncthreads();
    if (threadIdx.x == 0) { const int k = (int)atomicAdd(ctr, 1u); s_next = k < 132 ? k * 8 + (int)(blockIdx.x & 7) : 1 << 20; }
    __syncthreads();
    const int it = s_next;
    if (it >= (1 << 20)) break;
    attn_item(p, l, it, lds);
  }
}

template <bool A_F32>
DI void mini_gemm(f32x4 (&acc)[2][2], const void* Ap, int lda, const bf16_t* Bp, int ldb, int K, int wave, int l15, int quad) {
  const int kw = K >> 2, k0 = wave * kw;
#pragma unroll 2
  for (int ks = 0; ks < kw; ks += 32) {
    bf16x8 a[2], b[2];
#pragma unroll
    for (int mi = 0; mi < 2; ++mi) {
      if (A_F32) {
        const float* ap = (const float*)Ap + (size_t)(mi * 16 + l15) * lda + k0 + ks + quad * 8;
        const f32x4 v0 = *(const f32x4*)ap, v1 = *(const f32x4*)(ap + 4);
        u32x4 t; t[0] = pk2(v0[0], v0[1]); t[1] = pk2(v0[2], v0[3]); t[2] = pk2(v1[0], v1[1]); t[3] = pk2(v1[2], v1[3]);
        a[mi] = __builtin_bit_cast(bf16x8, t);
      } else {
        a[mi] = *(const bf16x8*)((const bf16_t*)Ap + (size_t)(mi * 16 + l15) * lda + k0 + ks + quad * 8);
      }
      b[mi] = *(const bf16x8*)(Bp + (size_t)(mi * 16 + l15) * ldb + k0 + ks + quad * 8);
    }
#pragma unroll
    for (int mi = 0; mi < 2; ++mi)
#pragma unroll
      for (int ni = 0; ni < 2; ++ni) acc[mi][ni] = __builtin_amdgcn_mfma_f32_16x16x32_bf16(b[ni], a[mi], acc[mi][ni], 0, 0, 0);
  }
}
DI f32x4 mini_reduce(const f32x4 (&acc)[2][2], char* lds, int wave, int lane) {
  float* red = (float*)lds;
  __syncthreads();
#pragma unroll
  for (int i = 0; i < 2; ++i)
#pragma unroll
    for (int j = 0; j < 2; ++j)
#pragma unroll
      for (int e = 0; e < 4; ++e) red[((wave * 4 + i * 2 + j) * 4 + e) * 64 + lane] = acc[i][j][e];
  __syncthreads();
  f32x4 r;
#pragma unroll
  for (int e = 0; e < 4; ++e) r[e] = (red[((0 * 4 + wave) * 4 + e) * 64 + lane] + red[((1 * 4 + wave) * 4 + e) * 64 + lane]) + (red[((2 * 4 + wave) * 4 + e) * 64 + lane] + red[((3 * 4 + wave) * 4 + e) * 64 + lane]);
  return r;
}
DI void zero_mini(f32x4 (&acc)[2][2]) {
#pragma unroll
  for (int i = 0; i < 2; ++i)
#pragma unroll
    for (int j = 0; j < 2; ++j) acc[i][j] = (f32x4){0.f, 0.f, 0.f, 0.f};
}
DI void mini_merge(const Params& p, int l, int t, char* lds) {
  const int tid = tid_(), wave = __builtin_amdgcn_readfirstlane(tid >> 6), lane = tid & 63, l15 = lane & 15, quad = lane >> 4;
  const int R0 = MP + (t >> 5) * 32, C0 = (t & 31) * 32;
  f32x4 acc[2][2]; zero_mini(acc);
  mini_gemm<false>(acc, p.o_r + (size_t)R0 * 512, 512, p.wt_brr + (size_t)C0 * 512, 512, 512, wave, l15, quad);
  const f32x4 v1 = mini_reduce(acc, lds, wave, lane);
  zero_mini(acc);
  mini_gemm<false>(acc, p.o_a + (size_t)R0 * 512, 512, p.wt_bra + (size_t)C0 * 512, 512, 512, wave, l15, quad);
  const f32x4 v2 = mini_reduce(acc, lds, wave, lane);
  const int R = R0 + (wave >> 1) * 16 + l15, c = C0 + (wave & 1) * 16 + quad * 4;
  const u32x2 g1 = *(const u32x2*)(p.z + (size_t)R * NZ + C_MR + c), g2 = *(const u32x2*)(p.z + (size_t)R * NZ + C_MA + c);
  u32x2 o;
  o[0] = pk2(bf_lo(g1[0]) * v1[0] + bf_lo(g2[0]) * v2[0], bf_hi(g1[0]) * v1[1] + bf_hi(g2[0]) * v2[1]);
  o[1] = pk2(bf_lo(g1[1]) * v1[2] + bf_lo(g2[1]) * v2[2], bf_hi(g1[1]) * v1[3] + bf_hi(g2[1]) * v2[3]);
  *(u32x2*)(p.hn + (size_t)R * DM + c) = o;
}
DI void mini_out(const Params& p, int l, int t, char* lds) {
  const int tid = tid_(), wave = __builtin_amdgcn_readfirstlane(tid >> 6), lane = tid & 63, l15 = lane & 15, quad = lane >> 4;
  const int R0 = MP + (t >> 5) * 32, C0 = (t & 31) * 32;
  f32x4 acc[2][2]; zero_mini(acc);
  mini_gemm<false>(acc, p.hn + (size_t)R0 * DM, DM, p.wt_out + (size_t)C0 * DM, DM, DM, wave, l15, quad);
  const f32x4 v = mini_reduce(acc, lds, wave, lane);
  const int R = R0 + (wave >> 1) * 16 + l15, c = C0 + (wave & 1) * 16 + quad * 4;
  const f32x4 xv = *(const f32x4*)(x_row(p, l, R) + c);
  const f32x4 x1 = xv + v;
  *(f32x4*)(p.out + (size_t)R * DM + c) = x1;
  const f32x4 gv = *(const f32x4*)(p.ple_norm_g + l * DM + c);
  u32x2 o; o[0] = pk2(x1[0] * gv[0], x1[1] * gv[1]); o[1] = pk2(x1[2] * gv[2], x1[3] * gv[3]);
  *(u32x2*)(p.o_r + (size_t)R * DM + c) = o;
  float sq = x1[0] * x1[0] + x1[1] * x1[1] + x1[2] * x1[2] + x1[3] * x1[3];
  sq += __shfl_xor(sq, 16); sq += __shfl_xor(sq, 32);
  if (quad == 0) atomicAdd(p.ss2 + R, sq);
}
DI void mini_ple(const Params& p, int l, int t, char* lds) {
  const int tid = tid_(), wave = __builtin_amdgcn_readfirstlane(tid >> 6), lane = tid & 63, l15 = lane & 15, quad = lane >> 4;
  const int R0 = MP + (t >> 5) * 32, C0 = (t & 31) * 32;
  f32x4 acc[2][2]; zero_mini(acc);
  mini_gemm<false>(acc, p.o_r + (size_t)R0 * DM, DM, p.wt_gate + (size_t)C0 * DM, DM, DM, wave, l15, quad);
  const f32x4 g = mini_reduce(acc, lds, wave, lane);
  zero_mini(acc);
  mini_gemm<true>(acc, p.ps + ((size_t)l * MS + (R0 - MP)) * 256, 256, p.wt_ple + (size_t)C0 * 256, 256, 256, wave, l15, quad);
  const f32x4 e = mini_reduce(acc, lds, wave, lane);
  const int R = R0 + (wave >> 1) * 16 + l15, c = C0 + (wave & 1) * 16 + quad * 4;
  const float rs = rsqrtf(p.ss2[R] * (1.0f / 1024.0f) + 1e-6f);
  float* xo = p.out + (size_t)R * DM + c;
  const f32x4 xv = *(const f32x4*)xo;
  f32x4 o;
#pragma unroll
  for (int k = 0; k < 4; ++k) o[k] = xv[k] + e[k] * bf1((bf16_t)(pk2(sigmoidf_(g[k] * rs), 0.f) & 0xffff));
  *(f32x4*)xo = o;
  if (l + 1 < NL) {
    const f32x4 gn = *(const f32x4*)(p.norm_g + (l + 1) * DM + c);
    u32x2 hv; hv[0] = pk2(o[0] * gn[0], o[1] * gn[1]); hv[1] = pk2(o[2] * gn[2], o[3] * gn[3]);
    *(u32x2*)(p.hn + (size_t)R * DM + c) = hv;
    float sq = o[0] * o[0] + o[1] * o[1] + o[2] * o[2] + o[3] * o[3];
    sq += __shfl_xor(sq, 16); sq += __shfl_xor(sq, 32);
    if (quad == 0) atomicAdd(p.ss1 + R, sq);
  }
}
DI void phase_merge(const Params& p, int l, char* lds) {
  const int tid = tid_(), wave = __builtin_amdgcn_readfirstlane(tid >> 6), lane = tid & 63;
  const int wm = wave >> 1, wn = wave & 1, l15 = lane & 15, quad = lane >> 4;
  for (int r = 0;; ++r) {
    const int g = xcd_tile(r, 128 * 8); if (g < 0) break;
    int mt, nt; tile_decode(g, 128, 8, mt, nt);
    f32x4 a1[4][4]; zero_acc(a1);
    gemm_dma(a1, p.o_r + (size_t)mt * 128 * 512, 512, p.wt_brr + (size_t)nt * 128 * 512, 512, 512, lds);
    u32x2 pk[4][4];
#pragma unroll
    for (int mi = 0; mi < 4; ++mi) {
      const int R = mt * 128 + wm * 64 + mi * 16 + l15;
#pragma unroll
      for (int ni = 0; ni < 4; ++ni) {
        const int c = nt * 128 + wn * 64 + ni * 16 + quad * 4;
        const u32x2 g1 = *(const u32x2*)(p.z + (size_t)R * NZ + C_MR + c);
        const f32x4 v1 = a1[mi][ni];
        pk[mi][ni][0] = pk2(bf_lo(g1[0]) * v1[0], bf_hi(g1[0]) * v1[1]);
        pk[mi][ni][1] = pk2(bf_lo(g1[1]) * v1[2], bf_hi(g1[1]) * v1[3]);
      }
    }
    zero_acc(a1);
    gemm_dma(a1, p.o_a + (size_t)mt * 128 * 512, 512, p.wt_bra + (size_t)nt * 128 * 512, 512, 512, lds);
#pragma unroll
    for (int mi = 0; mi < 4; ++mi) {
      const int R = mt * 128 + wm * 64 + mi * 16 + l15;
#pragma unroll
      for (int ni = 0; ni < 4; ++ni) {
        const int c = nt * 128 + wn * 64 + ni * 16 + quad * 4;
        const u32x2 g2 = *(const u32x2*)(p.z + (size_t)R * NZ + C_MA + c);
        const f32x4 v2 = a1[mi][ni]; const u32x2 u1 = pk[mi][ni];
        u32x2 o;
        o[0] = pk2(bf_lo(u1[0]) + bf_lo(g2[0]) * v2[0], bf_hi(u1[0]) + bf_hi(g2[0]) * v2[1]);
        o[1] = pk2(bf_lo(u1[1]) + bf_lo(g2[1]) * v2[2], bf_hi(u1[1]) + bf_hi(g2[1]) * v2[3]);
        *(u32x2*)(p.hn + (size_t)R * DM + c) = o;
      }
    }
  }
  for (int t = blockIdx.x; t < 512; t += gridDim.x) mini_merge(p, l, t, lds);
}
DI void phase_out(const Params& p, int l, char* lds) {
  const int tid = tid_(), wave = __builtin_amdgcn_readfirstlane(tid >> 6), lane = tid & 63;
  const int wm = wave >> 1, wn = wave & 1, l15 = lane & 15, quad = lane >> 4;
  for (int r = 0;; ++r) {
    const int g = xcd_tile(r, 128 * 8); if (g < 0) break;
    int mt, nt; tile_decode(g, 128, 8, mt, nt);
    f32x4 acc[4][4]; zero_acc(acc);
    gemm_dma(acc, p.hn + (size_t)mt * 128 * DM, DM, p.wt_out + (size_t)nt * 128 * DM, DM, DM, lds);
#pragma unroll
    for (int mi = 0; mi < 4; ++mi) {
      const int R = mt * 128 + wm * 64 + mi * 16 + l15;
      const float* xr = x_row(p, l, R);
      const float* g2 = p.ple_norm_g + l * DM;
      bf16_t* xb = p.o_r + (size_t)R * DM;
      float sq = 0.f;
#pragma unroll
      for (int ni = 0; ni < 4; ++ni) {
        const int c = nt * 128 + wn * 64 + ni * 16 + quad * 4;
        const f32x4 xv = *(const f32x4*)(xr + c);
        const f32x4 x1 = xv + acc[mi][ni];
        *(f32x4*)(p.out + (size_t)R * DM + c) = x1;
        const f32x4 gv = *(const f32x4*)(g2 + c);
        u32x2 o; o[0] = pk2(x1[0] * gv[0], x1[1] * gv[1]); o[1] = pk2(x1[2] * gv[2], x1[3] * gv[3]);
        *(u32x2*)(xb + c) = o;
        sq += x1[0] * x1[0] + x1[1] * x1[1] + x1[2] * x1[2] + x1[3] * x1[3];
      }
      sq += __shfl_xor(sq, 16); sq += __shfl_xor(sq, 32);
      if (quad == 0) atomicAdd(p.ss2 + R, sq);
    }
  }
  for (int t = blockIdx.x; t < 512; t += gridDim.x) mini_out(p, l, t, lds);
}
DI void phase_ple(const Params& p, int l, char* lds) {
  const int tid = tid_(), wave = __builtin_amdgcn_readfirstlane(tid >> 6), lane = tid & 63;
  const int wm = wave >> 1, wn = wave & 1, l15 = lane & 15, quad = lane >> 4;
  for (int r = 0;; ++r) {
    const int g = xcd_tile(r, 128 * 8); if (g < 0) break;
    int mt, nt; tile_decode(g, 128, 8, mt, nt);
    f32x4 a1[4][4]; zero_acc(a1);
    gemm_dma(a1, p.o_r + (size_t)mt * 128 * DM, DM, p.wt_gate + (size_t)nt * 128 * DM, DM, DM, lds);
    u32x2 pk[4][4];
#pragma unroll
    for (int mi = 0; mi < 4; ++mi) {
      const float rs = rsqrtf(p.ss2[mt * 128 + wm * 64 + mi * 16 + l15] * (1.0f / 1024.0f) + 1e-6f);
#pragma unroll
      for (int ni = 0; ni < 4; ++ni) { const f32x4 v = a1[mi][ni] * rs; pk[mi][ni][0] = pk2(sigmoidf_(v[0]), sigmoidf_(v[1])); pk[mi][ni][1] = pk2(sigmoidf_(v[2]), sigmoidf_(v[3])); }
    }
    zero_acc(a1);
    const int r0 = mt * 128;
    const float* pa = r0 < MP ? p.pp + ((size_t)l * MP + r0) * 256 : p.ps + ((size_t)l * MS + (r0 - MP)) * 256;
    gemm_core<true>(a1, pa, 256, p.wt_ple + (size_t)nt * 128 * 256, 256, 256, lds);
#pragma unroll
    for (int mi = 0; mi < 4; ++mi) {
      const int R = mt * 128 + wm * 64 + mi * 16 + l15;
      float sq = 0.f;
#pragma unroll
      for (int ni = 0; ni < 4; ++ni) {
        const int c = nt * 128 + wn * 64 + ni * 16 + quad * 4;
        float* xo = p.out + (size_t)R * DM + c;
        const f32x4 xv = *(const f32x4*)xo; const f32x4 e = a1[mi][ni]; const u32x2 g = pk[mi][ni];
        f32x4 o;
        o[0] = xv[0] + e[0] * bf_lo(g[0]); o[1] = xv[1] + e[1] * bf_hi(g[0]);
        o[2] = xv[2] + e[2] * bf_lo(g[1]); o[3] = xv[3] + e[3] * bf_hi(g[1]);
        *(f32x4*)xo = o;
        if (l + 1 < NL) {
          const f32x4 gn = *(const f32x4*)(p.norm_g + (l + 1) * DM + c);
          u32x2 hv; hv[0] = pk2(o[0] * gn[0], o[1] * gn[1]); hv[1] = pk2(o[2] * gn[2], o[3] * gn[3]);
          *(u32x2*)(p.hn + (size_t)R * DM + c) = hv;
          sq += o[0] * o[0] + o[1] * o[1] + o[2] * o[2] + o[3] * o[3];
        }
      }
      if (l + 1 < NL) {
        sq += __shfl_xor(sq, 16); sq += __shfl_xor(sq, 32);
        if (quad == 0) atomicAdd(p.ss1 + R, sq);
      }
    }
  }
  for (int t = blockIdx.x; t < 512; t += gridDim.x) mini_ple(p, l, t, lds);
  if (l + 1 < NL) {
    for (int it = blockIdx.x; it < 2080 + 16 + 2048; it += gridDim.x) {
      if (it < 2080) wconv_tile(p, l + 1, it, (float*)lds);
      else if (it < 2096) wconv_tile(p, l + 1, 2400 + (it - 2080), (float*)lds);
      else cache_item(p, l + 1, it - 2096, lds);
    }
  }
}


#define XB_TMO      128
#define XB_XCNT(j)  (256  + 64 * (j))
#define XB_XSUB(j)  (1280 + 64 * (j))
#define XB_XGEN(j)  (2304 + 64 * (j))
#define XB_TOP      3328
#define XB_TOPGEN   3392
#define XB_SPIN_CAP (1u << 18)
#define LAS __attribute__((address_space(3)))
DI unsigned xb_ld(unsigned* p)              { return __hip_atomic_load(p, __ATOMIC_RELAXED, __HIP_MEMORY_SCOPE_AGENT); }
DI unsigned xb_add(unsigned* p, unsigned v) { return __hip_atomic_fetch_add(p, v, __ATOMIC_RELAXED, __HIP_MEMORY_SCOPE_AGENT); }
DI unsigned xb_xcc_id() { return (unsigned)__builtin_amdgcn_s_getreg((3 << 11) | 20) & 0xFu; }
#define XB_SPIN(cond, bar) do { unsigned _sp = 0; while (cond) { __builtin_amdgcn_s_sleep(1); \
    if ((++_sp & 255u) == 0u) { if (xb_ld(&(bar)[XB_TMO])) break; if (_sp > XB_SPIN_CAP) { atomicAdd(&(bar)[XB_TMO], 1u); break; } } } } while (0)
struct XcdBarrier { unsigned* bar; unsigned x; volatile LAS unsigned* st; };
DI XcdBarrier xcd_barrier_post(unsigned* bar, volatile LAS unsigned* st) {
  XcdBarrier b; b.bar = bar; b.x = xb_xcc_id(); b.st = st;
  if (threadIdx.x == 0) (void)xb_add(&bar[XB_XCNT(b.x)], 1u);
  return b;
}
DI void xcd_barrier_complete(unsigned* bar, unsigned x, unsigned& nloc, unsigned& nx) {
  const unsigned G = gridDim.x * gridDim.y * gridDim.z;
  unsigned sum, cnt, mine, sp = 0u;
  for (;;) {
    sum = 0u; cnt = 0u; mine = 0u;
#pragma unroll
    for (unsigned j = 0; j < 16; ++j) { const unsigned c = xb_ld(&bar[XB_XCNT(j)]); sum += c; cnt += (c > 0u) ? 1u : 0u; mine = (j == x) ? c : mine; }
    if (sum == G) break;
    __builtin_amdgcn_s_sleep(1);
    if ((++sp & 255u) == 0u) { if (xb_ld(&bar[XB_TMO])) break; if (sp > XB_SPIN_CAP) { atomicAdd(&bar[XB_TMO], 1u); break; } }
  }
  nloc = mine > 0u ? mine : 1u; nx = cnt > 0u ? cnt : 1u;
}
DI void xcd_barrier(const XcdBarrier& b) {
  asm volatile("s_waitcnt vmcnt(0)" ::: "memory");
  __syncthreads();
  if (threadIdx.x == 0) {
    unsigned* bar = b.bar;
    __builtin_amdgcn_s_waitcnt(0);
    unsigned nloc = b.st[0], nx = b.st[1];
    if (nloc == 0u) { xcd_barrier_complete(bar, b.x, nloc, nx); b.st[0] = nloc; b.st[1] = nx; }
    const unsigned old = xb_add(&bar[XB_XSUB(b.x)], 1u);
    const unsigned gen = old / nloc;
    if (old + 1u == (gen + 1u) * nloc) {
      __builtin_amdgcn_fence(__ATOMIC_RELEASE, "agent");
      asm volatile("s_waitcnt vmcnt(0)" ::: "memory");
      const unsigned og = xb_add(&bar[XB_TOP], 1u);
      const unsigned tg = og / nx;
      if (og + 1u == (tg + 1u) * nx) xb_add(&bar[XB_TOPGEN], 1u);
      else XB_SPIN(xb_ld(&bar[XB_TOPGEN]) == tg, bar);
      __builtin_amdgcn_fence(__ATOMIC_ACQUIRE, "agent");
      xb_add(&bar[XB_XGEN(b.x)], 1u);
      asm volatile("s_waitcnt vmcnt(0)" ::: "memory");
    } else {
      XB_SPIN(xb_ld(&bar[XB_XGEN(b.x)]) == gen, bar);
      __builtin_amdgcn_fence(__ATOMIC_ACQUIRE, "agent");
      asm volatile("s_waitcnt vmcnt(0)" ::: "memory");
    }
  }
  __syncthreads();
}
constexpr int LDS_BYTES = 73728;
DI void run_phase(const Params& p, int ph, int l, char* lds) {
  switch (ph) {
    case 1: phase_norm0(p, lds); break;
    case 2: phase_gemm_in(p, l, lds); break;
    case 3: phase_mix(p, l, lds); break;
    case 4: phase_merge(p, l, lds); break;
    case 5: phase_out(p, l, lds); break;
    case 6: break;
    case 7: phase_ple(p, l, lds); break;
    case 8: phase_chunk(p, l, lds); break;
  }
}

#if MEGA
__global__ void __launch_bounds__(256, 2) k_mega(Params p) {
  __shared__ __attribute__((aligned(16))) char lds[LDS_BYTES];
  __shared__ uint4 xb_words;
  cg::grid_group grid = cg::this_grid();
  if (threadIdx.x == 0) xb_words = make_uint4(0u, 0u, 0u, 0u);
  __syncthreads();
  const XcdBarrier xb = xcd_barrier_post(p.bar, (volatile LAS unsigned*)&xb_words);
  phase_norm0(p, lds);
  grid.sync();
#pragma unroll 1
  for (int l = 0; l < NL; ++l) {
    phase_gemm_in(p, l, lds); xcd_barrier(xb);
    phase_chunk(p, l, lds); xcd_barrier(xb);
    phase_mix(p, l, lds); xcd_barrier(xb);
    phase_o(p, l, blockIdx.x, NCH_P / 2, gridDim.x); xcd_barrier(xb);
    phase_merge(p, l, lds); xcd_barrier(xb);
    phase_out(p, l, lds); xcd_barrier(xb);
    phase_ple(p, l, lds); if (l + 1 < NL) xcd_barrier(xb);
  }
}
#else
template <int PH>
__global__ void __launch_bounds__(256, 2) k_phase(Params p, int l) {
  __shared__ __attribute__((aligned(16))) char lds[LDS_BYTES];
  run_phase(p, PH, l, lds);
}
#endif

extern "C" void kernel_launch(void* const* d_in, const int* in_sizes, int n_in, void* d_out, int out_size, void* d_ws, size_t ws_size,
                              hipStream_t stream) {
  Params p{};
  const float** pf = (const float**)&p;
  for (int i = 0; i < 33; ++i) pf[i] = (const float*)d_in[i];
  p.out = (float*)d_out;
  char* w = (char*)d_ws; size_t off = 0;
  auto take = [&](size_t bytes) { char* r = w + off; off += (bytes + 255) & ~(size_t)255; return (bf16_t*)r; };
  p.gS = take((size_t)(NCH + 1) * 4096 * 2);
  p.ss1 = (float*)take((size_t)MT * 4); p.ss2 = (float*)take((size_t)MT * 4);
  p.bar = (unsigned*)take((size_t)(XCD_BAR_WORDS + 64 * NL) * 4);
  p.wt_in = take((size_t)NZ * 1024 * 2);
  p.wt_brr = take((size_t)1024 * 512 * 2);
  p.wt_bra = take((size_t)1024 * 512 * 2);
  p.wt_out = take((size_t)1024 * 1024 * 2);
  p.wt_ple = take((size_t)1024 * 256 * 2);
  p.wt_gate = take((size_t)1024 * 1024 * 2);
  p.w2t = take((size_t)512 * 64 * 2);
  p.a2t = take((size_t)512 * 64 * 2);
  p.z = take((size_t)MT * NZ * 2);
  p.vtp = take((size_t)16 * 128 * 4096 * 2);
  p.vts = take((size_t)32 * 128 * 64 * 2);
  p.kc = take((size_t)8 * 1024 * 512 * 2);
  p.vct = take((size_t)32 * 128 * 1024 * 2);
  p.o_r = take((size_t)MT * 512 * 2);
  p.o_a = take((size_t)MT * 512 * 2);
  p.hn = take((size_t)MT * DM * 2);
  p.cPT = p.hn;
  p.cG = take((size_t)NCH * 4096 * 2);
  p.cRT = take((size_t)NCH * 2048 * 2);
  p.cOI = take((size_t)NCH * 2048 * 2);
  p.cBA = take((size_t)NCH * 2048 * 2);
  if (off > ws_size) { fprintf(stderr, "workspace too small: need %zu have %zu\n", off, ws_size); return; }
#if MEGA
  hipMemsetAsync(p.bar, 0, (size_t)(XCD_BAR_WORDS + 64 * NL) * 4, stream);
  static int grid_blocks = 0;
  if (!grid_blocks) {
    int dev = 0, cus = 0, per_cu = 0;
    hipGetDevice(&dev);
    hipDeviceGetAttribute(&cus, hipDeviceAttributeMultiprocessorCount, dev);
    hipOccupancyMaxActiveBlocksPerMultiprocessor(&per_cu, k_mega, 256, 0);
    if (per_cu > 2) per_cu = 2;
    grid_blocks = cus * per_cu;
  }
  void* args[] = {&p};
  hipError_t e = hipLaunchCooperativeKernel((void*)k_mega, dim3(grid_blocks), dim3(256), args, 0, stream);
  if (e != hipSuccess) fprintf(stderr, "cooperative launch failed: %s (grid %d)\n", hipGetErrorString(e), grid_blocks);
#else
  const int G = 512;
  for (int l = 0; l < NL; ++l) {
    k_phase<1><<<G, 256, 0, stream>>>(p, l);
    k_phase<2><<<G, 256, 0, stream>>>(p, l);
    k_phase<8><<<G, 256, 0, stream>>>(p, l);
    k_phase<3><<<G, 256, 0, stream>>>(p, l);
    k_phase<4><<<G, 256, 0, stream>>>(p, l);
    k_phase<5><<<G, 256, 0, stream>>>(p, l);
    k_phase<6><<<G, 256, 0, stream>>>(p, l);
    k_phase<7><<<G, 256, 0, stream>>>(p, l);
  }
#endif
}
```
